# Optimizing an MI355X kernel written in HIP

```python
import jax, jax.numpy as jnp
from jax import lax
import numpy as np

D_MODEL = 1024
BATCH = 4
SEQ = 4096
DEPTH = 2

GRID_W = 64
CTX_LEN = 256
EPS = 1e-6

N_MIXERS = 4
D_MIX = D_MODEL
D_GROUP = D_MIX // N_MIXERS
A_HEADS = 4
A_DH = D_GROUP // A_HEADS
B_HEADS = 4
B_DH = D_GROUP // B_HEADS
WIN_H = 8
WIN_W = 16
C_HEADS = 4
C_DV = D_GROUP // C_HEADS
C_DK = C_DV // 2
C_GATE_RANK = 16
C_GATE_NORM = 16.0
D_HEADS = 4
D_NOPE = D_GROUP // D_HEADS
D_V = D_GROUP // D_HEADS
D_ROPE = D_NOPE // 2
ROPE_FREQS = D_ROPE // 4
ROPE_BASE = 10000.0
D_Q_RANK = 3 * D_GROUP // 4
D_KV_RANK = D_GROUP // 2
MLA_SCALE = (D_NOPE + D_ROPE) ** -0.5
Q_BLOCK = 128
CHUNK = 64
N_GROUPS = 4
EXPERTS_PER_GROUP = 8
N_EXPERTS = N_GROUPS * EXPERTS_PER_GROUP
TOP_K = 2
D_EXPERT = D_MODEL // 4
MOE_BLOCK = 256

IN_SIZES = (
    D_GROUP, D_GROUP, D_GROUP, D_GROUP, D_GROUP,
    D_GROUP, D_GROUP, D_GROUP,
    C_HEADS * C_DK, C_HEADS * C_DK, C_HEADS * C_DV, C_HEADS * C_DV,
    C_GATE_RANK, C_GATE_RANK,
    D_Q_RANK, D_KV_RANK, D_ROPE,
)
D_IN = sum(IN_SIZES)

kernel_name = 'hybrid_parallel_heads_dit_moe'


def rmsnorm(x, g):
    xf = x.astype(jnp.float32)
    y = xf * lax.rsqrt(jnp.mean(xf * xf, axis=-1, keepdims=True) + EPS)
    return (y * g.astype(jnp.float32)).astype(x.dtype)


def split_heads(t, n_heads):
    return t.reshape(t.shape[:-1] + (n_heads, t.shape[-1] // n_heads))


def merge_heads(t):
    return t.reshape(t.shape[:-2] + (t.shape[-2] * t.shape[-1],))


def flip(t):
    return jnp.flip(t, axis=1)


def split_projection(p):
    return jnp.split(p, np.cumsum(IN_SIZES)[:-1].tolist(), axis=-1)


def rope_2d(u, cos, sin):
    v = u.reshape(u.shape[:-1] + (2, 2, ROPE_FREQS))
    u1, u2 = v[..., 0, :], v[..., 1, :]
    out = jnp.stack([u1 * cos - u2 * sin, u1 * sin + u2 * cos], axis=-2)
    return out.reshape(u.shape).astype(u.dtype)


def chunk_gated_recurrence(q, k, v, log_a, s0):
    b, t, h, _ = q.shape
    dv = v.shape[-1]
    n = t // CHUNK

    def chunks(u):
        return jnp.moveaxis(u.astype(jnp.float32).reshape(b, n, CHUNK, h, u.shape[-1]), 1, 0)

    lower = jnp.tril(jnp.ones((CHUNK, CHUNK), dtype=bool))[None, :, :, None, None]

    def step(state, inp):
        qc, kc, vc, gc = inp
        cum = jnp.cumsum(gc, axis=1)
        rel = jnp.exp(jnp.where(lower, cum[:, :, None] - cum[:, None], -jnp.inf))
        att = jnp.einsum('bihk,bjhk,bijhk->bhij', qc, kc, rel)
        o = (jnp.einsum('bhij,bjhv->bihv', att, vc)
             + jnp.einsum('bihk,bhkv->bihv', qc * jnp.exp(cum), state))
        last = cum[:, -1]
        state = (jnp.exp(last)[..., None] * state
                 + jnp.einsum('bjhk,bjhv->bhkv', kc * jnp.exp(last[:, None] - cum), vc))
        return state, o

    state, o = lax.scan(step, s0, (chunks(q), chunks(k), chunks(v), chunks(log_a)))
    o = jnp.moveaxis(o, 0, 1).reshape(b, t, h, dv)
    return o.astype(v.dtype), state


def bidirectional_recurrence(lat, ctx):
    def both_directions(q, v, k_f, la_f, k_b, la_b, s_f, s_b):
        o_f, s_f = chunk_gated_recurrence(q, k_f, v, la_f, s_f)
        o_b, s_b = chunk_gated_recurrence(flip(q), flip(k_b), flip(v), flip(la_b), s_b)
        return o_f + flip(o_b), s_f, s_b

    qc, vc = ctx[0], ctx[1]
    s0 = jnp.zeros((qc.shape[0], qc.shape[2], qc.shape[3], vc.shape[3]), jnp.float32)
    o_ctx, s_f, s_b = both_directions(*ctx, s0, s0)
    o_lat, _, _ = both_directions(*lat, s_f, s_b)
    return o_lat, o_ctx


def hgrn_lower_bounds(logits):
    cum = jnp.cumsum(jax.nn.softmax(logits.astype(jnp.float32), axis=0), axis=0)
    return cum - cum[0]


def hgrn2_mixer(cols_lat, cols_ctx, lb, norm_g, with_ctx_out):
    def prep(q, i, f_fwd, f_bwd):
        q = split_heads(jax.nn.silu(q), A_HEADS) * (A_DH ** -0.5)
        v = split_heads(i, A_HEADS)
        dirs = []
        for f_logit, lbd in ((f_fwd, lb[0]), (f_bwd, lb[1])):
            z = f_logit.astype(jnp.float32)
            log_f = jnp.logaddexp(jnp.log(lbd), jnp.log1p(-lbd) + jax.nn.log_sigmoid(z))
            k = (1.0 - lbd) * jax.nn.sigmoid(-z)
            dirs += [split_heads(k, A_HEADS), split_heads(log_f, A_HEADS)]
        return (q, v, *dirs)

    o_lat, o_ctx = bidirectional_recurrence(prep(*cols_lat[:4]), prep(*cols_ctx[:4]))

    def readout(o, g):
        return merge_heads(rmsnorm(o, norm_g.reshape(A_HEADS, A_DH))) * jax.nn.silu(g)

    return readout(o_lat, cols_lat[4]), (readout(o_ctx, cols_ctx[4]) if with_ctx_out else None)


def gla_mixer(cols_lat, cols_ctx, wg_f, bg_f, wg_b, bg_b, norm_g, with_ctx_out):
    def prep(q, k, v, g, z_f, z_b):
        q = split_heads(q, C_HEADS) * (C_DK ** -0.5)
        k = split_heads(k, C_HEADS)
        v = split_heads(v, C_HEADS)
        la_f = split_heads(jax.nn.log_sigmoid((z_f @ wg_f + bg_f).astype(jnp.float32)) / C_GATE_NORM, C_HEADS)
        la_b = split_heads(jax.nn.log_sigmoid((z_b @ wg_b + bg_b).astype(jnp.float32)) / C_GATE_NORM, C_HEADS)
        return (q, v, k, la_f, k, la_b)

    o_lat, o_ctx = bidirectional_recurrence(prep(*cols_lat), prep(*cols_ctx))

    def readout(o, g):
        return merge_heads(rmsnorm(o, norm_g.reshape(C_HEADS, C_DV))) * jax.nn.silu(g)

    return readout(o_lat, cols_lat[3]), (readout(o_ctx, cols_ctx[3]) if with_ctx_out else None)


def neighbourhood_attention_mixer(cols_lat, cols_ctx, rpb, with_ctx_out):
    q, k, v = (split_heads(u, B_HEADS) for u in cols_lat)
    qc, kc, vc = (split_heads(u, B_HEADS) for u in cols_ctx)
    b, n = q.shape[:2]
    rows_n = n // GRID_W
    kh = min(WIN_H, rows_n)
    scale = B_DH ** -0.5
    r = jnp.arange(rows_n)
    row_idx = jnp.clip(r - kh // 2, 0, rows_n - kh)[:, None] + jnp.arange(kh)[None]
    cidx = jnp.arange(GRID_W)
    c_start = jnp.clip(cidx - WIN_W // 2, 0, GRID_W - WIN_W)
    col_in = (cidx[None] >= c_start[:, None]) & (cidx[None] < c_start[:, None] + WIN_W)
    dr = row_idx - r[:, None] + (WIN_H - 1)
    dc = jnp.clip(cidx[None] - cidx[:, None], -(WIN_W - 1), WIN_W - 1) + (WIN_W - 1)
    bias = rpb[:, dr[:, None, :, None], dc[None, :, None, :]].astype(jnp.float32)

    qg = q.reshape(b, rows_n, GRID_W, B_HEADS, B_DH) * scale
    kg = k.reshape(b, rows_n, GRID_W, B_HEADS, B_DH)[:, row_idx]
    vg = v.reshape(b, rows_n, GRID_W, B_HEADS, B_DH)[:, row_idx]
    s_win = jnp.einsum('brqhd,brjwhd->bhrqjw', qg, kg).astype(jnp.float32) + bias[None]
    s_win = jnp.where(col_in[:, None, :], s_win, -jnp.inf)
    s_ctx = jnp.einsum('brqhd,blhd->bhrql', qg, kc).astype(jnp.float32)
    n_win = kh * GRID_W
    s = jnp.concatenate([s_win.reshape(b, B_HEADS, rows_n, GRID_W, n_win), s_ctx], axis=-1)
    p = jax.nn.softmax(s, axis=-1).astype(v.dtype)
    p_win = p[..., :n_win].reshape(b, B_HEADS, rows_n, GRID_W, kh, GRID_W)
    o = (jnp.einsum('bhrqjw,brjwhd->brqhd', p_win, vg)
         + jnp.einsum('bhrql,blhd->brqhd', p[..., n_win:], vc))
    o_lat = o.reshape(b, n, D_GROUP)
    o_ctx = None
    if with_ctx_out:
        s_cc = jnp.einsum('bqhd,blhd->bhql', qc * scale, kc).astype(jnp.float32)
        o_ctx = merge_heads(jnp.einsum('bhql,blhd->bqhd', jax.nn.softmax(s_cc, axis=-1).astype(vc.dtype), vc))
    return o_lat, o_ctx


def mla_attend(qn, qr, kn, kr, v):
    s = (jnp.einsum('bqhd,bkhd->bhqk', qn, kn) + jnp.einsum('bqhr,bkr->bhqk', qr, kr)).astype(jnp.float32) * MLA_SCALE
    p = jax.nn.softmax(s, axis=-1).astype(v.dtype)
    return jnp.einsum('bhqk,bkhd->bqhd', p, v)


def mla_mixer(cols_lat, cols_ctx, q_norm_g, w_uq, kv_norm_g, w_ukv, cos, sin, with_ctx_out):
    def prep(cq, ckv, k_rope):
        q = split_heads(rmsnorm(cq, q_norm_g) @ w_uq, D_HEADS)
        kv = split_heads(rmsnorm(ckv, kv_norm_g) @ w_ukv, D_HEADS)
        return q[..., :D_NOPE], q[..., D_NOPE:], kv[..., :D_NOPE], k_rope, kv[..., D_NOPE:]

    qn, qr, kn, kr, v = prep(*cols_lat)
    qr = rope_2d(qr, cos[:, None], sin[:, None])
    kr = rope_2d(kr, cos, sin)
    qnc, qrc, knc, krc, vc = prep(*cols_ctx)
    kn_all = jnp.concatenate([knc, kn], axis=1)
    kr_all = jnp.concatenate([krc, kr], axis=1)
    v_all = jnp.concatenate([vc, v], axis=1)
    b, n = qn.shape[:2]
    nb = n // Q_BLOCK

    def blocks(u):
        return jnp.moveaxis(u.reshape((b, nb, Q_BLOCK) + u.shape[2:]), 1, 0)

    o = lax.map(lambda qs: mla_attend(qs[0], qs[1], kn_all, kr_all, v_all), (blocks(qn), blocks(qr)))
    o_lat = jnp.moveaxis(o, 0, 1).reshape(b, n, D_GROUP)
    o_ctx = merge_heads(mla_attend(qnc, qrc, knc, krc, vc)) if with_ctx_out else None
    return o_lat, o_ctx


def hierarchical_moe(h, w_rg, b_rg, w_re, b_re, w_gu, w_dn):
    t_tok, d = h.shape
    hf = h.astype(jnp.float32)
    g_logits = hf @ w_rg.astype(jnp.float32) + b_rg.astype(jnp.float32)
    _, g_sel = lax.top_k(g_logits, 1)
    p_group = jnp.take_along_axis(jax.nn.softmax(g_logits, axis=-1), g_sel, axis=-1)
    e_logits = (hf @ w_re.astype(jnp.float32) + b_re.astype(jnp.float32)).reshape(t_tok, N_GROUPS, EXPERTS_PER_GROUP)
    e_in_group = jnp.take_along_axis(e_logits, g_sel[:, :, None], axis=1)[:, 0]
    w_top, i_top = lax.top_k(jax.nn.softmax(e_in_group, axis=-1), TOP_K)
    w_top = p_group * w_top / jnp.sum(w_top, axis=-1, keepdims=True)
    expert_id = (g_sel * EXPERTS_PER_GROUP + i_top).reshape(-1)
    n_assign = t_tok * TOP_K
    token_id = jnp.repeat(jnp.arange(t_tok), TOP_K)
    order = jnp.argsort(expert_id)
    e_sorted, tok_sorted, w_sorted = expert_id[order], token_id[order], w_top.reshape(-1)[order]
    counts = jnp.zeros((N_EXPERTS,), jnp.int32).at[expert_id].add(1)
    starts = jnp.cumsum(counts) - counts
    padded = (counts + MOE_BLOCK - 1) // MOE_BLOCK * MOE_BLOCK
    padded_end = jnp.cumsum(padded)
    dest = (padded_end - padded)[e_sorted] + jnp.arange(n_assign) - starts[e_sorted]
    n_blocks = -(-n_assign // MOE_BLOCK) + N_EXPERTS
    xs = jnp.zeros((n_blocks * MOE_BLOCK, d), h.dtype).at[dest].set(h[tok_sorted])
    block_expert = jnp.minimum(jnp.searchsorted(padded_end, jnp.arange(n_blocks) * MOE_BLOCK, side='right'), N_EXPERTS - 1)

    def expert_block(args):
        xb, e = args
        gu = xb @ w_gu[e]
        return (jax.nn.silu(gu[:, :D_EXPERT]) * gu[:, D_EXPERT:]) @ w_dn[e]

    ys = lax.map(expert_block, (xs.reshape(n_blocks, MOE_BLOCK, d), block_expert)).reshape(-1, d)
    y = jnp.zeros((t_tok, d), jnp.float32).at[tok_sorted].add(ys[dest].astype(jnp.float32) * w_sorted[:, None])
    return y.astype(h.dtype)


def setup_inputs(seed: int = 0) -> dict:
    key = jax.random.key(seed)
    ks = iter(jax.random.split(key, 32))

    def normal(shape, scale):
        return scale * jax.random.normal(next(ks), shape, jnp.float32)

    def gain(shape):
        return 1.0 + normal(shape, 0.05)

    D = D_MODEL
    return {
        'x': normal((BATCH, SEQ, D), 1.0),
        'c': normal((BATCH, D), 1.0),
        'ctx': normal((BATCH, CTX_LEN, D), 1.0),
        'c_ctx': normal((D,), 1.0),
        'w_mod': normal((DEPTH, D, 6 * D), 0.5 * D ** -0.5),
        'b_mod': normal((DEPTH, 6 * D), 0.02),
        'norm1_g': gain((DEPTH, D)),
        'norm2_g': gain((DEPTH, D)),
        'w_in': normal((DEPTH, D, D_IN), D ** -0.5),
        'w_out': normal((DEPTH, D_MIX, D), D_MIX ** -0.5),
        'hgrn_lb_logits': normal((DEPTH, 2, D_GROUP), 0.5),
        'hgrn_norm_g': gain((DEPTH, D_GROUP)),
        'na_rpb': normal((DEPTH, B_HEADS, 2 * WIN_H - 1, 2 * WIN_W - 1), 0.5),
        'gla_wg_f': normal((DEPTH, C_GATE_RANK, C_HEADS * C_DK), C_GATE_RANK ** -0.5),
        'gla_bg_f': normal((DEPTH, C_HEADS * C_DK), 0.1),
        'gla_wg_b': normal((DEPTH, C_GATE_RANK, C_HEADS * C_DK), C_GATE_RANK ** -0.5),
        'gla_bg_b': normal((DEPTH, C_HEADS * C_DK), 0.1),
        'gla_norm_g': gain((DEPTH, D_GROUP)),
        'mla_q_norm_g': gain((DEPTH, D_Q_RANK)),
        'mla_w_uq': normal((DEPTH, D_Q_RANK, D_HEADS * (D_NOPE + D_ROPE)), D_Q_RANK ** -0.5),
        'mla_kv_norm_g': gain((DEPTH, D_KV_RANK)),
        'mla_w_ukv': normal((DEPTH, D_KV_RANK, D_HEADS * (D_NOPE + D_V)), D_KV_RANK ** -0.5),
        'moe_w_rg': normal((DEPTH, D, N_GROUPS), D ** -0.5),
        'moe_b_rg': normal((DEPTH, N_GROUPS), 0.01),
        'moe_w_re': normal((DEPTH, D, N_EXPERTS), D ** -0.5),
        'moe_b_re': normal((DEPTH, N_EXPERTS), 0.01),
        'moe_w_gu': normal((DEPTH, N_EXPERTS, D, 2 * D_EXPERT), D ** -0.5),
        'moe_w_dn': normal((DEPTH, N_EXPERTS, D_EXPERT, D), D_EXPERT ** -0.5),
        'final_norm_g': gain((D,)),
    }


def reference(x, c, ctx, c_ctx, w_mod, b_mod, norm1_g, norm2_g, w_in, w_out, hgrn_lb_logits, hgrn_norm_g,
              na_rpb, gla_wg_f, gla_bg_f, gla_wg_b, gla_bg_b, gla_norm_g, mla_q_norm_g, mla_w_uq,
              mla_kv_norm_g, mla_w_ukv, moe_w_rg, moe_b_rg, moe_w_re, moe_b_re, moe_w_gu, moe_w_dn, final_norm_g):
    b, n, _ = x.shape
    l_ctx = ctx.shape[1]
    t = jnp.arange(n)
    inv_freq = ROPE_BASE ** (-jnp.arange(ROPE_FREQS, dtype=jnp.float32) / ROPE_FREQS)
    ang = jnp.stack([(t // GRID_W).astype(jnp.float32)[:, None] * inv_freq,
                     (t % GRID_W).astype(jnp.float32)[:, None] * inv_freq], axis=1)
    cos, sin = jnp.cos(ang), jnp.sin(ang)
    lower_bounds = hgrn_lower_bounds(hgrn_lb_logits)
    c_act = jax.nn.silu(c)
    c_ctx_act = jax.nn.silu(c_ctx)
    xc = ctx
    for layer in range(DEPTH):
        keep_ctx = layer < DEPTH - 1
        m_lat = jnp.split((c_act @ w_mod[layer] + b_mod[layer])[:, None, :], 6, axis=-1)
        m_ctx = jnp.split(c_ctx_act @ w_mod[layer] + b_mod[layer], 6, axis=-1)
        h = rmsnorm(x, norm1_g[layer]) * (1.0 + m_lat[1]) + m_lat[0]
        hc = rmsnorm(xc, norm1_g[layer]) * (1.0 + m_ctx[1]) + m_ctx[0]
        p = split_projection(h @ w_in[layer])
        pc = split_projection(hc @ w_in[layer])
        oa, oac = hgrn2_mixer(p[0:5], pc[0:5], lower_bounds[layer], hgrn_norm_g[layer], keep_ctx)
        ob, obc = neighbourhood_attention_mixer(p[5:8], pc[5:8], na_rpb[layer], keep_ctx)
        og, ogc = gla_mixer(p[8:14], pc[8:14], gla_wg_f[layer], gla_bg_f[layer], gla_wg_b[layer], gla_bg_b[layer],
                            gla_norm_g[layer], keep_ctx)
        od, odc = mla_mixer(p[14:17], pc[14:17], mla_q_norm_g[layer], mla_w_uq[layer], mla_kv_norm_g[layer],
                            mla_w_ukv[layer], cos, sin, keep_ctx)
        x = x + m_lat[2] * (jnp.concatenate([oa, ob, og, od], axis=-1) @ w_out[layer])
        h2 = rmsnorm(x, norm2_g[layer]) * (1.0 + m_lat[4]) + m_lat[3]
        moe_args = (moe_w_rg[layer], moe_b_rg[layer], moe_w_re[layer], moe_b_re[layer], moe_w_gu[layer], moe_w_dn[layer])
        if keep_ctx:
            xc = xc + m_ctx[2] * (jnp.concatenate([oac, obc, ogc, odc], axis=-1) @ w_out[layer])
            h2c = rmsnorm(xc, norm2_g[layer]) * (1.0 + m_ctx[4]) + m_ctx[3]
            y = hierarchical_moe(jnp.concatenate([h2c.reshape(-1, D_MODEL), h2.reshape(-1, D_MODEL)], axis=0), *moe_args)
            xc = xc + m_ctx[5] * y[: b * l_ctx].reshape(b, l_ctx, D_MODEL)
            x = x + m_lat[5] * y[b * l_ctx:].reshape(b, n, D_MODEL)
        else:
            y = hierarchical_moe(h2.reshape(-1, D_MODEL), *moe_args)
            x = x + m_lat[5] * y.reshape(b, n, D_MODEL)
    return rmsnorm(x, final_norm_g)
```

```cpp
#include <hip/hip_runtime.h>
#include <cstdio>
#include <cstdint>

#ifndef MK_ONE_LAUNCH
#define MK_ONE_LAUNCH 1
#endif

#define DI __device__ __forceinline__
#define GAS __attribute__((address_space(1)))
#define LAS __attribute__((address_space(3)))
typedef unsigned short bf16;
typedef unsigned v4u __attribute__((ext_vector_type(4)));
typedef unsigned v2u __attribute__((ext_vector_type(2)));
typedef float f32x4 __attribute__((ext_vector_type(4)));
typedef short bf16x8 __attribute__((ext_vector_type(8)));
#define LDS_WAIT() asm volatile("s_waitcnt lgkmcnt(0)" ::: "memory")

constexpr int D = 1024, NB = 4, SEQ = 4096, LCTX = 256, NCTX = NB * LCTX, NLAT = NB * SEQ, MTOK = NCTX + NLAT;
constexpr int DIN = 3200, PP = 3328;
constexpr int CA_Q = 0, CA_I = 256, CA_FF = 512, CA_FB = 768, CA_G = 1024;
constexpr int CB_Q = 1280, CB_K = 1536, CB_V = 1792;
constexpr int CC_Q = 2048, CC_K = 2176, CC_V = 2304, CC_G = 2560, CC_ZF = 2816, CC_ZB = 2832;
constexpr int CD_Q = 2848, CD_KV = 3040, CD_R = 3168;
constexpr int NKEY = LCTX + SEQ;
constexpr int NCHUNK = NKEY / 64;
constexpr float EPS = 1e-6f;
constexpr float LOG2E = 1.4426950408889634f;
constexpr int MOE_MAXT = 168;
constexpr int MOE_CAP = 2 * 17408;

enum { I_X = 0, I_C, I_CTX, I_CCTX, I_WMOD, I_BMOD, I_N1G, I_N2G, I_WIN, I_WOUT, I_LBL, I_HNG, I_RPB, I_WGF, I_BGF, I_WGB, I_BGB, I_GNG, I_QNG, I_WUQ, I_KVNG, I_WUKV,
       I_WRG, I_BRG, I_WRE, I_BRE, I_WGU, I_WDN, I_FNG, N_IN };

constexpr size_t MiB = 1u << 20;
constexpr size_t WS_CTL = 0, CTL_BYTES = 2 * MiB;
constexpr size_t WS_WTIN = 2 * MiB;
constexpr size_t WTIN_L = (size_t)PP * D * 2;
constexpr size_t WS_WTOUT = 16 * MiB;
constexpr size_t WS_WTUQ = 20 * MiB;
constexpr size_t WS_WTUKV = WS_WTUQ + 512 * 1024;
constexpr size_t WS_MOD = 21 * MiB;
constexpr size_t WS_WR = WS_MOD + 512 * 1024;
constexpr size_t WS_WTGU = 22 * MiB;
constexpr size_t WS_WTDN = 86 * MiB;
constexpr size_t WS_X = 118 * MiB;
constexpr size_t WS_H = 186 * MiB;
constexpr size_t WS_CAT = 220 * MiB;
constexpr size_t WS_P = 254 * MiB;
constexpr size_t WS_XS = WS_P;
constexpr size_t WS_ACT = 338 * MiB;
constexpr size_t WS_QM = 366 * MiB;
constexpr size_t WS_KM = 379 * MiB;
constexpr size_t WS_VM = 392 * MiB;
constexpr size_t WS_RSH = 401 * MiB;
constexpr size_t WS_RSG = 435 * MiB;
constexpr size_t WS_RAH = 452 * MiB;
constexpr size_t WS_RAG = WS_RAH + 600 * 1024;
constexpr size_t WS_MOE = 453 * MiB;
constexpr size_t WS_VNT = 454 * MiB;
constexpr size_t WS_RIDX = 463 * MiB;
constexpr size_t WS_END = 468 * MiB;
constexpr int CW_BAR = 4096;
constexpr int CW_CNT = 16384;
constexpr int CW_GUC = 32768;
constexpr int CW_TMO = 64;

constexpr int RING_BYTES = 131072;
constexpr int MISC_OFF = RING_BYTES;
constexpr int LDS_BYTES = 147456;

DI float bf2f(unsigned v) { return __uint_as_float(v << 16); }
DI unsigned f2bf(float f) { unsigned u = __float_as_uint(f); return (u + 0x7fffu + ((u >> 16) & 1u)) >> 16; }
typedef __bf16 bf16v2 __attribute__((ext_vector_type(2)));
typedef float f32x2 __attribute__((ext_vector_type(2)));
DI unsigned pk2(float lo, float hi) { const f32x2 v = {lo, hi}; return __builtin_bit_cast(unsigned, __builtin_convertvector(v, bf16v2)); }
DI f32x4 bf4f(v2u w) { f32x4 r; r.x = __uint_as_float(w.x << 16); r.y = __uint_as_float(w.x & 0xffff0000u); r.z = __uint_as_float(w.y << 16); r.w = __uint_as_float(w.y & 0xffff0000u); return r; }
DI v2u f4bf(f32x4 v) { return (v2u){pk2(v.x, v.y), pk2(v.z, v.w)}; }
DI bf16x8 pack8(float a0, float a1, float a2, float a3, float a4, float a5, float a6, float a7) {
    v4u p; p.x = pk2(a0, a1); p.y = pk2(a2, a3); p.z = pk2(a4, a5); p.w = pk2(a6, a7);
    return __builtin_bit_cast(bf16x8, p);
}
DI float wave_sum(float v) {
#pragma unroll
    for (int o = 1; o < 64; o <<= 1) v += __shfl_xor(v, o);
    return v;
}
DI float frcp_(float x) { return __builtin_amdgcn_rcpf(x); }
DI float sigmoid_(float x) { return frcp_(1.f + __expf(-x)); }
DI float silu_(float x) { return x * frcp_(1.f + __expf(-x)); }
DI float logsigmoid_(float x) { return fminf(x, 0.f) - __logf(1.f + __expf(-fabsf(x))); }
DI void unpack8(v4u w, float* f) {
    f[0] = __uint_as_float(w.x << 16); f[1] = __uint_as_float(w.x & 0xffff0000u);
    f[2] = __uint_as_float(w.y << 16); f[3] = __uint_as_float(w.y & 0xffff0000u);
    f[4] = __uint_as_float(w.z << 16); f[5] = __uint_as_float(w.z & 0xffff0000u);
    f[6] = __uint_as_float(w.w << 16); f[7] = __uint_as_float(w.w & 0xffff0000u);
}
DI int bidx_of_row(int m) { return m < NCTX ? 4 : ((m - NCTX) >> 12); }

namespace pg8 {
#define PG8_LAS __attribute__((address_space(3)))
typedef unsigned short bf16_t;
typedef unsigned u32x4 __attribute__((ext_vector_type(4)));
constexpr int BM = 256, BK = 64, HALF = 128, HTB = HALF * BK * 2, STAGE_BYTES = 8 * HTB, NXCD = 8, WGM = 8;
__host__ __device__ __forceinline__ int lds_byte(int r, int c) { const int st = (r >> 4) * 2 + (c >> 5), rr = r & 15, cc = c & 31, ob = rr * 64 + cc * 2; return st * 1024 + (ob ^ (((ob >> 9) & 1) << 5)); }
__host__ __device__ __forceinline__ void stage_rc(int b, int& R, int& C) { const int st = b / 1024, sb = b % 1024, swz = sb ^ (((sb >> 9) & 1) << 5); R = (st >> 1) * 16 + swz / 64; C = (st & 1) * 32 + (swz % 64) / 2; }
__host__ __device__ __forceinline__ int perm32(int rho) { const int n = rho >> 4, i = rho & 15; return 8 * (i >> 2) + 4 * n + (i & 3); }
struct Unit { int pm, pn; size_t bo; };
struct LinearRows { static constexpr bool LINEAR = true; __device__ __forceinline__ int operator()(const Unit& u, int r) const { return u.pm * BM + r; } };
struct MoeRows { static constexpr bool LINEAR = false; const PG8_LAS int* idx; int pm0;
    __device__ __forceinline__ int operator()(const Unit& u, int r) const { return idx[(u.pm == pm0 ? 0 : 256) + r]; } };
struct Gemm { const GAS bf16_t* A; const GAS bf16_t* Bt; int M, N, K; };
struct StaticOrder {
    int nM, nN, nwg, G, c;
    __device__ void init(int M, int N, int G_, int c_) { nM = M / BM; nN = N / BM; nwg = nM * nN; G = G_; c = c_; }
    __device__ bool next(int i, Unit& u) const {
        const long L = (long)i * G + c; if (L >= nwg) return false;
        int wgid = (int)L; { const int q = nwg / NXCD, r = nwg % NXCD, xcd = wgid % NXCD, off = wgid / NXCD; wgid = (xcd < r ? xcd * (q + 1) : r * (q + 1) + (xcd - r) * q) + off; }
        const int nig = WGM * nN, gid = wgid / nig, fm = gid * WGM, gsz = (nM - fm) < WGM ? (nM - fm) : WGM;
        u.pm = fm + ((wgid % nig) % gsz); u.pn = (wgid % nig) / gsz; u.bo = 0; return true;
    }
    __device__ __forceinline__ void a_ready(const Unit&) const {}
    __device__ __forceinline__ void done(const Unit&) const {}
};
struct GroupedOrder {
    int nT, nN, G, c; const PG8_LAS int* tile_e; size_t estride; int pm0 = 0;
    __device__ bool next(int i, Unit& u) const {
        if (c < 0) return false;
        const long L = (long)i * G + c; if (L >= (long)nT * nN) return false;
        u.pm = pm0 + (int)(L / nN); u.pn = (int)(L % nN); u.bo = (size_t)__builtin_amdgcn_readfirstlane(tile_e[u.pm]) * estride; return true;
    }
    __device__ __forceinline__ void a_ready(const Unit&) const {}
    __device__ __forceinline__ void done(const Unit&) const {}
};
struct GroupedPublish : GroupedOrder { GAS unsigned* done_cnt;
    __device__ __forceinline__ void done(const Unit& u) const { asm volatile("s_waitcnt vmcnt(0)" ::: "memory");
        if ((threadIdx.x & 63) == 0) __hip_atomic_fetch_add(done_cnt + 64 * u.pm, 1u, __ATOMIC_RELAXED, __HIP_MEMORY_SCOPE_AGENT); } };
__device__ __forceinline__ void wait_rowtile(const GAS unsigned* ready, int pm, unsigned need) {
    if (threadIdx.x < 64) {
        unsigned spins = 0;
        while ((unsigned)__builtin_amdgcn_readfirstlane(__hip_atomic_load(ready + 64 * pm, __ATOMIC_RELAXED, __HIP_MEMORY_SCOPE_AGENT)) < need && ++spins < (1u << 22)) __builtin_amdgcn_s_sleep(2);
        __builtin_amdgcn_fence(__ATOMIC_ACQUIRE, "agent");
        asm volatile("s_waitcnt vmcnt(0)" ::: "memory");
    }
    __syncthreads();
}
__device__ __forceinline__ unsigned cvt_pk_bf16(float lo, float hi) { unsigned r; asm volatile("v_cvt_pk_bf16_f32 %0, %1, %2" : "=v"(r) : "v"(lo), "v"(hi)); return r; }

struct EpiStoreBf16 {
    static constexpr bool PERM = true;
    GAS bf16_t* O; int ldc;
    __device__ __forceinline__ void operator()(const f32x4 (&acc)[2][2][4][2], const Unit& u, int wr, int wc, int fr, int fq) const {
        const int row0 = u.pm * BM + wr * 64 + fr, col0 = u.pn * BM + wc * 32 + 8 * fq;
#pragma unroll
        for (int ai = 0; ai < 2; ++ai)
#pragma unroll
            for (int m = 0; m < 4; ++m) { GAS bf16_t* rowp = O + (size_t)(row0 + ai * HALF + m * 16) * ldc + col0;
#pragma unroll
                for (int bj = 0; bj < 2; ++bj) { const f32x4 v0 = acc[ai][bj][m][0], v1 = acc[ai][bj][m][1];
                    u32x4 w; w.x = cvt_pk_bf16(v0[0], v0[1]); w.y = cvt_pk_bf16(v0[2], v0[3]); w.z = cvt_pk_bf16(v1[0], v1[1]); w.w = cvt_pk_bf16(v1[2], v1[3]);
                    *(GAS u32x4*)(rowp + bj * HALF) = w; } }
    }
};
struct EpiResid {
    static constexpr bool PERM = false;
    GAS bf16_t* X; int row_off; const GAS float* mod;
    const GAS float* src_ctx; const GAS float* src_lat;
    __device__ __forceinline__ void operator()(const f32x4 (&acc)[2][2][4][2], const Unit& u, int wr, int wc, int fr, int fq) const {
        const int row0 = row_off + u.pm * BM + wr * 64 + fr, col0 = u.pn * BM + wc * 32 + 4 * fq;
#pragma unroll
        for (int ai = 0; ai < 2; ++ai)
#pragma unroll
            for (int m = 0; m < 4; ++m) { const int row = row0 + ai * HALF + m * 16; GAS bf16_t* rowp = X + (size_t)row * D + col0; const GAS float* gp = mod + (size_t)bidx_of_row(row) * 6144 + col0;
                const GAS float* bp = src_lat ? (row < NCTX ? src_ctx + (size_t)row * D + col0 : src_lat + (size_t)(row - NCTX) * D + col0) : (const GAS float*)nullptr;
#pragma unroll
                for (int bj = 0; bj < 2; ++bj)
#pragma unroll
                    for (int n = 0; n < 2; ++n) { const f32x4 g = *(const GAS f32x4*)(gp + bj * HALF + n * 16);
                        f32x4 x = src_lat ? *(const GAS f32x4*)(bp + bj * HALF + n * 16) : bf4f(*(const GAS v2u*)(rowp + bj * HALF + n * 16));
                        x = x + g * acc[ai][bj][m][n]; *(GAS v2u*)(rowp + bj * HALF + n * 16) = f4bf(x); } }
    }
};
struct EpiGateUp {
    static constexpr bool PERM = true;
    GAS bf16_t* O; unsigned nbytes;
    __device__ __forceinline__ void operator()(const f32x4 (&acc)[2][2][4][2], const Unit& u, int wr, int wc, int fr, int fq) const {
        const int row0 = u.pm * BM + wr * 64 + fr, col0 = u.pn * HALF + wc * 32 + 8 * fq;
        const __amdgpu_buffer_rsrc_t rsrc = __builtin_amdgcn_make_buffer_rsrc((void*)O, 0, (int)nbytes, 0x00020000);
#pragma unroll
        for (int ai = 0; ai < 2; ++ai)
#pragma unroll
            for (int m = 0; m < 4; ++m) { const unsigned off = (unsigned)((row0 + ai * HALF + m * 16) * 256 + col0) * 2u;
                float r[8];
#pragma unroll
                for (int n = 0; n < 2; ++n)
#pragma unroll
                    for (int j = 0; j < 4; ++j) { const float g = acc[ai][0][m][n][j], up = acc[ai][1][m][n][j]; r[n * 4 + j] = g * __builtin_amdgcn_rcpf(1.f + __expf(-g)) * up; }
                u32x4 w; w.x = cvt_pk_bf16(r[0], r[1]); w.y = cvt_pk_bf16(r[2], r[3]); w.z = cvt_pk_bf16(r[4], r[5]); w.w = cvt_pk_bf16(r[6], r[7]);
                __builtin_amdgcn_raw_buffer_store_b128(w, rsrc, (int)off, 0, 16); }
    }
};

template <class Epi, class Sched, class Rows = LinearRows>
__device__ __forceinline__ void gemm_phase(PG8_LAS unsigned char* lds, const Gemm g, const Sched& S, const Epi& E, const Rows RM = Rows()) {
    const int tid = threadIdx.x, wid = __builtin_amdgcn_readfirstlane(tid >> 6), lane = tid & 63, wr = wid >> 2, wc = wid & 3, fr = lane & 15, fq = lane >> 4;
    const int K = g.K, nt = K / BK;
    unsigned voffB[2]; int rA[2], cA2[2];
#pragma unroll
    for (int i = 0; i < 2; ++i) { int R, C; stage_rc(tid * 16 + i * 8192, R, C); const int Rb = Epi::PERM ? ((R & ~31) + perm32(R & 31)) : R;
        rA[i] = R; cA2[i] = C * 2; voffB[i] = (unsigned)(Rb * K + C) * 2u; }
    unsigned oAc[2][2], oAn[2][2];
#define PG8_AOFF(dst, u) do { _Pragma("unroll") for (int _h = 0; _h < 2; ++_h) _Pragma("unroll") for (int _i = 0; _i < 2; ++_i) dst[_h][_i] = (unsigned)RM(u, _h * HALF + rA[_i]) * (unsigned)(K * 2) + (unsigned)cA2[_i]; } while (0)
#define PG8_STAGE_A(bufoff, o2, kbyte) do { _Pragma("unroll") for (int _i = 0; _i < 2; ++_i) \
        __builtin_amdgcn_global_load_lds((const unsigned*)((const char*)g.A + (size_t)(kbyte) + (o2)[_i]), (PG8_LAS unsigned*)(lds + (bufoff) + ldsw + _i * 8192), 16, 0, 0); } while (0)
    const size_t kstep = (size_t)(BK * 2);
    const size_t hstep = (size_t)HALF * K * 2;
    const size_t tstep = 2 * hstep;
    const unsigned ldsw = (unsigned)wid * 1024u;
    const int aoff = lds_byte(wr * 64 + fr, fq * 8), boff = lds_byte(wc * 32 + fr, fq * 8);
#define PG8_SA(b, h) (((b) * 2 + (h)) * HTB)
#define PG8_SB(b, h) ((4 + (b) * 2 + (h)) * HTB)
#define PG8_STAGE(bufoff, gbase, voff) do { _Pragma("unroll") for (int _i = 0; _i < 2; ++_i) \
        __builtin_amdgcn_global_load_lds((const unsigned*)((const char*)(gbase) + (voff)[_i]), (PG8_LAS unsigned*)(lds + (bufoff) + ldsw + _i * 8192), 16, 0, 0); } while (0)
#define PG8_LDA(dst, b, h) do { _Pragma("unroll") for (int m = 0; m < 4; ++m) _Pragma("unroll") for (int k = 0; k < 2; ++k) dst[m][k] = *(const PG8_LAS bf16x8*)(lds + PG8_SA(b, h) + aoff + m * 2048 + k * 1024); } while (0)
#define PG8_LDB(dst, b, h) do { _Pragma("unroll") for (int n = 0; n < 2; ++n) _Pragma("unroll") for (int k = 0; k < 2; ++k) dst[n][k] = *(const PG8_LAS bf16x8*)(lds + PG8_SB(b, h) + boff + n * 2048 + k * 1024); } while (0)
#define PG8_MMA(ai, bj, At, Bt) do { __builtin_amdgcn_s_setprio(1); _Pragma("unroll") for (int m = 0; m < 4; ++m) _Pragma("unroll") for (int n = 0; n < 2; ++n) _Pragma("unroll") for (int k = 0; k < 2; ++k) \
        acc[ai][bj][m][n] = __builtin_amdgcn_mfma_f32_16x16x32_bf16(Bt[n][k], At[m][k], acc[ai][bj][m][n], 0, 0, 0); __builtin_amdgcn_s_setprio(0); } while (0)
#define PG8_WAIT_V(n) asm volatile("s_waitcnt vmcnt(" #n ")" ::: "memory")
#define PG8_WAIT_L(n) asm volatile("s_waitcnt lgkmcnt(" #n ")" ::: "memory")
#define PG8_BAR __builtin_amdgcn_s_barrier()
#define PG8_SCHED __builtin_amdgcn_sched_barrier(0)
    Unit cur, nxt; int ui = 0;
    if (!S.next(0, cur)) return;
    f32x4 acc[2][2][4][2];
#pragma unroll
    for (int a = 0; a < 2; ++a)
#pragma unroll
        for (int b = 0; b < 2; ++b)
#pragma unroll
            for (int m = 0; m < 4; ++m)
#pragma unroll
                for (int n = 0; n < 2; ++n) acc[a][b][m][n] = (f32x4){0.f, 0.f, 0.f, 0.f};
    bf16x8 At[4][2], B0[2][2], B1[2][2];
    const char* cB = (const char*)g.Bt + cur.bo + (size_t)cur.pn * tstep;
    S.a_ready(cur);
    PG8_AOFF(oAc, cur);
    PG8_STAGE(PG8_SB(0, 0), cB, voffB); PG8_STAGE_A(PG8_SA(0, 0), oAc[0], 0); PG8_STAGE(PG8_SB(0, 1), cB + hstep, voffB); PG8_STAGE_A(PG8_SA(0, 1), oAc[1], 0);
    if (wr == 1) PG8_BAR;
    PG8_WAIT_V(4); PG8_BAR;
    PG8_STAGE(PG8_SB(1, 0), cB + kstep, voffB); PG8_STAGE_A(PG8_SA(1, 0), oAc[0], kstep); PG8_STAGE(PG8_SB(1, 1), cB + hstep + kstep, voffB);
    PG8_WAIT_V(6); PG8_BAR;
    for (;;) {
        const bool has_next = S.next(ui + 1, nxt);
        const char* nB = has_next ? (const char*)g.Bt + nxt.bo + (size_t)nxt.pn * tstep : cB;
        unsigned dAn = 0u;
        if constexpr (Rows::LINEAR) { if (has_next) dAn = (unsigned)(nxt.pm - cur.pm) * (unsigned)(BM * K * 2); }
        else { if (has_next) PG8_AOFF(oAn, nxt);
            else {
#pragma unroll
                for (int _h = 0; _h < 2; ++_h)
#pragma unroll
                    for (int _i = 0; _i < 2; ++_i) oAn[_h][_i] = oAc[_h][_i]; } }
        for (int t = 0; t < nt; t += 2) {
            const bool last = (t == nt - 2);
            const size_t k1 = (size_t)(t + 1) * kstep, k2 = last ? 0 : (size_t)(t + 2) * kstep, k3 = k2 + kstep;
            unsigned o20[2], o21[2];
#pragma unroll
            for (int _i = 0; _i < 2; ++_i) { if constexpr (Rows::LINEAR) { o20[_i] = oAc[0][_i] + (last ? dAn : 0u); o21[_i] = oAc[1][_i] + (last ? dAn : 0u); }
                else { o20[_i] = last ? oAn[0][_i] : oAc[0][_i]; o21[_i] = last ? oAn[1][_i] : oAc[1][_i]; } }
            const char* b2 = last ? nB : cB + (size_t)(t + 2) * kstep;
            const char* b3 = b2 + kstep;
            if (last && has_next) S.a_ready(nxt);
            PG8_LDB(B0, 0, 0); PG8_SCHED; PG8_LDA(At, 0, 0); PG8_STAGE_A(PG8_SA(1, 1), oAc[1], k1);
            PG8_WAIT_L(8); PG8_BAR; PG8_WAIT_L(0); PG8_MMA(0, 0, At, B0); PG8_BAR; PG8_SCHED;
            PG8_LDB(B1, 0, 1); PG8_STAGE(PG8_SB(0, 0), b2, voffB);
            PG8_BAR; PG8_WAIT_L(0); PG8_MMA(0, 1, At, B1); PG8_BAR;
            PG8_LDA(At, 0, 1); PG8_STAGE_A(PG8_SA(0, 0), o20, k2);
            PG8_BAR; PG8_WAIT_L(0); PG8_MMA(1, 0, At, B0); PG8_BAR; PG8_SCHED;
            PG8_STAGE(PG8_SB(0, 1), b2 + hstep, voffB);
            PG8_WAIT_V(6); PG8_BAR; PG8_MMA(1, 1, At, B1); PG8_BAR;
            PG8_LDB(B0, 1, 0); PG8_SCHED; PG8_LDA(At, 1, 0); PG8_STAGE_A(PG8_SA(0, 1), o21, k2);
            PG8_WAIT_L(8); PG8_BAR; PG8_WAIT_L(0); PG8_MMA(0, 0, At, B0); PG8_BAR; PG8_SCHED;
            PG8_LDB(B1, 1, 1); PG8_STAGE(PG8_SB(1, 0), b3, voffB);
            PG8_BAR; PG8_WAIT_L(0); PG8_MMA(0, 1, At, B1); PG8_BAR;
            PG8_LDA(At, 1, 1); PG8_STAGE_A(PG8_SA(1, 0), o20, k3);
            PG8_BAR; PG8_WAIT_L(0); PG8_MMA(1, 0, At, B0); PG8_BAR; PG8_SCHED;
            PG8_STAGE(PG8_SB(1, 1), b3 + hstep, voffB);
            PG8_WAIT_V(6); PG8_BAR; PG8_MMA(1, 1, At, B1); PG8_BAR;
        }
        E(acc, cur, wr, wc, fr, fq); S.done(cur);
        if (!has_next) break;
#pragma unroll
        for (int a = 0; a < 2; ++a)
#pragma unroll
            for (int b = 0; b < 2; ++b)
#pragma unroll
                for (int m = 0; m < 4; ++m)
#pragma unroll
                    for (int n = 0; n < 2; ++n) acc[a][b][m][n] = (f32x4){0.f, 0.f, 0.f, 0.f};
        cur = nxt; cB = nB; ++ui;
#pragma unroll
        for (int _h = 0; _h < 2; ++_h)
#pragma unroll
            for (int _i = 0; _i < 2; ++_i) { if constexpr (Rows::LINEAR) oAc[_h][_i] += dAn; else oAc[_h][_i] = oAn[_h][_i]; }
    }
    PG8_WAIT_V(0);
    if (wr == 0) PG8_BAR;
    PG8_BAR;
#undef PG8_SA
#undef PG8_SB
#undef PG8_STAGE
#undef PG8_STAGE_A
#undef PG8_AOFF
#undef PG8_LDA
#undef PG8_LDB
#undef PG8_MMA
#undef PG8_WAIT_V
#undef PG8_WAIT_L
#undef PG8_BAR
#undef PG8_SCHED
}
}

#define XB_TMO      128
#define XB_XCNT(j)  (256  + 64 * (j))
#define XB_XSUB(j)  (1280 + 64 * (j))
#define XB_XGEN(j)  (2304 + 64 * (j))
#define XB_TOP      3328
#define XB_TOPGEN   3392
#define XCD_BAR_WORDS 3456
#define XB_SPIN_CAP (1u << 18)
__device__ __forceinline__ unsigned xb_ld(unsigned* p)              { return __hip_atomic_load(p, __ATOMIC_RELAXED, __HIP_MEMORY_SCOPE_AGENT); }
__device__ __forceinline__ unsigned xb_add(unsigned* p, unsigned v) { return __hip_atomic_fetch_add(p, v, __ATOMIC_RELAXED, __HIP_MEMORY_SCOPE_AGENT); }
__device__ __forceinline__ unsigned xb_xcc_id() { return (unsigned)__builtin_amdgcn_s_getreg((3 << 11) | 20) & 0xFu; }
#define XB_SPIN(cond, bar) do { unsigned _sp = 0; while (cond) { __builtin_amdgcn_s_sleep(1); \
    if ((++_sp & 255u) == 0u) { if (xb_ld(&(bar)[XB_TMO])) break; if (_sp > XB_SPIN_CAP) { atomicAdd(&(bar)[XB_TMO], 1u); break; } } } } while (0)
struct XcdBarrier { unsigned* bar; unsigned x; volatile LAS unsigned* st; };
__device__ __forceinline__ XcdBarrier xcd_barrier_post(unsigned* bar, volatile LAS unsigned* st) {
    XcdBarrier b; b.bar = bar; b.x = xb_xcc_id(); b.st = st;
    if (threadIdx.x == 0) (void)xb_add(&bar[XB_XCNT(b.x)], 1u);
    return b;
}
__device__ __forceinline__ void xcd_barrier_complete(unsigned* bar, unsigned x, unsigned& nloc, unsigned& nx) {
    const unsigned G = gridDim.x * gridDim.y * gridDim.z;
    unsigned sum, cnt, mine, sp = 0u;
    for (;;) {
        sum = 0u; cnt = 0u; mine = 0u;
#pragma unroll
        for (unsigned j = 0; j < 16; ++j) { const unsigned c = xb_ld(&bar[XB_XCNT(j)]); sum += c; cnt += (c > 0u) ? 1u : 0u; mine = (j == x) ? c : mine; }
        if (sum == G) break;
        __builtin_amdgcn_s_sleep(1);
        if ((++sp & 255u) == 0u) { if (xb_ld(&bar[XB_TMO])) break; if (sp > XB_SPIN_CAP) { atomicAdd(&bar[XB_TMO], 1u); break; } }
    }
    nloc = mine > 0u ? mine : 1u; nx = cnt > 0u ? cnt : 1u;
}
__device__ __forceinline__ void xcd_barrier(const XcdBarrier& b) {
    asm volatile("s_waitcnt vmcnt(0)" ::: "memory");
    __syncthreads();
    if (threadIdx.x == 0) {
        unsigned* bar = b.bar;
        __builtin_amdgcn_s_waitcnt(0);
        unsigned nloc = b.st[0], nx = b.st[1];
        if (nloc == 0u) { xcd_barrier_complete(bar, b.x, nloc, nx); b.st[0] = nloc; b.st[1] = nx; }
        const unsigned old = xb_add(&bar[XB_XSUB(b.x)], 1u);
        const unsigned gen = old / nloc;
        if (old + 1u == (gen + 1u) * nloc) {
            __builtin_amdgcn_fence(__ATOMIC_RELEASE, "agent");
            asm volatile("s_waitcnt vmcnt(0)" ::: "memory");
            const unsigned og = xb_add(&bar[XB_TOP], 1u);
            const unsigned tg = og / nx;
            if (og + 1u == (tg + 1u) * nx) xb_add(&bar[XB_TOPGEN], 1u);
            else XB_SPIN(xb_ld(&bar[XB_TOPGEN]) == tg, bar);
            __builtin_amdgcn_fence(__ATOMIC_ACQUIRE, "agent");
            xb_add(&bar[XB_XGEN(b.x)], 1u);
            asm volatile("s_waitcnt vmcnt(0)" ::: "memory");
        } else {
            XB_SPIN(xb_ld(&bar[XB_XGEN(b.x)]) == gen, bar);
            __builtin_amdgcn_fence(__ATOMIC_ACQUIRE, "agent");
            asm volatile("s_waitcnt vmcnt(0)" ::: "memory");
        }
    }
    __syncthreads();
}

struct Args { const float* in[N_IN]; float* out; unsigned char* ws; int ph_lo, ph_hi; int pad0, pad1; };
extern __shared__ __attribute__((aligned(16))) unsigned char lds_raw[];
constexpr int PTR_OFF = MISC_OFF + 2048;
struct Ctx {
    DI unsigned long long raw(int i) const { volatile LAS unsigned* t = (volatile LAS unsigned*)((LAS unsigned char*)lds_raw + PTR_OFF) + 2 * i;
        const unsigned lo = __builtin_amdgcn_readfirstlane(t[0]), hi = __builtin_amdgcn_readfirstlane(t[1]); return ((unsigned long long)hi << 32) | lo; }
    DI const GAS float* in(int i) const { return (const GAS float*)raw(i); }
    DI GAS float* out() const { return (GAS float*)raw(N_IN); }
    DI GAS unsigned char* ws() const { return (GAS unsigned char*)raw(N_IN + 1); }
};

DI void transpose_item(const GAS float* W, int N, int k0, int n0, GAS bf16* WT, int Kd, int drow0, LAS float* scr, int lane) {
    float wv[32];
#pragma unroll
    for (int i = 0; i < 32; ++i) wv[i] = W[(size_t)(k0 + 2 * i + (lane >> 5)) * N + n0 + (lane & 31)];
#pragma unroll
    for (int i = 0; i < 32; ++i) scr[(2 * i + (lane >> 5)) * 33 + (lane & 31)] = wv[i];
    LDS_WAIT(); asm volatile("" ::: "memory");
    const int c = lane & 7;
#pragma unroll
    for (int j = 0; j < 4; ++j) { const int n = (lane >> 3) + 8 * j; const LAS float* s = scr + (8 * c) * 33 + n;
        v4u o; o.x = pk2(s[0 * 33], s[1 * 33]); o.y = pk2(s[2 * 33], s[3 * 33]); o.z = pk2(s[4 * 33], s[5 * 33]); o.w = pk2(s[6 * 33], s[7 * 33]);
        *(GAS v4u*)(WT + (size_t)(drow0 + n) * Kd + k0 + 8 * c) = o; }
    LDS_WAIT(); asm volatile("" ::: "memory");
}

DI void weight_copies(const Ctx& a, int l, LAS unsigned char* lds, int tid, int lane, int wave, int gwv, int ngw, int gt, int ngt) {
    GAS unsigned char* ws = a.ws();
    for (int i = gt; i < 128 * 1024 / 8; i += ngt) *(GAS v4u*)(ws + WS_WTIN + (size_t)l * WTIN_L + (size_t)3200 * D * 2 + (size_t)i * 16) = (v4u){0u, 0u, 0u, 0u};
    LAS float* scr = (LAS float*)(lds + wave * 16384);
    constexpr int IT_IN = 16 * 100, IT_OUT = 16 * 32, IT_UQ = 3 * 12, IT_UKV = 2 * 16, IT_GU = 32 * 16 * 16, IT_DN = 32 * 4 * 32;
    constexpr int NITEMS = IT_IN + IT_OUT + IT_UQ + IT_UKV + IT_GU + IT_DN;
    for (int it = gwv; it < NITEMS; it += ngw) {
        int r = it;
        if (r < IT_IN) { const int kb = r / 100, nb = r % 100;
            transpose_item(a.in(I_WIN) + (size_t)l * D * DIN, DIN, kb * 64, nb * 32, (GAS bf16*)(ws + WS_WTIN + (size_t)l * WTIN_L), D, nb * 32, scr, lane); continue; } r -= IT_IN;
        if (r < IT_OUT) { const int kb = r / 32, nb = r % 32;
            transpose_item(a.in(I_WOUT) + (size_t)l * D * D, D, kb * 64, nb * 32, (GAS bf16*)(ws + WS_WTOUT + (size_t)l * D * D * 2), D, nb * 32, scr, lane); continue; } r -= IT_OUT;
        if (r < IT_UQ) { const int kb = r / 12, nb = r % 12;
            transpose_item(a.in(I_WUQ) + (size_t)l * 192 * 384, 384, kb * 64, nb * 32, (GAS bf16*)(ws + WS_WTUQ + (size_t)l * 384 * 192 * 2), 192, nb * 32, scr, lane); continue; } r -= IT_UQ;
        if (r < IT_UKV) { const int kb = r / 16, nb = r % 16;
            transpose_item(a.in(I_WUKV) + (size_t)l * 128 * 512, 512, kb * 64, nb * 32, (GAS bf16*)(ws + WS_WTUKV + (size_t)l * 512 * 128 * 2), 128, nb * 32, scr, lane); continue; } r -= IT_UKV;
        if (r < IT_GU) { const int le = l * 32 + r / 256, q = r % 256, kb = q / 16, nb = q % 16; const int n0 = nb * 32, c0 = n0 & 255, isup = n0 >> 8;
            const int drow0 = (c0 >> 7) * 256 + isup * 128 + (c0 & 127);
            transpose_item(a.in(I_WGU) + (size_t)le * D * 512, 512, kb * 64, n0, (GAS bf16*)(ws + WS_WTGU + (size_t)le * 512 * D * 2), D, drow0, scr, lane); continue; } r -= IT_GU;
        { const int le = l * 32 + r / 128, q = r % 128, kb = q / 32, nb = q % 32;
            transpose_item(a.in(I_WDN) + (size_t)le * 256 * D, D, kb * 64, nb * 32, (GAS bf16*)(ws + WS_WTDN + (size_t)le * D * 256 * 2), 256, nb * 32, scr, lane); }
    }
}

DI void phase_prologue(const Ctx& a, LAS unsigned char* lds, int tid, int lane, int wave, int bid, int G) {
    GAS unsigned char* ws = a.ws();
    GAS float* MOD = (GAS float*)(ws + WS_MOD);
    {
        LAS float* S = (LAS float*)lds;
        LAS float* R = (LAS float*)(lds + 5 * 1024 * 4);
        if (bid < 192) {
            const GAS float* cvec = a.in(I_C); const GAS float* cctx = a.in(I_CCTX);
            for (int i = tid; i < 5 * 1024; i += 512) { const int r = i >> 10, k = i & 1023; const float v = r < 4 ? cvec[r * 1024 + k] : cctx[k]; S[i] = silu_(v); }
        }
        __syncthreads();
        for (int u = bid; u < 192; u += G) {
            const int l = u / 96, cl = tid & 63, n = (u % 96) * 64 + cl, ks = tid >> 6;
            const GAS float* W = a.in(I_WMOD) + (size_t)l * 1024 * 6144 + n; const GAS float* bmod = a.in(I_BMOD);
            float acc[5] = {0.f, 0.f, 0.f, 0.f, 0.f};
            for (int k = ks * 128; k < ks * 128 + 128; ++k) { const float w = W[(size_t)k * 6144];
#pragma unroll
                for (int r = 0; r < 5; ++r) acc[r] += S[r * 1024 + k] * w; }
#pragma unroll
            for (int r = 0; r < 5; ++r) R[(ks * 5 + r) * 64 + cl] = acc[r];
            __syncthreads();
            if (tid < 320) { const int r = tid >> 6; float s = 0.f;
#pragma unroll
                for (int k2 = 0; k2 < 8; ++k2) s += R[(k2 * 5 + r) * 64 + cl];
                MOD[(size_t)(l * 5 + r) * 6144 + n] = s + bmod[l * 6144 + n]; }
            __syncthreads();
        }
    }
    for (int i = bid * 512 + tid; i < 2 * 48 * 1024; i += G * 512) { const int l = i / (48 * 1024), r = i % (48 * 1024), c = r >> 10, k = r & 1023;
        const float w = c < 4 ? a.in(I_WRG)[(size_t)l * D * 4 + k * 4 + c] : (c < 36 ? a.in(I_WRE)[(size_t)l * D * 32 + k * 32 + (c - 4)] : 0.f);
        const unsigned hi = f2bf(w); const float lo = w - bf2f(hi);
        GAS bf16* WR = (GAS bf16*)(ws + WS_WR) + (size_t)l * 2 * 48 * 1024;
        WR[c * 1024 + k] = (bf16)hi; WR[48 * 1024 + c * 1024 + k] = (bf16)f2bf(lo); }
    weight_copies(a, 0, lds, tid, lane, wave, bid * 8 + wave, G * 8, bid * 512 + tid, G * 512);
}

DI void norm_row_store(const f32x4 (&v)[4], const GAS float* g, const GAS float* shift, const GAS float* scale, GAS bf16* hrow, int lane) {
    float ss = 0.f;
#pragma unroll
    for (int j = 0; j < 4; ++j) ss += (v[j].x * v[j].x + v[j].y * v[j].y) + (v[j].z * v[j].z + v[j].w * v[j].w);
    const float rstd = rsqrtf(wave_sum(ss) * (1.f / D) + EPS);
#pragma unroll
    for (int j = 0; j < 4; ++j) { const int c = 4 * lane + 256 * j;
        const f32x4 gg = *(const GAS f32x4*)(g + c), sh = *(const GAS f32x4*)(shift + c), sc = *(const GAS f32x4*)(scale + c);
        const f32x4 y = v[j] * rstd * gg * (1.f + sc) + sh;
        v2u o; o.x = pk2(y.x, y.y); o.y = pk2(y.z, y.w); *(GAS v2u*)(hrow + c) = o; }
}

DI void phase_norm1_l0(const Ctx& a, int lane, int gw, int NGW) {
    GAS unsigned char* ws = a.ws(); GAS bf16* H = (GAS bf16*)(ws + WS_H); const GAS float* MOD = (const GAS float*)(ws + WS_MOD);
    const GAS float* xin = a.in(I_X); const GAS float* cin = a.in(I_CTX); const GAS float* n1g = a.in(I_N1G);
    for (int m = gw; m < MTOK; m += NGW) {
        const GAS float* src = m < NCTX ? cin + (size_t)m * D : xin + (size_t)(m - NCTX) * D;
        f32x4 v[4];
#pragma unroll
        for (int j = 0; j < 4; ++j) v[j] = *(const GAS f32x4*)(src + 4 * lane + 256 * j);
        const GAS float* mb = MOD + (size_t)bidx_of_row(m) * 6144;
        norm_row_store(v, n1g, mb, mb + 1024, H + (size_t)m * D, lane);
    }
}

DI bf16x8 ld8(const LAS bf16* p) { return *(const LAS bf16x8*)p; }
DI bf16x8 ld8(const GAS bf16* p) { return *(const GAS bf16x8*)p; }
template <class PA, class PB>
DI f32x4 mma16(PA A, int lda, PB B, int ldb, int K, int lane) {
    f32x4 acc = {0.f, 0.f, 0.f, 0.f};
    const int r = lane & 15, q = (lane >> 4) * 8;
    for (int k = 0; k < K; k += 32) {
        const bf16x8 av = ld8(A + r * lda + k + q);
        const bf16x8 bv = ld8(B + r * ldb + k + q);
        acc = __builtin_amdgcn_mfma_f32_16x16x32_bf16(av, bv, acc, 0, 0, 0);
    }
    return acc;
}

constexpr int CQ_P = 200, CKV_P = 136, STG_P = 520;
constexpr int PL_CQ = 0, PL_CKV = 12800, PL_STG = 21504, PL_RK = 54784, PL_T = 56832;
DI float rope_ang(int t, int ri) { const int ax = ri >> 4, f = ri & 7; const float p = (float)(ax == 0 ? (t >> 6) : (t & 63)); return p * __builtin_amdgcn_exp2f(-1.6609640474436813f * (float)f) * 0.15915494309189535f; }
DI void prep_unit(const Ctx& a, int l, int unit, LAS unsigned char* lds, int tid, int lane, int wave) {
    GAS unsigned char* ws = a.ws();
    const GAS bf16* P = (const GAS bf16*)(ws + WS_P);
    LAS bf16* CQ = (LAS bf16*)(lds + PL_CQ); LAS bf16* CKV = (LAS bf16*)(lds + PL_CKV); LAS bf16* STG = (LAS bf16*)(lds + PL_STG); LAS bf16* RK = (LAS bf16*)(lds + PL_RK); LAS bf16* T = (LAS bf16*)(lds + PL_T);
    const int m0 = unit * 32;
    const bool isctx = m0 < NCTX;
    const int bb = isctx ? (m0 >> 8) : ((m0 - NCTX) >> 12);
    const int pos0 = isctx ? (m0 & 255) : (256 + ((m0 - NCTX) & 4095));
    const int t0 = isctx ? 0 : ((m0 - NCTX) & 4095);
    { const GAS float* gq = a.in(I_QNG) + l * 192; const GAS float* gkv = a.in(I_KVNG) + l * 128;
        const bool isq = lane < 24, iskv = lane >= 24 && lane < 40; const int pc = isq ? lane : lane - 24;
        float gn[8];
#pragma unroll
        for (int e = 0; e < 8; ++e) gn[e] = isq ? gq[pc * 8 + e] : (iskv ? gkv[pc * 8 + e] : 0.f);
#pragma unroll
        for (int rr = 0; rr < 4; ++rr) { const int r = wave * 4 + rr; float x[8];
            v4u w = (v4u){0u, 0u, 0u, 0u}; if (lane < 40) w = *(const GAS v4u*)(P + (size_t)(m0 + r) * PP + (isq ? CD_Q : CD_KV) + pc * 8);
            unpack8(w, x); float ss = 0.f;
#pragma unroll
            for (int e = 0; e < 8; ++e) ss += x[e] * x[e];
            const float sq = wave_sum(isq ? ss : 0.f), skv = wave_sum(iskv ? ss : 0.f);
            const float rs = isq ? rsqrtf(sq * (1.f / 192.f) + EPS) : rsqrtf(skv * (1.f / 128.f) + EPS);
#pragma unroll
            for (int e = 0; e < 8; ++e) x[e] *= rs * gn[e];
            const v4u o = (v4u){pk2(x[0], x[1]), pk2(x[2], x[3]), pk2(x[4], x[5]), pk2(x[6], x[7])};
            if (isq) *(LAS v4u*)(CQ + r * CQ_P + pc * 8) = o; else if (iskv) *(LAS v4u*)(CKV + r * CKV_P + pc * 8) = o; } }
    for (int e = tid; e < 32 * 32; e += 512) { const int r = e >> 5, ri = e & 31; const GAS bf16* prow = P + (size_t)(m0 + r) * PP + CD_R;
        float v = bf2f(prow[ri]);
        if (!isctx) { const float pv = bf2f(prow[ri ^ 8]); const float ang = rope_ang(t0 + r, ri); const float cs = __builtin_amdgcn_cosf(ang), sn = __builtin_amdgcn_sinf(ang);
            v = ((ri >> 3) & 1) == 0 ? (v * cs - pv * sn) : (pv * sn + v * cs); }
        RK[r * 32 + ri] = (bf16)f2bf(v); }
    for (int e = tid; e < 32 * 32; e += 512) { const int r = e >> 5, c8 = e & 31; *(LAS v4u*)(T + r * 264 + c8 * 8) = *(const GAS v4u*)(P + (size_t)(m0 + r) * PP + CB_V + c8 * 8); }
    __syncthreads();
    GAS bf16* QM = (GAS bf16*)(ws + WS_QM); GAS bf16* KM = (GAS bf16*)(ws + WS_KM); GAS bf16* VM = (GAS bf16*)(ws + WS_VM); GAS bf16* VNT = (GAS bf16*)(ws + WS_VNT);
    const GAS bf16* WTQ = (const GAS bf16*)(ws + WS_WTUQ + (size_t)l * 384 * 192 * 2);
    const GAS bf16* WTKV = (const GAS bf16*)(ws + WS_WTUKV + (size_t)l * 512 * 128 * 2);
    const float qs = 0.10206207261596575f * LOG2E;
    const int fr = lane & 15, fq = lane >> 4;
    for (int e = tid; e < 256 * 4; e += 512) { const int col = e >> 2, p8 = e & 3; unsigned hv[8];
#pragma unroll
        for (int j = 0; j < 8; ++j) hv[j] = T[(p8 * 8 + j) * 264 + col];
        *(GAS v4u*)(VNT + ((size_t)(bb * 4) * 64 + col) * NKEY + pos0 + p8 * 8) = (v4u){hv[0] | (hv[1] << 16), hv[2] | (hv[3] << 16), hv[4] | (hv[5] << 16), hv[6] | (hv[7] << 16)}; }
    { bf16x8 bfr[3][6];
#pragma unroll
      for (int i = 0; i < 3; ++i)
#pragma unroll
        for (int ks = 0; ks < 6; ++ks) bfr[i][ks] = *(const GAS bf16x8*)(WTQ + (size_t)((wave + 8 * i) * 16 + fr) * 192 + ks * 32 + fq * 8);
#pragma unroll
      for (int i = 0; i < 3; ++i) { const int nb = wave + 8 * i;
        const int c = nb * 16 + fr, within = c % 96;
#pragma unroll
        for (int mb = 0; mb < 2; ++mb) { f32x4 acc = {0.f, 0.f, 0.f, 0.f};
#pragma unroll
            for (int ks = 0; ks < 6; ++ks) acc = __builtin_amdgcn_mfma_f32_16x16x32_bf16(*(const LAS bf16x8*)(CQ + (mb * 16 + fr) * CQ_P + ks * 32 + fq * 8), bfr[i][ks], acc, 0, 0, 0);
#pragma unroll
            for (int j = 0; j < 4; ++j) { const int r = mb * 16 + 4 * fq + j; float v = acc[j]; const float pv = __shfl_xor(v, 8);
                if (within >= 64 && !isctx) { const int ri = within - 64; const float ang = rope_ang(t0 + r, ri); const float cs = __builtin_amdgcn_cosf(ang), sn = __builtin_amdgcn_sinf(ang);
                    v = ((ri >> 3) & 1) == 0 ? (v * cs - pv * sn) : (pv * sn + v * cs); }
                STG[r * STG_P + c] = (bf16)f2bf(v * qs); } } } }
    __syncthreads();
    for (int e = tid; e < 32 * 48; e += 512) { const int r = e / 48, hp = e % 48, hd = hp / 12, pc = hp % 12;
        *(GAS v4u*)(QM + ((size_t)(bb * 4 + hd) * NKEY + pos0 + r) * 96 + pc * 8) = *(const LAS v4u*)(STG + r * STG_P + hd * 96 + pc * 8); }
    __syncthreads();
    { bf16x8 bfr[4][4];
#pragma unroll
      for (int i = 0; i < 4; ++i)
#pragma unroll
        for (int ks = 0; ks < 4; ++ks) bfr[i][ks] = *(const GAS bf16x8*)(WTKV + (size_t)((wave + 8 * i) * 16 + fr) * 128 + ks * 32 + fq * 8);
#pragma unroll
      for (int i = 0; i < 4; ++i) { const int nb = wave + 8 * i;
#pragma unroll
        for (int mb = 0; mb < 2; ++mb) { f32x4 acc = {0.f, 0.f, 0.f, 0.f};
#pragma unroll
            for (int ks = 0; ks < 4; ++ks) acc = __builtin_amdgcn_mfma_f32_16x16x32_bf16(*(const LAS bf16x8*)(CKV + (mb * 16 + fr) * CKV_P + ks * 32 + fq * 8), bfr[i][ks], acc, 0, 0, 0);
#pragma unroll
            for (int j = 0; j < 4; ++j) STG[(mb * 16 + 4 * fq + j) * STG_P + nb * 16 + fr] = (bf16)f2bf(acc[j]); } } }
    __syncthreads();
    for (int e = tid; e < 32 * 48; e += 512) { const int r = e / 48, hp = e % 48, hd = hp / 12, pc = hp % 12;
        const v4u v = pc < 8 ? *(const LAS v4u*)(STG + r * STG_P + hd * 128 + pc * 8) : *(const LAS v4u*)(RK + r * 32 + (pc - 8) * 8);
        *(GAS v4u*)(KM + ((size_t)(bb * 4 + hd) * NKEY + pos0 + r) * 96 + pc * 8) = v; }
    for (int e = tid; e < 256 * 4; e += 512) { const int col = e >> 2, p8 = e & 3, hd = col >> 6, dv = col & 63; unsigned hv[8];
#pragma unroll
        for (int j = 0; j < 8; ++j) hv[j] = STG[(p8 * 8 + j) * STG_P + hd * 128 + 64 + dv];
        *(GAS v4u*)(VM + ((size_t)(bb * 4 + hd) * 64 + dv) * NKEY + pos0 + p8 * 8) = (v4u){hv[0] | (hv[1] << 16), hv[2] | (hv[3] << 16), hv[4] | (hv[5] << 16), hv[6] | (hv[7] << 16)}; }
    __syncthreads();
}

constexpr int RP = 65;
DI int scan_row(int b, int dir, int c, int i) {
    const int s = 64 * c + i;
    if (dir == 0) return s < 256 ? b * 256 + s : NCTX + b * SEQ + (s - 256);
    return s < 256 ? b * 256 + 255 - s : NCTX + b * SEQ + SEQ - 1 - (s - 256);
}
#ifndef BAR_LDS
#define BAR_LDS() asm volatile("s_waitcnt lgkmcnt(0)\n\ts_barrier" ::: "memory")
#endif
constexpr int RC_P = 68;
constexpr int L_C = 0, L_QD = 17408, L_QE = 26624, L_KD = 35840, L_VT = 58880, L_ST = 68096, L_ATT = 77312, L_O = 86528, L_T = 103168;
template <int MIX> struct RecCfg { static constexpr int DK = MIX == 0 ? 64 : 32, DKP = DK + 8, NP = DK / 8, CPT = DK / 8; };
template <int MIX> struct RecPre {
    v4u fk;
    v4u zg[MIX == 1 ? 2 : 1];
    v4u qp;
    v4u vp; f32x4 s0, s1;
};
template <int MIX, bool R3>
DI void rec_fetch(RecPre<MIX>& R, const GAS bf16* P, const GAS float* RSbase, int b, int h, int dir, int c, int tid) {
    constexpr int DK = RecCfg<MIX>::DK;
    const int lane = tid & 63, wave = tid >> 6;
    const GAS bf16* prow = P + (size_t)scan_row(b, dir, c, lane) * PP;
    if (MIX == 0) { R.fk = *(const GAS v4u*)(prow + (dir ? CA_FB : CA_FF) + h * 64 + 8 * wave); if (R3) R.qp = *(const GAS v4u*)(prow + CA_Q + h * 64 + 8 * wave); }
    else { const GAS bf16* zr = prow + (dir ? CC_ZB : CC_ZF); R.zg[0] = *(const GAS v4u*)zr; R.zg[1] = *(const GAS v4u*)(zr + 8);
        const v2u kk = *(const GAS v2u*)(prow + CC_K + h * 32 + 4 * wave); R.fk = (v4u){kk.x, kk.y, 0u, 0u};
        if (R3) { const v2u qq = *(const GAS v2u*)(prow + CC_Q + h * 32 + 4 * wave); R.qp = (v4u){qq.x, qq.y, 0u, 0u}; } }
    R.vp = *(const GAS v4u*)(P + (size_t)scan_row(b, dir, c, tid >> 3) * PP + (MIX == 0 ? CA_I : CC_V) + h * 64 + (tid & 7) * 8);
    if (R3 && tid < DK * 8) { const GAS float* rs = RSbase + (size_t)(((b * 4 + h) * 2 + dir) * NCHUNK + c) * DK * 64 + (tid >> 3) * 64 + (tid & 7) * 8; R.s0 = *(const GAS f32x4*)rs; R.s1 = *(const GAS f32x4*)(rs + 4); }
}
DI float dpp_shr_(float v, int ctrl_sel) { const int iv = __builtin_bit_cast(int, v); int r;
    switch (ctrl_sel) { case 1: r = __builtin_amdgcn_update_dpp(0, iv, 0x111, 0xf, 0xf, true); break; case 2: r = __builtin_amdgcn_update_dpp(0, iv, 0x112, 0xf, 0xf, true); break;
                        case 4: r = __builtin_amdgcn_update_dpp(0, iv, 0x114, 0xf, 0xf, true); break; default: r = __builtin_amdgcn_update_dpp(0, iv, 0x118, 0xf, 0xf, true); break; }
    return __builtin_bit_cast(float, r); }
DI float scan64(float v) {
    v += dpp_shr_(v, 1); v += dpp_shr_(v, 2); v += dpp_shr_(v, 4); v += dpp_shr_(v, 8);
    v += __builtin_bit_cast(float, __builtin_amdgcn_update_dpp(0, __builtin_bit_cast(int, v), 0x142, 0xa, 0xf, false));
    v += __builtin_bit_cast(float, __builtin_amdgcn_update_dpp(0, __builtin_bit_cast(int, v), 0x143, 0xc, 0xf, false));
    return v; }
DI float lane_read(float v, int ln) { return __builtin_bit_cast(float, __builtin_amdgcn_readlane(__builtin_bit_cast(int, v), ln)); }
template <int MIX>
DI void rec_front(const RecPre<MIX>& R, const GAS float* lg, const GAS float* wgp, const GAS float* bgp, int l, int h, int dir, int wave, float (&kv)[RecCfg<MIX>::CPT], float (&cum)[RecCfg<MIX>::CPT]) {
    if (MIX == 0) { float z[8]; unpack8(R.fk, z);
#pragma unroll
        for (int e = 0; e < 8; ++e) { const int ch = h * 64 + 8 * wave + e; float lb = 0.f; if (l == 1) lb = sigmoid_(lg[512 + dir * 256 + ch] - lg[dir * 256 + ch]);
            const float f = lb + (1.f - lb) * sigmoid_(z[e]); cum[e] = scan64(__logf(f)); kv[e] = (1.f - lb) * sigmoid_(-z[e]); }
    } else { float z[16], kk[8]; unpack8(R.zg[0], z); unpack8(R.zg[1], z + 8); unpack8(R.fk, kk);
#pragma unroll
        for (int c = 0; c < 4; ++c) { const int ch = h * 32 + 4 * wave + c; float sacc = bgp[ch];
#pragma unroll
            for (int r = 0; r < 16; ++r) sacc += z[r] * wgp[r * 128 + ch];
            cum[c] = scan64(logsigmoid_(sacc) * (1.f / 16.f)); kv[c] = kk[c]; } }
}
template <int N> DI void st_bf16(LAS bf16* p, const float (&v)[N]) {
    if (N == 8) *(LAS v4u*)p = (v4u){pk2(v[0], v[1]), pk2(v[2], v[3]), pk2(v[4], v[5]), pk2(v[6], v[7])};
    else *(LAS v2u*)p = (v2u){pk2(v[0], v[1]), pk2(v[2], v[3])};
}
DI void rec_vt_store(const v4u vp, LAS bf16* VT, int tid) { const int j = tid >> 3, v8 = tid & 7; const unsigned ww[4] = {vp.x, vp.y, vp.z, vp.w};
#pragma unroll
    for (int e = 0; e < 8; ++e) VT[(v8 * 8 + e) * 72 + j] = (bf16)((ww[e >> 1] >> ((e & 1) * 16)) & 0xffffu); }

template <int MIX>
DI void rec_r1_run(const Ctx& a, int l, LAS unsigned char* lds, int tid, int bid, int G) {
    constexpr int DK = RecCfg<MIX>::DK, CPT = RecCfg<MIX>::CPT;
    const int lane = tid & 63, wave = __builtin_amdgcn_readfirstlane(tid >> 6);
    LAS bf16* KT = (LAS bf16*)(lds + L_KD); LAS bf16* VT = (LAS bf16*)(lds + L_VT);
    GAS unsigned char* wsb = a.ws(); const GAS bf16* P = (const GAS bf16*)(wsb + WS_P);
    GAS float* RSb = (GAS float*)(wsb + (MIX == 0 ? WS_RSH : WS_RSG)); GAS float* RAb = (GAS float*)(wsb + (MIX == 0 ? WS_RAH : WS_RAG));
    const GAS float* lg = a.in(I_LBL);
    const GAS float* wgF = a.in(I_WGF) + l * 16 * 128; const GAS float* wgB = a.in(I_WGB) + l * 16 * 128; const GAS float* bgF = a.in(I_BGF) + l * 128; const GAS float* bgB = a.in(I_BGB) + l * 128;
    constexpr int NU = 32 * NCHUNK;
    const bool rebal = (MIX == 0) && (G == 256);
    const int n0 = (rebal && bid < 32) ? 4 : 0, nn = (NU - 1 - bid) / G + 1, n1 = nn + ((rebal && bid >= 128) ? 1 : 0);
    auto unit_at = [&](int n) { if (n >= n1) return NU; if (n < nn) return bid + G * n; const int e = bid - 128; return (e & 31) + G * (e >> 5); };
    RecPre<MIX> Rs[2];
    int nidx = n0;
    int u0 = unit_at(nidx), u1 = unit_at(nidx + 1);
#pragma unroll
    for (int par = 0; par < 2; ++par) { const int unit = par ? u1 : u0; if (unit < NU) { const int c = unit % NCHUNK, chain = unit / NCHUNK; rec_fetch<MIX, false>(Rs[par], P, RSb, chain >> 3, (chain >> 1) & 3, chain & 1, c, tid); } }
    BAR_LDS();
#pragma unroll 1
    while (u0 < NU) {
        const int n2 = unit_at(nidx + 2), n3 = unit_at(nidx + 3);
#pragma unroll
        for (int par = 0; par < 2; ++par) { const int unit = par ? u1 : u0; if (unit < NU) { RecPre<MIX>& R = Rs[par];
            LAS bf16* KTp = par ? (LAS bf16*)(lds + L_ST) : KT; LAS bf16* VTp = par ? (LAS bf16*)(lds + L_ATT) : VT;
            const int c = unit % NCHUNK, chain = unit / NCHUNK, dir = chain & 1, h = (chain >> 1) & 3;
            { float kv[CPT], cum[CPT]; rec_front<MIX>(R, lg, dir ? wgB : wgF, dir ? bgB : bgF, l, h, dir, wave, kv, cum);
#pragma unroll
                for (int e = 0; e < CPT; ++e) { const float last = lane_read(cum[e], 63); KTp[(CPT * wave + e) * 72 + lane] = (bf16)f2bf(kv[e] * __expf(last - cum[e]));
                    if (lane == 63) RAb[(size_t)(chain * NCHUNK + c) * DK + CPT * wave + e] = __expf(cum[e]); } }
            rec_vt_store(R.vp, VTp, tid);
            { const int nu = par ? n3 : n2; if (nu < NU) { const int c2 = nu % NCHUNK, ch2 = nu / NCHUNK; rec_fetch<MIX, false>(R, P, RSb, ch2 >> 3, (ch2 >> 1) & 3, ch2 & 1, c2, tid); } } } }
        BAR_LDS();
#pragma unroll
        for (int par = 0; par < 2; ++par) { const int unit = par ? u1 : u0; if (unit < NU) {
            const LAS bf16* KTp = par ? (const LAS bf16*)(lds + L_ST) : KT; const LAS bf16* VTp = par ? (const LAS bf16*)(lds + L_ATT) : VT;
            const int c = unit % NCHUNK, chain = unit / NCHUNK;
            GAS float* RS = RSb + (size_t)(chain * NCHUNK + c) * DK * 64;
#pragma unroll 1
            for (int tl = wave; tl < (DK / 16) * 4; tl += 8) { const int kb = tl >> 2, vb = tl & 3;
                const f32x4 acc = mma16(KTp + kb * 16 * 72, 72, VTp + vb * 16 * 72, 72, 64, lane);
#pragma unroll
                for (int j = 0; j < 4; ++j) RS[(kb * 16 + 4 * (lane >> 4) + j) * 64 + vb * 16 + (lane & 15)] = acc[j]; } } }
        BAR_LDS();
        nidx += 2; u0 = n2; u1 = n3;
    }
}

DI void rec_r2(const Ctx& a, int gtid, int gthreads) {
    GAS unsigned char* wsb = a.ws();
#pragma unroll 1
    for (int e = gtid; e < 32 * 4096 + 32 * 2048; e += gthreads) {
        const bool g = e >= 32 * 4096; const int ee = g ? e - 32 * 4096 : e; const int DK = g ? 32 : 64, per = DK * 64;
        const int chain = ee / per, kv = ee % per, k = kv >> 6;
        GAS float* RS = (GAS float*)(wsb + (g ? WS_RSG : WS_RSH)) + (size_t)chain * NCHUNK * per + kv;
        const GAS float* RA = (const GAS float*)(wsb + (g ? WS_RAG : WS_RAH)) + (size_t)chain * NCHUNK * DK + k;
        float S = 0.f;
#pragma unroll 1
        for (int c = 0; c < NCHUNK; c += 4) { float U[4], A[4];
#pragma unroll
            for (int u = 0; u < 4; ++u) { U[u] = RS[(size_t)(c + u) * per]; A[u] = RA[(c + u) * DK]; }
#pragma unroll
            for (int u = 0; u < 4; ++u) { RS[(size_t)(c + u) * per] = S; S = A[u] * S + U[u]; } }
    }
}

template <int MIX>
DI void rec_r3_run(const Ctx& a, int l, LAS unsigned char* lds, int tid, int bid, int G, bool keep_ctx) {
    constexpr int DK = RecCfg<MIX>::DK, DKP = RecCfg<MIX>::DKP, CPT = RecCfg<MIX>::CPT;
    const int lane = tid & 63, wave = __builtin_amdgcn_readfirstlane(tid >> 6);
    LAS bf16* QD = (LAS bf16*)(lds + L_QD); LAS bf16* QE = (LAS bf16*)(lds + L_QE); LAS bf16* KD = (LAS bf16*)(lds + L_KD);
    LAS bf16* VT = (LAS bf16*)(lds + L_VT); LAS bf16* ST = (LAS bf16*)(lds + L_ST); LAS bf16* ATT = (LAS bf16*)(lds + L_ATT); LAS float* Ob = (LAS float*)(lds + L_O);
    GAS unsigned char* wsb = a.ws(); const GAS bf16* P = (const GAS bf16*)(wsb + WS_P); GAS bf16* CAT = (GAS bf16*)(wsb + WS_CAT);
    const GAS float* RSb = (const GAS float*)(wsb + (MIX == 0 ? WS_RSH : WS_RSG));
    const GAS float* lg = a.in(I_LBL); const GAS float* ngb = a.in(MIX == 0 ? I_HNG : I_GNG) + l * 256;
    const GAS float* wgF = a.in(I_WGF) + l * 16 * 128; const GAS float* wgB = a.in(I_WGB) + l * 16 * 128; const GAS float* bgF = a.in(I_BGF) + l * 128; const GAS float* bgB = a.in(I_BGB) + l * 128;
    constexpr int nR = 16 * NCHUNK;
    const int nAct = keep_ctx ? nR : 16 * 64, first = (bid + (MIX == 0 ? 0 : G - 64)) % G;
    auto unit_of = [&](int a) { return a >= nAct ? nR : (keep_ctx ? a : (a >> 6) * NCHUNK + 4 + (a & 63)); };
    auto scanc = [&](int tc, int dir) { return dir == 0 ? tc : (tc < 4 ? 3 - tc : 71 - tc); };
    RecPre<MIX> Rs[2];
    int aidx = first;
    int unit = unit_of(aidx);
    if (unit < nR) { const int tc = unit % NCHUNK, bh = unit / NCHUNK; rec_fetch<MIX, true>(Rs[0], P, RSb, bh >> 2, bh & 3, 0, scanc(tc, 0), tid); rec_fetch<MIX, true>(Rs[1], P, RSb, bh >> 2, bh & 3, 1, scanc(tc, 1), tid); }
    BAR_LDS();
#pragma unroll 1
    while (unit < nR) {
        const int tc = unit % NCHUNK, bh = unit / NCHUNK, h = bh & 3, b = bh >> 2;
        const int nunit = unit_of(aidx + G);
        v4u gatep = (v4u){0u, 0u, 0u, 0u};
#pragma unroll
        for (int dir = 0; dir < 2; ++dir) { RecPre<MIX>& R = Rs[dir];
            if (tid < DK * 8) { const int k = tid >> 3, v8 = tid & 7;
#pragma unroll
                for (int e = 0; e < 4; ++e) { ST[(v8 * 8 + e) * DKP + k] = (bf16)f2bf(R.s0[e]); ST[(v8 * 8 + 4 + e) * DKP + k] = (bf16)f2bf(R.s1[e]); } }
            rec_vt_store(R.vp, VT, tid);
            { const int ri = lane, I = ri >> 4; float kv[CPT], cm[CPT], qv[CPT], e8[CPT];
                rec_front<MIX>(R, lg, dir ? wgB : wgF, dir ? bgB : bgF, l, h, dir, wave, kv, cm);
                { float q8[8]; unpack8(R.qp, q8);
#pragma unroll
                    for (int e = 0; e < CPT; ++e) qv[e] = MIX == 0 ? silu_(q8[e]) * 0.125f : q8[e] * 0.17677669529663687f; }
#pragma unroll
                for (int e = 0; e < CPT; ++e) e8[e] = qv[e] * __expf(cm[e]);
                st_bf16<CPT>(QE + ri * DKP + CPT * wave, e8);
#pragma unroll
                for (int I2 = 0; I2 < 4; ++I2) {
                    float rf[CPT];
#pragma unroll
                    for (int e = 0; e < CPT; ++e) rf[e] = I2 == 0 ? 0.f : lane_read(cm[e], 16 * I2 - 1);
                    if (I2 >= I) {
                        if (I2 == I) {
#pragma unroll
                            for (int e = 0; e < CPT; ++e) e8[e] = qv[e] * __expf(cm[e] - rf[e]);
                            st_bf16<CPT>(QD + ri * DKP + CPT * wave, e8); }
#pragma unroll
                        for (int e = 0; e < CPT; ++e) e8[e] = kv[e] * __expf(fminf(rf[e] - cm[e], 80.f));
                        const int rowbase = I2 == 0 ? 0 : (I2 == 1 ? 16 : (I2 == 2 ? 48 : 96));
                        st_bf16<CPT>(KD + (rowbase + ri) * DKP + CPT * wave, e8); } } }
            if (dir == 0) {
                const int row = (tc < 4 ? b * 256 + tc * 64 : NCTX + b * SEQ + (tc - 4) * 64) + (tid >> 3);
                gatep = *(const GAS v4u*)(P + (size_t)row * PP + (MIX == 0 ? CA_G : CC_G) + h * 64 + (tid & 7) * 8); }
            if (nunit < nR) { const int tc2 = nunit % NCHUNK, bh2 = nunit / NCHUNK; rec_fetch<MIX, true>(R, P, RSb, bh2 >> 2, bh2 & 3, dir, scanc(tc2, dir), tid); }
            BAR_LDS();
            { const int I = wave >> 1, g = lane >> 4, c16 = lane & 15;
                const int rowbase = I == 0 ? 0 : (I == 1 ? 16 : (I == 2 ? 48 : 96));
                bf16x8 Bq[2];
#pragma unroll
                for (int m = 0; m < 2; ++m) {
                    f32x4 t0 = mma16(KD + (rowbase + 2 * m * 16) * DKP, DKP, QD + I * 16 * DKP, DKP, DK, lane);
                    f32x4 t1 = mma16(KD + (rowbase + (2 * m + 1) * 16) * DKP, DKP, QD + I * 16 * DKP, DKP, DK, lane);
#pragma unroll
                    for (int jj = 0; jj < 4; ++jj) { const bool up = 4 * g + jj > c16;
                        t0[jj] = (2 * m > I || (2 * m == I && up)) ? 0.f : t0[jj]; t1[jj] = (2 * m + 1 > I || (2 * m + 1 == I && up)) ? 0.f : t1[jj]; }
                    Bq[m] = pack8(t0[0], t0[1], t0[2], t0[3], t1[0], t1[1], t1[2], t1[3]); }
#pragma unroll
                for (int u = 0; u < 2; ++u) { const int vb = 2 * (wave & 1) + u; f32x4 acc = {0.f, 0.f, 0.f, 0.f};
#pragma unroll
                    for (int m = 0; m < 2; ++m) { const LAS bf16* vr = VT + (vb * 16 + c16) * 72 + 32 * m + 4 * g;
                        const v2u lo = *(const LAS v2u*)vr, hi = *(const LAS v2u*)(vr + 16);
                        acc = __builtin_amdgcn_mfma_f32_16x16x32_bf16(__builtin_bit_cast(bf16x8, (v4u){lo.x, lo.y, hi.x, hi.y}), Bq[m], acc, 0, 0, 0); }
                    const f32x4 acc2 = mma16(ST + vb * 16 * DKP, DKP, QE + I * 16 * DKP, DKP, DK, lane);
#pragma unroll
                    for (int jj = 0; jj < 4; ++jj) { const int i = I * 16 + c16, v = vb * 16 + 4 * g + jj; const float o = acc[jj] + acc2[jj];
                        if (dir == 0) Ob[i * RP + v] = o; else Ob[(63 - i) * RP + v] += o; } } }
            BAR_LDS();
        }
        { const int tl = tid >> 3, jg = tid & 7; float x[8]; float ss = 0.f;
#pragma unroll
            for (int vv = 0; vv < 8; ++vv) { x[vv] = Ob[tl * RP + jg * 8 + vv]; ss += x[vv] * x[vv]; }
            ss += __shfl_xor(ss, 1); ss += __shfl_xor(ss, 2); ss += __shfl_xor(ss, 4);
            const float rstd = rsqrtf(ss * (1.f / 64.f) + EPS);
            const int row = tc < 4 ? b * 256 + tc * 64 + tl : NCTX + b * SEQ + (tc - 4) * 64 + tl;
            const GAS float* ng = ngb + h * 64 + jg * 8;
            float gt[8]; unpack8(gatep, gt);
            float y[8];
#pragma unroll
            for (int vv = 0; vv < 8; ++vv) y[vv] = x[vv] * rstd * ng[vv] * silu_(gt[vv]);
            v4u ow; ow.x = pk2(y[0], y[1]); ow.y = pk2(y[2], y[3]); ow.z = pk2(y[4], y[5]); ow.w = pk2(y[6], y[7]);
            *(GAS v4u*)(CAT + (size_t)row * D + (MIX == 0 ? 0 : 512) + h * 64 + jg * 8) = ow; }
        unit = nunit; aidx += G;
    }
    __syncthreads();
}

typedef float f32x16 __attribute__((ext_vector_type(16)));
DI int swap23(int r) { return (r & 19) | ((r & 4) << 1) | ((r & 8) >> 1); }
struct AttnDesc {
    const GAS bf16* q; int qpitch;
    const GAS bf16* k; int kpitch;
    const GAS bf16* vt;
    GAS bf16* o; int opitch;
    int ntiles; float scale;
    int b, r0, rs0;
    const LAS float* rpb;
};
template <int DQK, bool NA>
DI void attn_mfma_unit(LAS unsigned char* lds, const AttnDesc& A, int tid, int lane, int wave) {
    constexpr int KP = DQK + 8, VP = 72, NS = DQK / 16, KPIECES = 64 * (DQK / 8);
    constexpr int BUF = 64 * KP * 2 + 64 * VP * 2;
    const int q = lane & 31, g = lane >> 5;
    auto tpos = [&](int t) { return NA ? (t < 4 ? 64 * t : 256 + 64 * (A.rs0 + t - 4)) : 64 * t; };
    auto krow = [&](int pos) { return NA ? (pos < 256 ? A.b * 256 + pos : NCTX + A.b * SEQ + (pos - 256)) : pos; };
    const int qi = NA ? (2 * (wave >> 2) + (q >> 4)) * 64 + 16 * (wave & 3) + (q & 15) : wave * 32 + q;
    const int kc0 = NA ? min(max(16 * (wave & 3) - 8, 0), 32) : 0;
    bf16x8 Qf[NS];
    { const GAS bf16* qp = A.q + (size_t)qi * A.qpitch + 8 * g;
#pragma unroll
        for (int s2 = 0; s2 < NS; ++s2) Qf[s2] = *(const GAS bf16x8*)(qp + 16 * s2); }
    f32x16 O[2];
#pragma unroll
    for (int db = 0; db < 2; ++db)
#pragma unroll
        for (int i = 0; i < 16; ++i) O[db][i] = 0.f;
    float mrun = -1e30f, lrun = 0.f;
    const int qr = NA ? A.r0 + (qi >> 6) : 0, qc = NA ? (qi & 63) : 0;
    const int wrs = NA ? min(max(qr - 4, 0), 56) : 0, cs = NA ? min(max(qc - 8, 0), 48) : 0;
    const int qr0 = NA ? A.r0 + 2 * (wave >> 2) : 0, wlo = NA ? min(max(qr0 - 4, 0), 56) : 0, whi = NA ? min(max(qr0 + 1 - 4, 0), 56) + 8 : 0;
    v4u kreg[2], vreg;
    auto gload = [&](int t) { const int pos = tpos(t);
#pragma unroll
        for (int u = 0; u < 2; ++u) { const int p = tid + 512 * u; if (p < KPIECES) { const int key = p / (DQK / 8), d8 = p % (DQK / 8); kreg[u] = *(const GAS v4u*)(A.k + (size_t)krow(pos + key) * A.kpitch + d8 * 8); } }
        vreg = *(const GAS v4u*)(A.vt + (size_t)(tid >> 3) * NKEY + pos + (tid & 7) * 8); };
    auto lstore = [&](int buf) { LAS bf16* Kt = (LAS bf16*)(lds + buf * BUF); LAS bf16* Vt = Kt + 64 * KP;
#pragma unroll
        for (int u = 0; u < 2; ++u) { const int p = tid + 512 * u; if (p < KPIECES) { const int key = p / (DQK / 8), d8 = p % (DQK / 8); *(LAS v4u*)(Kt + key * KP + d8 * 8) = kreg[u]; } }
        *(LAS v4u*)(Vt + (tid >> 3) * VP + (tid & 7) * 8) = vreg; };
    __syncthreads();
    gload(0); lstore(0);
    __syncthreads();
#pragma unroll 1
    for (int t = 0; t < A.ntiles; ++t) {
        const bool more = t + 1 < A.ntiles;
        if (more) gload(t + 1);
        bool active = true, rowok = true; int dr = 0;
        const bool win = NA && t >= 4;
        if (win) { const int wr = A.rs0 + t - 4; active = (wr >= wlo) && (wr < whi); rowok = (wr >= wrs) && (wr < wrs + 8); dr = min(max(wr - qr + 7, 0), 14); }
        if (active) {
            const LAS bf16* Kt = (const LAS bf16*)(lds + (t & 1) * BUF); const LAS bf16* Vt = Kt + 64 * KP;
            f32x16 S[2];
#pragma unroll
            for (int kb = 0; kb < 2; ++kb) {
#pragma unroll
                for (int i = 0; i < 16; ++i) S[kb][i] = 0.f;
                if (win && kb == 1) continue;
                const LAS bf16* kp = Kt + ((win ? kc0 : kb * 32) + swap23(q)) * KP + 8 * g;
#pragma unroll
                for (int s2 = 0; s2 < NS; ++s2) { const bf16x8 a = *(const LAS bf16x8*)(kp + 16 * s2); S[kb] = __builtin_amdgcn_mfma_f32_32x32x16_bf16(a, Qf[s2], S[kb], 0, 0, 0); }
            }
            float mx = -INFINITY;
            if (NA) {
                if (win) {
#pragma unroll
                    for (int i = 0; i < 16; ++i) { const int kc = kc0 + 16 * (i >> 3) + 8 * g + (i & 7); const int dc = min(max(kc - qc, -15), 15) + 15;
                        const float bv = A.rpb[dr * 31 + dc]; const float sv = (rowok && kc >= cs && kc < cs + 16) ? S[0][i] * A.scale + bv : -INFINITY;
                        S[0][i] = sv; mx = fmaxf(mx, sv); }
                } else {
#pragma unroll
                    for (int kb = 0; kb < 2; ++kb)
#pragma unroll
                        for (int i = 0; i < 16; ++i) { const float sv = S[kb][i] * A.scale; S[kb][i] = sv; mx = fmaxf(mx, sv); }
                }
            } else {
#pragma unroll
                for (int kb = 0; kb < 2; ++kb)
#pragma unroll
                    for (int i = 0; i < 16; ++i) mx = fmaxf(mx, S[kb][i]);
            }
            mx = fmaxf(mx, __shfl_xor(mx, 32));
            const float mn = fmaxf(mrun, mx), alpha = __builtin_amdgcn_exp2f(mrun - mn);
            mrun = mn;
            if (__any(alpha != 1.f)) { lrun *= alpha;
#pragma unroll
                for (int db = 0; db < 2; ++db)
#pragma unroll
                    for (int i = 0; i < 16; ++i) O[db][i] *= alpha; }
            bf16x8 Pf[4];
#pragma unroll
            for (int ks = 0; ks < 4; ++ks) { if (win && ks >= 2) continue; const int kb = ks >> 1, o8 = (ks & 1) * 8; float p[8];
#pragma unroll
                for (int j = 0; j < 8; ++j) { p[j] = __builtin_amdgcn_exp2f(S[kb][o8 + j] - mn); lrun += p[j]; }
                Pf[ks] = pack8(p[0], p[1], p[2], p[3], p[4], p[5], p[6], p[7]); }
#pragma unroll
            for (int db = 0; db < 2; ++db) { const LAS bf16* vp = Vt + (db * 32 + q) * VP + (win ? kc0 : 0) + 8 * g;
#pragma unroll
                for (int ks = 0; ks < 4; ++ks) { if (win && ks >= 2) continue; const bf16x8 a = *(const LAS bf16x8*)(vp + 16 * ks); O[db] = __builtin_amdgcn_mfma_f32_32x32x16_bf16(a, Pf[ks], O[db], 0, 0, 0); } }
        }
        if (more) lstore((t + 1) & 1);
        __syncthreads();
    }
    const float ltot = lrun + __shfl_xor(lrun, 32), inv = 1.f / ltot;
    GAS bf16* op = A.o + (size_t)qi * A.opitch + 4 * g;
#pragma unroll
    for (int db = 0; db < 2; ++db)
#pragma unroll
        for (int i4 = 0; i4 < 4; ++i4) { v2u w; w.x = pk2(O[db][4 * i4] * inv, O[db][4 * i4 + 1] * inv); w.y = pk2(O[db][4 * i4 + 2] * inv, O[db][4 * i4 + 3] * inv); *(GAS v2u*)(op + 32 * db + 8 * i4) = w; }
}

constexpr float MLA_TH = 8.f;
constexpr int NA_SLOT = 2 * 64 * 72 * 2, NA_RPB = 4 * NA_SLOT;
DI void na_unit(LAS unsigned char* lds, const AttnDesc& A, const GAS float* rp, int tid, int lane, int wave) {
    constexpr int KP = 72, VP = 72, NS = 4, KBUF = 64 * KP * 2;
    const int q = lane & 31, g = lane >> 5, NT = A.ntiles;
    auto tpos = [&](int t) { return t < 4 ? 64 * t : 256 + 64 * (A.rs0 + t - 4); };
    auto krow = [&](int pos) { return pos < 256 ? A.b * 256 + pos : NCTX + A.b * SEQ + (pos - 256); };
    const int qi = (2 * (wave >> 2) + (q >> 4)) * 64 + 16 * (wave & 3) + (q & 15);
    const int kc0 = min(max(16 * (wave & 3) - 8, 0), 32);
    bf16x8 Qf[NS];
    { const GAS bf16* qp = A.q + (size_t)qi * A.qpitch + 8 * g;
#pragma unroll
        for (int s2 = 0; s2 < NS; ++s2) Qf[s2] = *(const GAS bf16x8*)(qp + 16 * s2); }
    f32x16 O[2];
#pragma unroll
    for (int db = 0; db < 2; ++db)
#pragma unroll
        for (int i = 0; i < 16; ++i) O[db][i] = 0.f;
    float mrun = -1e30f, lrun = 0.f;
    const int qr = A.r0 + (qi >> 6), qc = qi & 63;
    const int wrs = min(max(qr - 4, 0), 56), cs = min(max(qc - 8, 0), 48);
    const int qr0 = A.r0 + 2 * (wave >> 2), wlo = min(max(qr0 - 4, 0), 56), whi = min(max(qr0 + 1 - 4, 0), 56) + 8;
    auto koffs = [&](int i) { const int j = i * 64 + lane, row = j / 9, pc = min(j % 9, 7); return (unsigned)(row * (PP * 2) + pc * 16); };
    auto voffs = [&](int i) { const int j = i * 64 + lane, row = j / 9, pc = min(j % 9, 7); return (unsigned)(row * (NKEY * 2) + pc * 16); };
    const int iv1 = wave == 0 ? 0 : wave - 1, iv2 = wave < 2 ? 7 + wave : iv1;
    const unsigned goff0 = koffs(wave), goff1 = wave == 0 ? koffs(8) : voffs(iv1), goff2 = voffs(iv2);
    auto dma = [&](int t, int slot) __attribute__((always_inline)) { const int pos = tpos(t);
        const GAS unsigned char* kb = (const GAS unsigned char*)(A.k + (size_t)krow(pos) * A.kpitch); const GAS unsigned char* vb = (const GAS unsigned char*)(A.vt + pos);
        LAS unsigned char* kl = lds + slot * NA_SLOT; LAS unsigned char* vl = kl + KBUF;
        __builtin_amdgcn_global_load_lds((const GAS unsigned*)(kb + goff0), (LAS unsigned*)(kl + wave * 1024), 16, 0, 0);
        __builtin_amdgcn_global_load_lds((const GAS unsigned*)((wave == 0 ? kb : vb) + goff1), (LAS unsigned*)(wave == 0 ? kl + 8 * 1024 : vl + iv1 * 1024), 16, 0, 0);
        __builtin_amdgcn_global_load_lds((const GAS unsigned*)(vb + goff2), (LAS unsigned*)(vl + iv2 * 1024), 16, 0, 0);
    };
    LAS float* T = (LAS float*)(lds + NA_RPB);
    float tv[4];
#pragma unroll
    for (int u = 0; u < 4; ++u) { const int e = tid + 512 * u, r = e >> 7, dcr = (e & 127) - 64; const bool in = r < 15 && dcr >= -15 && dcr <= 15;
        tv[u] = in ? rp[r * 31 + dcr + 15] * LOG2E : (r == 15 ? -INFINITY : 0.f); }
    float mcol[16];
#pragma unroll
    for (int i = 0; i < 16; ++i) { const int kc = kc0 + 16 * (i >> 3) + 8 * g + (i & 7); mcol[i] = (kc >= cs && kc < cs + 16) ? 0.f : -INFINITY; }
    __syncthreads();
    dma(0, 0); dma(min(1, NT - 1), 1); dma(min(2, NT - 1), 2);
#pragma unroll
    for (int u = 0; u < 4; ++u) T[tid + 512 * u] = tv[u];
    asm volatile("s_waitcnt vmcnt(6)\n\ts_waitcnt lgkmcnt(0)\n\ts_barrier" ::: "memory");
#pragma unroll 1
    for (int t = 0; t < NT; ++t) {
        dma(min(t + 3, NT - 1), (t + 3) & 3);
        bool active = true, rowok = true; int dr = 0;
        const bool win = t >= 4;
        if (win) { const int wr = A.rs0 + t - 4; active = (wr >= wlo) && (wr < whi); rowok = (wr >= wrs) && (wr < wrs + 8); dr = min(max(wr - qr + 7, 0), 14); }
        if (active) {
            const LAS bf16* Kt = (const LAS bf16*)(lds + (t & 3) * NA_SLOT); const LAS bf16* Vt = Kt + 64 * KP;
            f32x16 S[2];
#pragma unroll
            for (int kb = 0; kb < 2; ++kb) {
#pragma unroll
                for (int i = 0; i < 16; ++i) S[kb][i] = 0.f;
                if (win && kb == 1) continue;
                const LAS bf16* kp = Kt + ((win ? kc0 : kb * 32) + swap23(q)) * KP + 8 * g;
#pragma unroll
                for (int s2 = 0; s2 < NS; ++s2) { const bf16x8 a = *(const LAS bf16x8*)(kp + 16 * s2); S[kb] = __builtin_amdgcn_mfma_f32_32x32x16_bf16(a, Qf[s2], S[kb], 0, 0, 0); }
            }
            float mx = -INFINITY;
            if (win) { const LAS float* tb = T + (rowok ? dr : 15) * 128 + (kc0 + 8 * g - qc + 64);
#pragma unroll
                for (int i = 0; i < 16; ++i) { const float sv = (S[0][i] * A.scale + tb[16 * (i >> 3) + (i & 7)]) + mcol[i]; S[0][i] = sv; mx = fmaxf(mx, sv); }
            } else {
#pragma unroll
                for (int kb = 0; kb < 2; ++kb)
#pragma unroll
                    for (int i = 0; i < 16; ++i) { const float sv = S[kb][i] * A.scale; S[kb][i] = sv; mx = fmaxf(mx, sv); }
            }
            if (__any(mx > mrun + MLA_TH)) { const float mf = fmaxf(mx, __shfl_xor(mx, 32)), mn = fmaxf(mrun, mf), alpha = __builtin_amdgcn_exp2f(mrun - mn);
                mrun = mn; lrun *= alpha;
#pragma unroll
                for (int db = 0; db < 2; ++db)
#pragma unroll
                    for (int i = 0; i < 16; ++i) O[db][i] *= alpha; }
            bf16x8 Pf[4];
#pragma unroll
            for (int ks = 0; ks < 4; ++ks) { if (win && ks >= 2) continue; const int kb = ks >> 1, o8 = (ks & 1) * 8; float p[8];
#pragma unroll
                for (int j = 0; j < 8; ++j) { p[j] = __builtin_amdgcn_exp2f(S[kb][o8 + j] - mrun); lrun += p[j]; }
                Pf[ks] = pack8(p[0], p[1], p[2], p[3], p[4], p[5], p[6], p[7]); }
#pragma unroll
            for (int db = 0; db < 2; ++db) { const LAS bf16* vp = Vt + (db * 32 + q) * VP + (win ? kc0 : 0) + 8 * g;
#pragma unroll
                for (int ks = 0; ks < 4; ++ks) { if (win && ks >= 2) continue; const bf16x8 a = *(const LAS bf16x8*)(vp + 16 * ks); O[db] = __builtin_amdgcn_mfma_f32_32x32x16_bf16(a, Pf[ks], O[db], 0, 0, 0); } }
        }
        asm volatile("s_waitcnt vmcnt(6)\n\ts_waitcnt lgkmcnt(0)\n\ts_barrier" ::: "memory");
    }
    asm volatile("s_waitcnt vmcnt(0)" ::: "memory");
    const float ltot = lrun + __shfl_xor(lrun, 32), inv = 1.f / ltot;
    GAS bf16* op = A.o + (size_t)qi * A.opitch + 4 * g;
#pragma unroll
    for (int db = 0; db < 2; ++db)
#pragma unroll
        for (int i4 = 0; i4 < 4; ++i4) { v2u w; w.x = pk2(O[db][4 * i4] * inv, O[db][4 * i4 + 1] * inv); w.y = pk2(O[db][4 * i4 + 2] * inv, O[db][4 * i4 + 3] * inv); *(GAS v2u*)(op + 32 * db + 8 * i4) = w; }
}

struct TagF { static constexpr bool value = false; }; struct TagT { static constexpr bool value = true; };
#define SGB(mask, n) __builtin_amdgcn_sched_group_barrier(mask, n, 0)
DI void mla_unit(LAS unsigned char* lds, const AttnDesc& A, int tid, int lane, int wave) {
    constexpr int KP = 104, VP = 72, NS = 6, KBUF = 64 * KP * 2, VBUF = 64 * VP * 2;
    const int q = lane & 31, g = lane >> 5, NT = A.ntiles;
    bf16x8 Qf[NS];
    { const GAS bf16* qp = A.q + (size_t)(wave * 32 + q) * A.qpitch + 8 * g;
#pragma unroll
        for (int s2 = 0; s2 < NS; ++s2) Qf[s2] = *(const GAS bf16x8*)(qp + 16 * s2); }
    f32x16 O[2], Cm;
#pragma unroll
    for (int i = 0; i < 16; ++i) { O[0][i] = 0.f; O[1][i] = 0.f; Cm[i] = 0.f; }
    float lrun = 0.f;
    auto koffs = [&](int i) { const int j = i * 64 + lane, row = j / 13, pc = min(j % 13, 11); return (unsigned)(row * 192 + pc * 16); };
    auto voffs = [&](int i) { const int j = i * 64 + lane, row = j / 9, pc = min(j % 9, 7); return (unsigned)(row * (NKEY * 2) + pc * 16); };
    const int i2 = min(wave + 3, 8);
    const unsigned goff0 = koffs(wave), goff1 = wave < 5 ? koffs(wave + 8) : voffs(wave - 5), goff2 = voffs(i2);
    auto dma = [&](int tk, int ks, int tv, int vs) __attribute__((always_inline)) {
        const GAS unsigned char* kb = (const GAS unsigned char*)A.k + (size_t)tk * (64 * 96 * 2); const GAS unsigned char* vb = (const GAS unsigned char*)A.vt + (size_t)tv * 128;
        LAS unsigned char* kl = lds + ks * KBUF; LAS unsigned char* vl = lds + 2 * KBUF + vs * VBUF;
        __builtin_amdgcn_global_load_lds((const GAS unsigned*)(kb + goff0), (LAS unsigned*)(kl + wave * 1024), 16, 0, 0);
        __builtin_amdgcn_global_load_lds((const GAS unsigned*)((wave < 5 ? kb : vb) + goff1), (LAS unsigned*)(wave < 5 ? kl + (wave + 8) * 1024 : vl + (wave - 5) * 1024), 16, 0, 0);
        __builtin_amdgcn_global_load_lds((const GAS unsigned*)(vb + goff2), (LAS unsigned*)(vl + i2 * 1024), 16, 0, 0);
    };
    auto qk = [&](f32x16& S0, f32x16& S1, int buf) __attribute__((always_inline)) {
        const LAS bf16* kp = (const LAS bf16*)(lds + buf * KBUF) + swap23(q) * KP + 8 * g;
        S0 = __builtin_amdgcn_mfma_f32_32x32x16_bf16(*(const LAS bf16x8*)kp, Qf[0], Cm, 0, 0, 0);
#pragma unroll
        for (int s2 = 1; s2 < NS; ++s2) S0 = __builtin_amdgcn_mfma_f32_32x32x16_bf16(*(const LAS bf16x8*)(kp + 16 * s2), Qf[s2], S0, 0, 0, 0);
        S1 = __builtin_amdgcn_mfma_f32_32x32x16_bf16(*(const LAS bf16x8*)(kp + 32 * KP), Qf[0], Cm, 0, 0, 0);
#pragma unroll
        for (int s2 = 1; s2 < NS; ++s2) S1 = __builtin_amdgcn_mfma_f32_32x32x16_bf16(*(const LAS bf16x8*)(kp + 32 * KP + 16 * s2), Qf[s2], S1, 0, 0, 0);
    };
    auto smax = [&](const f32x16& S0, const f32x16& S1) __attribute__((always_inline)) { float mx = fmaxf(S0[0], S0[1]);
#pragma unroll
        for (int i = 2; i < 16; ++i) mx = fmaxf(mx, S0[i]);
#pragma unroll
        for (int i = 0; i < 16; ++i) mx = fmaxf(mx, S1[i]);
        return mx; };
    auto rebase = [&](f32x16& S0, f32x16& S1, float mx) __attribute__((always_inline)) {
        const float mf = fmaxf(mx, __shfl_xor(mx, 32)), d = fmaxf(mf, 0.f), alpha = __builtin_amdgcn_exp2f(-d);
        lrun *= alpha;
#pragma unroll
        for (int i = 0; i < 16; ++i) { O[0][i] *= alpha; O[1][i] *= alpha; S0[i] -= d; S1[i] -= d; Cm[i] -= d; }
        asm volatile("" : "+v"(Cm));
    };
    auto softmax_p = [&](const f32x16& S0, const f32x16& S1, bf16x8 (&Pf)[4]) __attribute__((always_inline)) {
#pragma unroll
        for (int ks = 0; ks < 4; ++ks) { const int o8 = (ks & 1) * 8; float p[8];
#pragma unroll
            for (int j = 0; j < 8; ++j) { p[j] = __builtin_amdgcn_exp2f(ks < 2 ? S0[o8 + j] : S1[o8 + j]); lrun += p[j]; }
            Pf[ks] = pack8(p[0], p[1], p[2], p[3], p[4], p[5], p[6], p[7]); }
    };
    auto pv = [&](const bf16x8 (&Pf)[4], int buf) __attribute__((always_inline)) {
        const LAS bf16* vp = (const LAS bf16*)(lds + 2 * KBUF + buf * VBUF) + q * VP + 8 * g;
#pragma unroll
        for (int ks = 0; ks < 4; ++ks)
#pragma unroll
            for (int db = 0; db < 2; ++db) O[db] = __builtin_amdgcn_mfma_f32_32x32x16_bf16(*(const LAS bf16x8*)(vp + db * 32 * VP + 16 * ks), Pf[ks], O[db], 0, 0, 0);
    };
    f32x16 Sa[2], Sb[2];
    if (wave >= 4) __builtin_amdgcn_s_setprio(1);
    __syncthreads();
    dma(0, 0, 0, 0); dma(1, 1, 0, 0);
    asm volatile("s_waitcnt vmcnt(0)" ::: "memory");
    __syncthreads();
    qk(Sa[0], Sa[1], 0);
    { const float mx = smax(Sa[0], Sa[1]); const float mf = fmaxf(mx, __shfl_xor(mx, 32));
#pragma unroll
        for (int i = 0; i < 16; ++i) { Sa[0][i] -= mf; Sa[1][i] -= mf; Cm[i] = -mf; }
        asm volatile("" : "+v"(Cm)); }
    __syncthreads();
    auto step = [&](f32x16 (&Sc)[2], f32x16 (&Sn)[2], const int t, auto par) __attribute__((always_inline)) {
        constexpr int PAR = decltype(par)::value ? 1 : 0;
        dma(min(t + 2, NT - 1), PAR, min(t + 1, NT - 1), PAR ^ 1);
        __builtin_amdgcn_sched_barrier(0);
        bf16x8 Pf[4];
        qk(Sn[0], Sn[1], PAR ^ 1);
        softmax_p(Sc[0], Sc[1], Pf);
        pv(Pf, PAR);
        const float mx = smax(Sn[0], Sn[1]);
        SGB(0x100, 3);
#pragma unroll
        for (int m = 0; m < 16; ++m) { SGB(0x008, 1); SGB(0x100, 1); SGB(0x400, 2); SGB(0x002, 3); }
#pragma unroll
        for (int m = 0; m < 4; ++m) { SGB(0x008, 1); SGB(0x100, 1); SGB(0x002, 5); }
        if (__any(mx > MLA_TH)) rebase(Sn[0], Sn[1], mx);
        asm volatile("s_waitcnt vmcnt(0)" ::: "memory");
        __syncthreads();
    };
#pragma unroll 1
    for (int t = 0; t < NT - 2; t += 2) { step(Sa, Sb, t, TagF{}); step(Sb, Sa, t + 1, TagT{}); }
    step(Sa, Sb, NT - 2, TagF{});
    { bf16x8 Pf[4]; softmax_p(Sb[0], Sb[1], Pf); pv(Pf, (NT - 1) & 1); }
    __builtin_amdgcn_s_setprio(0);
    const float ltot = lrun + __shfl_xor(lrun, 32), inv = 1.f / ltot;
    GAS bf16* op = A.o + (size_t)(wave * 32 + q) * A.opitch + 4 * g;
#pragma unroll
    for (int db = 0; db < 2; ++db)
#pragma unroll
        for (int i4 = 0; i4 < 4; ++i4) { v2u w; w.x = pk2(O[db][4 * i4] * inv, O[db][4 * i4 + 1] * inv); w.y = pk2(O[db][4 * i4 + 2] * inv, O[db][4 * i4 + 3] * inv); *(GAS v2u*)(op + 32 * db + 8 * i4) = w; }
}

DI int moe_tables(const GAS unsigned* cnt  , LAS int* off, LAS int* tile_e, int tid) {
    if (tid == 0) { int o = 0; for (int e = 0; e < 32; ++e) { off[e] = o; o += ((int)cnt[e * 64] + 255) & ~255; } off[32] = o; }
    __syncthreads();
    if (tid < MOE_MAXT) { const int r = tid * 256; int ex = 0; for (int e = 0; e < 32; ++e) if (r >= off[e + 1]) ex = e + 1; tile_e[tid] = ex < 32 ? ex : 31; }
    __syncthreads();
    return off[32] >> 8;
}

#define TIDS const int tid = threadIdx.x, lane = tid & 63, wave = __builtin_amdgcn_readfirstlane(tid >> 6), bid = blockIdx.x, G = gridDim.x, gw = bid * 8 + wave, NGW = G * 8; (void)lane; (void)gw; (void)NGW
DI void ph_gemm_in(const Ctx& cx, int l) {
    TIDS; GAS unsigned char* ws = cx.ws(); LAS unsigned char* lds = (LAS unsigned char*)lds_raw;
    pg8::Gemm g{(const GAS bf16*)(ws + WS_H), (const GAS bf16*)(ws + WS_WTIN + (size_t)l * WTIN_L), MTOK, PP, D}; pg8::StaticOrder S; S.init(MTOK, PP, G, bid);
    pg8::EpiStoreBf16 E{(GAS bf16*)(ws + WS_P), PP};
    pg8::gemm_phase(lds, g, S, E);
}
DI void ph_prep_r1(const Ctx& cx, int l) {
    TIDS; LAS unsigned char* lds = (LAS unsigned char*)lds_raw;
#pragma unroll 1
    for (int u = bid; u < MTOK / 32; u += G) prep_unit(cx, l, u, lds, tid, lane, wave);
    __syncthreads();
    rec_r1_run<0>(cx, l, lds, tid, bid, G); rec_r1_run<1>(cx, l, lds, tid, bid, G);
    __syncthreads();
}
DI void ph_mixers(const Ctx& cx, int l) {
    TIDS; GAS unsigned char* ws = cx.ws(); LAS unsigned char* lds = (LAS unsigned char*)lds_raw;
    const bool keep_ctx = (l == 0);
    GAS bf16* CAT = (GAS bf16*)(ws + WS_CAT); const GAS bf16* P = (const GAS bf16*)(ws + WS_P);
    const int nATT = 256 + (keep_ctx ? 16 : 0), nR = 16 * NCHUNK;
    const int vc = (G % 8 == 0) ? (bid % 8) * (G / 8) + bid / 8 : bid;
    const bool r3first = ((bid >> 3) & 1) != 0;
    if (r3first) { rec_r3_run<0>(cx, l, lds, tid, bid, G, keep_ctx); rec_r3_run<1>(cx, l, lds, tid, bid, G, keep_ctx); __syncthreads(); }
#pragma unroll 1
    for (int it = 0; it < 2; ++it) { const int u = it == 0 ? vc : (G == 256 && bid >= 128 && bid < 144 ? 256 + bid - 128 : (G == 256 ? nATT : bid + G)); if (u >= nATT) continue;
        const GAS bf16* QM = (const GAS bf16*)(ws + WS_QM); const GAS bf16* KM = (const GAS bf16*)(ws + WS_KM); const GAS bf16* VM = (const GAS bf16*)(ws + WS_VM);
        AttnDesc A{}; int bh, b, h;
        if (u < 256) { bh = u >> 4; b = bh >> 2; h = bh & 3; const int qb = u & 15; A.q = QM + ((size_t)bh * NKEY + 256 + qb * 256) * 96; A.ntiles = NKEY / 64; A.o = CAT + (size_t)(NCTX + b * SEQ + qb * 256) * D + 768 + h * 64; }
        else { bh = u - 256; b = bh >> 2; h = bh & 3; A.q = QM + (size_t)bh * NKEY * 96; A.ntiles = 4; A.o = CAT + (size_t)(b * 256) * D + 768 + h * 64; }
        A.qpitch = 96; A.k = KM + (size_t)bh * NKEY * 96; A.kpitch = 96; A.vt = VM + (size_t)bh * 64 * NKEY; A.opitch = D; A.scale = 1.f;
        mla_unit(lds, A, tid, lane, wave);
    }
#pragma unroll 1
    for (int it = 0; it < 2; ++it) { const int u = it == 0 ? vc : (G == 256 && bid >= 160 && bid < 176 ? 256 + bid - 160 : (G == 256 ? nATT : bid + G)); if (u >= nATT) continue;
        LAS float* rpb = (LAS float*)(lds + NA_RPB);
        AttnDesc A{}; int bh, b, h; size_t qrow;
        if (u < 256) { bh = u >> 4; b = bh >> 2; h = bh & 3; const int rq = u & 15; A.r0 = rq * 4; A.rs0 = min(max(A.r0 - 4, 0), 56); const int rsl = min(max(A.r0 + 3 - 4, 0), 56);
            A.ntiles = 4 + (rsl + 8 - A.rs0); qrow = (size_t)NCTX + b * SEQ + A.r0 * 64; }
        else { bh = u - 256; b = bh >> 2; h = bh & 3; A.ntiles = 4; qrow = (size_t)b * 256; }
        const GAS float* rp = cx.in(I_RPB) + (size_t)(l * 4 + h) * 465;
        A.q = P + qrow * PP + CB_Q + h * 64; A.qpitch = PP; A.k = P + CB_K + h * 64; A.kpitch = PP; A.vt = (const GAS bf16*)(ws + WS_VNT) + (size_t)bh * 64 * NKEY;
        A.o = CAT + qrow * D + 256 + h * 64; A.opitch = D; A.scale = 0.125f * LOG2E; A.b = b; A.rpb = rpb;
        na_unit(lds, A, rp, tid, lane, wave);
    }
    __syncthreads();
    if (!r3first) { rec_r3_run<0>(cx, l, lds, tid, bid, G, keep_ctx); rec_r3_run<1>(cx, l, lds, tid, bid, G, keep_ctx); }
}
DI void ph_gemm_out(const Ctx& cx, int l) {
    TIDS; GAS unsigned char* ws = cx.ws(); LAS unsigned char* lds = (LAS unsigned char*)lds_raw;
    const int roff = (l == 0) ? 0 : NCTX, Mg = MTOK - roff;
    pg8::Gemm g{(const GAS bf16*)(ws + WS_CAT) + (size_t)roff * D, (const GAS bf16*)(ws + WS_WTOUT + (size_t)l * D * D * 2), Mg, D, D}; pg8::StaticOrder S; S.init(Mg, D, G, bid);
    pg8::EpiResid E{(GAS pg8::bf16_t*)(ws + WS_X), roff, (const GAS float*)(ws + WS_MOD) + (size_t)l * 5 * 6144 + 2 * 1024, l == 0 ? cx.in(I_CTX) : (const GAS float*)nullptr, l == 0 ? cx.in(I_X) : (const GAS float*)nullptr};
    pg8::gemm_phase(lds, g, S, E);
    if (l == 0) { const int nbusy = (Mg / 256) * (D / 256) - G;
        if (nbusy >= 0 && nbusy < G && bid >= nbusy) { __syncthreads(); weight_copies(cx, 1, lds, tid, lane, wave, (bid - nbusy) * 8 + wave, (G - nbusy) * 8, (bid - nbusy) * 512 + tid, (G - nbusy) * 512); } }
}
DI void ph_router(const Ctx& cx, int l) {
    TIDS; GAS unsigned char* ws = cx.ws(); LAS unsigned char* lds = (LAS unsigned char*)lds_raw;
    const int m_lo = (l == 0) ? 0 : NCTX;
    const GAS bf16* X = (const GAS bf16*)(ws + WS_X); GAS bf16* H = (GAS bf16*)(ws + WS_H); const GAS float* MOD = (const GAS float*)(ws + WS_MOD) + (size_t)l * 5 * 6144;
    GAS int* EID = (GAS int*)(ws + WS_MOE); GAS float* GATE = (GAS float*)(ws + WS_MOE) + MTOK * 2; GAS int* POS = (GAS int*)(ws + WS_MOE) + MTOK * 4;
    GAS unsigned* cnt = (GAS unsigned*)(ws + WS_CTL) + CW_CNT + l * 32 * 64; GAS int* RIDX = (GAS int*)(ws + WS_RIDX);
    const GAS bf16* WRh = (const GAS bf16*)(ws + WS_WR) + (size_t)l * 2 * 48 * 1024; const GAS bf16* WRl = WRh + 48 * 1024;
    const GAS float* n2g = cx.in(I_N2G) + l * D; const GAS float* brg = cx.in(I_BRG) + l * 4; const GAS float* bre = cx.in(I_BRE) + l * 32;
    constexpr int AP = 136;
    LAS bf16* Ah = (LAS bf16*)(lds + wave * 12288); LAS bf16* Al = Ah + 16 * AP; LAS float* LG = (LAS float*)(lds + wave * 12288 + 2 * 16 * AP * 2); LAS float* RSD = LG + 16 * 48;
    const int nunits = (MTOK - m_lo) / 16;
#pragma unroll 1
    for (int unit = wave * G + bid; unit < nunits; unit += NGW) {
        const int m0 = m_lo + unit * 16; const GAS float* mb = MOD + (size_t)bidx_of_row(m0) * 6144;
#pragma unroll 1
        for (int r4 = 0; r4 < 16; r4 += 4) { f32x4 v[4][4];
#pragma unroll
            for (int r = 0; r < 4; ++r)
#pragma unroll
                for (int j = 0; j < 4; ++j) v[r][j] = bf4f(*(const GAS v2u*)(X + (size_t)(m0 + r4 + r) * D + 4 * lane + 256 * j));
#pragma unroll
            for (int r = 0; r < 4; ++r) { float ss = 0.f;
#pragma unroll
                for (int j = 0; j < 4; ++j) ss += (v[r][j].x * v[r][j].x + v[r][j].y * v[r][j].y) + (v[r][j].z * v[r][j].z + v[r][j].w * v[r][j].w);
                const float rs = rsqrtf(wave_sum(ss) * (1.f / D) + EPS); if (lane == 0) RSD[r4 + r] = rs; } }
        f32x4 acc[3];
#pragma unroll
        for (int ct = 0; ct < 3; ++ct) acc[ct] = (f32x4){0.f, 0.f, 0.f, 0.f};
#pragma unroll 1
        for (int kc = 0; kc < 8; ++kc) { const int c = kc * 128 + 2 * lane;
            const f32x2 gg = *(const GAS f32x2*)(n2g + c), sh = *(const GAS f32x2*)(mb + 3 * 1024 + c), sc = *(const GAS f32x2*)(mb + 4 * 1024 + c);
            f32x2 xv[16];
#pragma unroll
            for (int r = 0; r < 16; ++r) { const unsigned w = *(const GAS unsigned*)(X + (size_t)(m0 + r) * D + c); xv[r].x = __uint_as_float(w << 16); xv[r].y = __uint_as_float(w & 0xffff0000u); }
            LDS_WAIT();
#pragma unroll
            for (int r = 0; r < 16; ++r) { const float rs = RSD[r]; const float y0 = xv[r].x * rs * gg.x * (1.f + sc.x) + sh.x, y1 = xv[r].y * rs * gg.y * (1.f + sc.y) + sh.y;
                const unsigned hi = pk2(y0, y1); const float l0 = y0 - bf2f(hi & 0xffffu), l1 = y1 - bf2f(hi >> 16);
                *(GAS unsigned*)(H + (size_t)(m0 + r) * D + c) = hi;
                *(LAS unsigned*)(Ah + r * AP + 2 * lane) = hi; *(LAS unsigned*)(Al + r * AP + 2 * lane) = pk2(l0, l1); }
            LDS_WAIT(); asm volatile("" ::: "memory");
            const int fr = lane & 15, fq = lane >> 4;
#pragma unroll
            for (int ks = 0; ks < 4; ++ks) { const bf16x8 ah = *(const LAS bf16x8*)(Ah + fr * AP + ks * 32 + fq * 8), al = *(const LAS bf16x8*)(Al + fr * AP + ks * 32 + fq * 8);
                bf16x8 bh[3], bl[3];
#pragma unroll
                for (int ct = 0; ct < 3; ++ct) { const size_t bo = (size_t)(ct * 16 + fr) * 1024 + kc * 128 + ks * 32 + fq * 8; bh[ct] = *(const GAS bf16x8*)(WRh + bo); bl[ct] = *(const GAS bf16x8*)(WRl + bo); }
                asm volatile("s_waitcnt vmcnt(0)" : "+v"(bh[0]), "+v"(bh[1]), "+v"(bh[2]), "+v"(bl[0]), "+v"(bl[1]), "+v"(bl[2]) :: "memory");
#pragma unroll
                for (int ct = 0; ct < 3; ++ct) {
                    acc[ct] = __builtin_amdgcn_mfma_f32_16x16x32_bf16(ah, bh[ct], acc[ct], 0, 0, 0);
                    acc[ct] = __builtin_amdgcn_mfma_f32_16x16x32_bf16(ah, bl[ct], acc[ct], 0, 0, 0);
                    acc[ct] = __builtin_amdgcn_mfma_f32_16x16x32_bf16(al, bh[ct], acc[ct], 0, 0, 0); } }
        }
#pragma unroll
        for (int ct = 0; ct < 3; ++ct)
#pragma unroll
            for (int j = 0; j < 4; ++j) LG[(4 * (lane >> 4) + j) * 48 + ct * 16 + (lane & 15)] = acc[ct][j];
        LDS_WAIT(); asm volatile("" ::: "memory");
        if (lane < 16) { const LAS float* lg = LG + lane * 48; const int m = m0 + lane;
            float gl[4]; int gsel = 0;
#pragma unroll
            for (int i = 0; i < 4; ++i) gl[i] = lg[i] + brg[i];
            float gmax = gl[0];
#pragma unroll
            for (int i = 1; i < 4; ++i) if (gl[i] > gmax) { gmax = gl[i]; gsel = i; }
            float den = 0.f;
#pragma unroll
            for (int i = 0; i < 4; ++i) den += __expf(gl[i] - gmax);
            const float pg = 1.f / den;
            float e1 = -INFINITY, e2 = -INFINITY; int i1 = 0, i2 = 0;
#pragma unroll 1
            for (int i = 0; i < 8; ++i) { const float ev = lg[4 + gsel * 8 + i] + bre[gsel * 8 + i];
                if (ev > e1) { e2 = e1; i2 = i1; e1 = ev; i1 = i; } else if (ev > e2) { e2 = ev; i2 = i; } }
            const float x2 = __expf(e2 - e1), w1 = pg / (1.f + x2), w2 = pg * x2 / (1.f + x2);
            const int ex1 = gsel * 8 + i1, ex2 = gsel * 8 + i2;
            const int p1 = (int)__hip_atomic_fetch_add(cnt + ex1 * 64, 1u, __ATOMIC_RELAXED, __HIP_MEMORY_SCOPE_AGENT), p2 = (int)__hip_atomic_fetch_add(cnt + ex2 * 64, 1u, __ATOMIC_RELAXED, __HIP_MEMORY_SCOPE_AGENT);
            EID[m * 2] = ex1; EID[m * 2 + 1] = ex2; GATE[m * 2] = w1; GATE[m * 2 + 1] = w2; POS[m * 2] = p1; POS[m * 2 + 1] = p2;
            RIDX[(size_t)ex1 * MOE_CAP + p1] = m; RIDX[(size_t)ex2 * MOE_CAP + p2] = m; }
        LDS_WAIT(); asm volatile("" ::: "memory");
    }
}
DI void ph_gemm_gu(const Ctx& cx, int l) {
    TIDS; GAS unsigned char* ws = cx.ws(); LAS unsigned char* lds = (LAS unsigned char*)lds_raw;
    LAS int* moe_off = (LAS int*)(lds + MISC_OFF + 64 * 4); LAS int* moe_te = (LAS int*)(lds + MISC_OFF + 128 * 4);
    const int nT = moe_tables((const GAS unsigned*)(ws + WS_CTL) + CW_CNT + l * 32 * 64, moe_off, moe_te, tid);
    pg8::Gemm g{(const GAS bf16*)(ws + WS_H), (const GAS bf16*)(ws + WS_WTGU + (size_t)l * 32 * 512 * D * 2), nT * 256, 512, D};
    const int vc = (G % 8 == 0) ? (bid % 8) * (G / 8) + bid / 8 : bid;
    pg8::GroupedPublish S{{nT, 2, G, vc, moe_te, (size_t)512 * D * 2}, (GAS unsigned*)(ws + WS_CTL) + CW_GUC + l * MOE_MAXT * 64};
    pg8::EpiGateUp E{(GAS bf16*)(ws + WS_ACT), (unsigned)(MOE_MAXT * 256 * 256 * 2)};
    LAS int* ridx_l = (LAS int*)(lds + MISC_OFF + 4096);
    { const GAS unsigned* cntp = (const GAS unsigned*)(ws + WS_CTL) + CW_CNT + l * 32 * 64; const GAS int* RIDX = (const GAS int*)(ws + WS_RIDX);
        const int vcl = (G % 8 == 0) ? (bid % 8) * (G / 8) + bid / 8 : bid; const int i = tid >> 8, r = tid & 255, L = vcl + i * G;
        if (L < nT * 2) { const int pm = L >> 1, e = moe_te[pm], slot = pm * 256 - moe_off[e] + r; ridx_l[i * 256 + r] = slot < (int)cntp[e * 64] ? RIDX[(size_t)e * MOE_CAP + slot] : 0; }
        __syncthreads(); }
    pg8::MoeRows RM{ridx_l, vc >> 1};
    pg8::gemm_phase(lds, g, S, E, RM);
}
DI void ph_gemm_dn(const Ctx& cx, int l) {
    TIDS; GAS unsigned char* ws = cx.ws(); LAS unsigned char* lds = (LAS unsigned char*)lds_raw;
    LAS int* moe_off = (LAS int*)(lds + MISC_OFF + 64 * 4); LAS int* moe_te = (LAS int*)(lds + MISC_OFF + 128 * 4);
    const int nT = moe_tables((const GAS unsigned*)(ws + WS_CTL) + CW_CNT + l * 32 * 64, moe_off, moe_te, tid);
    pg8::Gemm g{(const GAS bf16*)(ws + WS_ACT), (const GAS bf16*)(ws + WS_WTDN + (size_t)l * 32 * D * 256 * 2), nT * 256, D, 256};
    pg8::EpiStoreBf16 E{(GAS bf16*)(ws + WS_XS), D};
    const GAS unsigned* ready = (const GAS unsigned*)(ws + WS_CTL) + CW_GUC + l * MOE_MAXT * 64;
    const int vc = (G % 8 == 0) ? (bid % 8) * (G / 8) + bid / 8 : bid;
    const int nb2 = (nT * 2 > G && nT * 2 - G < G / 2) ? nT * 2 - G : 0, Gd = G - nb2, cd = vc - nb2;
    const int pmE = nb2 ? G / 2 : nT, nE = pmE * 4, nL = (nT - pmE) * 4;
    const int cl = cd < 0 ? -1 : (cd - nE % Gd + Gd) % Gd;
    pg8::GroupedOrder S1{pmE, 4, Gd, cd, moe_te, (size_t)D * 256 * 2, 0};
    pg8::GroupedOrder S2{nT - pmE, 4, Gd, cl, moe_te, (size_t)D * 256 * 2, pmE};
    { pg8::Unit u;
#pragma unroll 1
      for (int i = 0; S1.next(i, u); ++i) pg8::wait_rowtile(ready, u.pm, 16u); }
    pg8::gemm_phase(lds, g, S1, E);
    if (nL > 0) { pg8::Unit u;
#pragma unroll 1
      for (int i = 0; S2.next(i, u); ++i) pg8::wait_rowtile(ready, u.pm, 16u);
      pg8::gemm_phase(lds, g, S2, E); }
}
DI void ph_combine(const Ctx& cx, int l) {
    TIDS; GAS unsigned char* ws = cx.ws(); LAS unsigned char* lds = (LAS unsigned char*)lds_raw;
    LAS int* moe_off = (LAS int*)(lds + MISC_OFF + 64 * 4); LAS int* moe_te = (LAS int*)(lds + MISC_OFF + 128 * 4);
    const int m_lo = (l == 0) ? 0 : NCTX;
    moe_tables((const GAS unsigned*)(ws + WS_CTL) + CW_CNT + l * 32 * 64, moe_off, moe_te, tid);
    const GAS int* EID = (const GAS int*)(ws + WS_MOE); const GAS float* GATE = (const GAS float*)(ws + WS_MOE) + MTOK * 2; const GAS int* POS = (const GAS int*)(ws + WS_MOE) + MTOK * 4;
    const GAS bf16* YS = (const GAS bf16*)(ws + WS_XS); GAS bf16* X = (GAS bf16*)(ws + WS_X); GAS bf16* H = (GAS bf16*)(ws + WS_H);
    const GAS float* MODB = (const GAS float*)(ws + WS_MOD); const GAS float* MOD = MODB + (size_t)l * 5 * 6144;
    const GAS float* n1g1 = cx.in(I_N1G) + D; const GAS float* fng = cx.in(I_FNG); GAS float* outp = cx.out();
#pragma unroll 1
    for (int m = m_lo + gw; m < MTOK; m += NGW) {
        const int d0 = moe_off[EID[m * 2]] + POS[m * 2], d1 = moe_off[EID[m * 2 + 1]] + POS[m * 2 + 1];
        const float w0 = GATE[m * 2], w1 = GATE[m * 2 + 1];
        const GAS float* mb = MOD + (size_t)bidx_of_row(m) * 6144;
        f32x4 v[4];
#pragma unroll
        for (int j = 0; j < 4; ++j) { const int c = 4 * lane + 256 * j;
            const v2u a0 = *(const GAS v2u*)(YS + (size_t)d0 * D + c), a1 = *(const GAS v2u*)(YS + (size_t)d1 * D + c);
            f32x4 y; y.x = w0 * bf2f(a0.x & 0xffffu) + w1 * bf2f(a1.x & 0xffffu); y.y = w0 * bf2f(a0.x >> 16) + w1 * bf2f(a1.x >> 16);
            y.z = w0 * bf2f(a0.y & 0xffffu) + w1 * bf2f(a1.y & 0xffffu); y.w = w0 * bf2f(a0.y >> 16) + w1 * bf2f(a1.y >> 16);
            const f32x4 g5 = *(const GAS f32x4*)(mb + 5 * 1024 + c);
            v[j] = bf4f(*(const GAS v2u*)(X + (size_t)m * D + c)) + g5 * y; }
        if (l == 0) {
#pragma unroll
            for (int j = 0; j < 4; ++j) *(GAS v2u*)(X + (size_t)m * D + 4 * lane + 256 * j) = f4bf(v[j]);
            const GAS float* mb1 = MODB + (size_t)(5 + bidx_of_row(m)) * 6144;
            norm_row_store(v, n1g1, mb1, mb1 + 1024, H + (size_t)m * D, lane);
        } else {
            float ss = 0.f;
#pragma unroll
            for (int j = 0; j < 4; ++j) ss += (v[j].x * v[j].x + v[j].y * v[j].y) + (v[j].z * v[j].z + v[j].w * v[j].w);
            const float rstd = rsqrtf(wave_sum(ss) * (1.f / D) + EPS);
#pragma unroll
            for (int j = 0; j < 4; ++j) { const int c = 4 * lane + 256 * j; const f32x4 gg = *(const GAS f32x4*)(fng + c);
                *(GAS f32x4*)(outp + (size_t)(m - NCTX) * D + c) = v[j] * rstd * gg; }
        }
    }
}

#ifndef PH_MASK
#define PH_MASK 0xFFF
#endif
#define PHON(j) (((PH_MASK) >> (j)) & 1)
__global__ void __launch_bounds__(512, 2) fwd_kernel(Args args) {
    LAS unsigned char* lds = (LAS unsigned char*)lds_raw;
    volatile LAS unsigned* MISC = (volatile LAS unsigned*)(lds + MISC_OFF);
    {
        const int tid = threadIdx.x;
        for (int u = tid; u < (LDS_BYTES - MISC_OFF) / 4; u += 512) MISC[u] = 0u;
        __syncthreads();
        if (tid == 0) { volatile LAS unsigned long long* t = (volatile LAS unsigned long long*)(lds + PTR_OFF);
#pragma unroll
            for (int i = 0; i < N_IN; ++i) t[i] = (unsigned long long)args.in[i];
            t[N_IN] = (unsigned long long)args.out; t[N_IN + 1] = (unsigned long long)args.ws; }
        __syncthreads();
    }
    const Ctx cx;
#if MK_ONE_LAUNCH
    XcdBarrier bar = xcd_barrier_post((unsigned*)(cx.ws() + WS_CTL) + CW_BAR, MISC + 8);
#define GRID_BAR() xcd_barrier(bar)
#else
#define GRID_BAR() do { } while (0)
#endif
    const int lo = args.ph_lo, hi = args.ph_hi;
#define IN(k) (lo <= (k) && (k) < hi)
#define BOTH(k) (IN(k) && IN((k) + 1))
    if (PHON(0) && IN(0)) { TIDS; phase_prologue(cx, lds, tid, lane, wave, bid, G); if (BOTH(0)) GRID_BAR(); }
    if (PHON(1) && IN(1)) { TIDS; phase_norm1_l0(cx, lane, gw, NGW); if (BOTH(1)) GRID_BAR(); }
#define LAYER(L) { constexpr int l = L; constexpr int pb = 2 + 10 * l; \
        if (PHON(2) && IN(pb + 0)) { ph_gemm_in(cx, l); if (BOTH(pb + 0)) GRID_BAR(); } \
        if (PHON(3) && IN(pb + 1)) { ph_prep_r1(cx, l); if (BOTH(pb + 1)) GRID_BAR(); } \
        if (PHON(4) && IN(pb + 2)) { rec_r2(cx, blockIdx.x * 512 + threadIdx.x, gridDim.x * 512); if (BOTH(pb + 2)) GRID_BAR(); } \
        if (PHON(5) && IN(pb + 3)) { ph_mixers(cx, l); if (BOTH(pb + 3)) GRID_BAR(); } \
        if (PHON(6) && IN(pb + 4)) { ph_gemm_out(cx, l); if (BOTH(pb + 4)) GRID_BAR(); } \
        if (PHON(7) && IN(pb + 5)) { ph_router(cx, l); if (BOTH(pb + 5)) GRID_BAR(); } \
        if (PHON(9) && IN(pb + 7)) { ph_gemm_gu(cx, l);   } \
        if (PHON(10) && IN(pb + 8)) { ph_gemm_dn(cx, l); if (BOTH(pb + 8)) GRID_BAR(); } \
        if (PHON(11) && IN(pb + 9)) { ph_combine(cx, l); if (BOTH(pb + 9)) GRID_BAR(); } }
    LAYER(0)
    LAYER(1)
#undef LAYER
#undef IN
#undef BOTH
}

constexpr int NPHASES = 22;
extern "C" void kernel_launch(void* const* d_in, const int* in_sizes, int n_in, void* d_out, int out_size, void* d_ws, size_t ws_size, hipStream_t stream) {
    static int grid = 0;
    if (grid == 0) {
        if (n_in != N_IN || out_size != NLAT * D || ws_size < WS_END) { fprintf(stderr, "kernel_launch: unexpected problem (n_in %d, out %d, ws %zu)\n", n_in, out_size, ws_size); grid = -1; return; }
        int dev = 0, cus = 0, per_cu = 0;
        if (hipGetDevice(&dev) != hipSuccess || hipDeviceGetAttribute(&cus, hipDeviceAttributeMultiprocessorCount, dev) != hipSuccess) { grid = -1; return; }
        if (hipFuncSetAttribute((const void*)fwd_kernel, hipFuncAttributeMaxDynamicSharedMemorySize, LDS_BYTES) != hipSuccess) { fprintf(stderr, "kernel_launch: hipFuncSetAttribute failed\n"); grid = -1; return; }
        if (hipOccupancyMaxActiveBlocksPerMultiprocessor(&per_cu, (const void*)fwd_kernel, 512, LDS_BYTES) != hipSuccess || per_cu < 1) fprintf(stderr, "kernel_launch: occupancy query reports %d\n", per_cu);
        (void)hipGetLastError();
        grid = cus;
    }
    if (grid < 0) return;
    (void)hipMemsetAsync((char*)d_ws + WS_CTL, 0, CTL_BYTES, stream);
    Args a{};
    for (int i = 0; i < N_IN; ++i) a.in[i] = (const float*)d_in[i];
    a.out = (float*)d_out; a.ws = (unsigned char*)d_ws;
#if MK_ONE_LAUNCH
    a.ph_lo = 0; a.ph_hi = NPHASES;
    hipLaunchKernelGGL(fwd_kernel, dim3(grid), dim3(512), LDS_BYTES, stream, a);
#else
    for (int p = 0; p < NPHASES; ++p) { a.ph_lo = p; a.ph_hi = p + 1; hipLaunchKernelGGL(fwd_kernel, dim3(grid), dim3(512), LDS_BYTES, stream, a); }
#endif
}
```

```cpp
#include <hip/hip_runtime.h>
#include <cstdio>
#include <cstdint>

#ifndef MK_ONE_LAUNCH
#define MK_ONE_LAUNCH 1
#endif

#define DI __device__ __forceinline__
#define GAS __attribute__((address_space(1)))
#define LAS __attribute__((address_space(3)))
typedef unsigned short bf16;
typedef unsigned v4u __attribute__((ext_vector_type(4)));
typedef unsigned v2u __attribute__((ext_vector_type(2)));
typedef float f32x4 __attribute__((ext_vector_type(4)));
typedef short bf16x8 __attribute__((ext_vector_type(8)));
#define LDS_WAIT() asm volatile("s_waitcnt lgkmcnt(0)" ::: "memory")

constexpr int D = 1024, NB = 4, SEQ = 4096, LCTX = 256, NCTX = NB * LCTX, NLAT = NB * SEQ, MTOK = NCTX + NLAT;
constexpr int DIN = 3200, PP = 3328;
constexpr int CA_Q = 0, CA_I = 256, CA_FF = 512, CA_FB = 768, CA_G = 1024;
constexpr int CB_Q = 1280, CB_K = 1536, CB_V = 1792;
constexpr int CC_Q = 2048, CC_K = 2176, CC_V = 2304, CC_G = 2560, CC_ZF = 2816, CC_ZB = 2832;
constexpr int CD_Q = 2848, CD_KV = 3040, CD_R = 3168;
constexpr int NKEY = LCTX + SEQ;
constexpr int NCHUNK = NKEY / 64;
constexpr float EPS = 1e-6f;
constexpr float LOG2E = 1.4426950408889634f;
constexpr int MOE_MAXT = 168;
constexpr int MOE_CAP = 2 * 17408;

enum { I_X = 0, I_C, I_CTX, I_CCTX, I_WMOD, I_BMOD, I_N1G, I_N2G, I_WIN, I_WOUT, I_LBL, I_HNG, I_RPB, I_WGF, I_BGF, I_WGB, I_BGB, I_GNG, I_QNG, I_WUQ, I_KVNG, I_WUKV,
       I_WRG, I_BRG, I_WRE, I_BRE, I_WGU, I_WDN, I_FNG, N_IN };

constexpr size_t MiB = 1u << 20;
constexpr size_t WS_CTL = 0, CTL_BYTES = 2 * MiB;
constexpr size_t WS_WTIN = 2 * MiB;
constexpr size_t WTIN_L = (size_t)PP * D * 2;
constexpr size_t WS_WTOUT = 16 * MiB;
constexpr size_t WS_WTUQ = 20 * MiB;
constexpr size_t WS_WTUKV = WS_WTUQ + 512 * 1024;
constexpr size_t WS_MOD = 21 * MiB;
constexpr size_t WS_WR = WS_MOD + 512 * 1024;
constexpr size_t WS_WTGU = 22 * MiB;
constexpr size_t WS_WTDN = 86 * MiB;
constexpr size_t WS_X = 118 * MiB;
constexpr size_t WS_H = 186 * MiB;
constexpr size_t WS_CAT = 220 * MiB;
constexpr size_t WS_P = 254 * MiB;
constexpr size_t WS_XS = WS_P;
constexpr size_t WS_ACT = 338 * MiB;
constexpr size_t WS_QM = 366 * MiB;
constexpr size_t WS_KM = 379 * MiB;
constexpr size_t WS_VM = 392 * MiB;
constexpr size_t WS_RSH = 401 * MiB;
constexpr size_t WS_RSG = 435 * MiB;
constexpr size_t WS_RAH = 452 * MiB;
constexpr size_t WS_RAG = WS_RAH + 600 * 1024;
constexpr size_t WS_MOE = 453 * MiB;
constexpr size_t WS_VNT = 454 * MiB;
constexpr size_t WS_RIDX = 463 * MiB;
constexpr size_t WS_END = 468 * MiB;
constexpr int CW_BAR = 4096;
constexpr int CW_CNT = 16384;
constexpr int CW_GUC = 32768;
constexpr int CW_TMO = 64;

constexpr int RING_BYTES = 131072;
constexpr int MISC_OFF = RING_BYTES;
constexpr int LDS_BYTES = 147456;

DI float bf2f(unsigned v) { return __uint_as_float(v << 16); }
DI unsigned f2bf(float f) { unsigned u = __float_as_uint(f); return (u + 0x7fffu + ((u >> 16) & 1u)) >> 16; }
typedef __bf16 bf16v2 __attribute__((ext_vector_type(2)));
typedef float f32x2 __attribute__((ext_vector_type(2)));
DI unsigned pk2(float lo, float hi) { const f32x2 v = {lo, hi}; return __builtin_bit_cast(unsigned, __builtin_convertvector(v, bf16v2)); }
DI f32x4 bf4f(v2u w) { f32x4 r; r.x = __uint_as_float(w.x << 16); r.y = __uint_as_float(w.x & 0xffff0000u); r.z = __uint_as_float(w.y << 16); r.w = __uint_as_float(w.y & 0xffff0000u); return r; }
DI v2u f4bf(f32x4 v) { return (v2u){pk2(v.x, v.y), pk2(v.z, v.w)}; }
DI bf16x8 pack8(float a0, float a1, float a2, float a3, float a4, float a5, float a6, float a7) {
    v4u p; p.x = pk2(a0, a1); p.y = pk2(a2, a3); p.z = pk2(a4, a5); p.w = pk2(a6, a7);
    return __builtin_bit_cast(bf16x8, p);
}
DI float wave_sum(float v) {
#pragma unroll
    for (int o = 1; o < 64; o <<= 1) v += __shfl_xor(v, o);
    return v;
}
DI float frcp_(float x) { return __builtin_amdgcn_rcpf(x); }
DI float sigmoid_(float x) { return frcp_(1.f + __expf(-x)); }
DI float silu_(float x) { return x * frcp_(1.f + __expf(-x)); }
DI float logsigmoid_(float x) { return fminf(x, 0.f) - __logf(1.f + __expf(-fabsf(x))); }
DI void unpack8(v4u w, float* f) {
    f[0] = __uint_as_float(w.x << 16); f[1] = __uint_as_float(w.x & 0xffff0000u);
    f[2] = __uint_as_float(w.y << 16); f[3] = __uint_as_float(w.y & 0xffff0000u);
    f[4] = __uint_as_float(w.z << 16); f[5] = __uint_as_float(w.z & 0xffff0000u);
    f[6] = __uint_as_float(w.w << 16); f[7] = __uint_as_float(w.w & 0xffff0000u);
}
DI int bidx_of_row(int m) { return m < NCTX ? 4 : ((m - NCTX) >> 12); }

namespace pg8 {
#define PG8_LAS __attribute__((address_space(3)))
typedef unsigned short bf16_t;
typedef unsigned u32x4 __attribute__((ext_vector_type(4)));
constexpr int BM = 256, BK = 64, HALF = 128, HTB = HALF * BK * 2, STAGE_BYTES = 8 * HTB, NXCD = 8, WGM = 8;
__host__ __device__ __forceinline__ int lds_byte(int r, int c) { const int st = (r >> 4) * 2 + (c >> 5), rr = r & 15, cc = c & 31, ob = rr * 64 + cc * 2; return st * 1024 + (ob ^ (((ob >> 9) & 1) << 5)); }
__host__ __device__ __forceinline__ void stage_rc(int b, int& R, int& C) { const int st = b / 1024, sb = b % 1024, swz = sb ^ (((sb >> 9) & 1) << 5); R = (st >> 1) * 16 + swz / 64; C = (st & 1) * 32 + (swz % 64) / 2; }
__host__ __device__ __forceinline__ int perm32(int rho) { const int n = rho >> 4, i = rho & 15; return 8 * (i >> 2) + 4 * n + (i & 3); }
struct Unit { int pm, pn; size_t bo; };
struct LinearRows { static constexpr bool LINEAR = true; __device__ __forceinline__ int operator()(const Unit& u, int r) const { return u.pm * BM + r; } };
struct MoeRows { static constexpr bool LINEAR = false; const PG8_LAS int* idx; int pm0;
    __device__ __forceinline__ int operator()(const Unit& u, int r) const { return idx[(u.pm == pm0 ? 0 : 256) + r]; } };
struct Gemm { const GAS bf16_t* A; const GAS bf16_t* Bt; int M, N, K; };
struct StaticOrder {
    int nM, nN, nwg, G, c;
    __device__ void init(int M, int N, int G_, int c_) { nM = M / BM; nN = N / BM; nwg = nM * nN; G = G_; c = c_; }
    __device__ bool next(int i, Unit& u) const {
        const long L = (long)i * G + c; if (L >= nwg) return false;
        int wgid = (int)L; { const int q = nwg / NXCD, r = nwg % NXCD, xcd = wgid % NXCD, off = wgid / NXCD; wgid = (xcd < r ? xcd * (q + 1) : r * (q + 1) + (xcd - r) * q) + off; }
        const int nig = WGM * nN, gid = wgid / nig, fm = gid * WGM, gsz = (nM - fm) < WGM ? (nM - fm) : WGM;
        u.pm = fm + ((wgid % nig) % gsz); u.pn = (wgid % nig) / gsz; u.bo = 0; return true;
    }
    __device__ __forceinline__ void a_ready(const Unit&) const {}
    __device__ __forceinline__ void done(const Unit&) const {}
};
struct GroupedOrder {
    int nT, nN, G, c; const PG8_LAS int* tile_e; size_t estride; int pm0 = 0;
    __device__ bool next(int i, Unit& u) const {
        if (c < 0) return false;
        const long L = (long)i * G + c; if (L >= (long)nT * nN) return false;
        u.pm = pm0 + (int)(L / nN); u.pn = (int)(L % nN); u.bo = (size_t)__builtin_amdgcn_readfirstlane(tile_e[u.pm]) * estride; return true;
    }
    __device__ __forceinline__ void a_ready(const Unit&) const {}
    __device__ __forceinline__ void done(const Unit&) const {}
};
struct GroupedPublish : GroupedOrder { GAS unsigned* done_cnt;
    __device__ __forceinline__ void done(const Unit& u) const { asm volatile("s_waitcnt vmcnt(0)" ::: "memory");
        if ((threadIdx.x & 63) == 0) __hip_atomic_fetch_add(done_cnt + 64 * u.pm, 1u, __ATOMIC_RELAXED, __HIP_MEMORY_SCOPE_AGENT); } };
__device__ __forceinline__ void wait_rowtile(const GAS unsigned* ready, int pm, unsigned need) {
    if (threadIdx.x < 64) {
        unsigned spins = 0;
        while ((unsigned)__builtin_amdgcn_readfirstlane(__hip_atomic_load(ready + 64 * pm, __ATOMIC_RELAXED, __HIP_MEMORY_SCOPE_AGENT)) < need && ++spins < (1u << 22)) __builtin_amdgcn_s_sleep(2);
        __builtin_amdgcn_fence(__ATOMIC_ACQUIRE, "agent");
        asm volatile("s_waitcnt vmcnt(0)" ::: "memory");
    }
    __syncthreads();
}
__device__ __forceinline__ unsigned cvt_pk_bf16(float lo, float hi) { unsigned r; asm volatile("v_cvt_pk_bf16_f32 %0, %1, %2" : "=v"(r) : "v"(lo), "v"(hi)); return r; }

struct EpiStoreBf16 {
    static constexpr bool PERM = true;
    GAS bf16_t* O; int ldc;
    __device__ __forceinline__ void operator()(const f32x4 (&acc)[2][2][4][2], const Unit& u, int wr, int wc, int fr, int fq) const {
        const int row0 = u.pm * BM + wr * 64 + fr, col0 = u.pn * BM + wc * 32 + 8 * fq;
#pragma unroll
        for (int ai = 0; ai < 2; ++ai)
#pragma unroll
            for (int m = 0; m < 4; ++m) { GAS bf16_t* rowp = O + (size_t)(row0 + ai * HALF + m * 16) * ldc + col0;
#pragma unroll
                for (int bj = 0; bj < 2; ++bj) { const f32x4 v0 = acc[ai][bj][m][0], v1 = acc[ai][bj][m][1];
                    u32x4 w; w.x = cvt_pk_bf16(v0[0], v0[1]); w.y = cvt_pk_bf16(v0[2], v0[3]); w.z = cvt_pk_bf16(v1[0], v1[1]); w.w = cvt_pk_bf16(v1[2], v1[3]);
                    *(GAS u32x4*)(rowp + bj * HALF) = w; } }
    }
};
struct EpiResid {
    static constexpr bool PERM = false;
    GAS bf16_t* X; int row_off; const GAS float* mod;
    const GAS float* src_ctx; const GAS float* src_lat;
    __device__ __forceinline__ void operator()(const f32x4 (&acc)[2][2][4][2], const Unit& u, int wr, int wc, int fr, int fq) const {
        const int row0 = row_off + u.pm * BM + wr * 64 + fr, col0 = u.pn * BM + wc * 32 + 4 * fq;
#pragma unroll
        for (int ai = 0; ai < 2; ++ai)
#pragma unroll
            for (int m = 0; m < 4; ++m) { const int row = row0 + ai * HALF + m * 16; GAS bf16_t* rowp = X + (size_t)row * D + col0; const GAS float* gp = mod + (size_t)bidx_of_row(row) * 6144 + col0;
                const GAS float* bp = src_lat ? (row < NCTX ? src_ctx + (size_t)row * D + col0 : src_lat + (size_t)(row - NCTX) * D + col0) : (const GAS float*)nullptr;
#pragma unroll
                for (int bj = 0; bj < 2; ++bj)
#pragma unroll
                    for (int n = 0; n < 2; ++n) { const f32x4 g = *(const GAS f32x4*)(gp + bj * HALF + n * 16);
                        f32x4 x = src_lat ? *(const GAS f32x4*)(bp + bj * HALF + n * 16) : bf4f(*(const GAS v2u*)(rowp + bj * HALF + n * 16));
                        x = x + g * acc[ai][bj][m][n]; *(GAS v2u*)(rowp + bj * HALF + n * 16) = f4bf(x); } }
    }
};
struct EpiGateUp {
    static constexpr bool PERM = true;
    GAS bf16_t* O; unsigned nbytes;
    __device__ __forceinline__ void operator()(const f32x4 (&acc)[2][2][4][2], const Unit& u, int wr, int wc, int fr, int fq) const {
        const int row0 = u.pm * BM + wr * 64 + fr, col0 = u.pn * HALF + wc * 32 + 8 * fq;
        const __amdgpu_buffer_rsrc_t rsrc = __builtin_amdgcn_make_buffer_rsrc((void*)O, 0, (int)nbytes, 0x00020000);
#pragma unroll
        for (int ai = 0; ai < 2; ++ai)
#pragma unroll
            for (int m = 0; m < 4; ++m) { const unsigned off = (unsigned)((row0 + ai * HALF + m * 16) * 256 + col0) * 2u;
                float r[8];
#pragma unroll
                for (int n = 0; n < 2; ++n)
#pragma unroll
                    for (int j = 0; j < 4; ++j) { const float g = acc[ai][0][m][n][j], up = acc[ai][1][m][n][j]; r[n * 4 + j] = g * __builtin_amdgcn_rcpf(1.f + __expf(-g)) * up; }
                u32x4 w; w.x = cvt_pk_bf16(r[0], r[1]); w.y = cvt_pk_bf16(r[2], r[3]); w.z = cvt_pk_bf16(r[4], r[5]); w.w = cvt_pk_bf16(r[6], r[7]);
                __builtin_amdgcn_raw_buffer_store_b128(w, rsrc, (int)off, 0, 16); }
    }
};

template <class Epi, class Sched, class Rows = LinearRows>
__device__ __forceinline__ void gemm_phase(PG8_LAS unsigned char* lds, const Gemm g, const Sched& S, const Epi& E, const Rows RM = Rows()) {
    const int tid = threadIdx.x, wid = __builtin_amdgcn_readfirstlane(tid >> 6), lane = tid & 63, wr = wid >> 2, wc = wid & 3, fr = lane & 15, fq = lane >> 4;
    const int K = g.K, nt = K / BK;
    unsigned voffB[2]; int rA[2], cA2[2];
#pragma unroll
    for (int i = 0; i < 2; ++i) { int R, C; stage_rc(tid * 16 + i * 8192, R, C); const int Rb = Epi::PERM ? ((R & ~31) + perm32(R & 31)) : R;
        rA[i] = R; cA2[i] = C * 2; voffB[i] = (unsigned)(Rb * K + C) * 2u; }
    unsigned oAc[2][2], oAn[2][2];
#define PG8_AOFF(dst, u) do { _Pragma("unroll") for (int _h = 0; _h < 2; ++_h) _Pragma("unroll") for (int _i = 0; _i < 2; ++_i) dst[_h][_i] = (unsigned)RM(u, _h * HALF + rA[_i]) * (unsigned)(K * 2) + (unsigned)cA2[_i]; } while (0)
#define PG8_STAGE_A(bufoff, o2, kbyte) do { _Pragma("unroll") for (int _i = 0; _i < 2; ++_i) \
        __builtin_amdgcn_global_load_lds((const unsigned*)((const char*)g.A + (size_t)(kbyte) + (o2)[_i]), (PG8_LAS unsigned*)(lds + (bufoff) + ldsw + _i * 8192), 16, 0, 0); } while (0)
    const size_t kstep = (size_t)(BK * 2);
    const size_t hstep = (size_t)HALF * K * 2;
    const size_t tstep = 2 * hstep;
    const unsigned ldsw = (unsigned)wid * 1024u;
    const int aoff = lds_byte(wr * 64 + fr, fq * 8), boff = lds_byte(wc * 32 + fr, fq * 8);
#define PG8_SA(b, h) (((b) * 2 + (h)) * HTB)
#define PG8_SB(b, h) ((4 + (b) * 2 + (h)) * HTB)
#define PG8_STAGE(bufoff, gbase, voff) do { _Pragma("unroll") for (int _i = 0; _i < 2; ++_i) \
        __builtin_amdgcn_global_load_lds((const unsigned*)((const char*)(gbase) + (voff)[_i]), (PG8_LAS unsigned*)(lds + (bufoff) + ldsw + _i * 8192), 16, 0, 0); } while (0)
#define PG8_LDA(dst, b, h) do { _Pragma("unroll") for (int m = 0; m < 4; ++m) _Pragma("unroll") for (int k = 0; k < 2; ++k) dst[m][k] = *(const PG8_LAS bf16x8*)(lds + PG8_SA(b, h) + aoff + m * 2048 + k * 1024); } while (0)
#define PG8_LDB(dst, b, h) do { _Pragma("unroll") for (int n = 0; n < 2; ++n) _Pragma("unroll") for (int k = 0; k < 2; ++k) dst[n][k] = *(const PG8_LAS bf16x8*)(lds + PG8_SB(b, h) + boff + n * 2048 + k * 1024); } while (0)
#define PG8_MMA(ai, bj, At, Bt) do { __builtin_amdgcn_s_setprio(1); _Pragma("unroll") for (int m = 0; m < 4; ++m) _Pragma("unroll") for (int n = 0; n < 2; ++n) _Pragma("unroll") for (int k = 0; k < 2; ++k) \
        acc[ai][bj][m][n] = __builtin_amdgcn_mfma_f32_16x16x32_bf16(Bt[n][k], At[m][k], acc[ai][bj][m][n], 0, 0, 0); __builtin_amdgcn_s_setprio(0); } while (0)
#define PG8_WAIT_V(n) asm volatile("s_waitcnt vmcnt(" #n ")" ::: "memory")
#define PG8_WAIT_L(n) asm volatile("s_waitcnt lgkmcnt(" #n ")" ::: "memory")
#define PG8_BAR __builtin_amdgcn_s_barrier()
#define PG8_SCHED __builtin_amdgcn_sched_barrier(0)
    Unit cur, nxt; int ui = 0;
    if (!S.next(0, cur)) return;
    f32x4 acc[2][2][4][2];
#pragma unroll
    for (int a = 0; a < 2; ++a)
#pragma unroll
        for (int b = 0; b < 2; ++b)
#pragma unroll
            for (int m = 0; m < 4; ++m)
#pragma unroll
                for (int n = 0; n < 2; ++n) acc[a][b][m][n] = (f32x4){0.f, 0.f, 0.f, 0.f};
    bf16x8 At[4][2], B0[2][2], B1[2][2];
    const char* cB = (const char*)g.Bt + cur.bo + (size_t)cur.pn * tstep;
    S.a_ready(cur);
    PG8_AOFF(oAc, cur);
    PG8_STAGE(PG8_SB(0, 0), cB, voffB); PG8_STAGE_A(PG8_SA(0, 0), oAc[0], 0); PG8_STAGE(PG8_SB(0, 1), cB + hstep, voffB); PG8_STAGE_A(PG8_SA(0, 1), oAc[1], 0);
    if (wr == 1) PG8_BAR;
    PG8_WAIT_V(4); PG8_BAR;
    PG8_STAGE(PG8_SB(1, 0), cB + kstep, voffB); PG8_STAGE_A(PG8_SA(1, 0), oAc[0], kstep); PG8_STAGE(PG8_SB(1, 1), cB + hstep + kstep, voffB);
    PG8_WAIT_V(6); PG8_BAR;
    for (;;) {
        const bool has_next = S.next(ui + 1, nxt);
        const char* nB = has_next ? (const char*)g.Bt + nxt.bo + (size_t)nxt.pn * tstep : cB;
        unsigned dAn = 0u;
        if constexpr (Rows::LINEAR) { if (has_next) dAn = (unsigned)(nxt.pm - cur.pm) * (unsigned)(BM * K * 2); }
        else { if (has_next) PG8_AOFF(oAn, nxt);
            else {
#pragma unroll
                for (int _h = 0; _h < 2; ++_h)
#pragma unroll
                    for (int _i = 0; _i < 2; ++_i) oAn[_h][_i] = oAc[_h][_i]; } }
        for (int t = 0; t < nt; t += 2) {
            const bool last = (t == nt - 2);
            const size_t k1 = (size_t)(t + 1) * kstep, k2 = last ? 0 : (size_t)(t + 2) * kstep, k3 = k2 + kstep;
            unsigned o20[2], o21[2];
#pragma unroll
            for (int _i = 0; _i < 2; ++_i) { if constexpr (Rows::LINEAR) { o20[_i] = oAc[0][_i] + (last ? dAn : 0u); o21[_i] = oAc[1][_i] + (last ? dAn : 0u); }
                else { o20[_i] = last ? oAn[0][_i] : oAc[0][_i]; o21[_i] = last ? oAn[1][_i] : oAc[1][_i]; } }
            const char* b2 = last ? nB : cB + (size_t)(t + 2) * kstep;
            const char* b3 = b2 + kstep;
            if (last && has_next) S.a_ready(nxt);
            PG8_LDB(B0, 0, 0); PG8_SCHED; PG8_LDA(At, 0, 0); PG8_STAGE_A(PG8_SA(1, 1), oAc[1], k1);
            PG8_WAIT_L(8); PG8_BAR; PG8_WAIT_L(0); PG8_MMA(0, 0, At, B0); PG8_BAR; PG8_SCHED;
            PG8_LDB(B1, 0, 1); PG8_STAGE(PG8_SB(0, 0), b2, voffB);
            PG8_BAR; PG8_WAIT_L(0); PG8_MMA(0, 1, At, B1); PG8_BAR;
            PG8_LDA(At, 0, 1); PG8_STAGE_A(PG8_SA(0, 0), o20, k2);
            PG8_BAR; PG8_WAIT_L(0); PG8_MMA(1, 0, At, B0); PG8_BAR; PG8_SCHED;
            PG8_STAGE(PG8_SB(0, 1), b2 + hstep, voffB);
            PG8_WAIT_V(6); PG8_BAR; PG8_MMA(1, 1, At, B1); PG8_BAR;
            PG8_LDB(B0, 1, 0); PG8_SCHED; PG8_LDA(At, 1, 0); PG8_STAGE_A(PG8_SA(0, 1), o21, k2);
            PG8_WAIT_L(8); PG8_BAR; PG8_WAIT_L(0); PG8_MMA(0, 0, At, B0); PG8_BAR; PG8_SCHED;
            PG8_LDB(B1, 1, 1); PG8_STAGE(PG8_SB(1, 0), b3, voffB);
            PG8_BAR; PG8_WAIT_L(0); PG8_MMA(0, 1, At, B1); PG8_BAR;
            PG8_LDA(At, 1, 1); PG8_STAGE_A(PG8_SA(1, 0), o20, k3);
            PG8_BAR; PG8_WAIT_L(0); PG8_MMA(1, 0, At, B0); PG8_BAR; PG8_SCHED;
            PG8_STAGE(PG8_SB(1, 1), b3 + hstep, voffB);
            PG8_WAIT_V(6); PG8_BAR; PG8_MMA(1, 1, At, B1); PG8_BAR;
        }
        E(acc, cur, wr, wc, fr, fq); S.done(cur);
        if (!has_next) break;
#pragma unroll
        for (int a = 0; a < 2; ++a)
#pragma unroll
            for (int b = 0; b < 2; ++b)
#pragma unroll
                for (int m = 0; m < 4; ++m)
#pragma unroll
                    for (int n = 0; n < 2; ++n) acc[a][b][m][n] = (f32x4){0.f, 0.f, 0.f, 0.f};
        cur = nxt; cB = nB; ++ui;
#pragma unroll
        for (int _h = 0; _h < 2; ++_h)
#pragma unroll
            for (int _i = 0; _i < 2; ++_i) { if constexpr (Rows::LINEAR) oAc[_h][_i] += dAn; else oAc[_h][_i] = oAn[_h][_i]; }
    }
    PG8_WAIT_V(0);
    if (wr == 0) PG8_BAR;
    PG8_BAR;
#undef PG8_SA
#undef PG8_SB
#undef PG8_STAGE
#undef PG8_STAGE_A
#undef PG8_AOFF
#undef PG8_LDA
#undef PG8_LDB
#undef PG8_MMA
#undef PG8_WAIT_V
#undef PG8_WAIT_L
#undef PG8_BAR
#undef PG8_SCHED
}
}

#define XB_TMO      128
#define XB_XCNT(j)  (256  + 64 * (j))
#define XB_XSUB(j)  (1280 + 64 * (j))
#define XB_XGEN(j)  (2304 + 64 * (j))
#define XB_TOP      3328
#define XB_TOPGEN   3392
#define XCD_BAR_WORDS 3456
#define XB_SPIN_CAP (1u << 18)
__device__ __forceinline__ unsigned xb_ld(unsigned* p)              { return __hip_atomic_load(p, __ATOMIC_RELAXED, __HIP_MEMORY_SCOPE_AGENT); }
__device__ __forceinline__ unsigned xb_add(unsigned* p, unsigned v) { return __hip_atomic_fetch_add(p, v, __ATOMIC_RELAXED, __HIP_MEMORY_SCOPE_AGENT); }
__device__ __forceinline__ unsigned xb_xcc_id() { return (unsigned)__builtin_amdgcn_s_getreg((3 << 11) | 20) & 0xFu; }
#define XB_SPIN(cond, bar) do { unsigned _sp = 0; while (cond) { __builtin_amdgcn_s_sleep(1); \
    if ((++_sp & 255u) == 0u) { if (xb_ld(&(bar)[XB_TMO])) break; if (_sp > XB_SPIN_CAP) { atomicAdd(&(bar)[XB_TMO], 1u); break; } } } } while (0)
struct XcdBarrier { unsigned* bar; unsigned x; volatile LAS unsigned* st; };
__device__ __forceinline__ XcdBarrier xcd_barrier_post(unsigned* bar, volatile LAS unsigned* st) {
    XcdBarrier b; b.bar = bar; b.x = xb_xcc_id(); b.st = st;
    if (threadIdx.x == 0) (void)xb_add(&bar[XB_XCNT(b.x)], 1u);
    return b;
}
__device__ __forceinline__ void xcd_barrier_complete(unsigned* bar, unsigned x, unsigned& nloc, unsigned& nx) {
    const unsigned G = gridDim.x * gridDim.y * gridDim.z;
    unsigned sum, cnt, mine, sp = 0u;
    for (;;) {
        sum = 0u; cnt = 0u; mine = 0u;
#pragma unroll
        for (unsigned j = 0; j < 16; ++j) { const unsigned c = xb_ld(&bar[XB_XCNT(j)]); sum += c; cnt += (c > 0u) ? 1u : 0u; mine = (j == x) ? c : mine; }
        if (sum == G) break;
        __builtin_amdgcn_s_sleep(1);
        if ((++sp & 255u) == 0u) { if (xb_ld(&bar[XB_TMO])) break; if (sp > XB_SPIN_CAP) { atomicAdd(&bar[XB_TMO], 1u); break; } }
    }
    nloc = mine > 0u ? mine : 1u; nx = cnt > 0u ? cnt : 1u;
}
__device__ __forceinline__ void xcd_barrier(const XcdBarrier& b) {
    asm volatile("s_waitcnt vmcnt(0)" ::: "memory");
    __syncthreads();
    if (threadIdx.x == 0) {
        unsigned* bar = b.bar;
        __builtin_amdgcn_s_waitcnt(0);
        unsigned nloc = b.st[0], nx = b.st[1];
        if (nloc == 0u) { xcd_barrier_complete(bar, b.x, nloc, nx); b.st[0] = nloc; b.st[1] = nx; }
        const unsigned old = xb_add(&bar[XB_XSUB(b.x)], 1u);
        const unsigned gen = old / nloc;
        if (old + 1u == (gen + 1u) * nloc) {
            __builtin_amdgcn_fence(__ATOMIC_RELEASE, "agent");
            asm volatile("s_waitcnt vmcnt(0)" ::: "memory");
            const unsigned og = xb_add(&bar[XB_TOP], 1u);
            const unsigned tg = og / nx;
            if (og + 1u == (tg + 1u) * nx) xb_add(&bar[XB_TOPGEN], 1u);
            else XB_SPIN(xb_ld(&bar[XB_TOPGEN]) == tg, bar);
            __builtin_amdgcn_fence(__ATOMIC_ACQUIRE, "agent");
            xb_add(&bar[XB_XGEN(b.x)], 1u);
            asm volatile("s_waitcnt vmcnt(0)" ::: "memory");
        } else {
            XB_SPIN(xb_ld(&bar[XB_XGEN(b.x)]) == gen, bar);
            __builtin_amdgcn_fence(__ATOMIC_ACQUIRE, "agent");
            asm volatile("s_waitcnt vmcnt(0)" ::: "memory");
        }
    }
    __syncthreads();
}

struct Args { const float* in[N_IN]; float* out; unsigned char* ws; int ph_lo, ph_hi; int pad0, pad1; };
extern __shared__ __attribute__((aligned(16))) unsigned char lds_raw[];
constexpr int PTR_OFF = MISC_OFF + 2048;
struct Ctx {
    DI unsigned long long raw(int i) const { volatile LAS unsigned* t = (volatile LAS unsigned*)((LAS unsigned char*)lds_raw + PTR_OFF) + 2 * i;
        const unsigned lo = __builtin_amdgcn_readfirstlane(t[0]), hi = __builtin_amdgcn_readfirstlane(t[1]); return ((unsigned long long)hi << 32) | lo; }
    DI const GAS float* in(int i) const { return (const GAS float*)raw(i); }
    DI GAS float* out() const { return (GAS float*)raw(N_IN); }
    DI GAS unsigned char* ws() const { return (GAS unsigned char*)raw(N_IN + 1); }
};

DI void transpose_item(const GAS float* W, int N, int k0, int n0, GAS bf16* WT, int Kd, int drow0, LAS float* scr, int lane) {
    float wv[32];
#pragma unroll
    for (int i = 0; i < 32; ++i) wv[i] = W[(size_t)(k0 + 2 * i + (lane >> 5)) * N + n0 + (lane & 31)];
#pragma unroll
    for (int i = 0; i < 32; ++i) scr[(2 * i + (lane >> 5)) * 33 + (lane & 31)] = wv[i];
    LDS_WAIT(); asm volatile("" ::: "memory");
    const int c = lane & 7;
#pragma unroll
    for (int j = 0; j < 4; ++j) { const int n = (lane >> 3) + 8 * j; const LAS float* s = scr + (8 * c) * 33 + n;
        v4u o; o.x = pk2(s[0 * 33], s[1 * 33]); o.y = pk2(s[2 * 33], s[3 * 33]); o.z = pk2(s[4 * 33], s[5 * 33]); o.w = pk2(s[6 * 33], s[7 * 33]);
        *(GAS v4u*)(WT + (size_t)(drow0 + n) * Kd + k0 + 8 * c) = o; }
    LDS_WAIT(); asm volatile("" ::: "memory");
}

DI void weight_copies(const Ctx& a, int l, LAS unsigned char* lds, int tid, int lane, int wave, int gwv, int ngw, int gt, int ngt) {
    GAS unsigned char* ws = a.ws();
    for (int i = gt; i < 128 * 1024 / 8; i += ngt) *(GAS v4u*)(ws + WS_WTIN + (size_t)l * WTIN_L + (size_t)3200 * D * 2 + (size_t)i * 16) = (v4u){0u, 0u, 0u, 0u};
    LAS float* scr = (LAS float*)(lds + wave * 16384);
    constexpr int IT_IN = 16 * 100, IT_OUT = 16 * 32, IT_UQ = 3 * 12, IT_UKV = 2 * 16, IT_GU = 32 * 16 * 16, IT_DN = 32 * 4 * 32;
    constexpr int NITEMS = IT_IN + IT_OUT + IT_UQ + IT_UKV + IT_GU + IT_DN;
    for (int it = gwv; it < NITEMS; it += ngw) {
        int r = it;
        if (r < IT_IN) { const int kb = r / 100, nb = r % 100;
            transpose_item(a.in(I_WIN) + (size_t)l * D * DIN, DIN, kb * 64, nb * 32, (GAS bf16*)(ws + WS_WTIN + (size_t)l * WTIN_L), D, nb * 32, scr, lane); continue; } r -= IT_IN;
        if (r < IT_OUT) { const int kb = r / 32, nb = r % 32;
            transpose_item(a.in(I_WOUT) + (size_t)l * D * D, D, kb * 64, nb * 32, (GAS bf16*)(ws + WS_WTOUT + (size_t)l * D * D * 2), D, nb * 32, scr, lane); continue; } r -= IT_OUT;
        if (r < IT_UQ) { const int kb = r / 12, nb = r % 12;
            transpose_item(a.in(I_WUQ) + (size_t)l * 192 * 384, 384, kb * 64, nb * 32, (GAS bf16*)(ws + WS_WTUQ + (size_t)l * 384 * 192 * 2), 192, nb * 32, scr, lane); continue; } r -= IT_UQ;
        if (r < IT_UKV) { const int kb = r / 16, nb = r % 16;
            transpose_item(a.in(I_WUKV) + (size_t)l * 128 * 512, 512, kb * 64, nb * 32, (GAS bf16*)(ws + WS_WTUKV + (size_t)l * 512 * 128 * 2), 128, nb * 32, scr, lane); continue; } r -= IT_UKV;
        if (r < IT_GU) { const int le = l * 32 + r / 256, q = r % 256, kb = q / 16, nb = q % 16; const int n0 = nb * 32, c0 = n0 & 255, isup = n0 >> 8;
            const int drow0 = (c0 >> 7) * 256 + isup * 128 + (c0 & 127);
            transpose_item(a.in(I_WGU) + (size_t)le * D * 512, 512, kb * 64, n0, (GAS bf16*)(ws + WS_WTGU + (size_t)le * 512 * D * 2), D, drow0, scr, lane); continue; } r -= IT_GU;
        { const int le = l * 32 + r / 128, q = r % 128, kb = q / 32, nb = q % 32;
            transpose_item(a.in(I_WDN) + (size_t)le * 256 * D, D, kb * 64, nb * 32, (GAS bf16*)(ws + WS_WTDN + (size_t)le * D * 256 * 2), 256, nb * 32, scr, lane); }
    }
}

DI void phase_prologue(const Ctx& a, LAS unsigned char* lds, int tid, int lane, int wave, int bid, int G) {
    GAS unsigned char* ws = a.ws();
    GAS float* MOD = (GAS float*)(ws + WS_MOD);
    {
        LAS float* S = (LAS float*)lds;
        LAS float* R = (LAS float*)(lds + 5 * 1024 * 4);
        if (bid < 192) {
            const GAS float* cvec = a.in(I_C); const GAS float* cctx = a.in(I_CCTX);
            for (int i = tid; i < 5 * 1024; i += 512) { const int r = i >> 10, k = i & 1023; const float v = r < 4 ? cvec[r * 1024 + k] : cctx[k]; S[i] = silu_(v); }
        }
        __syncthreads();
        for (int u = bid; u < 192; u += G) {
            const int l = u / 96, cl = tid & 63, n = (u % 96) * 64 + cl, ks = tid >> 6;
            const GAS float* W = a.in(I_WMOD) + (size_t)l * 1024 * 6144 + n; const GAS float* bmod = a.in(I_BMOD);
            float acc[5] = {0.f, 0.f, 0.f, 0.f, 0.f};
            for (int k = ks * 128; k < ks * 128 + 128; ++k) { const float w = W[(size_t)k * 6144];
#pragma unroll
                for (int r = 0; r < 5; ++r) acc[r] += S[r * 1024 + k] * w; }
#pragma unroll
            for (int r = 0; r < 5; ++r) R[(ks * 5 + r) * 64 + cl] = acc[r];
            __syncthreads();
            if (tid < 320) { const int r = tid >> 6; float s = 0.f;
#pragma unroll
                for (int k2 = 0; k2 < 8; ++k2) s += R[(k2 * 5 + r) * 64 + cl];
                MOD[(size_t)(l * 5 + r) * 6144 + n] = s + bmod[l * 6144 + n]; }
            __syncthreads();
        }
    }
    for (int i = bid * 512 + tid; i < 2 * 48 * 1024; i += G * 512) { const int l = i / (48 * 1024), r = i % (48 * 1024), c = r >> 10, k = r & 1023;
        const float w = c < 4 ? a.in(I_WRG)[(size_t)l * D * 4 + k * 4 + c] : (c < 36 ? a.in(I_WRE)[(size_t)l * D * 32 + k * 32 + (c - 4)] : 0.f);
        const unsigned hi = f2bf(w); const float lo = w - bf2f(hi);
        GAS bf16* WR = (GAS bf16*)(ws + WS_WR) + (size_t)l * 2 * 48 * 1024;
        WR[c * 1024 + k] = (bf16)hi; WR[48 * 1024 + c * 1024 + k] = (bf16)f2bf(lo); }
    weight_copies(a, 0, lds, tid, lane, wave, bid * 8 + wave, G * 8, bid * 512 + tid, G * 512);
}

DI void norm_row_store(const f32x4 (&v)[4], const GAS float* g, const GAS float* shift, const GAS float* scale, GAS bf16* hrow, int lane) {
    float ss = 0.f;
#pragma unroll
    for (int j = 0; j < 4; ++j) ss += (v[j].x * v[j].x + v[j].y * v[j].y) + (v[j].z * v[j].z + v[j].w * v[j].w);
    const float rstd = rsqrtf(wave_sum(ss) * (1.f / D) + EPS);
#pragma unroll
    for (int j = 0; j < 4; ++j) { const int c = 4 * lane + 256 * j;
        const f32x4 gg = *(const GAS f32x4*)(g + c), sh = *(const GAS f32x4*)(shift + c), sc = *(const GAS f32x4*)(scale + c);
        const f32x4 y = v[j] * rstd * gg * (1.f + sc) + sh;
        v2u o; o.x = pk2(y.x, y.y); o.y = pk2(y.z, y.w); *(GAS v2u*)(hrow + c) = o; }
}

DI void phase_norm1_l0(const Ctx& a, int lane, int gw, int NGW) {
    GAS unsigned char* ws = a.ws(); GAS bf16* H = (GAS bf16*)(ws + WS_H); const GAS float* MOD = (const GAS float*)(ws + WS_MOD);
    const GAS float* xin = a.in(I_X); const GAS float* cin = a.in(I_CTX); const GAS float* n1g = a.in(I_N1G);
    for (int m = gw; m < MTOK; m += NGW) {
        const GAS float* src = m < NCTX ? cin + (size_t)m * D : xin + (size_t)(m - NCTX) * D;
        f32x4 v[4];
#pragma unroll
        for (int j = 0; j < 4; ++j) v[j] = *(const GAS f32x4*)(src + 4 * lane + 256 * j);
        const GAS float* mb = MOD + (size_t)bidx_of_row(m) * 6144;
        norm_row_store(v, n1g, mb, mb + 1024, H + (size_t)m * D, lane);
    }
}

DI bf16x8 ld8(const LAS bf16* p) { return *(const LAS bf16x8*)p; }
DI bf16x8 ld8(const GAS bf16* p) { return *(const GAS bf16x8*)p; }
template <class PA, class PB>
DI f32x4 mma16(PA A, int lda, PB B, int ldb, int K, int lane) {
    f32x4 acc = {0.f, 0.f, 0.f, 0.f};
    const int r = lane & 15, q = (lane >> 4) * 8;
    for (int k = 0; k < K; k += 32) {
        const bf16x8 av = ld8(A + r * lda + k + q);
        const bf16x8 bv = ld8(B + r * ldb + k + q);
        acc = __builtin_amdgcn_mfma_f32_16x16x32_bf16(av, bv, acc, 0, 0, 0);
    }
    return acc;
}

constexpr int CQ_P = 200, CKV_P = 136, STG_P = 520;
constexpr int PR = 64, PL_CQ = 0, PL_CKV = 25600, PL_RK = 43008, PL_STG = 47104, PL_T = PL_STG;
DI float rope_ang(int t, int ri) { const int ax = ri >> 4, f = ri & 7; const float p = (float)(ax == 0 ? (t >> 6) : (t & 63)); return p * __builtin_amdgcn_exp2f(-1.6609640474436813f * (float)f) * 0.15915494309189535f; }
DI void prep_unit(const Ctx& a, int l, int unit, LAS unsigned char* lds, int tid, int lane, int wave) {
    GAS unsigned char* ws = a.ws();
    const GAS bf16* P = (const GAS bf16*)(ws + WS_P);
    LAS bf16* CQ = (LAS bf16*)(lds + PL_CQ); LAS bf16* CKV = (LAS bf16*)(lds + PL_CKV); LAS bf16* STG = (LAS bf16*)(lds + PL_STG); LAS bf16* RK = (LAS bf16*)(lds + PL_RK); LAS bf16* T = (LAS bf16*)(lds + PL_T);
    const int m0 = unit * PR;
    const bool isctx = m0 < NCTX;
    const int bb = isctx ? (m0 >> 8) : ((m0 - NCTX) >> 12);
    const int pos0 = isctx ? (m0 & 255) : (256 + ((m0 - NCTX) & 4095));
    const int t0 = isctx ? 0 : ((m0 - NCTX) & 4095);
    { const GAS float* gq = a.in(I_QNG) + l * 192; const GAS float* gkv = a.in(I_KVNG) + l * 128;
        const bool isq = lane < 24, iskv = lane >= 24 && lane < 40; const int pc = isq ? lane : lane - 24;
        float gn[8];
#pragma unroll
        for (int e = 0; e < 8; ++e) gn[e] = isq ? gq[pc * 8 + e] : (iskv ? gkv[pc * 8 + e] : 0.f);
#pragma unroll
        for (int rr = 0; rr < PR / 8; ++rr) { const int r = wave * (PR / 8) + rr; float x[8];
            v4u w = (v4u){0u, 0u, 0u, 0u}; if (lane < 40) w = *(const GAS v4u*)(P + (size_t)(m0 + r) * PP + (isq ? CD_Q : CD_KV) + pc * 8);
            unpack8(w, x); float ss = 0.f;
#pragma unroll
            for (int e = 0; e < 8; ++e) ss += x[e] * x[e];
            const float sq = wave_sum(isq ? ss : 0.f), skv = wave_sum(iskv ? ss : 0.f);
            const float rs = isq ? rsqrtf(sq * (1.f / 192.f) + EPS) : rsqrtf(skv * (1.f / 128.f) + EPS);
#pragma unroll
            for (int e = 0; e < 8; ++e) x[e] *= rs * gn[e];
            const v4u o = (v4u){pk2(x[0], x[1]), pk2(x[2], x[3]), pk2(x[4], x[5]), pk2(x[6], x[7])};
            if (isq) *(LAS v4u*)(CQ + r * CQ_P + pc * 8) = o; else if (iskv) *(LAS v4u*)(CKV + r * CKV_P + pc * 8) = o; } }
    for (int e = tid; e < PR * 32; e += 512) { const int r = e >> 5, ri = e & 31; const GAS bf16* prow = P + (size_t)(m0 + r) * PP + CD_R;
        float v = bf2f(prow[ri]);
        if (!isctx) { const float pv = bf2f(prow[ri ^ 8]); const float ang = rope_ang(t0 + r, ri); const float cs = __builtin_amdgcn_cosf(ang), sn = __builtin_amdgcn_sinf(ang);
            v = ((ri >> 3) & 1) == 0 ? (v * cs - pv * sn) : (pv * sn + v * cs); }
        RK[r * 32 + ri] = (bf16)f2bf(v); }
    for (int e = tid; e < PR * 32; e += 512) { const int r = e >> 5, c8 = e & 31; *(LAS v4u*)(T + r * 264 + c8 * 8) = *(const GAS v4u*)(P + (size_t)(m0 + r) * PP + CB_V + c8 * 8); }
    __syncthreads();
    GAS bf16* QM = (GAS bf16*)(ws + WS_QM); GAS bf16* KM = (GAS bf16*)(ws + WS_KM); GAS bf16* VM = (GAS bf16*)(ws + WS_VM); GAS bf16* VNT = (GAS bf16*)(ws + WS_VNT);
    const GAS bf16* WTQ = (const GAS bf16*)(ws + WS_WTUQ + (size_t)l * 384 * 192 * 2);
    const GAS bf16* WTKV = (const GAS bf16*)(ws + WS_WTUKV + (size_t)l * 512 * 128 * 2);
    const float qs = 0.10206207261596575f * LOG2E;
    const int fr = lane & 15, fq = lane >> 4;
    for (int e = tid; e < 256 * (PR / 8); e += 512) { const int col = e / (PR / 8), p8 = e % (PR / 8); unsigned hv[8];
#pragma unroll
        for (int j = 0; j < 8; ++j) hv[j] = T[(p8 * 8 + j) * 264 + col];
        *(GAS v4u*)(VNT + ((size_t)(bb * 4) * 64 + col) * NKEY + pos0 + p8 * 8) = (v4u){hv[0] | (hv[1] << 16), hv[2] | (hv[3] << 16), hv[4] | (hv[5] << 16), hv[6] | (hv[7] << 16)}; }
    __syncthreads();
    { bf16x8 bfr[3][6];
#pragma unroll
      for (int i = 0; i < 3; ++i)
#pragma unroll
        for (int ks = 0; ks < 6; ++ks) bfr[i][ks] = *(const GAS bf16x8*)(WTQ + (size_t)((wave + 8 * i) * 16 + fr) * 192 + ks * 32 + fq * 8);
#pragma unroll
      for (int i = 0; i < 3; ++i) { const int nb = wave + 8 * i;
        const int c = nb * 16 + fr, within = c % 96;
#pragma unroll
        for (int mb = 0; mb < PR / 16; ++mb) { f32x4 acc = {0.f, 0.f, 0.f, 0.f};
#pragma unroll
            for (int ks = 0; ks < 6; ++ks) acc = __builtin_amdgcn_mfma_f32_16x16x32_bf16(*(const LAS bf16x8*)(CQ + (mb * 16 + fr) * CQ_P + ks * 32 + fq * 8), bfr[i][ks], acc, 0, 0, 0);
#pragma unroll
            for (int j = 0; j < 4; ++j) { const int r = mb * 16 + 4 * fq + j; float v = acc[j]; const float pv = __shfl_xor(v, 8);
                if (within >= 64 && !isctx) { const int ri = within - 64; const float ang = rope_ang(t0 + r, ri); const float cs = __builtin_amdgcn_cosf(ang), sn = __builtin_amdgcn_sinf(ang);
                    v = ((ri >> 3) & 1) == 0 ? (v * cs - pv * sn) : (pv * sn + v * cs); }
                STG[r * STG_P + c] = (bf16)f2bf(v * qs); } } } }
    __syncthreads();
    for (int e = tid; e < PR * 48; e += 512) { const int r = e / 48, hp = e % 48, hd = hp / 12, pc = hp % 12;
        *(GAS v4u*)(QM + ((size_t)(bb * 4 + hd) * NKEY + pos0 + r) * 96 + pc * 8) = *(const LAS v4u*)(STG + r * STG_P + hd * 96 + pc * 8); }
    __syncthreads();
    { bf16x8 bfr[4][4];
#pragma unroll
      for (int i = 0; i < 4; ++i)
#pragma unroll
        for (int ks = 0; ks < 4; ++ks) bfr[i][ks] = *(const GAS bf16x8*)(WTKV + (size_t)((wave + 8 * i) * 16 + fr) * 128 + ks * 32 + fq * 8);
#pragma unroll
      for (int i = 0; i < 4; ++i) { const int nb = wave + 8 * i;
#pragma unroll
        for (int mb = 0; mb < PR / 16; ++mb) { f32x4 acc = {0.f, 0.f, 0.f, 0.f};
#pragma unroll
            for (int ks = 0; ks < 4; ++ks) acc = __builtin_amdgcn_mfma_f32_16x16x32_bf16(*(const LAS bf16x8*)(CKV + (mb * 16 + fr) * CKV_P + ks * 32 + fq * 8), bfr[i][ks], acc, 0, 0, 0);
#pragma unroll
            for (int j = 0; j < 4; ++j) STG[(mb * 16 + 4 * fq + j) * STG_P + nb * 16 + fr] = (bf16)f2bf(acc[j]); } } }
    __syncthreads();
    for (int e = tid; e < PR * 48; e += 512) { const int r = e / 48, hp = e % 48, hd = hp / 12, pc = hp % 12;
        const v4u v = pc < 8 ? *(const LAS v4u*)(STG + r * STG_P + hd * 128 + pc * 8) : *(const LAS v4u*)(RK + r * 32 + (pc - 8) * 8);
        *(GAS v4u*)(KM + ((size_t)(bb * 4 + hd) * NKEY + pos0 + r) * 96 + pc * 8) = v; }
    for (int e = tid; e < 256 * (PR / 8); e += 512) { const int col = e / (PR / 8), p8 = e % (PR / 8), hd = col >> 6, dv = col & 63; unsigned hv[8];
#pragma unroll
        for (int j = 0; j < 8; ++j) hv[j] = STG[(p8 * 8 + j) * STG_P + hd * 128 + 64 + dv];
        *(GAS v4u*)(VM + ((size_t)(bb * 4 + hd) * 64 + dv) * NKEY + pos0 + p8 * 8) = (v4u){hv[0] | (hv[1] << 16), hv[2] | (hv[3] << 16), hv[4] | (hv[5] << 16), hv[6] | (hv[7] << 16)}; }
    __syncthreads();
}

constexpr int RP = 65;
DI int scan_row(int b, int dir, int c, int i) {
    const int s = 64 * c + i;
    if (dir == 0) return s < 256 ? b * 256 + s : NCTX + b * SEQ + (s - 256);
    return s < 256 ? b * 256 + 255 - s : NCTX + b * SEQ + SEQ - 1 - (s - 256);
}
#ifndef BAR_LDS
#define BAR_LDS() asm volatile("s_waitcnt lgkmcnt(0)\n\ts_barrier" ::: "memory")
#endif
constexpr int RC_P = 68;
constexpr int L_C = 0, L_QD = 17408, L_QE = 26624, L_KD = 35840, L_VT = 58880, L_ST = 68096, L_ATT = 77312, L_O = 86528, L_T = 103168;
template <int MIX> struct RecCfg { static constexpr int DK = MIX == 0 ? 64 : 32, DKP = DK + 8, NP = DK / 8, CPT = DK / 8; };
template <int MIX> struct RecPre {
    v4u fk;
    v4u zg[MIX == 1 ? 2 : 1];
    v4u qp;
    v4u vp; f32x4 s0, s1;
};
template <int MIX, bool R3>
DI void rec_fetch(RecPre<MIX>& R, const GAS bf16* P, const GAS float* RSbase, int b, int h, int dir, int c, int tid) {
    constexpr int DK = RecCfg<MIX>::DK;
    const int lane = tid & 63, wave = tid >> 6;
    const GAS bf16* prow = P + (size_t)scan_row(b, dir, c, lane) * PP;
    if (MIX == 0) { R.fk = *(const GAS v4u*)(prow + (dir ? CA_FB : CA_FF) + h * 64 + 8 * wave); if (R3) R.qp = *(const GAS v4u*)(prow + CA_Q + h * 64 + 8 * wave); }
    else { const GAS bf16* zr = prow + (dir ? CC_ZB : CC_ZF); R.zg[0] = *(const GAS v4u*)zr; R.zg[1] = *(const GAS v4u*)(zr + 8);
        const v2u kk = *(const GAS v2u*)(prow + CC_K + h * 32 + 4 * wave); R.fk = (v4u){kk.x, kk.y, 0u, 0u};
        if (R3) { const v2u qq = *(const GAS v2u*)(prow + CC_Q + h * 32 + 4 * wave); R.qp = (v4u){qq.x, qq.y, 0u, 0u}; } }
    R.vp = *(const GAS v4u*)(P + (size_t)scan_row(b, dir, c, tid >> 3) * PP + (MIX == 0 ? CA_I : CC_V) + h * 64 + (tid & 7) * 8);
    if (R3 && tid < DK * 8) { const GAS float* rs = RSbase + (size_t)(((b * 4 + h) * 2 + dir) * NCHUNK + c) * DK * 64 + (tid >> 3) * 64 + (tid & 7) * 8; R.s0 = *(const GAS f32x4*)rs; R.s1 = *(const GAS f32x4*)(rs + 4); }
}
DI float dpp_shr_(float v, int ctrl_sel) { const int iv = __builtin_bit_cast(int, v); int r;
    switch (ctrl_sel) { case 1: r = __builtin_amdgcn_update_dpp(0, iv, 0x111, 0xf, 0xf, true); break; case 2: r = __builtin_amdgcn_update_dpp(0, iv, 0x112, 0xf, 0xf, true); break;
                        case 4: r = __builtin_amdgcn_update_dpp(0, iv, 0x114, 0xf, 0xf, true); break; default: r = __builtin_amdgcn_update_dpp(0, iv, 0x118, 0xf, 0xf, true); break; }
    return __builtin_bit_cast(float, r); }
DI float scan64(float v) {
    v += dpp_shr_(v, 1); v += dpp_shr_(v, 2); v += dpp_shr_(v, 4); v += dpp_shr_(v, 8);
    v += __builtin_bit_cast(float, __builtin_amdgcn_update_dpp(0, __builtin_bit_cast(int, v), 0x142, 0xa, 0xf, false));
    v += __builtin_bit_cast(float, __builtin_amdgcn_update_dpp(0, __builtin_bit_cast(int, v), 0x143, 0xc, 0xf, false));
    return v; }
DI float lane_read(float v, int ln) { return __builtin_bit_cast(float, __builtin_amdgcn_readlane(__builtin_bit_cast(int, v), ln)); }
template <int MIX>
DI void rec_front(const RecPre<MIX>& R, const GAS float* lg, const GAS float* wgp, const GAS float* bgp, int l, int h, int dir, int wave, float (&kv)[RecCfg<MIX>::CPT], float (&cum)[RecCfg<MIX>::CPT]) {
    if (MIX == 0) { float z[8]; unpack8(R.fk, z);
#pragma unroll
        for (int e = 0; e < 8; ++e) { const int ch = h * 64 + 8 * wave + e; float lb = 0.f; if (l == 1) lb = sigmoid_(lg[512 + dir * 256 + ch] - lg[dir * 256 + ch]);
            const float f = lb + (1.f - lb) * sigmoid_(z[e]); cum[e] = scan64(__logf(f)); kv[e] = (1.f - lb) * sigmoid_(-z[e]); }
    } else { float z[16], kk[8]; unpack8(R.zg[0], z); unpack8(R.zg[1], z + 8); unpack8(R.fk, kk);
#pragma unroll
        for (int c = 0; c < 4; ++c) { const int ch = h * 32 + 4 * wave + c; float sacc = bgp[ch];
#pragma unroll
            for (int r = 0; r < 16; ++r) sacc += z[r] * wgp[r * 128 + ch];
            cum[c] = scan64(logsigmoid_(sacc) * (1.f / 16.f)); kv[c] = kk[c]; } }
}
template <int N> DI void st_bf16(LAS bf16* p, const float (&v)[N]) {
    if (N == 8) *(LAS v4u*)p = (v4u){pk2(v[0], v[1]), pk2(v[2], v[3]), pk2(v[4], v[5]), pk2(v[6], v[7])};
    else *(LAS v2u*)p = (v2u){pk2(v[0], v[1]), pk2(v[2], v[3])};
}
DI void rec_vt_store(const v4u vp, LAS bf16* VT, int tid) { const int j = tid >> 3, v8 = tid & 7; const unsigned ww[4] = {vp.x, vp.y, vp.z, vp.w};
#pragma unroll
    for (int e = 0; e < 8; ++e) VT[(v8 * 8 + e) * 72 + j] = (bf16)((ww[e >> 1] >> ((e & 1) * 16)) & 0xffffu); }

template <int MIX>
DI void rec_r1_run(const Ctx& a, int l, LAS unsigned char* lds, int tid, int bid, int G) {
    constexpr int DK = RecCfg<MIX>::DK, CPT = RecCfg<MIX>::CPT;
    const int lane = tid & 63, wave = __builtin_amdgcn_readfirstlane(tid >> 6);
    LAS bf16* KT = (LAS bf16*)(lds + L_KD); LAS bf16* VT = (LAS bf16*)(lds + L_VT);
    GAS unsigned char* wsb = a.ws(); const GAS bf16* P = (const GAS bf16*)(wsb + WS_P);
    GAS float* RSb = (GAS float*)(wsb + (MIX == 0 ? WS_RSH : WS_RSG)); GAS float* RAb = (GAS float*)(wsb + (MIX == 0 ? WS_RAH : WS_RAG));
    const GAS float* lg = a.in(I_LBL);
    const GAS float* wgF = a.in(I_WGF) + l * 16 * 128; const GAS float* wgB = a.in(I_WGB) + l * 16 * 128; const GAS float* bgF = a.in(I_BGF) + l * 128; const GAS float* bgB = a.in(I_BGB) + l * 128;
    constexpr int NU = 32 * NCHUNK;
    const bool rebal = (MIX == 0) && (G == 256);
    const int n0 = (rebal && bid < 16) ? 8 : 0, nn = (NU - 1 - bid) / G + 1, n1 = nn + ((rebal && bid >= 128) ? 1 : 0);
    auto unit_at = [&](int n) { if (n >= n1) return NU; if (n < nn) return bid + G * n; const int e = bid - 128; return (e & 15) + G * (e >> 4); };
    RecPre<MIX> Rs[2];
    int nidx = n0;
    int u0 = unit_at(nidx), u1 = unit_at(nidx + 1);
#pragma unroll
    for (int par = 0; par < 2; ++par) { const int unit = par ? u1 : u0; if (unit < NU) { const int c = unit % NCHUNK, chain = unit / NCHUNK; rec_fetch<MIX, false>(Rs[par], P, RSb, chain >> 3, (chain >> 1) & 3, chain & 1, c, tid); } }
    BAR_LDS();
#pragma unroll 1
    while (u0 < NU) {
        const int n2 = unit_at(nidx + 2), n3 = unit_at(nidx + 3);
#pragma unroll
        for (int par = 0; par < 2; ++par) { const int unit = par ? u1 : u0; if (unit < NU) { RecPre<MIX>& R = Rs[par];
            LAS bf16* KTp = par ? (LAS bf16*)(lds + L_ST) : KT; LAS bf16* VTp = par ? (LAS bf16*)(lds + L_ATT) : VT;
            const int c = unit % NCHUNK, chain = unit / NCHUNK, dir = chain & 1, h = (chain >> 1) & 3;
            { float kv[CPT], cum[CPT]; rec_front<MIX>(R, lg, dir ? wgB : wgF, dir ? bgB : bgF, l, h, dir, wave, kv, cum);
#pragma unroll
                for (int e = 0; e < CPT; ++e) { const float last = lane_read(cum[e], 63); KTp[(CPT * wave + e) * 72 + lane] = (bf16)f2bf(kv[e] * __expf(last - cum[e]));
                    if (lane == 63) RAb[(size_t)(chain * NCHUNK + c) * DK + CPT * wave + e] = __expf(cum[e]); } }
            rec_vt_store(R.vp, VTp, tid);
            { const int nu = par ? n3 : n2; if (nu < NU) { const int c2 = nu % NCHUNK, ch2 = nu / NCHUNK; rec_fetch<MIX, false>(R, P, RSb, ch2 >> 3, (ch2 >> 1) & 3, ch2 & 1, c2, tid); } } } }
        BAR_LDS();
#pragma unroll
        for (int par = 0; par < 2; ++par) { const int unit = par ? u1 : u0; if (unit < NU) {
            const LAS bf16* KTp = par ? (const LAS bf16*)(lds + L_ST) : KT; const LAS bf16* VTp = par ? (const LAS bf16*)(lds + L_ATT) : VT;
            const int c = unit % NCHUNK, chain = unit / NCHUNK;
            GAS float* RS = RSb + (size_t)(chain * NCHUNK + c) * DK * 64;
#pragma unroll 1
            for (int tl = wave; tl < (DK / 16) * 4; tl += 8) { const int kb = tl >> 2, vb = tl & 3;
                const f32x4 acc = mma16(KTp + kb * 16 * 72, 72, VTp + vb * 16 * 72, 72, 64, lane);
#pragma unroll
                for (int j = 0; j < 4; ++j) RS[(kb * 16 + 4 * (lane >> 4) + j) * 64 + vb * 16 + (lane & 15)] = acc[j]; } } }
        BAR_LDS();
        nidx += 2; u0 = n2; u1 = n3;
    }
}

DI void rec_r2(const Ctx& a, int gtid, int gthreads) {
    GAS unsigned char* wsb = a.ws();
#pragma unroll 1
    for (int e = gtid; e < 32 * 4096 + 32 * 2048; e += gthreads) {
        const bool g = e >= 32 * 4096; const int ee = g ? e - 32 * 4096 : e; const int DK = g ? 32 : 64, per = DK * 64;
        const int chain = ee / per, kv = ee % per, k = kv >> 6;
        GAS float* RS = (GAS float*)(wsb + (g ? WS_RSG : WS_RSH)) + (size_t)chain * NCHUNK * per + kv;
        const GAS float* RA = (const GAS float*)(wsb + (g ? WS_RAG : WS_RAH)) + (size_t)chain * NCHUNK * DK + k;
        float S = 0.f;
#pragma unroll 1
        for (int c = 0; c < NCHUNK; c += 4) { float U[4], A[4];
#pragma unroll
            for (int u = 0; u < 4; ++u) { U[u] = RS[(size_t)(c + u) * per]; A[u] = RA[(c + u) * DK]; }
#pragma unroll
            for (int u = 0; u < 4; ++u) { RS[(size_t)(c + u) * per] = S; S = A[u] * S + U[u]; } }
    }
}

template <int MIX>
DI void rec_r3_run(const Ctx& a, int l, LAS unsigned char* lds, int tid, int bid, int G, bool keep_ctx) {
    constexpr int DK = RecCfg<MIX>::DK, DKP = RecCfg<MIX>::DKP, CPT = RecCfg<MIX>::CPT;
    const int lane = tid & 63, wave = __builtin_amdgcn_readfirstlane(tid >> 6);
    LAS bf16* QD = (LAS bf16*)(lds + L_QD); LAS bf16* QE = (LAS bf16*)(lds + L_QE); LAS bf16* KD = (LAS bf16*)(lds + L_KD);
    LAS bf16* VT = (LAS bf16*)(lds + L_VT); LAS bf16* ST = (LAS bf16*)(lds + L_ST); LAS bf16* ATT = (LAS bf16*)(lds + L_ATT); LAS float* Ob = (LAS float*)(lds + L_O);
    GAS unsigned char* wsb = a.ws(); const GAS bf16* P = (const GAS bf16*)(wsb + WS_P); GAS bf16* CAT = (GAS bf16*)(wsb + WS_CAT);
    const GAS float* RSb = (const GAS float*)(wsb + (MIX == 0 ? WS_RSH : WS_RSG));
    const GAS float* lg = a.in(I_LBL); const GAS float* ngb = a.in(MIX == 0 ? I_HNG : I_GNG) + l * 256;
    const GAS float* wgF = a.in(I_WGF) + l * 16 * 128; const GAS float* wgB = a.in(I_WGB) + l * 16 * 128; const GAS float* bgF = a.in(I_BGF) + l * 128; const GAS float* bgB = a.in(I_BGB) + l * 128;
    constexpr int nR = 16 * NCHUNK;
    const int nAct = keep_ctx ? nR : 16 * 64, first = (bid + (MIX == 0 ? 0 : G - 64)) % G;
    auto unit_of = [&](int a) { return a >= nAct ? nR : (keep_ctx ? a : (a >> 6) * NCHUNK + 4 + (a & 63)); };
    auto scanc = [&](int tc, int dir) { return dir == 0 ? tc : (tc < 4 ? 3 - tc : 71 - tc); };
    RecPre<MIX> Rs[2];
    int aidx = first;
    int unit = unit_of(aidx);
    if (unit < nR) { const int tc = unit % NCHUNK, bh = unit / NCHUNK; rec_fetch<MIX, true>(Rs[0], P, RSb, bh >> 2, bh & 3, 0, scanc(tc, 0), tid); rec_fetch<MIX, true>(Rs[1], P, RSb, bh >> 2, bh & 3, 1, scanc(tc, 1), tid); }
    BAR_LDS();
#pragma unroll 1
    while (unit < nR) {
        const int tc = unit % NCHUNK, bh = unit / NCHUNK, h = bh & 3, b = bh >> 2;
        const int nunit = unit_of(aidx + G);
        v4u gatep = (v4u){0u, 0u, 0u, 0u};
#pragma unroll
        for (int dir = 0; dir < 2; ++dir) { RecPre<MIX>& R = Rs[dir];
            if (tid < DK * 8) { const int k = tid >> 3, v8 = tid & 7;
#pragma unroll
                for (int e = 0; e < 4; ++e) { ST[(v8 * 8 + e) * DKP + k] = (bf16)f2bf(R.s0[e]); ST[(v8 * 8 + 4 + e) * DKP + k] = (bf16)f2bf(R.s1[e]); } }
            rec_vt_store(R.vp, VT, tid);
            { const int ri = lane, I = ri >> 4; float kv[CPT], cm[CPT], qv[CPT], e8[CPT];
                rec_front<MIX>(R, lg, dir ? wgB : wgF, dir ? bgB : bgF, l, h, dir, wave, kv, cm);
                { float q8[8]; unpack8(R.qp, q8);
#pragma unroll
                    for (int e = 0; e < CPT; ++e) qv[e] = MIX == 0 ? silu_(q8[e]) * 0.125f : q8[e] * 0.17677669529663687f; }
#pragma unroll
                for (int e = 0; e < CPT; ++e) e8[e] = qv[e] * __expf(cm[e]);
                st_bf16<CPT>(QE + ri * DKP + CPT * wave, e8);
#pragma unroll
                for (int I2 = 0; I2 < 4; ++I2) {
                    float rf[CPT];
#pragma unroll
                    for (int e = 0; e < CPT; ++e) rf[e] = I2 == 0 ? 0.f : lane_read(cm[e], 16 * I2 - 1);
                    if (I2 >= I) {
                        if (I2 == I) {
#pragma unroll
                            for (int e = 0; e < CPT; ++e) e8[e] = qv[e] * __expf(cm[e] - rf[e]);
                            st_bf16<CPT>(QD + ri * DKP + CPT * wave, e8); }
#pragma unroll
                        for (int e = 0; e < CPT; ++e) e8[e] = kv[e] * __expf(fminf(rf[e] - cm[e], 80.f));
                        const int rowbase = I2 == 0 ? 0 : (I2 == 1 ? 16 : (I2 == 2 ? 48 : 96));
                        st_bf16<CPT>(KD + (rowbase + ri) * DKP + CPT * wave, e8); } } }
            if (dir == 0) {
                const int row = (tc < 4 ? b * 256 + tc * 64 : NCTX + b * SEQ + (tc - 4) * 64) + (tid >> 3);
                gatep = *(const GAS v4u*)(P + (size_t)row * PP + (MIX == 0 ? CA_G : CC_G) + h * 64 + (tid & 7) * 8); }
            if (nunit < nR) { const int tc2 = nunit % NCHUNK, bh2 = nunit / NCHUNK; rec_fetch<MIX, true>(R, P, RSb, bh2 >> 2, bh2 & 3, dir, scanc(tc2, dir), tid); }
            BAR_LDS();
            { const int I = wave >> 1, g = lane >> 4, c16 = lane & 15;
                const int rowbase = I == 0 ? 0 : (I == 1 ? 16 : (I == 2 ? 48 : 96));
                bf16x8 Bq[2];
#pragma unroll
                for (int m = 0; m < 2; ++m) {
                    f32x4 t0 = mma16(KD + (rowbase + 2 * m * 16) * DKP, DKP, QD + I * 16 * DKP, DKP, DK, lane);
                    f32x4 t1 = mma16(KD + (rowbase + (2 * m + 1) * 16) * DKP, DKP, QD + I * 16 * DKP, DKP, DK, lane);
#pragma unroll
                    for (int jj = 0; jj < 4; ++jj) { const bool up = 4 * g + jj > c16;
                        t0[jj] = (2 * m > I || (2 * m == I && up)) ? 0.f : t0[jj]; t1[jj] = (2 * m + 1 > I || (2 * m + 1 == I && up)) ? 0.f : t1[jj]; }
                    Bq[m] = pack8(t0[0], t0[1], t0[2], t0[3], t1[0], t1[1], t1[2], t1[3]); }
#pragma unroll
                for (int u = 0; u < 2; ++u) { const int vb = 2 * (wave & 1) + u; f32x4 acc = {0.f, 0.f, 0.f, 0.f};
#pragma unroll
                    for (int m = 0; m < 2; ++m) { const LAS bf16* vr = VT + (vb * 16 + c16) * 72 + 32 * m + 4 * g;
                        const v2u lo = *(const LAS v2u*)vr, hi = *(const LAS v2u*)(vr + 16);
                        acc = __builtin_amdgcn_mfma_f32_16x16x32_bf16(__builtin_bit_cast(bf16x8, (v4u){lo.x, lo.y, hi.x, hi.y}), Bq[m], acc, 0, 0, 0); }
                    const f32x4 acc2 = mma16(ST + vb * 16 * DKP, DKP, QE + I * 16 * DKP, DKP, DK, lane);
#pragma unroll
                    for (int jj = 0; jj < 4; ++jj) { const int i = I * 16 + c16, v = vb * 16 + 4 * g + jj; const float o = acc[jj] + acc2[jj];
                        if (dir == 0) Ob[i * RP + v] = o; else Ob[(63 - i) * RP + v] += o; } } }
            BAR_LDS();
        }
        { const int tl = tid >> 3, jg = tid & 7; float x[8]; float ss = 0.f;
#pragma unroll
            for (int vv = 0; vv < 8; ++vv) { x[vv] = Ob[tl * RP + jg * 8 + vv]; ss += x[vv] * x[vv]; }
            ss += __shfl_xor(ss, 1); ss += __shfl_xor(ss, 2); ss += __shfl_xor(ss, 4);
            const float rstd = rsqrtf(ss * (1.f / 64.f) + EPS);
            const int row = tc < 4 ? b * 256 + tc * 64 + tl : NCTX + b * SEQ + (tc - 4) * 64 + tl;
            const GAS float* ng = ngb + h * 64 + jg * 8;
            float gt[8]; unpack8(gatep, gt);
            float y[8];
#pragma unroll
            for (int vv = 0; vv < 8; ++vv) y[vv] = x[vv] * rstd * ng[vv] * silu_(gt[vv]);
            v4u ow; ow.x = pk2(y[0], y[1]); ow.y = pk2(y[2], y[3]); ow.z = pk2(y[4], y[5]); ow.w = pk2(y[6], y[7]);
            *(GAS v4u*)(CAT + (size_t)row * D + (MIX == 0 ? 0 : 512) + h * 64 + jg * 8) = ow; }
        unit = nunit; aidx += G;
    }
    __syncthreads();
}

typedef float f32x16 __attribute__((ext_vector_type(16)));
DI int swap23(int r) { return (r & 19) | ((r & 4) << 1) | ((r & 8) >> 1); }
struct AttnDesc {
    const GAS bf16* q; int qpitch;
    const GAS bf16* k; int kpitch;
    const GAS bf16* vt;
    GAS bf16* o; int opitch;
    int ntiles; float scale;
    int b, r0, rs0;
    const LAS float* rpb;
};
template <int DQK, bool NA>
DI void attn_mfma_unit(LAS unsigned char* lds, const AttnDesc& A, int tid, int lane, int wave) {
    constexpr int KP = DQK + 8, VP = 72, NS = DQK / 16, KPIECES = 64 * (DQK / 8);
    constexpr int BUF = 64 * KP * 2 + 64 * VP * 2;
    const int q = lane & 31, g = lane >> 5;
    auto tpos = [&](int t) { return NA ? (t < 4 ? 64 * t : 256 + 64 * (A.rs0 + t - 4)) : 64 * t; };
    auto krow = [&](int pos) { return NA ? (pos < 256 ? A.b * 256 + pos : NCTX + A.b * SEQ + (pos - 256)) : pos; };
    const int qi = NA ? (2 * (wave >> 2) + (q >> 4)) * 64 + 16 * (wave & 3) + (q & 15) : wave * 32 + q;
    const int kc0 = NA ? min(max(16 * (wave & 3) - 8, 0), 32) : 0;
    bf16x8 Qf[NS];
    { const GAS bf16* qp = A.q + (size_t)qi * A.qpitch + 8 * g;
#pragma unroll
        for (int s2 = 0; s2 < NS; ++s2) Qf[s2] = *(const GAS bf16x8*)(qp + 16 * s2); }
    f32x16 O[2];
#pragma unroll
    for (int db = 0; db < 2; ++db)
#pragma unroll
        for (int i = 0; i < 16; ++i) O[db][i] = 0.f;
    float mrun = -1e30f, lrun = 0.f;
    const int qr = NA ? A.r0 + (qi >> 6) : 0, qc = NA ? (qi & 63) : 0;
    const int wrs = NA ? min(max(qr - 4, 0), 56) : 0, cs = NA ? min(max(qc - 8, 0), 48) : 0;
    const int qr0 = NA ? A.r0 + 2 * (wave >> 2) : 0, wlo = NA ? min(max(qr0 - 4, 0), 56) : 0, whi = NA ? min(max(qr0 + 1 - 4, 0), 56) + 8 : 0;
    v4u kreg[2], vreg;
    auto gload = [&](int t) { const int pos = tpos(t);
#pragma unroll
        for (int u = 0; u < 2; ++u) { const int p = tid + 512 * u; if (p < KPIECES) { const int key = p / (DQK / 8), d8 = p % (DQK / 8); kreg[u] = *(const GAS v4u*)(A.k + (size_t)krow(pos + key) * A.kpitch + d8 * 8); } }
        vreg = *(const GAS v4u*)(A.vt + (size_t)(tid >> 3) * NKEY + pos + (tid & 7) * 8); };
    auto lstore = [&](int buf) { LAS bf16* Kt = (LAS bf16*)(lds + buf * BUF); LAS bf16* Vt = Kt + 64 * KP;
#pragma unroll
        for (int u = 0; u < 2; ++u) { const int p = tid + 512 * u; if (p < KPIECES) { const int key = p / (DQK / 8), d8 = p % (DQK / 8); *(LAS v4u*)(Kt + key * KP + d8 * 8) = kreg[u]; } }
        *(LAS v4u*)(Vt + (tid >> 3) * VP + (tid & 7) * 8) = vreg; };
    __syncthreads();
    gload(0); lstore(0);
    __syncthreads();
#pragma unroll 1
    for (int t = 0; t < A.ntiles; ++t) {
        const bool more = t + 1 < A.ntiles;
        if (more) gload(t + 1);
        bool active = true, rowok = true; int dr = 0;
        const bool win = NA && t >= 4;
        if (win) { const int wr = A.rs0 + t - 4; active = (wr >= wlo) && (wr < whi); rowok = (wr >= wrs) && (wr < wrs + 8); dr = min(max(wr - qr + 7, 0), 14); }
        if (active) {
            const LAS bf16* Kt = (const LAS bf16*)(lds + (t & 1) * BUF); const LAS bf16* Vt = Kt + 64 * KP;
            f32x16 S[2];
#pragma unroll
            for (int kb = 0; kb < 2; ++kb) {
#pragma unroll
                for (int i = 0; i < 16; ++i) S[kb][i] = 0.f;
                if (win && kb == 1) continue;
                const LAS bf16* kp = Kt + ((win ? kc0 : kb * 32) + swap23(q)) * KP + 8 * g;
#pragma unroll
                for (int s2 = 0; s2 < NS; ++s2) { const bf16x8 a = *(const LAS bf16x8*)(kp + 16 * s2); S[kb] = __builtin_amdgcn_mfma_f32_32x32x16_bf16(a, Qf[s2], S[kb], 0, 0, 0); }
            }
            float mx = -INFINITY;
            if (NA) {
                if (win) {
#pragma unroll
                    for (int i = 0; i < 16; ++i) { const int kc = kc0 + 16 * (i >> 3) + 8 * g + (i & 7); const int dc = min(max(kc - qc, -15), 15) + 15;
                        const float bv = A.rpb[dr * 31 + dc]; const float sv = (rowok && kc >= cs && kc < cs + 16) ? S[0][i] * A.scale + bv : -INFINITY;
                        S[0][i] = sv; mx = fmaxf(mx, sv); }
                } else {
#pragma unroll
                    for (int kb = 0; kb < 2; ++kb)
#pragma unroll
                        for (int i = 0; i < 16; ++i) { const float sv = S[kb][i] * A.scale; S[kb][i] = sv; mx = fmaxf(mx, sv); }
                }
            } else {
#pragma unroll
                for (int kb = 0; kb < 2; ++kb)
#pragma unroll
                    for (int i = 0; i < 16; ++i) mx = fmaxf(mx, S[kb][i]);
            }
            mx = fmaxf(mx, __shfl_xor(mx, 32));
            const float mn = fmaxf(mrun, mx), alpha = __builtin_amdgcn_exp2f(mrun - mn);
            mrun = mn;
            if (__any(alpha != 1.f)) { lrun *= alpha;
#pragma unroll
                for (int db = 0; db < 2; ++db)
#pragma unroll
                    for (int i = 0; i < 16; ++i) O[db][i] *= alpha; }
            bf16x8 Pf[4];
#pragma unroll
            for (int ks = 0; ks < 4; ++ks) { if (win && ks >= 2) continue; const int kb = ks >> 1, o8 = (ks & 1) * 8; float p[8];
#pragma unroll
                for (int j = 0; j < 8; ++j) { p[j] = __builtin_amdgcn_exp2f(S[kb][o8 + j] - mn); lrun += p[j]; }
                Pf[ks] = pack8(p[0], p[1], p[2], p[3], p[4], p[5], p[6], p[7]); }
#pragma unroll
            for (int db = 0; db < 2; ++db) { const LAS bf16* vp = Vt + (db * 32 + q) * VP + (win ? kc0 : 0) + 8 * g;
#pragma unroll
                for (int ks = 0; ks < 4; ++ks) { if (win && ks >= 2) continue; const bf16x8 a = *(const LAS bf16x8*)(vp + 16 * ks); O[db] = __builtin_amdgcn_mfma_f32_32x32x16_bf16(a, Pf[ks], O[db], 0, 0, 0); } }
        }
        if (more) lstore((t + 1) & 1);
        __syncthreads();
    }
    const float ltot = lrun + __shfl_xor(lrun, 32), inv = 1.f / ltot;
    GAS bf16* op = A.o + (size_t)qi * A.opitch + 4 * g;
#pragma unroll
    for (int db = 0; db < 2; ++db)
#pragma unroll
        for (int i4 = 0; i4 < 4; ++i4) { v2u w; w.x = pk2(O[db][4 * i4] * inv, O[db][4 * i4 + 1] * inv); w.y = pk2(O[db][4 * i4 + 2] * inv, O[db][4 * i4 + 3] * inv); *(GAS v2u*)(op + 32 * db + 8 * i4) = w; }
}

constexpr float MLA_TH = 8.f;
constexpr int NA_SLOT = 2 * 64 * 72 * 2, NA_RPB = 4 * NA_SLOT;
DI void na_unit(LAS unsigned char* lds, const AttnDesc& A, const GAS float* rp, int tid, int lane, int wave) {
    constexpr int KP = 72, VP = 72, NS = 4, KBUF = 64 * KP * 2;
    const int q = lane & 31, g = lane >> 5, NT = A.ntiles;
    auto tpos = [&](int t) { return t < 4 ? 64 * t : 256 + 64 * (A.rs0 + t - 4); };
    auto krow = [&](int pos) { return pos < 256 ? A.b * 256 + pos : NCTX + A.b * SEQ + (pos - 256); };
    const int qi = (2 * (wave >> 2) + (q >> 4)) * 64 + 16 * (wave & 3) + (q & 15);
    const int kc0 = min(max(16 * (wave & 3) - 8, 0), 32);
    bf16x8 Qf[NS];
    { const GAS bf16* qp = A.q + (size_t)qi * A.qpitch + 8 * g;
#pragma unroll
        for (int s2 = 0; s2 < NS; ++s2) Qf[s2] = *(const GAS bf16x8*)(qp + 16 * s2); }
    f32x16 O[2];
#pragma unroll
    for (int db = 0; db < 2; ++db)
#pragma unroll
        for (int i = 0; i < 16; ++i) O[db][i] = 0.f;
    float mrun = -1e30f, lrun = 0.f;
    const int qr = A.r0 + (qi >> 6), qc = qi & 63;
    const int wrs = min(max(qr - 4, 0), 56), cs = min(max(qc - 8, 0), 48);
    const int qr0 = A.r0 + 2 * (wave >> 2), wlo = min(max(qr0 - 4, 0), 56), whi = min(max(qr0 + 1 - 4, 0), 56) + 8;
    auto koffs = [&](int i) { const int j = i * 64 + lane, row = j / 9, pc = min(j % 9, 7); return (unsigned)(row * (PP * 2) + pc * 16); };
    auto voffs = [&](int i) { const int j = i * 64 + lane, row = j / 9, pc = min(j % 9, 7); return (unsigned)(row * (NKEY * 2) + pc * 16); };
    const int iv1 = wave == 0 ? 0 : wave - 1, iv2 = wave < 2 ? 7 + wave : iv1;
    const unsigned goff0 = koffs(wave), goff1 = wave == 0 ? koffs(8) : voffs(iv1), goff2 = voffs(iv2);
    auto dma = [&](int t, int slot) __attribute__((always_inline)) { const int pos = tpos(t);
        const GAS unsigned char* kb = (const GAS unsigned char*)(A.k + (size_t)krow(pos) * A.kpitch); const GAS unsigned char* vb = (const GAS unsigned char*)(A.vt + pos);
        LAS unsigned char* kl = lds + slot * NA_SLOT; LAS unsigned char* vl = kl + KBUF;
        __builtin_amdgcn_global_load_lds((const GAS unsigned*)(kb + goff0), (LAS unsigned*)(kl + wave * 1024), 16, 0, 0);
        __builtin_amdgcn_global_load_lds((const GAS unsigned*)((wave == 0 ? kb : vb) + goff1), (LAS unsigned*)(wave == 0 ? kl + 8 * 1024 : vl + iv1 * 1024), 16, 0, 0);
        __builtin_amdgcn_global_load_lds((const GAS unsigned*)(vb + goff2), (LAS unsigned*)(vl + iv2 * 1024), 16, 0, 0);
    };
    LAS float* T = (LAS float*)(lds + NA_RPB);
    float tv[4];
#pragma unroll
    for (int u = 0; u < 4; ++u) { const int e = tid + 512 * u, r = e >> 7, dcr = (e & 127) - 64; const bool in = r < 15 && dcr >= -15 && dcr <= 15;
        tv[u] = in ? rp[r * 31 + dcr + 15] * LOG2E : (r == 15 ? -INFINITY : 0.f); }
    float mcol[16];
#pragma unroll
    for (int i = 0; i < 16; ++i) { const int kc = kc0 + 16 * (i >> 3) + 8 * g + (i & 7); mcol[i] = (kc >= cs && kc < cs + 16) ? 0.f : -INFINITY; }
    __syncthreads();
    dma(0, 0); dma(min(1, NT - 1), 1); dma(min(2, NT - 1), 2);
#pragma unroll
    for (int u = 0; u < 4; ++u) T[tid + 512 * u] = tv[u];
    asm volatile("s_waitcnt vmcnt(6)\n\ts_waitcnt lgkmcnt(0)\n\ts_barrier" ::: "memory");
#pragma unroll 1
    for (int t = 0; t < NT; ++t) {
        dma(min(t + 3, NT - 1), (t + 3) & 3);
        bool active = true, rowok = true; int dr = 0;
        const bool win = t >= 4;
        if (win) { const int wr = A.rs0 + t - 4; active = (wr >= wlo) && (wr < whi); rowok = (wr >= wrs) && (wr < wrs + 8); dr = min(max(wr - qr + 7, 0), 14); }
        if (active) {
            const LAS bf16* Kt = (const LAS bf16*)(lds + (t & 3) * NA_SLOT); const LAS bf16* Vt = Kt + 64 * KP;
            f32x16 S[2];
#pragma unroll
            for (int kb = 0; kb < 2; ++kb) {
#pragma unroll
                for (int i = 0; i < 16; ++i) S[kb][i] = 0.f;
                if (win && kb == 1) continue;
                const LAS bf16* kp = Kt + ((win ? kc0 : kb * 32) + swap23(q)) * KP + 8 * g;
#pragma unroll
                for (int s2 = 0; s2 < NS; ++s2) { const bf16x8 a = *(const LAS bf16x8*)(kp + 16 * s2); S[kb] = __builtin_amdgcn_mfma_f32_32x32x16_bf16(a, Qf[s2], S[kb], 0, 0, 0); }
            }
            float mx = -INFINITY;
            if (win) { const LAS float* tb = T + (rowok ? dr : 15) * 128 + (kc0 + 8 * g - qc + 64);
#pragma unroll
                for (int i = 0; i < 16; ++i) { const float sv = (S[0][i] * A.scale + tb[16 * (i >> 3) + (i & 7)]) + mcol[i]; S[0][i] = sv; mx = fmaxf(mx, sv); }
            } else {
#pragma unroll
                for (int kb = 0; kb < 2; ++kb)
#pragma unroll
                    for (int i = 0; i < 16; ++i) { const float sv = S[kb][i] * A.scale; S[kb][i] = sv; mx = fmaxf(mx, sv); }
            }
            if (__any(mx > mrun + MLA_TH)) { const float mf = fmaxf(mx, __shfl_xor(mx, 32)), mn = fmaxf(mrun, mf), alpha = __builtin_amdgcn_exp2f(mrun - mn);
                mrun = mn; lrun *= alpha;
#pragma unroll
                for (int db = 0; db < 2; ++db)
#pragma unroll
                    for (int i = 0; i < 16; ++i) O[db][i] *= alpha; }
            bf16x8 Pf[4];
#pragma unroll
            for (int ks = 0; ks < 4; ++ks) { if (win && ks >= 2) continue; const int kb = ks >> 1, o8 = (ks & 1) * 8; float p[8];
#pragma unroll
                for (int j = 0; j < 8; ++j) { p[j] = __builtin_amdgcn_exp2f(S[kb][o8 + j] - mrun); lrun += p[j]; }
                Pf[ks] = pack8(p[0], p[1], p[2], p[3], p[4], p[5], p[6], p[7]); }
#pragma unroll
            for (int db = 0; db < 2; ++db) { const LAS bf16* vp = Vt + (db * 32 + q) * VP + (win ? kc0 : 0) + 8 * g;
#pragma unroll
                for (int ks = 0; ks < 4; ++ks) { if (win && ks >= 2) continue; const bf16x8 a = *(const LAS bf16x8*)(vp + 16 * ks); O[db] = __builtin_amdgcn_mfma_f32_32x32x16_bf16(a, Pf[ks], O[db], 0, 0, 0); } }
        }
        asm volatile("s_waitcnt vmcnt(6)\n\ts_waitcnt lgkmcnt(0)\n\ts_barrier" ::: "memory");
    }
    asm volatile("s_waitcnt vmcnt(0)" ::: "memory");
    const float ltot = lrun + __shfl_xor(lrun, 32), inv = 1.f / ltot;
    GAS bf16* op = A.o + (size_t)qi * A.opitch + 4 * g;
#pragma unroll
    for (int db = 0; db < 2; ++db)
#pragma unroll
        for (int i4 = 0; i4 < 4; ++i4) { v2u w; w.x = pk2(O[db][4 * i4] * inv, O[db][4 * i4 + 1] * inv); w.y = pk2(O[db][4 * i4 + 2] * inv, O[db][4 * i4 + 3] * inv); *(GAS v2u*)(op + 32 * db + 8 * i4) = w; }
}

struct TagF { static constexpr bool value = false; }; struct TagT { static constexpr bool value = true; };
#define SGB(mask, n) __builtin_amdgcn_sched_group_barrier(mask, n, 0)
DI void mla_unit(LAS unsigned char* lds, const AttnDesc& A, int tid, int lane, int wave) {
    constexpr int KP = 104, VP = 72, NS = 6, KBUF = 64 * KP * 2, VBUF = 64 * VP * 2;
    const int q = lane & 31, g = lane >> 5, NT = A.ntiles;
    bf16x8 Qf[NS];
    { const GAS bf16* qp = A.q + (size_t)(wave * 32 + q) * A.qpitch + 8 * g;
#pragma unroll
        for (int s2 = 0; s2 < NS; ++s2) Qf[s2] = *(const GAS bf16x8*)(qp + 16 * s2); }
    f32x16 O[2], Cm;
#pragma unroll
    for (int i = 0; i < 16; ++i) { O[0][i] = 0.f; O[1][i] = 0.f; Cm[i] = 0.f; }
    float lrun = 0.f;
    auto koffs = [&](int i) { const int j = i * 64 + lane, row = j / 13, pc = min(j % 13, 11); return (unsigned)(row * 192 + pc * 16); };
    auto voffs = [&](int i) { const int j = i * 64 + lane, row = j / 9, pc = min(j % 9, 7); return (unsigned)(row * (NKEY * 2) + pc * 16); };
    const int i2 = min(wave + 3, 8);
    const unsigned goff0 = koffs(wave), goff1 = wave < 5 ? koffs(wave + 8) : voffs(wave - 5), goff2 = voffs(i2);
    auto dma = [&](int tk, int ks, int tv, int vs) __attribute__((always_inline)) {
        const GAS unsigned char* kb = (const GAS unsigned char*)A.k + (size_t)tk * (64 * 96 * 2); const GAS unsigned char* vb = (const GAS unsigned char*)A.vt + (size_t)tv * 128;
        LAS unsigned char* kl = lds + ks * KBUF; LAS unsigned char* vl = lds + 2 * KBUF + vs * VBUF;
        __builtin_amdgcn_global_load_lds((const GAS unsigned*)(kb + goff0), (LAS unsigned*)(kl + wave * 1024), 16, 0, 0);
        __builtin_amdgcn_global_load_lds((const GAS unsigned*)((wave < 5 ? kb : vb) + goff1), (LAS unsigned*)(wave < 5 ? kl + (wave + 8) * 1024 : vl + (wave - 5) * 1024), 16, 0, 0);
        __builtin_amdgcn_global_load_lds((const GAS unsigned*)(vb + goff2), (LAS unsigned*)(vl + i2 * 1024), 16, 0, 0);
    };
    auto qk = [&](f32x16& S0, f32x16& S1, int buf) __attribute__((always_inline)) {
        const LAS bf16* kp = (const LAS bf16*)(lds + buf * KBUF) + swap23(q) * KP + 8 * g;
        S0 = __builtin_amdgcn_mfma_f32_32x32x16_bf16(*(const LAS bf16x8*)kp, Qf[0], Cm, 0, 0, 0);
#pragma unroll
        for (int s2 = 1; s2 < NS; ++s2) S0 = __builtin_amdgcn_mfma_f32_32x32x16_bf16(*(const LAS bf16x8*)(kp + 16 * s2), Qf[s2], S0, 0, 0, 0);
        S1 = __builtin_amdgcn_mfma_f32_32x32x16_bf16(*(const LAS bf16x8*)(kp + 32 * KP), Qf[0], Cm, 0, 0, 0);
#pragma unroll
        for (int s2 = 1; s2 < NS; ++s2) S1 = __builtin_amdgcn_mfma_f32_32x32x16_bf16(*(const LAS bf16x8*)(kp + 32 * KP + 16 * s2), Qf[s2], S1, 0, 0, 0);
    };
    auto smax = [&](const f32x16& S0, const f32x16& S1) __attribute__((always_inline)) { float mx = fmaxf(S0[0], S0[1]);
#pragma unroll
        for (int i = 2; i < 16; ++i) mx = fmaxf(mx, S0[i]);
#pragma unroll
        for (int i = 0; i < 16; ++i) mx = fmaxf(mx, S1[i]);
        return mx; };
    auto rebase = [&](f32x16& S0, f32x16& S1, float mx) __attribute__((always_inline)) {
        const float mf = fmaxf(mx, __shfl_xor(mx, 32)), d = fmaxf(mf, 0.f), alpha = __builtin_amdgcn_exp2f(-d);
        lrun *= alpha;
#pragma unroll
        for (int i = 0; i < 16; ++i) { O[0][i] *= alpha; O[1][i] *= alpha; S0[i] -= d; S1[i] -= d; Cm[i] -= d; }
        asm volatile("" : "+v"(Cm));
    };
    auto softmax_p = [&](const f32x16& S0, const f32x16& S1, bf16x8 (&Pf)[4]) __attribute__((always_inline)) {
#pragma unroll
        for (int ks = 0; ks < 4; ++ks) { const int o8 = (ks & 1) * 8; float p[8];
#pragma unroll
            for (int j = 0; j < 8; ++j) { p[j] = __builtin_amdgcn_exp2f(ks < 2 ? S0[o8 + j] : S1[o8 + j]); lrun += p[j]; }
            Pf[ks] = pack8(p[0], p[1], p[2], p[3], p[4], p[5], p[6], p[7]); }
    };
    auto pv = [&](const bf16x8 (&Pf)[4], int buf) __attribute__((always_inline)) {
        const LAS bf16* vp = (const LAS bf16*)(lds + 2 * KBUF + buf * VBUF) + q * VP + 8 * g;
#pragma unroll
        for (int ks = 0; ks < 4; ++ks)
#pragma unroll
            for (int db = 0; db < 2; ++db) O[db] = __builtin_amdgcn_mfma_f32_32x32x16_bf16(*(const LAS bf16x8*)(vp + db * 32 * VP + 16 * ks), Pf[ks], O[db], 0, 0, 0);
    };
    f32x16 Sa[2], Sb[2];
    __syncthreads();
    dma(0, 0, 0, 0); dma(1, 1, 0, 0);
    asm volatile("s_waitcnt vmcnt(0)" ::: "memory");
    __syncthreads();
    qk(Sa[0], Sa[1], 0);
    { const float mx = smax(Sa[0], Sa[1]); const float mf = fmaxf(mx, __shfl_xor(mx, 32));
#pragma unroll
        for (int i = 0; i < 16; ++i) { Sa[0][i] -= mf; Sa[1][i] -= mf; Cm[i] = -mf; }
        asm volatile("" : "+v"(Cm)); }
    __syncthreads();
    auto step = [&](f32x16 (&Sc)[2], f32x16 (&Sn)[2], const int t, auto par) __attribute__((always_inline)) {
        constexpr int PAR = decltype(par)::value ? 1 : 0;
        dma(min(t + 2, NT - 1), PAR, min(t + 1, NT - 1), PAR ^ 1);
        __builtin_amdgcn_sched_barrier(0);
        bf16x8 Pf[4];
        qk(Sn[0], Sn[1], PAR ^ 1);
        softmax_p(Sc[0], Sc[1], Pf);
        pv(Pf, PAR);
        const float mx = smax(Sn[0], Sn[1]);
        SGB(0x100, 3);
#pragma unroll
        for (int m = 0; m < 16; ++m) { SGB(0x008, 1); SGB(0x100, 1); SGB(0x400, 2); SGB(0x002, 3); }
#pragma unroll
        for (int m = 0; m < 4; ++m) { SGB(0x008, 1); SGB(0x100, 1); SGB(0x002, 5); }
        if (__any(mx > MLA_TH)) rebase(Sn[0], Sn[1], mx);
        asm volatile("s_waitcnt vmcnt(0)" ::: "memory");
        __syncthreads();
    };
#pragma unroll 1
    for (int t = 0; t < NT - 2; t += 2) { step(Sa, Sb, t, TagF{}); step(Sb, Sa, t + 1, TagT{}); }
    step(Sa, Sb, NT - 2, TagF{});
    { bf16x8 Pf[4]; softmax_p(Sb[0], Sb[1], Pf); pv(Pf, (NT - 1) & 1); }
    const float ltot = lrun + __shfl_xor(lrun, 32), inv = 1.f / ltot;
    GAS bf16* op = A.o + (size_t)(wave * 32 + q) * A.opitch + 4 * g;
#pragma unroll
    for (int db = 0; db < 2; ++db)
#pragma unroll
        for (int i4 = 0; i4 < 4; ++i4) { v2u w; w.x = pk2(O[db][4 * i4] * inv, O[db][4 * i4 + 1] * inv); w.y = pk2(O[db][4 * i4 + 2] * inv, O[db][4 * i4 + 3] * inv); *(GAS v2u*)(op + 32 * db + 8 * i4) = w; }
}

DI int moe_tables(const GAS unsigned* cnt  , LAS int* off, LAS int* tile_e, int tid) {
    if (tid == 0) { int o = 0; for (int e = 0; e < 32; ++e) { off[e] = o; o += ((int)cnt[e * 64] + 255) & ~255; } off[32] = o; }
    __syncthreads();
    if (tid < MOE_MAXT) { const int r = tid * 256; int ex = 0; for (int e = 0; e < 32; ++e) if (r >= off[e + 1]) ex = e + 1; tile_e[tid] = ex < 32 ? ex : 31; }
    __syncthreads();
    return off[32] >> 8;
}

#define TIDS const int tid = threadIdx.x, lane = tid & 63, wave = __builtin_amdgcn_readfirstlane(tid >> 6), bid = blockIdx.x, G = gridDim.x, gw = bid * 8 + wave, NGW = G * 8; (void)lane; (void)gw; (void)NGW
DI void ph_gemm_in(const Ctx& cx, int l) {
    TIDS; GAS unsigned char* ws = cx.ws(); LAS unsigned char* lds = (LAS unsigned char*)lds_raw;
    pg8::Gemm g{(const GAS bf16*)(ws + WS_H), (const GAS bf16*)(ws + WS_WTIN + (size_t)l * WTIN_L), MTOK, PP, D}; pg8::StaticOrder S; S.init(MTOK, PP, G, bid);
    pg8::EpiStoreBf16 E{(GAS bf16*)(ws + WS_P), PP};
    pg8::gemm_phase(lds, g, S, E);
}
DI void ph_prep_r1(const Ctx& cx, int l) {
    TIDS; LAS unsigned char* lds = (LAS unsigned char*)lds_raw;
#pragma unroll 1
    for (int u = bid; u < MTOK / PR; u += G) prep_unit(cx, l, u, lds, tid, lane, wave);
    __syncthreads();
    rec_r1_run<0>(cx, l, lds, tid, bid, G); rec_r1_run<1>(cx, l, lds, tid, bid, G);
    __syncthreads();
}
DI void ph_mixers(const Ctx& cx, int l) {
    TIDS; GAS unsigned char* ws = cx.ws(); LAS unsigned char* lds = (LAS unsigned char*)lds_raw;
    const bool keep_ctx = (l == 0);
    GAS bf16* CAT = (GAS bf16*)(ws + WS_CAT); const GAS bf16* P = (const GAS bf16*)(ws + WS_P);
    const int nATT = 256 + (keep_ctx ? 16 : 0), nR = 16 * NCHUNK;
    const int vc = (G % 8 == 0) ? (bid % 8) * (G / 8) + bid / 8 : bid;
    const bool r3first = ((bid >> 3) & 1) != 0;
    if (r3first) { rec_r3_run<0>(cx, l, lds, tid, bid, G, keep_ctx); rec_r3_run<1>(cx, l, lds, tid, bid, G, keep_ctx); __syncthreads(); }
#pragma unroll 1
    for (int it = 0; it < 2; ++it) { const int u = it == 0 ? vc : (G == 256 && bid >= 128 && bid < 144 ? 256 + bid - 128 : (G == 256 ? nATT : bid + G)); if (u >= nATT) continue;
        const GAS bf16* QM = (const GAS bf16*)(ws + WS_QM); const GAS bf16* KM = (const GAS bf16*)(ws + WS_KM); const GAS bf16* VM = (const GAS bf16*)(ws + WS_VM);
        AttnDesc A{}; int bh, b, h;
        if (u < 256) { bh = u >> 4; b = bh >> 2; h = bh & 3; const int qb = u & 15; A.q = QM + ((size_t)bh * NKEY + 256 + qb * 256) * 96; A.ntiles = NKEY / 64; A.o = CAT + (size_t)(NCTX + b * SEQ + qb * 256) * D + 768 + h * 64; }
        else { bh = u - 256; b = bh >> 2; h = bh & 3; A.q = QM + (size_t)bh * NKEY * 96; A.ntiles = 4; A.o = CAT + (size_t)(b * 256) * D + 768 + h * 64; }
        A.qpitch = 96; A.k = KM + (size_t)bh * NKEY * 96; A.kpitch = 96; A.vt = VM + (size_t)bh * 64 * NKEY; A.opitch = D; A.scale = 1.f;
        mla_unit(lds, A, tid, lane, wave);
    }
#pragma unroll 1
    for (int it = 0; it < 2; ++it) { const int u = it == 0 ? vc : (G == 256 && bid >= 160 && bid < 176 ? 256 + bid - 160 : (G == 256 ? nATT : bid + G)); if (u >= nATT) continue;
        LAS float* rpb = (LAS float*)(lds + NA_RPB);
        AttnDesc A{}; int bh, b, h; size_t qrow;
        if (u < 256) { bh = u >> 4; b = bh >> 2; h = bh & 3; const int rq = u & 15; A.r0 = rq * 4; A.rs0 = min(max(A.r0 - 4, 0), 56); const int rsl = min(max(A.r0 + 3 - 4, 0), 56);
            A.ntiles = 4 + (rsl + 8 - A.rs0); qrow = (size_t)NCTX + b * SEQ + A.r0 * 64; }
        else { bh = u - 256; b = bh >> 2; h = bh & 3; A.ntiles = 4; qrow = (size_t)b * 256; }
        const GAS float* rp = cx.in(I_RPB) + (size_t)(l * 4 + h) * 465;
        A.q = P + qrow * PP + CB_Q + h * 64; A.qpitch = PP; A.k = P + CB_K + h * 64; A.kpitch = PP; A.vt = (const GAS bf16*)(ws + WS_VNT) + (size_t)bh * 64 * NKEY;
        A.o = CAT + qrow * D + 256 + h * 64; A.opitch = D; A.scale = 0.125f * LOG2E; A.b = b; A.rpb = rpb;
        na_unit(lds, A, rp, tid, lane, wave);
    }
    __syncthreads();
    if (!r3first) { rec_r3_run<0>(cx, l, lds, tid, bid, G, keep_ctx); rec_r3_run<1>(cx, l, lds, tid, bid, G, keep_ctx); }
}
DI void ph_gemm_out(const Ctx& cx, int l) {
    TIDS; GAS unsigned char* ws = cx.ws(); LAS unsigned char* lds = (LAS unsigned char*)lds_raw;
    const int roff = (l == 0) ? 0 : NCTX, Mg = MTOK - roff;
    pg8::Gemm g{(const GAS bf16*)(ws + WS_CAT) + (size_t)roff * D, (const GAS bf16*)(ws + WS_WTOUT + (size_t)l * D * D * 2), Mg, D, D}; pg8::StaticOrder S; S.init(Mg, D, G, bid);
    pg8::EpiResid E{(GAS pg8::bf16_t*)(ws + WS_X), roff, (const GAS float*)(ws + WS_MOD) + (size_t)l * 5 * 6144 + 2 * 1024, l == 0 ? cx.in(I_CTX) : (const GAS float*)nullptr, l == 0 ? cx.in(I_X) : (const GAS float*)nullptr};
    pg8::gemm_phase(lds, g, S, E);
    if (l == 0) { const int nbusy = (Mg / 256) * (D / 256) - G;
        if (nbusy >= 0 && nbusy < G && bid >= nbusy) { __syncthreads(); weight_copies(cx, 1, lds, tid, lane, wave, (bid - nbusy) * 8 + wave, (G - nbusy) * 8, (bid - nbusy) * 512 + tid, (G - nbusy) * 512); } }
}
DI void ph_router(const Ctx& cx, int l) {
    TIDS; GAS unsigned char* ws = cx.ws(); LAS unsigned char* lds = (LAS unsigned char*)lds_raw;
    const int m_lo = (l == 0) ? 0 : NCTX;
    const GAS bf16* X = (const GAS bf16*)(ws + WS_X); GAS bf16* H = (GAS bf16*)(ws + WS_H); const GAS float* MOD = (const GAS float*)(ws + WS_MOD) + (size_t)l * 5 * 6144;
    GAS int* EID = (GAS int*)(ws + WS_MOE); GAS float* GATE = (GAS float*)(ws + WS_MOE) + MTOK * 2; GAS int* POS = (GAS int*)(ws + WS_MOE) + MTOK * 4;
    GAS unsigned* cnt = (GAS unsigned*)(ws + WS_CTL) + CW_CNT + l * 32 * 64; GAS int* RIDX = (GAS int*)(ws + WS_RIDX);
    const GAS bf16* WRh = (const GAS bf16*)(ws + WS_WR) + (size_t)l * 2 * 48 * 1024; const GAS bf16* WRl = WRh + 48 * 1024;
    const GAS float* n2g = cx.in(I_N2G) + l * D; const GAS float* brg = cx.in(I_BRG) + l * 4; const GAS float* bre = cx.in(I_BRE) + l * 32;
    constexpr int AP = 136;
    LAS bf16* Ah = (LAS bf16*)(lds + wave * 12288); LAS bf16* Al = Ah + 16 * AP; LAS float* LG = (LAS float*)(lds + wave * 12288 + 2 * 16 * AP * 2); LAS float* RSD = LG + 16 * 48;
    const int nunits = (MTOK - m_lo) / 16;
#pragma unroll 1
    for (int unit = wave * G + bid; unit < nunits; unit += NGW) {
        const int m0 = m_lo + unit * 16; const GAS float* mb = MOD + (size_t)bidx_of_row(m0) * 6144;
#pragma unroll 1
        for (int r4 = 0; r4 < 16; r4 += 4) { f32x4 v[4][4];
#pragma unroll
            for (int r = 0; r < 4; ++r)
#pragma unroll
                for (int j = 0; j < 4; ++j) v[r][j] = bf4f(*(const GAS v2u*)(X + (size_t)(m0 + r4 + r) * D + 4 * lane + 256 * j));
#pragma unroll
            for (int r = 0; r < 4; ++r) { float ss = 0.f;
#pragma unroll
                for (int j = 0; j < 4; ++j) ss += (v[r][j].x * v[r][j].x + v[r][j].y * v[r][j].y) + (v[r][j].z * v[r][j].z + v[r][j].w * v[r][j].w);
                const float rs = rsqrtf(wave_sum(ss) * (1.f / D) + EPS); if (lane == 0) RSD[r4 + r] = rs; } }
        f32x4 acc[3];
#pragma unroll
        for (int ct = 0; ct < 3; ++ct) acc[ct] = (f32x4){0.f, 0.f, 0.f, 0.f};
#pragma unroll 1
        for (int kc = 0; kc < 8; ++kc) { const int c = kc * 128 + 2 * lane;
            const f32x2 gg = *(const GAS f32x2*)(n2g + c), sh = *(const GAS f32x2*)(mb + 3 * 1024 + c), sc = *(const GAS f32x2*)(mb + 4 * 1024 + c);
            f32x2 xv[16];
#pragma unroll
            for (int r = 0; r < 16; ++r) { const unsigned w = *(const GAS unsigned*)(X + (size_t)(m0 + r) * D + c); xv[r].x = __uint_as_float(w << 16); xv[r].y = __uint_as_float(w & 0xffff0000u); }
            LDS_WAIT();
#pragma unroll
            for (int r = 0; r < 16; ++r) { const float rs = RSD[r]; const float y0 = xv[r].x * rs * gg.x * (1.f + sc.x) + sh.x, y1 = xv[r].y * rs * gg.y * (1.f + sc.y) + sh.y;
                const unsigned hi = pk2(y0, y1); const float l0 = y0 - bf2f(hi & 0xffffu), l1 = y1 - bf2f(hi >> 16);
                *(GAS unsigned*)(H + (size_t)(m0 + r) * D + c) = hi;
                *(LAS unsigned*)(Ah + r * AP + 2 * lane) = hi; *(LAS unsigned*)(Al + r * AP + 2 * lane) = pk2(l0, l1); }
            LDS_WAIT(); asm volatile("" ::: "memory");
            const int fr = lane & 15, fq = lane >> 4;
#pragma unroll
            for (int ks = 0; ks < 4; ++ks) { const bf16x8 ah = *(const LAS bf16x8*)(Ah + fr * AP + ks * 32 + fq * 8), al = *(const LAS bf16x8*)(Al + fr * AP + ks * 32 + fq * 8);
                bf16x8 bh[3], bl[3];
#pragma unroll
                for (int ct = 0; ct < 3; ++ct) { const size_t bo = (size_t)(ct * 16 + fr) * 1024 + kc * 128 + ks * 32 + fq * 8; bh[ct] = *(const GAS bf16x8*)(WRh + bo); bl[ct] = *(const GAS bf16x8*)(WRl + bo); }
                asm volatile("s_waitcnt vmcnt(0)" : "+v"(bh[0]), "+v"(bh[1]), "+v"(bh[2]), "+v"(bl[0]), "+v"(bl[1]), "+v"(bl[2]) :: "memory");
#pragma unroll
                for (int ct = 0; ct < 3; ++ct) {
                    acc[ct] = __builtin_amdgcn_mfma_f32_16x16x32_bf16(ah, bh[ct], acc[ct], 0, 0, 0);
                    acc[ct] = __builtin_amdgcn_mfma_f32_16x16x32_bf16(ah, bl[ct], acc[ct], 0, 0, 0);
                    acc[ct] = __builtin_amdgcn_mfma_f32_16x16x32_bf16(al, bh[ct], acc[ct], 0, 0, 0); } }
        }
#pragma unroll
        for (int ct = 0; ct < 3; ++ct)
#pragma unroll
            for (int j = 0; j < 4; ++j) LG[(4 * (lane >> 4) + j) * 48 + ct * 16 + (lane & 15)] = acc[ct][j];
        LDS_WAIT(); asm volatile("" ::: "memory");
        if (lane < 16) { const LAS float* lg = LG + lane * 48; const int m = m0 + lane;
            float gl[4]; int gsel = 0;
#pragma unroll
            for (int i = 0; i < 4; ++i) gl[i] = lg[i] + brg[i];
            float gmax = gl[0];
#pragma unroll
            for (int i = 1; i < 4; ++i) if (gl[i] > gmax) { gmax = gl[i]; gsel = i; }
            float den = 0.f;
#pragma unroll
            for (int i = 0; i < 4; ++i) den += __expf(gl[i] - gmax);
            const float pg = 1.f / den;
            float e1 = -INFINITY, e2 = -INFINITY; int i1 = 0, i2 = 0;
#pragma unroll 1
            for (int i = 0; i < 8; ++i) { const float ev = lg[4 + gsel * 8 + i] + bre[gsel * 8 + i];
                if (ev > e1) { e2 = e1; i2 = i1; e1 = ev; i1 = i; } else if (ev > e2) { e2 = ev; i2 = i; } }
            const float x2 = __expf(e2 - e1), w1 = pg / (1.f + x2), w2 = pg * x2 / (1.f + x2);
            const int ex1 = gsel * 8 + i1, ex2 = gsel * 8 + i2;
            const int p1 = (int)__hip_atomic_fetch_add(cnt + ex1 * 64, 1u, __ATOMIC_RELAXED, __HIP_MEMORY_SCOPE_AGENT), p2 = (int)__hip_atomic_fetch_add(cnt + ex2 * 64, 1u, __ATOMIC_RELAXED, __HIP_MEMORY_SCOPE_AGENT);
            EID[m * 2] = ex1; EID[m * 2 + 1] = ex2; GATE[m * 2] = w1; GATE[m * 2 + 1] = w2; POS[m * 2] = p1; POS[m * 2 + 1] = p2;
            RIDX[(size_t)ex1 * MOE_CAP + p1] = m; RIDX[(size_t)ex2 * MOE_CAP + p2] = m; }
        LDS_WAIT(); asm volatile("" ::: "memory");
    }
}
DI void ph_gemm_gu(const Ctx& cx, int l) {
    TIDS; GAS unsigned char* ws = cx.ws(); LAS unsigned char* lds = (LAS unsigned char*)lds_raw;
    LAS int* moe_off = (LAS int*)(lds + MISC_OFF + 64 * 4); LAS int* moe_te = (LAS int*)(lds + MISC_OFF + 128 * 4);
    const int nT = moe_tables((const GAS unsigned*)(ws + WS_CTL) + CW_CNT + l * 32 * 64, moe_off, moe_te, tid);
    pg8::Gemm g{(const GAS bf16*)(ws + WS_H), (const GAS bf16*)(ws + WS_WTGU + (size_t)l * 32 * 512 * D * 2), nT * 256, 512, D};
    const int vc = (G % 8 == 0) ? (bid % 8) * (G / 8) + bid / 8 : bid;
    pg8::GroupedPublish S{{nT, 2, G, vc, moe_te, (size_t)512 * D * 2}, (GAS unsigned*)(ws + WS_CTL) + CW_GUC + l * MOE_MAXT * 64};
    pg8::EpiGateUp E{(GAS bf16*)(ws + WS_ACT), (unsigned)(MOE_MAXT * 256 * 256 * 2)};
    LAS int* ridx_l = (LAS int*)(lds + MISC_OFF + 4096);
    { const GAS unsigned* cntp = (const GAS unsigned*)(ws + WS_CTL) + CW_CNT + l * 32 * 64; const GAS int* RIDX = (const GAS int*)(ws + WS_RIDX);
        const int vcl = (G % 8 == 0) ? (bid % 8) * (G / 8) + bid / 8 : bid; const int i = tid >> 8, r = tid & 255, L = vcl + i * G;
        if (L < nT * 2) { const int pm = L >> 1, e = moe_te[pm], slot = pm * 256 - moe_off[e] + r; ridx_l[i * 256 + r] = slot < (int)cntp[e * 64] ? RIDX[(size_t)e * MOE_CAP + slot] : 0; }
        __syncthreads(); }
    pg8::MoeRows RM{ridx_l, vc >> 1};
    pg8::gemm_phase(lds, g, S, E, RM);
}
DI void ph_gemm_dn(const Ctx& cx, int l) {
    TIDS; GAS unsigned char* ws = cx.ws(); LAS unsigned char* lds = (LAS unsigned char*)lds_raw;
    LAS int* moe_off = (LAS int*)(lds + MISC_OFF + 64 * 4); LAS int* moe_te = (LAS int*)(lds + MISC_OFF + 128 * 4);
    const int nT = moe_tables((const GAS unsigned*)(ws + WS_CTL) + CW_CNT + l * 32 * 64, moe_off, moe_te, tid);
    pg8::Gemm g{(const GAS bf16*)(ws + WS_ACT), (const GAS bf16*)(ws + WS_WTDN + (size_t)l * 32 * D * 256 * 2), nT * 256, D, 256};
    pg8::EpiStoreBf16 E{(GAS bf16*)(ws + WS_XS), D};
    const GAS unsigned* ready = (const GAS unsigned*)(ws + WS_CTL) + CW_GUC + l * MOE_MAXT * 64;
    const int vc = (G % 8 == 0) ? (bid % 8) * (G / 8) + bid / 8 : bid;
    const int nb2 = (nT * 2 > G && nT * 2 - G < G / 2) ? nT * 2 - G : 0, Gd = G - nb2, cd = vc - nb2;
    const int pmE = nb2 ? G / 2 : nT, nE = pmE * 4, nL = (nT - pmE) * 4;
    const int cl = cd < 0 ? -1 : (cd - nE % Gd + Gd) % Gd;
    pg8::GroupedOrder S1{pmE, 4, Gd, cd, moe_te, (size_t)D * 256 * 2, 0};
    pg8::GroupedOrder S2{nT - pmE, 4, Gd, cl, moe_te, (size_t)D * 256 * 2, pmE};
    { pg8::Unit u;
#pragma unroll 1
      for (int i = 0; S1.next(i, u); ++i) pg8::wait_rowtile(ready, u.pm, 16u); }
    pg8::gemm_phase(lds, g, S1, E);
    if (nL > 0) { pg8::Unit u;
#pragma unroll 1
      for (int i = 0; S2.next(i, u); ++i) pg8::wait_rowtile(ready, u.pm, 16u);
      pg8::gemm_phase(lds, g, S2, E); }
}
DI void ph_combine(const Ctx& cx, int l) {
    TIDS; GAS unsigned char* ws = cx.ws(); LAS unsigned char* lds = (LAS unsigned char*)lds_raw;
    LAS int* moe_off = (LAS int*)(lds + MISC_OFF + 64 * 4); LAS int* moe_te = (LAS int*)(lds + MISC_OFF + 128 * 4);
    const int m_lo = (l == 0) ? 0 : NCTX;
    moe_tables((const GAS unsigned*)(ws + WS_CTL) + CW_CNT + l * 32 * 64, moe_off, moe_te, tid);
    const GAS int* EID = (const GAS int*)(ws + WS_MOE); const GAS float* GATE = (const GAS float*)(ws + WS_MOE) + MTOK * 2; const GAS int* POS = (const GAS int*)(ws + WS_MOE) + MTOK * 4;
    const GAS bf16* YS = (const GAS bf16*)(ws + WS_XS); GAS bf16* X = (GAS bf16*)(ws + WS_X); GAS bf16* H = (GAS bf16*)(ws + WS_H);
    const GAS float* MODB = (const GAS float*)(ws + WS_MOD); const GAS float* MOD = MODB + (size_t)l * 5 * 6144;
    const GAS float* n1g1 = cx.in(I_N1G) + D; const GAS float* fng = cx.in(I_FNG); GAS float* outp = cx.out();
#pragma unroll 1
    for (int m = m_lo + gw; m < MTOK; m += NGW) {
        const int d0 = moe_off[EID[m * 2]] + POS[m * 2], d1 = moe_off[EID[m * 2 + 1]] + POS[m * 2 + 1];
        const float w0 = GATE[m * 2], w1 = GATE[m * 2 + 1];
        const GAS float* mb = MOD + (size_t)bidx_of_row(m) * 6144;
        f32x4 v[4];
#pragma unroll
        for (int j = 0; j < 4; ++j) { const int c = 4 * lane + 256 * j;
            const v2u a0 = *(const GAS v2u*)(YS + (size_t)d0 * D + c), a1 = *(const GAS v2u*)(YS + (size_t)d1 * D + c);
            f32x4 y; y.x = w0 * bf2f(a0.x & 0xffffu) + w1 * bf2f(a1.x & 0xffffu); y.y = w0 * bf2f(a0.x >> 16) + w1 * bf2f(a1.x >> 16);
            y.z = w0 * bf2f(a0.y & 0xffffu) + w1 * bf2f(a1.y & 0xffffu); y.w = w0 * bf2f(a0.y >> 16) + w1 * bf2f(a1.y >> 16);
            const f32x4 g5 = *(const GAS f32x4*)(mb + 5 * 1024 + c);
            v[j] = bf4f(*(const GAS v2u*)(X + (size_t)m * D + c)) + g5 * y; }
        if (l == 0) {
#pragma unroll
            for (int j = 0; j < 4; ++j) *(GAS v2u*)(X + (size_t)m * D + 4 * lane + 256 * j) = f4bf(v[j]);
            const GAS float* mb1 = MODB + (size_t)(5 + bidx_of_row(m)) * 6144;
            norm_row_store(v, n1g1, mb1, mb1 + 1024, H + (size_t)m * D, lane);
        } else {
            float ss = 0.f;
#pragma unroll
            for (int j = 0; j < 4; ++j) ss += (v[j].x * v[j].x + v[j].y * v[j].y) + (v[j].z * v[j].z + v[j].w * v[j].w);
            const float rstd = rsqrtf(wave_sum(ss) * (1.f / D) + EPS);
#pragma unroll
            for (int j = 0; j < 4; ++j) { const int c = 4 * lane + 256 * j; const f32x4 gg = *(const GAS f32x4*)(fng + c);
                *(GAS f32x4*)(outp + (size_t)(m - NCTX) * D + c) = v[j] * rstd * gg; }
        }
    }
}

#ifndef PH_MASK
#define PH_MASK 0xFFF
#endif
#define PHON(j) (((PH_MASK) >> (j)) & 1)
__global__ void __launch_bounds__(512, 2) fwd_kernel(Args args) {
    LAS unsigned char* lds = (LAS unsigned char*)lds_raw;
    volatile LAS unsigned* MISC = (volatile LAS unsigned*)(lds + MISC_OFF);
    {
        const int tid = threadIdx.x;
        for (int u = tid; u < (LDS_BYTES - MISC_OFF) / 4; u += 512) MISC[u] = 0u;
        __syncthreads();
        if (tid == 0) { volatile LAS unsigned long long* t = (volatile LAS unsigned long long*)(lds + PTR_OFF);
#pragma unroll
            for (int i = 0; i < N_IN; ++i) t[i] = (unsigned long long)args.in[i];
            t[N_IN] = (unsigned long long)args.out; t[N_IN + 1] = (unsigned long long)args.ws; }
        __syncthreads();
    }
    const Ctx cx;
#if MK_ONE_LAUNCH
    XcdBarrier bar = xcd_barrier_post((unsigned*)(cx.ws() + WS_CTL) + CW_BAR, MISC + 8);
#define GRID_BAR() xcd_barrier(bar)
#else
#define GRID_BAR() do { } while (0)
#endif
    const int lo = args.ph_lo, hi = args.ph_hi;
#define IN(k) (lo <= (k) && (k) < hi)
#define BOTH(k) (IN(k) && IN((k) + 1))
    if (PHON(0) && IN(0)) { TIDS; phase_prologue(cx, lds, tid, lane, wave, bid, G); if (BOTH(0)) GRID_BAR(); }
    if (PHON(1) && IN(1)) { TIDS; phase_norm1_l0(cx, lane, gw, NGW); if (BOTH(1)) GRID_BAR(); }
#define LAYER(L) { constexpr int l = L; constexpr int pb = 2 + 10 * l; \
        if (PHON(2) && IN(pb + 0)) { ph_gemm_in(cx, l); if (BOTH(pb + 0)) GRID_BAR(); } \
        if (PHON(3) && IN(pb + 1)) { ph_prep_r1(cx, l); if (BOTH(pb + 1)) GRID_BAR(); } \
        if (PHON(4) && IN(pb + 2)) { rec_r2(cx, blockIdx.x * 512 + threadIdx.x, gridDim.x * 512); if (BOTH(pb + 2)) GRID_BAR(); } \
        if (PHON(5) && IN(pb + 3)) { ph_mixers(cx, l); if (BOTH(pb + 3)) GRID_BAR(); } \
        if (PHON(6) && IN(pb + 4)) { ph_gemm_out(cx, l); if (BOTH(pb + 4)) GRID_BAR(); } \
        if (PHON(7) && IN(pb + 5)) { ph_router(cx, l); if (BOTH(pb + 5)) GRID_BAR(); } \
        if (PHON(9) && IN(pb + 7)) { ph_gemm_gu(cx, l);   } \
        if (PHON(10) && IN(pb + 8)) { ph_gemm_dn(cx, l); if (BOTH(pb + 8)) GRID_BAR(); } \
        if (PHON(11) && IN(pb + 9)) { ph_combine(cx, l); if (BOTH(pb + 9)) GRID_BAR(); } }
    LAYER(0)
    LAYER(1)
#undef LAYER
#undef IN
#undef BOTH
}

constexpr int NPHASES = 22;
extern "C" void kernel_launch(void* const* d_in, const int* in_sizes, int n_in, void* d_out, int out_size, void* d_ws, size_t ws_size, hipStream_t stream) {
    static int grid = 0;
    if (grid == 0) {
        if (n_in != N_IN || out_size != NLAT * D || ws_size < WS_END) { fprintf(stderr, "kernel_launch: unexpected problem (n_in %d, out %d, ws %zu)\n", n_in, out_size, ws_size); grid = -1; return; }
        int dev = 0, cus = 0, per_cu = 0;
        if (hipGetDevice(&dev) != hipSuccess || hipDeviceGetAttribute(&cus, hipDeviceAttributeMultiprocessorCount, dev) != hipSuccess) { grid = -1; return; }
        if (hipFuncSetAttribute((const void*)fwd_kernel, hipFuncAttributeMaxDynamicSharedMemorySize, LDS_BYTES) != hipSuccess) { fprintf(stderr, "kernel_launch: hipFuncSetAttribute failed\n"); grid = -1; return; }
        if (hipOccupancyMaxActiveBlocksPerMultiprocessor(&per_cu, (const void*)fwd_kernel, 512, LDS_BYTES) != hipSuccess || per_cu < 1) fprintf(stderr, "kernel_launch: occupancy query reports %d\n", per_cu);
        (void)hipGetLastError();
        grid = cus;
    }
    if (grid < 0) return;
    (void)hipMemsetAsync((char*)d_ws + WS_CTL, 0, CTL_BYTES, stream);
    Args a{};
    for (int i = 0; i < N_IN; ++i) a.in[i] = (const float*)d_in[i];
    a.out = (float*)d_out; a.ws = (unsigned char*)d_ws;
#if MK_ONE_LAUNCH
    a.ph_lo = 0; a.ph_hi = NPHASES;
    hipLaunchKernelGGL(fwd_kernel, dim3(grid), dim3(512), LDS_BYTES, stream, a);
#else
    for (int p = 0; p < NPHASES; ++p) { a.ph_lo = p; a.ph_hi = p + 1; hipLaunchKernelGGL(fwd_kernel, dim3(grid), dim3(512), LDS_BYTES, stream, a); }
#endif
}
```

```cpp
#include <hip/hip_runtime.h>
#include <cstdio>
#include <cstdint>

#ifndef MK_ONE_LAUNCH
#define MK_ONE_LAUNCH 1
#endif

#define DI __device__ __forceinline__
#define GAS __attribute__((address_space(1)))
#define LAS __attribute__((address_space(3)))
typedef unsigned short bf16;
typedef unsigned v4u __attribute__((ext_vector_type(4)));
typedef unsigned v2u __attribute__((ext_vector_type(2)));
typedef float f32x4 __attribute__((ext_vector_type(4)));
typedef short bf16x8 __attribute__((ext_vector_type(8)));
#define LDS_WAIT() asm volatile("s_waitcnt lgkmcnt(0)" ::: "memory")

constexpr int D = 1024, NB = 4, SEQ = 4096, LCTX = 256, NCTX = NB * LCTX, NLAT = NB * SEQ, MTOK = NCTX + NLAT;
constexpr int DIN = 3200, PP = 3328;
constexpr int CA_Q = 0, CA_I = 256, CA_FF = 512, CA_FB = 768, CA_G = 1024;
constexpr int CB_Q = 1280, CB_K = 1536, CB_V = 1792;
constexpr int CC_Q = 2048, CC_K = 2176, CC_V = 2304, CC_G = 2560, CC_ZF = 2816, CC_ZB = 2832;
constexpr int CD_Q = 2848, CD_KV = 3040, CD_R = 3168;
constexpr int NKEY = LCTX + SEQ;
constexpr int NCHUNK = NKEY / 64;
constexpr float EPS = 1e-6f;
constexpr float LOG2E = 1.4426950408889634f;
constexpr int MOE_MAXT = 168;
constexpr int MOE_CAP = 2 * 17408;

enum { I_X = 0, I_C, I_CTX, I_CCTX, I_WMOD, I_BMOD, I_N1G, I_N2G, I_WIN, I_WOUT, I_LBL, I_HNG, I_RPB, I_WGF, I_BGF, I_WGB, I_BGB, I_GNG, I_QNG, I_WUQ, I_KVNG, I_WUKV,
       I_WRG, I_BRG, I_WRE, I_BRE, I_WGU, I_WDN, I_FNG, N_IN };

constexpr size_t MiB = 1u << 20;
constexpr size_t WS_CTL = 0, CTL_BYTES = 2 * MiB;
constexpr size_t WS_WTIN = 2 * MiB;
constexpr size_t WTIN_L = (size_t)PP * D * 2;
constexpr size_t WS_WTOUT = 16 * MiB;
constexpr size_t WS_WTUQ = 20 * MiB;
constexpr size_t WS_WTUKV = WS_WTUQ + 512 * 1024;
constexpr size_t WS_MOD = 21 * MiB;
constexpr size_t WS_WR = WS_MOD + 512 * 1024;
constexpr size_t WS_WTGU = 22 * MiB;
constexpr size_t WS_WTDN = 86 * MiB;
constexpr size_t WS_X = 118 * MiB;
constexpr size_t WS_H = 186 * MiB;
constexpr size_t WS_CAT = 220 * MiB;
constexpr size_t WS_P = 254 * MiB;
constexpr size_t WS_XS = WS_P;
constexpr size_t WS_ACT = 338 * MiB;
constexpr size_t WS_QM = 366 * MiB;
constexpr size_t WS_KM = 379 * MiB;
constexpr size_t WS_VM = 392 * MiB;
constexpr size_t WS_RSH = 401 * MiB;
constexpr size_t WS_RSG = 435 * MiB;
constexpr size_t WS_RAH = 452 * MiB;
constexpr size_t WS_RAG = WS_RAH + 600 * 1024;
constexpr size_t WS_MOE = 453 * MiB;
constexpr size_t WS_VNT = 454 * MiB;
constexpr size_t WS_RIDX = 463 * MiB;
constexpr size_t WS_END = 468 * MiB;
constexpr int CW_BAR = 4096;
constexpr int CW_CNT = 16384;
constexpr int CW_GUC = 32768;
constexpr int CW_TMO = 64;

constexpr int RING_BYTES = 131072;
constexpr int MISC_OFF = RING_BYTES;
constexpr int LDS_BYTES = 147456;

DI float bf2f(unsigned v) { return __uint_as_float(v << 16); }
DI unsigned f2bf(float f) { unsigned u = __float_as_uint(f); return (u + 0x7fffu + ((u >> 16) & 1u)) >> 16; }
typedef __bf16 bf16v2 __attribute__((ext_vector_type(2)));
typedef float f32x2 __attribute__((ext_vector_type(2)));
DI unsigned pk2(float lo, float hi) { const f32x2 v = {lo, hi}; return __builtin_bit_cast(unsigned, __builtin_convertvector(v, bf16v2)); }
DI f32x4 bf4f(v2u w) { f32x4 r; r.x = __uint_as_float(w.x << 16); r.y = __uint_as_float(w.x & 0xffff0000u); r.z = __uint_as_float(w.y << 16); r.w = __uint_as_float(w.y & 0xffff0000u); return r; }
DI v2u f4bf(f32x4 v) { return (v2u){pk2(v.x, v.y), pk2(v.z, v.w)}; }
DI bf16x8 pack8(float a0, float a1, float a2, float a3, float a4, float a5, float a6, float a7) {
    v4u p; p.x = pk2(a0, a1); p.y = pk2(a2, a3); p.z = pk2(a4, a5); p.w = pk2(a6, a7);
    return __builtin_bit_cast(bf16x8, p);
}
DI float wave_sum(float v) {
#pragma unroll
    for (int o = 1; o < 64; o <<= 1) v += __shfl_xor(v, o);
    return v;
}
DI float frcp_(float x) { return __builtin_amdgcn_rcpf(x); }
DI float sigmoid_(float x) { return frcp_(1.f + __expf(-x)); }
DI float silu_(float x) { return x * frcp_(1.f + __expf(-x)); }
DI float logsigmoid_(float x) { return fminf(x, 0.f) - __logf(1.f + __expf(-fabsf(x))); }
DI void unpack8(v4u w, float* f) {
    f[0] = __uint_as_float(w.x << 16); f[1] = __uint_as_float(w.x & 0xffff0000u);
    f[2] = __uint_as_float(w.y << 16); f[3] = __uint_as_float(w.y & 0xffff0000u);
    f[4] = __uint_as_float(w.z << 16); f[5] = __uint_as_float(w.z & 0xffff0000u);
    f[6] = __uint_as_float(w.w << 16); f[7] = __uint_as_float(w.w & 0xffff0000u);
}
DI int bidx_of_row(int m) { return m < NCTX ? 4 : ((m - NCTX) >> 12); }

namespace pg8 {
#define PG8_LAS __attribute__((address_space(3)))
typedef unsigned short bf16_t;
typedef unsigned u32x4 __attribute__((ext_vector_type(4)));
constexpr int BM = 256, BK = 64, HALF = 128, HTB = HALF * BK * 2, STAGE_BYTES = 8 * HTB, NXCD = 8, WGM = 8;
__host__ __device__ __forceinline__ int lds_byte(int r, int c) { const int st = (r >> 4) * 2 + (c >> 5), rr = r & 15, cc = c & 31, ob = rr * 64 + cc * 2; return st * 1024 + (ob ^ (((ob >> 9) & 1) << 5)); }
__host__ __device__ __forceinline__ void stage_rc(int b, int& R, int& C) { const int st = b / 1024, sb = b % 1024, swz = sb ^ (((sb >> 9) & 1) << 5); R = (st >> 1) * 16 + swz / 64; C = (st & 1) * 32 + (swz % 64) / 2; }
__host__ __device__ __forceinline__ int perm32(int rho) { const int n = rho >> 4, i = rho & 15; return 8 * (i >> 2) + 4 * n + (i & 3); }
struct Unit { int pm, pn; size_t bo; };
struct LinearRows { static constexpr bool LINEAR = true; __device__ __forceinline__ int operator()(const Unit& u, int r) const { return u.pm * BM + r; } };
struct MoeRows { static constexpr bool LINEAR = false; const PG8_LAS int* idx; int pm0;
    __device__ __forceinline__ int operator()(const Unit& u, int r) const { return idx[(u.pm == pm0 ? 0 : 256) + r]; } };
struct Gemm { const GAS bf16_t* A; const GAS bf16_t* Bt; int M, N, K; };
struct StaticOrder {
    int nM, nN, nwg, G, c;
    __device__ void init(int M, int N, int G_, int c_) { nM = M / BM; nN = N / BM; nwg = nM * nN; G = G_; c = c_; }
    __device__ bool next(int i, Unit& u) const {
        const long L = (long)i * G + c; if (L >= nwg) return false;
        int wgid = (int)L; { const int q = nwg / NXCD, r = nwg % NXCD, xcd = wgid % NXCD, off = wgid / NXCD; wgid = (xcd < r ? xcd * (q + 1) : r * (q + 1) + (xcd - r) * q) + off; }
        const int nig = WGM * nN, gid = wgid / nig, fm = gid * WGM, gsz = (nM - fm) < WGM ? (nM - fm) : WGM;
        u.pm = fm + ((wgid % nig) % gsz); u.pn = (wgid % nig) / gsz; u.bo = 0; return true;
    }
    __device__ __forceinline__ void a_ready(const Unit&) const {}
    __device__ __forceinline__ void done(const Unit&) const {}
};
struct GroupedOrder {
    int nT, nN, G, c; const PG8_LAS int* tile_e; size_t estride; int pm0 = 0;
    __device__ bool next(int i, Unit& u) const {
        if (c < 0) return false;
        const long L = (long)i * G + c; if (L >= (long)nT * nN) return false;
        u.pm = pm0 + (int)(L / nN); u.pn = (int)(L % nN); u.bo = (size_t)__builtin_amdgcn_readfirstlane(tile_e[u.pm]) * estride; return true;
    }
    __device__ __forceinline__ void a_ready(const Unit&) const {}
    __device__ __forceinline__ void done(const Unit&) const {}
};
struct GroupedPublish : GroupedOrder { GAS unsigned* done_cnt;
    __device__ __forceinline__ void done(const Unit& u) const { asm volatile("s_waitcnt vmcnt(0)" ::: "memory");
        if ((threadIdx.x & 63) == 0) __hip_atomic_fetch_add(done_cnt + 64 * u.pm, 1u, __ATOMIC_RELAXED, __HIP_MEMORY_SCOPE_AGENT); } };
__device__ __forceinline__ void wait_rowtile(const GAS unsigned* ready, int pm, unsigned need) {
    if (threadIdx.x < 64) {
        unsigned spins = 0;
        while ((unsigned)__builtin_amdgcn_readfirstlane(__hip_atomic_load(ready + 64 * pm, __ATOMIC_RELAXED, __HIP_MEMORY_SCOPE_AGENT)) < need && ++spins < (1u << 22)) __builtin_amdgcn_s_sleep(2);
        __builtin_amdgcn_fence(__ATOMIC_ACQUIRE, "agent");
        asm volatile("s_waitcnt vmcnt(0)" ::: "memory");
    }
    __syncthreads();
}
__device__ __forceinline__ unsigned cvt_pk_bf16(float lo, float hi) { unsigned r; asm volatile("v_cvt_pk_bf16_f32 %0, %1, %2" : "=v"(r) : "v"(lo), "v"(hi)); return r; }

struct EpiStoreBf16 {
    static constexpr bool PERM = true;
    GAS bf16_t* O; int ldc;
    __device__ __forceinline__ void operator()(const f32x4 (&acc)[2][2][4][2], const Unit& u, int wr, int wc, int fr, int fq) const {
        const int row0 = u.pm * BM + wr * 64 + fr, col0 = u.pn * BM + wc * 32 + 8 * fq;
#pragma unroll
        for (int ai = 0; ai < 2; ++ai)
#pragma unroll
            for (int m = 0; m < 4; ++m) { GAS bf16_t* rowp = O + (size_t)(row0 + ai * HALF + m * 16) * ldc + col0;
#pragma unroll
                for (int bj = 0; bj < 2; ++bj) { const f32x4 v0 = acc[ai][bj][m][0], v1 = acc[ai][bj][m][1];
                    u32x4 w; w.x = cvt_pk_bf16(v0[0], v0[1]); w.y = cvt_pk_bf16(v0[2], v0[3]); w.z = cvt_pk_bf16(v1[0], v1[1]); w.w = cvt_pk_bf16(v1[2], v1[3]);
                    *(GAS u32x4*)(rowp + bj * HALF) = w; } }
    }
};
struct EpiResid {
    static constexpr bool PERM = false;
    GAS bf16_t* X; int row_off; const GAS float* mod;
    const GAS float* src_ctx; const GAS float* src_lat;
    __device__ __forceinline__ void operator()(const f32x4 (&acc)[2][2][4][2], const Unit& u, int wr, int wc, int fr, int fq) const {
        const int row0 = row_off + u.pm * BM + wr * 64 + fr, col0 = u.pn * BM + wc * 32 + 4 * fq;
#pragma unroll
        for (int ai = 0; ai < 2; ++ai)
#pragma unroll
            for (int m = 0; m < 4; ++m) { const int row = row0 + ai * HALF + m * 16; GAS bf16_t* rowp = X + (size_t)row * D + col0; const GAS float* gp = mod + (size_t)bidx_of_row(row) * 6144 + col0;
                const GAS float* bp = src_lat ? (row < NCTX ? src_ctx + (size_t)row * D + col0 : src_lat + (size_t)(row - NCTX) * D + col0) : (const GAS float*)nullptr;
#pragma unroll
                for (int bj = 0; bj < 2; ++bj)
#pragma unroll
                    for (int n = 0; n < 2; ++n) { const f32x4 g = *(const GAS f32x4*)(gp + bj * HALF + n * 16);
                        f32x4 x = src_lat ? *(const GAS f32x4*)(bp + bj * HALF + n * 16) : bf4f(*(const GAS v2u*)(rowp + bj * HALF + n * 16));
                        x = x + g * acc[ai][bj][m][n]; *(GAS v2u*)(rowp + bj * HALF + n * 16) = f4bf(x); } }
    }
};
struct EpiGateUp {
    static constexpr bool PERM = true;
    GAS bf16_t* O; unsigned nbytes;
    __device__ __forceinline__ void operator()(const f32x4 (&acc)[2][2][4][2], const Unit& u, int wr, int wc, int fr, int fq) const {
        const int row0 = u.pm * BM + wr * 64 + fr, col0 = u.pn * HALF + wc * 32 + 8 * fq;
        const __amdgpu_buffer_rsrc_t rsrc = __builtin_amdgcn_make_buffer_rsrc((void*)O, 0, (int)nbytes, 0x00020000);
#pragma unroll
        for (int ai = 0; ai < 2; ++ai)
#pragma unroll
            for (int m = 0; m < 4; ++m) { const unsigned off = (unsigned)((row0 + ai * HALF + m * 16) * 256 + col0) * 2u;
                float r[8];
#pragma unroll
                for (int n = 0; n < 2; ++n)
#pragma unroll
                    for (int j = 0; j < 4; ++j) { const float g = acc[ai][0][m][n][j], up = acc[ai][1][m][n][j]; r[n * 4 + j] = g * __builtin_amdgcn_rcpf(1.f + __expf(-g)) * up; }
                u32x4 w; w.x = cvt_pk_bf16(r[0], r[1]); w.y = cvt_pk_bf16(r[2], r[3]); w.z = cvt_pk_bf16(r[4], r[5]); w.w = cvt_pk_bf16(r[6], r[7]);
                __builtin_amdgcn_raw_buffer_store_b128(w, rsrc, (int)off, 0, 16); }
    }
};

template <class Epi, class Sched, class Rows = LinearRows>
__device__ __forceinline__ void gemm_phase(PG8_LAS unsigned char* lds, const Gemm g, const Sched& S, const Epi& E, const Rows RM = Rows()) {
    const int tid = threadIdx.x, wid = __builtin_amdgcn_readfirstlane(tid >> 6), lane = tid & 63, wr = wid >> 2, wc = wid & 3, fr = lane & 15, fq = lane >> 4;
    const int K = g.K, nt = K / BK;
    unsigned voffB[2]; int rA[2], cA2[2];
#pragma unroll
    for (int i = 0; i < 2; ++i) { int R, C; stage_rc(tid * 16 + i * 8192, R, C); const int Rb = Epi::PERM ? ((R & ~31) + perm32(R & 31)) : R;
        rA[i] = R; cA2[i] = C * 2; voffB[i] = (unsigned)(Rb * K + C) * 2u; }
    unsigned oAc[2][2], oAn[2][2];
#define PG8_AOFF(dst, u) do { _Pragma("unroll") for (int _h = 0; _h < 2; ++_h) _Pragma("unroll") for (int _i = 0; _i < 2; ++_i) dst[_h][_i] = (unsigned)RM(u, _h * HALF + rA[_i]) * (unsigned)(K * 2) + (unsigned)cA2[_i]; } while (0)
#define PG8_STAGE_A(bufoff, o2, kbyte) do { _Pragma("unroll") for (int _i = 0; _i < 2; ++_i) \
        __builtin_amdgcn_global_load_lds((const unsigned*)((const char*)g.A + (size_t)(kbyte) + (o2)[_i]), (PG8_LAS unsigned*)(lds + (bufoff) + ldsw + _i * 8192), 16, 0, 0); } while (0)
    const size_t kstep = (size_t)(BK * 2);
    const size_t hstep = (size_t)HALF * K * 2;
    const size_t tstep = 2 * hstep;
    const unsigned ldsw = (unsigned)wid * 1024u;
    const int aoff = lds_byte(wr * 64 + fr, fq * 8), boff = lds_byte(wc * 32 + fr, fq * 8);
#define PG8_SA(b, h) (((b) * 2 + (h)) * HTB)
#define PG8_SB(b, h) ((4 + (b) * 2 + (h)) * HTB)
#define PG8_STAGE(bufoff, gbase, voff) do { _Pragma("unroll") for (int _i = 0; _i < 2; ++_i) \
        __builtin_amdgcn_global_load_lds((const unsigned*)((const char*)(gbase) + (voff)[_i]), (PG8_LAS unsigned*)(lds + (bufoff) + ldsw + _i * 8192), 16, 0, 0); } while (0)
#define PG8_LDA(dst, b, h) do { _Pragma("unroll") for (int m = 0; m < 4; ++m) _Pragma("unroll") for (int k = 0; k < 2; ++k) dst[m][k] = *(const PG8_LAS bf16x8*)(lds + PG8_SA(b, h) + aoff + m * 2048 + k * 1024); } while (0)
#define PG8_LDB(dst, b, h) do { _Pragma("unroll") for (int n = 0; n < 2; ++n) _Pragma("unroll") for (int k = 0; k < 2; ++k) dst[n][k] = *(const PG8_LAS bf16x8*)(lds + PG8_SB(b, h) + boff + n * 2048 + k * 1024); } while (0)
#define PG8_MMA(ai, bj, At, Bt) do { __builtin_amdgcn_s_setprio(1); _Pragma("unroll") for (int m = 0; m < 4; ++m) _Pragma("unroll") for (int n = 0; n < 2; ++n) _Pragma("unroll") for (int k = 0; k < 2; ++k) \
        acc[ai][bj][m][n] = __builtin_amdgcn_mfma_f32_16x16x32_bf16(Bt[n][k], At[m][k], acc[ai][bj][m][n], 0, 0, 0); __builtin_amdgcn_s_setprio(0); } while (0)
#define PG8_WAIT_V(n) asm volatile("s_waitcnt vmcnt(" #n ")" ::: "memory")
#define PG8_WAIT_L(n) asm volatile("s_waitcnt lgkmcnt(" #n ")" ::: "memory")
#define PG8_BAR __builtin_amdgcn_s_barrier()
#define PG8_SCHED __builtin_amdgcn_sched_barrier(0)
    Unit cur, nxt; int ui = 0;
    if (!S.next(0, cur)) return;
    f32x4 acc[2][2][4][2];
#pragma unroll
    for (int a = 0; a < 2; ++a)
#pragma unroll
        for (int b = 0; b < 2; ++b)
#pragma unroll
            for (int m = 0; m < 4; ++m)
#pragma unroll
                for (int n = 0; n < 2; ++n) acc[a][b][m][n] = (f32x4){0.f, 0.f, 0.f, 0.f};
    bf16x8 At[4][2], B0[2][2], B1[2][2];
    const char* cB = (const char*)g.Bt + cur.bo + (size_t)cur.pn * tstep;
    S.a_ready(cur);
    PG8_AOFF(oAc, cur);
    PG8_STAGE(PG8_SB(0, 0), cB, voffB); PG8_STAGE_A(PG8_SA(0, 0), oAc[0], 0); PG8_STAGE(PG8_SB(0, 1), cB + hstep, voffB); PG8_STAGE_A(PG8_SA(0, 1), oAc[1], 0);
    if (wr == 1) PG8_BAR;
    PG8_WAIT_V(4); PG8_BAR;
    PG8_STAGE(PG8_SB(1, 0), cB + kstep, voffB); PG8_STAGE_A(PG8_SA(1, 0), oAc[0], kstep); PG8_STAGE(PG8_SB(1, 1), cB + hstep + kstep, voffB);
    PG8_WAIT_V(6); PG8_BAR;
    for (;;) {
        const bool has_next = S.next(ui + 1, nxt);
        const char* nB = has_next ? (const char*)g.Bt + nxt.bo + (size_t)nxt.pn * tstep : cB;
        unsigned dAn = 0u;
        if constexpr (Rows::LINEAR) { if (has_next) dAn = (unsigned)(nxt.pm - cur.pm) * (unsigned)(BM * K * 2); }
        else { if (has_next) PG8_AOFF(oAn, nxt);
            else {
#pragma unroll
                for (int _h = 0; _h < 2; ++_h)
#pragma unroll
                    for (int _i = 0; _i < 2; ++_i) oAn[_h][_i] = oAc[_h][_i]; } }
        for (int t = 0; t < nt; t += 2) {
            const bool last = (t == nt - 2);
            const size_t k1 = (size_t)(t + 1) * kstep, k2 = last ? 0 : (size_t)(t + 2) * kstep, k3 = k2 + kstep;
            unsigned o20[2], o21[2];
#pragma unroll
            for (int _i = 0; _i < 2; ++_i) { if constexpr (Rows::LINEAR) { o20[_i] = oAc[0][_i] + (last ? dAn : 0u); o21[_i] = oAc[1][_i] + (last ? dAn : 0u); }
                else { o20[_i] = last ? oAn[0][_i] : oAc[0][_i]; o21[_i] = last ? oAn[1][_i] : oAc[1][_i]; } }
            const char* b2 = last ? nB : cB + (size_t)(t + 2) * kstep;
            const char* b3 = b2 + kstep;
            if (last && has_next) S.a_ready(nxt);
            PG8_LDB(B0, 0, 0); PG8_SCHED; PG8_LDA(At, 0, 0); PG8_STAGE_A(PG8_SA(1, 1), oAc[1], k1);
            PG8_WAIT_L(8); PG8_BAR; PG8_WAIT_L(0); PG8_MMA(0, 0, At, B0); PG8_BAR; PG8_SCHED;
            PG8_LDB(B1, 0, 1); PG8_STAGE(PG8_SB(0, 0), b2, voffB);
            PG8_BAR; PG8_WAIT_L(0); PG8_MMA(0, 1, At, B1); PG8_BAR;
            PG8_LDA(At, 0, 1); PG8_STAGE_A(PG8_SA(0, 0), o20, k2);
            PG8_BAR; PG8_WAIT_L(0); PG8_MMA(1, 0, At, B0); PG8_BAR; PG8_SCHED;
            PG8_STAGE(PG8_SB(0, 1), b2 + hstep, voffB);
            PG8_WAIT_V(6); PG8_BAR; PG8_MMA(1, 1, At, B1); PG8_BAR;
            PG8_LDB(B0, 1, 0); PG8_SCHED; PG8_LDA(At, 1, 0); PG8_STAGE_A(PG8_SA(0, 1), o21, k2);
            PG8_WAIT_L(8); PG8_BAR; PG8_WAIT_L(0); PG8_MMA(0, 0, At, B0); PG8_BAR; PG8_SCHED;
            PG8_LDB(B1, 1, 1); PG8_STAGE(PG8_SB(1, 0), b3, voffB);
            PG8_BAR; PG8_WAIT_L(0); PG8_MMA(0, 1, At, B1); PG8_BAR;
            PG8_LDA(At, 1, 1); PG8_STAGE_A(PG8_SA(1, 0), o20, k3);
            PG8_BAR; PG8_WAIT_L(0); PG8_MMA(1, 0, At, B0); PG8_BAR; PG8_SCHED;
            PG8_STAGE(PG8_SB(1, 1), b3 + hstep, voffB);
            PG8_WAIT_V(6); PG8_BAR; PG8_MMA(1, 1, At, B1); PG8_BAR;
        }
        E(acc, cur, wr, wc, fr, fq); S.done(cur);
        if (!has_next) break;
#pragma unroll
        for (int a = 0; a < 2; ++a)
#pragma unroll
            for (int b = 0; b < 2; ++b)
#pragma unroll
                for (int m = 0; m < 4; ++m)
#pragma unroll
                    for (int n = 0; n < 2; ++n) acc[a][b][m][n] = (f32x4){0.f, 0.f, 0.f, 0.f};
        cur = nxt; cB = nB; ++ui;
#pragma unroll
        for (int _h = 0; _h < 2; ++_h)
#pragma unroll
            for (int _i = 0; _i < 2; ++_i) { if constexpr (Rows::LINEAR) oAc[_h][_i] += dAn; else oAc[_h][_i] = oAn[_h][_i]; }
    }
    PG8_WAIT_V(0);
    if (wr == 0) PG8_BAR;
    PG8_BAR;
#undef PG8_SA
#undef PG8_SB
#undef PG8_STAGE
#undef PG8_STAGE_A
#undef PG8_AOFF
#undef PG8_LDA
#undef PG8_LDB
#undef PG8_MMA
#undef PG8_WAIT_V
#undef PG8_WAIT_L
#undef PG8_BAR
#undef PG8_SCHED
}
}

#define XB_TMO      128
#define XB_XCNT(j)  (256  + 64 * (j))
#define XB_XSUB(j)  (1280 + 64 * (j))
#define XB_XGEN(j)  (2304 + 64 * (j))
#define XB_TOP      3328
#define XB_TOPGEN   3392
#define XCD_BAR_WORDS 3456
#define XB_SPIN_CAP (1u << 18)
__device__ __forceinline__ unsigned xb_ld(unsigned* p)              { return __hip_atomic_load(p, __ATOMIC_RELAXED, __HIP_MEMORY_SCOPE_AGENT); }
__device__ __forceinline__ unsigned xb_add(unsigned* p, unsigned v) { return __hip_atomic_fetch_add(p, v, __ATOMIC_RELAXED, __HIP_MEMORY_SCOPE_AGENT); }
__device__ __forceinline__ unsigned xb_xcc_id() { return (unsigned)__builtin_amdgcn_s_getreg((3 << 11) | 20) & 0xFu; }
#define XB_SPIN(cond, bar) do { unsigned _sp = 0; while (cond) { __builtin_amdgcn_s_sleep(1); \
    if ((++_sp & 255u) == 0u) { if (xb_ld(&(bar)[XB_TMO])) break; if (_sp > XB_SPIN_CAP) { atomicAdd(&(bar)[XB_TMO], 1u); break; } } } } while (0)
struct XcdBarrier { unsigned* bar; unsigned x; volatile LAS unsigned* st; };
__device__ __forceinline__ XcdBarrier xcd_barrier_post(unsigned* bar, volatile LAS unsigned* st) {
    XcdBarrier b; b.bar = bar; b.x = xb_xcc_id(); b.st = st;
    if (threadIdx.x == 0) (void)xb_add(&bar[XB_XCNT(b.x)], 1u);
    return b;
}
__device__ __forceinline__ void xcd_barrier_complete(unsigned* bar, unsigned x, unsigned& nloc, unsigned& nx) {
    const unsigned G = gridDim.x * gridDim.y * gridDim.z;
    unsigned sum, cnt, mine, sp = 0u;
    for (;;) {
        sum = 0u; cnt = 0u; mine = 0u;
#pragma unroll
        for (unsigned j = 0; j < 16; ++j) { const unsigned c = xb_ld(&bar[XB_XCNT(j)]); sum += c; cnt += (c > 0u) ? 1u : 0u; mine = (j == x) ? c : mine; }
        if (sum == G) break;
        __builtin_amdgcn_s_sleep(1);
        if ((++sp & 255u) == 0u) { if (xb_ld(&bar[XB_TMO])) break; if (sp > XB_SPIN_CAP) { atomicAdd(&bar[XB_TMO], 1u); break; } }
    }
    nloc = mine > 0u ? mine : 1u; nx = cnt > 0u ? cnt : 1u;
}
__device__ __forceinline__ void xcd_barrier(const XcdBarrier& b) {
    asm volatile("s_waitcnt vmcnt(0)" ::: "memory");
    __syncthreads();
    if (threadIdx.x == 0) {
        unsigned* bar = b.bar;
        __builtin_amdgcn_s_waitcnt(0);
        unsigned nloc = b.st[0], nx = b.st[1];
        if (nloc == 0u) { xcd_barrier_complete(bar, b.x, nloc, nx); b.st[0] = nloc; b.st[1] = nx; }
        const unsigned old = xb_add(&bar[XB_XSUB(b.x)], 1u);
        const unsigned gen = old / nloc;
        if (old + 1u == (gen + 1u) * nloc) {
            __builtin_amdgcn_fence(__ATOMIC_RELEASE, "agent");
            asm volatile("s_waitcnt vmcnt(0)" ::: "memory");
            const unsigned og = xb_add(&bar[XB_TOP], 1u);
            const unsigned tg = og / nx;
            if (og + 1u == (tg + 1u) * nx) xb_add(&bar[XB_TOPGEN], 1u);
            else XB_SPIN(xb_ld(&bar[XB_TOPGEN]) == tg, bar);
            __builtin_amdgcn_fence(__ATOMIC_ACQUIRE, "agent");
            xb_add(&bar[XB_XGEN(b.x)], 1u);
            asm volatile("s_waitcnt vmcnt(0)" ::: "memory");
        } else {
            XB_SPIN(xb_ld(&bar[XB_XGEN(b.x)]) == gen, bar);
            __builtin_amdgcn_fence(__ATOMIC_ACQUIRE, "agent");
            asm volatile("s_waitcnt vmcnt(0)" ::: "memory");
        }
    }
    __syncthreads();
}

struct Args { const float* in[N_IN]; float* out; unsigned char* ws; int ph_lo, ph_hi; int pad0, pad1; };
extern __shared__ __attribute__((aligned(16))) unsigned char lds_raw[];
constexpr int PTR_OFF = MISC_OFF + 2048;
struct Ctx {
    DI unsigned long long raw(int i) const { volatile LAS unsigned* t = (volatile LAS unsigned*)((LAS unsigned char*)lds_raw + PTR_OFF) + 2 * i;
        const unsigned lo = __builtin_amdgcn_readfirstlane(t[0]), hi = __builtin_amdgcn_readfirstlane(t[1]); return ((unsigned long long)hi << 32) | lo; }
    DI const GAS float* in(int i) const { return (const GAS float*)raw(i); }
    DI GAS float* out() const { return (GAS float*)raw(N_IN); }
    DI GAS unsigned char* ws() const { return (GAS unsigned char*)raw(N_IN + 1); }
};

DI void transpose_item(const GAS float* W, int N, int k0, int n0, GAS bf16* WT, int Kd, int drow0, LAS float* scr, int lane) {
    float wv[32];
#pragma unroll
    for (int i = 0; i < 32; ++i) wv[i] = W[(size_t)(k0 + 2 * i + (lane >> 5)) * N + n0 + (lane & 31)];
#pragma unroll
    for (int i = 0; i < 32; ++i) scr[(2 * i + (lane >> 5)) * 33 + (lane & 31)] = wv[i];
    LDS_WAIT(); asm volatile("" ::: "memory");
    const int c = lane & 7;
#pragma unroll
    for (int j = 0; j < 4; ++j) { const int n = (lane >> 3) + 8 * j; const LAS float* s = scr + (8 * c) * 33 + n;
        v4u o; o.x = pk2(s[0 * 33], s[1 * 33]); o.y = pk2(s[2 * 33], s[3 * 33]); o.z = pk2(s[4 * 33], s[5 * 33]); o.w = pk2(s[6 * 33], s[7 * 33]);
        *(GAS v4u*)(WT + (size_t)(drow0 + n) * Kd + k0 + 8 * c) = o; }
    LDS_WAIT(); asm volatile("" ::: "memory");
}

DI void weight_copies(const Ctx& a, int l, LAS unsigned char* lds, int tid, int lane, int wave, int gwv, int ngw, int gt, int ngt) {
    GAS unsigned char* ws = a.ws();
    for (int i = gt; i < 128 * 1024 / 8; i += ngt) *(GAS v4u*)(ws + WS_WTIN + (size_t)l * WTIN_L + (size_t)3200 * D * 2 + (size_t)i * 16) = (v4u){0u, 0u, 0u, 0u};
    LAS float* scr = (LAS float*)(lds + wave * 16384);
    constexpr int IT_IN = 16 * 100, IT_OUT = 16 * 32, IT_UQ = 3 * 12, IT_UKV = 2 * 16, IT_GU = 32 * 16 * 16, IT_DN = 32 * 4 * 32;
    constexpr int NITEMS = IT_IN + IT_OUT + IT_UQ + IT_UKV + IT_GU + IT_DN;
    for (int it = gwv; it < NITEMS; it += ngw) {
        int r = it;
        if (r < IT_IN) { const int kb = r / 100, nb = r % 100;
            transpose_item(a.in(I_WIN) + (size_t)l * D * DIN, DIN, kb * 64, nb * 32, (GAS bf16*)(ws + WS_WTIN + (size_t)l * WTIN_L), D, nb * 32, scr, lane); continue; } r -= IT_IN;
        if (r < IT_OUT) { const int kb = r / 32, nb = r % 32;
            transpose_item(a.in(I_WOUT) + (size_t)l * D * D, D, kb * 64, nb * 32, (GAS bf16*)(ws + WS_WTOUT + (size_t)l * D * D * 2), D, nb * 32, scr, lane); continue; } r -= IT_OUT;
        if (r < IT_UQ) { const int kb = r / 12, nb = r % 12;
            transpose_item(a.in(I_WUQ) + (size_t)l * 192 * 384, 384, kb * 64, nb * 32, (GAS bf16*)(ws + WS_WTUQ + (size_t)l * 384 * 192 * 2), 192, nb * 32, scr, lane); continue; } r -= IT_UQ;
        if (r < IT_UKV) { const int kb = r / 16, nb = r % 16;
            transpose_item(a.in(I_WUKV) + (size_t)l * 128 * 512, 512, kb * 64, nb * 32, (GAS bf16*)(ws + WS_WTUKV + (size_t)l * 512 * 128 * 2), 128, nb * 32, scr, lane); continue; } r -= IT_UKV;
        if (r < IT_GU) { const int le = l * 32 + r / 256, q = r % 256, kb = q / 16, nb = q % 16; const int n0 = nb * 32, c0 = n0 & 255, isup = n0 >> 8;
            const int drow0 = (c0 >> 7) * 256 + isup * 128 + (c0 & 127);
            transpose_item(a.in(I_WGU) + (size_t)le * D * 512, 512, kb * 64, n0, (GAS bf16*)(ws + WS_WTGU + (size_t)le * 512 * D * 2), D, drow0, scr, lane); continue; } r -= IT_GU;
        { const int le = l * 32 + r / 128, q = r % 128, kb = q / 32, nb = q % 32;
            transpose_item(a.in(I_WDN) + (size_t)le * 256 * D, D, kb * 64, nb * 32, (GAS bf16*)(ws + WS_WTDN + (size_t)le * D * 256 * 2), 256, nb * 32, scr, lane); }
    }
}

DI void phase_prologue(const Ctx& a, LAS unsigned char* lds, int tid, int lane, int wave, int bid, int G) {
    GAS unsigned char* ws = a.ws();
    GAS float* MOD = (GAS float*)(ws + WS_MOD);
    {
        LAS float* S = (LAS float*)lds;
        LAS float* R = (LAS float*)(lds + 5 * 1024 * 4);
        if (bid < 192) {
            const GAS float* cvec = a.in(I_C); const GAS float* cctx = a.in(I_CCTX);
            for (int i = tid; i < 5 * 1024; i += 512) { const int r = i >> 10, k = i & 1023; const float v = r < 4 ? cvec[r * 1024 + k] : cctx[k]; S[i] = silu_(v); }
        }
        __syncthreads();
        for (int u = bid; u < 192; u += G) {
            const int l = u / 96, cl = tid & 63, n = (u % 96) * 64 + cl, ks = tid >> 6;
            const GAS float* W = a.in(I_WMOD) + (size_t)l * 1024 * 6144 + n; const GAS float* bmod = a.in(I_BMOD);
            float acc[5] = {0.f, 0.f, 0.f, 0.f, 0.f};
            for (int k = ks * 128; k < ks * 128 + 128; ++k) { const float w = W[(size_t)k * 6144];
#pragma unroll
                for (int r = 0; r < 5; ++r) acc[r] += S[r * 1024 + k] * w; }
#pragma unroll
            for (int r = 0; r < 5; ++r) R[(ks * 5 + r) * 64 + cl] = acc[r];
            __syncthreads();
            if (tid < 320) { const int r = tid >> 6; float s = 0.f;
#pragma unroll
                for (int k2 = 0; k2 < 8; ++k2) s += R[(k2 * 5 + r) * 64 + cl];
                MOD[(size_t)(l * 5 + r) * 6144 + n] = s + bmod[l * 6144 + n]; }
            __syncthreads();
        }
    }
    for (int i = bid * 512 + tid; i < 2 * 48 * 1024; i += G * 512) { const int l = i / (48 * 1024), r = i % (48 * 1024), c = r >> 10, k = r & 1023;
        const float w = c < 4 ? a.in(I_WRG)[(size_t)l * D * 4 + k * 4 + c] : (c < 36 ? a.in(I_WRE)[(size_t)l * D * 32 + k * 32 + (c - 4)] : 0.f);
        const unsigned hi = f2bf(w); const float lo = w - bf2f(hi);
        GAS bf16* WR = (GAS bf16*)(ws + WS_WR) + (size_t)l * 2 * 48 * 1024;
        WR[c * 1024 + k] = (bf16)hi; WR[48 * 1024 + c * 1024 + k] = (bf16)f2bf(lo); }
    weight_copies(a, 0, lds, tid, lane, wave, bid * 8 + wave, G * 8, bid * 512 + tid, G * 512);
}

DI void norm_row_store(const f32x4 (&v)[4], const GAS float* g, const GAS float* shift, const GAS float* scale, GAS bf16* hrow, int lane) {
    float ss = 0.f;
#pragma unroll
    for (int j = 0; j < 4; ++j) ss += (v[j].x * v[j].x + v[j].y * v[j].y) + (v[j].z * v[j].z + v[j].w * v[j].w);
    const float rstd = rsqrtf(wave_sum(ss) * (1.f / D) + EPS);
#pragma unroll
    for (int j = 0; j < 4; ++j) { const int c = 4 * lane + 256 * j;
        const f32x4 gg = *(const GAS f32x4*)(g + c), sh = *(const GAS f32x4*)(shift + c), sc = *(const GAS f32x4*)(scale + c);
        const f32x4 y = v[j] * rstd * gg * (1.f + sc) + sh;
        v2u o; o.x = pk2(y.x, y.y); o.y = pk2(y.z, y.w); *(GAS v2u*)(hrow + c) = o; }
}

DI void phase_norm1_l0(const Ctx& a, int lane, int gw, int NGW) {
    GAS unsigned char* ws = a.ws(); GAS bf16* H = (GAS bf16*)(ws + WS_H); const GAS float* MOD = (const GAS float*)(ws + WS_MOD);
    const GAS float* xin = a.in(I_X); const GAS float* cin = a.in(I_CTX); const GAS float* n1g = a.in(I_N1G);
    for (int m = gw; m < MTOK; m += NGW) {
        const GAS float* src = m < NCTX ? cin + (size_t)m * D : xin + (size_t)(m - NCTX) * D;
        f32x4 v[4];
#pragma unroll
        for (int j = 0; j < 4; ++j) v[j] = *(const GAS f32x4*)(src + 4 * lane + 256 * j);
        const GAS float* mb = MOD + (size_t)bidx_of_row(m) * 6144;
        norm_row_store(v, n1g, mb, mb + 1024, H + (size_t)m * D, lane);
    }
}

DI bf16x8 ld8(const LAS bf16* p) { return *(const LAS bf16x8*)p; }
DI bf16x8 ld8(const GAS bf16* p) { return *(const GAS bf16x8*)p; }
template <class PA, class PB>
DI f32x4 mma16(PA A, int lda, PB B, int ldb, int K, int lane) {
    f32x4 acc = {0.f, 0.f, 0.f, 0.f};
    const int r = lane & 15, q = (lane >> 4) * 8;
    for (int k = 0; k < K; k += 32) {
        const bf16x8 av = ld8(A + r * lda + k + q);
        const bf16x8 bv = ld8(B + r * ldb + k + q);
        acc = __builtin_amdgcn_mfma_f32_16x16x32_bf16(av, bv, acc, 0, 0, 0);
    }
    return acc;
}

constexpr int CQ_P = 200, CKV_P = 136, STG_P = 520;
constexpr int PR = 64, PL_CQ = 0, PL_CKV = 25600, PL_RK = 43008, PL_STG = 47104, PL_T = PL_STG;
DI float rope_ang(int t, int ri) { const int ax = ri >> 4, f = ri & 7; const float p = (float)(ax == 0 ? (t >> 6) : (t & 63)); return p * __builtin_amdgcn_exp2f(-1.6609640474436813f * (float)f) * 0.15915494309189535f; }
DI void prep_unit(const Ctx& a, int l, int unit, LAS unsigned char* lds, int tid, int lane, int wave) {
    GAS unsigned char* ws = a.ws();
    const GAS bf16* P = (const GAS bf16*)(ws + WS_P);
    LAS bf16* CQ = (LAS bf16*)(lds + PL_CQ); LAS bf16* CKV = (LAS bf16*)(lds + PL_CKV); LAS bf16* STG = (LAS bf16*)(lds + PL_STG); LAS bf16* RK = (LAS bf16*)(lds + PL_RK); LAS bf16* T = (LAS bf16*)(lds + PL_T);
    const int m0 = unit * PR;
    const bool isctx = m0 < NCTX;
    const int bb = isctx ? (m0 >> 8) : ((m0 - NCTX) >> 12);
    const int pos0 = isctx ? (m0 & 255) : (256 + ((m0 - NCTX) & 4095));
    const int t0 = isctx ? 0 : ((m0 - NCTX) & 4095);
    { const GAS float* gq = a.in(I_QNG) + l * 192; const GAS float* gkv = a.in(I_KVNG) + l * 128;
        const bool isq = lane < 24, iskv = lane >= 24 && lane < 40; const int pc = isq ? lane : lane - 24;
        float gn[8];
#pragma unroll
        for (int e = 0; e < 8; ++e) gn[e] = isq ? gq[pc * 8 + e] : (iskv ? gkv[pc * 8 + e] : 0.f);
#pragma unroll
        for (int rr = 0; rr < PR / 8; ++rr) { const int r = wave * (PR / 8) + rr; float x[8];
            v4u w = (v4u){0u, 0u, 0u, 0u}; if (lane < 40) w = *(const GAS v4u*)(P + (size_t)(m0 + r) * PP + (isq ? CD_Q : CD_KV) + pc * 8);
            unpack8(w, x); float ss = 0.f;
#pragma unroll
            for (int e = 0; e < 8; ++e) ss += x[e] * x[e];
            const float sq = wave_sum(isq ? ss : 0.f), skv = wave_sum(iskv ? ss : 0.f);
            const float rs = isq ? rsqrtf(sq * (1.f / 192.f) + EPS) : rsqrtf(skv * (1.f / 128.f) + EPS);
#pragma unroll
            for (int e = 0; e < 8; ++e) x[e] *= rs * gn[e];
            const v4u o = (v4u){pk2(x[0], x[1]), pk2(x[2], x[3]), pk2(x[4], x[5]), pk2(x[6], x[7])};
            if (isq) *(LAS v4u*)(CQ + r * CQ_P + pc * 8) = o; else if (iskv) *(LAS v4u*)(CKV + r * CKV_P + pc * 8) = o; } }
    for (int e = tid; e < PR * 32; e += 512) { const int r = e >> 5, ri = e & 31; const GAS bf16* prow = P + (size_t)(m0 + r) * PP + CD_R;
        float v = bf2f(prow[ri]);
        if (!isctx) { const float pv = bf2f(prow[ri ^ 8]); const float ang = rope_ang(t0 + r, ri); const float cs = __builtin_amdgcn_cosf(ang), sn = __builtin_amdgcn_sinf(ang);
            v = ((ri >> 3) & 1) == 0 ? (v * cs - pv * sn) : (pv * sn + v * cs); }
        RK[r * 32 + ri] = (bf16)f2bf(v); }
    for (int e = tid; e < PR * 32; e += 512) { const int r = e >> 5, c8 = e & 31; *(LAS v4u*)(T + r * 264 + c8 * 8) = *(const GAS v4u*)(P + (size_t)(m0 + r) * PP + CB_V + c8 * 8); }
    __syncthreads();
    GAS bf16* QM = (GAS bf16*)(ws + WS_QM); GAS bf16* KM = (GAS bf16*)(ws + WS_KM); GAS bf16* VM = (GAS bf16*)(ws + WS_VM); GAS bf16* VNT = (GAS bf16*)(ws + WS_VNT);
    const GAS bf16* WTQ = (const GAS bf16*)(ws + WS_WTUQ + (size_t)l * 384 * 192 * 2);
    const GAS bf16* WTKV = (const GAS bf16*)(ws + WS_WTUKV + (size_t)l * 512 * 128 * 2);
    const float qs = 0.10206207261596575f * LOG2E;
    const int fr = lane & 15, fq = lane >> 4;
    for (int e = tid; e < 256 * (PR / 8); e += 512) { const int col = e / (PR / 8), p8 = e % (PR / 8); unsigned hv[8];
#pragma unroll
        for (int j = 0; j < 8; ++j) hv[j] = T[(p8 * 8 + j) * 264 + col];
        *(GAS v4u*)(VNT + ((size_t)(bb * 4) * 64 + col) * NKEY + pos0 + p8 * 8) = (v4u){hv[0] | (hv[1] << 16), hv[2] | (hv[3] << 16), hv[4] | (hv[5] << 16), hv[6] | (hv[7] << 16)}; }
    __syncthreads();
    { bf16x8 bfr[3][6];
#pragma unroll
      for (int i = 0; i < 3; ++i)
#pragma unroll
        for (int ks = 0; ks < 6; ++ks) bfr[i][ks] = *(const GAS bf16x8*)(WTQ + (size_t)((wave + 8 * i) * 16 + fr) * 192 + ks * 32 + fq * 8);
#pragma unroll
      for (int i = 0; i < 3; ++i) { const int nb = wave + 8 * i;
        const int c = nb * 16 + fr, within = c % 96;
#pragma unroll
        for (int mb = 0; mb < PR / 16; ++mb) { f32x4 acc = {0.f, 0.f, 0.f, 0.f};
#pragma unroll
            for (int ks = 0; ks < 6; ++ks) acc = __builtin_amdgcn_mfma_f32_16x16x32_bf16(*(const LAS bf16x8*)(CQ + (mb * 16 + fr) * CQ_P + ks * 32 + fq * 8), bfr[i][ks], acc, 0, 0, 0);
#pragma unroll
            for (int j = 0; j < 4; ++j) { const int r = mb * 16 + 4 * fq + j; float v = acc[j]; const float pv = __shfl_xor(v, 8);
                if (within >= 64 && !isctx) { const int ri = within - 64; const float ang = rope_ang(t0 + r, ri); const float cs = __builtin_amdgcn_cosf(ang), sn = __builtin_amdgcn_sinf(ang);
                    v = ((ri >> 3) & 1) == 0 ? (v * cs - pv * sn) : (pv * sn + v * cs); }
                STG[r * STG_P + c] = (bf16)f2bf(v * qs); } } } }
    __syncthreads();
    for (int e = tid; e < PR * 48; e += 512) { const int r = e / 48, hp = e % 48, hd = hp / 12, pc = hp % 12;
        *(GAS v4u*)(QM + ((size_t)(bb * 4 + hd) * NKEY + pos0 + r) * 96 + pc * 8) = *(const LAS v4u*)(STG + r * STG_P + hd * 96 + pc * 8); }
    __syncthreads();
    { bf16x8 bfr[4][4];
#pragma unroll
      for (int i = 0; i < 4; ++i)
#pragma unroll
        for (int ks = 0; ks < 4; ++ks) bfr[i][ks] = *(const GAS bf16x8*)(WTKV + (size_t)((wave + 8 * i) * 16 + fr) * 128 + ks * 32 + fq * 8);
#pragma unroll
      for (int i = 0; i < 4; ++i) { const int nb = wave + 8 * i;
#pragma unroll
        for (int mb = 0; mb < PR / 16; ++mb) { f32x4 acc = {0.f, 0.f, 0.f, 0.f};
#pragma unroll
            for (int ks = 0; ks < 4; ++ks) acc = __builtin_amdgcn_mfma_f32_16x16x32_bf16(*(const LAS bf16x8*)(CKV + (mb * 16 + fr) * CKV_P + ks * 32 + fq * 8), bfr[i][ks], acc, 0, 0, 0);
#pragma unroll
            for (int j = 0; j < 4; ++j) STG[(mb * 16 + 4 * fq + j) * STG_P + nb * 16 + fr] = (bf16)f2bf(acc[j]); } } }
    __syncthreads();
    for (int e = tid; e < PR * 48; e += 512) { const int r = e / 48, hp = e % 48, hd = hp / 12, pc = hp % 12;
        const v4u v = pc < 8 ? *(const LAS v4u*)(STG + r * STG_P + hd * 128 + pc * 8) : *(const LAS v4u*)(RK + r * 32 + (pc - 8) * 8);
        *(GAS v4u*)(KM + ((size_t)(bb * 4 + hd) * NKEY + pos0 + r) * 96 + pc * 8) = v; }
    for (int e = tid; e < 256 * (PR / 8); e += 512) { const int col = e / (PR / 8), p8 = e % (PR / 8), hd = col >> 6, dv = col & 63; unsigned hv[8];
#pragma unroll
        for (int j = 0; j < 8; ++j) hv[j] = STG[(p8 * 8 + j) * STG_P + hd * 128 + 64 + dv];
        *(GAS v4u*)(VM + ((size_t)(bb * 4 + hd) * 64 + dv) * NKEY + pos0 + p8 * 8) = (v4u){hv[0] | (hv[1] << 16), hv[2] | (hv[3] << 16), hv[4] | (hv[5] << 16), hv[6] | (hv[7] << 16)}; }
    __syncthreads();
}

constexpr int RP = 65;
DI int scan_row(int b, int dir, int c, int i) {
    const int s = 64 * c + i;
    if (dir == 0) return s < 256 ? b * 256 + s : NCTX + b * SEQ + (s - 256);
    return s < 256 ? b * 256 + 255 - s : NCTX + b * SEQ + SEQ - 1 - (s - 256);
}
#ifndef BAR_LDS
#define BAR_LDS() asm volatile("s_waitcnt lgkmcnt(0)\n\ts_barrier" ::: "memory")
#endif
constexpr int RC_P = 68;
constexpr int L_C = 0, L_QD = 17408, L_QE = 26624, L_KD = 35840, L_VT = 58880, L_ST = 68096, L_ATT = 77312, L_O = 86528, L_T = 103168;
template <int MIX> struct RecCfg { static constexpr int DK = MIX == 0 ? 64 : 32, DKP = DK + 8, NP = DK / 8, CPT = DK / 8; };
template <int MIX> struct RecPre {
    v4u fk;
    v4u zg[MIX == 1 ? 2 : 1];
    v4u qp;
    v4u vp; f32x4 s0, s1;
};
template <int MIX, bool R3>
DI void rec_fetch(RecPre<MIX>& R, const GAS bf16* P, const GAS float* RSbase, int b, int h, int dir, int c, int tid) {
    constexpr int DK = RecCfg<MIX>::DK;
    const int lane = tid & 63, wave = tid >> 6;
    const GAS bf16* prow = P + (size_t)scan_row(b, dir, c, lane) * PP;
    if (MIX == 0) { R.fk = *(const GAS v4u*)(prow + (dir ? CA_FB : CA_FF) + h * 64 + 8 * wave); if (R3) R.qp = *(const GAS v4u*)(prow + CA_Q + h * 64 + 8 * wave); }
    else { const GAS bf16* zr = prow + (dir ? CC_ZB : CC_ZF); R.zg[0] = *(const GAS v4u*)zr; R.zg[1] = *(const GAS v4u*)(zr + 8);
        const v2u kk = *(const GAS v2u*)(prow + CC_K + h * 32 + 4 * wave); R.fk = (v4u){kk.x, kk.y, 0u, 0u};
        if (R3) { const v2u qq = *(const GAS v2u*)(prow + CC_Q + h * 32 + 4 * wave); R.qp = (v4u){qq.x, qq.y, 0u, 0u}; } }
    R.vp = *(const GAS v4u*)(P + (size_t)scan_row(b, dir, c, tid >> 3) * PP + (MIX == 0 ? CA_I : CC_V) + h * 64 + (tid & 7) * 8);
    if (R3 && tid < DK * 8) { const GAS float* rs = RSbase + (size_t)(((b * 4 + h) * 2 + dir) * NCHUNK + c) * DK * 64 + (tid >> 3) * 64 + (tid & 7) * 8; R.s0 = *(const GAS f32x4*)rs; R.s1 = *(const GAS f32x4*)(rs + 4); }
}
DI float dpp_shr_(float v, int ctrl_sel) { const int iv = __builtin_bit_cast(int, v); int r;
    switch (ctrl_sel) { case 1: r = __builtin_amdgcn_update_dpp(0, iv, 0x111, 0xf, 0xf, true); break; case 2: r = __builtin_amdgcn_update_dpp(0, iv, 0x112, 0xf, 0xf, true); break;
                        case 4: r = __builtin_amdgcn_update_dpp(0, iv, 0x114, 0xf, 0xf, true); break; default: r = __builtin_amdgcn_update_dpp(0, iv, 0x118, 0xf, 0xf, true); break; }
    return __builtin_bit_cast(float, r); }
DI float scan64(float v) {
    v += dpp_shr_(v, 1); v += dpp_shr_(v, 2); v += dpp_shr_(v, 4); v += dpp_shr_(v, 8);
    v += __builtin_bit_cast(float, __builtin_amdgcn_update_dpp(0, __builtin_bit_cast(int, v), 0x142, 0xa, 0xf, false));
    v += __builtin_bit_cast(float, __builtin_amdgcn_update_dpp(0, __builtin_bit_cast(int, v), 0x143, 0xc, 0xf, false));
    return v; }
DI float lane_read(float v, int ln) { return __builtin_bit_cast(float, __builtin_amdgcn_readlane(__builtin_bit_cast(int, v), ln)); }
template <int MIX>
DI void rec_front(const RecPre<MIX>& R, const GAS float* lg, const GAS float* wgp, const GAS float* bgp, int l, int h, int dir, int wave, float (&kv)[RecCfg<MIX>::CPT], float (&cum)[RecCfg<MIX>::CPT]) {
    if (MIX == 0) { float z[8]; unpack8(R.fk, z);
#pragma unroll
        for (int e = 0; e < 8; ++e) { const int ch = h * 64 + 8 * wave + e; float lb = 0.f; if (l == 1) lb = sigmoid_(lg[512 + dir * 256 + ch] - lg[dir * 256 + ch]);
            const float f = lb + (1.f - lb) * sigmoid_(z[e]); cum[e] = scan64(__logf(f)); kv[e] = (1.f - lb) * sigmoid_(-z[e]); }
    } else { float z[16], kk[8]; unpack8(R.zg[0], z); unpack8(R.zg[1], z + 8); unpack8(R.fk, kk);
#pragma unroll
        for (int c = 0; c < 4; ++c) { const int ch = h * 32 + 4 * wave + c; float sacc = bgp[ch];
#pragma unroll
            for (int r = 0; r < 16; ++r) sacc += z[r] * wgp[r * 128 + ch];
            cum[c] = scan64(logsigmoid_(sacc) * (1.f / 16.f)); kv[c] = kk[c]; } }
}
template <int N> DI void st_bf16(LAS bf16* p, const float (&v)[N]) {
    if (N == 8) *(LAS v4u*)p = (v4u){pk2(v[0], v[1]), pk2(v[2], v[3]), pk2(v[4], v[5]), pk2(v[6], v[7])};
    else *(LAS v2u*)p = (v2u){pk2(v[0], v[1]), pk2(v[2], v[3])};
}
DI void rec_vt_store(const v4u vp, LAS bf16* VT, int tid) { const int j = tid >> 3, v8 = tid & 7; const unsigned ww[4] = {vp.x, vp.y, vp.z, vp.w};
#pragma unroll
    for (int e = 0; e < 8; ++e) VT[(v8 * 8 + e) * 72 + j] = (bf16)((ww[e >> 1] >> ((e & 1) * 16)) & 0xffffu); }

template <int MIX>
DI void rec_r1_run(const Ctx& a, int l, LAS unsigned char* lds, int tid, int bid, int G) {
    constexpr int DK = RecCfg<MIX>::DK, CPT = RecCfg<MIX>::CPT;
    const int lane = tid & 63, wave = __builtin_amdgcn_readfirstlane(tid >> 6);
    LAS bf16* KT = (LAS bf16*)(lds + L_KD); LAS bf16* VT = (LAS bf16*)(lds + L_VT);
    GAS unsigned char* wsb = a.ws(); const GAS bf16* P = (const GAS bf16*)(wsb + WS_P);
    GAS float* RSb = (GAS float*)(wsb + (MIX == 0 ? WS_RSH : WS_RSG)); GAS float* RAb = (GAS float*)(wsb + (MIX == 0 ? WS_RAH : WS_RAG));
    const GAS float* lg = a.in(I_LBL);
    const GAS float* wgF = a.in(I_WGF) + l * 16 * 128; const GAS float* wgB = a.in(I_WGB) + l * 16 * 128; const GAS float* bgF = a.in(I_BGF) + l * 128; const GAS float* bgB = a.in(I_BGB) + l * 128;
    constexpr int NU = 32 * NCHUNK;
    const bool rebal = (MIX == 0) && (G == 256);
    const int n0 = (rebal && bid < 16) ? 8 : 0, nn = (NU - 1 - bid) / G + 1, n1 = nn + ((rebal && bid >= 128) ? 1 : 0);
    auto unit_at = [&](int n) { if (n >= n1) return NU; if (n < nn) return bid + G * n; const int e = bid - 128; return (e & 15) + G * (e >> 4); };
    RecPre<MIX> Rs[2];
    int nidx = n0;
    int u0 = unit_at(nidx), u1 = unit_at(nidx + 1);
#pragma unroll
    for (int par = 0; par < 2; ++par) { const int unit = par ? u1 : u0; if (unit < NU) { const int c = unit % NCHUNK, chain = unit / NCHUNK; rec_fetch<MIX, false>(Rs[par], P, RSb, chain >> 3, (chain >> 1) & 3, chain & 1, c, tid); } }
    BAR_LDS();
#pragma unroll 1
    while (u0 < NU) {
        const int n2 = unit_at(nidx + 2), n3 = unit_at(nidx + 3);
#pragma unroll
        for (int par = 0; par < 2; ++par) { const int unit = par ? u1 : u0; if (unit < NU) { RecPre<MIX>& R = Rs[par];
            LAS bf16* KTp = par ? (LAS bf16*)(lds + L_ST) : KT; LAS bf16* VTp = par ? (LAS bf16*)(lds + L_ATT) : VT;
            const int c = unit % NCHUNK, chain = unit / NCHUNK, dir = chain & 1, h = (chain >> 1) & 3;
            { float kv[CPT], cum[CPT]; rec_front<MIX>(R, lg, dir ? wgB : wgF, dir ? bgB : bgF, l, h, dir, wave, kv, cum);
#pragma unroll
                for (int e = 0; e < CPT; ++e) { const float last = lane_read(cum[e], 63); KTp[(CPT * wave + e) * 72 + lane] = (bf16)f2bf(kv[e] * __expf(last - cum[e]));
                    if (lane == 63) RAb[(size_t)(chain * NCHUNK + c) * DK + CPT * wave + e] = __expf(cum[e]); } }
            rec_vt_store(R.vp, VTp, tid);
            { const int nu = par ? n3 : n2; if (nu < NU) { const int c2 = nu % NCHUNK, ch2 = nu / NCHUNK; rec_fetch<MIX, false>(R, P, RSb, ch2 >> 3, (ch2 >> 1) & 3, ch2 & 1, c2, tid); } } } }
        BAR_LDS();
#pragma unroll
        for (int par = 0; par < 2; ++par) { const int unit = par ? u1 : u0; if (unit < NU) {
            const LAS bf16* KTp = par ? (const LAS bf16*)(lds + L_ST) : KT; const LAS bf16* VTp = par ? (const LAS bf16*)(lds + L_ATT) : VT;
            const int c = unit % NCHUNK, chain = unit / NCHUNK;
            GAS float* RS = RSb + (size_t)(chain * NCHUNK + c) * DK * 64;
#pragma unroll 1
            for (int tl = wave; tl < (DK / 16) * 4; tl += 8) { const int kb = tl >> 2, vb = tl & 3;
                const f32x4 acc = mma16(KTp + kb * 16 * 72, 72, VTp + vb * 16 * 72, 72, 64, lane);
#pragma unroll
                for (int j = 0; j < 4; ++j) RS[(kb * 16 + 4 * (lane >> 4) + j) * 64 + vb * 16 + (lane & 15)] = acc[j]; } } }
        BAR_LDS();
        nidx += 2; u0 = n2; u1 = n3;
    }
}

DI void rec_r2(const Ctx& a, int gtid, int gthreads) {
    GAS unsigned char* wsb = a.ws();
#pragma unroll 1
    for (int e = gtid; e < 32 * 4096 + 32 * 2048; e += gthreads) {
        const bool g = e >= 32 * 4096; const int ee = g ? e - 32 * 4096 : e; const int DK = g ? 32 : 64, per = DK * 64;
        const int chain = ee / per, kv = ee % per, k = kv >> 6;
        GAS float* RS = (GAS float*)(wsb + (g ? WS_RSG : WS_RSH)) + (size_t)chain * NCHUNK * per + kv;
        const GAS float* RA = (const GAS float*)(wsb + (g ? WS_RAG : WS_RAH)) + (size_t)chain * NCHUNK * DK + k;
        float S = 0.f;
#pragma unroll 1
        for (int c = 0; c < NCHUNK; c += 4) { float U[4], A[4];
#pragma unroll
            for (int u = 0; u < 4; ++u) { U[u] = RS[(size_t)(c + u) * per]; A[u] = RA[(c + u) * DK]; }
#pragma unroll
            for (int u = 0; u < 4; ++u) { RS[(size_t)(c + u) * per] = S; S = A[u] * S + U[u]; } }
    }
}

template <int MIX>
DI void rec_r3_run(const Ctx& a, int l, LAS unsigned char* lds, int tid, int bid, int G, bool keep_ctx) {
    constexpr int DK = RecCfg<MIX>::DK, DKP = RecCfg<MIX>::DKP, CPT = RecCfg<MIX>::CPT;
    const int lane = tid & 63, wave = __builtin_amdgcn_readfirstlane(tid >> 6);
    LAS bf16* QD = (LAS bf16*)(lds + L_QD); LAS bf16* QE = (LAS bf16*)(lds + L_QE); LAS bf16* KD = (LAS bf16*)(lds + L_KD);
    LAS bf16* VT = (LAS bf16*)(lds + L_VT); LAS bf16* ST = (LAS bf16*)(lds + L_ST); LAS bf16* ATT = (LAS bf16*)(lds + L_ATT); LAS float* Ob = (LAS float*)(lds + L_O);
    GAS unsigned char* wsb = a.ws(); const GAS bf16* P = (const GAS bf16*)(wsb + WS_P); GAS bf16* CAT = (GAS bf16*)(wsb + WS_CAT);
    const GAS float* RSb = (const GAS float*)(wsb + (MIX == 0 ? WS_RSH : WS_RSG));
    const GAS float* lg = a.in(I_LBL); const GAS float* ngb = a.in(MIX == 0 ? I_HNG : I_GNG) + l * 256;
    const GAS float* wgF = a.in(I_WGF) + l * 16 * 128; const GAS float* wgB = a.in(I_WGB) + l * 16 * 128; const GAS float* bgF = a.in(I_BGF) + l * 128; const GAS float* bgB = a.in(I_BGB) + l * 128;
    constexpr int nR = 16 * NCHUNK;
    const int nAct = keep_ctx ? nR : 16 * 64, first = (bid + (MIX == 0 ? 0 : G - 64)) % G;
    auto unit_of = [&](int a) { return a >= nAct ? nR : (keep_ctx ? a : (a >> 6) * NCHUNK + 4 + (a & 63)); };
    auto scanc = [&](int tc, int dir) { return dir == 0 ? tc : (tc < 4 ? 3 - tc : 71 - tc); };
    RecPre<MIX> Rs[2];
    int aidx = first;
    int unit = unit_of(aidx);
    if (unit < nR) { const int tc = unit % NCHUNK, bh = unit / NCHUNK; rec_fetch<MIX, true>(Rs[0], P, RSb, bh >> 2, bh & 3, 0, scanc(tc, 0), tid); rec_fetch<MIX, true>(Rs[1], P, RSb, bh >> 2, bh & 3, 1, scanc(tc, 1), tid); }
    BAR_LDS();
#pragma unroll 1
    while (unit < nR) {
        const int tc = unit % NCHUNK, bh = unit / NCHUNK, h = bh & 3, b = bh >> 2;
        const int nunit = unit_of(aidx + G);
        v4u gatep = (v4u){0u, 0u, 0u, 0u};
#pragma unroll
        for (int dir = 0; dir < 2; ++dir) { RecPre<MIX>& R = Rs[dir];
            if (tid < DK * 8) { const int k = tid >> 3, v8 = tid & 7;
#pragma unroll
                for (int e = 0; e < 4; ++e) { ST[(v8 * 8 + e) * DKP + k] = (bf16)f2bf(R.s0[e]); ST[(v8 * 8 + 4 + e) * DKP + k] = (bf16)f2bf(R.s1[e]); } }
            rec_vt_store(R.vp, VT, tid);
            { const int ri = lane, I = ri >> 4; float kv[CPT], cm[CPT], qv[CPT], e8[CPT];
                rec_front<MIX>(R, lg, dir ? wgB : wgF, dir ? bgB : bgF, l, h, dir, wave, kv, cm);
                { float q8[8]; unpack8(R.qp, q8);
#pragma unroll
                    for (int e = 0; e < CPT; ++e) qv[e] = MIX == 0 ? silu_(q8[e]) * 0.125f : q8[e] * 0.17677669529663687f; }
#pragma unroll
                for (int e = 0; e < CPT; ++e) e8[e] = qv[e] * __expf(cm[e]);
                st_bf16<CPT>(QE + ri * DKP + CPT * wave, e8);
#pragma unroll
                for (int I2 = 0; I2 < 4; ++I2) {
                    float rf[CPT];
#pragma unroll
                    for (int e = 0; e < CPT; ++e) rf[e] = I2 == 0 ? 0.f : lane_read(cm[e], 16 * I2 - 1);
                    if (I2 >= I) {
                        if (I2 == I) {
#pragma unroll
                            for (int e = 0; e < CPT; ++e) e8[e] = qv[e] * __expf(cm[e] - rf[e]);
                            st_bf16<CPT>(QD + ri * DKP + CPT * wave, e8); }
#pragma unroll
                        for (int e = 0; e < CPT; ++e) e8[e] = kv[e] * __expf(fminf(rf[e] - cm[e], 80.f));
                        const int rowbase = I2 == 0 ? 0 : (I2 == 1 ? 16 : (I2 == 2 ? 48 : 96));
                        st_bf16<CPT>(KD + (rowbase + ri) * DKP + CPT * wave, e8); } } }
            if (dir == 0) {
                const int row = (tc < 4 ? b * 256 + tc * 64 : NCTX + b * SEQ + (tc - 4) * 64) + (tid >> 3);
                gatep = *(const GAS v4u*)(P + (size_t)row * PP + (MIX == 0 ? CA_G : CC_G) + h * 64 + (tid & 7) * 8); }
            if (nunit < nR) { const int tc2 = nunit % NCHUNK, bh2 = nunit / NCHUNK; rec_fetch<MIX, true>(R, P, RSb, bh2 >> 2, bh2 & 3, dir, scanc(tc2, dir), tid); }
            BAR_LDS();
            { const int I = wave >> 1, g = lane >> 4, c16 = lane & 15;
                const int rowbase = I == 0 ? 0 : (I == 1 ? 16 : (I == 2 ? 48 : 96));
                bf16x8 Bq[2];
#pragma unroll
                for (int m = 0; m < 2; ++m) {
                    f32x4 t0 = mma16(KD + (rowbase + 2 * m * 16) * DKP, DKP, QD + I * 16 * DKP, DKP, DK, lane);
                    f32x4 t1 = mma16(KD + (rowbase + (2 * m + 1) * 16) * DKP, DKP, QD + I * 16 * DKP, DKP, DK, lane);
#pragma unroll
                    for (int jj = 0; jj < 4; ++jj) { const bool up = 4 * g + jj > c16;
                        t0[jj] = (2 * m > I || (2 * m == I && up)) ? 0.f : t0[jj]; t1[jj] = (2 * m + 1 > I || (2 * m + 1 == I && up)) ? 0.f : t1[jj]; }
                    Bq[m] = pack8(t0[0], t0[1], t0[2], t0[3], t1[0], t1[1], t1[2], t1[3]); }
#pragma unroll
                for (int u = 0; u < 2; ++u) { const int vb = 2 * (wave & 1) + u; f32x4 acc = {0.f, 0.f, 0.f, 0.f};
#pragma unroll
                    for (int m = 0; m < 2; ++m) { const LAS bf16* vr = VT + (vb * 16 + c16) * 72 + 32 * m + 4 * g;
                        const v2u lo = *(const LAS v2u*)vr, hi = *(const LAS v2u*)(vr + 16);
                        acc = __builtin_amdgcn_mfma_f32_16x16x32_bf16(__builtin_bit_cast(bf16x8, (v4u){lo.x, lo.y, hi.x, hi.y}), Bq[m], acc, 0, 0, 0); }
                    const f32x4 acc2 = mma16(ST + vb * 16 * DKP, DKP, QE + I * 16 * DKP, DKP, DK, lane);
#pragma unroll
                    for (int jj = 0; jj < 4; ++jj) { const int i = I * 16 + c16, v = vb * 16 + 4 * g + jj; const float o = acc[jj] + acc2[jj];
                        if (dir == 0) Ob[i * RP + v] = o; else Ob[(63 - i) * RP + v] += o; } } }
            BAR_LDS();
        }
        { const int tl = tid >> 3, jg = tid & 7; float x[8]; float ss = 0.f;
#pragma unroll
            for (int vv = 0; vv < 8; ++vv) { x[vv] = Ob[tl * RP + jg * 8 + vv]; ss += x[vv] * x[vv]; }
            ss += __shfl_xor(ss, 1); ss += __shfl_xor(ss, 2); ss += __shfl_xor(ss, 4);
            const float rstd = rsqrtf(ss * (1.f / 64.f) + EPS);
            const int row = tc < 4 ? b * 256 + tc * 64 + tl : NCTX + b * SEQ + (tc - 4) * 64 + tl;
            const GAS float* ng = ngb + h * 64 + jg * 8;
            float gt[8]; unpack8(gatep, gt);
            float y[8];
#pragma unroll
            for (int vv = 0; vv < 8; ++vv) y[vv] = x[vv] * rstd * ng[vv] * silu_(gt[vv]);
            v4u ow; ow.x = pk2(y[0], y[1]); ow.y = pk2(y[2], y[3]); ow.z = pk2(y[4], y[5]); ow.w = pk2(y[6], y[7]);
            *(GAS v4u*)(CAT + (size_t)row * D + (MIX == 0 ? 0 : 512) + h * 64 + jg * 8) = ow; }
        unit = nunit; aidx += G;
    }
    __syncthreads();
}

typedef float f32x16 __attribute__((ext_vector_type(16)));
DI int swap23(int r) { return (r & 19) | ((r & 4) << 1) | ((r & 8) >> 1); }
struct AttnDesc {
    const GAS bf16* q; int qpitch;
    const GAS bf16* k; int kpitch;
    const GAS bf16* vt;
    GAS bf16* o; int opitch;
    int ntiles; float scale;
    int b, r0, rs0;
    const LAS float* rpb;
};
template <int DQK, bool NA>
DI void attn_mfma_unit(LAS unsigned char* lds, const AttnDesc& A, int tid, int lane, int wave) {
    constexpr int KP = DQK + 8, VP = 72, NS = DQK / 16, KPIECES = 64 * (DQK / 8);
    constexpr int BUF = 64 * KP * 2 + 64 * VP * 2;
    const int q = lane & 31, g = lane >> 5;
    auto tpos = [&](int t) { return NA ? (t < 4 ? 64 * t : 256 + 64 * (A.rs0 + t - 4)) : 64 * t; };
    auto krow = [&](int pos) { return NA ? (pos < 256 ? A.b * 256 + pos : NCTX + A.b * SEQ + (pos - 256)) : pos; };
    const int qi = NA ? (2 * (wave >> 2) + (q >> 4)) * 64 + 16 * (wave & 3) + (q & 15) : wave * 32 + q;
    const int kc0 = NA ? min(max(16 * (wave & 3) - 8, 0), 32) : 0;
    bf16x8 Qf[NS];
    { const GAS bf16* qp = A.q + (size_t)qi * A.qpitch + 8 * g;
#pragma unroll
        for (int s2 = 0; s2 < NS; ++s2) Qf[s2] = *(const GAS bf16x8*)(qp + 16 * s2); }
    f32x16 O[2];
#pragma unroll
    for (int db = 0; db < 2; ++db)
#pragma unroll
        for (int i = 0; i < 16; ++i) O[db][i] = 0.f;
    float mrun = -1e30f, lrun = 0.f;
    const int qr = NA ? A.r0 + (qi >> 6) : 0, qc = NA ? (qi & 63) : 0;
    const int wrs = NA ? min(max(qr - 4, 0), 56) : 0, cs = NA ? min(max(qc - 8, 0), 48) : 0;
    const int qr0 = NA ? A.r0 + 2 * (wave >> 2) : 0, wlo = NA ? min(max(qr0 - 4, 0), 56) : 0, whi = NA ? min(max(qr0 + 1 - 4, 0), 56) + 8 : 0;
    v4u kreg[2], vreg;
    auto gload = [&](int t) { const int pos = tpos(t);
#pragma unroll
        for (int u = 0; u < 2; ++u) { const int p = tid + 512 * u; if (p < KPIECES) { const int key = p / (DQK / 8), d8 = p % (DQK / 8); kreg[u] = *(const GAS v4u*)(A.k + (size_t)krow(pos + key) * A.kpitch + d8 * 8); } }
        vreg = *(const GAS v4u*)(A.vt + (size_t)(tid >> 3) * NKEY + pos + (tid & 7) * 8); };
    auto lstore = [&](int buf) { LAS bf16* Kt = (LAS bf16*)(lds + buf * BUF); LAS bf16* Vt = Kt + 64 * KP;
#pragma unroll
        for (int u = 0; u < 2; ++u) { const int p = tid + 512 * u; if (p < KPIECES) { const int key = p / (DQK / 8), d8 = p % (DQK / 8); *(LAS v4u*)(Kt + key * KP + d8 * 8) = kreg[u]; } }
        *(LAS v4u*)(Vt + (tid >> 3) * VP + (tid & 7) * 8) = vreg; };
    __syncthreads();
    gload(0); lstore(0);
    __syncthreads();
#pragma unroll 1
    for (int t = 0; t < A.ntiles; ++t) {
        const bool more = t + 1 < A.ntiles;
        if (more) gload(t + 1);
        bool active = true, rowok = true; int dr = 0;
        const bool win = NA && t >= 4;
        if (win) { const int wr = A.rs0 + t - 4; active = (wr >= wlo) && (wr < whi); rowok = (wr >= wrs) && (wr < wrs + 8); dr = min(max(wr - qr + 7, 0), 14); }
        if (active) {
            const LAS bf16* Kt = (const LAS bf16*)(lds + (t & 1) * BUF); const LAS bf16* Vt = Kt + 64 * KP;
            f32x16 S[2];
#pragma unroll
            for (int kb = 0; kb < 2; ++kb) {
#pragma unroll
                for (int i = 0; i < 16; ++i) S[kb][i] = 0.f;
                if (win && kb == 1) continue;
                const LAS bf16* kp = Kt + ((win ? kc0 : kb * 32) + swap23(q)) * KP + 8 * g;
#pragma unroll
                for (int s2 = 0; s2 < NS; ++s2) { const bf16x8 a = *(const LAS bf16x8*)(kp + 16 * s2); S[kb] = __builtin_amdgcn_mfma_f32_32x32x16_bf16(a, Qf[s2], S[kb], 0, 0, 0); }
            }
            float mx = -INFINITY;
            if (NA) {
                if (win) {
#pragma unroll
                    for (int i = 0; i < 16; ++i) { const int kc = kc0 + 16 * (i >> 3) + 8 * g + (i & 7); const int dc = min(max(kc - qc, -15), 15) + 15;
                        const float bv = A.rpb[dr * 31 + dc]; const float sv = (rowok && kc >= cs && kc < cs + 16) ? S[0][i] * A.scale + bv : -INFINITY;
                        S[0][i] = sv; mx = fmaxf(mx, sv); }
                } else {
#pragma unroll
                    for (int kb = 0; kb < 2; ++kb)
#pragma unroll
                        for (int i = 0; i < 16; ++i) { const float sv = S[kb][i] * A.scale; S[kb][i] = sv; mx = fmaxf(mx, sv); }
                }
            } else {
#pragma unroll
                for (int kb = 0; kb < 2; ++kb)
#pragma unroll
                    for (int i = 0; i < 16; ++i) mx = fmaxf(mx, S[kb][i]);
            }
            mx = fmaxf(mx, __shfl_xor(mx, 32));
            const float mn = fmaxf(mrun, mx), alpha = __builtin_amdgcn_exp2f(mrun - mn);
            mrun = mn;
            if (__any(alpha != 1.f)) { lrun *= alpha;
#pragma unroll
                for (int db = 0; db < 2; ++db)
#pragma unroll
                    for (int i = 0; i < 16; ++i) O[db][i] *= alpha; }
            bf16x8 Pf[4];
#pragma unroll
            for (int ks = 0; ks < 4; ++ks) { if (win && ks >= 2) continue; const int kb = ks >> 1, o8 = (ks & 1) * 8; float p[8];
#pragma unroll
                for (int j = 0; j < 8; ++j) { p[j] = __builtin_amdgcn_exp2f(S[kb][o8 + j] - mn); lrun += p[j]; }
                Pf[ks] = pack8(p[0], p[1], p[2], p[3], p[4], p[5], p[6], p[7]); }
#pragma unroll
            for (int db = 0; db < 2; ++db) { const LAS bf16* vp = Vt + (db * 32 + q) * VP + (win ? kc0 : 0) + 8 * g;
#pragma unroll
                for (int ks = 0; ks < 4; ++ks) { if (win && ks >= 2) continue; const bf16x8 a = *(const LAS bf16x8*)(vp + 16 * ks); O[db] = __builtin_amdgcn_mfma_f32_32x32x16_bf16(a, Pf[ks], O[db], 0, 0, 0); } }
        }
        if (more) lstore((t + 1) & 1);
        __syncthreads();
    }
    const float ltot = lrun + __shfl_xor(lrun, 32), inv = 1.f / ltot;
    GAS bf16* op = A.o + (size_t)qi * A.opitch + 4 * g;
#pragma unroll
    for (int db = 0; db < 2; ++db)
#pragma unroll
        for (int i4 = 0; i4 < 4; ++i4) { v2u w; w.x = pk2(O[db][4 * i4] * inv, O[db][4 * i4 + 1] * inv); w.y = pk2(O[db][4 * i4 + 2] * inv, O[db][4 * i4 + 3] * inv); *(GAS v2u*)(op + 32 * db + 8 * i4) = w; }
}

constexpr float MLA_TH = 8.f;
constexpr int NA_SLOT = 2 * 64 * 72 * 2, NA_RPB = 4 * NA_SLOT;
DI void na_unit(LAS unsigned char* lds, const AttnDesc& A, const GAS float* rp, int tid, int lane, int wave) {
    constexpr int KP = 72, VP = 72, NS = 4, KBUF = 64 * KP * 2;
    const int q = lane & 31, g = lane >> 5, NT = A.ntiles;
    auto tpos = [&](int t) { return t < 4 ? 64 * t : 256 + 64 * (A.rs0 + t - 4); };
    auto krow = [&](int pos) { return pos < 256 ? A.b * 256 + pos : NCTX + A.b * SEQ + (pos - 256); };
    const int qi = (2 * (wave >> 2) + (q >> 4)) * 64 + 16 * (wave & 3) + (q & 15);
    const int kc0 = min(max(16 * (wave & 3) - 8, 0), 32);
    bf16x8 Qf[NS];
    { const GAS bf16* qp = A.q + (size_t)qi * A.qpitch + 8 * g;
#pragma unroll
        for (int s2 = 0; s2 < NS; ++s2) Qf[s2] = *(const GAS bf16x8*)(qp + 16 * s2); }
    f32x16 O[2];
#pragma unroll
    for (int db = 0; db < 2; ++db)
#pragma unroll
        for (int i = 0; i < 16; ++i) O[db][i] = 0.f;
    float mrun = -1e30f, lrun = 0.f;
    const int qr = A.r0 + (qi >> 6), qc = qi & 63;
    const int wrs = min(max(qr - 4, 0), 56), cs = min(max(qc - 8, 0), 48);
    const int qr0 = A.r0 + 2 * (wave >> 2), wlo = min(max(qr0 - 4, 0), 56), whi = min(max(qr0 + 1 - 4, 0), 56) + 8;
    auto koffs = [&](int i) { const int j = i * 64 + lane, row = j / 9, pc = min(j % 9, 7); return (unsigned)(row * (PP * 2) + pc * 16); };
    auto voffs = [&](int i) { const int j = i * 64 + lane, row = j / 9, pc = min(j % 9, 7); return (unsigned)(row * (NKEY * 2) + pc * 16); };
    const int iv1 = wave == 0 ? 0 : wave - 1, iv2 = wave < 2 ? 7 + wave : iv1;
    const unsigned goff0 = koffs(wave), goff1 = wave == 0 ? koffs(8) : voffs(iv1), goff2 = voffs(iv2);
    auto dma = [&](int t, int slot) __attribute__((always_inline)) { const int pos = tpos(t);
        const GAS unsigned char* kb = (const GAS unsigned char*)(A.k + (size_t)krow(pos) * A.kpitch); const GAS unsigned char* vb = (const GAS unsigned char*)(A.vt + pos);
        LAS unsigned char* kl = lds + slot * NA_SLOT; LAS unsigned char* vl = kl + KBUF;
        __builtin_amdgcn_global_load_lds((const GAS unsigned*)(kb + goff0), (LAS unsigned*)(kl + wave * 1024), 16, 0, 0);
        __builtin_amdgcn_global_load_lds((const GAS unsigned*)((wave == 0 ? kb : vb) + goff1), (LAS unsigned*)(wave == 0 ? kl + 8 * 1024 : vl + iv1 * 1024), 16, 0, 0);
        __builtin_amdgcn_global_load_lds((const GAS unsigned*)(vb + goff2), (LAS unsigned*)(vl + iv2 * 1024), 16, 0, 0);
    };
    LAS float* T = (LAS float*)(lds + NA_RPB);
    float tv[4];
#pragma unroll
    for (int u = 0; u < 4; ++u) { const int e = tid + 512 * u, r = e >> 7, dcr = (e & 127) - 64; const bool in = r < 15 && dcr >= -15 && dcr <= 15;
        tv[u] = in ? rp[r * 31 + dcr + 15] * LOG2E : (r == 15 ? -INFINITY : 0.f); }
    float mcol[16];
#pragma unroll
    for (int i = 0; i < 16; ++i) { const int kc = kc0 + 16 * (i >> 3) + 8 * g + (i & 7); mcol[i] = (kc >= cs && kc < cs + 16) ? 0.f : -INFINITY; }
    __syncthreads();
    dma(0, 0); dma(min(1, NT - 1), 1); dma(min(2, NT - 1), 2);
#pragma unroll
    for (int u = 0; u < 4; ++u) T[tid + 512 * u] = tv[u];
    asm volatile("s_waitcnt vmcnt(6)\n\ts_waitcnt lgkmcnt(0)\n\ts_barrier" ::: "memory");
#pragma unroll 1
    for (int t = 0; t < NT; ++t) {
        dma(min(t + 3, NT - 1), (t + 3) & 3);
        bool active = true, rowok = true; int dr = 0;
        const bool win = t >= 4;
        if (win) { const int wr = A.rs0 + t - 4; active = (wr >= wlo) && (wr < whi); rowok = (wr >= wrs) && (wr < wrs + 8); dr = min(max(wr - qr + 7, 0), 14); }
        if (active) {
            const LAS bf16* Kt = (const LAS bf16*)(lds + (t & 3) * NA_SLOT); const LAS bf16* Vt = Kt + 64 * KP;
            f32x16 S[2];
#pragma unroll
            for (int kb = 0; kb < 2; ++kb) {
#pragma unroll
                for (int i = 0; i < 16; ++i) S[kb][i] = 0.f;
                if (win && kb == 1) continue;
                const LAS bf16* kp = Kt + ((win ? kc0 : kb * 32) + swap23(q)) * KP + 8 * g;
#pragma unroll
                for (int s2 = 0; s2 < NS; ++s2) { const bf16x8 a = *(const LAS bf16x8*)(kp + 16 * s2); S[kb] = __builtin_amdgcn_mfma_f32_32x32x16_bf16(a, Qf[s2], S[kb], 0, 0, 0); }
            }
            float mx = -INFINITY;
            if (win) { const LAS float* tb = T + (rowok ? dr : 15) * 128 + (kc0 + 8 * g - qc + 64);
#pragma unroll
                for (int i = 0; i < 16; ++i) { const float sv = (S[0][i] * A.scale + tb[16 * (i >> 3) + (i & 7)]) + mcol[i]; S[0][i] = sv; mx = fmaxf(mx, sv); }
            } else {
#pragma unroll
                for (int kb = 0; kb < 2; ++kb)
#pragma unroll
                    for (int i = 0; i < 16; ++i) { const float sv = S[kb][i] * A.scale; S[kb][i] = sv; mx = fmaxf(mx, sv); }
            }
            if (__any(mx > mrun + MLA_TH)) { const float mf = fmaxf(mx, __shfl_xor(mx, 32)), mn = fmaxf(mrun, mf), alpha = __builtin_amdgcn_exp2f(mrun - mn);
                mrun = mn; lrun *= alpha;
#pragma unroll
                for (int db = 0; db < 2; ++db)
#pragma unroll
                    for (int i = 0; i < 16; ++i) O[db][i] *= alpha; }
            bf16x8 Pf[4];
#pragma unroll
            for (int ks = 0; ks < 4; ++ks) { if (win && ks >= 2) continue; const int kb = ks >> 1, o8 = (ks & 1) * 8; float p[8];
#pragma unroll
                for (int j = 0; j < 8; ++j) { p[j] = __builtin_amdgcn_exp2f(S[kb][o8 + j] - mrun); lrun += p[j]; }
                Pf[ks] = pack8(p[0], p[1], p[2], p[3], p[4], p[5], p[6], p[7]); }
#pragma unroll
            for (int db = 0; db < 2; ++db) { const LAS bf16* vp = Vt + (db * 32 + q) * VP + (win ? kc0 : 0) + 8 * g;
#pragma unroll
                for (int ks = 0; ks < 4; ++ks) { if (win && ks >= 2) continue; const bf16x8 a = *(const LAS bf16x8*)(vp + 16 * ks); O[db] = __builtin_amdgcn_mfma_f32_32x32x16_bf16(a, Pf[ks], O[db], 0, 0, 0); } }
        }
        asm volatile("s_waitcnt vmcnt(6)\n\ts_waitcnt lgkmcnt(0)\n\ts_barrier" ::: "memory");
    }
    asm volatile("s_waitcnt vmcnt(0)" ::: "memory");
    const float ltot = lrun + __shfl_xor(lrun, 32), inv = 1.f / ltot;
    GAS bf16* op = A.o + (size_t)qi * A.opitch + 4 * g;
#pragma unroll
    for (int db = 0; db < 2; ++db)
#pragma unroll
        for (int i4 = 0; i4 < 4; ++i4) { v2u w; w.x = pk2(O[db][4 * i4] * inv, O[db][4 * i4 + 1] * inv); w.y = pk2(O[db][4 * i4 + 2] * inv, O[db][4 * i4 + 3] * inv); *(GAS v2u*)(op + 32 * db + 8 * i4) = w; }
}

struct TagF { static constexpr bool value = false; }; struct TagT { static constexpr bool value = true; };
#define SGB(mask, n) __builtin_amdgcn_sched_group_barrier(mask, n, 0)
DI void mla_unit(LAS unsigned char* lds, const AttnDesc& A, int tid, int lane, int wave) {
    constexpr int KP = 104, VP = 72, NS = 6, KBUF = 64 * KP * 2, VBUF = 64 * VP * 2;
    const int q = lane & 31, g = lane >> 5, NT = A.ntiles;
    bf16x8 Qf[NS];
    { const GAS bf16* qp = A.q + (size_t)(wave * 32 + q) * A.qpitch + 8 * g;
#pragma unroll
        for (int s2 = 0; s2 < NS; ++s2) Qf[s2] = *(const GAS bf16x8*)(qp + 16 * s2); }
    f32x16 O[2], Cm;
#pragma unroll
    for (int i = 0; i < 16; ++i) { O[0][i] = 0.f; O[1][i] = 0.f; Cm[i] = 0.f; }
    float lrun = 0.f;
    auto koffs = [&](int i) { const int j = i * 64 + lane, row = j / 13, pc = min(j % 13, 11); return (unsigned)(row * 192 + pc * 16); };
    auto voffs = [&](int i) { const int j = i * 64 + lane, row = j / 9, pc = min(j % 9, 7); return (unsigned)(row * (NKEY * 2) + pc * 16); };
    const int i2 = min(wave + 3, 8);
    const unsigned goff0 = koffs(wave), goff1 = wave < 5 ? koffs(wave + 8) : voffs(wave - 5), goff2 = voffs(i2);
    auto dma = [&](int tk, int ks, int tv, int vs) __attribute__((always_inline)) {
        const GAS unsigned char* kb = (const GAS unsigned char*)A.k + (size_t)tk * (64 * 96 * 2); const GAS unsigned char* vb = (const GAS unsigned char*)A.vt + (size_t)tv * 128;
        LAS unsigned char* kl = lds + ks * KBUF; LAS unsigned char* vl = lds + 2 * KBUF + vs * VBUF;
        __builtin_amdgcn_global_load_lds((const GAS unsigned*)(kb + goff0), (LAS unsigned*)(kl + wave * 1024), 16, 0, 0);
        __builtin_amdgcn_global_load_lds((const GAS unsigned*)((wave < 5 ? kb : vb) + goff1), (LAS unsigned*)(wave < 5 ? kl + (wave + 8) * 1024 : vl + (wave - 5) * 1024), 16, 0, 0);
        __builtin_amdgcn_global_load_lds((const GAS unsigned*)(vb + goff2), (LAS unsigned*)(vl + i2 * 1024), 16, 0, 0);
    };
    auto qk = [&](f32x16& S0, f32x16& S1, int buf) __attribute__((always_inline)) {
        const LAS bf16* kp = (const LAS bf16*)(lds + buf * KBUF) + swap23(q) * KP + 8 * g;
        S0 = __builtin_amdgcn_mfma_f32_32x32x16_bf16(*(const LAS bf16x8*)kp, Qf[0], Cm, 0, 0, 0);
#pragma unroll
        for (int s2 = 1; s2 < NS; ++s2) S0 = __builtin_amdgcn_mfma_f32_32x32x16_bf16(*(const LAS bf16x8*)(kp + 16 * s2), Qf[s2], S0, 0, 0, 0);
        S1 = __builtin_amdgcn_mfma_f32_32x32x16_bf16(*(const LAS bf16x8*)(kp + 32 * KP), Qf[0], Cm, 0, 0, 0);
#pragma unroll
        for (int s2 = 1; s2 < NS; ++s2) S1 = __builtin_amdgcn_mfma_f32_32x32x16_bf16(*(const LAS bf16x8*)(kp + 32 * KP + 16 * s2), Qf[s2], S1, 0, 0, 0);
    };
    auto smax = [&](const f32x16& S0, const f32x16& S1) __attribute__((always_inline)) { float mx = fmaxf(S0[0], S0[1]);
#pragma unroll
        for (int i = 2; i < 16; ++i) mx = fmaxf(mx, S0[i]);
#pragma unroll
        for (int i = 0; i < 16; ++i) mx = fmaxf(mx, S1[i]);
        return mx; };
    auto rebase = [&](f32x16& S0, f32x16& S1, float mx) __attribute__((always_inline)) {
        const float mf = fmaxf(mx, __shfl_xor(mx, 32)), d = fmaxf(mf, 0.f), alpha = __builtin_amdgcn_exp2f(-d);
        lrun *= alpha;
#pragma unroll
        for (int i = 0; i < 16; ++i) { O[0][i] *= alpha; O[1][i] *= alpha; S0[i] -= d; S1[i] -= d; Cm[i] -= d; }
        asm volatile("" : "+v"(Cm));
    };
    auto softmax_p = [&](const f32x16& S0, const f32x16& S1, bf16x8 (&Pf)[4]) __attribute__((always_inline)) {
#pragma unroll
        for (int ks = 0; ks < 4; ++ks) { const int o8 = (ks & 1) * 8; float p[8];
#pragma unroll
            for (int j = 0; j < 8; ++j) { p[j] = __builtin_amdgcn_exp2f(ks < 2 ? S0[o8 + j] : S1[o8 + j]); lrun += p[j]; }
            Pf[ks] = pack8(p[0], p[1], p[2], p[3], p[4], p[5], p[6], p[7]); }
    };
    auto pv = [&](const bf16x8 (&Pf)[4], int buf) __attribute__((always_inline)) {
        const LAS bf16* vp = (const LAS bf16*)(lds + 2 * KBUF + buf * VBUF) + q * VP + 8 * g;
#pragma unroll
        for (int ks = 0; ks < 4; ++ks)
#pragma unroll
            for (int db = 0; db < 2; ++db) O[db] = __builtin_amdgcn_mfma_f32_32x32x16_bf16(*(const LAS bf16x8*)(vp + db * 32 * VP + 16 * ks), Pf[ks], O[db], 0, 0, 0);
    };
    f32x16 Sa[2], Sb[2];
    __syncthreads();
    dma(0, 0, 0, 0); dma(1, 1, 0, 0);
    asm volatile("s_waitcnt vmcnt(0)" ::: "memory");
    __syncthreads();
    qk(Sa[0], Sa[1], 0);
    { const float mx = smax(Sa[0], Sa[1]); const float mf = fmaxf(mx, __shfl_xor(mx, 32));
#pragma unroll
        for (int i = 0; i < 16; ++i) { Sa[0][i] -= mf; Sa[1][i] -= mf; Cm[i] = -mf; }
        asm volatile("" : "+v"(Cm)); }
    __syncthreads();
    auto step = [&](f32x16 (&Sc)[2], f32x16 (&Sn)[2], const int t, auto par) __attribute__((always_inline)) {
        constexpr int PAR = decltype(par)::value ? 1 : 0;
        dma(min(t + 2, NT - 1), PAR, min(t + 1, NT - 1), PAR ^ 1);
        __builtin_amdgcn_sched_barrier(0);
        bf16x8 Pf[4];
        qk(Sn[0], Sn[1], PAR ^ 1);
        softmax_p(Sc[0], Sc[1], Pf);
        pv(Pf, PAR);
        const float mx = smax(Sn[0], Sn[1]);
        SGB(0x100, 3);
#pragma unroll
        for (int m = 0; m < 16; ++m) { SGB(0x008, 1); SGB(0x100, 1); SGB(0x400, 2); SGB(0x002, 3); }
#pragma unroll
        for (int m = 0; m < 4; ++m) { SGB(0x008, 1); SGB(0x100, 1); SGB(0x002, 5); }
        if (__any(mx > MLA_TH)) rebase(Sn[0], Sn[1], mx);
        asm volatile("s_waitcnt vmcnt(0)" ::: "memory");
        __syncthreads();
    };
#pragma unroll 1
    for (int t = 0; t < NT - 2; t += 2) { step(Sa, Sb, t, TagF{}); step(Sb, Sa, t + 1, TagT{}); }
    step(Sa, Sb, NT - 2, TagF{});
    { bf16x8 Pf[4]; softmax_p(Sb[0], Sb[1], Pf); pv(Pf, (NT - 1) & 1); }
    const float ltot = lrun + __shfl_xor(lrun, 32), inv = 1.f / ltot;
    GAS bf16* op = A.o + (size_t)(wave * 32 + q) * A.opitch + 4 * g;
#pragma unroll
    for (int db = 0; db < 2; ++db)
#pragma unroll
        for (int i4 = 0; i4 < 4; ++i4) { v2u w; w.x = pk2(O[db][4 * i4] * inv, O[db][4 * i4 + 1] * inv); w.y = pk2(O[db][4 * i4 + 2] * inv, O[db][4 * i4 + 3] * inv); *(GAS v2u*)(op + 32 * db + 8 * i4) = w; }
}

DI int moe_tables(const GAS unsigned* cnt  , LAS int* off, LAS int* tile_e, int tid) {
    if (tid == 0) { int o = 0; for (int e = 0; e < 32; ++e) { off[e] = o; o += ((int)cnt[e * 64] + 255) & ~255; } off[32] = o; }
    __syncthreads();
    if (tid < MOE_MAXT) { const int r = tid * 256; int ex = 0; for (int e = 0; e < 32; ++e) if (r >= off[e + 1]) ex = e + 1; tile_e[tid] = ex < 32 ? ex : 31; }
    __syncthreads();
    return off[32] >> 8;
}

#define TIDS const int tid = threadIdx.x, lane = tid & 63, wave = __builtin_amdgcn_readfirstlane(tid >> 6), bid = blockIdx.x, G = gridDim.x, gw = bid * 8 + wave, NGW = G * 8; (void)lane; (void)gw; (void)NGW
DI void ph_gemm_in(const Ctx& cx, int l) {
    TIDS; GAS unsigned char* ws = cx.ws(); LAS unsigned char* lds = (LAS unsigned char*)lds_raw;
    pg8::Gemm g{(const GAS bf16*)(ws + WS_H), (const GAS bf16*)(ws + WS_WTIN + (size_t)l * WTIN_L), MTOK, PP, D}; pg8::StaticOrder S; S.init(MTOK, PP, G, bid);
    pg8::EpiStoreBf16 E{(GAS bf16*)(ws + WS_P), PP};
    pg8::gemm_phase(lds, g, S, E);
}
DI void ph_prep_r1(const Ctx& cx, int l) {
    TIDS; LAS unsigned char* lds = (LAS unsigned char*)lds_raw;
#pragma unroll 1
    for (int u = bid; u < MTOK / PR; u += G) prep_unit(cx, l, u, lds, tid, lane, wave);
    __syncthreads();
    rec_r1_run<0>(cx, l, lds, tid, bid, G); rec_r1_run<1>(cx, l, lds, tid, bid, G);
    __syncthreads();
}
DI void ph_mixers(const Ctx& cx, int l) {
    TIDS; GAS unsigned char* ws = cx.ws(); LAS unsigned char* lds = (LAS unsigned char*)lds_raw;
    const bool keep_ctx = (l == 0);
    GAS bf16* CAT = (GAS bf16*)(ws + WS_CAT); const GAS bf16* P = (const GAS bf16*)(ws + WS_P);
    const int nATT = 256 + (keep_ctx ? 16 : 0), nR = 16 * NCHUNK;
    const int vc = (G % 8 == 0) ? (bid % 8) * (G / 8) + bid / 8 : bid;
    const bool r3first = ((bid >> 3) & 1) != 0;
    if (r3first) { rec_r3_run<0>(cx, l, lds, tid, bid, G, keep_ctx); rec_r3_run<1>(cx, l, lds, tid, bid, G, keep_ctx); __syncthreads(); }
#pragma unroll 1
    for (int it = 0; it < 2; ++it) { const int u = it == 0 ? vc : (G == 256 && bid >= 128 && bid < 144 ? 256 + bid - 128 : (G == 256 ? nATT : bid + G)); if (u >= nATT) continue;
        const GAS bf16* QM = (const GAS bf16*)(ws + WS_QM); const GAS bf16* KM = (const GAS bf16*)(ws + WS_KM); const GAS bf16* VM = (const GAS bf16*)(ws + WS_VM);
        AttnDesc A{}; int bh, b, h;
        if (u < 256) { bh = u >> 4; b = bh >> 2; h = bh & 3; const int qb = u & 15; A.q = QM + ((size_t)bh * NKEY + 256 + qb * 256) * 96; A.ntiles = NKEY / 64; A.o = CAT + (size_t)(NCTX + b * SEQ + qb * 256) * D + 768 + h * 64; }
        else { bh = u - 256; b = bh >> 2; h = bh & 3; A.q = QM + (size_t)bh * NKEY * 96; A.ntiles = 4; A.o = CAT + (size_t)(b * 256) * D + 768 + h * 64; }
        A.qpitch = 96; A.k = KM + (size_t)bh * NKEY * 96; A.kpitch = 96; A.vt = VM + (size_t)bh * 64 * NKEY; A.opitch = D; A.scale = 1.f;
        mla_unit(lds, A, tid, lane, wave);
    }
#pragma unroll 1
    for (int it = 0; it < 2; ++it) { const int u = it == 0 ? vc : (G == 256 && bid >= 160 && bid < 176 ? 256 + bid - 160 : (G == 256 ? nATT : bid + G)); if (u >= nATT) continue;
        LAS float* rpb = (LAS float*)(lds + NA_RPB);
        AttnDesc A{}; int bh, b, h; size_t qrow;
        if (u < 256) { bh = u >> 4; b = bh >> 2; h = bh & 3; const int rq = u & 15; A.r0 = rq * 4; A.rs0 = min(max(A.r0 - 4, 0), 56); const int rsl = min(max(A.r0 + 3 - 4, 0), 56);
            A.ntiles = 4 + (rsl + 8 - A.rs0); qrow = (size_t)NCTX + b * SEQ + A.r0 * 64; }
        else { bh = u - 256; b = bh >> 2; h = bh & 3; A.ntiles = 4; qrow = (size_t)b * 256; }
        const GAS float* rp = cx.in(I_RPB) + (size_t)(l * 4 + h) * 465;
        A.q = P + qrow * PP + CB_Q + h * 64; A.qpitch = PP; A.k = P + CB_K + h * 64; A.kpitch = PP; A.vt = (const GAS bf16*)(ws + WS_VNT) + (size_t)bh * 64 * NKEY;
        A.o = CAT + qrow * D + 256 + h * 64; A.opitch = D; A.scale = 0.125f * LOG2E; A.b = b; A.rpb = rpb;
        na_unit(lds, A, rp, tid, lane, wave);
    }
    __syncthreads();
    if (!r3first) { rec_r3_run<0>(cx, l, lds, tid, bid, G, keep_ctx); rec_r3_run<1>(cx, l, lds, tid, bid, G, keep_ctx); }
}
DI void ph_gemm_out(const Ctx& cx, int l) {
    TIDS; GAS unsigned char* ws = cx.ws(); LAS unsigned char* lds = (LAS unsigned char*)lds_raw;
    const int roff = (l == 0) ? 0 : NCTX, Mg = MTOK - roff;
    pg8::Gemm g{(const GAS bf16*)(ws + WS_CAT) + (size_t)roff * D, (const GAS bf16*)(ws + WS_WTOUT + (size_t)l * D * D * 2), Mg, D, D}; pg8::StaticOrder S; S.init(Mg, D, G, bid);
    pg8::EpiResid E{(GAS pg8::bf16_t*)(ws + WS_X), roff, (const GAS float*)(ws + WS_MOD) + (size_t)l * 5 * 6144 + 2 * 1024, l == 0 ? cx.in(I_CTX) : (const GAS float*)nullptr, l == 0 ? cx.in(I_X) : (const GAS float*)nullptr};
    pg8::gemm_phase(lds, g, S, E);
    if (l == 0) { const int nbusy = (Mg / 256) * (D / 256) - G;
        if (nbusy >= 0 && nbusy < G && bid >= nbusy) { __syncthreads(); weight_copies(cx, 1, lds, tid, lane, wave, (bid - nbusy) * 8 + wave, (G - nbusy) * 8, (bid - nbusy) * 512 + tid, (G - nbusy) * 512); } }
}
DI void ph_router(const Ctx& cx, int l) {
    TIDS; GAS unsigned char* ws = cx.ws(); LAS unsigned char* lds = (LAS unsigned char*)lds_raw;
    const int m_lo = (l == 0) ? 0 : NCTX;
    const GAS bf16* X = (const GAS bf16*)(ws + WS_X); GAS bf16* H = (GAS bf16*)(ws + WS_H); const GAS float* MOD = (const GAS float*)(ws + WS_MOD) + (size_t)l * 5 * 6144;
    GAS int* EID = (GAS int*)(ws + WS_MOE); GAS float* GATE = (GAS float*)(ws + WS_MOE) + MTOK * 2; GAS int* POS = (GAS int*)(ws + WS_MOE) + MTOK * 4;
    GAS unsigned* cnt = (GAS unsigned*)(ws + WS_CTL) + CW_CNT + l * 32 * 64; GAS int* RIDX = (GAS int*)(ws + WS_RIDX);
    const GAS bf16* WRh = (const GAS bf16*)(ws + WS_WR) + (size_t)l * 2 * 48 * 1024; const GAS bf16* WRl = WRh + 48 * 1024;
    const GAS float* n2g = cx.in(I_N2G) + l * D; const GAS float* brg = cx.in(I_BRG) + l * 4; const GAS float* bre = cx.in(I_BRE) + l * 32;
    constexpr int AP = 136;
    LAS bf16* Ah = (LAS bf16*)(lds + wave * 12288); LAS bf16* Al = Ah + 16 * AP; LAS float* LG = (LAS float*)(lds + wave * 12288 + 2 * 16 * AP * 2); LAS float* RSD = LG + 16 * 48;
    const int nunits = (MTOK - m_lo) / 16;
#pragma unroll 1
    for (int unit = wave * G + bid; unit < nunits; unit += NGW) {
        const int m0 = m_lo + unit * 16; const GAS float* mb = MOD + (size_t)bidx_of_row(m0) * 6144;
        const int p16 = lane & 15, rg = lane >> 4;
        float rsr[4];
        { float ss[4] = {0.f, 0.f, 0.f, 0.f};
#pragma unroll 2
            for (int kc = 0; kc < 8; ++kc) { v4u xp[4];
#pragma unroll
                for (int i = 0; i < 4; ++i) xp[i] = *(const GAS v4u*)(X + (size_t)(m0 + 4 * rg + i) * D + kc * 128 + 8 * p16);
#pragma unroll
                for (int i = 0; i < 4; ++i) { float x[8]; unpack8(xp[i], x);
#pragma unroll
                    for (int e = 0; e < 8; ++e) ss[i] += x[e] * x[e]; } }
#pragma unroll
            for (int i = 0; i < 4; ++i) { float t = ss[i]; t += __shfl_xor(t, 1); t += __shfl_xor(t, 2); t += __shfl_xor(t, 4); t += __shfl_xor(t, 8); rsr[i] = rsqrtf(t * (1.f / D) + EPS); } }
        f32x4 acc[3];
#pragma unroll
        for (int ct = 0; ct < 3; ++ct) acc[ct] = (f32x4){0.f, 0.f, 0.f, 0.f};
#pragma unroll 1
        for (int kc = 0; kc < 8; ++kc) { const int c = kc * 128 + 8 * p16;
            v4u xp[4];
#pragma unroll
            for (int i = 0; i < 4; ++i) xp[i] = *(const GAS v4u*)(X + (size_t)(m0 + 4 * rg + i) * D + c);
            float gg[8], sh[8], sc[8];
            { const f32x4 a0 = *(const GAS f32x4*)(n2g + c), a1 = *(const GAS f32x4*)(n2g + c + 4), b0 = *(const GAS f32x4*)(mb + 3 * 1024 + c), b1 = *(const GAS f32x4*)(mb + 3 * 1024 + c + 4),
                  c0 = *(const GAS f32x4*)(mb + 4 * 1024 + c), c1 = *(const GAS f32x4*)(mb + 4 * 1024 + c + 4);
                gg[0] = a0.x; gg[1] = a0.y; gg[2] = a0.z; gg[3] = a0.w; gg[4] = a1.x; gg[5] = a1.y; gg[6] = a1.z; gg[7] = a1.w;
                sh[0] = b0.x; sh[1] = b0.y; sh[2] = b0.z; sh[3] = b0.w; sh[4] = b1.x; sh[5] = b1.y; sh[6] = b1.z; sh[7] = b1.w;
                sc[0] = c0.x; sc[1] = c0.y; sc[2] = c0.z; sc[3] = c0.w; sc[4] = c1.x; sc[5] = c1.y; sc[6] = c1.z; sc[7] = c1.w; }
            LDS_WAIT();
#pragma unroll
            for (int i = 0; i < 4; ++i) { const int r = 4 * rg + i; float x[8], y[8]; unpack8(xp[i], x);
#pragma unroll
                for (int e = 0; e < 8; ++e) y[e] = x[e] * rsr[i] * gg[e] * (1.f + sc[e]) + sh[e];
                const v4u hi = (v4u){pk2(y[0], y[1]), pk2(y[2], y[3]), pk2(y[4], y[5]), pk2(y[6], y[7])};
                float hf[8]; unpack8(hi, hf);
                const v4u lo = (v4u){pk2(y[0] - hf[0], y[1] - hf[1]), pk2(y[2] - hf[2], y[3] - hf[3]), pk2(y[4] - hf[4], y[5] - hf[5]), pk2(y[6] - hf[6], y[7] - hf[7])};
                *(GAS v4u*)(H + (size_t)(m0 + r) * D + c) = hi;
                *(LAS v4u*)(Ah + r * AP + 8 * p16) = hi; *(LAS v4u*)(Al + r * AP + 8 * p16) = lo; }
            LDS_WAIT(); asm volatile("" ::: "memory");
            const int fr = lane & 15, fq = lane >> 4;
#pragma unroll
            for (int ks = 0; ks < 4; ++ks) { const bf16x8 ah = *(const LAS bf16x8*)(Ah + fr * AP + ks * 32 + fq * 8), al = *(const LAS bf16x8*)(Al + fr * AP + ks * 32 + fq * 8);
                bf16x8 bh[3], bl[3];
#pragma unroll
                for (int ct = 0; ct < 3; ++ct) { const size_t bo = (size_t)(ct * 16 + fr) * 1024 + kc * 128 + ks * 32 + fq * 8; bh[ct] = *(const GAS bf16x8*)(WRh + bo); bl[ct] = *(const GAS bf16x8*)(WRl + bo); }
                asm volatile("s_waitcnt vmcnt(0)" : "+v"(bh[0]), "+v"(bh[1]), "+v"(bh[2]), "+v"(bl[0]), "+v"(bl[1]), "+v"(bl[2]) :: "memory");
#pragma unroll
                for (int ct = 0; ct < 3; ++ct) {
                    acc[ct] = __builtin_amdgcn_mfma_f32_16x16x32_bf16(ah, bh[ct], acc[ct], 0, 0, 0);
                    acc[ct] = __builtin_amdgcn_mfma_f32_16x16x32_bf16(ah, bl[ct], acc[ct], 0, 0, 0);
                    acc[ct] = __builtin_amdgcn_mfma_f32_16x16x32_bf16(al, bh[ct], acc[ct], 0, 0, 0); } }
        }
#pragma unroll
        for (int ct = 0; ct < 3; ++ct)
#pragma unroll
            for (int j = 0; j < 4; ++j) LG[(4 * (lane >> 4) + j) * 48 + ct * 16 + (lane & 15)] = acc[ct][j];
        LDS_WAIT(); asm volatile("" ::: "memory");
        if (lane < 16) { const LAS float* lg = LG + lane * 48; const int m = m0 + lane;
            float gl[4]; int gsel = 0;
#pragma unroll
            for (int i = 0; i < 4; ++i) gl[i] = lg[i] + brg[i];
            float gmax = gl[0];
#pragma unroll
            for (int i = 1; i < 4; ++i) if (gl[i] > gmax) { gmax = gl[i]; gsel = i; }
            float den = 0.f;
#pragma unroll
            for (int i = 0; i < 4; ++i) den += __expf(gl[i] - gmax);
            const float pg = 1.f / den;
            float e1 = -INFINITY, e2 = -INFINITY; int i1 = 0, i2 = 0;
#pragma unroll 1
            for (int i = 0; i < 8; ++i) { const float ev = lg[4 + gsel * 8 + i] + bre[gsel * 8 + i];
                if (ev > e1) { e2 = e1; i2 = i1; e1 = ev; i1 = i; } else if (ev > e2) { e2 = ev; i2 = i; } }
            const float x2 = __expf(e2 - e1), w1 = pg / (1.f + x2), w2 = pg * x2 / (1.f + x2);
            const int ex1 = gsel * 8 + i1, ex2 = gsel * 8 + i2;
            const int p1 = (int)__hip_atomic_fetch_add(cnt + ex1 * 64, 1u, __ATOMIC_RELAXED, __HIP_MEMORY_SCOPE_AGENT), p2 = (int)__hip_atomic_fetch_add(cnt + ex2 * 64, 1u, __ATOMIC_RELAXED, __HIP_MEMORY_SCOPE_AGENT);
            EID[m * 2] = ex1; EID[m * 2 + 1] = ex2; GATE[m * 2] = w1; GATE[m * 2 + 1] = w2; POS[m * 2] = p1; POS[m * 2 + 1] = p2;
            RIDX[(size_t)ex1 * MOE_CAP + p1] = m; RIDX[(size_t)ex2 * MOE_CAP + p2] = m; }
        LDS_WAIT(); asm volatile("" ::: "memory");
    }
}
DI void ph_gemm_gu(const Ctx& cx, int l) {
    TIDS; GAS unsigned char* ws = cx.ws(); LAS unsigned char* lds = (LAS unsigned char*)lds_raw;
    LAS int* moe_off = (LAS int*)(lds + MISC_OFF + 64 * 4); LAS int* moe_te = (LAS int*)(lds + MISC_OFF + 128 * 4);
    const int nT = moe_tables((const GAS unsigned*)(ws + WS_CTL) + CW_CNT + l * 32 * 64, moe_off, moe_te, tid);
    pg8::Gemm g{(const GAS bf16*)(ws + WS_H), (const GAS bf16*)(ws + WS_WTGU + (size_t)l * 32 * 512 * D * 2), nT * 256, 512, D};
    const int vc = (G % 8 == 0) ? (bid % 8) * (G / 8) + bid / 8 : bid;
    pg8::GroupedPublish S{{nT, 2, G, vc, moe_te, (size_t)512 * D * 2}, (GAS unsigned*)(ws + WS_CTL) + CW_GUC + l * MOE_MAXT * 64};
    pg8::EpiGateUp E{(GAS bf16*)(ws + WS_ACT), (unsigned)(MOE_MAXT * 256 * 256 * 2)};
    LAS int* ridx_l = (LAS int*)(lds + MISC_OFF + 4096);
    { const GAS unsigned* cntp = (const GAS unsigned*)(ws + WS_CTL) + CW_CNT + l * 32 * 64; const GAS int* RIDX = (const GAS int*)(ws + WS_RIDX);
        const int vcl = (G % 8 == 0) ? (bid % 8) * (G / 8) + bid / 8 : bid; const int i = tid >> 8, r = tid & 255, L = vcl + i * G;
        if (L < nT * 2) { const int pm = L >> 1, e = moe_te[pm], slot = pm * 256 - moe_off[e] + r; ridx_l[i * 256 + r] = slot < (int)cntp[e * 64] ? RIDX[(size_t)e * MOE_CAP + slot] : 0; }
        __syncthreads(); }
    pg8::MoeRows RM{ridx_l, vc >> 1};
    pg8::gemm_phase(lds, g, S, E, RM);
}
DI void ph_gemm_dn(const Ctx& cx, int l) {
    TIDS; GAS unsigned char* ws = cx.ws(); LAS unsigned char* lds = (LAS unsigned char*)lds_raw;
    LAS int* moe_off = (LAS int*)(lds + MISC_OFF + 64 * 4); LAS int* moe_te = (LAS int*)(lds + MISC_OFF + 128 * 4);
    const int nT = moe_tables((const GAS unsigned*)(ws + WS_CTL) + CW_CNT + l * 32 * 64, moe_off, moe_te, tid);
    pg8::Gemm g{(const GAS bf16*)(ws + WS_ACT), (const GAS bf16*)(ws + WS_WTDN + (size_t)l * 32 * D * 256 * 2), nT * 256, D, 256};
    pg8::EpiStoreBf16 E{(GAS bf16*)(ws + WS_XS), D};
    const GAS unsigned* ready = (const GAS unsigned*)(ws + WS_CTL) + CW_GUC + l * MOE_MAXT * 64;
    const int vc = (G % 8 == 0) ? (bid % 8) * (G / 8) + bid / 8 : bid;
    const int nb2 = (nT * 2 > G && nT * 2 - G < G / 2) ? nT * 2 - G : 0, Gd = G - nb2, cd = vc - nb2;
    const int pmE = nb2 ? G / 2 : nT, nE = pmE * 4, nL = (nT - pmE) * 4;
    const int cl = cd < 0 ? -1 : (cd - nE % Gd + Gd) % Gd;
    pg8::GroupedOrder S1{pmE, 4, Gd, cd, moe_te, (size_t)D * 256 * 2, 0};
    pg8::GroupedOrder S2{nT - pmE, 4, Gd, cl, moe_te, (size_t)D * 256 * 2, pmE};
    { pg8::Unit u;
#pragma unroll 1
      for (int i = 0; S1.next(i, u); ++i) pg8::wait_rowtile(ready, u.pm, 16u); }
    pg8::gemm_phase(lds, g, S1, E);
    if (nL > 0) { pg8::Unit u;
#pragma unroll 1
      for (int i = 0; S2.next(i, u); ++i) pg8::wait_rowtile(ready, u.pm, 16u);
      pg8::gemm_phase(lds, g, S2, E); }
}
DI void ph_combine(const Ctx& cx, int l) {
    TIDS; GAS unsigned char* ws = cx.ws(); LAS unsigned char* lds = (LAS unsigned char*)lds_raw;
    LAS int* moe_off = (LAS int*)(lds + MISC_OFF + 64 * 4); LAS int* moe_te = (LAS int*)(lds + MISC_OFF + 128 * 4);
    const int m_lo = (l == 0) ? 0 : NCTX;
    moe_tables((const GAS unsigned*)(ws + WS_CTL) + CW_CNT + l * 32 * 64, moe_off, moe_te, tid);
    const GAS int* EID = (const GAS int*)(ws + WS_MOE); const GAS float* GATE = (const GAS float*)(ws + WS_MOE) + MTOK * 2; const GAS int* POS = (const GAS int*)(ws + WS_MOE) + MTOK * 4;
    const GAS bf16* YS = (const GAS bf16*)(ws + WS_XS); GAS bf16* X = (GAS bf16*)(ws + WS_X); GAS bf16* H = (GAS bf16*)(ws + WS_H);
    const GAS float* MODB = (const GAS float*)(ws + WS_MOD); const GAS float* MOD = MODB + (size_t)l * 5 * 6144;
    const GAS float* n1g1 = cx.in(I_N1G) + D; const GAS float* fng = cx.in(I_FNG); GAS float* outp = cx.out();
#pragma unroll 1
    for (int m = m_lo + gw; m < MTOK; m += NGW) {
        const int d0 = moe_off[EID[m * 2]] + POS[m * 2], d1 = moe_off[EID[m * 2 + 1]] + POS[m * 2 + 1];
        const float w0 = GATE[m * 2], w1 = GATE[m * 2 + 1];
        const GAS float* mb = MOD + (size_t)bidx_of_row(m) * 6144;
        f32x4 v[4];
#pragma unroll
        for (int j = 0; j < 4; ++j) { const int c = 4 * lane + 256 * j;
            const v2u a0 = *(const GAS v2u*)(YS + (size_t)d0 * D + c), a1 = *(const GAS v2u*)(YS + (size_t)d1 * D + c);
            f32x4 y; y.x = w0 * bf2f(a0.x & 0xffffu) + w1 * bf2f(a1.x & 0xffffu); y.y = w0 * bf2f(a0.x >> 16) + w1 * bf2f(a1.x >> 16);
            y.z = w0 * bf2f(a0.y & 0xffffu) + w1 * bf2f(a1.y & 0xffffu); y.w = w0 * bf2f(a0.y >> 16) + w1 * bf2f(a1.y >> 16);
            const f32x4 g5 = *(const GAS f32x4*)(mb + 5 * 1024 + c);
            v[j] = bf4f(*(const GAS v2u*)(X + (size_t)m * D + c)) + g5 * y; }
        if (l == 0) {
#pragma unroll
            for (int j = 0; j < 4; ++j) *(GAS v2u*)(X + (size_t)m * D + 4 * lane + 256 * j) = f4bf(v[j]);
            const GAS float* mb1 = MODB + (size_t)(5 + bidx_of_row(m)) * 6144;
            norm_row_store(v, n1g1, mb1, mb1 + 1024, H + (size_t)m * D, lane);
        } else {
            float ss = 0.f;
#pragma unroll
            for (int j = 0; j < 4; ++j) ss += (v[j].x * v[j].x + v[j].y * v[j].y) + (v[j].z * v[j].z + v[j].w * v[j].w);
            const float rstd = rsqrtf(wave_sum(ss) * (1.f / D) + EPS);
#pragma unroll
            for (int j = 0; j < 4; ++j) { const int c = 4 * lane + 256 * j; const f32x4 gg = *(const GAS f32x4*)(fng + c);
                *(GAS f32x4*)(outp + (size_t)(m - NCTX) * D + c) = v[j] * rstd * gg; }
        }
    }
}

#ifndef PH_MASK
#define PH_MASK 0xFFF
#endif
#define PHON(j) (((PH_MASK) >> (j)) & 1)
__global__ void __launch_bounds__(512, 2) fwd_kernel(Args args) {
    LAS unsigned char* lds = (LAS unsigned char*)lds_raw;
    volatile LAS unsigned* MISC = (volatile LAS unsigned*)(lds + MISC_OFF);
    {
        const int tid = threadIdx.x;
        for (int u = tid; u < (LDS_BYTES - MISC_OFF) / 4; u += 512) MISC[u] = 0u;
        __syncthreads();
        if (tid == 0) { volatile LAS unsigned long long* t = (volatile LAS unsigned long long*)(lds + PTR_OFF);
#pragma unroll
            for (int i = 0; i < N_IN; ++i) t[i] = (unsigned long long)args.in[i];
            t[N_IN] = (unsigned long long)args.out; t[N_IN + 1] = (unsigned long long)args.ws; }
        __syncthreads();
    }
    const Ctx cx;
#if MK_ONE_LAUNCH
    XcdBarrier bar = xcd_barrier_post((unsigned*)(cx.ws() + WS_CTL) + CW_BAR, MISC + 8);
#define GRID_BAR() xcd_barrier(bar)
#else
#define GRID_BAR() do { } while (0)
#endif
    const int lo = args.ph_lo, hi = args.ph_hi;
#define IN(k) (lo <= (k) && (k) < hi)
#define BOTH(k) (IN(k) && IN((k) + 1))
    if (PHON(0) && IN(0)) { TIDS; phase_prologue(cx, lds, tid, lane, wave, bid, G); if (BOTH(0)) GRID_BAR(); }
    if (PHON(1) && IN(1)) { TIDS; phase_norm1_l0(cx, lane, gw, NGW); if (BOTH(1)) GRID_BAR(); }
#define LAYER(L) { constexpr int l = L; constexpr int pb = 2 + 10 * l; \
        if (PHON(2) && IN(pb + 0)) { ph_gemm_in(cx, l); if (BOTH(pb + 0)) GRID_BAR(); } \
        if (PHON(3) && IN(pb + 1)) { ph_prep_r1(cx, l); if (BOTH(pb + 1)) GRID_BAR(); } \
        if (PHON(4) && IN(pb + 2)) { rec_r2(cx, blockIdx.x * 512 + threadIdx.x, gridDim.x * 512); if (BOTH(pb + 2)) GRID_BAR(); } \
        if (PHON(5) && IN(pb + 3)) { ph_mixers(cx, l); if (BOTH(pb + 3)) GRID_BAR(); } \
        if (PHON(6) && IN(pb + 4)) { ph_gemm_out(cx, l); if (BOTH(pb + 4)) GRID_BAR(); } \
        if (PHON(7) && IN(pb + 5)) { ph_router(cx, l); if (BOTH(pb + 5)) GRID_BAR(); } \
        if (PHON(9) && IN(pb + 7)) { ph_gemm_gu(cx, l);   } \
        if (PHON(10) && IN(pb + 8)) { ph_gemm_dn(cx, l); if (BOTH(pb + 8)) GRID_BAR(); } \
        if (PHON(11) && IN(pb + 9)) { ph_combine(cx, l); if (BOTH(pb + 9)) GRID_BAR(); } }
    LAYER(0)
    LAYER(1)
#undef LAYER
#undef IN
#undef BOTH
}

constexpr int NPHASES = 22;
extern "C" void kernel_launch(void* const* d_in, const int* in_sizes, int n_in, void* d_out, int out_size, void* d_ws, size_t ws_size, hipStream_t stream) {
    static int grid = 0;
    if (grid == 0) {
        if (n_in != N_IN || out_size != NLAT * D || ws_size < WS_END) { fprintf(stderr, "kernel_launch: unexpected problem (n_in %d, out %d, ws %zu)\n", n_in, out_size, ws_size); grid = -1; return; }
        int dev = 0, cus = 0, per_cu = 0;
        if (hipGetDevice(&dev) != hipSuccess || hipDeviceGetAttribute(&cus, hipDeviceAttributeMultiprocessorCount, dev) != hipSuccess) { grid = -1; return; }
        if (hipFuncSetAttribute((const void*)fwd_kernel, hipFuncAttributeMaxDynamicSharedMemorySize, LDS_BYTES) != hipSuccess) { fprintf(stderr, "kernel_launch: hipFuncSetAttribute failed\n"); grid = -1; return; }
        if (hipOccupancyMaxActiveBlocksPerMultiprocessor(&per_cu, (const void*)fwd_kernel, 512, LDS_BYTES) != hipSuccess || per_cu < 1) fprintf(stderr, "kernel_launch: occupancy query reports %d\n", per_cu);
        (void)hipGetLastError();
        grid = cus;
    }
    if (grid < 0) return;
    (void)hipMemsetAsync((char*)d_ws + WS_CTL, 0, CTL_BYTES, stream);
    Args a{};
    for (int i = 0; i < N_IN; ++i) a.in[i] = (const float*)d_in[i];
    a.out = (float*)d_out; a.ws = (unsigned char*)d_ws;
#if MK_ONE_LAUNCH
    a.ph_lo = 0; a.ph_hi = NPHASES;
    hipLaunchKernelGGL(fwd_kernel, dim3(grid), dim3(512), LDS_BYTES, stream, a);
#else
    for (int p = 0; p < NPHASES; ++p) { a.ph_lo = p; a.ph_hi = p + 1; hipLaunchKernelGGL(fwd_kernel, dim3(grid), dim3(512), LDS_BYTES, stream, a); }
#endif
}
```

```cpp
#include <hip/hip_runtime.h>
#include <cstdio>
#include <cstdint>

#ifndef MK_ONE_LAUNCH
#define MK_ONE_LAUNCH 1
#endif

#define DI __device__ __forceinline__
#define GAS __attribute__((address_space(1)))
#define LAS __attribute__((address_space(3)))
typedef unsigned short bf16;
typedef unsigned v4u __attribute__((ext_vector_type(4)));
typedef unsigned v2u __attribute__((ext_vector_type(2)));
typedef float f32x4 __attribute__((ext_vector_type(4)));
typedef short bf16x8 __attribute__((ext_vector_type(8)));
#define LDS_WAIT() asm volatile("s_waitcnt lgkmcnt(0)" ::: "memory")

constexpr int D = 1024, NB = 4, SEQ = 4096, LCTX = 256, NCTX = NB * LCTX, NLAT = NB * SEQ, MTOK = NCTX + NLAT;
constexpr int DIN = 3200, PP = 3328;
constexpr int CA_Q = 0, CA_I = 256, CA_FF = 512, CA_FB = 768, CA_G = 1024;
constexpr int CB_Q = 1280, CB_K = 1536, CB_V = 1792;
constexpr int CC_Q = 2048, CC_K = 2176, CC_V = 2304, CC_G = 2560, CC_ZF = 2816, CC_ZB = 2832;
constexpr int CD_Q = 2848, CD_KV = 3040, CD_R = 3168;
constexpr int NKEY = LCTX + SEQ;
constexpr int NCHUNK = NKEY / 64;
constexpr float EPS = 1e-6f;
constexpr float LOG2E = 1.4426950408889634f;
constexpr int MOE_MAXT = 168;
constexpr int MOE_CAP = 2 * 17408;

enum { I_X = 0, I_C, I_CTX, I_CCTX, I_WMOD, I_BMOD, I_N1G, I_N2G, I_WIN, I_WOUT, I_LBL, I_HNG, I_RPB, I_WGF, I_BGF, I_WGB, I_BGB, I_GNG, I_QNG, I_WUQ, I_KVNG, I_WUKV,
       I_WRG, I_BRG, I_WRE, I_BRE, I_WGU, I_WDN, I_FNG, N_IN };

constexpr size_t MiB = 1u << 20;
constexpr size_t WS_CTL = 0, CTL_BYTES = 2 * MiB;
constexpr size_t WS_WTIN = 2 * MiB;
constexpr size_t WTIN_L = (size_t)PP * D * 2;
constexpr size_t WS_WTOUT = 16 * MiB;
constexpr size_t WS_WTUQ = 20 * MiB;
constexpr size_t WS_WTUKV = WS_WTUQ + 512 * 1024;
constexpr size_t WS_MOD = 21 * MiB;
constexpr size_t WS_WR = WS_MOD + 512 * 1024;
constexpr size_t WS_WTGU = 22 * MiB;
constexpr size_t WS_WTDN = 86 * MiB;
constexpr size_t WS_X = 118 * MiB;
constexpr size_t WS_H = 186 * MiB;
constexpr size_t WS_CAT = 220 * MiB;
constexpr size_t WS_P = 254 * MiB;
constexpr size_t WS_XS = WS_P;
constexpr size_t WS_ACT = 338 * MiB;
constexpr size_t WS_QM = 366 * MiB;
constexpr size_t WS_KM = 379 * MiB;
constexpr size_t WS_VM = 392 * MiB;
constexpr size_t WS_RSH = 401 * MiB;
constexpr size_t WS_RSG = 435 * MiB;
constexpr size_t WS_RAH = 452 * MiB;
constexpr size_t WS_RAG = WS_RAH + 600 * 1024;
constexpr size_t WS_MOE = 453 * MiB;
constexpr size_t WS_VNT = 454 * MiB;
constexpr size_t WS_RIDX = 463 * MiB;
constexpr size_t WS_END = 468 * MiB;
constexpr int CW_BAR = 4096;
constexpr int CW_CNT = 16384;
constexpr int CW_GUC = 32768;
constexpr int CW_TMO = 64;

constexpr int RING_BYTES = 131072;
constexpr int MISC_OFF = RING_BYTES;
constexpr int LDS_BYTES = 147456;

DI float bf2f(unsigned v) { return __uint_as_float(v << 16); }
DI unsigned f2bf(float f) { unsigned u = __float_as_uint(f); return (u + 0x7fffu + ((u >> 16) & 1u)) >> 16; }
typedef __bf16 bf16v2 __attribute__((ext_vector_type(2)));
typedef float f32x2 __attribute__((ext_vector_type(2)));
DI unsigned pk2(float lo, float hi) { const f32x2 v = {lo, hi}; return __builtin_bit_cast(unsigned, __builtin_convertvector(v, bf16v2)); }
DI f32x4 bf4f(v2u w) { f32x4 r; r.x = __uint_as_float(w.x << 16); r.y = __uint_as_float(w.x & 0xffff0000u); r.z = __uint_as_float(w.y << 16); r.w = __uint_as_float(w.y & 0xffff0000u); return r; }
DI v2u f4bf(f32x4 v) { return (v2u){pk2(v.x, v.y), pk2(v.z, v.w)}; }
DI bf16x8 pack8(float a0, float a1, float a2, float a3, float a4, float a5, float a6, float a7) {
    v4u p; p.x = pk2(a0, a1); p.y = pk2(a2, a3); p.z = pk2(a4, a5); p.w = pk2(a6, a7);
    return __builtin_bit_cast(bf16x8, p);
}
DI float wave_sum(float v) {
#pragma unroll
    for (int o = 1; o < 64; o <<= 1) v += __shfl_xor(v, o);
    return v;
}
DI float frcp_(float x) { return __builtin_amdgcn_rcpf(x); }
DI float sigmoid_(float x) { return frcp_(1.f + __expf(-x)); }
DI float silu_(float x) { return x * frcp_(1.f + __expf(-x)); }
DI float logsigmoid_(float x) { return fminf(x, 0.f) - __logf(1.f + __expf(-fabsf(x))); }
DI void unpack8(v4u w, float* f) {
    f[0] = __uint_as_float(w.x << 16); f[1] = __uint_as_float(w.x & 0xffff0000u);
    f[2] = __uint_as_float(w.y << 16); f[3] = __uint_as_float(w.y & 0xffff0000u);
    f[4] = __uint_as_float(w.z << 16); f[5] = __uint_as_float(w.z & 0xffff0000u);
    f[6] = __uint_as_float(w.w << 16); f[7] = __uint_as_float(w.w & 0xffff0000u);
}
DI int bidx_of_row(int m) { return m < NCTX ? 4 : ((m - NCTX) >> 12); }

namespace pg8 {
#define PG8_LAS __attribute__((address_space(3)))
typedef unsigned short bf16_t;
typedef unsigned u32x4 __attribute__((ext_vector_type(4)));
constexpr int BM = 256, BK = 64, HALF = 128, HTB = HALF * BK * 2, STAGE_BYTES = 8 * HTB, NXCD = 8, WGM = 8;
__host__ __device__ __forceinline__ int lds_byte(int r, int c) { const int st = (r >> 4) * 2 + (c >> 5), rr = r & 15, cc = c & 31, ob = rr * 64 + cc * 2; return st * 1024 + (ob ^ (((ob >> 9) & 1) << 5)); }
__host__ __device__ __forceinline__ void stage_rc(int b, int& R, int& C) { const int st = b / 1024, sb = b % 1024, swz = sb ^ (((sb >> 9) & 1) << 5); R = (st >> 1) * 16 + swz / 64; C = (st & 1) * 32 + (swz % 64) / 2; }
__host__ __device__ __forceinline__ int perm32(int rho) { const int n = rho >> 4, i = rho & 15; return 8 * (i >> 2) + 4 * n + (i & 3); }
struct Unit { int pm, pn; size_t bo; };
struct LinearRows { static constexpr bool LINEAR = true; __device__ __forceinline__ int operator()(const Unit& u, int r) const { return u.pm * BM + r; } };
struct MoeRows { static constexpr bool LINEAR = false; const PG8_LAS int* idx; int pm0;
    __device__ __forceinline__ int operator()(const Unit& u, int r) const { return idx[(u.pm == pm0 ? 0 : 256) + r]; } };
struct Gemm { const GAS bf16_t* A; const GAS bf16_t* Bt; int M, N, K; };
struct StaticOrder {
    int nM, nN, nwg, G, c;
    __device__ void init(int M, int N, int G_, int c_) { nM = M / BM; nN = N / BM; nwg = nM * nN; G = G_; c = c_; }
    __device__ bool next(int i, Unit& u) const {
        const long L = (long)i * G + c; if (L >= nwg) return false;
        int wgid = (int)L; { const int q = nwg / NXCD, r = nwg % NXCD, xcd = wgid % NXCD, off = wgid / NXCD; wgid = (xcd < r ? xcd * (q + 1) : r * (q + 1) + (xcd - r) * q) + off; }
        const int nig = WGM * nN, gid = wgid / nig, fm = gid * WGM, gsz = (nM - fm) < WGM ? (nM - fm) : WGM;
        u.pm = fm + ((wgid % nig) % gsz); u.pn = (wgid % nig) / gsz; u.bo = 0; return true;
    }
    __device__ __forceinline__ void a_ready(const Unit&) const {}
    __device__ __forceinline__ void done(const Unit&) const {}
};
struct GroupedOrder {
    int nT, nN, G, c; const PG8_LAS int* tile_e; size_t estride; int pm0 = 0;
    __device__ bool next(int i, Unit& u) const {
        if (c < 0) return false;
        const long L = (long)i * G + c; if (L >= (long)nT * nN) return false;
        u.pm = pm0 + (int)(L / nN); u.pn = (int)(L % nN); u.bo = (size_t)__builtin_amdgcn_readfirstlane(tile_e[u.pm]) * estride; return true;
    }
    __device__ __forceinline__ void a_ready(const Unit&) const {}
    __device__ __forceinline__ void done(const Unit&) const {}
};
struct GroupedPublish : GroupedOrder { GAS unsigned* done_cnt;
    __device__ __forceinline__ void done(const Unit& u) const { asm volatile("s_waitcnt vmcnt(0)" ::: "memory");
        if ((threadIdx.x & 63) == 0) __hip_atomic_fetch_add(done_cnt + 64 * u.pm, 1u, __ATOMIC_RELAXED, __HIP_MEMORY_SCOPE_AGENT); } };
__device__ __forceinline__ void wait_rowtile(const GAS unsigned* ready, int pm, unsigned need) {
    if (threadIdx.x < 64) {
        unsigned spins = 0;
        while ((unsigned)__builtin_amdgcn_readfirstlane(__hip_atomic_load(ready + 64 * pm, __ATOMIC_RELAXED, __HIP_MEMORY_SCOPE_AGENT)) < need && ++spins < (1u << 22)) __builtin_amdgcn_s_sleep(2);
        __builtin_amdgcn_fence(__ATOMIC_ACQUIRE, "agent");
        asm volatile("s_waitcnt vmcnt(0)" ::: "memory");
    }
    __syncthreads();
}
__device__ __forceinline__ unsigned cvt_pk_bf16(float lo, float hi) { unsigned r; asm volatile("v_cvt_pk_bf16_f32 %0, %1, %2" : "=v"(r) : "v"(lo), "v"(hi)); return r; }

struct EpiStoreBf16 {
    static constexpr bool PERM = true;
    GAS bf16_t* O; int ldc;
    __device__ __forceinline__ void operator()(const f32x4 (&acc)[2][2][4][2], const Unit& u, int wr, int wc, int fr, int fq) const {
        const int row0 = u.pm * BM + wr * 64 + fr, col0 = u.pn * BM + wc * 32 + 8 * fq;
#pragma unroll
        for (int ai = 0; ai < 2; ++ai)
#pragma unroll
            for (int m = 0; m < 4; ++m) { GAS bf16_t* rowp = O + (size_t)(row0 + ai * HALF + m * 16) * ldc + col0;
#pragma unroll
                for (int bj = 0; bj < 2; ++bj) { const f32x4 v0 = acc[ai][bj][m][0], v1 = acc[ai][bj][m][1];
                    u32x4 w; w.x = cvt_pk_bf16(v0[0], v0[1]); w.y = cvt_pk_bf16(v0[2], v0[3]); w.z = cvt_pk_bf16(v1[0], v1[1]); w.w = cvt_pk_bf16(v1[2], v1[3]);
                    *(GAS u32x4*)(rowp + bj * HALF) = w; } }
    }
};
struct EpiResid {
    static constexpr bool PERM = false;
    GAS bf16_t* X; int row_off; const GAS float* mod;
    const GAS float* src_ctx; const GAS float* src_lat;
    __device__ __forceinline__ void operator()(const f32x4 (&acc)[2][2][4][2], const Unit& u, int wr, int wc, int fr, int fq) const {
        const int row0 = row_off + u.pm * BM + wr * 64 + fr, col0 = u.pn * BM + wc * 32 + 4 * fq;
#pragma unroll
        for (int ai = 0; ai < 2; ++ai)
#pragma unroll
            for (int m = 0; m < 4; ++m) { const int row = row0 + ai * HALF + m * 16; GAS bf16_t* rowp = X + (size_t)row * D + col0; const GAS float* gp = mod + (size_t)bidx_of_row(row) * 6144 + col0;
                const GAS float* bp = src_lat ? (row < NCTX ? src_ctx + (size_t)row * D + col0 : src_lat + (size_t)(row - NCTX) * D + col0) : (const GAS float*)nullptr;
#pragma unroll
                for (int bj = 0; bj < 2; ++bj)
#pragma unroll
                    for (int n = 0; n < 2; ++n) { const f32x4 g = *(const GAS f32x4*)(gp + bj * HALF + n * 16);
                        f32x4 x = src_lat ? *(const GAS f32x4*)(bp + bj * HALF + n * 16) : bf4f(*(const GAS v2u*)(rowp + bj * HALF + n * 16));
                        x = x + g * acc[ai][bj][m][n]; *(GAS v2u*)(rowp + bj * HALF + n * 16) = f4bf(x); } }
    }
};
struct EpiGateUp {
    static constexpr bool PERM = true;
    GAS bf16_t* O; unsigned nbytes;
    __device__ __forceinline__ void operator()(const f32x4 (&acc)[2][2][4][2], const Unit& u, int wr, int wc, int fr, int fq) const {
        const int row0 = u.pm * BM + wr * 64 + fr, col0 = u.pn * HALF + wc * 32 + 8 * fq;
        const __amdgpu_buffer_rsrc_t rsrc = __builtin_amdgcn_make_buffer_rsrc((void*)O, 0, (int)nbytes, 0x00020000);
#pragma unroll
        for (int ai = 0; ai < 2; ++ai)
#pragma unroll
            for (int m = 0; m < 4; ++m) { const unsigned off = (unsigned)((row0 + ai * HALF + m * 16) * 256 + col0) * 2u;
                float r[8];
#pragma unroll
                for (int n = 0; n < 2; ++n)
#pragma unroll
                    for (int j = 0; j < 4; ++j) { const float g = acc[ai][0][m][n][j], up = acc[ai][1][m][n][j]; r[n * 4 + j] = g * __builtin_amdgcn_rcpf(1.f + __expf(-g)) * up; }
                u32x4 w; w.x = cvt_pk_bf16(r[0], r[1]); w.y = cvt_pk_bf16(r[2], r[3]); w.z = cvt_pk_bf16(r[4], r[5]); w.w = cvt_pk_bf16(r[6], r[7]);
                __builtin_amdgcn_raw_buffer_store_b128(w, rsrc, (int)off, 0, 16); }
    }
};

template <class Epi, class Sched, class Rows = LinearRows>
__device__ __forceinline__ void gemm_phase(PG8_LAS unsigned char* lds, const Gemm g, const Sched& S, const Epi& E, const Rows RM = Rows()) {
    const int tid = threadIdx.x, wid = __builtin_amdgcn_readfirstlane(tid >> 6), lane = tid & 63, wr = wid >> 2, wc = wid & 3, fr = lane & 15, fq = lane >> 4;
    const int K = g.K, nt = K / BK;
    unsigned voffB[2]; int rA[2], cA2[2];
#pragma unroll
    for (int i = 0; i < 2; ++i) { int R, C; stage_rc(tid * 16 + i * 8192, R, C); const int Rb = Epi::PERM ? ((R & ~31) + perm32(R & 31)) : R;
        rA[i] = R; cA2[i] = C * 2; voffB[i] = (unsigned)(Rb * K + C) * 2u; }
    unsigned oAc[2][2], oAn[2][2];
#define PG8_AOFF(dst, u) do { _Pragma("unroll") for (int _h = 0; _h < 2; ++_h) _Pragma("unroll") for (int _i = 0; _i < 2; ++_i) dst[_h][_i] = (unsigned)RM(u, _h * HALF + rA[_i]) * (unsigned)(K * 2) + (unsigned)cA2[_i]; } while (0)
#define PG8_STAGE_A(bufoff, o2, kbyte) do { _Pragma("unroll") for (int _i = 0; _i < 2; ++_i) \
        __builtin_amdgcn_global_load_lds((const unsigned*)((const char*)g.A + (size_t)(kbyte) + (o2)[_i]), (PG8_LAS unsigned*)(lds + (bufoff) + ldsw + _i * 8192), 16, 0, 0); } while (0)
    const size_t kstep = (size_t)(BK * 2);
    const size_t hstep = (size_t)HALF * K * 2;
    const size_t tstep = 2 * hstep;
    const unsigned ldsw = (unsigned)wid * 1024u;
    const int aoff = lds_byte(wr * 64 + fr, fq * 8), boff = lds_byte(wc * 32 + fr, fq * 8);
#define PG8_SA(b, h) (((b) * 2 + (h)) * HTB)
#define PG8_SB(b, h) ((4 + (b) * 2 + (h)) * HTB)
#define PG8_STAGE(bufoff, gbase, voff) do { _Pragma("unroll") for (int _i = 0; _i < 2; ++_i) \
        __builtin_amdgcn_global_load_lds((const unsigned*)((const char*)(gbase) + (voff)[_i]), (PG8_LAS unsigned*)(lds + (bufoff) + ldsw + _i * 8192), 16, 0, 0); } while (0)
#define PG8_LDA(dst, b, h) do { _Pragma("unroll") for (int m = 0; m < 4; ++m) _Pragma("unroll") for (int k = 0; k < 2; ++k) dst[m][k] = *(const PG8_LAS bf16x8*)(lds + PG8_SA(b, h) + aoff + m * 2048 + k * 1024); } while (0)
#define PG8_LDB(dst, b, h) do { _Pragma("unroll") for (int n = 0; n < 2; ++n) _Pragma("unroll") for (int k = 0; k < 2; ++k) dst[n][k] = *(const PG8_LAS bf16x8*)(lds + PG8_SB(b, h) + boff + n * 2048 + k * 1024); } while (0)
#define PG8_MMA(ai, bj, At, Bt) do { __builtin_amdgcn_s_setprio(1); _Pragma("unroll") for (int m = 0; m < 4; ++m) _Pragma("unroll") for (int n = 0; n < 2; ++n) _Pragma("unroll") for (int k = 0; k < 2; ++k) \
        acc[ai][bj][m][n] = __builtin_amdgcn_mfma_f32_16x16x32_bf16(Bt[n][k], At[m][k], acc[ai][bj][m][n], 0, 0, 0); __builtin_amdgcn_s_setprio(0); } while (0)
#define PG8_WAIT_V(n) asm volatile("s_waitcnt vmcnt(" #n ")" ::: "memory")
#define PG8_WAIT_L(n) asm volatile("s_waitcnt lgkmcnt(" #n ")" ::: "memory")
#define PG8_BAR __builtin_amdgcn_s_barrier()
#define PG8_SCHED __builtin_amdgcn_sched_barrier(0)
    Unit cur, nxt; int ui = 0;
    if (!S.next(0, cur)) return;
    f32x4 acc[2][2][4][2];
#pragma unroll
    for (int a = 0; a < 2; ++a)
#pragma unroll
        for (int b = 0; b < 2; ++b)
#pragma unroll
            for (int m = 0; m < 4; ++m)
#pragma unroll
                for (int n = 0; n < 2; ++n) acc[a][b][m][n] = (f32x4){0.f, 0.f, 0.f, 0.f};
    bf16x8 At[4][2], B0[2][2], B1[2][2];
    const char* cB = (const char*)g.Bt + cur.bo + (size_t)cur.pn * tstep;
    S.a_ready(cur);
    PG8_AOFF(oAc, cur);
    PG8_STAGE(PG8_SB(0, 0), cB, voffB); PG8_STAGE_A(PG8_SA(0, 0), oAc[0], 0); PG8_STAGE(PG8_SB(0, 1), cB + hstep, voffB); PG8_STAGE_A(PG8_SA(0, 1), oAc[1], 0);
    if (wr == 1) PG8_BAR;
    PG8_WAIT_V(4); PG8_BAR;
    PG8_STAGE(PG8_SB(1, 0), cB + kstep, voffB); PG8_STAGE_A(PG8_SA(1, 0), oAc[0], kstep); PG8_STAGE(PG8_SB(1, 1), cB + hstep + kstep, voffB);
    PG8_WAIT_V(6); PG8_BAR;
    for (;;) {
        const bool has_next = S.next(ui + 1, nxt);
        const char* nB = has_next ? (const char*)g.Bt + nxt.bo + (size_t)nxt.pn * tstep : cB;
        unsigned dAn = 0u;
        if constexpr (Rows::LINEAR) { if (has_next) dAn = (unsigned)(nxt.pm - cur.pm) * (unsigned)(BM * K * 2); }
        else { if (has_next) PG8_AOFF(oAn, nxt);
            else {
#pragma unroll
                for (int _h = 0; _h < 2; ++_h)
#pragma unroll
                    for (int _i = 0; _i < 2; ++_i) oAn[_h][_i] = oAc[_h][_i]; } }
        for (int t = 0; t < nt; t += 2) {
            const bool last = (t == nt - 2);
            const size_t k1 = (size_t)(t + 1) * kstep, k2 = last ? 0 : (size_t)(t + 2) * kstep, k3 = k2 + kstep;
            unsigned o20[2], o21[2];
#pragma unroll
            for (int _i = 0; _i < 2; ++_i) { if constexpr (Rows::LINEAR) { o20[_i] = oAc[0][_i] + (last ? dAn : 0u); o21[_i] = oAc[1][_i] + (last ? dAn : 0u); }
                else { o20[_i] = last ? oAn[0][_i] : oAc[0][_i]; o21[_i] = last ? oAn[1][_i] : oAc[1][_i]; } }
            const char* b2 = last ? nB : cB + (size_t)(t + 2) * kstep;
            const char* b3 = b2 + kstep;
            if (last && has_next) S.a_ready(nxt);
            PG8_LDB(B0, 0, 0); PG8_SCHED; PG8_LDA(At, 0, 0); PG8_STAGE_A(PG8_SA(1, 1), oAc[1], k1);
            PG8_WAIT_L(8); PG8_BAR; PG8_WAIT_L(0); PG8_MMA(0, 0, At, B0); PG8_BAR; PG8_SCHED;
            PG8_LDB(B1, 0, 1); PG8_STAGE(PG8_SB(0, 0), b2, voffB);
            PG8_BAR; PG8_WAIT_L(0); PG8_MMA(0, 1, At, B1); PG8_BAR;
            PG8_LDA(At, 0, 1); PG8_STAGE_A(PG8_SA(0, 0), o20, k2);
            PG8_BAR; PG8_WAIT_L(0); PG8_MMA(1, 0, At, B0); PG8_BAR; PG8_SCHED;
            PG8_STAGE(PG8_SB(0, 1), b2 + hstep, voffB);
            PG8_WAIT_V(6); PG8_BAR; PG8_MMA(1, 1, At, B1); PG8_BAR;
            PG8_LDB(B0, 1, 0); PG8_SCHED; PG8_LDA(At, 1, 0); PG8_STAGE_A(PG8_SA(0, 1), o21, k2);
            PG8_WAIT_L(8); PG8_BAR; PG8_WAIT_L(0); PG8_MMA(0, 0, At, B0); PG8_BAR; PG8_SCHED;
            PG8_LDB(B1, 1, 1); PG8_STAGE(PG8_SB(1, 0), b3, voffB);
            PG8_BAR; PG8_WAIT_L(0); PG8_MMA(0, 1, At, B1); PG8_BAR;
            PG8_LDA(At, 1, 1); PG8_STAGE_A(PG8_SA(1, 0), o20, k3);
            PG8_BAR; PG8_WAIT_L(0); PG8_MMA(1, 0, At, B0); PG8_BAR; PG8_SCHED;
            PG8_STAGE(PG8_SB(1, 1), b3 + hstep, voffB);
            PG8_WAIT_V(6); PG8_BAR; PG8_MMA(1, 1, At, B1); PG8_BAR;
        }
        E(acc, cur, wr, wc, fr, fq); S.done(cur);
        if (!has_next) break;
#pragma unroll
        for (int a = 0; a < 2; ++a)
#pragma unroll
            for (int b = 0; b < 2; ++b)
#pragma unroll
                for (int m = 0; m < 4; ++m)
#pragma unroll
                    for (int n = 0; n < 2; ++n) acc[a][b][m][n] = (f32x4){0.f, 0.f, 0.f, 0.f};
        cur = nxt; cB = nB; ++ui;
#pragma unroll
        for (int _h = 0; _h < 2; ++_h)
#pragma unroll
            for (int _i = 0; _i < 2; ++_i) { if constexpr (Rows::LINEAR) oAc[_h][_i] += dAn; else oAc[_h][_i] = oAn[_h][_i]; }
    }
    PG8_WAIT_V(0);
    if (wr == 0) PG8_BAR;
    PG8_BAR;
#undef PG8_SA
#undef PG8_SB
#undef PG8_STAGE
#undef PG8_STAGE_A
#undef PG8_AOFF
#undef PG8_LDA
#undef PG8_LDB
#undef PG8_MMA
#undef PG8_WAIT_V
#undef PG8_WAIT_L
#undef PG8_BAR
#undef PG8_SCHED
}
}

#define XB_TMO      128
#define XB_XCNT(j)  (256  + 64 * (j))
#define XB_XSUB(j)  (1280 + 64 * (j))
#define XB_XGEN(j)  (2304 + 64 * (j))
#define XB_TOP      3328
#define XB_TOPGEN   3392
#define XCD_BAR_WORDS 3456
#define XB_SPIN_CAP (1u << 18)
__device__ __forceinline__ unsigned xb_ld(unsigned* p)              { return __hip_atomic_load(p, __ATOMIC_RELAXED, __HIP_MEMORY_SCOPE_AGENT); }
__device__ __forceinline__ unsigned xb_add(unsigned* p, unsigned v) { return __hip_atomic_fetch_add(p, v, __ATOMIC_RELAXED, __HIP_MEMORY_SCOPE_AGENT); }
__device__ __forceinline__ unsigned xb_xcc_id() { return (unsigned)__builtin_amdgcn_s_getreg((3 << 11) | 20) & 0xFu; }
#define XB_SPIN(cond, bar) do { unsigned _sp = 0; while (cond) { __builtin_amdgcn_s_sleep(1); \
    if ((++_sp & 255u) == 0u) { if (xb_ld(&(bar)[XB_TMO])) break; if (_sp > XB_SPIN_CAP) { atomicAdd(&(bar)[XB_TMO], 1u); break; } } } } while (0)
struct XcdBarrier { unsigned* bar; unsigned x; volatile LAS unsigned* st; };
__device__ __forceinline__ XcdBarrier xcd_barrier_post(unsigned* bar, volatile LAS unsigned* st) {
    XcdBarrier b; b.bar = bar; b.x = xb_xcc_id(); b.st = st;
    if (threadIdx.x == 0) (void)xb_add(&bar[XB_XCNT(b.x)], 1u);
    return b;
}
__device__ __forceinline__ void xcd_barrier_complete(unsigned* bar, unsigned x, unsigned& nloc, unsigned& nx) {
    const unsigned G = gridDim.x * gridDim.y * gridDim.z;
    unsigned sum, cnt, mine, sp = 0u;
    for (;;) {
        sum = 0u; cnt = 0u; mine = 0u;
#pragma unroll
        for (unsigned j = 0; j < 16; ++j) { const unsigned c = xb_ld(&bar[XB_XCNT(j)]); sum += c; cnt += (c > 0u) ? 1u : 0u; mine = (j == x) ? c : mine; }
        if (sum == G) break;
        __builtin_amdgcn_s_sleep(1);
        if ((++sp & 255u) == 0u) { if (xb_ld(&bar[XB_TMO])) break; if (sp > XB_SPIN_CAP) { atomicAdd(&bar[XB_TMO], 1u); break; } }
    }
    nloc = mine > 0u ? mine : 1u; nx = cnt > 0u ? cnt : 1u;
}
__device__ __forceinline__ void xcd_barrier(const XcdBarrier& b) {
    asm volatile("s_waitcnt vmcnt(0)" ::: "memory");
    __syncthreads();
    if (threadIdx.x == 0) {
        unsigned* bar = b.bar;
        __builtin_amdgcn_s_waitcnt(0);
        unsigned nloc = b.st[0], nx = b.st[1];
        if (nloc == 0u) { xcd_barrier_complete(bar, b.x, nloc, nx); b.st[0] = nloc; b.st[1] = nx; }
        const unsigned old = xb_add(&bar[XB_XSUB(b.x)], 1u);
        const unsigned gen = old / nloc;
        if (old + 1u == (gen + 1u) * nloc) {
            __builtin_amdgcn_fence(__ATOMIC_RELEASE, "agent");
            asm volatile("s_waitcnt vmcnt(0)" ::: "memory");
            const unsigned og = xb_add(&bar[XB_TOP], 1u);
            const unsigned tg = og / nx;
            if (og + 1u == (tg + 1u) * nx) xb_add(&bar[XB_TOPGEN], 1u);
            else XB_SPIN(xb_ld(&bar[XB_TOPGEN]) == tg, bar);
            __builtin_amdgcn_fence(__ATOMIC_ACQUIRE, "agent");
            xb_add(&bar[XB_XGEN(b.x)], 1u);
            asm volatile("s_waitcnt vmcnt(0)" ::: "memory");
        } else {
            XB_SPIN(xb_ld(&bar[XB_XGEN(b.x)]) == gen, bar);
            __builtin_amdgcn_fence(__ATOMIC_ACQUIRE, "agent");
            asm volatile("s_waitcnt vmcnt(0)" ::: "memory");
        }
    }
    __syncthreads();
}

struct Args { const float* in[N_IN]; float* out; unsigned char* ws; int ph_lo, ph_hi; int pad0, pad1; };
extern __shared__ __attribute__((aligned(16))) unsigned char lds_raw[];
constexpr int PTR_OFF = MISC_OFF + 2048;
struct Ctx {
    DI unsigned long long raw(int i) const { volatile LAS unsigned* t = (volatile LAS unsigned*)((LAS unsigned char*)lds_raw + PTR_OFF) + 2 * i;
        const unsigned lo = __builtin_amdgcn_readfirstlane(t[0]), hi = __builtin_amdgcn_readfirstlane(t[1]); return ((unsigned long long)hi << 32) | lo; }
    DI const GAS float* in(int i) const { return (const GAS float*)raw(i); }
    DI GAS float* out() const { return (GAS float*)raw(N_IN); }
    DI GAS unsigned char* ws() const { return (GAS unsigned char*)raw(N_IN + 1); }
};

DI void transpose_item(const GAS float* W, int N, int k0, int n0, GAS bf16* WT, int Kd, int drow0, LAS float* scr, int lane) {
    float wv[32];
#pragma unroll
    for (int i = 0; i < 32; ++i) wv[i] = W[(size_t)(k0 + 2 * i + (lane >> 5)) * N + n0 + (lane & 31)];
#pragma unroll
    for (int i = 0; i < 32; ++i) scr[(2 * i + (lane >> 5)) * 33 + (lane & 31)] = wv[i];
    LDS_WAIT(); asm volatile("" ::: "memory");
    const int c = lane & 7;
#pragma unroll
    for (int j = 0; j < 4; ++j) { const int n = (lane >> 3) + 8 * j; const LAS float* s = scr + (8 * c) * 33 + n;
        v4u o; o.x = pk2(s[0 * 33], s[1 * 33]); o.y = pk2(s[2 * 33], s[3 * 33]); o.z = pk2(s[4 * 33], s[5 * 33]); o.w = pk2(s[6 * 33], s[7 * 33]);
        *(GAS v4u*)(WT + (size_t)(drow0 + n) * Kd + k0 + 8 * c) = o; }
    LDS_WAIT(); asm volatile("" ::: "memory");
}

DI void weight_copies(const Ctx& a, int l, LAS unsigned char* lds, int tid, int lane, int wave, int gwv, int ngw, int gt, int ngt) {
    GAS unsigned char* ws = a.ws();
    for (int i = gt; i < 128 * 1024 / 8; i += ngt) *(GAS v4u*)(ws + WS_WTIN + (size_t)l * WTIN_L + (size_t)3200 * D * 2 + (size_t)i * 16) = (v4u){0u, 0u, 0u, 0u};
    LAS float* scr = (LAS float*)(lds + wave * 16384);
    constexpr int IT_IN = 16 * 100, IT_OUT = 16 * 32, IT_UQ = 3 * 12, IT_UKV = 2 * 16, IT_GU = 32 * 16 * 16, IT_DN = 32 * 4 * 32;
    constexpr int NITEMS = IT_IN + IT_OUT + IT_UQ + IT_UKV + IT_GU + IT_DN;
    for (int it = gwv; it < NITEMS; it += ngw) {
        int r = it;
        if (r < IT_IN) { const int kb = r / 100, nb = r % 100;
            transpose_item(a.in(I_WIN) + (size_t)l * D * DIN, DIN, kb * 64, nb * 32, (GAS bf16*)(ws + WS_WTIN + (size_t)l * WTIN_L), D, nb * 32, scr, lane); continue; } r -= IT_IN;
        if (r < IT_OUT) { const int kb = r / 32, nb = r % 32;
            transpose_item(a.in(I_WOUT) + (size_t)l * D * D, D, kb * 64, nb * 32, (GAS bf16*)(ws + WS_WTOUT + (size_t)l * D * D * 2), D, nb * 32, scr, lane); continue; } r -= IT_OUT;
        if (r < IT_UQ) { const int kb = r / 12, nb = r % 12;
            transpose_item(a.in(I_WUQ) + (size_t)l * 192 * 384, 384, kb * 64, nb * 32, (GAS bf16*)(ws + WS_WTUQ + (size_t)l * 384 * 192 * 2), 192, nb * 32, scr, lane); continue; } r -= IT_UQ;
        if (r < IT_UKV) { const int kb = r / 16, nb = r % 16;
            transpose_item(a.in(I_WUKV) + (size_t)l * 128 * 512, 512, kb * 64, nb * 32, (GAS bf16*)(ws + WS_WTUKV + (size_t)l * 512 * 128 * 2), 128, nb * 32, scr, lane); continue; } r -= IT_UKV;
        if (r < IT_GU) { const int le = l * 32 + r / 256, q = r % 256, kb = q / 16, nb = q % 16; const int n0 = nb * 32, c0 = n0 & 255, isup = n0 >> 8;
            const int drow0 = (c0 >> 7) * 256 + isup * 128 + (c0 & 127);
            transpose_item(a.in(I_WGU) + (size_t)le * D * 512, 512, kb * 64, n0, (GAS bf16*)(ws + WS_WTGU + (size_t)le * 512 * D * 2), D, drow0, scr, lane); continue; } r -= IT_GU;
        { const int le = l * 32 + r / 128, q = r % 128, kb = q / 32, nb = q % 32;
            transpose_item(a.in(I_WDN) + (size_t)le * 256 * D, D, kb * 64, nb * 32, (GAS bf16*)(ws + WS_WTDN + (size_t)le * D * 256 * 2), 256, nb * 32, scr, lane); }
    }
}

DI void phase_prologue(const Ctx& a, LAS unsigned char* lds, int tid, int lane, int wave, int bid, int G) {
    GAS unsigned char* ws = a.ws();
    GAS float* MOD = (GAS float*)(ws + WS_MOD);
    {
        LAS float* S = (LAS float*)lds;
        LAS float* R = (LAS float*)(lds + 5 * 1024 * 4);
        if (bid < 192) {
            const GAS float* cvec = a.in(I_C); const GAS float* cctx = a.in(I_CCTX);
            for (int i = tid; i < 5 * 1024; i += 512) { const int r = i >> 10, k = i & 1023; const float v = r < 4 ? cvec[r * 1024 + k] : cctx[k]; S[i] = silu_(v); }
        }
        __syncthreads();
        for (int u = bid; u < 192; u += G) {
            const int l = u / 96, cl = tid & 63, n = (u % 96) * 64 + cl, ks = tid >> 6;
            const GAS float* W = a.in(I_WMOD) + (size_t)l * 1024 * 6144 + n; const GAS float* bmod = a.in(I_BMOD);
            float acc[5] = {0.f, 0.f, 0.f, 0.f, 0.f};
            for (int k = ks * 128; k < ks * 128 + 128; ++k) { const float w = W[(size_t)k * 6144];
#pragma unroll
                for (int r = 0; r < 5; ++r) acc[r] += S[r * 1024 + k] * w; }
#pragma unroll
            for (int r = 0; r < 5; ++r) R[(ks * 5 + r) * 64 + cl] = acc[r];
            __syncthreads();
            if (tid < 320) { const int r = tid >> 6; float s = 0.f;
#pragma unroll
                for (int k2 = 0; k2 < 8; ++k2) s += R[(k2 * 5 + r) * 64 + cl];
                MOD[(size_t)(l * 5 + r) * 6144 + n] = s + bmod[l * 6144 + n]; }
            __syncthreads();
        }
    }
    for (int i = bid * 512 + tid; i < 2 * 48 * 1024; i += G * 512) { const int l = i / (48 * 1024), r = i % (48 * 1024), c = r >> 10, k = r & 1023;
        const float w = c < 4 ? a.in(I_WRG)[(size_t)l * D * 4 + k * 4 + c] : (c < 36 ? a.in(I_WRE)[(size_t)l * D * 32 + k * 32 + (c - 4)] : 0.f);
        const unsigned hi = f2bf(w); const float lo = w - bf2f(hi);
        GAS bf16* WR = (GAS bf16*)(ws + WS_WR) + (size_t)l * 2 * 48 * 1024;
        WR[c * 1024 + k] = (bf16)hi; WR[48 * 1024 + c * 1024 + k] = (bf16)f2bf(lo); }
    weight_copies(a, 0, lds, tid, lane, wave, bid * 8 + wave, G * 8, bid * 512 + tid, G * 512);
}

DI void norm_row_store(const f32x4 (&v)[4], const GAS float* g, const GAS float* shift, const GAS float* scale, GAS bf16* hrow, int lane) {
    float ss = 0.f;
#pragma unroll
    for (int j = 0; j < 4; ++j) ss += (v[j].x * v[j].x + v[j].y * v[j].y) + (v[j].z * v[j].z + v[j].w * v[j].w);
    const float rstd = rsqrtf(wave_sum(ss) * (1.f / D) + EPS);
#pragma unroll
    for (int j = 0; j < 4; ++j) { const int c = 4 * lane + 256 * j;
        const f32x4 gg = *(const GAS f32x4*)(g + c), sh = *(const GAS f32x4*)(shift + c), sc = *(const GAS f32x4*)(scale + c);
        const f32x4 y = v[j] * rstd * gg * (1.f + sc) + sh;
        v2u o; o.x = pk2(y.x, y.y); o.y = pk2(y.z, y.w); *(GAS v2u*)(hrow + c) = o; }
}

DI void phase_norm1_l0(const Ctx& a, int lane, int gw, int NGW) {
    GAS unsigned char* ws = a.ws(); GAS bf16* H = (GAS bf16*)(ws + WS_H); const GAS float* MOD = (const GAS float*)(ws + WS_MOD);
    const GAS float* xin = a.in(I_X); const GAS float* cin = a.in(I_CTX); const GAS float* n1g = a.in(I_N1G);
    for (int m = gw; m < MTOK; m += NGW) {
        const GAS float* src = m < NCTX ? cin + (size_t)m * D : xin + (size_t)(m - NCTX) * D;
        f32x4 v[4];
#pragma unroll
        for (int j = 0; j < 4; ++j) v[j] = *(const GAS f32x4*)(src + 4 * lane + 256 * j);
        const GAS float* mb = MOD + (size_t)bidx_of_row(m) * 6144;
        norm_row_store(v, n1g, mb, mb + 1024, H + (size_t)m * D, lane);
    }
}

DI bf16x8 ld8(const LAS bf16* p) { return *(const LAS bf16x8*)p; }
DI bf16x8 ld8(const GAS bf16* p) { return *(const GAS bf16x8*)p; }
template <class PA, class PB>
DI f32x4 mma16(PA A, int lda, PB B, int ldb, int K, int lane) {
    f32x4 acc = {0.f, 0.f, 0.f, 0.f};
    const int r = lane & 15, q = (lane >> 4) * 8;
    for (int k = 0; k < K; k += 32) {
        const bf16x8 av = ld8(A + r * lda + k + q);
        const bf16x8 bv = ld8(B + r * ldb + k + q);
        acc = __builtin_amdgcn_mfma_f32_16x16x32_bf16(av, bv, acc, 0, 0, 0);
    }
    return acc;
}

constexpr int CQ_P = 200, CKV_P = 136, STG_P = 520;
constexpr int PR = 64, PL_CQ = 0, PL_CKV = 25600, PL_RK = 43008, PL_STG = 47104, PL_T = PL_STG;
DI float rope_ang(int t, int ri) { const int ax = ri >> 4, f = ri & 7; const float p = (float)(ax == 0 ? (t >> 6) : (t & 63)); return p * __builtin_amdgcn_exp2f(-1.6609640474436813f * (float)f) * 0.15915494309189535f; }
DI void prep_unit(const Ctx& a, int l, int unit, LAS unsigned char* lds, int tid, int lane, int wave) {
    GAS unsigned char* ws = a.ws();
    const GAS bf16* P = (const GAS bf16*)(ws + WS_P);
    LAS bf16* CQ = (LAS bf16*)(lds + PL_CQ); LAS bf16* CKV = (LAS bf16*)(lds + PL_CKV); LAS bf16* STG = (LAS bf16*)(lds + PL_STG); LAS bf16* RK = (LAS bf16*)(lds + PL_RK); LAS bf16* T = (LAS bf16*)(lds + PL_T);
    const int m0 = unit * PR;
    const bool isctx = m0 < NCTX;
    const int bb = isctx ? (m0 >> 8) : ((m0 - NCTX) >> 12);
    const int pos0 = isctx ? (m0 & 255) : (256 + ((m0 - NCTX) & 4095));
    const int t0 = isctx ? 0 : ((m0 - NCTX) & 4095);
    { const GAS float* gq = a.in(I_QNG) + l * 192; const GAS float* gkv = a.in(I_KVNG) + l * 128;
        const bool isq = lane < 24, iskv = lane >= 24 && lane < 40; const int pc = isq ? lane : lane - 24;
        float gn[8];
#pragma unroll
        for (int e = 0; e < 8; ++e) gn[e] = isq ? gq[pc * 8 + e] : (iskv ? gkv[pc * 8 + e] : 0.f);
#pragma unroll
        for (int rr = 0; rr < PR / 8; ++rr) { const int r = wave * (PR / 8) + rr; float x[8];
            v4u w = (v4u){0u, 0u, 0u, 0u}; if (lane < 40) w = *(const GAS v4u*)(P + (size_t)(m0 + r) * PP + (isq ? CD_Q : CD_KV) + pc * 8);
            unpack8(w, x); float ss = 0.f;
#pragma unroll
            for (int e = 0; e < 8; ++e) ss += x[e] * x[e];
            const float sq = wave_sum(isq ? ss : 0.f), skv = wave_sum(iskv ? ss : 0.f);
            const float rs = isq ? rsqrtf(sq * (1.f / 192.f) + EPS) : rsqrtf(skv * (1.f / 128.f) + EPS);
#pragma unroll
            for (int e = 0; e < 8; ++e) x[e] *= rs * gn[e];
            const v4u o = (v4u){pk2(x[0], x[1]), pk2(x[2], x[3]), pk2(x[4], x[5]), pk2(x[6], x[7])};
            if (isq) *(LAS v4u*)(CQ + r * CQ_P + pc * 8) = o; else if (iskv) *(LAS v4u*)(CKV + r * CKV_P + pc * 8) = o; } }
    for (int e = tid; e < PR * 32; e += 512) { const int r = e >> 5, ri = e & 31; const GAS bf16* prow = P + (size_t)(m0 + r) * PP + CD_R;
        float v = bf2f(prow[ri]);
        if (!isctx) { const float pv = bf2f(prow[ri ^ 8]); const float ang = rope_ang(t0 + r, ri); const float cs = __builtin_amdgcn_cosf(ang), sn = __builtin_amdgcn_sinf(ang);
            v = ((ri >> 3) & 1) == 0 ? (v * cs - pv * sn) : (pv * sn + v * cs); }
        RK[r * 32 + ri] = (bf16)f2bf(v); }
    for (int e = tid; e < PR * 32; e += 512) { const int r = e >> 5, c8 = e & 31; *(LAS v4u*)(T + r * 264 + c8 * 8) = *(const GAS v4u*)(P + (size_t)(m0 + r) * PP + CB_V + c8 * 8); }
    __syncthreads();
    GAS bf16* QM = (GAS bf16*)(ws + WS_QM); GAS bf16* KM = (GAS bf16*)(ws + WS_KM); GAS bf16* VM = (GAS bf16*)(ws + WS_VM); GAS bf16* VNT = (GAS bf16*)(ws + WS_VNT);
    const GAS bf16* WTQ = (const GAS bf16*)(ws + WS_WTUQ + (size_t)l * 384 * 192 * 2);
    const GAS bf16* WTKV = (const GAS bf16*)(ws + WS_WTUKV + (size_t)l * 512 * 128 * 2);
    const float qs = 0.10206207261596575f * LOG2E;
    const int fr = lane & 15, fq = lane >> 4;
    for (int e = tid; e < 256 * (PR / 8); e += 512) { const int col = e / (PR / 8), p8 = e % (PR / 8); unsigned hv[8];
#pragma unroll
        for (int j = 0; j < 8; ++j) hv[j] = T[(p8 * 8 + j) * 264 + col];
        *(GAS v4u*)(VNT + ((size_t)(bb * 4) * 64 + col) * NKEY + pos0 + p8 * 8) = (v4u){hv[0] | (hv[1] << 16), hv[2] | (hv[3] << 16), hv[4] | (hv[5] << 16), hv[6] | (hv[7] << 16)}; }
    __syncthreads();
    { bf16x8 bfr[3][6];
#pragma unroll
      for (int i = 0; i < 3; ++i)
#pragma unroll
        for (int ks = 0; ks < 6; ++ks) bfr[i][ks] = *(const GAS bf16x8*)(WTQ + (size_t)((wave + 8 * i) * 16 + fr) * 192 + ks * 32 + fq * 8);
#pragma unroll
      for (int i = 0; i < 3; ++i) { const int nb = wave + 8 * i;
        const int c = nb * 16 + fr, within = c % 96;
#pragma unroll
        for (int mb = 0; mb < PR / 16; ++mb) { f32x4 acc = {0.f, 0.f, 0.f, 0.f};
#pragma unroll
            for (int ks = 0; ks < 6; ++ks) acc = __builtin_amdgcn_mfma_f32_16x16x32_bf16(*(const LAS bf16x8*)(CQ + (mb * 16 + fr) * CQ_P + ks * 32 + fq * 8), bfr[i][ks], acc, 0, 0, 0);
#pragma unroll
            for (int j = 0; j < 4; ++j) { const int r = mb * 16 + 4 * fq + j; float v = acc[j]; const float pv = __shfl_xor(v, 8);
                if (within >= 64 && !isctx) { const int ri = within - 64; const float ang = rope_ang(t0 + r, ri); const float cs = __builtin_amdgcn_cosf(ang), sn = __builtin_amdgcn_sinf(ang);
                    v = ((ri >> 3) & 1) == 0 ? (v * cs - pv * sn) : (pv * sn + v * cs); }
                STG[r * STG_P + c] = (bf16)f2bf(v * qs); } } } }
    __syncthreads();
    for (int e = tid; e < PR * 48; e += 512) { const int r = e / 48, hp = e % 48, hd = hp / 12, pc = hp % 12;
        *(GAS v4u*)(QM + ((size_t)(bb * 4 + hd) * NKEY + pos0 + r) * 96 + pc * 8) = *(const LAS v4u*)(STG + r * STG_P + hd * 96 + pc * 8); }
    __syncthreads();
    { bf16x8 bfr[4][4];
#pragma unroll
      for (int i = 0; i < 4; ++i)
#pragma unroll
        for (int ks = 0; ks < 4; ++ks) bfr[i][ks] = *(const GAS bf16x8*)(WTKV + (size_t)((wave + 8 * i) * 16 + fr) * 128 + ks * 32 + fq * 8);
#pragma unroll
      for (int i = 0; i < 4; ++i) { const int nb = wave + 8 * i;
#pragma unroll
        for (int mb = 0; mb < PR / 16; ++mb) { f32x4 acc = {0.f, 0.f, 0.f, 0.f};
#pragma unroll
            for (int ks = 0; ks < 4; ++ks) acc = __builtin_amdgcn_mfma_f32_16x16x32_bf16(*(const LAS bf16x8*)(CKV + (mb * 16 + fr) * CKV_P + ks * 32 + fq * 8), bfr[i][ks], acc, 0, 0, 0);
#pragma unroll
            for (int j = 0; j < 4; ++j) STG[(mb * 16 + 4 * fq + j) * STG_P + nb * 16 + fr] = (bf16)f2bf(acc[j]); } } }
    __syncthreads();
    for (int e = tid; e < PR * 48; e += 512) { const int r = e / 48, hp = e % 48, hd = hp / 12, pc = hp % 12;
        const v4u v = pc < 8 ? *(const LAS v4u*)(STG + r * STG_P + hd * 128 + pc * 8) : *(const LAS v4u*)(RK + r * 32 + (pc - 8) * 8);
        *(GAS v4u*)(KM + ((size_t)(bb * 4 + hd) * NKEY + pos0 + r) * 96 + pc * 8) = v; }
    for (int e = tid; e < 256 * (PR / 8); e += 512) { const int col = e / (PR / 8), p8 = e % (PR / 8), hd = col >> 6, dv = col & 63; unsigned hv[8];
#pragma unroll
        for (int j = 0; j < 8; ++j) hv[j] = STG[(p8 * 8 + j) * STG_P + hd * 128 + 64 + dv];
        *(GAS v4u*)(VM + ((size_t)(bb * 4 + hd) * 64 + dv) * NKEY + pos0 + p8 * 8) = (v4u){hv[0] | (hv[1] << 16), hv[2] | (hv[3] << 16), hv[4] | (hv[5] << 16), hv[6] | (hv[7] << 16)}; }
    __syncthreads();
}

constexpr int RP = 65;
DI int scan_row(int b, int dir, int c, int i) {
    const int s = 64 * c + i;
    if (dir == 0) return s < 256 ? b * 256 + s : NCTX + b * SEQ + (s - 256);
    return s < 256 ? b * 256 + 255 - s : NCTX + b * SEQ + SEQ - 1 - (s - 256);
}
#ifndef BAR_LDS
#define BAR_LDS() asm volatile("s_waitcnt lgkmcnt(0)\n\ts_barrier" ::: "memory")
#endif
constexpr int RC_P = 68;
constexpr int L_C = 0, L_QD = 17408, L_QE = 26624, L_KD = 35840, L_VT = 58880, L_ST = 68096, L_ATT = 77312, L_O = 86528, L_T = 103168;
template <int MIX> struct RecCfg { static constexpr int DK = MIX == 0 ? 64 : 32, DKP = DK + 8, NP = DK / 8, CPT = DK / 8; };
template <int MIX> struct RecPre {
    v4u fk;
    v4u zg[MIX == 1 ? 2 : 1];
    v4u qp;
    v4u vp; f32x4 s0, s1;
};
template <int MIX, bool R3>
DI void rec_fetch(RecPre<MIX>& R, const GAS bf16* P, const GAS float* RSbase, int b, int h, int dir, int c, int tid) {
    constexpr int DK = RecCfg<MIX>::DK;
    const int lane = tid & 63, wave = tid >> 6;
    const GAS bf16* prow = P + (size_t)scan_row(b, dir, c, lane) * PP;
    if (MIX == 0) { R.fk = *(const GAS v4u*)(prow + (dir ? CA_FB : CA_FF) + h * 64 + 8 * wave); if (R3) R.qp = *(const GAS v4u*)(prow + CA_Q + h * 64 + 8 * wave); }
    else { const GAS bf16* zr = prow + (dir ? CC_ZB : CC_ZF); R.zg[0] = *(const GAS v4u*)zr; R.zg[1] = *(const GAS v4u*)(zr + 8);
        const v2u kk = *(const GAS v2u*)(prow + CC_K + h * 32 + 4 * wave); R.fk = (v4u){kk.x, kk.y, 0u, 0u};
        if (R3) { const v2u qq = *(const GAS v2u*)(prow + CC_Q + h * 32 + 4 * wave); R.qp = (v4u){qq.x, qq.y, 0u, 0u}; } }
    R.vp = *(const GAS v4u*)(P + (size_t)scan_row(b, dir, c, tid >> 3) * PP + (MIX == 0 ? CA_I : CC_V) + h * 64 + (tid & 7) * 8);
    if (R3 && tid < DK * 8) { const GAS float* rs = RSbase + (size_t)(((b * 4 + h) * 2 + dir) * NCHUNK + c) * DK * 64 + (tid >> 3) * 64 + (tid & 7) * 8; R.s0 = *(const GAS f32x4*)rs; R.s1 = *(const GAS f32x4*)(rs + 4); }
}
DI float dpp_shr_(float v, int ctrl_sel) { const int iv = __builtin_bit_cast(int, v); int r;
    switch (ctrl_sel) { case 1: r = __builtin_amdgcn_update_dpp(0, iv, 0x111, 0xf, 0xf, true); break; case 2: r = __builtin_amdgcn_update_dpp(0, iv, 0x112, 0xf, 0xf, true); break;
                        case 4: r = __builtin_amdgcn_update_dpp(0, iv, 0x114, 0xf, 0xf, true); break; default: r = __builtin_amdgcn_update_dpp(0, iv, 0x118, 0xf, 0xf, true); break; }
    return __builtin_bit_cast(float, r); }
DI float scan64(float v) {
    v += dpp_shr_(v, 1); v += dpp_shr_(v, 2); v += dpp_shr_(v, 4); v += dpp_shr_(v, 8);
    v += __builtin_bit_cast(float, __builtin_amdgcn_update_dpp(0, __builtin_bit_cast(int, v), 0x142, 0xa, 0xf, false));
    v += __builtin_bit_cast(float, __builtin_amdgcn_update_dpp(0, __builtin_bit_cast(int, v), 0x143, 0xc, 0xf, false));
    return v; }
DI float lane_read(float v, int ln) { return __builtin_bit_cast(float, __builtin_amdgcn_readlane(__builtin_bit_cast(int, v), ln)); }
template <int MIX>
DI void rec_front(const RecPre<MIX>& R, const GAS float* lg, const GAS float* wgp, const GAS float* bgp, int l, int h, int dir, int wave, float (&kv)[RecCfg<MIX>::CPT], float (&cum)[RecCfg<MIX>::CPT]) {
    if (MIX == 0) { float z[8]; unpack8(R.fk, z);
#pragma unroll
        for (int e = 0; e < 8; ++e) { const int ch = h * 64 + 8 * wave + e; float lb = 0.f; if (l == 1) lb = sigmoid_(lg[512 + dir * 256 + ch] - lg[dir * 256 + ch]);
            const float f = lb + (1.f - lb) * sigmoid_(z[e]); cum[e] = scan64(__logf(f)); kv[e] = (1.f - lb) * sigmoid_(-z[e]); }
    } else { float z[16], kk[8]; unpack8(R.zg[0], z); unpack8(R.zg[1], z + 8); unpack8(R.fk, kk);
#pragma unroll
        for (int c = 0; c < 4; ++c) { const int ch = h * 32 + 4 * wave + c; float sacc = bgp[ch];
#pragma unroll
            for (int r = 0; r < 16; ++r) sacc += z[r] * wgp[r * 128 + ch];
            cum[c] = scan64(logsigmoid_(sacc) * (1.f / 16.f)); kv[c] = kk[c]; } }
}
template <int N> DI void st_bf16(LAS bf16* p, const float (&v)[N]) {
    if (N == 8) *(LAS v4u*)p = (v4u){pk2(v[0], v[1]), pk2(v[2], v[3]), pk2(v[4], v[5]), pk2(v[6], v[7])};
    else *(LAS v2u*)p = (v2u){pk2(v[0], v[1]), pk2(v[2], v[3])};
}
DI void rec_vt_store(const v4u vp, LAS bf16* VT, int tid) { const int j = tid >> 3, v8 = tid & 7; const unsigned ww[4] = {vp.x, vp.y, vp.z, vp.w};
#pragma unroll
    for (int e = 0; e < 8; ++e) VT[(v8 * 8 + e) * 72 + j] = (bf16)((ww[e >> 1] >> ((e & 1) * 16)) & 0xffffu); }

template <int MIX>
DI void rec_r1_run(const Ctx& a, int l, LAS unsigned char* lds, int tid, int bid, int G) {
    constexpr int DK = RecCfg<MIX>::DK, CPT = RecCfg<MIX>::CPT;
    const int lane = tid & 63, wave = __builtin_amdgcn_readfirstlane(tid >> 6);
    LAS bf16* KT = (LAS bf16*)(lds + L_KD); LAS bf16* VT = (LAS bf16*)(lds + L_VT);
    GAS unsigned char* wsb = a.ws(); const GAS bf16* P = (const GAS bf16*)(wsb + WS_P);
    GAS float* RSb = (GAS float*)(wsb + (MIX == 0 ? WS_RSH : WS_RSG)); GAS float* RAb = (GAS float*)(wsb + (MIX == 0 ? WS_RAH : WS_RAG));
    const GAS float* lg = a.in(I_LBL);
    const GAS float* wgF = a.in(I_WGF) + l * 16 * 128; const GAS float* wgB = a.in(I_WGB) + l * 16 * 128; const GAS float* bgF = a.in(I_BGF) + l * 128; const GAS float* bgB = a.in(I_BGB) + l * 128;
    constexpr int NU = 32 * NCHUNK;
    const bool rebal = (MIX == 0) && (G == 256);
    const int n0 = (rebal && bid < 16) ? 8 : 0, nn = (NU - 1 - bid) / G + 1, n1 = nn + ((rebal && bid >= 128) ? 1 : 0);
    auto unit_at = [&](int n) { if (n >= n1) return NU; if (n < nn) return bid + G * n; const int e = bid - 128; return (e & 15) + G * (e >> 4); };
    RecPre<MIX> Rs[2];
    int nidx = n0;
    int u0 = unit_at(nidx), u1 = unit_at(nidx + 1);
#pragma unroll
    for (int par = 0; par < 2; ++par) { const int unit = par ? u1 : u0; if (unit < NU) { const int c = unit % NCHUNK, chain = unit / NCHUNK; rec_fetch<MIX, false>(Rs[par], P, RSb, chain >> 3, (chain >> 1) & 3, chain & 1, c, tid); } }
    BAR_LDS();
#pragma unroll 1
    while (u0 < NU) {
        const int n2 = unit_at(nidx + 2), n3 = unit_at(nidx + 3);
#pragma unroll
        for (int par = 0; par < 2; ++par) { const int unit = par ? u1 : u0; if (unit < NU) { RecPre<MIX>& R = Rs[par];
            LAS bf16* KTp = par ? (LAS bf16*)(lds + L_ST) : KT; LAS bf16* VTp = par ? (LAS bf16*)(lds + L_ATT) : VT;
            const int c = unit % NCHUNK, chain = unit / NCHUNK, dir = chain & 1, h = (chain >> 1) & 3;
            { float kv[CPT], cum[CPT]; rec_front<MIX>(R, lg, dir ? wgB : wgF, dir ? bgB : bgF, l, h, dir, wave, kv, cum);
#pragma unroll
                for (int e = 0; e < CPT; ++e) { const float last = lane_read(cum[e], 63); KTp[(CPT * wave + e) * 72 + lane] = (bf16)f2bf(kv[e] * __expf(last - cum[e]));
                    if (lane == 63) RAb[(size_t)(chain * NCHUNK + c) * DK + CPT * wave + e] = __expf(cum[e]); } }
            rec_vt_store(R.vp, VTp, tid);
            { const int nu = par ? n3 : n2; if (nu < NU) { const int c2 = nu % NCHUNK, ch2 = nu / NCHUNK; rec_fetch<MIX, false>(R, P, RSb, ch2 >> 3, (ch2 >> 1) & 3, ch2 & 1, c2, tid); } } } }
        BAR_LDS();
#pragma unroll
        for (int par = 0; par < 2; ++par) { const int unit = par ? u1 : u0; if (unit < NU) {
            const LAS bf16* KTp = par ? (const LAS bf16*)(lds + L_ST) : KT; const LAS bf16* VTp = par ? (const LAS bf16*)(lds + L_ATT) : VT;
            const int c = unit % NCHUNK, chain = unit / NCHUNK;
            GAS float* RS = RSb + (size_t)(chain * NCHUNK + c) * DK * 64;
#pragma unroll 1
            for (int tl = wave; tl < (DK / 16) * 4; tl += 8) { const int kb = tl >> 2, vb = tl & 3;
                const f32x4 acc = mma16(KTp + kb * 16 * 72, 72, VTp + vb * 16 * 72, 72, 64, lane);
#pragma unroll
                for (int j = 0; j < 4; ++j) RS[(kb * 16 + 4 * (lane >> 4) + j) * 64 + vb * 16 + (lane & 15)] = acc[j]; } } }
        BAR_LDS();
        nidx += 2; u0 = n2; u1 = n3;
    }
}

DI void rec_r2(const Ctx& a, int gtid, int gthreads) {
    GAS unsigned char* wsb = a.ws();
#pragma unroll 1
    for (int e = gtid; e < 32 * 4096 + 32 * 2048; e += gthreads) {
        const bool g = e >= 32 * 4096; const int ee = g ? e - 32 * 4096 : e; const int DK = g ? 32 : 64, per = DK * 64;
        const int chain = ee / per, kv = ee % per, k = kv >> 6;
        GAS float* RS = (GAS float*)(wsb + (g ? WS_RSG : WS_RSH)) + (size_t)chain * NCHUNK * per + kv;
        const GAS float* RA = (const GAS float*)(wsb + (g ? WS_RAG : WS_RAH)) + (size_t)chain * NCHUNK * DK + k;
        float S = 0.f;
#pragma unroll 1
        for (int c = 0; c < NCHUNK; c += 4) { float U[4], A[4];
#pragma unroll
            for (int u = 0; u < 4; ++u) { U[u] = RS[(size_t)(c + u) * per]; A[u] = RA[(c + u) * DK]; }
#pragma unroll
            for (int u = 0; u < 4; ++u) { RS[(size_t)(c + u) * per] = S; S = A[u] * S + U[u]; } }
    }
}

template <int MIX>
DI void rec_r3_run(const Ctx& a, int l, LAS unsigned char* lds, int tid, int bid, int G, bool keep_ctx) {
    constexpr int DK = RecCfg<MIX>::DK, DKP = RecCfg<MIX>::DKP, CPT = RecCfg<MIX>::CPT;
    const int lane = tid & 63, wave = __builtin_amdgcn_readfirstlane(tid >> 6);
    LAS bf16* QD = (LAS bf16*)(lds + L_QD); LAS bf16* QE = (LAS bf16*)(lds + L_QE); LAS bf16* KD = (LAS bf16*)(lds + L_KD);
    LAS bf16* VT = (LAS bf16*)(lds + L_VT); LAS bf16* ST = (LAS bf16*)(lds + L_ST); LAS bf16* ATT = (LAS bf16*)(lds + L_ATT); LAS float* Ob = (LAS float*)(lds + L_O);
    GAS unsigned char* wsb = a.ws(); const GAS bf16* P = (const GAS bf16*)(wsb + WS_P); GAS bf16* CAT = (GAS bf16*)(wsb + WS_CAT);
    const GAS float* RSb = (const GAS float*)(wsb + (MIX == 0 ? WS_RSH : WS_RSG));
    const GAS float* lg = a.in(I_LBL); const GAS float* ngb = a.in(MIX == 0 ? I_HNG : I_GNG) + l * 256;
    const GAS float* wgF = a.in(I_WGF) + l * 16 * 128; const GAS float* wgB = a.in(I_WGB) + l * 16 * 128; const GAS float* bgF = a.in(I_BGF) + l * 128; const GAS float* bgB = a.in(I_BGB) + l * 128;
    constexpr int nR = 16 * NCHUNK;
    const int nAct = keep_ctx ? nR : 16 * 64, first = (bid + (MIX == 0 ? 0 : G - 64)) % G;
    auto unit_of = [&](int a) { return a >= nAct ? nR : (keep_ctx ? a : (a >> 6) * NCHUNK + 4 + (a & 63)); };
    auto scanc = [&](int tc, int dir) { return dir == 0 ? tc : (tc < 4 ? 3 - tc : 71 - tc); };
    RecPre<MIX> Rs[2];
    int aidx = first;
    int unit = unit_of(aidx);
    if (unit < nR) { const int tc = unit % NCHUNK, bh = unit / NCHUNK; rec_fetch<MIX, true>(Rs[0], P, RSb, bh >> 2, bh & 3, 0, scanc(tc, 0), tid); rec_fetch<MIX, true>(Rs[1], P, RSb, bh >> 2, bh & 3, 1, scanc(tc, 1), tid); }
    BAR_LDS();
#pragma unroll 1
    while (unit < nR) {
        const int tc = unit % NCHUNK, bh = unit / NCHUNK, h = bh & 3, b = bh >> 2;
        const int nunit = unit_of(aidx + G);
        v4u gatep = (v4u){0u, 0u, 0u, 0u};
#pragma unroll
        for (int dir = 0; dir < 2; ++dir) { RecPre<MIX>& R = Rs[dir];
            if (tid < DK * 8) { const int k = tid >> 3, v8 = tid & 7;
#pragma unroll
                for (int e = 0; e < 4; ++e) { ST[(v8 * 8 + e) * DKP + k] = (bf16)f2bf(R.s0[e]); ST[(v8 * 8 + 4 + e) * DKP + k] = (bf16)f2bf(R.s1[e]); } }
            rec_vt_store(R.vp, VT, tid);
            { const int ri = lane, I = ri >> 4; float kv[CPT], cm[CPT], qv[CPT], e8[CPT];
                rec_front<MIX>(R, lg, dir ? wgB : wgF, dir ? bgB : bgF, l, h, dir, wave, kv, cm);
                { float q8[8]; unpack8(R.qp, q8);
#pragma unroll
                    for (int e = 0; e < CPT; ++e) qv[e] = MIX == 0 ? silu_(q8[e]) * 0.125f : q8[e] * 0.17677669529663687f; }
#pragma unroll
                for (int e = 0; e < CPT; ++e) e8[e] = qv[e] * __expf(cm[e]);
                st_bf16<CPT>(QE + ri * DKP + CPT * wave, e8);
#pragma unroll
                for (int I2 = 0; I2 < 4; ++I2) {
                    float rf[CPT];
#pragma unroll
                    for (int e = 0; e < CPT; ++e) rf[e] = I2 == 0 ? 0.f : lane_read(cm[e], 16 * I2 - 1);
                    if (I2 >= I) {
                        if (I2 == I) {
#pragma unroll
                            for (int e = 0; e < CPT; ++e) e8[e] = qv[e] * __expf(cm[e] - rf[e]);
                            st_bf16<CPT>(QD + ri * DKP + CPT * wave, e8); }
#pragma unroll
                        for (int e = 0; e < CPT; ++e) e8[e] = kv[e] * __expf(fminf(rf[e] - cm[e], 80.f));
                        const int rowbase = I2 == 0 ? 0 : (I2 == 1 ? 16 : (I2 == 2 ? 48 : 96));
                        st_bf16<CPT>(KD + (rowbase + ri) * DKP + CPT * wave, e8); } } }
            if (dir == 0) {
                const int row = (tc < 4 ? b * 256 + tc * 64 : NCTX + b * SEQ + (tc - 4) * 64) + (tid >> 3);
                gatep = *(const GAS v4u*)(P + (size_t)row * PP + (MIX == 0 ? CA_G : CC_G) + h * 64 + (tid & 7) * 8); }
            if (nunit < nR) { const int tc2 = nunit % NCHUNK, bh2 = nunit / NCHUNK; rec_fetch<MIX, true>(R, P, RSb, bh2 >> 2, bh2 & 3, dir, scanc(tc2, dir), tid); }
            BAR_LDS();
            { const int I = wave >> 1, g = lane >> 4, c16 = lane & 15;
                const int rowbase = I == 0 ? 0 : (I == 1 ? 16 : (I == 2 ? 48 : 96));
                bf16x8 Bq[2];
#pragma unroll
                for (int m = 0; m < 2; ++m) {
                    f32x4 t0 = mma16(KD + (rowbase + 2 * m * 16) * DKP, DKP, QD + I * 16 * DKP, DKP, DK, lane);
                    f32x4 t1 = mma16(KD + (rowbase + (2 * m + 1) * 16) * DKP, DKP, QD + I * 16 * DKP, DKP, DK, lane);
#pragma unroll
                    for (int jj = 0; jj < 4; ++jj) { const bool up = 4 * g + jj > c16;
                        t0[jj] = (2 * m > I || (2 * m == I && up)) ? 0.f : t0[jj]; t1[jj] = (2 * m + 1 > I || (2 * m + 1 == I && up)) ? 0.f : t1[jj]; }
                    Bq[m] = pack8(t0[0], t0[1], t0[2], t0[3], t1[0], t1[1], t1[2], t1[3]); }
#pragma unroll
                for (int u = 0; u < 2; ++u) { const int vb = 2 * (wave & 1) + u; f32x4 acc = {0.f, 0.f, 0.f, 0.f};
#pragma unroll
                    for (int m = 0; m < 2; ++m) { const LAS bf16* vr = VT + (vb * 16 + c16) * 72 + 32 * m + 4 * g;
                        const v2u lo = *(const LAS v2u*)vr, hi = *(const LAS v2u*)(vr + 16);
                        acc = __builtin_amdgcn_mfma_f32_16x16x32_bf16(__builtin_bit_cast(bf16x8, (v4u){lo.x, lo.y, hi.x, hi.y}), Bq[m], acc, 0, 0, 0); }
                    const f32x4 acc2 = mma16(ST + vb * 16 * DKP, DKP, QE + I * 16 * DKP, DKP, DK, lane);
#pragma unroll
                    for (int jj = 0; jj < 4; ++jj) { const int i = I * 16 + c16, v = vb * 16 + 4 * g + jj; const float o = acc[jj] + acc2[jj];
                        if (dir == 0) Ob[i * RP + v] = o; else Ob[(63 - i) * RP + v] += o; } } }
            BAR_LDS();
        }
        { const int tl = tid >> 3, jg = tid & 7; float x[8]; float ss = 0.f;
#pragma unroll
            for (int vv = 0; vv < 8; ++vv) { x[vv] = Ob[tl * RP + jg * 8 + vv]; ss += x[vv] * x[vv]; }
            ss += __shfl_xor(ss, 1); ss += __shfl_xor(ss, 2); ss += __shfl_xor(ss, 4);
            const float rstd = rsqrtf(ss * (1.f / 64.f) + EPS);
            const int row = tc < 4 ? b * 256 + tc * 64 + tl : NCTX + b * SEQ + (tc - 4) * 64 + tl;
            const GAS float* ng = ngb + h * 64 + jg * 8;
            float gt[8]; unpack8(gatep, gt);
            float y[8];
#pragma unroll
            for (int vv = 0; vv < 8; ++vv) y[vv] = x[vv] * rstd * ng[vv] * silu_(gt[vv]);
            v4u ow; ow.x = pk2(y[0], y[1]); ow.y = pk2(y[2], y[3]); ow.z = pk2(y[4], y[5]); ow.w = pk2(y[6], y[7]);
            *(GAS v4u*)(CAT + (size_t)row * D + (MIX == 0 ? 0 : 512) + h * 64 + jg * 8) = ow; }
        unit = nunit; aidx += G;
    }
    __syncthreads();
}

typedef float f32x16 __attribute__((ext_vector_type(16)));
DI int swap23(int r) { return (r & 19) | ((r & 4) << 1) | ((r & 8) >> 1); }
struct AttnDesc {
    const GAS bf16* q; int qpitch;
    const GAS bf16* k; int kpitch;
    const GAS bf16* vt;
    GAS bf16* o; int opitch;
    int ntiles; float scale;
    int b, r0, rs0;
    const LAS float* rpb;
};
template <int DQK, bool NA>
DI void attn_mfma_unit(LAS unsigned char* lds, const AttnDesc& A, int tid, int lane, int wave) {
    constexpr int KP = DQK + 8, VP = 72, NS = DQK / 16, KPIECES = 64 * (DQK / 8);
    constexpr int BUF = 64 * KP * 2 + 64 * VP * 2;
    const int q = lane & 31, g = lane >> 5;
    auto tpos = [&](int t) { return NA ? (t < 4 ? 64 * t : 256 + 64 * (A.rs0 + t - 4)) : 64 * t; };
    auto krow = [&](int pos) { return NA ? (pos < 256 ? A.b * 256 + pos : NCTX + A.b * SEQ + (pos - 256)) : pos; };
    const int qi = NA ? (2 * (wave >> 2) + (q >> 4)) * 64 + 16 * (wave & 3) + (q & 15) : wave * 32 + q;
    const int kc0 = NA ? min(max(16 * (wave & 3) - 8, 0), 32) : 0;
    bf16x8 Qf[NS];
    { const GAS bf16* qp = A.q + (size_t)qi * A.qpitch + 8 * g;
#pragma unroll
        for (int s2 = 0; s2 < NS; ++s2) Qf[s2] = *(const GAS bf16x8*)(qp + 16 * s2); }
    f32x16 O[2];
#pragma unroll
    for (int db = 0; db < 2; ++db)
#pragma unroll
        for (int i = 0; i < 16; ++i) O[db][i] = 0.f;
    float mrun = -1e30f, lrun = 0.f;
    const int qr = NA ? A.r0 + (qi >> 6) : 0, qc = NA ? (qi & 63) : 0;
    const int wrs = NA ? min(max(qr - 4, 0), 56) : 0, cs = NA ? min(max(qc - 8, 0), 48) : 0;
    const int qr0 = NA ? A.r0 + 2 * (wave >> 2) : 0, wlo = NA ? min(max(qr0 - 4, 0), 56) : 0, whi = NA ? min(max(qr0 + 1 - 4, 0), 56) + 8 : 0;
    v4u kreg[2], vreg;
    auto gload = [&](int t) { const int pos = tpos(t);
#pragma unroll
        for (int u = 0; u < 2; ++u) { const int p = tid + 512 * u; if (p < KPIECES) { const int key = p / (DQK / 8), d8 = p % (DQK / 8); kreg[u] = *(const GAS v4u*)(A.k + (size_t)krow(pos + key) * A.kpitch + d8 * 8); } }
        vreg = *(const GAS v4u*)(A.vt + (size_t)(tid >> 3) * NKEY + pos + (tid & 7) * 8); };
    auto lstore = [&](int buf) { LAS bf16* Kt = (LAS bf16*)(lds + buf * BUF); LAS bf16* Vt = Kt + 64 * KP;
#pragma unroll
        for (int u = 0; u < 2; ++u) { const int p = tid + 512 * u; if (p < KPIECES) { const int key = p / (DQK / 8), d8 = p % (DQK / 8); *(LAS v4u*)(Kt + key * KP + d8 * 8) = kreg[u]; } }
        *(LAS v4u*)(Vt + (tid >> 3) * VP + (tid & 7) * 8) = vreg; };
    __syncthreads();
    gload(0); lstore(0);
    __syncthreads();
#pragma unroll 1
    for (int t = 0; t < A.ntiles; ++t) {
        const bool more = t + 1 < A.ntiles;
        if (more) gload(t + 1);
        bool active = true, rowok = true; int dr = 0;
        const bool win = NA && t >= 4;
        if (win) { const int wr = A.rs0 + t - 4; active = (wr >= wlo) && (wr < whi); rowok = (wr >= wrs) && (wr < wrs + 8); dr = min(max(wr - qr + 7, 0), 14); }
        if (active) {
            const LAS bf16* Kt = (const LAS bf16*)(lds + (t & 1) * BUF); const LAS bf16* Vt = Kt + 64 * KP;
            f32x16 S[2];
#pragma unroll
            for (int kb = 0; kb < 2; ++kb) {
#pragma unroll
                for (int i = 0; i < 16; ++i) S[kb][i] = 0.f;
                if (win && kb == 1) continue;
                const LAS bf16* kp = Kt + ((win ? kc0 : kb * 32) + swap23(q)) * KP + 8 * g;
#pragma unroll
                for (int s2 = 0; s2 < NS; ++s2) { const bf16x8 a = *(const LAS bf16x8*)(kp + 16 * s2); S[kb] = __builtin_amdgcn_mfma_f32_32x32x16_bf16(a, Qf[s2], S[kb], 0, 0, 0); }
            }
            float mx = -INFINITY;
            if (NA) {
                if (win) {
#pragma unroll
                    for (int i = 0; i < 16; ++i) { const int kc = kc0 + 16 * (i >> 3) + 8 * g + (i & 7); const int dc = min(max(kc - qc, -15), 15) + 15;
                        const float bv = A.rpb[dr * 31 + dc]; const float sv = (rowok && kc >= cs && kc < cs + 16) ? S[0][i] * A.scale + bv : -INFINITY;
                        S[0][i] = sv; mx = fmaxf(mx, sv); }
                } else {
#pragma unroll
                    for (int kb = 0; kb < 2; ++kb)
#pragma unroll
                        for (int i = 0; i < 16; ++i) { const float sv = S[kb][i] * A.scale; S[kb][i] = sv; mx = fmaxf(mx, sv); }
                }
            } else {
#pragma unroll
                for (int kb = 0; kb < 2; ++kb)
#pragma unroll
                    for (int i = 0; i < 16; ++i) mx = fmaxf(mx, S[kb][i]);
            }
            mx = fmaxf(mx, __shfl_xor(mx, 32));
            const float mn = fmaxf(mrun, mx), alpha = __builtin_amdgcn_exp2f(mrun - mn);
            mrun = mn;
            if (__any(alpha != 1.f)) { lrun *= alpha;
#pragma unroll
                for (int db = 0; db < 2; ++db)
#pragma unroll
                    for (int i = 0; i < 16; ++i) O[db][i] *= alpha; }
            bf16x8 Pf[4];
#pragma unroll
            for (int ks = 0; ks < 4; ++ks) { if (win && ks >= 2) continue; const int kb = ks >> 1, o8 = (ks & 1) * 8; float p[8];
#pragma unroll
                for (int j = 0; j < 8; ++j) { p[j] = __builtin_amdgcn_exp2f(S[kb][o8 + j] - mn); lrun += p[j]; }
                Pf[ks] = pack8(p[0], p[1], p[2], p[3], p[4], p[5], p[6], p[7]); }
#pragma unroll
            for (int db = 0; db < 2; ++db) { const LAS bf16* vp = Vt + (db * 32 + q) * VP + (win ? kc0 : 0) + 8 * g;
#pragma unroll
                for (int ks = 0; ks < 4; ++ks) { if (win && ks >= 2) continue; const bf16x8 a = *(const LAS bf16x8*)(vp + 16 * ks); O[db] = __builtin_amdgcn_mfma_f32_32x32x16_bf16(a, Pf[ks], O[db], 0, 0, 0); } }
        }
        if (more) lstore((t + 1) & 1);
        __syncthreads();
    }
    const float ltot = lrun + __shfl_xor(lrun, 32), inv = 1.f / ltot;
    GAS bf16* op = A.o + (size_t)qi * A.opitch + 4 * g;
#pragma unroll
    for (int db = 0; db < 2; ++db)
#pragma unroll
        for (int i4 = 0; i4 < 4; ++i4) { v2u w; w.x = pk2(O[db][4 * i4] * inv, O[db][4 * i4 + 1] * inv); w.y = pk2(O[db][4 * i4 + 2] * inv, O[db][4 * i4 + 3] * inv); *(GAS v2u*)(op + 32 * db + 8 * i4) = w; }
}

constexpr float MLA_TH = 8.f;
constexpr int NA_SLOT = 2 * 64 * 72 * 2, NA_RPB = 4 * NA_SLOT;
DI void na_unit(LAS unsigned char* lds, const AttnDesc& A, const GAS float* rp, int tid, int lane, int wave) {
    constexpr int KP = 72, VP = 72, NS = 4, KBUF = 64 * KP * 2;
    const int q = lane & 31, g = lane >> 5, NT = A.ntiles;
    auto tpos = [&](int t) { return t < 4 ? 64 * t : 256 + 64 * (A.rs0 + t - 4); };
    auto krow = [&](int pos) { return pos < 256 ? A.b * 256 + pos : NCTX + A.b * SEQ + (pos - 256); };
    const int qi = (2 * (wave >> 2) + (q >> 4)) * 64 + 16 * (wave & 3) + (q & 15);
    const int kc0 = min(max(16 * (wave & 3) - 8, 0), 32);
    bf16x8 Qf[NS];
    { const GAS bf16* qp = A.q + (size_t)qi * A.qpitch + 8 * g;
#pragma unroll
        for (int s2 = 0; s2 < NS; ++s2) Qf[s2] = *(const GAS bf16x8*)(qp + 16 * s2); }
    f32x16 O[2];
#pragma unroll
    for (int db = 0; db < 2; ++db)
#pragma unroll
        for (int i = 0; i < 16; ++i) O[db][i] = 0.f;
    float mrun = -1e30f, lrun = 0.f;
    const int qr = A.r0 + (qi >> 6), qc = qi & 63;
    const int wrs = min(max(qr - 4, 0), 56), cs = min(max(qc - 8, 0), 48);
    const int qr0 = A.r0 + 2 * (wave >> 2), wlo = min(max(qr0 - 4, 0), 56), whi = min(max(qr0 + 1 - 4, 0), 56) + 8;
    auto koffs = [&](int i) { const int j = i * 64 + lane, row = j / 9, pc = min(j % 9, 7); return (unsigned)(row * (PP * 2) + pc * 16); };
    auto voffs = [&](int i) { const int j = i * 64 + lane, row = j / 9, pc = min(j % 9, 7); return (unsigned)(row * (NKEY * 2) + pc * 16); };
    const int iv1 = wave == 0 ? 0 : wave - 1, iv2 = wave < 2 ? 7 + wave : iv1;
    const unsigned goff0 = koffs(wave), goff1 = wave == 0 ? koffs(8) : voffs(iv1), goff2 = voffs(iv2);
    auto dma = [&](int t, int slot) __attribute__((always_inline)) { const int pos = tpos(t);
        const GAS unsigned char* kb = (const GAS unsigned char*)(A.k + (size_t)krow(pos) * A.kpitch); const GAS unsigned char* vb = (const GAS unsigned char*)(A.vt + pos);
        LAS unsigned char* kl = lds + slot * NA_SLOT; LAS unsigned char* vl = kl + KBUF;
        __builtin_amdgcn_global_load_lds((const GAS unsigned*)(kb + goff0), (LAS unsigned*)(kl + wave * 1024), 16, 0, 0);
        __builtin_amdgcn_global_load_lds((const GAS unsigned*)((wave == 0 ? kb : vb) + goff1), (LAS unsigned*)(wave == 0 ? kl + 8 * 1024 : vl + iv1 * 1024), 16, 0, 0);
        __builtin_amdgcn_global_load_lds((const GAS unsigned*)(vb + goff2), (LAS unsigned*)(vl + iv2 * 1024), 16, 0, 0);
    };
    LAS float* T = (LAS float*)(lds + NA_RPB);
    float tv[4];
#pragma unroll
    for (int u = 0; u < 4; ++u) { const int e = tid + 512 * u, r = e >> 7, dcr = (e & 127) - 64; const bool in = r < 15 && dcr >= -15 && dcr <= 15;
        tv[u] = in ? rp[r * 31 + dcr + 15] * LOG2E : (r == 15 ? -INFINITY : 0.f); }
    float mcol[16];
#pragma unroll
    for (int i = 0; i < 16; ++i) { const int kc = kc0 + 16 * (i >> 3) + 8 * g + (i & 7); mcol[i] = (kc >= cs && kc < cs + 16) ? 0.f : -INFINITY; }
    __syncthreads();
    dma(0, 0); dma(min(1, NT - 1), 1); dma(min(2, NT - 1), 2);
#pragma unroll
    for (int u = 0; u < 4; ++u) T[tid + 512 * u] = tv[u];
    asm volatile("s_waitcnt vmcnt(6)\n\ts_waitcnt lgkmcnt(0)\n\ts_barrier" ::: "memory");
#pragma unroll 1
    for (int t = 0; t < NT; ++t) {
        dma(min(t + 3, NT - 1), (t + 3) & 3);
        bool active = true, rowok = true; int dr = 0;
        const bool win = t >= 4;
        if (win) { const int wr = A.rs0 + t - 4; active = (wr >= wlo) && (wr < whi); rowok = (wr >= wrs) && (wr < wrs + 8); dr = min(max(wr - qr + 7, 0), 14); }
        if (active) {
            const LAS bf16* Kt = (const LAS bf16*)(lds + (t & 3) * NA_SLOT); const LAS bf16* Vt = Kt + 64 * KP;
            f32x16 S[2];
#pragma unroll
            for (int kb = 0; kb < 2; ++kb) {
#pragma unroll
                for (int i = 0; i < 16; ++i) S[kb][i] = 0.f;
                if (win && kb == 1) continue;
                const LAS bf16* kp = Kt + ((win ? kc0 : kb * 32) + swap23(q)) * KP + 8 * g;
#pragma unroll
                for (int s2 = 0; s2 < NS; ++s2) { const bf16x8 a = *(const LAS bf16x8*)(kp + 16 * s2); S[kb] = __builtin_amdgcn_mfma_f32_32x32x16_bf16(a, Qf[s2], S[kb], 0, 0, 0); }
            }
            float mx = -INFINITY;
            if (win) { const LAS float* tb = T + (rowok ? dr : 15) * 128 + (kc0 + 8 * g - qc + 64);
#pragma unroll
                for (int i = 0; i < 16; ++i) { const float sv = (S[0][i] * A.scale + tb[16 * (i >> 3) + (i & 7)]) + mcol[i]; S[0][i] = sv; mx = fmaxf(mx, sv); }
            } else {
#pragma unroll
                for (int kb = 0; kb < 2; ++kb)
#pragma unroll
                    for (int i = 0; i < 16; ++i) { const float sv = S[kb][i] * A.scale; S[kb][i] = sv; mx = fmaxf(mx, sv); }
            }
            if (__any(mx > mrun + MLA_TH)) { const float mf = fmaxf(mx, __shfl_xor(mx, 32)), mn = fmaxf(mrun, mf), alpha = __builtin_amdgcn_exp2f(mrun - mn);
                mrun = mn; lrun *= alpha;
#pragma unroll
                for (int db = 0; db < 2; ++db)
#pragma unroll
                    for (int i = 0; i < 16; ++i) O[db][i] *= alpha; }
            bf16x8 Pf[4];
#pragma unroll
            for (int ks = 0; ks < 4; ++ks) { if (win && ks >= 2) continue; const int kb = ks >> 1, o8 = (ks & 1) * 8; float p[8];
#pragma unroll
                for (int j = 0; j < 8; ++j) { p[j] = __builtin_amdgcn_exp2f(S[kb][o8 + j] - mrun); lrun += p[j]; }
                Pf[ks] = pack8(p[0], p[1], p[2], p[3], p[4], p[5], p[6], p[7]); }
#pragma unroll
            for (int db = 0; db < 2; ++db) { const LAS bf16* vp = Vt + (db * 32 + q) * VP + (win ? kc0 : 0) + 8 * g;
#pragma unroll
                for (int ks = 0; ks < 4; ++ks) { if (win && ks >= 2) continue; const bf16x8 a = *(const LAS bf16x8*)(vp + 16 * ks); O[db] = __builtin_amdgcn_mfma_f32_32x32x16_bf16(a, Pf[ks], O[db], 0, 0, 0); } }
        }
        asm volatile("s_waitcnt vmcnt(6)\n\ts_waitcnt lgkmcnt(0)\n\ts_barrier" ::: "memory");
    }
    asm volatile("s_waitcnt vmcnt(0)" ::: "memory");
    const float ltot = lrun + __shfl_xor(lrun, 32), inv = 1.f / ltot;
    GAS bf16* op = A.o + (size_t)qi * A.opitch + 4 * g;
#pragma unroll
    for (int db = 0; db < 2; ++db)
#pragma unroll
        for (int i4 = 0; i4 < 4; ++i4) { v2u w; w.x = pk2(O[db][4 * i4] * inv, O[db][4 * i4 + 1] * inv); w.y = pk2(O[db][4 * i4 + 2] * inv, O[db][4 * i4 + 3] * inv); *(GAS v2u*)(op + 32 * db + 8 * i4) = w; }
}

struct TagF { static constexpr bool value = false; }; struct TagT { static constexpr bool value = true; };
#define SGB(mask, n) __builtin_amdgcn_sched_group_barrier(mask, n, 0)
DI void mla_unit(LAS unsigned char* lds, const AttnDesc& A, int tid, int lane, int wave) {
    constexpr int KP = 104, VP = 72, NS = 6, KBUF = 64 * KP * 2, VBUF = 64 * VP * 2;
    const int q = lane & 31, g = lane >> 5, NT = A.ntiles;
    bf16x8 Qf[NS];
    { const GAS bf16* qp = A.q + (size_t)(wave * 32 + q) * A.qpitch + 8 * g;
#pragma unroll
        for (int s2 = 0; s2 < NS; ++s2) Qf[s2] = *(const GAS bf16x8*)(qp + 16 * s2); }
    f32x16 O[2], Cm;
#pragma unroll
    for (int i = 0; i < 16; ++i) { O[0][i] = 0.f; O[1][i] = 0.f; Cm[i] = 0.f; }
    float lrun = 0.f;
    auto koffs = [&](int i) { const int j = i * 64 + lane, row = j / 13, pc = min(j % 13, 11); return (unsigned)(row * 192 + pc * 16); };
    auto voffs = [&](int i) { const int j = i * 64 + lane, row = j / 9, pc = min(j % 9, 7); return (unsigned)(row * (NKEY * 2) + pc * 16); };
    const int i2 = min(wave + 3, 8);
    const unsigned goff0 = koffs(wave), goff1 = wave < 5 ? koffs(wave + 8) : voffs(wave - 5), goff2 = voffs(i2);
    auto dma = [&](int tk, int ks, int tv, int vs) __attribute__((always_inline)) {
        const GAS unsigned char* kb = (const GAS unsigned char*)A.k + (size_t)tk * (64 * 96 * 2); const GAS unsigned char* vb = (const GAS unsigned char*)A.vt + (size_t)tv * 128;
        LAS unsigned char* kl = lds + ks * KBUF; LAS unsigned char* vl = lds + 2 * KBUF + vs * VBUF;
        __builtin_amdgcn_global_load_lds((const GAS unsigned*)(kb + goff0), (LAS unsigned*)(kl + wave * 1024), 16, 0, 0);
        __builtin_amdgcn_global_load_lds((const GAS unsigned*)((wave < 5 ? kb : vb) + goff1), (LAS unsigned*)(wave < 5 ? kl + (wave + 8) * 1024 : vl + (wave - 5) * 1024), 16, 0, 0);
        __builtin_amdgcn_global_load_lds((const GAS unsigned*)(vb + goff2), (LAS unsigned*)(vl + i2 * 1024), 16, 0, 0);
    };
    auto qk = [&](f32x16& S0, f32x16& S1, int buf) __attribute__((always_inline)) {
        const LAS bf16* kp = (const LAS bf16*)(lds + buf * KBUF) + swap23(q) * KP + 8 * g;
        S0 = __builtin_amdgcn_mfma_f32_32x32x16_bf16(*(const LAS bf16x8*)kp, Qf[0], Cm, 0, 0, 0);
#pragma unroll
        for (int s2 = 1; s2 < NS; ++s2) S0 = __builtin_amdgcn_mfma_f32_32x32x16_bf16(*(const LAS bf16x8*)(kp + 16 * s2), Qf[s2], S0, 0, 0, 0);
        S1 = __builtin_amdgcn_mfma_f32_32x32x16_bf16(*(const LAS bf16x8*)(kp + 32 * KP), Qf[0], Cm, 0, 0, 0);
#pragma unroll
        for (int s2 = 1; s2 < NS; ++s2) S1 = __builtin_amdgcn_mfma_f32_32x32x16_bf16(*(const LAS bf16x8*)(kp + 32 * KP + 16 * s2), Qf[s2], S1, 0, 0, 0);
    };
    auto smax = [&](const f32x16& S0, const f32x16& S1) __attribute__((always_inline)) { float mx = fmaxf(S0[0], S0[1]);
#pragma unroll
        for (int i = 2; i < 16; ++i) mx = fmaxf(mx, S0[i]);
#pragma unroll
        for (int i = 0; i < 16; ++i) mx = fmaxf(mx, S1[i]);
        return mx; };
    auto rebase = [&](f32x16& S0, f32x16& S1, float mx) __attribute__((always_inline)) {
        const float mf = fmaxf(mx, __shfl_xor(mx, 32)), d = fmaxf(mf, 0.f), alpha = __builtin_amdgcn_exp2f(-d);
        lrun *= alpha;
#pragma unroll
        for (int i = 0; i < 16; ++i) { O[0][i] *= alpha; O[1][i] *= alpha; S0[i] -= d; S1[i] -= d; Cm[i] -= d; }
        asm volatile("" : "+v"(Cm));
    };
    auto softmax_p = [&](const f32x16& S0, const f32x16& S1, bf16x8 (&Pf)[4]) __attribute__((always_inline)) {
#pragma unroll
        for (int ks = 0; ks < 4; ++ks) { const int o8 = (ks & 1) * 8; float p[8];
#pragma unroll
            for (int j = 0; j < 8; ++j) { p[j] = __builtin_amdgcn_exp2f(ks < 2 ? S0[o8 + j] : S1[o8 + j]); lrun += p[j]; }
            Pf[ks] = pack8(p[0], p[1], p[2], p[3], p[4], p[5], p[6], p[7]); }
    };
    auto pv = [&](const bf16x8 (&Pf)[4], int buf) __attribute__((always_inline)) {
        const LAS bf16* vp = (const LAS bf16*)(lds + 2 * KBUF + buf * VBUF) + q * VP + 8 * g;
#pragma unroll
        for (int ks = 0; ks < 4; ++ks)
#pragma unroll
            for (int db = 0; db < 2; ++db) O[db] = __builtin_amdgcn_mfma_f32_32x32x16_bf16(*(const LAS bf16x8*)(vp + db * 32 * VP + 16 * ks), Pf[ks], O[db], 0, 0, 0);
    };
    f32x16 Sa[2], Sb[2];
    __syncthreads();
    dma(0, 0, 0, 0); dma(1, 1, 0, 0);
    asm volatile("s_waitcnt vmcnt(0)" ::: "memory");
    __syncthreads();
    qk(Sa[0], Sa[1], 0);
    { const float mx = smax(Sa[0], Sa[1]); const float mf = fmaxf(mx, __shfl_xor(mx, 32));
#pragma unroll
        for (int i = 0; i < 16; ++i) { Sa[0][i] -= mf; Sa[1][i] -= mf; Cm[i] = -mf; }
        asm volatile("" : "+v"(Cm)); }
    __syncthreads();
    auto step = [&](f32x16 (&Sc)[2], f32x16 (&Sn)[2], const int t, auto par) __attribute__((always_inline)) {
        constexpr int PAR = decltype(par)::value ? 1 : 0;
        dma(min(t + 2, NT - 1), PAR, min(t + 1, NT - 1), PAR ^ 1);
        __builtin_amdgcn_sched_barrier(0);
        bf16x8 Pf[4];
        qk(Sn[0], Sn[1], PAR ^ 1);
        softmax_p(Sc[0], Sc[1], Pf);
        pv(Pf, PAR);
        const float mx = smax(Sn[0], Sn[1]);
        SGB(0x100, 3);
#pragma unroll
        for (int m = 0; m < 16; ++m) { SGB(0x008, 1); SGB(0x100, 1); SGB(0x400, 2); SGB(0x002, 3); }
#pragma unroll
        for (int m = 0; m < 4; ++m) { SGB(0x008, 1); SGB(0x100, 1); SGB(0x002, 5); }
        if (__any(mx > MLA_TH)) rebase(Sn[0], Sn[1], mx);
        asm volatile("s_waitcnt vmcnt(0)" ::: "memory");
        __syncthreads();
    };
#pragma unroll 1
    for (int t = 0; t < NT - 2; t += 2) { step(Sa, Sb, t, TagF{}); step(Sb, Sa, t + 1, TagT{}); }
    step(Sa, Sb, NT - 2, TagF{});
    { bf16x8 Pf[4]; softmax_p(Sb[0], Sb[1], Pf); pv(Pf, (NT - 1) & 1); }
    const float ltot = lrun + __shfl_xor(lrun, 32), inv = 1.f / ltot;
    GAS bf16* op = A.o + (size_t)(wave * 32 + q) * A.opitch + 4 * g;
#pragma unroll
    for (int db = 0; db < 2; ++db)
#pragma unroll
        for (int i4 = 0; i4 < 4; ++i4) { v2u w; w.x = pk2(O[db][4 * i4] * inv, O[db][4 * i4 + 1] * inv); w.y = pk2(O[db][4 * i4 + 2] * inv, O[db][4 * i4 + 3] * inv); *(GAS v2u*)(op + 32 * db + 8 * i4) = w; }
}

DI int moe_tables(const GAS unsigned* cnt  , LAS int* off, LAS int* tile_e, int tid) {
    if (tid == 0) { int o = 0; for (int e = 0; e < 32; ++e) { off[e] = o; o += ((int)cnt[e * 64] + 255) & ~255; } off[32] = o; }
    __syncthreads();
    if (tid < MOE_MAXT) { const int r = tid * 256; int ex = 0; for (int e = 0; e < 32; ++e) if (r >= off[e + 1]) ex = e + 1; tile_e[tid] = ex < 32 ? ex : 31; }
    __syncthreads();
    return off[32] >> 8;
}

#define TIDS const int tid = threadIdx.x, lane = tid & 63, wave = __builtin_amdgcn_readfirstlane(tid >> 6), bid = blockIdx.x, G = gridDim.x, gw = bid * 8 + wave, NGW = G * 8; (void)lane; (void)gw; (void)NGW
DI void ph_gemm_in(const Ctx& cx, int l) {
    TIDS; GAS unsigned char* ws = cx.ws(); LAS unsigned char* lds = (LAS unsigned char*)lds_raw;
    pg8::Gemm g{(const GAS bf16*)(ws + WS_H), (const GAS bf16*)(ws + WS_WTIN + (size_t)l * WTIN_L), MTOK, PP, D}; pg8::StaticOrder S; S.init(MTOK, PP, G, bid);
    pg8::EpiStoreBf16 E{(GAS bf16*)(ws + WS_P), PP};
    pg8::gemm_phase(lds, g, S, E);
}
DI void ph_prep_r1(const Ctx& cx, int l) {
    TIDS; LAS unsigned char* lds = (LAS unsigned char*)lds_raw;
#pragma unroll 1
    for (int u = bid; u < MTOK / PR; u += G) prep_unit(cx, l, u, lds, tid, lane, wave);
    __syncthreads();
    rec_r1_run<0>(cx, l, lds, tid, bid, G); rec_r1_run<1>(cx, l, lds, tid, bid, G);
    __syncthreads();
}
DI void ph_mixers(const Ctx& cx, int l) {
    TIDS; GAS unsigned char* ws = cx.ws(); LAS unsigned char* lds = (LAS unsigned char*)lds_raw;
    const bool keep_ctx = (l == 0);
    GAS bf16* CAT = (GAS bf16*)(ws + WS_CAT); const GAS bf16* P = (const GAS bf16*)(ws + WS_P);
    const int nATT = 256 + (keep_ctx ? 16 : 0), nR = 16 * NCHUNK;
    const int vc = (G % 8 == 0) ? (bid % 8) * (G / 8) + bid / 8 : bid;
    const bool r3first = ((bid >> 3) & 1) != 0;
    if (r3first) { rec_r3_run<0>(cx, l, lds, tid, bid, G, keep_ctx); rec_r3_run<1>(cx, l, lds, tid, bid, G, keep_ctx); __syncthreads(); }
#pragma unroll 1
    for (int it = 0; it < 2; ++it) { const int u = it == 0 ? vc : (G == 256 && bid >= 128 && bid < 144 ? 256 + bid - 128 : (G == 256 ? nATT : bid + G)); if (u >= nATT) continue;
        const GAS bf16* QM = (const GAS bf16*)(ws + WS_QM); const GAS bf16* KM = (const GAS bf16*)(ws + WS_KM); const GAS bf16* VM = (const GAS bf16*)(ws + WS_VM);
        AttnDesc A{}; int bh, b, h;
        if (u < 256) { bh = u >> 4; b = bh >> 2; h = bh & 3; const int qb = u & 15; A.q = QM + ((size_t)bh * NKEY + 256 + qb * 256) * 96; A.ntiles = NKEY / 64; A.o = CAT + (size_t)(NCTX + b * SEQ + qb * 256) * D + 768 + h * 64; }
        else { bh = u - 256; b = bh >> 2; h = bh & 3; A.q = QM + (size_t)bh * NKEY * 96; A.ntiles = 4; A.o = CAT + (size_t)(b * 256) * D + 768 + h * 64; }
        A.qpitch = 96; A.k = KM + (size_t)bh * NKEY * 96; A.kpitch = 96; A.vt = VM + (size_t)bh * 64 * NKEY; A.opitch = D; A.scale = 1.f;
        mla_unit(lds, A, tid, lane, wave);
    }
#pragma unroll 1
    for (int it = 0; it < 2; ++it) { const int u = it == 0 ? vc : (G == 256 && bid >= 160 && bid < 176 ? 256 + bid - 160 : (G == 256 ? nATT : bid + G)); if (u >= nATT) continue;
        LAS float* rpb = (LAS float*)(lds + NA_RPB);
        AttnDesc A{}; int bh, b, h; size_t qrow;
        if (u < 256) { bh = u >> 4; b = bh >> 2; h = bh & 3; const int rq = u & 15; A.r0 = rq * 4; A.rs0 = min(max(A.r0 - 4, 0), 56); const int rsl = min(max(A.r0 + 3 - 4, 0), 56);
            A.ntiles = 4 + (rsl + 8 - A.rs0); qrow = (size_t)NCTX + b * SEQ + A.r0 * 64; }
        else { bh = u - 256; b = bh >> 2; h = bh & 3; A.ntiles = 4; qrow = (size_t)b * 256; }
        const GAS float* rp = cx.in(I_RPB) + (size_t)(l * 4 + h) * 465;
        A.q = P + qrow * PP + CB_Q + h * 64; A.qpitch = PP; A.k = P + CB_K + h * 64; A.kpitch = PP; A.vt = (const GAS bf16*)(ws + WS_VNT) + (size_t)bh * 64 * NKEY;
        A.o = CAT + qrow * D + 256 + h * 64; A.opitch = D; A.scale = 0.125f * LOG2E; A.b = b; A.rpb = rpb;
        na_unit(lds, A, rp, tid, lane, wave);
    }
    __syncthreads();
    if (!r3first) { rec_r3_run<0>(cx, l, lds, tid, bid, G, keep_ctx); rec_r3_run<1>(cx, l, lds, tid, bid, G, keep_ctx); }
}
DI void ph_gemm_out(const Ctx& cx, int l) {
    TIDS; GAS unsigned char* ws = cx.ws(); LAS unsigned char* lds = (LAS unsigned char*)lds_raw;
    const int roff = (l == 0) ? 0 : NCTX, Mg = MTOK - roff;
    pg8::Gemm g{(const GAS bf16*)(ws + WS_CAT) + (size_t)roff * D, (const GAS bf16*)(ws + WS_WTOUT + (size_t)l * D * D * 2), Mg, D, D}; pg8::StaticOrder S; S.init(Mg, D, G, bid);
    pg8::EpiResid E{(GAS pg8::bf16_t*)(ws + WS_X), roff, (const GAS float*)(ws + WS_MOD) + (size_t)l * 5 * 6144 + 2 * 1024, l == 0 ? cx.in(I_CTX) : (const GAS float*)nullptr, l == 0 ? cx.in(I_X) : (const GAS float*)nullptr};
    pg8::gemm_phase(lds, g, S, E);
    if (l == 0) { const int nbusy = (Mg / 256) * (D / 256) - G;
        if (nbusy >= 0 && nbusy < G && bid >= nbusy) { __syncthreads(); weight_copies(cx, 1, lds, tid, lane, wave, (bid - nbusy) * 8 + wave, (G - nbusy) * 8, (bid - nbusy) * 512 + tid, (G - nbusy) * 512); } }
}
DI void ph_router(const Ctx& cx, int l) {
    TIDS; GAS unsigned char* ws = cx.ws(); LAS unsigned char* lds = (LAS unsigned char*)lds_raw;
    const int m_lo = (l == 0) ? 0 : NCTX;
    const GAS bf16* X = (const GAS bf16*)(ws + WS_X); GAS bf16* H = (GAS bf16*)(ws + WS_H); const GAS float* MOD = (const GAS float*)(ws + WS_MOD) + (size_t)l * 5 * 6144;
    GAS int* EID = (GAS int*)(ws + WS_MOE); GAS float* GATE = (GAS float*)(ws + WS_MOE) + MTOK * 2; GAS int* POS = (GAS int*)(ws + WS_MOE) + MTOK * 4;
    GAS unsigned* cnt = (GAS unsigned*)(ws + WS_CTL) + CW_CNT + l * 32 * 64; GAS int* RIDX = (GAS int*)(ws + WS_RIDX);
    const GAS bf16* WRh = (const GAS bf16*)(ws + WS_WR) + (size_t)l * 2 * 48 * 1024; const GAS bf16* WRl = WRh + 48 * 1024;
    const GAS float* n2g = cx.in(I_N2G) + l * D; const GAS float* brg = cx.in(I_BRG) + l * 4; const GAS float* bre = cx.in(I_BRE) + l * 32;
    constexpr int AP = 136;
    LAS bf16* Ah = (LAS bf16*)(lds + wave * 12288); LAS bf16* Al = Ah + 16 * AP; LAS float* LG = (LAS float*)(lds + wave * 12288 + 2 * 16 * AP * 2); LAS float* RSD = LG + 16 * 48;
    const int nunits = (MTOK - m_lo) / 16;
#pragma unroll 1
    for (int unit = wave * G + bid; unit < nunits; unit += NGW) {
        const int m0 = m_lo + unit * 16; const GAS float* mb = MOD + (size_t)bidx_of_row(m0) * 6144;
        const int p16 = lane & 15, rg = lane >> 4;
        float rsr[4];
        { float ss[4] = {0.f, 0.f, 0.f, 0.f};
#pragma unroll 2
            for (int kc = 0; kc < 8; ++kc) { v4u xp[4];
#pragma unroll
                for (int i = 0; i < 4; ++i) xp[i] = *(const GAS v4u*)(X + (size_t)(m0 + 4 * rg + i) * D + kc * 128 + 8 * p16);
#pragma unroll
                for (int i = 0; i < 4; ++i) { float x[8]; unpack8(xp[i], x);
#pragma unroll
                    for (int e = 0; e < 8; ++e) ss[i] += x[e] * x[e]; } }
#pragma unroll
            for (int i = 0; i < 4; ++i) { float t = ss[i]; t += __shfl_xor(t, 1); t += __shfl_xor(t, 2); t += __shfl_xor(t, 4); t += __shfl_xor(t, 8); rsr[i] = rsqrtf(t * (1.f / D) + EPS); } }
        f32x4 acc[3];
#pragma unroll
        for (int ct = 0; ct < 3; ++ct) acc[ct] = (f32x4){0.f, 0.f, 0.f, 0.f};
#pragma unroll 1
        for (int kc = 0; kc < 8; ++kc) { const int c = kc * 128 + 8 * p16;
            const int fr = lane & 15, fq = lane >> 4;
            bf16x8 bh[4][3], bl[4][3];
#pragma unroll
            for (int ks = 0; ks < 4; ++ks)
#pragma unroll
                for (int ct = 0; ct < 3; ++ct) { const size_t bo = (size_t)(ct * 16 + fr) * 1024 + kc * 128 + ks * 32 + fq * 8; bh[ks][ct] = *(const GAS bf16x8*)(WRh + bo); bl[ks][ct] = *(const GAS bf16x8*)(WRl + bo); }
            v4u xp[4];
#pragma unroll
            for (int i = 0; i < 4; ++i) xp[i] = *(const GAS v4u*)(X + (size_t)(m0 + 4 * rg + i) * D + c);
            float gg[8], sh[8], sc[8];
            { const f32x4 a0 = *(const GAS f32x4*)(n2g + c), a1 = *(const GAS f32x4*)(n2g + c + 4), b0 = *(const GAS f32x4*)(mb + 3 * 1024 + c), b1 = *(const GAS f32x4*)(mb + 3 * 1024 + c + 4),
                  c0 = *(const GAS f32x4*)(mb + 4 * 1024 + c), c1 = *(const GAS f32x4*)(mb + 4 * 1024 + c + 4);
                gg[0] = a0.x; gg[1] = a0.y; gg[2] = a0.z; gg[3] = a0.w; gg[4] = a1.x; gg[5] = a1.y; gg[6] = a1.z; gg[7] = a1.w;
                sh[0] = b0.x; sh[1] = b0.y; sh[2] = b0.z; sh[3] = b0.w; sh[4] = b1.x; sh[5] = b1.y; sh[6] = b1.z; sh[7] = b1.w;
                sc[0] = c0.x; sc[1] = c0.y; sc[2] = c0.z; sc[3] = c0.w; sc[4] = c1.x; sc[5] = c1.y; sc[6] = c1.z; sc[7] = c1.w; }
            LDS_WAIT();
#pragma unroll
            for (int i = 0; i < 4; ++i) { const int r = 4 * rg + i; float x[8], y[8]; unpack8(xp[i], x);
#pragma unroll
                for (int e = 0; e < 8; ++e) y[e] = x[e] * rsr[i] * gg[e] * (1.f + sc[e]) + sh[e];
                const v4u hi = (v4u){pk2(y[0], y[1]), pk2(y[2], y[3]), pk2(y[4], y[5]), pk2(y[6], y[7])};
                float hf[8]; unpack8(hi, hf);
                const v4u lo = (v4u){pk2(y[0] - hf[0], y[1] - hf[1]), pk2(y[2] - hf[2], y[3] - hf[3]), pk2(y[4] - hf[4], y[5] - hf[5]), pk2(y[6] - hf[6], y[7] - hf[7])};
                *(GAS v4u*)(H + (size_t)(m0 + r) * D + c) = hi;
                *(LAS v4u*)(Ah + r * AP + 8 * p16) = hi; *(LAS v4u*)(Al + r * AP + 8 * p16) = lo; }
            LDS_WAIT();
            asm volatile("s_waitcnt vmcnt(0)" : "+v"(bh[0][0]), "+v"(bh[0][1]), "+v"(bh[0][2]), "+v"(bl[0][0]), "+v"(bl[0][1]), "+v"(bl[0][2]), "+v"(bh[1][0]), "+v"(bh[1][1]), "+v"(bh[1][2]), "+v"(bl[1][0]), "+v"(bl[1][1]), "+v"(bl[1][2]),
                         "+v"(bh[2][0]), "+v"(bh[2][1]), "+v"(bh[2][2]), "+v"(bl[2][0]), "+v"(bl[2][1]), "+v"(bl[2][2]), "+v"(bh[3][0]), "+v"(bh[3][1]), "+v"(bh[3][2]), "+v"(bl[3][0]), "+v"(bl[3][1]), "+v"(bl[3][2]) :: "memory");
#pragma unroll
            for (int ks = 0; ks < 4; ++ks) { const bf16x8 ah = *(const LAS bf16x8*)(Ah + fr * AP + ks * 32 + fq * 8), al = *(const LAS bf16x8*)(Al + fr * AP + ks * 32 + fq * 8);
#pragma unroll
                for (int ct = 0; ct < 3; ++ct) {
                    acc[ct] = __builtin_amdgcn_mfma_f32_16x16x32_bf16(ah, bh[ks][ct], acc[ct], 0, 0, 0);
                    acc[ct] = __builtin_amdgcn_mfma_f32_16x16x32_bf16(ah, bl[ks][ct], acc[ct], 0, 0, 0);
                    acc[ct] = __builtin_amdgcn_mfma_f32_16x16x32_bf16(al, bh[ks][ct], acc[ct], 0, 0, 0); } }
        }
#pragma unroll
        for (int ct = 0; ct < 3; ++ct)
#pragma unroll
            for (int j = 0; j < 4; ++j) LG[(4 * (lane >> 4) + j) * 48 + ct * 16 + (lane & 15)] = acc[ct][j];
        LDS_WAIT(); asm volatile("" ::: "memory");
        if (lane < 16) { const LAS float* lg = LG + lane * 48; const int m = m0 + lane;
            float gl[4]; int gsel = 0;
#pragma unroll
            for (int i = 0; i < 4; ++i) gl[i] = lg[i] + brg[i];
            float gmax = gl[0];
#pragma unroll
            for (int i = 1; i < 4; ++i) if (gl[i] > gmax) { gmax = gl[i]; gsel = i; }
            float den = 0.f;
#pragma unroll
            for (int i = 0; i < 4; ++i) den += __expf(gl[i] - gmax);
            const float pg = 1.f / den;
            float e1 = -INFINITY, e2 = -INFINITY; int i1 = 0, i2 = 0;
#pragma unroll 1
            for (int i = 0; i < 8; ++i) { const float ev = lg[4 + gsel * 8 + i] + bre[gsel * 8 + i];
                if (ev > e1) { e2 = e1; i2 = i1; e1 = ev; i1 = i; } else if (ev > e2) { e2 = ev; i2 = i; } }
            const float x2 = __expf(e2 - e1), w1 = pg / (1.f + x2), w2 = pg * x2 / (1.f + x2);
            const int ex1 = gsel * 8 + i1, ex2 = gsel * 8 + i2;
            const int p1 = (int)__hip_atomic_fetch_add(cnt + ex1 * 64, 1u, __ATOMIC_RELAXED, __HIP_MEMORY_SCOPE_AGENT), p2 = (int)__hip_atomic_fetch_add(cnt + ex2 * 64, 1u, __ATOMIC_RELAXED, __HIP_MEMORY_SCOPE_AGENT);
            EID[m * 2] = ex1; EID[m * 2 + 1] = ex2; GATE[m * 2] = w1; GATE[m * 2 + 1] = w2; POS[m * 2] = p1; POS[m * 2 + 1] = p2;
            RIDX[(size_t)ex1 * MOE_CAP + p1] = m; RIDX[(size_t)ex2 * MOE_CAP + p2] = m; }
        LDS_WAIT(); asm volatile("" ::: "memory");
    }
}
DI void ph_gemm_gu(const Ctx& cx, int l) {
    TIDS; GAS unsigned char* ws = cx.ws(); LAS unsigned char* lds = (LAS unsigned char*)lds_raw;
    LAS int* moe_off = (LAS int*)(lds + MISC_OFF + 64 * 4); LAS int* moe_te = (LAS int*)(lds + MISC_OFF + 128 * 4);
    const int nT = moe_tables((const GAS unsigned*)(ws + WS_CTL) + CW_CNT + l * 32 * 64, moe_off, moe_te, tid);
    pg8::Gemm g{(const GAS bf16*)(ws + WS_H), (const GAS bf16*)(ws + WS_WTGU + (size_t)l * 32 * 512 * D * 2), nT * 256, 512, D};
    const int vc = (G % 8 == 0) ? (bid % 8) * (G / 8) + bid / 8 : bid;
    pg8::GroupedPublish S{{nT, 2, G, vc, moe_te, (size_t)512 * D * 2}, (GAS unsigned*)(ws + WS_CTL) + CW_GUC + l * MOE_MAXT * 64};
    pg8::EpiGateUp E{(GAS bf16*)(ws + WS_ACT), (unsigned)(MOE_MAXT * 256 * 256 * 2)};
    LAS int* ridx_l = (LAS int*)(lds + MISC_OFF + 4096);
    { const GAS unsigned* cntp = (const GAS unsigned*)(ws + WS_CTL) + CW_CNT + l * 32 * 64; const GAS int* RIDX = (const GAS int*)(ws + WS_RIDX);
        const int vcl = (G % 8 == 0) ? (bid % 8) * (G / 8) + bid / 8 : bid; const int i = tid >> 8, r = tid & 255, L = vcl + i * G;
        if (L < nT * 2) { const int pm = L >> 1, e = moe_te[pm], slot = pm * 256 - moe_off[e] + r; ridx_l[i * 256 + r] = slot < (int)cntp[e * 64] ? RIDX[(size_t)e * MOE_CAP + slot] : 0; }
        __syncthreads(); }
    pg8::MoeRows RM{ridx_l, vc >> 1};
    pg8::gemm_phase(lds, g, S, E, RM);
}
DI void ph_gemm_dn(const Ctx& cx, int l) {
    TIDS; GAS unsigned char* ws = cx.ws(); LAS unsigned char* lds = (LAS unsigned char*)lds_raw;
    LAS int* moe_off = (LAS int*)(lds + MISC_OFF + 64 * 4); LAS int* moe_te = (LAS int*)(lds + MISC_OFF + 128 * 4);
    const int nT = moe_tables((const GAS unsigned*)(ws + WS_CTL) + CW_CNT + l * 32 * 64, moe_off, moe_te, tid);
    pg8::Gemm g{(const GAS bf16*)(ws + WS_ACT), (const GAS bf16*)(ws + WS_WTDN + (size_t)l * 32 * D * 256 * 2), nT * 256, D, 256};
    pg8::EpiStoreBf16 E{(GAS bf16*)(ws + WS_XS), D};
    const GAS unsigned* ready = (const GAS unsigned*)(ws + WS_CTL) + CW_GUC + l * MOE_MAXT * 64;
    const int vc = (G % 8 == 0) ? (bid % 8) * (G / 8) + bid / 8 : bid;
    const int nb2 = (nT * 2 > G && nT * 2 - G < G / 2) ? nT * 2 - G : 0, Gd = G - nb2, cd = vc - nb2;
    const int pmE = nb2 ? G / 2 : nT, nE = pmE * 4, nL = (nT - pmE) * 4;
    const int cl = cd < 0 ? -1 : (cd - nE % Gd + Gd) % Gd;
    pg8::GroupedOrder S1{pmE, 4, Gd, cd, moe_te, (size_t)D * 256 * 2, 0};
    pg8::GroupedOrder S2{nT - pmE, 4, Gd, cl, moe_te, (size_t)D * 256 * 2, pmE};
    { pg8::Unit u;
#pragma unroll 1
      for (int i = 0; S1.next(i, u); ++i) pg8::wait_rowtile(ready, u.pm, 16u); }
    pg8::gemm_phase(lds, g, S1, E);
    if (nL > 0) { pg8::Unit u;
#pragma unroll 1
      for (int i = 0; S2.next(i, u); ++i) pg8::wait_rowtile(ready, u.pm, 16u);
      pg8::gemm_phase(lds, g, S2, E); }
}
DI void ph_combine(const Ctx& cx, int l) {
    TIDS; GAS unsigned char* ws = cx.ws(); LAS unsigned char* lds = (LAS unsigned char*)lds_raw;
    LAS int* moe_off = (LAS int*)(lds + MISC_OFF + 64 * 4); LAS int* moe_te = (LAS int*)(lds + MISC_OFF + 128 * 4);
    const int m_lo = (l == 0) ? 0 : NCTX;
    moe_tables((const GAS unsigned*)(ws + WS_CTL) + CW_CNT + l * 32 * 64, moe_off, moe_te, tid);
    const GAS int* EID = (const GAS int*)(ws + WS_MOE); const GAS float* GATE = (const GAS float*)(ws + WS_MOE) + MTOK * 2; const GAS int* POS = (const GAS int*)(ws + WS_MOE) + MTOK * 4;
    const GAS bf16* YS = (const GAS bf16*)(ws + WS_XS); GAS bf16* X = (GAS bf16*)(ws + WS_X); GAS bf16* H = (GAS bf16*)(ws + WS_H);
    const GAS float* MODB = (const GAS float*)(ws + WS_MOD); const GAS float* MOD = MODB + (size_t)l * 5 * 6144;
    const GAS float* n1g1 = cx.in(I_N1G) + D; const GAS float* fng = cx.in(I_FNG); GAS float* outp = cx.out();
#pragma unroll 1
    for (int m = m_lo + gw; m < MTOK; m += NGW) {
        const int d0 = moe_off[EID[m * 2]] + POS[m * 2], d1 = moe_off[EID[m * 2 + 1]] + POS[m * 2 + 1];
        const float w0 = GATE[m * 2], w1 = GATE[m * 2 + 1];
        const GAS float* mb = MOD + (size_t)bidx_of_row(m) * 6144;
        f32x4 v[4];
#pragma unroll
        for (int j = 0; j < 4; ++j) { const int c = 4 * lane + 256 * j;
            const v2u a0 = *(const GAS v2u*)(YS + (size_t)d0 * D + c), a1 = *(const GAS v2u*)(YS + (size_t)d1 * D + c);
            f32x4 y; y.x = w0 * bf2f(a0.x & 0xffffu) + w1 * bf2f(a1.x & 0xffffu); y.y = w0 * bf2f(a0.x >> 16) + w1 * bf2f(a1.x >> 16);
            y.z = w0 * bf2f(a0.y & 0xffffu) + w1 * bf2f(a1.y & 0xffffu); y.w = w0 * bf2f(a0.y >> 16) + w1 * bf2f(a1.y >> 16);
            const f32x4 g5 = *(const GAS f32x4*)(mb + 5 * 1024 + c);
            v[j] = bf4f(*(const GAS v2u*)(X + (size_t)m * D + c)) + g5 * y; }
        if (l == 0) {
#pragma unroll
            for (int j = 0; j < 4; ++j) *(GAS v2u*)(X + (size_t)m * D + 4 * lane + 256 * j) = f4bf(v[j]);
            const GAS float* mb1 = MODB + (size_t)(5 + bidx_of_row(m)) * 6144;
            norm_row_store(v, n1g1, mb1, mb1 + 1024, H + (size_t)m * D, lane);
        } else {
            float ss = 0.f;
#pragma unroll
            for (int j = 0; j < 4; ++j) ss += (v[j].x * v[j].x + v[j].y * v[j].y) + (v[j].z * v[j].z + v[j].w * v[j].w);
            const float rstd = rsqrtf(wave_sum(ss) * (1.f / D) + EPS);
#pragma unroll
            for (int j = 0; j < 4; ++j) { const int c = 4 * lane + 256 * j; const f32x4 gg = *(const GAS f32x4*)(fng + c);
                *(GAS f32x4*)(outp + (size_t)(m - NCTX) * D + c) = v[j] * rstd * gg; }
        }
    }
}

#ifndef PH_MASK
#define PH_MASK 0xFFF
#endif
#define PHON(j) (((PH_MASK) >> (j)) & 1)
__global__ void __launch_bounds__(512, 2) fwd_kernel(Args args) {
    LAS unsigned char* lds = (LAS unsigned char*)lds_raw;
    volatile LAS unsigned* MISC = (volatile LAS unsigned*)(lds + MISC_OFF);
    {
        const int tid = threadIdx.x;
        for (int u = tid; u < (LDS_BYTES - MISC_OFF) / 4; u += 512) MISC[u] = 0u;
        __syncthreads();
        if (tid == 0) { volatile LAS unsigned long long* t = (volatile LAS unsigned long long*)(lds + PTR_OFF);
#pragma unroll
            for (int i = 0; i < N_IN; ++i) t[i] = (unsigned long long)args.in[i];
            t[N_IN] = (unsigned long long)args.out; t[N_IN + 1] = (unsigned long long)args.ws; }
        __syncthreads();
    }
    const Ctx cx;
#if MK_ONE_LAUNCH
    XcdBarrier bar = xcd_barrier_post((unsigned*)(cx.ws() + WS_CTL) + CW_BAR, MISC + 8);
#define GRID_BAR() xcd_barrier(bar)
#else
#define GRID_BAR() do { } while (0)
#endif
    const int lo = args.ph_lo, hi = args.ph_hi;
#define IN(k) (lo <= (k) && (k) < hi)
#define BOTH(k) (IN(k) && IN((k) + 1))
    if (PHON(0) && IN(0)) { TIDS; phase_prologue(cx, lds, tid, lane, wave, bid, G); if (BOTH(0)) GRID_BAR(); }
    if (PHON(1) && IN(1)) { TIDS; phase_norm1_l0(cx, lane, gw, NGW); if (BOTH(1)) GRID_BAR(); }
#define LAYER(L) { constexpr int l = L; constexpr int pb = 2 + 10 * l; \
        if (PHON(2) && IN(pb + 0)) { ph_gemm_in(cx, l); if (BOTH(pb + 0)) GRID_BAR(); } \
        if (PHON(3) && IN(pb + 1)) { ph_prep_r1(cx, l); if (BOTH(pb + 1)) GRID_BAR(); } \
        if (PHON(4) && IN(pb + 2)) { rec_r2(cx, blockIdx.x * 512 + threadIdx.x, gridDim.x * 512); if (BOTH(pb + 2)) GRID_BAR(); } \
        if (PHON(5) && IN(pb + 3)) { ph_mixers(cx, l); if (BOTH(pb + 3)) GRID_BAR(); } \
        if (PHON(6) && IN(pb + 4)) { ph_gemm_out(cx, l); if (BOTH(pb + 4)) GRID_BAR(); } \
        if (PHON(7) && IN(pb + 5)) { ph_router(cx, l); if (BOTH(pb + 5)) GRID_BAR(); } \
        if (PHON(9) && IN(pb + 7)) { ph_gemm_gu(cx, l);   } \
        if (PHON(10) && IN(pb + 8)) { ph_gemm_dn(cx, l); if (BOTH(pb + 8)) GRID_BAR(); } \
        if (PHON(11) && IN(pb + 9)) { ph_combine(cx, l); if (BOTH(pb + 9)) GRID_BAR(); } }
    LAYER(0)
    LAYER(1)
#undef LAYER
#undef IN
#undef BOTH
}

constexpr int NPHASES = 22;
extern "C" void kernel_launch(void* const* d_in, const int* in_sizes, int n_in, void* d_out, int out_size, void* d_ws, size_t ws_size, hipStream_t stream) {
    static int grid = 0;
    if (grid == 0) {
        if (n_in != N_IN || out_size != NLAT * D || ws_size < WS_END) { fprintf(stderr, "kernel_launch: unexpected problem (n_in %d, out %d, ws %zu)\n", n_in, out_size, ws_size); grid = -1; return; }
        int dev = 0, cus = 0, per_cu = 0;
        if (hipGetDevice(&dev) != hipSuccess || hipDeviceGetAttribute(&cus, hipDeviceAttributeMultiprocessorCount, dev) != hipSuccess) { grid = -1; return; }
        if (hipFuncSetAttribute((const void*)fwd_kernel, hipFuncAttributeMaxDynamicSharedMemorySize, LDS_BYTES) != hipSuccess) { fprintf(stderr, "kernel_launch: hipFuncSetAttribute failed\n"); grid = -1; return; }
        if (hipOccupancyMaxActiveBlocksPerMultiprocessor(&per_cu, (const void*)fwd_kernel, 512, LDS_BYTES) != hipSuccess || per_cu < 1) fprintf(stderr, "kernel_launch: occupancy query reports %d\n", per_cu);
        (void)hipGetLastError();
        grid = cus;
    }
    if (grid < 0) return;
    (void)hipMemsetAsync((char*)d_ws + WS_CTL, 0, CTL_BYTES, stream);
    Args a{};
    for (int i = 0; i < N_IN; ++i) a.in[i] = (const float*)d_in[i];
    a.out = (float*)d_out; a.ws = (unsigned char*)d_ws;
#if MK_ONE_LAUNCH
    a.ph_lo = 0; a.ph_hi = NPHASES;
    hipLaunchKernelGGL(fwd_kernel, dim3(grid), dim3(512), LDS_BYTES, stream, a);
#else
    for (int p = 0; p < NPHASES; ++p) { a.ph_lo = p; a.ph_hi = p + 1; hipLaunchKernelGGL(fwd_kernel, dim3(grid), dim3(512), LDS_BYTES, stream, a); }
#endif
}
```

```cpp
#include <hip/hip_runtime.h>
#include <cstdio>
#include <cstdint>

#ifndef MK_ONE_LAUNCH
#define MK_ONE_LAUNCH 1
#endif

#define DI __device__ __forceinline__
#define GAS __attribute__((address_space(1)))
#define LAS __attribute__((address_space(3)))
typedef unsigned short bf16;
typedef unsigned v4u __attribute__((ext_vector_type(4)));
typedef unsigned v2u __attribute__((ext_vector_type(2)));
typedef float f32x4 __attribute__((ext_vector_type(4)));
typedef short bf16x8 __attribute__((ext_vector_type(8)));
#define LDS_WAIT() asm volatile("s_waitcnt lgkmcnt(0)" ::: "memory")

constexpr int D = 1024, NB = 4, SEQ = 4096, LCTX = 256, NCTX = NB * LCTX, NLAT = NB * SEQ, MTOK = NCTX + NLAT;
constexpr int DIN = 3200, PP = 3328;
constexpr int CA_Q = 0, CA_I = 256, CA_FF = 512, CA_FB = 768, CA_G = 1024;
constexpr int CB_Q = 1280, CB_K = 1536, CB_V = 1792;
constexpr int CC_Q = 2048, CC_K = 2176, CC_V = 2304, CC_G = 2560, CC_ZF = 2816, CC_ZB = 2832;
constexpr int CD_Q = 2848, CD_KV = 3040, CD_R = 3168;
constexpr int NKEY = LCTX + SEQ;
constexpr int NCHUNK = NKEY / 64;
constexpr float EPS = 1e-6f;
constexpr float LOG2E = 1.4426950408889634f;
constexpr int MOE_MAXT = 168;
constexpr int MOE_CAP = 2 * 17408;

enum { I_X = 0, I_C, I_CTX, I_CCTX, I_WMOD, I_BMOD, I_N1G, I_N2G, I_WIN, I_WOUT, I_LBL, I_HNG, I_RPB, I_WGF, I_BGF, I_WGB, I_BGB, I_GNG, I_QNG, I_WUQ, I_KVNG, I_WUKV,
       I_WRG, I_BRG, I_WRE, I_BRE, I_WGU, I_WDN, I_FNG, N_IN };

constexpr size_t MiB = 1u << 20;
constexpr size_t WS_CTL = 0, CTL_BYTES = 2 * MiB;
constexpr size_t WS_WTIN = 2 * MiB;
constexpr size_t WTIN_L = (size_t)PP * D * 2;
constexpr size_t WS_WTOUT = 16 * MiB;
constexpr size_t WS_WTUQ = 20 * MiB;
constexpr size_t WS_WTUKV = WS_WTUQ + 512 * 1024;
constexpr size_t WS_MOD = 21 * MiB;
constexpr size_t WS_WR = WS_MOD + 512 * 1024;
constexpr size_t WS_WTGU = 22 * MiB;
constexpr size_t WS_WTDN = 86 * MiB;
constexpr size_t WS_X = 118 * MiB;
constexpr size_t WS_H = 186 * MiB;
constexpr size_t WS_CAT = 220 * MiB;
constexpr size_t WS_P = 254 * MiB;
constexpr size_t WS_XS = WS_P;
constexpr size_t WS_ACT = 338 * MiB;
constexpr size_t WS_QM = 366 * MiB;
constexpr size_t WS_KM = 379 * MiB;
constexpr size_t WS_VM = 392 * MiB;
constexpr size_t WS_RSH = 401 * MiB;
constexpr size_t WS_RSG = 435 * MiB;
constexpr size_t WS_RAH = 452 * MiB;
constexpr size_t WS_RAG = WS_RAH + 600 * 1024;
constexpr size_t WS_MOE = 453 * MiB;
constexpr size_t WS_VNT = 454 * MiB;
constexpr size_t WS_RIDX = 463 * MiB;
constexpr size_t WS_END = 468 * MiB;
constexpr int CW_BAR = 4096;
constexpr int CW_CNT = 16384;
constexpr int CW_GUC = 32768;
constexpr int CW_TMO = 64;

constexpr int RING_BYTES = 131072;
constexpr int MISC_OFF = RING_BYTES;
constexpr int LDS_BYTES = 147456;

DI float bf2f(unsigned v) { return __uint_as_float(v << 16); }
DI unsigned f2bf(float f) { unsigned u = __float_as_uint(f); return (u + 0x7fffu + ((u >> 16) & 1u)) >> 16; }
typedef __bf16 bf16v2 __attribute__((ext_vector_type(2)));
typedef float f32x2 __attribute__((ext_vector_type(2)));
DI unsigned pk2(float lo, float hi) { const f32x2 v = {lo, hi}; return __builtin_bit_cast(unsigned, __builtin_convertvector(v, bf16v2)); }
DI f32x4 bf4f(v2u w) { f32x4 r; r.x = __uint_as_float(w.x << 16); r.y = __uint_as_float(w.x & 0xffff0000u); r.z = __uint_as_float(w.y << 16); r.w = __uint_as_float(w.y & 0xffff0000u); return r; }
DI v2u f4bf(f32x4 v) { return (v2u){pk2(v.x, v.y), pk2(v.z, v.w)}; }
DI bf16x8 pack8(float a0, float a1, float a2, float a3, float a4, float a5, float a6, float a7) {
    v4u p; p.x = pk2(a0, a1); p.y = pk2(a2, a3); p.z = pk2(a4, a5); p.w = pk2(a6, a7);
    return __builtin_bit_cast(bf16x8, p);
}
DI float wave_sum(float v) {
#pragma unroll
    for (int o = 1; o < 64; o <<= 1) v += __shfl_xor(v, o);
    return v;
}
DI float frcp_(float x) { return __builtin_amdgcn_rcpf(x); }
DI float sigmoid_(float x) { return frcp_(1.f + __expf(-x)); }
DI float silu_(float x) { return x * frcp_(1.f + __expf(-x)); }
DI float logsigmoid_(float x) { return fminf(x, 0.f) - __logf(1.f + __expf(-fabsf(x))); }
DI void unpack8(v4u w, float* f) {
    f[0] = __uint_as_float(w.x << 16); f[1] = __uint_as_float(w.x & 0xffff0000u);
    f[2] = __uint_as_float(w.y << 16); f[3] = __uint_as_float(w.y & 0xffff0000u);
    f[4] = __uint_as_float(w.z << 16); f[5] = __uint_as_float(w.z & 0xffff0000u);
    f[6] = __uint_as_float(w.w << 16); f[7] = __uint_as_float(w.w & 0xffff0000u);
}
DI int bidx_of_row(int m) { return m < NCTX ? 4 : ((m - NCTX) >> 12); }

namespace pg8 {
#define PG8_LAS __attribute__((address_space(3)))
typedef unsigned short bf16_t;
typedef unsigned u32x4 __attribute__((ext_vector_type(4)));
constexpr int BM = 256, BK = 64, HALF = 128, HTB = HALF * BK * 2, STAGE_BYTES = 8 * HTB, NXCD = 8, WGM = 8;
__host__ __device__ __forceinline__ int lds_byte(int r, int c) { const int st = (r >> 4) * 2 + (c >> 5), rr = r & 15, cc = c & 31, ob = rr * 64 + cc * 2; return st * 1024 + (ob ^ (((ob >> 9) & 1) << 5)); }
__host__ __device__ __forceinline__ void stage_rc(int b, int& R, int& C) { const int st = b / 1024, sb = b % 1024, swz = sb ^ (((sb >> 9) & 1) << 5); R = (st >> 1) * 16 + swz / 64; C = (st & 1) * 32 + (swz % 64) / 2; }
__host__ __device__ __forceinline__ int perm32(int rho) { const int n = rho >> 4, i = rho & 15; return 8 * (i >> 2) + 4 * n + (i & 3); }
struct Unit { int pm, pn; size_t bo; };
struct LinearRows { static constexpr bool LINEAR = true; __device__ __forceinline__ int operator()(const Unit& u, int r) const { return u.pm * BM + r; } };
struct MoeRows { static constexpr bool LINEAR = false; const PG8_LAS int* idx; int pm0;
    __device__ __forceinline__ int operator()(const Unit& u, int r) const { return idx[(u.pm == pm0 ? 0 : 256) + r]; } };
struct Gemm { const GAS bf16_t* A; const GAS bf16_t* Bt; int M, N, K; };
struct StaticOrder {
    int nM, nN, nwg, G, c;
    __device__ void init(int M, int N, int G_, int c_) { nM = M / BM; nN = N / BM; nwg = nM * nN; G = G_; c = c_; }
    __device__ bool next(int i, Unit& u) const {
        const long L = (long)i * G + c; if (L >= nwg) return false;
        int wgid = (int)L; { const int q = nwg / NXCD, r = nwg % NXCD, xcd = wgid % NXCD, off = wgid / NXCD; wgid = (xcd < r ? xcd * (q + 1) : r * (q + 1) + (xcd - r) * q) + off; }
        const int nig = WGM * nN, gid = wgid / nig, fm = gid * WGM, gsz = (nM - fm) < WGM ? (nM - fm) : WGM;
        u.pm = fm + ((wgid % nig) % gsz); u.pn = (wgid % nig) / gsz; u.bo = 0; return true;
    }
    __device__ __forceinline__ void a_ready(const Unit&) const {}
    __device__ __forceinline__ void done(const Unit&) const {}
};
struct GroupedOrder {
    int nT, nN, G, c; const PG8_LAS int* tile_e; size_t estride; int pm0 = 0;
    __device__ bool next(int i, Unit& u) const {
        if (c < 0) return false;
        const long L = (long)i * G + c; if (L >= (long)nT * nN) return false;
        u.pm = pm0 + (int)(L / nN); u.pn = (int)(L % nN); u.bo = (size_t)__builtin_amdgcn_readfirstlane(tile_e[u.pm]) * estride; return true;
    }
    __device__ __forceinline__ void a_ready(const Unit&) const {}
    __device__ __forceinline__ void done(const Unit&) const {}
};
struct GroupedPublish : GroupedOrder { GAS unsigned* done_cnt;
    __device__ __forceinline__ void done(const Unit& u) const { asm volatile("s_waitcnt vmcnt(0)" ::: "memory");
        if ((threadIdx.x & 63) == 0) __hip_atomic_fetch_add(done_cnt + 64 * u.pm, 1u, __ATOMIC_RELAXED, __HIP_MEMORY_SCOPE_AGENT); } };
__device__ __forceinline__ void wait_rowtile(const GAS unsigned* ready, int pm, unsigned need) {
    if (threadIdx.x < 64) {
        unsigned spins = 0;
        while ((unsigned)__builtin_amdgcn_readfirstlane(__hip_atomic_load(ready + 64 * pm, __ATOMIC_RELAXED, __HIP_MEMORY_SCOPE_AGENT)) < need && ++spins < (1u << 22)) __builtin_amdgcn_s_sleep(2);
        __builtin_amdgcn_fence(__ATOMIC_ACQUIRE, "agent");
        asm volatile("s_waitcnt vmcnt(0)" ::: "memory");
    }
    __syncthreads();
}
__device__ __forceinline__ unsigned cvt_pk_bf16(float lo, float hi) { unsigned r; asm volatile("v_cvt_pk_bf16_f32 %0, %1, %2" : "=v"(r) : "v"(lo), "v"(hi)); return r; }

struct EpiStoreBf16 {
    static constexpr bool PERM = true;
    GAS bf16_t* O; int ldc;
    __device__ __forceinline__ void operator()(const f32x4 (&acc)[2][2][4][2], const Unit& u, int wr, int wc, int fr, int fq) const {
        const int row0 = u.pm * BM + wr * 64 + fr, col0 = u.pn * BM + wc * 32 + 8 * fq;
#pragma unroll
        for (int ai = 0; ai < 2; ++ai)
#pragma unroll
            for (int m = 0; m < 4; ++m) { GAS bf16_t* rowp = O + (size_t)(row0 + ai * HALF + m * 16) * ldc + col0;
#pragma unroll
                for (int bj = 0; bj < 2; ++bj) { const f32x4 v0 = acc[ai][bj][m][0], v1 = acc[ai][bj][m][1];
                    u32x4 w; w.x = cvt_pk_bf16(v0[0], v0[1]); w.y = cvt_pk_bf16(v0[2], v0[3]); w.z = cvt_pk_bf16(v1[0], v1[1]); w.w = cvt_pk_bf16(v1[2], v1[3]);
                    *(GAS u32x4*)(rowp + bj * HALF) = w; } }
    }
};
struct EpiResid {
    static constexpr bool PERM = false;
    GAS bf16_t* X; int row_off; const GAS float* mod;
    const GAS float* src_ctx; const GAS float* src_lat;
    __device__ __forceinline__ void operator()(const f32x4 (&acc)[2][2][4][2], const Unit& u, int wr, int wc, int fr, int fq) const {
        const int row0 = row_off + u.pm * BM + wr * 64 + fr, col0 = u.pn * BM + wc * 32 + 4 * fq;
#pragma unroll
        for (int ai = 0; ai < 2; ++ai)
#pragma unroll
            for (int m = 0; m < 4; ++m) { const int row = row0 + ai * HALF + m * 16; GAS bf16_t* rowp = X + (size_t)row * D + col0; const GAS float* gp = mod + (size_t)bidx_of_row(row) * 6144 + col0;
                const GAS float* bp = src_lat ? (row < NCTX ? src_ctx + (size_t)row * D + col0 : src_lat + (size_t)(row - NCTX) * D + col0) : (const GAS float*)nullptr;
#pragma unroll
                for (int bj = 0; bj < 2; ++bj)
#pragma unroll
                    for (int n = 0; n < 2; ++n) { const f32x4 g = *(const GAS f32x4*)(gp + bj * HALF + n * 16);
                        f32x4 x = src_lat ? *(const GAS f32x4*)(bp + bj * HALF + n * 16) : bf4f(*(const GAS v2u*)(rowp + bj * HALF + n * 16));
                        x = x + g * acc[ai][bj][m][n]; *(GAS v2u*)(rowp + bj * HALF + n * 16) = f4bf(x); } }
    }
};
struct EpiGateUp {
    static constexpr bool PERM = true;
    GAS bf16_t* O; unsigned nbytes;
    __device__ __forceinline__ void operator()(const f32x4 (&acc)[2][2][4][2], const Unit& u, int wr, int wc, int fr, int fq) const {
        const int row0 = u.pm * BM + wr * 64 + fr, col0 = u.pn * HALF + wc * 32 + 8 * fq;
        const __amdgpu_buffer_rsrc_t rsrc = __builtin_amdgcn_make_buffer_rsrc((void*)O, 0, (int)nbytes, 0x00020000);
#pragma unroll
        for (int ai = 0; ai < 2; ++ai)
#pragma unroll
            for (int m = 0; m < 4; ++m) { const unsigned off = (unsigned)((row0 + ai * HALF + m * 16) * 256 + col0) * 2u;
                float r[8];
#pragma unroll
                for (int n = 0; n < 2; ++n)
#pragma unroll
                    for (int j = 0; j < 4; ++j) { const float g = acc[ai][0][m][n][j], up = acc[ai][1][m][n][j]; r[n * 4 + j] = g * __builtin_amdgcn_rcpf(1.f + __expf(-g)) * up; }
                u32x4 w; w.x = cvt_pk_bf16(r[0], r[1]); w.y = cvt_pk_bf16(r[2], r[3]); w.z = cvt_pk_bf16(r[4], r[5]); w.w = cvt_pk_bf16(r[6], r[7]);
                __builtin_amdgcn_raw_buffer_store_b128(w, rsrc, (int)off, 0, 16); }
    }
};

template <class Epi, class Sched, class Rows = LinearRows>
__device__ __forceinline__ void gemm_phase(PG8_LAS unsigned char* lds, const Gemm g, const Sched& S, const Epi& E, const Rows RM = Rows()) {
    const int tid = threadIdx.x, wid = __builtin_amdgcn_readfirstlane(tid >> 6), lane = tid & 63, wr = wid >> 2, wc = wid & 3, fr = lane & 15, fq = lane >> 4;
    const int K = g.K, nt = K / BK;
    unsigned voffB[2]; int rA[2], cA2[2];
#pragma unroll
    for (int i = 0; i < 2; ++i) { int R, C; stage_rc(tid * 16 + i * 8192, R, C); const int Rb = Epi::PERM ? ((R & ~31) + perm32(R & 31)) : R;
        rA[i] = R; cA2[i] = C * 2; voffB[i] = (unsigned)(Rb * K + C) * 2u; }
    unsigned oAc[2][2], oAn[2][2];
#define PG8_AOFF(dst, u) do { _Pragma("unroll") for (int _h = 0; _h < 2; ++_h) _Pragma("unroll") for (int _i = 0; _i < 2; ++_i) dst[_h][_i] = (unsigned)RM(u, _h * HALF + rA[_i]) * (unsigned)(K * 2) + (unsigned)cA2[_i]; } while (0)
#define PG8_STAGE_A(bufoff, o2, kbyte) do { _Pragma("unroll") for (int _i = 0; _i < 2; ++_i) \
        __builtin_amdgcn_global_load_lds((const unsigned*)((const char*)g.A + (size_t)(kbyte) + (o2)[_i]), (PG8_LAS unsigned*)(lds + (bufoff) + ldsw + _i * 8192), 16, 0, 0); } while (0)
    const size_t kstep = (size_t)(BK * 2);
    const size_t hstep = (size_t)HALF * K * 2;
    const size_t tstep = 2 * hstep;
    const unsigned ldsw = (unsigned)wid * 1024u;
    const int aoff = lds_byte(wr * 64 + fr, fq * 8), boff = lds_byte(wc * 32 + fr, fq * 8);
#define PG8_SA(b, h) (((b) * 2 + (h)) * HTB)
#define PG8_SB(b, h) ((4 + (b) * 2 + (h)) * HTB)
#define PG8_STAGE(bufoff, gbase, voff) do { _Pragma("unroll") for (int _i = 0; _i < 2; ++_i) \
        __builtin_amdgcn_global_load_lds((const unsigned*)((const char*)(gbase) + (voff)[_i]), (PG8_LAS unsigned*)(lds + (bufoff) + ldsw + _i * 8192), 16, 0, 0); } while (0)
#define PG8_LDA(dst, b, h) do { _Pragma("unroll") for (int m = 0; m < 4; ++m) _Pragma("unroll") for (int k = 0; k < 2; ++k) dst[m][k] = *(const PG8_LAS bf16x8*)(lds + PG8_SA(b, h) + aoff + m * 2048 + k * 1024); } while (0)
#define PG8_LDB(dst, b, h) do { _Pragma("unroll") for (int n = 0; n < 2; ++n) _Pragma("unroll") for (int k = 0; k < 2; ++k) dst[n][k] = *(const PG8_LAS bf16x8*)(lds + PG8_SB(b, h) + boff + n * 2048 + k * 1024); } while (0)
#define PG8_MMA(ai, bj, At, Bt) do { __builtin_amdgcn_s_setprio(1); _Pragma("unroll") for (int m = 0; m < 4; ++m) _Pragma("unroll") for (int n = 0; n < 2; ++n) _Pragma("unroll") for (int k = 0; k < 2; ++k) \
        acc[ai][bj][m][n] = __builtin_amdgcn_mfma_f32_16x16x32_bf16(Bt[n][k], At[m][k], acc[ai][bj][m][n], 0, 0, 0); __builtin_amdgcn_s_setprio(0); } while (0)
#define PG8_WAIT_V(n) asm volatile("s_waitcnt vmcnt(" #n ")" ::: "memory")
#define PG8_WAIT_L(n) asm volatile("s_waitcnt lgkmcnt(" #n ")" ::: "memory")
#define PG8_BAR __builtin_amdgcn_s_barrier()
#define PG8_SCHED __builtin_amdgcn_sched_barrier(0)
    Unit cur, nxt; int ui = 0;
    if (!S.next(0, cur)) return;
    f32x4 acc[2][2][4][2];
#pragma unroll
    for (int a = 0; a < 2; ++a)
#pragma unroll
        for (int b = 0; b < 2; ++b)
#pragma unroll
            for (int m = 0; m < 4; ++m)
#pragma unroll
                for (int n = 0; n < 2; ++n) acc[a][b][m][n] = (f32x4){0.f, 0.f, 0.f, 0.f};
    bf16x8 At[4][2], B0[2][2], B1[2][2];
    const char* cB = (const char*)g.Bt + cur.bo + (size_t)cur.pn * tstep;
    S.a_ready(cur);
    PG8_AOFF(oAc, cur);
    PG8_STAGE(PG8_SB(0, 0), cB, voffB); PG8_STAGE_A(PG8_SA(0, 0), oAc[0], 0); PG8_STAGE(PG8_SB(0, 1), cB + hstep, voffB); PG8_STAGE_A(PG8_SA(0, 1), oAc[1], 0);
    if (wr == 1) PG8_BAR;
    PG8_WAIT_V(4); PG8_BAR;
    PG8_STAGE(PG8_SB(1, 0), cB + kstep, voffB); PG8_STAGE_A(PG8_SA(1, 0), oAc[0], kstep); PG8_STAGE(PG8_SB(1, 1), cB + hstep + kstep, voffB);
    PG8_WAIT_V(6); PG8_BAR;
    for (;;) {
        const bool has_next = S.next(ui + 1, nxt);
        const char* nB = has_next ? (const char*)g.Bt + nxt.bo + (size_t)nxt.pn * tstep : cB;
        unsigned dAn = 0u;
        if constexpr (Rows::LINEAR) { if (has_next) dAn = (unsigned)(nxt.pm - cur.pm) * (unsigned)(BM * K * 2); }
        else { if (has_next) PG8_AOFF(oAn, nxt);
            else {
#pragma unroll
                for (int _h = 0; _h < 2; ++_h)
#pragma unroll
                    for (int _i = 0; _i < 2; ++_i) oAn[_h][_i] = oAc[_h][_i]; } }
        for (int t = 0; t < nt; t += 2) {
            const bool last = (t == nt - 2);
            const size_t k1 = (size_t)(t + 1) * kstep, k2 = last ? 0 : (size_t)(t + 2) * kstep, k3 = k2 + kstep;
            unsigned o20[2], o21[2];
#pragma unroll
            for (int _i = 0; _i < 2; ++_i) { if constexpr (Rows::LINEAR) { o20[_i] = oAc[0][_i] + (last ? dAn : 0u); o21[_i] = oAc[1][_i] + (last ? dAn : 0u); }
                else { o20[_i] = last ? oAn[0][_i] : oAc[0][_i]; o21[_i] = last ? oAn[1][_i] : oAc[1][_i]; } }
            const char* b2 = last ? nB : cB + (size_t)(t + 2) * kstep;
            const char* b3 = b2 + kstep;
            if (last && has_next) S.a_ready(nxt);
            PG8_LDB(B0, 0, 0); PG8_SCHED; PG8_LDA(At, 0, 0); PG8_STAGE_A(PG8_SA(1, 1), oAc[1], k1);
            PG8_WAIT_L(8); PG8_BAR; PG8_WAIT_L(0); PG8_MMA(0, 0, At, B0); PG8_BAR; PG8_SCHED;
            PG8_LDB(B1, 0, 1); PG8_STAGE(PG8_SB(0, 0), b2, voffB);
            PG8_BAR; PG8_WAIT_L(0); PG8_MMA(0, 1, At, B1); PG8_BAR;
            PG8_LDA(At, 0, 1); PG8_STAGE_A(PG8_SA(0, 0), o20, k2);
            PG8_BAR; PG8_WAIT_L(0); PG8_MMA(1, 0, At, B0); PG8_BAR; PG8_SCHED;
            PG8_STAGE(PG8_SB(0, 1), b2 + hstep, voffB);
            PG8_WAIT_V(6); PG8_BAR; PG8_MMA(1, 1, At, B1); PG8_BAR;
            PG8_LDB(B0, 1, 0); PG8_SCHED; PG8_LDA(At, 1, 0); PG8_STAGE_A(PG8_SA(0, 1), o21, k2);
            PG8_WAIT_L(8); PG8_BAR; PG8_WAIT_L(0); PG8_MMA(0, 0, At, B0); PG8_BAR; PG8_SCHED;
            PG8_LDB(B1, 1, 1); PG8_STAGE(PG8_SB(1, 0), b3, voffB);
            PG8_BAR; PG8_WAIT_L(0); PG8_MMA(0, 1, At, B1); PG8_BAR;
            PG8_LDA(At, 1, 1); PG8_STAGE_A(PG8_SA(1, 0), o20, k3);
            PG8_BAR; PG8_WAIT_L(0); PG8_MMA(1, 0, At, B0); PG8_BAR; PG8_SCHED;
            PG8_STAGE(PG8_SB(1, 1), b3 + hstep, voffB);
            PG8_WAIT_V(6); PG8_BAR; PG8_MMA(1, 1, At, B1); PG8_BAR;
        }
        E(acc, cur, wr, wc, fr, fq); S.done(cur);
        if (!has_next) break;
#pragma unroll
        for (int a = 0; a < 2; ++a)
#pragma unroll
            for (int b = 0; b < 2; ++b)
#pragma unroll
                for (int m = 0; m < 4; ++m)
#pragma unroll
                    for (int n = 0; n < 2; ++n) acc[a][b][m][n] = (f32x4){0.f, 0.f, 0.f, 0.f};
        cur = nxt; cB = nB; ++ui;
#pragma unroll
        for (int _h = 0; _h < 2; ++_h)
#pragma unroll
            for (int _i = 0; _i < 2; ++_i) { if constexpr (Rows::LINEAR) oAc[_h][_i] += dAn; else oAc[_h][_i] = oAn[_h][_i]; }
    }
    PG8_WAIT_V(0);
    if (wr == 0) PG8_BAR;
    PG8_BAR;
#undef PG8_SA
#undef PG8_SB
#undef PG8_STAGE
#undef PG8_STAGE_A
#undef PG8_AOFF
#undef PG8_LDA
#undef PG8_LDB
#undef PG8_MMA
#undef PG8_WAIT_V
#undef PG8_WAIT_L
#undef PG8_BAR
#undef PG8_SCHED
}
}

#define XB_TMO      128
#define XB_XCNT(j)  (256  + 64 * (j))
#define XB_XSUB(j)  (1280 + 64 * (j))
#define XB_XGEN(j)  (2304 + 64 * (j))
#define XB_TOP      3328
#define XB_TOPGEN   3392
#define XCD_BAR_WORDS 3456
#define XB_SPIN_CAP (1u << 18)
__device__ __forceinline__ unsigned xb_ld(unsigned* p)              { return __hip_atomic_load(p, __ATOMIC_RELAXED, __HIP_MEMORY_SCOPE_AGENT); }
__device__ __forceinline__ unsigned xb_add(unsigned* p, unsigned v) { return __hip_atomic_fetch_add(p, v, __ATOMIC_RELAXED, __HIP_MEMORY_SCOPE_AGENT); }
__device__ __forceinline__ unsigned xb_xcc_id() { return (unsigned)__builtin_amdgcn_s_getreg((3 << 11) | 20) & 0xFu; }
#define XB_SPIN(cond, bar) do { unsigned _sp = 0; while (cond) { __builtin_amdgcn_s_sleep(1); \
    if ((++_sp & 255u) == 0u) { if (xb_ld(&(bar)[XB_TMO])) break; if (_sp > XB_SPIN_CAP) { atomicAdd(&(bar)[XB_TMO], 1u); break; } } } } while (0)
struct XcdBarrier { unsigned* bar; unsigned x; volatile LAS unsigned* st; };
__device__ __forceinline__ XcdBarrier xcd_barrier_post(unsigned* bar, volatile LAS unsigned* st) {
    XcdBarrier b; b.bar = bar; b.x = xb_xcc_id(); b.st = st;
    if (threadIdx.x == 0) (void)xb_add(&bar[XB_XCNT(b.x)], 1u);
    return b;
}
__device__ __forceinline__ void xcd_barrier_complete(unsigned* bar, unsigned x, unsigned& nloc, unsigned& nx) {
    const unsigned G = gridDim.x * gridDim.y * gridDim.z;
    unsigned sum, cnt, mine, sp = 0u;
    for (;;) {
        sum = 0u; cnt = 0u; mine = 0u;
#pragma unroll
        for (unsigned j = 0; j < 16; ++j) { const unsigned c = xb_ld(&bar[XB_XCNT(j)]); sum += c; cnt += (c > 0u) ? 1u : 0u; mine = (j == x) ? c : mine; }
        if (sum == G) break;
        __builtin_amdgcn_s_sleep(1);
        if ((++sp & 255u) == 0u) { if (xb_ld(&bar[XB_TMO])) break; if (sp > XB_SPIN_CAP) { atomicAdd(&bar[XB_TMO], 1u); break; } }
    }
    nloc = mine > 0u ? mine : 1u; nx = cnt > 0u ? cnt : 1u;
}
__device__ __forceinline__ void xcd_barrier(const XcdBarrier& b) {
    asm volatile("s_waitcnt vmcnt(0)" ::: "memory");
    __syncthreads();
    if (threadIdx.x == 0) {
        unsigned* bar = b.bar;
        __builtin_amdgcn_s_waitcnt(0);
        unsigned nloc = b.st[0], nx = b.st[1];
        if (nloc == 0u) { xcd_barrier_complete(bar, b.x, nloc, nx); b.st[0] = nloc; b.st[1] = nx; }
        const unsigned old = xb_add(&bar[XB_XSUB(b.x)], 1u);
        const unsigned gen = old / nloc;
        if (old + 1u == (gen + 1u) * nloc) {
            __builtin_amdgcn_fence(__ATOMIC_RELEASE, "agent");
            asm volatile("s_waitcnt vmcnt(0)" ::: "memory");
            const unsigned og = xb_add(&bar[XB_TOP], 1u);
            const unsigned tg = og / nx;
            if (og + 1u == (tg + 1u) * nx) xb_add(&bar[XB_TOPGEN], 1u);
            else XB_SPIN(xb_ld(&bar[XB_TOPGEN]) == tg, bar);
            __builtin_amdgcn_fence(__ATOMIC_ACQUIRE, "agent");
            xb_add(&bar[XB_XGEN(b.x)], 1u);
            asm volatile("s_waitcnt vmcnt(0)" ::: "memory");
        } else {
            XB_SPIN(xb_ld(&bar[XB_XGEN(b.x)]) == gen, bar);
            __builtin_amdgcn_fence(__ATOMIC_ACQUIRE, "agent");
            asm volatile("s_waitcnt vmcnt(0)" ::: "memory");
        }
    }
    __syncthreads();
}

struct Args { const float* in[N_IN]; float* out; unsigned char* ws; int ph_lo, ph_hi; int pad0, pad1; };
extern __shared__ __attribute__((aligned(16))) unsigned char lds_raw[];
constexpr int PTR_OFF = MISC_OFF + 2048;
struct Ctx {
    DI unsigned long long raw(int i) const { volatile LAS unsigned* t = (volatile LAS unsigned*)((LAS unsigned char*)lds_raw + PTR_OFF) + 2 * i;
        const unsigned lo = __builtin_amdgcn_readfirstlane(t[0]), hi = __builtin_amdgcn_readfirstlane(t[1]); return ((unsigned long long)hi << 32) | lo; }
    DI const GAS float* in(int i) const { return (const GAS float*)raw(i); }
    DI GAS float* out() const { return (GAS float*)raw(N_IN); }
    DI GAS unsigned char* ws() const { return (GAS unsigned char*)raw(N_IN + 1); }
};

DI void transpose_item(const GAS float* W, int N, int k0, int n0, GAS bf16* WT, int Kd, int drow0, LAS float* scr, int lane) {
    float wv[32];
#pragma unroll
    for (int i = 0; i < 32; ++i) wv[i] = W[(size_t)(k0 + 2 * i + (lane >> 5)) * N + n0 + (lane & 31)];
#pragma unroll
    for (int i = 0; i < 32; ++i) scr[(2 * i + (lane >> 5)) * 33 + (lane & 31)] = wv[i];
    LDS_WAIT(); asm volatile("" ::: "memory");
    const int c = lane & 7;
#pragma unroll
    for (int j = 0; j < 4; ++j) { const int n = (lane >> 3) + 8 * j; const LAS float* s = scr + (8 * c) * 33 + n;
        v4u o; o.x = pk2(s[0 * 33], s[1 * 33]); o.y = pk2(s[2 * 33], s[3 * 33]); o.z = pk2(s[4 * 33], s[5 * 33]); o.w = pk2(s[6 * 33], s[7 * 33]);
        *(GAS v4u*)(WT + (size_t)(drow0 + n) * Kd + k0 + 8 * c) = o; }
    LDS_WAIT(); asm volatile("" ::: "memory");
}

DI void weight_copies(const Ctx& a, int l, LAS unsigned char* lds, int tid, int lane, int wave, int gwv, int ngw, int gt, int ngt) {
    GAS unsigned char* ws = a.ws();
    for (int i = gt; i < 128 * 1024 / 8; i += ngt) *(GAS v4u*)(ws + WS_WTIN + (size_t)l * WTIN_L + (size_t)3200 * D * 2 + (size_t)i * 16) = (v4u){0u, 0u, 0u, 0u};
    LAS float* scr = (LAS float*)(lds + wave * 16384);
    constexpr int IT_IN = 16 * 100, IT_OUT = 16 * 32, IT_UQ = 3 * 12, IT_UKV = 2 * 16, IT_GU = 32 * 16 * 16, IT_DN = 32 * 4 * 32;
    constexpr int NITEMS = IT_IN + IT_OUT + IT_UQ + IT_UKV + IT_GU + IT_DN;
    for (int it = gwv; it < NITEMS; it += ngw) {
        int r = it;
        if (r < IT_IN) { const int kb = r / 100, nb = r % 100;
            transpose_item(a.in(I_WIN) + (size_t)l * D * DIN, DIN, kb * 64, nb * 32, (GAS bf16*)(ws + WS_WTIN + (size_t)l * WTIN_L), D, nb * 32, scr, lane); continue; } r -= IT_IN;
        if (r < IT_OUT) { const int kb = r / 32, nb = r % 32;
            transpose_item(a.in(I_WOUT) + (size_t)l * D * D, D, kb * 64, nb * 32, (GAS bf16*)(ws + WS_WTOUT + (size_t)l * D * D * 2), D, nb * 32, scr, lane); continue; } r -= IT_OUT;
        if (r < IT_UQ) { const int kb = r / 12, nb = r % 12;
            transpose_item(a.in(I_WUQ) + (size_t)l * 192 * 384, 384, kb * 64, nb * 32, (GAS bf16*)(ws + WS_WTUQ + (size_t)l * 384 * 192 * 2), 192, nb * 32, scr, lane); continue; } r -= IT_UQ;
        if (r < IT_UKV) { const int kb = r / 16, nb = r % 16;
            transpose_item(a.in(I_WUKV) + (size_t)l * 128 * 512, 512, kb * 64, nb * 32, (GAS bf16*)(ws + WS_WTUKV + (size_t)l * 512 * 128 * 2), 128, nb * 32, scr, lane); continue; } r -= IT_UKV;
        if (r < IT_GU) { const int le = l * 32 + r / 256, q = r % 256, kb = q / 16, nb = q % 16; const int n0 = nb * 32, c0 = n0 & 255, isup = n0 >> 8;
            const int drow0 = (c0 >> 7) * 256 + isup * 128 + (c0 & 127);
            transpose_item(a.in(I_WGU) + (size_t)le * D * 512, 512, kb * 64, n0, (GAS bf16*)(ws + WS_WTGU + (size_t)le * 512 * D * 2), D, drow0, scr, lane); continue; } r -= IT_GU;
        { const int le = l * 32 + r / 128, q = r % 128, kb = q / 32, nb = q % 32;
            transpose_item(a.in(I_WDN) + (size_t)le * 256 * D, D, kb * 64, nb * 32, (GAS bf16*)(ws + WS_WTDN + (size_t)le * D * 256 * 2), 256, nb * 32, scr, lane); }
    }
}

DI void phase_prologue(const Ctx& a, LAS unsigned char* lds, int tid, int lane, int wave, int bid, int G) {
    GAS unsigned char* ws = a.ws();
    GAS float* MOD = (GAS float*)(ws + WS_MOD);
    {
        LAS float* S = (LAS float*)lds;
        LAS float* R = (LAS float*)(lds + 5 * 1024 * 4);
        if (bid < 192) {
            const GAS float* cvec = a.in(I_C); const GAS float* cctx = a.in(I_CCTX);
            for (int i = tid; i < 5 * 1024; i += 512) { const int r = i >> 10, k = i & 1023; const float v = r < 4 ? cvec[r * 1024 + k] : cctx[k]; S[i] = silu_(v); }
        }
        __syncthreads();
        for (int u = bid; u < 192; u += G) {
            const int l = u / 96, cl = tid & 63, n = (u % 96) * 64 + cl, ks = tid >> 6;
            const GAS float* W = a.in(I_WMOD) + (size_t)l * 1024 * 6144 + n; const GAS float* bmod = a.in(I_BMOD);
            float acc[5] = {0.f, 0.f, 0.f, 0.f, 0.f};
            for (int k = ks * 128; k < ks * 128 + 128; ++k) { const float w = W[(size_t)k * 6144];
#pragma unroll
                for (int r = 0; r < 5; ++r) acc[r] += S[r * 1024 + k] * w; }
#pragma unroll
            for (int r = 0; r < 5; ++r) R[(ks * 5 + r) * 64 + cl] = acc[r];
            __syncthreads();
            if (tid < 320) { const int r = tid >> 6; float s = 0.f;
#pragma unroll
                for (int k2 = 0; k2 < 8; ++k2) s += R[(k2 * 5 + r) * 64 + cl];
                MOD[(size_t)(l * 5 + r) * 6144 + n] = s + bmod[l * 6144 + n]; }
            __syncthreads();
        }
    }
    for (int i = bid * 512 + tid; i < 2 * 48 * 1024; i += G * 512) { const int l = i / (48 * 1024), r = i % (48 * 1024), c = r >> 10, k = r & 1023;
        const float w = c < 4 ? a.in(I_WRG)[(size_t)l * D * 4 + k * 4 + c] : (c < 36 ? a.in(I_WRE)[(size_t)l * D * 32 + k * 32 + (c - 4)] : 0.f);
        const unsigned hi = f2bf(w); const float lo = w - bf2f(hi);
        GAS bf16* WR = (GAS bf16*)(ws + WS_WR) + (size_t)l * 2 * 48 * 1024;
        WR[c * 1024 + k] = (bf16)hi; WR[48 * 1024 + c * 1024 + k] = (bf16)f2bf(lo); }
    weight_copies(a, 0, lds, tid, lane, wave, bid * 8 + wave, G * 8, bid * 512 + tid, G * 512);
}

DI void norm_row_store(const f32x4 (&v)[4], const GAS float* g, const GAS float* shift, const GAS float* scale, GAS bf16* hrow, int lane) {
    float ss = 0.f;
#pragma unroll
    for (int j = 0; j < 4; ++j) ss += (v[j].x * v[j].x + v[j].y * v[j].y) + (v[j].z * v[j].z + v[j].w * v[j].w);
    const float rstd = rsqrtf(wave_sum(ss) * (1.f / D) + EPS);
#pragma unroll
    for (int j = 0; j < 4; ++j) { const int c = 4 * lane + 256 * j;
        const f32x4 gg = *(const GAS f32x4*)(g + c), sh = *(const GAS f32x4*)(shift + c), sc = *(const GAS f32x4*)(scale + c);
        const f32x4 y = v[j] * rstd * gg * (1.f + sc) + sh;
        v2u o; o.x = pk2(y.x, y.y); o.y = pk2(y.z, y.w); *(GAS v2u*)(hrow + c) = o; }
}

struct NormPar { f32x4 w[4], sh[4]; };
DI void load_normpar(NormPar& p, const GAS float* g, const GAS float* shift, const GAS float* scale, int lane) {
#pragma unroll
    for (int j = 0; j < 4; ++j) { const int c = 4 * lane + 256 * j; const f32x4 gg = *(const GAS f32x4*)(g + c), sc = *(const GAS f32x4*)(scale + c); p.w[j] = gg * (1.f + sc); p.sh[j] = *(const GAS f32x4*)(shift + c); }
}
DI void norm_row_store_c(const f32x4 (&v)[4], const NormPar& p, GAS bf16* hrow, int lane) {
    float ss = 0.f;
#pragma unroll
    for (int j = 0; j < 4; ++j) ss += (v[j].x * v[j].x + v[j].y * v[j].y) + (v[j].z * v[j].z + v[j].w * v[j].w);
    const float rstd = rsqrtf(wave_sum(ss) * (1.f / D) + EPS);
#pragma unroll
    for (int j = 0; j < 4; ++j) { const f32x4 y = v[j] * rstd * p.w[j] + p.sh[j]; v2u o; o.x = pk2(y.x, y.y); o.y = pk2(y.z, y.w); *(GAS v2u*)(hrow + 4 * lane + 256 * j) = o; }
}

DI void phase_norm1_l0(const Ctx& a, int lane, int gw, int NGW) {
    GAS unsigned char* ws = a.ws(); GAS bf16* H = (GAS bf16*)(ws + WS_H); const GAS float* MOD = (const GAS float*)(ws + WS_MOD);
    const GAS float* xin = a.in(I_X); const GAS float* cin = a.in(I_CTX); const GAS float* n1g = a.in(I_N1G);
    const int nwg = NGW >> 3, R = (MTOK + nwg - 1) / nwg, m_beg = (gw >> 3) * R + (gw & 7), m_end = min(((gw >> 3) + 1) * R, MTOK);
    NormPar np; int cb = -1;
#pragma unroll 1
    for (int m = m_beg; m < m_end; m += 8) {
        const GAS float* src = m < NCTX ? cin + (size_t)m * D : xin + (size_t)(m - NCTX) * D;
        f32x4 v[4];
#pragma unroll
        for (int j = 0; j < 4; ++j) v[j] = *(const GAS f32x4*)(src + 4 * lane + 256 * j);
        const int b = bidx_of_row(m);
        if (b != cb) { const GAS float* mb = MOD + (size_t)b * 6144; load_normpar(np, n1g, mb, mb + 1024, lane); cb = b; }
        norm_row_store_c(v, np, H + (size_t)m * D, lane);
    }
}

DI bf16x8 ld8(const LAS bf16* p) { return *(const LAS bf16x8*)p; }
DI bf16x8 ld8(const GAS bf16* p) { return *(const GAS bf16x8*)p; }
template <class PA, class PB>
DI f32x4 mma16(PA A, int lda, PB B, int ldb, int K, int lane) {
    f32x4 acc = {0.f, 0.f, 0.f, 0.f};
    const int r = lane & 15, q = (lane >> 4) * 8;
    for (int k = 0; k < K; k += 32) {
        const bf16x8 av = ld8(A + r * lda + k + q);
        const bf16x8 bv = ld8(B + r * ldb + k + q);
        acc = __builtin_amdgcn_mfma_f32_16x16x32_bf16(av, bv, acc, 0, 0, 0);
    }
    return acc;
}

constexpr int CQ_P = 200, CKV_P = 136, STG_P = 520;
constexpr int PR = 64, PL_CQ = 0, PL_CKV = 25600, PL_RK = 43008, PL_STG = 47104, PL_T = PL_STG;
DI float rope_ang(int t, int ri) { const int ax = ri >> 4, f = ri & 7; const float p = (float)(ax == 0 ? (t >> 6) : (t & 63)); return p * __builtin_amdgcn_exp2f(-1.6609640474436813f * (float)f) * 0.15915494309189535f; }
DI void prep_unit(const Ctx& a, int l, int unit, LAS unsigned char* lds, int tid, int lane, int wave) {
    GAS unsigned char* ws = a.ws();
    const GAS bf16* P = (const GAS bf16*)(ws + WS_P);
    LAS bf16* CQ = (LAS bf16*)(lds + PL_CQ); LAS bf16* CKV = (LAS bf16*)(lds + PL_CKV); LAS bf16* STG = (LAS bf16*)(lds + PL_STG); LAS bf16* RK = (LAS bf16*)(lds + PL_RK); LAS bf16* T = (LAS bf16*)(lds + PL_T);
    const int m0 = unit * PR;
    const bool isctx = m0 < NCTX;
    const int bb = isctx ? (m0 >> 8) : ((m0 - NCTX) >> 12);
    const int pos0 = isctx ? (m0 & 255) : (256 + ((m0 - NCTX) & 4095));
    const int t0 = isctx ? 0 : ((m0 - NCTX) & 4095);
    { const GAS float* gq = a.in(I_QNG) + l * 192; const GAS float* gkv = a.in(I_KVNG) + l * 128;
        const bool isq = lane < 24, iskv = lane >= 24 && lane < 40; const int pc = isq ? lane : lane - 24;
        float gn[8];
#pragma unroll
        for (int e = 0; e < 8; ++e) gn[e] = isq ? gq[pc * 8 + e] : (iskv ? gkv[pc * 8 + e] : 0.f);
#pragma unroll
        for (int rr = 0; rr < PR / 8; ++rr) { const int r = wave * (PR / 8) + rr; float x[8];
            v4u w = (v4u){0u, 0u, 0u, 0u}; if (lane < 40) w = *(const GAS v4u*)(P + (size_t)(m0 + r) * PP + (isq ? CD_Q : CD_KV) + pc * 8);
            unpack8(w, x); float ss = 0.f;
#pragma unroll
            for (int e = 0; e < 8; ++e) ss += x[e] * x[e];
            const float sq = wave_sum(isq ? ss : 0.f), skv = wave_sum(iskv ? ss : 0.f);
            const float rs = isq ? rsqrtf(sq * (1.f / 192.f) + EPS) : rsqrtf(skv * (1.f / 128.f) + EPS);
#pragma unroll
            for (int e = 0; e < 8; ++e) x[e] *= rs * gn[e];
            const v4u o = (v4u){pk2(x[0], x[1]), pk2(x[2], x[3]), pk2(x[4], x[5]), pk2(x[6], x[7])};
            if (isq) *(LAS v4u*)(CQ + r * CQ_P + pc * 8) = o; else if (iskv) *(LAS v4u*)(CKV + r * CKV_P + pc * 8) = o; } }
    for (int e = tid; e < PR * 32; e += 512) { const int r = e >> 5, ri = e & 31; const GAS bf16* prow = P + (size_t)(m0 + r) * PP + CD_R;
        float v = bf2f(prow[ri]);
        if (!isctx) { const float pv = bf2f(prow[ri ^ 8]); const float ang = rope_ang(t0 + r, ri); const float cs = __builtin_amdgcn_cosf(ang), sn = __builtin_amdgcn_sinf(ang);
            v = ((ri >> 3) & 1) == 0 ? (v * cs - pv * sn) : (pv * sn + v * cs); }
        RK[r * 32 + ri] = (bf16)f2bf(v); }
    for (int e = tid; e < PR * 32; e += 512) { const int r = e >> 5, c8 = e & 31; *(LAS v4u*)(T + r * 264 + c8 * 8) = *(const GAS v4u*)(P + (size_t)(m0 + r) * PP + CB_V + c8 * 8); }
    __syncthreads();
    GAS bf16* QM = (GAS bf16*)(ws + WS_QM); GAS bf16* KM = (GAS bf16*)(ws + WS_KM); GAS bf16* VM = (GAS bf16*)(ws + WS_VM); GAS bf16* VNT = (GAS bf16*)(ws + WS_VNT);
    const GAS bf16* WTQ = (const GAS bf16*)(ws + WS_WTUQ + (size_t)l * 384 * 192 * 2);
    const GAS bf16* WTKV = (const GAS bf16*)(ws + WS_WTUKV + (size_t)l * 512 * 128 * 2);
    const float qs = 0.10206207261596575f * LOG2E;
    const int fr = lane & 15, fq = lane >> 4;
    for (int e = tid; e < 256 * (PR / 8); e += 512) { const int col = e / (PR / 8), p8 = e % (PR / 8); unsigned hv[8];
#pragma unroll
        for (int j = 0; j < 8; ++j) hv[j] = T[(p8 * 8 + j) * 264 + col];
        *(GAS v4u*)(VNT + ((size_t)(bb * 4) * 64 + col) * NKEY + pos0 + p8 * 8) = (v4u){hv[0] | (hv[1] << 16), hv[2] | (hv[3] << 16), hv[4] | (hv[5] << 16), hv[6] | (hv[7] << 16)}; }
    __syncthreads();
    { bf16x8 bfr[3][6];
#pragma unroll
      for (int i = 0; i < 3; ++i)
#pragma unroll
        for (int ks = 0; ks < 6; ++ks) bfr[i][ks] = *(const GAS bf16x8*)(WTQ + (size_t)((wave + 8 * i) * 16 + fr) * 192 + ks * 32 + fq * 8);
#pragma unroll
      for (int i = 0; i < 3; ++i) { const int nb = wave + 8 * i;
        const int c = nb * 16 + fr, within = c % 96;
#pragma unroll
        for (int mb = 0; mb < PR / 16; ++mb) { f32x4 acc = {0.f, 0.f, 0.f, 0.f};
#pragma unroll
            for (int ks = 0; ks < 6; ++ks) acc = __builtin_amdgcn_mfma_f32_16x16x32_bf16(*(const LAS bf16x8*)(CQ + (mb * 16 + fr) * CQ_P + ks * 32 + fq * 8), bfr[i][ks], acc, 0, 0, 0);
#pragma unroll
            for (int j = 0; j < 4; ++j) { const int r = mb * 16 + 4 * fq + j; float v = acc[j]; const float pv = __shfl_xor(v, 8);
                if (within >= 64 && !isctx) { const int ri = within - 64; const float ang = rope_ang(t0 + r, ri); const float cs = __builtin_amdgcn_cosf(ang), sn = __builtin_amdgcn_sinf(ang);
                    v = ((ri >> 3) & 1) == 0 ? (v * cs - pv * sn) : (pv * sn + v * cs); }
                STG[r * STG_P + c] = (bf16)f2bf(v * qs); } } } }
    __syncthreads();
    for (int e = tid; e < PR * 48; e += 512) { const int r = e / 48, hp = e % 48, hd = hp / 12, pc = hp % 12;
        *(GAS v4u*)(QM + ((size_t)(bb * 4 + hd) * NKEY + pos0 + r) * 96 + pc * 8) = *(const LAS v4u*)(STG + r * STG_P + hd * 96 + pc * 8); }
    __syncthreads();
    { bf16x8 bfr[4][4];
#pragma unroll
      for (int i = 0; i < 4; ++i)
#pragma unroll
        for (int ks = 0; ks < 4; ++ks) bfr[i][ks] = *(const GAS bf16x8*)(WTKV + (size_t)((wave + 8 * i) * 16 + fr) * 128 + ks * 32 + fq * 8);
#pragma unroll
      for (int i = 0; i < 4; ++i) { const int nb = wave + 8 * i;
#pragma unroll
        for (int mb = 0; mb < PR / 16; ++mb) { f32x4 acc = {0.f, 0.f, 0.f, 0.f};
#pragma unroll
            for (int ks = 0; ks < 4; ++ks) acc = __builtin_amdgcn_mfma_f32_16x16x32_bf16(*(const LAS bf16x8*)(CKV + (mb * 16 + fr) * CKV_P + ks * 32 + fq * 8), bfr[i][ks], acc, 0, 0, 0);
#pragma unroll
            for (int j = 0; j < 4; ++j) STG[(mb * 16 + 4 * fq + j) * STG_P + nb * 16 + fr] = (bf16)f2bf(acc[j]); } } }
    __syncthreads();
    for (int e = tid; e < PR * 48; e += 512) { const int r = e / 48, hp = e % 48, hd = hp / 12, pc = hp % 12;
        const v4u v = pc < 8 ? *(const LAS v4u*)(STG + r * STG_P + hd * 128 + pc * 8) : *(const LAS v4u*)(RK + r * 32 + (pc - 8) * 8);
        *(GAS v4u*)(KM + ((size_t)(bb * 4 + hd) * NKEY + pos0 + r) * 96 + pc * 8) = v; }
    for (int e = tid; e < 256 * (PR / 8); e += 512) { const int col = e / (PR / 8), p8 = e % (PR / 8), hd = col >> 6, dv = col & 63; unsigned hv[8];
#pragma unroll
        for (int j = 0; j < 8; ++j) hv[j] = STG[(p8 * 8 + j) * STG_P + hd * 128 + 64 + dv];
        *(GAS v4u*)(VM + ((size_t)(bb * 4 + hd) * 64 + dv) * NKEY + pos0 + p8 * 8) = (v4u){hv[0] | (hv[1] << 16), hv[2] | (hv[3] << 16), hv[4] | (hv[5] << 16), hv[6] | (hv[7] << 16)}; }
    __syncthreads();
}

constexpr int RP = 65;
DI int scan_row(int b, int dir, int c, int i) {
    const int s = 64 * c + i;
    if (dir == 0) return s < 256 ? b * 256 + s : NCTX + b * SEQ + (s - 256);
    return s < 256 ? b * 256 + 255 - s : NCTX + b * SEQ + SEQ - 1 - (s - 256);
}
#ifndef BAR_LDS
#define BAR_LDS() asm volatile("s_waitcnt lgkmcnt(0)\n\ts_barrier" ::: "memory")
#endif
constexpr int RC_P = 68;
constexpr int L_C = 0, L_QD = 17408, L_QE = 26624, L_KD = 35840, L_VT = 58880, L_ST = 68096, L_ATT = 77312, L_O = 86528, L_T = 103168;
template <int MIX> struct RecCfg { static constexpr int DK = MIX == 0 ? 64 : 32, DKP = DK + 8, NP = DK / 8, CPT = DK / 8; };
template <int MIX> struct RecPre {
    v4u fk;
    v4u zg[MIX == 1 ? 2 : 1];
    v4u qp;
    v4u vp; f32x4 s0, s1;
};
template <int MIX, bool R3>
DI void rec_fetch(RecPre<MIX>& R, const GAS bf16* P, const GAS float* RSbase, int b, int h, int dir, int c, int tid) {
    constexpr int DK = RecCfg<MIX>::DK;
    const int lane = tid & 63, wave = tid >> 6;
    const GAS bf16* prow = P + (size_t)scan_row(b, dir, c, lane) * PP;
    if (MIX == 0) { R.fk = *(const GAS v4u*)(prow + (dir ? CA_FB : CA_FF) + h * 64 + 8 * wave); if (R3) R.qp = *(const GAS v4u*)(prow + CA_Q + h * 64 + 8 * wave); }
    else { const GAS bf16* zr = prow + (dir ? CC_ZB : CC_ZF); R.zg[0] = *(const GAS v4u*)zr; R.zg[1] = *(const GAS v4u*)(zr + 8);
        const v2u kk = *(const GAS v2u*)(prow + CC_K + h * 32 + 4 * wave); R.fk = (v4u){kk.x, kk.y, 0u, 0u};
        if (R3) { const v2u qq = *(const GAS v2u*)(prow + CC_Q + h * 32 + 4 * wave); R.qp = (v4u){qq.x, qq.y, 0u, 0u}; } }
    R.vp = *(const GAS v4u*)(P + (size_t)scan_row(b, dir, c, tid >> 3) * PP + (MIX == 0 ? CA_I : CC_V) + h * 64 + (tid & 7) * 8);
    if (R3 && tid < DK * 8) { const GAS float* rs = RSbase + (size_t)(((b * 4 + h) * 2 + dir) * NCHUNK + c) * DK * 64 + (tid >> 3) * 64 + (tid & 7) * 8; R.s0 = *(const GAS f32x4*)rs; R.s1 = *(const GAS f32x4*)(rs + 4); }
}
DI float dpp_shr_(float v, int ctrl_sel) { const int iv = __builtin_bit_cast(int, v); int r;
    switch (ctrl_sel) { case 1: r = __builtin_amdgcn_update_dpp(0, iv, 0x111, 0xf, 0xf, true); break; case 2: r = __builtin_amdgcn_update_dpp(0, iv, 0x112, 0xf, 0xf, true); break;
                        case 4: r = __builtin_amdgcn_update_dpp(0, iv, 0x114, 0xf, 0xf, true); break; default: r = __builtin_amdgcn_update_dpp(0, iv, 0x118, 0xf, 0xf, true); break; }
    return __builtin_bit_cast(float, r); }
DI float scan64(float v) {
    v += dpp_shr_(v, 1); v += dpp_shr_(v, 2); v += dpp_shr_(v, 4); v += dpp_shr_(v, 8);
    v += __builtin_bit_cast(float, __builtin_amdgcn_update_dpp(0, __builtin_bit_cast(int, v), 0x142, 0xa, 0xf, false));
    v += __builtin_bit_cast(float, __builtin_amdgcn_update_dpp(0, __builtin_bit_cast(int, v), 0x143, 0xc, 0xf, false));
    return v; }
DI float lane_read(float v, int ln) { return __builtin_bit_cast(float, __builtin_amdgcn_readlane(__builtin_bit_cast(int, v), ln)); }
template <int MIX>
DI void rec_front(const RecPre<MIX>& R, const GAS float* lg, const GAS float* wgp, const GAS float* bgp, int l, int h, int dir, int wave, float (&kv)[RecCfg<MIX>::CPT], float (&cum)[RecCfg<MIX>::CPT]) {
    if (MIX == 0) { float z[8]; unpack8(R.fk, z);
#pragma unroll
        for (int e = 0; e < 8; ++e) { const int ch = h * 64 + 8 * wave + e; float lb = 0.f; if (l == 1) lb = sigmoid_(lg[512 + dir * 256 + ch] - lg[dir * 256 + ch]);
            const float f = lb + (1.f - lb) * sigmoid_(z[e]); cum[e] = scan64(__logf(f)); kv[e] = (1.f - lb) * sigmoid_(-z[e]); }
    } else { float z[16], kk[8]; unpack8(R.zg[0], z); unpack8(R.zg[1], z + 8); unpack8(R.fk, kk);
#pragma unroll
        for (int c = 0; c < 4; ++c) { const int ch = h * 32 + 4 * wave + c; float sacc = bgp[ch];
#pragma unroll
            for (int r = 0; r < 16; ++r) sacc += z[r] * wgp[r * 128 + ch];
            cum[c] = scan64(logsigmoid_(sacc) * (1.f / 16.f)); kv[c] = kk[c]; } }
}
template <int N> DI void st_bf16(LAS bf16* p, const float (&v)[N]) {
    if (N == 8) *(LAS v4u*)p = (v4u){pk2(v[0], v[1]), pk2(v[2], v[3]), pk2(v[4], v[5]), pk2(v[6], v[7])};
    else *(LAS v2u*)p = (v2u){pk2(v[0], v[1]), pk2(v[2], v[3])};
}
DI void rec_vt_store(const v4u vp, LAS bf16* VT, int tid) { const int j = tid >> 3, v8 = tid & 7; const unsigned ww[4] = {vp.x, vp.y, vp.z, vp.w};
#pragma unroll
    for (int e = 0; e < 8; ++e) VT[(v8 * 8 + e) * 72 + j] = (bf16)((ww[e >> 1] >> ((e & 1) * 16)) & 0xffffu); }

template <int MIX>
DI void rec_r1_run(const Ctx& a, int l, LAS unsigned char* lds, int tid, int bid, int G) {
    constexpr int DK = RecCfg<MIX>::DK, CPT = RecCfg<MIX>::CPT;
    const int lane = tid & 63, wave = __builtin_amdgcn_readfirstlane(tid >> 6);
    LAS bf16* KT = (LAS bf16*)(lds + L_KD); LAS bf16* VT = (LAS bf16*)(lds + L_VT);
    GAS unsigned char* wsb = a.ws(); const GAS bf16* P = (const GAS bf16*)(wsb + WS_P);
    GAS float* RSb = (GAS float*)(wsb + (MIX == 0 ? WS_RSH : WS_RSG)); GAS float* RAb = (GAS float*)(wsb + (MIX == 0 ? WS_RAH : WS_RAG));
    const GAS float* lg = a.in(I_LBL);
    const GAS float* wgF = a.in(I_WGF) + l * 16 * 128; const GAS float* wgB = a.in(I_WGB) + l * 16 * 128; const GAS float* bgF = a.in(I_BGF) + l * 128; const GAS float* bgB = a.in(I_BGB) + l * 128;
    constexpr int NU = 32 * NCHUNK;
    const bool rebal = (MIX == 0) && (G == 256);
    const int n0 = (rebal && bid < 16) ? 8 : 0, nn = (NU - 1 - bid) / G + 1, n1 = nn + ((rebal && bid >= 128) ? 1 : 0);
    auto unit_at = [&](int n) { if (n >= n1) return NU; if (n < nn) return bid + G * n; const int e = bid - 128; return (e & 15) + G * (e >> 4); };
    RecPre<MIX> Rs[2];
    int nidx = n0;
    int u0 = unit_at(nidx), u1 = unit_at(nidx + 1);
#pragma unroll
    for (int par = 0; par < 2; ++par) { const int unit = par ? u1 : u0; if (unit < NU) { const int c = unit % NCHUNK, chain = unit / NCHUNK; rec_fetch<MIX, false>(Rs[par], P, RSb, chain >> 3, (chain >> 1) & 3, chain & 1, c, tid); } }
    BAR_LDS();
#pragma unroll 1
    while (u0 < NU) {
        const int n2 = unit_at(nidx + 2), n3 = unit_at(nidx + 3);
#pragma unroll
        for (int par = 0; par < 2; ++par) { const int unit = par ? u1 : u0; if (unit < NU) { RecPre<MIX>& R = Rs[par];
            LAS bf16* KTp = par ? (LAS bf16*)(lds + L_ST) : KT; LAS bf16* VTp = par ? (LAS bf16*)(lds + L_ATT) : VT;
            const int c = unit % NCHUNK, chain = unit / NCHUNK, dir = chain & 1, h = (chain >> 1) & 3;
            { float kv[CPT], cum[CPT]; rec_front<MIX>(R, lg, dir ? wgB : wgF, dir ? bgB : bgF, l, h, dir, wave, kv, cum);
#pragma unroll
                for (int e = 0; e < CPT; ++e) { const float last = lane_read(cum[e], 63); KTp[(CPT * wave + e) * 72 + lane] = (bf16)f2bf(kv[e] * __expf(last - cum[e]));
                    if (lane == 63) RAb[(size_t)(chain * NCHUNK + c) * DK + CPT * wave + e] = __expf(cum[e]); } }
            rec_vt_store(R.vp, VTp, tid);
            { const int nu = par ? n3 : n2; if (nu < NU) { const int c2 = nu % NCHUNK, ch2 = nu / NCHUNK; rec_fetch<MIX, false>(R, P, RSb, ch2 >> 3, (ch2 >> 1) & 3, ch2 & 1, c2, tid); } } } }
        BAR_LDS();
#pragma unroll
        for (int par = 0; par < 2; ++par) { const int unit = par ? u1 : u0; if (unit < NU) {
            const LAS bf16* KTp = par ? (const LAS bf16*)(lds + L_ST) : KT; const LAS bf16* VTp = par ? (const LAS bf16*)(lds + L_ATT) : VT;
            const int c = unit % NCHUNK, chain = unit / NCHUNK;
            GAS float* RS = RSb + (size_t)(chain * NCHUNK + c) * DK * 64;
#pragma unroll 1
            for (int tl = wave; tl < (DK / 16) * 4; tl += 8) { const int kb = tl >> 2, vb = tl & 3;
                const f32x4 acc = mma16(KTp + kb * 16 * 72, 72, VTp + vb * 16 * 72, 72, 64, lane);
#pragma unroll
                for (int j = 0; j < 4; ++j) RS[(kb * 16 + 4 * (lane >> 4) + j) * 64 + vb * 16 + (lane & 15)] = acc[j]; } } }
        BAR_LDS();
        nidx += 2; u0 = n2; u1 = n3;
    }
}

DI void rec_r2(const Ctx& a, int gtid, int gthreads) {
    GAS unsigned char* wsb = a.ws();
#pragma unroll 1
    for (int e = gtid; e < 32 * 4096 + 32 * 2048; e += gthreads) {
        const bool g = e >= 32 * 4096; const int ee = g ? e - 32 * 4096 : e; const int DK = g ? 32 : 64, per = DK * 64;
        const int chain = ee / per, kv = ee % per, k = kv >> 6;
        GAS float* RS = (GAS float*)(wsb + (g ? WS_RSG : WS_RSH)) + (size_t)chain * NCHUNK * per + kv;
        const GAS float* RA = (const GAS float*)(wsb + (g ? WS_RAG : WS_RAH)) + (size_t)chain * NCHUNK * DK + k;
        float S = 0.f;
#pragma unroll 1
        for (int c = 0; c < NCHUNK; c += 4) { float U[4], A[4];
#pragma unroll
            for (int u = 0; u < 4; ++u) { U[u] = RS[(size_t)(c + u) * per]; A[u] = RA[(c + u) * DK]; }
#pragma unroll
            for (int u = 0; u < 4; ++u) { RS[(size_t)(c + u) * per] = S; S = A[u] * S + U[u]; } }
    }
}

template <int MIX>
DI void rec_r3_run(const Ctx& a, int l, LAS unsigned char* lds, int tid, int bid, int G, bool keep_ctx) {
    constexpr int DK = RecCfg<MIX>::DK, DKP = RecCfg<MIX>::DKP, CPT = RecCfg<MIX>::CPT;
    const int lane = tid & 63, wave = __builtin_amdgcn_readfirstlane(tid >> 6);
    LAS bf16* QD = (LAS bf16*)(lds + L_QD); LAS bf16* QE = (LAS bf16*)(lds + L_QE); LAS bf16* KD = (LAS bf16*)(lds + L_KD);
    LAS bf16* VT = (LAS bf16*)(lds + L_VT); LAS bf16* ST = (LAS bf16*)(lds + L_ST); LAS bf16* ATT = (LAS bf16*)(lds + L_ATT); LAS float* Ob = (LAS float*)(lds + L_O);
    GAS unsigned char* wsb = a.ws(); const GAS bf16* P = (const GAS bf16*)(wsb + WS_P); GAS bf16* CAT = (GAS bf16*)(wsb + WS_CAT);
    const GAS float* RSb = (const GAS float*)(wsb + (MIX == 0 ? WS_RSH : WS_RSG));
    const GAS float* lg = a.in(I_LBL); const GAS float* ngb = a.in(MIX == 0 ? I_HNG : I_GNG) + l * 256;
    const GAS float* wgF = a.in(I_WGF) + l * 16 * 128; const GAS float* wgB = a.in(I_WGB) + l * 16 * 128; const GAS float* bgF = a.in(I_BGF) + l * 128; const GAS float* bgB = a.in(I_BGB) + l * 128;
    constexpr int nR = 16 * NCHUNK;
    const int nAct = keep_ctx ? nR : 16 * 64, first = (bid + (MIX == 0 ? 0 : G - 64)) % G;
    auto unit_of = [&](int a) { return a >= nAct ? nR : (keep_ctx ? a : (a >> 6) * NCHUNK + 4 + (a & 63)); };
    auto scanc = [&](int tc, int dir) { return dir == 0 ? tc : (tc < 4 ? 3 - tc : 71 - tc); };
    RecPre<MIX> Rs[2];
    int aidx = first;
    int unit = unit_of(aidx);
    if (unit < nR) { const int tc = unit % NCHUNK, bh = unit / NCHUNK; rec_fetch<MIX, true>(Rs[0], P, RSb, bh >> 2, bh & 3, 0, scanc(tc, 0), tid); rec_fetch<MIX, true>(Rs[1], P, RSb, bh >> 2, bh & 3, 1, scanc(tc, 1), tid); }
    BAR_LDS();
#pragma unroll 1
    while (unit < nR) {
        const int tc = unit % NCHUNK, bh = unit / NCHUNK, h = bh & 3, b = bh >> 2;
        const int nunit = unit_of(aidx + G);
        v4u gatep = (v4u){0u, 0u, 0u, 0u};
#pragma unroll
        for (int dir = 0; dir < 2; ++dir) { RecPre<MIX>& R = Rs[dir];
            if (tid < DK * 8) { const int k = tid >> 3, v8 = tid & 7;
#pragma unroll
                for (int e = 0; e < 4; ++e) { ST[(v8 * 8 + e) * DKP + k] = (bf16)f2bf(R.s0[e]); ST[(v8 * 8 + 4 + e) * DKP + k] = (bf16)f2bf(R.s1[e]); } }
            rec_vt_store(R.vp, VT, tid);
            { const int ri = lane, I = ri >> 4; float kv[CPT], cm[CPT], qv[CPT], e8[CPT];
                rec_front<MIX>(R, lg, dir ? wgB : wgF, dir ? bgB : bgF, l, h, dir, wave, kv, cm);
                { float q8[8]; unpack8(R.qp, q8);
#pragma unroll
                    for (int e = 0; e < CPT; ++e) qv[e] = MIX == 0 ? silu_(q8[e]) * 0.125f : q8[e] * 0.17677669529663687f; }
#pragma unroll
                for (int e = 0; e < CPT; ++e) e8[e] = qv[e] * __expf(cm[e]);
                st_bf16<CPT>(QE + ri * DKP + CPT * wave, e8);
#pragma unroll
                for (int I2 = 0; I2 < 4; ++I2) {
                    float rf[CPT];
#pragma unroll
                    for (int e = 0; e < CPT; ++e) rf[e] = I2 == 0 ? 0.f : lane_read(cm[e], 16 * I2 - 1);
                    if (I2 >= I) {
                        if (I2 == I) {
#pragma unroll
                            for (int e = 0; e < CPT; ++e) e8[e] = qv[e] * __expf(cm[e] - rf[e]);
                            st_bf16<CPT>(QD + ri * DKP + CPT * wave, e8); }
#pragma unroll
                        for (int e = 0; e < CPT; ++e) e8[e] = kv[e] * __expf(fminf(rf[e] - cm[e], 80.f));
                        const int rowbase = I2 == 0 ? 0 : (I2 == 1 ? 16 : (I2 == 2 ? 48 : 96));
                        st_bf16<CPT>(KD + (rowbase + ri) * DKP + CPT * wave, e8); } } }
            if (dir == 0) {
                const int row = (tc < 4 ? b * 256 + tc * 64 : NCTX + b * SEQ + (tc - 4) * 64) + (tid >> 3);
                gatep = *(const GAS v4u*)(P + (size_t)row * PP + (MIX == 0 ? CA_G : CC_G) + h * 64 + (tid & 7) * 8); }
            if (nunit < nR) { const int tc2 = nunit % NCHUNK, bh2 = nunit / NCHUNK; rec_fetch<MIX, true>(R, P, RSb, bh2 >> 2, bh2 & 3, dir, scanc(tc2, dir), tid); }
            BAR_LDS();
            { const int I = wave >> 1, g = lane >> 4, c16 = lane & 15;
                const int rowbase = I == 0 ? 0 : (I == 1 ? 16 : (I == 2 ? 48 : 96));
                bf16x8 Bq[2];
#pragma unroll
                for (int m = 0; m < 2; ++m) {
                    f32x4 t0 = mma16(KD + (rowbase + 2 * m * 16) * DKP, DKP, QD + I * 16 * DKP, DKP, DK, lane);
                    f32x4 t1 = mma16(KD + (rowbase + (2 * m + 1) * 16) * DKP, DKP, QD + I * 16 * DKP, DKP, DK, lane);
#pragma unroll
                    for (int jj = 0; jj < 4; ++jj) { const bool up = 4 * g + jj > c16;
                        t0[jj] = (2 * m > I || (2 * m == I && up)) ? 0.f : t0[jj]; t1[jj] = (2 * m + 1 > I || (2 * m + 1 == I && up)) ? 0.f : t1[jj]; }
                    Bq[m] = pack8(t0[0], t0[1], t0[2], t0[3], t1[0], t1[1], t1[2], t1[3]); }
#pragma unroll
                for (int u = 0; u < 2; ++u) { const int vb = 2 * (wave & 1) + u; f32x4 acc = {0.f, 0.f, 0.f, 0.f};
#pragma unroll
                    for (int m = 0; m < 2; ++m) { const LAS bf16* vr = VT + (vb * 16 + c16) * 72 + 32 * m + 4 * g;
                        const v2u lo = *(const LAS v2u*)vr, hi = *(const LAS v2u*)(vr + 16);
                        acc = __builtin_amdgcn_mfma_f32_16x16x32_bf16(__builtin_bit_cast(bf16x8, (v4u){lo.x, lo.y, hi.x, hi.y}), Bq[m], acc, 0, 0, 0); }
                    const f32x4 acc2 = mma16(ST + vb * 16 * DKP, DKP, QE + I * 16 * DKP, DKP, DK, lane);
#pragma unroll
                    for (int jj = 0; jj < 4; ++jj) { const int i = I * 16 + c16, v = vb * 16 + 4 * g + jj; const float o = acc[jj] + acc2[jj];
                        if (dir == 0) Ob[i * RP + v] = o; else Ob[(63 - i) * RP + v] += o; } } }
            BAR_LDS();
        }
        { const int tl = tid >> 3, jg = tid & 7; float x[8]; float ss = 0.f;
#pragma unroll
            for (int vv = 0; vv < 8; ++vv) { x[vv] = Ob[tl * RP + jg * 8 + vv]; ss += x[vv] * x[vv]; }
            ss += __shfl_xor(ss, 1); ss += __shfl_xor(ss, 2); ss += __shfl_xor(ss, 4);
            const float rstd = rsqrtf(ss * (1.f / 64.f) + EPS);
            const int row = tc < 4 ? b * 256 + tc * 64 + tl : NCTX + b * SEQ + (tc - 4) * 64 + tl;
            const GAS float* ng = ngb + h * 64 + jg * 8;
            float gt[8]; unpack8(gatep, gt);
            float y[8];
#pragma unroll
            for (int vv = 0; vv < 8; ++vv) y[vv] = x[vv] * rstd * ng[vv] * silu_(gt[vv]);
            v4u ow; ow.x = pk2(y[0], y[1]); ow.y = pk2(y[2], y[3]); ow.z = pk2(y[4], y[5]); ow.w = pk2(y[6], y[7]);
            *(GAS v4u*)(CAT + (size_t)row * D + (MIX == 0 ? 0 : 512) + h * 64 + jg * 8) = ow; }
        unit = nunit; aidx += G;
    }
    __syncthreads();
}

typedef float f32x16 __attribute__((ext_vector_type(16)));
DI int swap23(int r) { return (r & 19) | ((r & 4) << 1) | ((r & 8) >> 1); }
struct AttnDesc {
    const GAS bf16* q; int qpitch;
    const GAS bf16* k; int kpitch;
    const GAS bf16* vt;
    GAS bf16* o; int opitch;
    int ntiles; float scale;
    int b, r0, rs0;
    const LAS float* rpb;
};
template <int DQK, bool NA>
DI void attn_mfma_unit(LAS unsigned char* lds, const AttnDesc& A, int tid, int lane, int wave) {
    constexpr int KP = DQK + 8, VP = 72, NS = DQK / 16, KPIECES = 64 * (DQK / 8);
    constexpr int BUF = 64 * KP * 2 + 64 * VP * 2;
    const int q = lane & 31, g = lane >> 5;
    auto tpos = [&](int t) { return NA ? (t < 4 ? 64 * t : 256 + 64 * (A.rs0 + t - 4)) : 64 * t; };
    auto krow = [&](int pos) { return NA ? (pos < 256 ? A.b * 256 + pos : NCTX + A.b * SEQ + (pos - 256)) : pos; };
    const int qi = NA ? (2 * (wave >> 2) + (q >> 4)) * 64 + 16 * (wave & 3) + (q & 15) : wave * 32 + q;
    const int kc0 = NA ? min(max(16 * (wave & 3) - 8, 0), 32) : 0;
    bf16x8 Qf[NS];
    { const GAS bf16* qp = A.q + (size_t)qi * A.qpitch + 8 * g;
#pragma unroll
        for (int s2 = 0; s2 < NS; ++s2) Qf[s2] = *(const GAS bf16x8*)(qp + 16 * s2); }
    f32x16 O[2];
#pragma unroll
    for (int db = 0; db < 2; ++db)
#pragma unroll
        for (int i = 0; i < 16; ++i) O[db][i] = 0.f;
    float mrun = -1e30f, lrun = 0.f;
    const int qr = NA ? A.r0 + (qi >> 6) : 0, qc = NA ? (qi & 63) : 0;
    const int wrs = NA ? min(max(qr - 4, 0), 56) : 0, cs = NA ? min(max(qc - 8, 0), 48) : 0;
    const int qr0 = NA ? A.r0 + 2 * (wave >> 2) : 0, wlo = NA ? min(max(qr0 - 4, 0), 56) : 0, whi = NA ? min(max(qr0 + 1 - 4, 0), 56) + 8 : 0;
    v4u kreg[2], vreg;
    auto gload = [&](int t) { const int pos = tpos(t);
#pragma unroll
        for (int u = 0; u < 2; ++u) { const int p = tid + 512 * u; if (p < KPIECES) { const int key = p / (DQK / 8), d8 = p % (DQK / 8); kreg[u] = *(const GAS v4u*)(A.k + (size_t)krow(pos + key) * A.kpitch + d8 * 8); } }
        vreg = *(const GAS v4u*)(A.vt + (size_t)(tid >> 3) * NKEY + pos + (tid & 7) * 8); };
    auto lstore = [&](int buf) { LAS bf16* Kt = (LAS bf16*)(lds + buf * BUF); LAS bf16* Vt = Kt + 64 * KP;
#pragma unroll
        for (int u = 0; u < 2; ++u) { const int p = tid + 512 * u; if (p < KPIECES) { const int key = p / (DQK / 8), d8 = p % (DQK / 8); *(LAS v4u*)(Kt + key * KP + d8 * 8) = kreg[u]; } }
        *(LAS v4u*)(Vt + (tid >> 3) * VP + (tid & 7) * 8) = vreg; };
    __syncthreads();
    gload(0); lstore(0);
    __syncthreads();
#pragma unroll 1
    for (int t = 0; t < A.ntiles; ++t) {
        const bool more = t + 1 < A.ntiles;
        if (more) gload(t + 1);
        bool active = true, rowok = true; int dr = 0;
        const bool win = NA && t >= 4;
        if (win) { const int wr = A.rs0 + t - 4; active = (wr >= wlo) && (wr < whi); rowok = (wr >= wrs) && (wr < wrs + 8); dr = min(max(wr - qr + 7, 0), 14); }
        if (active) {
            const LAS bf16* Kt = (const LAS bf16*)(lds + (t & 1) * BUF); const LAS bf16* Vt = Kt + 64 * KP;
            f32x16 S[2];
#pragma unroll
            for (int kb = 0; kb < 2; ++kb) {
#pragma unroll
                for (int i = 0; i < 16; ++i) S[kb][i] = 0.f;
                if (win && kb == 1) continue;
                const LAS bf16* kp = Kt + ((win ? kc0 : kb * 32) + swap23(q)) * KP + 8 * g;
#pragma unroll
                for (int s2 = 0; s2 < NS; ++s2) { const bf16x8 a = *(const LAS bf16x8*)(kp + 16 * s2); S[kb] = __builtin_amdgcn_mfma_f32_32x32x16_bf16(a, Qf[s2], S[kb], 0, 0, 0); }
            }
            float mx = -INFINITY;
            if (NA) {
                if (win) {
#pragma unroll
                    for (int i = 0; i < 16; ++i) { const int kc = kc0 + 16 * (i >> 3) + 8 * g + (i & 7); const int dc = min(max(kc - qc, -15), 15) + 15;
                        const float bv = A.rpb[dr * 31 + dc]; const float sv = (rowok && kc >= cs && kc < cs + 16) ? S[0][i] * A.scale + bv : -INFINITY;
                        S[0][i] = sv; mx = fmaxf(mx, sv); }
                } else {
#pragma unroll
                    for (int kb = 0; kb < 2; ++kb)
#pragma unroll
                        for (int i = 0; i < 16; ++i) { const float sv = S[kb][i] * A.scale; S[kb][i] = sv; mx = fmaxf(mx, sv); }
                }
            } else {
#pragma unroll
                for (int kb = 0; kb < 2; ++kb)
#pragma unroll
                    for (int i = 0; i < 16; ++i) mx = fmaxf(mx, S[kb][i]);
            }
            mx = fmaxf(mx, __shfl_xor(mx, 32));
            const float mn = fmaxf(mrun, mx), alpha = __builtin_amdgcn_exp2f(mrun - mn);
            mrun = mn;
            if (__any(alpha != 1.f)) { lrun *= alpha;
#pragma unroll
                for (int db = 0; db < 2; ++db)
#pragma unroll
                    for (int i = 0; i < 16; ++i) O[db][i] *= alpha; }
            bf16x8 Pf[4];
#pragma unroll
            for (int ks = 0; ks < 4; ++ks) { if (win && ks >= 2) continue; const int kb = ks >> 1, o8 = (ks & 1) * 8; float p[8];
#pragma unroll
                for (int j = 0; j < 8; ++j) { p[j] = __builtin_amdgcn_exp2f(S[kb][o8 + j] - mn); lrun += p[j]; }
                Pf[ks] = pack8(p[0], p[1], p[2], p[3], p[4], p[5], p[6], p[7]); }
#pragma unroll
            for (int db = 0; db < 2; ++db) { const LAS bf16* vp = Vt + (db * 32 + q) * VP + (win ? kc0 : 0) + 8 * g;
#pragma unroll
                for (int ks = 0; ks < 4; ++ks) { if (win && ks >= 2) continue; const bf16x8 a = *(const LAS bf16x8*)(vp + 16 * ks); O[db] = __builtin_amdgcn_mfma_f32_32x32x16_bf16(a, Pf[ks], O[db], 0, 0, 0); } }
        }
        if (more) lstore((t + 1) & 1);
        __syncthreads();
    }
    const float ltot = lrun + __shfl_xor(lrun, 32), inv = 1.f / ltot;
    GAS bf16* op = A.o + (size_t)qi * A.opitch + 4 * g;
#pragma unroll
    for (int db = 0; db < 2; ++db)
#pragma unroll
        for (int i4 = 0; i4 < 4; ++i4) { v2u w; w.x = pk2(O[db][4 * i4] * inv, O[db][4 * i4 + 1] * inv); w.y = pk2(O[db][4 * i4 + 2] * inv, O[db][4 * i4 + 3] * inv); *(GAS v2u*)(op + 32 * db + 8 * i4) = w; }
}

constexpr float MLA_TH = 8.f;
constexpr int NA_SLOT = 2 * 64 * 72 * 2, NA_RPB = 4 * NA_SLOT;
DI void na_unit(LAS unsigned char* lds, const AttnDesc& A, const GAS float* rp, int tid, int lane, int wave) {
    constexpr int KP = 72, VP = 72, NS = 4, KBUF = 64 * KP * 2;
    const int q = lane & 31, g = lane >> 5, NT = A.ntiles;
    auto tpos = [&](int t) { return t < 4 ? 64 * t : 256 + 64 * (A.rs0 + t - 4); };
    auto krow = [&](int pos) { return pos < 256 ? A.b * 256 + pos : NCTX + A.b * SEQ + (pos - 256); };
    const int qi = (2 * (wave >> 2) + (q >> 4)) * 64 + 16 * (wave & 3) + (q & 15);
    const int kc0 = min(max(16 * (wave & 3) - 8, 0), 32);
    bf16x8 Qf[NS];
    { const GAS bf16* qp = A.q + (size_t)qi * A.qpitch + 8 * g;
#pragma unroll
        for (int s2 = 0; s2 < NS; ++s2) Qf[s2] = *(const GAS bf16x8*)(qp + 16 * s2); }
    f32x16 O[2];
#pragma unroll
    for (int db = 0; db < 2; ++db)
#pragma unroll
        for (int i = 0; i < 16; ++i) O[db][i] = 0.f;
    float mrun = -1e30f, lrun = 0.f;
    const int qr = A.r0 + (qi >> 6), qc = qi & 63;
    const int wrs = min(max(qr - 4, 0), 56), cs = min(max(qc - 8, 0), 48);
    const int qr0 = A.r0 + 2 * (wave >> 2), wlo = min(max(qr0 - 4, 0), 56), whi = min(max(qr0 + 1 - 4, 0), 56) + 8;
    auto koffs = [&](int i) { const int j = i * 64 + lane, row = j / 9, pc = min(j % 9, 7); return (unsigned)(row * (PP * 2) + pc * 16); };
    auto voffs = [&](int i) { const int j = i * 64 + lane, row = j / 9, pc = min(j % 9, 7); return (unsigned)(row * (NKEY * 2) + pc * 16); };
    const int iv1 = wave == 0 ? 0 : wave - 1, iv2 = wave < 2 ? 7 + wave : iv1;
    const unsigned goff0 = koffs(wave), goff1 = wave == 0 ? koffs(8) : voffs(iv1), goff2 = voffs(iv2);
    auto dma = [&](int t, int slot) __attribute__((always_inline)) { const int pos = tpos(t);
        const GAS unsigned char* kb = (const GAS unsigned char*)(A.k + (size_t)krow(pos) * A.kpitch); const GAS unsigned char* vb = (const GAS unsigned char*)(A.vt + pos);
        LAS unsigned char* kl = lds + slot * NA_SLOT; LAS unsigned char* vl = kl + KBUF;
        __builtin_amdgcn_global_load_lds((const GAS unsigned*)(kb + goff0), (LAS unsigned*)(kl + wave * 1024), 16, 0, 0);
        __builtin_amdgcn_global_load_lds((const GAS unsigned*)((wave == 0 ? kb : vb) + goff1), (LAS unsigned*)(wave == 0 ? kl + 8 * 1024 : vl + iv1 * 1024), 16, 0, 0);
        __builtin_amdgcn_global_load_lds((const GAS unsigned*)(vb + goff2), (LAS unsigned*)(vl + iv2 * 1024), 16, 0, 0);
    };
    LAS float* T = (LAS float*)(lds + NA_RPB);
    float tv[4];
#pragma unroll
    for (int u = 0; u < 4; ++u) { const int e = tid + 512 * u, r = e >> 7, dcr = (e & 127) - 64; const bool in = r < 15 && dcr >= -15 && dcr <= 15;
        tv[u] = in ? rp[r * 31 + dcr + 15] * LOG2E : (r == 15 ? -INFINITY : 0.f); }
    float mcol[16];
#pragma unroll
    for (int i = 0; i < 16; ++i) { const int kc = kc0 + 16 * (i >> 3) + 8 * g + (i & 7); mcol[i] = (kc >= cs && kc < cs + 16) ? 0.f : -INFINITY; }
    __syncthreads();
    dma(0, 0); dma(min(1, NT - 1), 1); dma(min(2, NT - 1), 2);
#pragma unroll
    for (int u = 0; u < 4; ++u) T[tid + 512 * u] = tv[u];
    asm volatile("s_waitcnt vmcnt(6)\n\ts_waitcnt lgkmcnt(0)\n\ts_barrier" ::: "memory");
#pragma unroll 1
    for (int t = 0; t < NT; ++t) {
        dma(min(t + 3, NT - 1), (t + 3) & 3);
        bool active = true, rowok = true; int dr = 0;
        const bool win = t >= 4;
        if (win) { const int wr = A.rs0 + t - 4; active = (wr >= wlo) && (wr < whi); rowok = (wr >= wrs) && (wr < wrs + 8); dr = min(max(wr - qr + 7, 0), 14); }
        if (active) {
            const LAS bf16* Kt = (const LAS bf16*)(lds + (t & 3) * NA_SLOT); const LAS bf16* Vt = Kt + 64 * KP;
            f32x16 S[2];
#pragma unroll
            for (int kb = 0; kb < 2; ++kb) {
#pragma unroll
                for (int i = 0; i < 16; ++i) S[kb][i] = 0.f;
                if (win && kb == 1) continue;
                const LAS bf16* kp = Kt + ((win ? kc0 : kb * 32) + swap23(q)) * KP + 8 * g;
#pragma unroll
                for (int s2 = 0; s2 < NS; ++s2) { const bf16x8 a = *(const LAS bf16x8*)(kp + 16 * s2); S[kb] = __builtin_amdgcn_mfma_f32_32x32x16_bf16(a, Qf[s2], S[kb], 0, 0, 0); }
            }
            float mx = -INFINITY;
            if (win) { const LAS float* tb = T + (rowok ? dr : 15) * 128 + (kc0 + 8 * g - qc + 64);
#pragma unroll
                for (int i = 0; i < 16; ++i) { const float sv = (S[0][i] * A.scale + tb[16 * (i >> 3) + (i & 7)]) + mcol[i]; S[0][i] = sv; mx = fmaxf(mx, sv); }
            } else {
#pragma unroll
                for (int kb = 0; kb < 2; ++kb)
#pragma unroll
                    for (int i = 0; i < 16; ++i) { const float sv = S[kb][i] * A.scale; S[kb][i] = sv; mx = fmaxf(mx, sv); }
            }
            if (__any(mx > mrun + MLA_TH)) { const float mf = fmaxf(mx, __shfl_xor(mx, 32)), mn = fmaxf(mrun, mf), alpha = __builtin_amdgcn_exp2f(mrun - mn);
                mrun = mn; lrun *= alpha;
#pragma unroll
                for (int db = 0; db < 2; ++db)
#pragma unroll
                    for (int i = 0; i < 16; ++i) O[db][i] *= alpha; }
            bf16x8 Pf[4];
#pragma unroll
            for (int ks = 0; ks < 4; ++ks) { if (win && ks >= 2) continue; const int kb = ks >> 1, o8 = (ks & 1) * 8; float p[8];
#pragma unroll
                for (int j = 0; j < 8; ++j) { p[j] = __builtin_amdgcn_exp2f(S[kb][o8 + j] - mrun); lrun += p[j]; }
                Pf[ks] = pack8(p[0], p[1], p[2], p[3], p[4], p[5], p[6], p[7]); }
#pragma unroll
            for (int db = 0; db < 2; ++db) { const LAS bf16* vp = Vt + (db * 32 + q) * VP + (win ? kc0 : 0) + 8 * g;
#pragma unroll
                for (int ks = 0; ks < 4; ++ks) { if (win && ks >= 2) continue; const bf16x8 a = *(const LAS bf16x8*)(vp + 16 * ks); O[db] = __builtin_amdgcn_mfma_f32_32x32x16_bf16(a, Pf[ks], O[db], 0, 0, 0); } }
        }
        asm volatile("s_waitcnt vmcnt(6)\n\ts_waitcnt lgkmcnt(0)\n\ts_barrier" ::: "memory");
    }
    asm volatile("s_waitcnt vmcnt(0)" ::: "memory");
    const float ltot = lrun + __shfl_xor(lrun, 32), inv = 1.f / ltot;
    GAS bf16* op = A.o + (size_t)qi * A.opitch + 4 * g;
#pragma unroll
    for (int db = 0; db < 2; ++db)
#pragma unroll
        for (int i4 = 0; i4 < 4; ++i4) { v2u w; w.x = pk2(O[db][4 * i4] * inv, O[db][4 * i4 + 1] * inv); w.y = pk2(O[db][4 * i4 + 2] * inv, O[db][4 * i4 + 3] * inv); *(GAS v2u*)(op + 32 * db + 8 * i4) = w; }
}

struct TagF { static constexpr bool value = false; }; struct TagT { static constexpr bool value = true; };
#define SGB(mask, n) __builtin_amdgcn_sched_group_barrier(mask, n, 0)
DI void mla_unit(LAS unsigned char* lds, const AttnDesc& A, int tid, int lane, int wave) {
    constexpr int KP = 104, VP = 72, NS = 6, KBUF = 64 * KP * 2, VBUF = 64 * VP * 2;
    const int q = lane & 31, g = lane >> 5, NT = A.ntiles;
    bf16x8 Qf[NS];
    { const GAS bf16* qp = A.q + (size_t)(wave * 32 + q) * A.qpitch + 8 * g;
#pragma unroll
        for (int s2 = 0; s2 < NS; ++s2) Qf[s2] = *(const GAS bf16x8*)(qp + 16 * s2); }
    f32x16 O[2], Cm;
#pragma unroll
    for (int i = 0; i < 16; ++i) { O[0][i] = 0.f; O[1][i] = 0.f; Cm[i] = 0.f; }
    float lrun = 0.f;
    auto koffs = [&](int i) { const int j = i * 64 + lane, row = j / 13, pc = min(j % 13, 11); return (unsigned)(row * 192 + pc * 16); };
    auto voffs = [&](int i) { const int j = i * 64 + lane, row = j / 9, pc = min(j % 9, 7); return (unsigned)(row * (NKEY * 2) + pc * 16); };
    const int i2 = min(wave + 3, 8);
    const unsigned goff0 = koffs(wave), goff1 = wave < 5 ? koffs(wave + 8) : voffs(wave - 5), goff2 = voffs(i2);
    auto dma = [&](int tk, int ks, int tv, int vs) __attribute__((always_inline)) {
        const GAS unsigned char* kb = (const GAS unsigned char*)A.k + (size_t)tk * (64 * 96 * 2); const GAS unsigned char* vb = (const GAS unsigned char*)A.vt + (size_t)tv * 128;
        LAS unsigned char* kl = lds + ks * KBUF; LAS unsigned char* vl = lds + 2 * KBUF + vs * VBUF;
        __builtin_amdgcn_global_load_lds((const GAS unsigned*)(kb + goff0), (LAS unsigned*)(kl + wave * 1024), 16, 0, 0);
        __builtin_amdgcn_global_load_lds((const GAS unsigned*)((wave < 5 ? kb : vb) + goff1), (LAS unsigned*)(wave < 5 ? kl + (wave + 8) * 1024 : vl + (wave - 5) * 1024), 16, 0, 0);
        __builtin_amdgcn_global_load_lds((const GAS unsigned*)(vb + goff2), (LAS unsigned*)(vl + i2 * 1024), 16, 0, 0);
    };
    auto qk = [&](f32x16& S0, f32x16& S1, int buf) __attribute__((always_inline)) {
        const LAS bf16* kp = (const LAS bf16*)(lds + buf * KBUF) + swap23(q) * KP + 8 * g;
        S0 = __builtin_amdgcn_mfma_f32_32x32x16_bf16(*(const LAS bf16x8*)kp, Qf[0], Cm, 0, 0, 0);
#pragma unroll
        for (int s2 = 1; s2 < NS; ++s2) S0 = __builtin_amdgcn_mfma_f32_32x32x16_bf16(*(const LAS bf16x8*)(kp + 16 * s2), Qf[s2], S0, 0, 0, 0);
        S1 = __builtin_amdgcn_mfma_f32_32x32x16_bf16(*(const LAS bf16x8*)(kp + 32 * KP), Qf[0], Cm, 0, 0, 0);
#pragma unroll
        for (int s2 = 1; s2 < NS; ++s2) S1 = __builtin_amdgcn_mfma_f32_32x32x16_bf16(*(const LAS bf16x8*)(kp + 32 * KP + 16 * s2), Qf[s2], S1, 0, 0, 0);
    };
    auto smax = [&](const f32x16& S0, const f32x16& S1) __attribute__((always_inline)) { float mx = fmaxf(S0[0], S0[1]);
#pragma unroll
        for (int i = 2; i < 16; ++i) mx = fmaxf(mx, S0[i]);
#pragma unroll
        for (int i = 0; i < 16; ++i) mx = fmaxf(mx, S1[i]);
        return mx; };
    auto rebase = [&](f32x16& S0, f32x16& S1, float mx) __attribute__((always_inline)) {
        const float mf = fmaxf(mx, __shfl_xor(mx, 32)), d = fmaxf(mf, 0.f), alpha = __builtin_amdgcn_exp2f(-d);
        lrun *= alpha;
#pragma unroll
        for (int i = 0; i < 16; ++i) { O[0][i] *= alpha; O[1][i] *= alpha; S0[i] -= d; S1[i] -= d; Cm[i] -= d; }
        asm volatile("" : "+v"(Cm));
    };
    auto softmax_p = [&](const f32x16& S0, const f32x16& S1, bf16x8 (&Pf)[4]) __attribute__((always_inline)) {
#pragma unroll
        for (int ks = 0; ks < 4; ++ks) { const int o8 = (ks & 1) * 8; float p[8];
#pragma unroll
            for (int j = 0; j < 8; ++j) { p[j] = __builtin_amdgcn_exp2f(ks < 2 ? S0[o8 + j] : S1[o8 + j]); lrun += p[j]; }
            Pf[ks] = pack8(p[0], p[1], p[2], p[3], p[4], p[5], p[6], p[7]); }
    };
    auto pv = [&](const bf16x8 (&Pf)[4], int buf) __attribute__((always_inline)) {
        const LAS bf16* vp = (const LAS bf16*)(lds + 2 * KBUF + buf * VBUF) + q * VP + 8 * g;
#pragma unroll
        for (int ks = 0; ks < 4; ++ks)
#pragma unroll
            for (int db = 0; db < 2; ++db) O[db] = __builtin_amdgcn_mfma_f32_32x32x16_bf16(*(const LAS bf16x8*)(vp + db * 32 * VP + 16 * ks), Pf[ks], O[db], 0, 0, 0);
    };
    f32x16 Sa[2], Sb[2];
    __syncthreads();
    dma(0, 0, 0, 0); dma(1, 1, 0, 0);
    asm volatile("s_waitcnt vmcnt(0)" ::: "memory");
    __syncthreads();
    qk(Sa[0], Sa[1], 0);
    { const float mx = smax(Sa[0], Sa[1]); const float mf = fmaxf(mx, __shfl_xor(mx, 32));
#pragma unroll
        for (int i = 0; i < 16; ++i) { Sa[0][i] -= mf; Sa[1][i] -= mf; Cm[i] = -mf; }
        asm volatile("" : "+v"(Cm)); }
    __syncthreads();
    auto step = [&](f32x16 (&Sc)[2], f32x16 (&Sn)[2], const int t, auto par) __attribute__((always_inline)) {
        constexpr int PAR = decltype(par)::value ? 1 : 0;
        dma(min(t + 2, NT - 1), PAR, min(t + 1, NT - 1), PAR ^ 1);
        __builtin_amdgcn_sched_barrier(0);
        bf16x8 Pf[4];
        qk(Sn[0], Sn[1], PAR ^ 1);
        softmax_p(Sc[0], Sc[1], Pf);
        pv(Pf, PAR);
        const float mx = smax(Sn[0], Sn[1]);
        SGB(0x100, 3);
#pragma unroll
        for (int m = 0; m < 16; ++m) { SGB(0x008, 1); SGB(0x100, 1); SGB(0x400, 2); SGB(0x002, 3); }
#pragma unroll
        for (int m = 0; m < 4; ++m) { SGB(0x008, 1); SGB(0x100, 1); SGB(0x002, 5); }
        if (__any(mx > MLA_TH)) rebase(Sn[0], Sn[1], mx);
        asm volatile("s_waitcnt vmcnt(0)" ::: "memory");
        __syncthreads();
    };
#pragma unroll 1
    for (int t = 0; t < NT - 2; t += 2) { step(Sa, Sb, t, TagF{}); step(Sb, Sa, t + 1, TagT{}); }
    step(Sa, Sb, NT - 2, TagF{});
    { bf16x8 Pf[4]; softmax_p(Sb[0], Sb[1], Pf); pv(Pf, (NT - 1) & 1); }
    const float ltot = lrun + __shfl_xor(lrun, 32), inv = 1.f / ltot;
    GAS bf16* op = A.o + (size_t)(wave * 32 + q) * A.opitch + 4 * g;
#pragma unroll
    for (int db = 0; db < 2; ++db)
#pragma unroll
        for (int i4 = 0; i4 < 4; ++i4) { v2u w; w.x = pk2(O[db][4 * i4] * inv, O[db][4 * i4 + 1] * inv); w.y = pk2(O[db][4 * i4 + 2] * inv, O[db][4 * i4 + 3] * inv); *(GAS v2u*)(op + 32 * db + 8 * i4) = w; }
}

DI int moe_tables(const GAS unsigned* cnt  , LAS int* off, LAS int* tile_e, int tid) {
    if (tid == 0) { int o = 0; for (int e = 0; e < 32; ++e) { off[e] = o; o += ((int)cnt[e * 64] + 255) & ~255; } off[32] = o; }
    __syncthreads();
    if (tid < MOE_MAXT) { const int r = tid * 256; int ex = 0; for (int e = 0; e < 32; ++e) if (r >= off[e + 1]) ex = e + 1; tile_e[tid] = ex < 32 ? ex : 31; }
    __syncthreads();
    return off[32] >> 8;
}

#define TIDS const int tid = threadIdx.x, lane = tid & 63, wave = __builtin_amdgcn_readfirstlane(tid >> 6), bid = blockIdx.x, G = gridDim.x, gw = bid * 8 + wave, NGW = G * 8; (void)lane; (void)gw; (void)NGW
DI void ph_gemm_in(const Ctx& cx, int l) {
    TIDS; GAS unsigned char* ws = cx.ws(); LAS unsigned char* lds = (LAS unsigned char*)lds_raw;
    pg8::Gemm g{(const GAS bf16*)(ws + WS_H), (const GAS bf16*)(ws + WS_WTIN + (size_t)l * WTIN_L), MTOK, PP, D}; pg8::StaticOrder S; S.init(MTOK, PP, G, bid);
    pg8::EpiStoreBf16 E{(GAS bf16*)(ws + WS_P), PP};
    pg8::gemm_phase(lds, g, S, E);
}
DI void ph_prep_r1(const Ctx& cx, int l) {
    TIDS; LAS unsigned char* lds = (LAS unsigned char*)lds_raw;
#pragma unroll 1
    for (int u = bid; u < MTOK / PR; u += G) prep_unit(cx, l, u, lds, tid, lane, wave);
    __syncthreads();
    rec_r1_run<0>(cx, l, lds, tid, bid, G); rec_r1_run<1>(cx, l, lds, tid, bid, G);
    __syncthreads();
}
DI void ph_mixers(const Ctx& cx, int l) {
    TIDS; GAS unsigned char* ws = cx.ws(); LAS unsigned char* lds = (LAS unsigned char*)lds_raw;
    const bool keep_ctx = (l == 0);
    GAS bf16* CAT = (GAS bf16*)(ws + WS_CAT); const GAS bf16* P = (const GAS bf16*)(ws + WS_P);
    const int nATT = 256 + (keep_ctx ? 16 : 0), nR = 16 * NCHUNK;
    const int vc = (G % 8 == 0) ? (bid % 8) * (G / 8) + bid / 8 : bid;
    const bool r3first = ((bid >> 3) & 1) != 0;
    if (r3first) { rec_r3_run<0>(cx, l, lds, tid, bid, G, keep_ctx); rec_r3_run<1>(cx, l, lds, tid, bid, G, keep_ctx); __syncthreads(); }
#pragma unroll 1
    for (int it = 0; it < 2; ++it) { const int u = it == 0 ? vc : (G == 256 && bid >= 128 && bid < 144 ? 256 + bid - 128 : (G == 256 ? nATT : bid + G)); if (u >= nATT) continue;
        const GAS bf16* QM = (const GAS bf16*)(ws + WS_QM); const GAS bf16* KM = (const GAS bf16*)(ws + WS_KM); const GAS bf16* VM = (const GAS bf16*)(ws + WS_VM);
        AttnDesc A{}; int bh, b, h;
        if (u < 256) { bh = u >> 4; b = bh >> 2; h = bh & 3; const int qb = u & 15; A.q = QM + ((size_t)bh * NKEY + 256 + qb * 256) * 96; A.ntiles = NKEY / 64; A.o = CAT + (size_t)(NCTX + b * SEQ + qb * 256) * D + 768 + h * 64; }
        else { bh = u - 256; b = bh >> 2; h = bh & 3; A.q = QM + (size_t)bh * NKEY * 96; A.ntiles = 4; A.o = CAT + (size_t)(b * 256) * D + 768 + h * 64; }
        A.qpitch = 96; A.k = KM + (size_t)bh * NKEY * 96; A.kpitch = 96; A.vt = VM + (size_t)bh * 64 * NKEY; A.opitch = D; A.scale = 1.f;
        mla_unit(lds, A, tid, lane, wave);
    }
#pragma unroll 1
    for (int it = 0; it < 2; ++it) { const int u = it == 0 ? vc : (G == 256 && bid >= 160 && bid < 176 ? 256 + bid - 160 : (G == 256 ? nATT : bid + G)); if (u >= nATT) continue;
        LAS float* rpb = (LAS float*)(lds + NA_RPB);
        AttnDesc A{}; int bh, b, h; size_t qrow;
        if (u < 256) { bh = u >> 4; b = bh >> 2; h = bh & 3; const int rq = u & 15; A.r0 = rq * 4; A.rs0 = min(max(A.r0 - 4, 0), 56); const int rsl = min(max(A.r0 + 3 - 4, 0), 56);
            A.ntiles = 4 + (rsl + 8 - A.rs0); qrow = (size_t)NCTX + b * SEQ + A.r0 * 64; }
        else { bh = u - 256; b = bh >> 2; h = bh & 3; A.ntiles = 4; qrow = (size_t)b * 256; }
        const GAS float* rp = cx.in(I_RPB) + (size_t)(l * 4 + h) * 465;
        A.q = P + qrow * PP + CB_Q + h * 64; A.qpitch = PP; A.k = P + CB_K + h * 64; A.kpitch = PP; A.vt = (const GAS bf16*)(ws + WS_VNT) + (size_t)bh * 64 * NKEY;
        A.o = CAT + qrow * D + 256 + h * 64; A.opitch = D; A.scale = 0.125f * LOG2E; A.b = b; A.rpb = rpb;
        na_unit(lds, A, rp, tid, lane, wave);
    }
    __syncthreads();
    if (!r3first) { rec_r3_run<0>(cx, l, lds, tid, bid, G, keep_ctx); rec_r3_run<1>(cx, l, lds, tid, bid, G, keep_ctx); }
}
DI void ph_gemm_out(const Ctx& cx, int l) {
    TIDS; GAS unsigned char* ws = cx.ws(); LAS unsigned char* lds = (LAS unsigned char*)lds_raw;
    const int roff = (l == 0) ? 0 : NCTX, Mg = MTOK - roff;
    pg8::Gemm g{(const GAS bf16*)(ws + WS_CAT) + (size_t)roff * D, (const GAS bf16*)(ws + WS_WTOUT + (size_t)l * D * D * 2), Mg, D, D}; pg8::StaticOrder S; S.init(Mg, D, G, bid);
    pg8::EpiResid E{(GAS pg8::bf16_t*)(ws + WS_X), roff, (const GAS float*)(ws + WS_MOD) + (size_t)l * 5 * 6144 + 2 * 1024, l == 0 ? cx.in(I_CTX) : (const GAS float*)nullptr, l == 0 ? cx.in(I_X) : (const GAS float*)nullptr};
    pg8::gemm_phase(lds, g, S, E);
    if (l == 0) { const int nbusy = (Mg / 256) * (D / 256) - G;
        if (nbusy >= 0 && nbusy < G && bid >= nbusy) { __syncthreads(); weight_copies(cx, 1, lds, tid, lane, wave, (bid - nbusy) * 8 + wave, (G - nbusy) * 8, (bid - nbusy) * 512 + tid, (G - nbusy) * 512); } }
}
DI void ph_router(const Ctx& cx, int l) {
    TIDS; GAS unsigned char* ws = cx.ws(); LAS unsigned char* lds = (LAS unsigned char*)lds_raw;
    const int m_lo = (l == 0) ? 0 : NCTX;
    const GAS bf16* X = (const GAS bf16*)(ws + WS_X); GAS bf16* H = (GAS bf16*)(ws + WS_H); const GAS float* MOD = (const GAS float*)(ws + WS_MOD) + (size_t)l * 5 * 6144;
    GAS int* EID = (GAS int*)(ws + WS_MOE); GAS float* GATE = (GAS float*)(ws + WS_MOE) + MTOK * 2; GAS int* POS = (GAS int*)(ws + WS_MOE) + MTOK * 4;
    GAS unsigned* cnt = (GAS unsigned*)(ws + WS_CTL) + CW_CNT + l * 32 * 64; GAS int* RIDX = (GAS int*)(ws + WS_RIDX);
    const GAS bf16* WRh = (const GAS bf16*)(ws + WS_WR) + (size_t)l * 2 * 48 * 1024; const GAS bf16* WRl = WRh + 48 * 1024;
    const GAS float* n2g = cx.in(I_N2G) + l * D; const GAS float* brg = cx.in(I_BRG) + l * 4; const GAS float* bre = cx.in(I_BRE) + l * 32;
    constexpr int AP = 136;
    LAS bf16* Ah = (LAS bf16*)(lds + wave * 12288); LAS bf16* Al = Ah + 16 * AP; LAS float* LG = (LAS float*)(lds + wave * 12288 + 2 * 16 * AP * 2); LAS float* RSD = LG + 16 * 48;
    const int nunits = (MTOK - m_lo) / 16;
#pragma unroll 1
    for (int unit = wave * G + bid; unit < nunits; unit += NGW) {
        const int m0 = m_lo + unit * 16; const GAS float* mb = MOD + (size_t)bidx_of_row(m0) * 6144;
        const int p16 = lane & 15, rg = lane >> 4;
        float rsr[4];
        { float ss[4] = {0.f, 0.f, 0.f, 0.f};
#pragma unroll 2
            for (int kc = 0; kc < 8; ++kc) { v4u xp[4];
#pragma unroll
                for (int i = 0; i < 4; ++i) xp[i] = *(const GAS v4u*)(X + (size_t)(m0 + 4 * rg + i) * D + kc * 128 + 8 * p16);
#pragma unroll
                for (int i = 0; i < 4; ++i) { float x[8]; unpack8(xp[i], x);
#pragma unroll
                    for (int e = 0; e < 8; ++e) ss[i] += x[e] * x[e]; } }
#pragma unroll
            for (int i = 0; i < 4; ++i) { float t = ss[i]; t += __shfl_xor(t, 1); t += __shfl_xor(t, 2); t += __shfl_xor(t, 4); t += __shfl_xor(t, 8); rsr[i] = rsqrtf(t * (1.f / D) + EPS); } }
        f32x4 acc[3];
#pragma unroll
        for (int ct = 0; ct < 3; ++ct) acc[ct] = (f32x4){0.f, 0.f, 0.f, 0.f};
#pragma unroll 1
        for (int kc = 0; kc < 8; ++kc) { const int c = kc * 128 + 8 * p16;
            const int fr = lane & 15, fq = lane >> 4;
            bf16x8 bh[4][3], bl[4][3];
#pragma unroll
            for (int ks = 0; ks < 4; ++ks)
#pragma unroll
                for (int ct = 0; ct < 3; ++ct) { const size_t bo = (size_t)(ct * 16 + fr) * 1024 + kc * 128 + ks * 32 + fq * 8; bh[ks][ct] = *(const GAS bf16x8*)(WRh + bo); bl[ks][ct] = *(const GAS bf16x8*)(WRl + bo); }
            v4u xp[4];
#pragma unroll
            for (int i = 0; i < 4; ++i) xp[i] = *(const GAS v4u*)(X + (size_t)(m0 + 4 * rg + i) * D + c);
            float gg[8], sh[8], sc[8];
            { const f32x4 a0 = *(const GAS f32x4*)(n2g + c), a1 = *(const GAS f32x4*)(n2g + c + 4), b0 = *(const GAS f32x4*)(mb + 3 * 1024 + c), b1 = *(const GAS f32x4*)(mb + 3 * 1024 + c + 4),
                  c0 = *(const GAS f32x4*)(mb + 4 * 1024 + c), c1 = *(const GAS f32x4*)(mb + 4 * 1024 + c + 4);
                gg[0] = a0.x; gg[1] = a0.y; gg[2] = a0.z; gg[3] = a0.w; gg[4] = a1.x; gg[5] = a1.y; gg[6] = a1.z; gg[7] = a1.w;
                sh[0] = b0.x; sh[1] = b0.y; sh[2] = b0.z; sh[3] = b0.w; sh[4] = b1.x; sh[5] = b1.y; sh[6] = b1.z; sh[7] = b1.w;
                sc[0] = c0.x; sc[1] = c0.y; sc[2] = c0.z; sc[3] = c0.w; sc[4] = c1.x; sc[5] = c1.y; sc[6] = c1.z; sc[7] = c1.w; }
            LDS_WAIT();
#pragma unroll
            for (int i = 0; i < 4; ++i) { const int r = 4 * rg + i; float x[8], y[8]; unpack8(xp[i], x);
#pragma unroll
                for (int e = 0; e < 8; ++e) y[e] = x[e] * rsr[i] * gg[e] * (1.f + sc[e]) + sh[e];
                const v4u hi = (v4u){pk2(y[0], y[1]), pk2(y[2], y[3]), pk2(y[4], y[5]), pk2(y[6], y[7])};
                float hf[8]; unpack8(hi, hf);
                const v4u lo = (v4u){pk2(y[0] - hf[0], y[1] - hf[1]), pk2(y[2] - hf[2], y[3] - hf[3]), pk2(y[4] - hf[4], y[5] - hf[5]), pk2(y[6] - hf[6], y[7] - hf[7])};
                *(GAS v4u*)(H + (size_t)(m0 + r) * D + c) = hi;
                *(LAS v4u*)(Ah + r * AP + 8 * p16) = hi; *(LAS v4u*)(Al + r * AP + 8 * p16) = lo; }
            LDS_WAIT();
            asm volatile("s_waitcnt vmcnt(0)" : "+v"(bh[0][0]), "+v"(bh[0][1]), "+v"(bh[0][2]), "+v"(bl[0][0]), "+v"(bl[0][1]), "+v"(bl[0][2]), "+v"(bh[1][0]), "+v"(bh[1][1]), "+v"(bh[1][2]), "+v"(bl[1][0]), "+v"(bl[1][1]), "+v"(bl[1][2]),
                         "+v"(bh[2][0]), "+v"(bh[2][1]), "+v"(bh[2][2]), "+v"(bl[2][0]), "+v"(bl[2][1]), "+v"(bl[2][2]), "+v"(bh[3][0]), "+v"(bh[3][1]), "+v"(bh[3][2]), "+v"(bl[3][0]), "+v"(bl[3][1]), "+v"(bl[3][2]) :: "memory");
#pragma unroll
            for (int ks = 0; ks < 4; ++ks) { const bf16x8 ah = *(const LAS bf16x8*)(Ah + fr * AP + ks * 32 + fq * 8), al = *(const LAS bf16x8*)(Al + fr * AP + ks * 32 + fq * 8);
#pragma unroll
                for (int ct = 0; ct < 3; ++ct) {
                    acc[ct] = __builtin_amdgcn_mfma_f32_16x16x32_bf16(ah, bh[ks][ct], acc[ct], 0, 0, 0);
                    acc[ct] = __builtin_amdgcn_mfma_f32_16x16x32_bf16(ah, bl[ks][ct], acc[ct], 0, 0, 0);
                    acc[ct] = __builtin_amdgcn_mfma_f32_16x16x32_bf16(al, bh[ks][ct], acc[ct], 0, 0, 0); } }
        }
#pragma unroll
        for (int ct = 0; ct < 3; ++ct)
#pragma unroll
            for (int j = 0; j < 4; ++j) LG[(4 * (lane >> 4) + j) * 48 + ct * 16 + (lane & 15)] = acc[ct][j];
        LDS_WAIT(); asm volatile("" ::: "memory");
        if (lane < 16) { const LAS float* lg = LG + lane * 48; const int m = m0 + lane;
            float gl[4]; int gsel = 0;
#pragma unroll
            for (int i = 0; i < 4; ++i) gl[i] = lg[i] + brg[i];
            float gmax = gl[0];
#pragma unroll
            for (int i = 1; i < 4; ++i) if (gl[i] > gmax) { gmax = gl[i]; gsel = i; }
            float den = 0.f;
#pragma unroll
            for (int i = 0; i < 4; ++i) den += __expf(gl[i] - gmax);
            const float pg = 1.f / den;
            float e1 = -INFINITY, e2 = -INFINITY; int i1 = 0, i2 = 0;
#pragma unroll 1
            for (int i = 0; i < 8; ++i) { const float ev = lg[4 + gsel * 8 + i] + bre[gsel * 8 + i];
                if (ev > e1) { e2 = e1; i2 = i1; e1 = ev; i1 = i; } else if (ev > e2) { e2 = ev; i2 = i; } }
            const float x2 = __expf(e2 - e1), w1 = pg / (1.f + x2), w2 = pg * x2 / (1.f + x2);
            const int ex1 = gsel * 8 + i1, ex2 = gsel * 8 + i2;
            const int p1 = (int)__hip_atomic_fetch_add(cnt + ex1 * 64, 1u, __ATOMIC_RELAXED, __HIP_MEMORY_SCOPE_AGENT), p2 = (int)__hip_atomic_fetch_add(cnt + ex2 * 64, 1u, __ATOMIC_RELAXED, __HIP_MEMORY_SCOPE_AGENT);
            EID[m * 2] = ex1; EID[m * 2 + 1] = ex2; GATE[m * 2] = w1; GATE[m * 2 + 1] = w2; POS[m * 2] = p1; POS[m * 2 + 1] = p2;
            RIDX[(size_t)ex1 * MOE_CAP + p1] = m; RIDX[(size_t)ex2 * MOE_CAP + p2] = m; }
        LDS_WAIT(); asm volatile("" ::: "memory");
    }
}
DI void ph_gemm_gu(const Ctx& cx, int l) {
    TIDS; GAS unsigned char* ws = cx.ws(); LAS unsigned char* lds = (LAS unsigned char*)lds_raw;
    LAS int* moe_off = (LAS int*)(lds + MISC_OFF + 64 * 4); LAS int* moe_te = (LAS int*)(lds + MISC_OFF + 128 * 4);
    const int nT = moe_tables((const GAS unsigned*)(ws + WS_CTL) + CW_CNT + l * 32 * 64, moe_off, moe_te, tid);
    pg8::Gemm g{(const GAS bf16*)(ws + WS_H), (const GAS bf16*)(ws + WS_WTGU + (size_t)l * 32 * 512 * D * 2), nT * 256, 512, D};
    const int vc = (G % 8 == 0) ? (bid % 8) * (G / 8) + bid / 8 : bid;
    pg8::GroupedPublish S{{nT, 2, G, vc, moe_te, (size_t)512 * D * 2}, (GAS unsigned*)(ws + WS_CTL) + CW_GUC + l * MOE_MAXT * 64};
    pg8::EpiGateUp E{(GAS bf16*)(ws + WS_ACT), (unsigned)(MOE_MAXT * 256 * 256 * 2)};
    LAS int* ridx_l = (LAS int*)(lds + MISC_OFF + 4096);
    { const GAS unsigned* cntp = (const GAS unsigned*)(ws + WS_CTL) + CW_CNT + l * 32 * 64; const GAS int* RIDX = (const GAS int*)(ws + WS_RIDX);
        const int vcl = (G % 8 == 0) ? (bid % 8) * (G / 8) + bid / 8 : bid; const int i = tid >> 8, r = tid & 255, L = vcl + i * G;
        if (L < nT * 2) { const int pm = L >> 1, e = moe_te[pm], slot = pm * 256 - moe_off[e] + r; ridx_l[i * 256 + r] = slot < (int)cntp[e * 64] ? RIDX[(size_t)e * MOE_CAP + slot] : 0; }
        __syncthreads(); }
    pg8::MoeRows RM{ridx_l, vc >> 1};
    pg8::gemm_phase(lds, g, S, E, RM);
}
DI void ph_gemm_dn(const Ctx& cx, int l) {
    TIDS; GAS unsigned char* ws = cx.ws(); LAS unsigned char* lds = (LAS unsigned char*)lds_raw;
    LAS int* moe_off = (LAS int*)(lds + MISC_OFF + 64 * 4); LAS int* moe_te = (LAS int*)(lds + MISC_OFF + 128 * 4);
    const int nT = moe_tables((const GAS unsigned*)(ws + WS_CTL) + CW_CNT + l * 32 * 64, moe_off, moe_te, tid);
    pg8::Gemm g{(const GAS bf16*)(ws + WS_ACT), (const GAS bf16*)(ws + WS_WTDN + (size_t)l * 32 * D * 256 * 2), nT * 256, D, 256};
    pg8::EpiStoreBf16 E{(GAS bf16*)(ws + WS_XS), D};
    const GAS unsigned* ready = (const GAS unsigned*)(ws + WS_CTL) + CW_GUC + l * MOE_MAXT * 64;
    const int vc = (G % 8 == 0) ? (bid % 8) * (G / 8) + bid / 8 : bid;
    const int nb2 = (nT * 2 > G && nT * 2 - G < G / 2) ? nT * 2 - G : 0, Gd = G - nb2, cd = vc - nb2;
    const int pmE = nb2 ? G / 2 : nT, nE = pmE * 4, nL = (nT - pmE) * 4;
    const int cl = cd < 0 ? -1 : (cd - nE % Gd + Gd) % Gd;
    pg8::GroupedOrder S1{pmE, 4, Gd, cd, moe_te, (size_t)D * 256 * 2, 0};
    pg8::GroupedOrder S2{nT - pmE, 4, Gd, cl, moe_te, (size_t)D * 256 * 2, pmE};
    { pg8::Unit u;
#pragma unroll 1
      for (int i = 0; S1.next(i, u); ++i) pg8::wait_rowtile(ready, u.pm, 16u); }
    pg8::gemm_phase(lds, g, S1, E);
    if (nL > 0) { pg8::Unit u;
#pragma unroll 1
      for (int i = 0; S2.next(i, u); ++i) pg8::wait_rowtile(ready, u.pm, 16u);
      pg8::gemm_phase(lds, g, S2, E); }
}
DI void ph_combine(const Ctx& cx, int l) {
    TIDS; GAS unsigned char* ws = cx.ws(); LAS unsigned char* lds = (LAS unsigned char*)lds_raw;
    LAS int* moe_off = (LAS int*)(lds + MISC_OFF + 64 * 4); LAS int* moe_te = (LAS int*)(lds + MISC_OFF + 128 * 4);
    const int m_lo = (l == 0) ? 0 : NCTX;
    moe_tables((const GAS unsigned*)(ws + WS_CTL) + CW_CNT + l * 32 * 64, moe_off, moe_te, tid);
    const GAS int* EID = (const GAS int*)(ws + WS_MOE); const GAS float* GATE = (const GAS float*)(ws + WS_MOE) + MTOK * 2; const GAS int* POS = (const GAS int*)(ws + WS_MOE) + MTOK * 4;
    const GAS bf16* YS = (const GAS bf16*)(ws + WS_XS); GAS bf16* X = (GAS bf16*)(ws + WS_X); GAS bf16* H = (GAS bf16*)(ws + WS_H);
    const GAS float* MODB = (const GAS float*)(ws + WS_MOD); const GAS float* MOD = MODB + (size_t)l * 5 * 6144;
    const GAS float* n1g1 = cx.in(I_N1G) + D; const GAS float* fng = cx.in(I_FNG); GAS float* outp = cx.out();
    const int R = (MTOK - m_lo + G - 1) / G, m_beg = m_lo + bid * R + wave, m_end = min(m_lo + (bid + 1) * R, MTOK);
    f32x4 g5r[4], fgr[4]; NormPar np; int cb = -1;
    if (l != 0) {
#pragma unroll
        for (int j = 0; j < 4; ++j) fgr[j] = *(const GAS f32x4*)(fng + 4 * lane + 256 * j); }
#pragma unroll 1
    for (int m = m_beg; m < m_end; m += 8) {
        const int d0 = moe_off[EID[m * 2]] + POS[m * 2], d1 = moe_off[EID[m * 2 + 1]] + POS[m * 2 + 1];
        const float w0 = GATE[m * 2], w1 = GATE[m * 2 + 1];
        { const int b = bidx_of_row(m);
            if (b != cb) { const GAS float* mb = MOD + (size_t)b * 6144;
#pragma unroll
                for (int j = 0; j < 4; ++j) g5r[j] = *(const GAS f32x4*)(mb + 5 * 1024 + 4 * lane + 256 * j);
                if (l == 0) { const GAS float* mb1 = MODB + (size_t)(5 + b) * 6144; load_normpar(np, n1g1, mb1, mb1 + 1024, lane); }
                cb = b; } }
        f32x4 v[4];
#pragma unroll
        for (int j = 0; j < 4; ++j) { const int c = 4 * lane + 256 * j;
            const v2u a0 = *(const GAS v2u*)(YS + (size_t)d0 * D + c), a1 = *(const GAS v2u*)(YS + (size_t)d1 * D + c);
            f32x4 y; y.x = w0 * bf2f(a0.x & 0xffffu) + w1 * bf2f(a1.x & 0xffffu); y.y = w0 * bf2f(a0.x >> 16) + w1 * bf2f(a1.x >> 16);
            y.z = w0 * bf2f(a0.y & 0xffffu) + w1 * bf2f(a1.y & 0xffffu); y.w = w0 * bf2f(a0.y >> 16) + w1 * bf2f(a1.y >> 16);
            v[j] = bf4f(*(const GAS v2u*)(X + (size_t)m * D + c)) + g5r[j] * y; }
        if (l == 0) {
#pragma unroll
            for (int j = 0; j < 4; ++j) *(GAS v2u*)(X + (size_t)m * D + 4 * lane + 256 * j) = f4bf(v[j]);
            norm_row_store_c(v, np, H + (size_t)m * D, lane);
        } else {
            float ss = 0.f;
#pragma unroll
            for (int j = 0; j < 4; ++j) ss += (v[j].x * v[j].x + v[j].y * v[j].y) + (v[j].z * v[j].z + v[j].w * v[j].w);
            const float rstd = rsqrtf(wave_sum(ss) * (1.f / D) + EPS);
#pragma unroll
            for (int j = 0; j < 4; ++j) { const int c = 4 * lane + 256 * j;
                *(GAS f32x4*)(outp + (size_t)(m - NCTX) * D + c) = v[j] * rstd * fgr[j]; }
        }
    }
}

#ifndef PH_MASK
#define PH_MASK 0xFFF
#endif
#define PHON(j) (((PH_MASK) >> (j)) & 1)
__global__ void __launch_bounds__(512, 2) fwd_kernel(Args args) {
    LAS unsigned char* lds = (LAS unsigned char*)lds_raw;
    volatile LAS unsigned* MISC = (volatile LAS unsigned*)(lds + MISC_OFF);
    {
        const int tid = threadIdx.x;
        for (int u = tid; u < (LDS_BYTES - MISC_OFF) / 4; u += 512) MISC[u] = 0u;
        __syncthreads();
        if (tid == 0) { volatile LAS unsigned long long* t = (volatile LAS unsigned long long*)(lds + PTR_OFF);
#pragma unroll
            for (int i = 0; i < N_IN; ++i) t[i] = (unsigned long long)args.in[i];
            t[N_IN] = (unsigned long long)args.out; t[N_IN + 1] = (unsigned long long)args.ws; }
        __syncthreads();
    }
    const Ctx cx;
#if MK_ONE_LAUNCH
    XcdBarrier bar = xcd_barrier_post((unsigned*)(cx.ws() + WS_CTL) + CW_BAR, MISC + 8);
#define GRID_BAR() xcd_barrier(bar)
#else
#define GRID_BAR() do { } while (0)
#endif
    const int lo = args.ph_lo, hi = args.ph_hi;
#define IN(k) (lo <= (k) && (k) < hi)
#define BOTH(k) (IN(k) && IN((k) + 1))
    if (PHON(0) && IN(0)) { TIDS; phase_prologue(cx, lds, tid, lane, wave, bid, G); if (BOTH(0)) GRID_BAR(); }
    if (PHON(1) && IN(1)) { TIDS; phase_norm1_l0(cx, lane, gw, NGW); if (BOTH(1)) GRID_BAR(); }
#define LAYER(L) { constexpr int l = L; constexpr int pb = 2 + 10 * l; \
        if (PHON(2) && IN(pb + 0)) { ph_gemm_in(cx, l); if (BOTH(pb + 0)) GRID_BAR(); } \
        if (PHON(3) && IN(pb + 1)) { ph_prep_r1(cx, l); if (BOTH(pb + 1)) GRID_BAR(); } \
        if (PHON(4) && IN(pb + 2)) { rec_r2(cx, blockIdx.x * 512 + threadIdx.x, gridDim.x * 512); if (BOTH(pb + 2)) GRID_BAR(); } \
        if (PHON(5) && IN(pb + 3)) { ph_mixers(cx, l); if (BOTH(pb + 3)) GRID_BAR(); } \
        if (PHON(6) && IN(pb + 4)) { ph_gemm_out(cx, l); if (BOTH(pb + 4)) GRID_BAR(); } \
        if (PHON(7) && IN(pb + 5)) { ph_router(cx, l); if (BOTH(pb + 5)) GRID_BAR(); } \
        if (PHON(9) && IN(pb + 7)) { ph_gemm_gu(cx, l);   } \
        if (PHON(10) && IN(pb + 8)) { ph_gemm_dn(cx, l); if (BOTH(pb + 8)) GRID_BAR(); } \
        if (PHON(11) && IN(pb + 9)) { ph_combine(cx, l); if (BOTH(pb + 9)) GRID_BAR(); } }
    LAYER(0)
    LAYER(1)
#undef LAYER
#undef IN
#undef BOTH
}

constexpr int NPHASES = 22;
extern "C" void kernel_launch(void* const* d_in, const int* in_sizes, int n_in, void* d_out, int out_size, void* d_ws, size_t ws_size, hipStream_t stream) {
    static int grid = 0;
    if (grid == 0) {
        if (n_in != N_IN || out_size != NLAT * D || ws_size < WS_END) { fprintf(stderr, "kernel_launch: unexpected problem (n_in %d, out %d, ws %zu)\n", n_in, out_size, ws_size); grid = -1; return; }
        int dev = 0, cus = 0, per_cu = 0;
        if (hipGetDevice(&dev) != hipSuccess || hipDeviceGetAttribute(&cus, hipDeviceAttributeMultiprocessorCount, dev) != hipSuccess) { grid = -1; return; }
        if (hipFuncSetAttribute((const void*)fwd_kernel, hipFuncAttributeMaxDynamicSharedMemorySize, LDS_BYTES) != hipSuccess) { fprintf(stderr, "kernel_launch: hipFuncSetAttribute failed\n"); grid = -1; return; }
        if (hipOccupancyMaxActiveBlocksPerMultiprocessor(&per_cu, (const void*)fwd_kernel, 512, LDS_BYTES) != hipSuccess || per_cu < 1) fprintf(stderr, "kernel_launch: occupancy query reports %d\n", per_cu);
        (void)hipGetLastError();
        grid = cus;
    }
    if (grid < 0) return;
    (void)hipMemsetAsync((char*)d_ws + WS_CTL, 0, CTL_BYTES, stream);
    Args a{};
    for (int i = 0; i < N_IN; ++i) a.in[i] = (const float*)d_in[i];
    a.out = (float*)d_out; a.ws = (unsigned char*)d_ws;
#if MK_ONE_LAUNCH
    a.ph_lo = 0; a.ph_hi = NPHASES;
    hipLaunchKernelGGL(fwd_kernel, dim3(grid), dim3(512), LDS_BYTES, stream, a);
#else
    for (int p = 0; p < NPHASES; ++p) { a.ph_lo = p; a.ph_hi = p + 1; hipLaunchKernelGGL(fwd_kernel, dim3(grid), dim3(512), LDS_BYTES, stream, a); }
#endif
}
```

```cpp
#include <hip/hip_runtime.h>
#include <cstdio>
#include <cstdint>

#ifndef MK_ONE_LAUNCH
#define MK_ONE_LAUNCH 1
#endif

#define DI __device__ __forceinline__
#define GAS __attribute__((address_space(1)))
#define LAS __attribute__((address_space(3)))
typedef unsigned short bf16;
typedef unsigned v4u __attribute__((ext_vector_type(4)));
typedef unsigned v2u __attribute__((ext_vector_type(2)));
typedef float f32x4 __attribute__((ext_vector_type(4)));
typedef short bf16x8 __attribute__((ext_vector_type(8)));
#define LDS_WAIT() asm volatile("s_waitcnt lgkmcnt(0)" ::: "memory")

constexpr int D = 1024, NB = 4, SEQ = 4096, LCTX = 256, NCTX = NB * LCTX, NLAT = NB * SEQ, MTOK = NCTX + NLAT;
constexpr int DIN = 3200, PP = 3328;
constexpr int CA_Q = 0, CA_I = 256, CA_FF = 512, CA_FB = 768, CA_G = 1024;
constexpr int CB_Q = 1280, CB_K = 1536, CB_V = 1792;
constexpr int CC_Q = 2048, CC_K = 2176, CC_V = 2304, CC_G = 2560, CC_ZF = 2816, CC_ZB = 2832;
constexpr int CD_Q = 2848, CD_KV = 3040, CD_R = 3168;
constexpr int NKEY = LCTX + SEQ;
constexpr int NCHUNK = NKEY / 64;
constexpr float EPS = 1e-6f;
constexpr float LOG2E = 1.4426950408889634f;
constexpr int MOE_MAXT = 168;
constexpr int MOE_CAP = 2 * 17408;

enum { I_X = 0, I_C, I_CTX, I_CCTX, I_WMOD, I_BMOD, I_N1G, I_N2G, I_WIN, I_WOUT, I_LBL, I_HNG, I_RPB, I_WGF, I_BGF, I_WGB, I_BGB, I_GNG, I_QNG, I_WUQ, I_KVNG, I_WUKV,
       I_WRG, I_BRG, I_WRE, I_BRE, I_WGU, I_WDN, I_FNG, N_IN };

constexpr size_t MiB = 1u << 20;
constexpr size_t WS_CTL = 0, CTL_BYTES = 2 * MiB;
constexpr size_t WS_WTIN = 2 * MiB;
constexpr size_t WTIN_L = (size_t)PP * D * 2;
constexpr size_t WS_WTOUT = 16 * MiB;
constexpr size_t WS_WTUQ = 20 * MiB;
constexpr size_t WS_WTUKV = WS_WTUQ + 512 * 1024;
constexpr size_t WS_MOD = 21 * MiB;
constexpr size_t WS_WR = WS_MOD + 512 * 1024;
constexpr size_t WS_WTGU = 22 * MiB;
constexpr size_t WS_WTDN = 86 * MiB;
constexpr size_t WS_X = 118 * MiB;
constexpr size_t WS_H = 186 * MiB;
constexpr size_t WS_CAT = 220 * MiB;
constexpr size_t WS_P = 254 * MiB;
constexpr size_t WS_XS = WS_P;
constexpr size_t WS_ACT = 338 * MiB;
constexpr size_t WS_QM = 366 * MiB;
constexpr size_t WS_KM = 379 * MiB;
constexpr size_t WS_VM = 392 * MiB;
constexpr size_t WS_RSH = 401 * MiB;
constexpr size_t WS_RSG = 435 * MiB;
constexpr size_t WS_RAH = 452 * MiB;
constexpr size_t WS_RAG = WS_RAH + 600 * 1024;
constexpr size_t WS_MOE = 453 * MiB;
constexpr size_t WS_VNT = 454 * MiB;
constexpr size_t WS_RIDX = 463 * MiB;
constexpr size_t WS_END = 468 * MiB;
constexpr int CW_BAR = 4096;
constexpr int CW_CNT = 16384;
constexpr int CW_GUC = 32768;
constexpr int CW_TMO = 64;

constexpr int RING_BYTES = 131072;
constexpr int MISC_OFF = RING_BYTES;
constexpr int LDS_BYTES = 147456;

DI float bf2f(unsigned v) { return __uint_as_float(v << 16); }
DI unsigned f2bf(float f) { unsigned u = __float_as_uint(f); return (u + 0x7fffu + ((u >> 16) & 1u)) >> 16; }
typedef __bf16 bf16v2 __attribute__((ext_vector_type(2)));
typedef float f32x2 __attribute__((ext_vector_type(2)));
DI unsigned pk2(float lo, float hi) { const f32x2 v = {lo, hi}; return __builtin_bit_cast(unsigned, __builtin_convertvector(v, bf16v2)); }
DI f32x4 bf4f(v2u w) { f32x4 r; r.x = __uint_as_float(w.x << 16); r.y = __uint_as_float(w.x & 0xffff0000u); r.z = __uint_as_float(w.y << 16); r.w = __uint_as_float(w.y & 0xffff0000u); return r; }
DI v2u f4bf(f32x4 v) { return (v2u){pk2(v.x, v.y), pk2(v.z, v.w)}; }
DI bf16x8 pack8(float a0, float a1, float a2, float a3, float a4, float a5, float a6, float a7) {
    v4u p; p.x = pk2(a0, a1); p.y = pk2(a2, a3); p.z = pk2(a4, a5); p.w = pk2(a6, a7);
    return __builtin_bit_cast(bf16x8, p);
}
DI float wave_sum(float v) {
#pragma unroll
    for (int o = 1; o < 64; o <<= 1) v += __shfl_xor(v, o);
    return v;
}
DI float frcp_(float x) { return __builtin_amdgcn_rcpf(x); }
DI float sigmoid_(float x) { return frcp_(1.f + __expf(-x)); }
DI float silu_(float x) { return x * frcp_(1.f + __expf(-x)); }
DI float logsigmoid_(float x) { return fminf(x, 0.f) - __logf(1.f + __expf(-fabsf(x))); }
DI void unpack8(v4u w, float* f) {
    f[0] = __uint_as_float(w.x << 16); f[1] = __uint_as_float(w.x & 0xffff0000u);
    f[2] = __uint_as_float(w.y << 16); f[3] = __uint_as_float(w.y & 0xffff0000u);
    f[4] = __uint_as_float(w.z << 16); f[5] = __uint_as_float(w.z & 0xffff0000u);
    f[6] = __uint_as_float(w.w << 16); f[7] = __uint_as_float(w.w & 0xffff0000u);
}
DI int bidx_of_row(int m) { return m < NCTX ? 4 : ((m - NCTX) >> 12); }

namespace pg8 {
#define PG8_LAS __attribute__((address_space(3)))
typedef unsigned short bf16_t;
typedef unsigned u32x4 __attribute__((ext_vector_type(4)));
constexpr int BM = 256, BK = 64, HALF = 128, HTB = HALF * BK * 2, STAGE_BYTES = 8 * HTB, NXCD = 8, WGM = 8;
__host__ __device__ __forceinline__ int lds_byte(int r, int c) { const int st = (r >> 4) * 2 + (c >> 5), rr = r & 15, cc = c & 31, ob = rr * 64 + cc * 2; return st * 1024 + (ob ^ (((ob >> 9) & 1) << 5)); }
__host__ __device__ __forceinline__ void stage_rc(int b, int& R, int& C) { const int st = b / 1024, sb = b % 1024, swz = sb ^ (((sb >> 9) & 1) << 5); R = (st >> 1) * 16 + swz / 64; C = (st & 1) * 32 + (swz % 64) / 2; }
__host__ __device__ __forceinline__ int perm32(int rho) { const int n = rho >> 4, i = rho & 15; return 8 * (i >> 2) + 4 * n + (i & 3); }
struct Unit { int pm, pn; size_t bo; };
struct LinearRows { static constexpr bool LINEAR = true; __device__ __forceinline__ int operator()(const Unit& u, int r) const { return u.pm * BM + r; } };
struct MoeRows { static constexpr bool LINEAR = false; const PG8_LAS int* idx; int pm0;
    __device__ __forceinline__ int operator()(const Unit& u, int r) const { return idx[(u.pm == pm0 ? 0 : 256) + r]; } };
struct Gemm { const GAS bf16_t* A; const GAS bf16_t* Bt; int M, N, K; };
struct StaticOrder {
    int nM, nN, nwg, G, c;
    __device__ void init(int M, int N, int G_, int c_) { nM = M / BM; nN = N / BM; nwg = nM * nN; G = G_; c = c_; }
    __device__ bool next(int i, Unit& u) const {
        const long L = (long)i * G + c; if (L >= nwg) return false;
        int wgid = (int)L; { const int q = nwg / NXCD, r = nwg % NXCD, xcd = wgid % NXCD, off = wgid / NXCD; wgid = (xcd < r ? xcd * (q + 1) : r * (q + 1) + (xcd - r) * q) + off; }
        const int nig = WGM * nN, gid = wgid / nig, fm = gid * WGM, gsz = (nM - fm) < WGM ? (nM - fm) : WGM;
        u.pm = fm + ((wgid % nig) % gsz); u.pn = (wgid % nig) / gsz; u.bo = 0; return true;
    }
    __device__ __forceinline__ void a_ready(const Unit&) const {}
    __device__ __forceinline__ void done(const Unit&) const {}
};
struct GroupedOrder {
    int nT, nN, G, c; const PG8_LAS int* tile_e; size_t estride; int pm0 = 0;
    __device__ bool next(int i, Unit& u) const {
        if (c < 0) return false;
        const long L = (long)i * G + c; if (L >= (long)nT * nN) return false;
        u.pm = pm0 + (int)(L / nN); u.pn = (int)(L % nN); u.bo = (size_t)__builtin_amdgcn_readfirstlane(tile_e[u.pm]) * estride; return true;
    }
    __device__ __forceinline__ void a_ready(const Unit&) const {}
    __device__ __forceinline__ void done(const Unit&) const {}
};
struct GroupedPublish : GroupedOrder { GAS unsigned* done_cnt;
    __device__ __forceinline__ void done(const Unit& u) const { asm volatile("s_waitcnt vmcnt(0)" ::: "memory");
        if ((threadIdx.x & 63) == 0) __hip_atomic_fetch_add(done_cnt + 64 * u.pm, 1u, __ATOMIC_RELAXED, __HIP_MEMORY_SCOPE_AGENT); } };
__device__ __forceinline__ void wait_rowtile(const GAS unsigned* ready, int pm, unsigned need) {
    if (threadIdx.x < 64) {
        unsigned spins = 0;
        while ((unsigned)__builtin_amdgcn_readfirstlane(__hip_atomic_load(ready + 64 * pm, __ATOMIC_RELAXED, __HIP_MEMORY_SCOPE_AGENT)) < need && ++spins < (1u << 22)) __builtin_amdgcn_s_sleep(2);
        __builtin_amdgcn_fence(__ATOMIC_ACQUIRE, "agent");
        asm volatile("s_waitcnt vmcnt(0)" ::: "memory");
    }
    __syncthreads();
}
__device__ __forceinline__ unsigned cvt_pk_bf16(float lo, float hi) { unsigned r; asm volatile("v_cvt_pk_bf16_f32 %0, %1, %2" : "=v"(r) : "v"(lo), "v"(hi)); return r; }

struct EpiStoreBf16 {
    static constexpr bool PERM = true;
    GAS bf16_t* O; int ldc;
    __device__ __forceinline__ void operator()(const f32x4 (&acc)[2][2][4][2], const Unit& u, int wr, int wc, int fr, int fq) const {
        const int row0 = u.pm * BM + wr * 64 + fr, col0 = u.pn * BM + wc * 32 + 8 * fq;
#pragma unroll
        for (int ai = 0; ai < 2; ++ai)
#pragma unroll
            for (int m = 0; m < 4; ++m) { GAS bf16_t* rowp = O + (size_t)(row0 + ai * HALF + m * 16) * ldc + col0;
#pragma unroll
                for (int bj = 0; bj < 2; ++bj) { const f32x4 v0 = acc[ai][bj][m][0], v1 = acc[ai][bj][m][1];
                    u32x4 w; w.x = cvt_pk_bf16(v0[0], v0[1]); w.y = cvt_pk_bf16(v0[2], v0[3]); w.z = cvt_pk_bf16(v1[0], v1[1]); w.w = cvt_pk_bf16(v1[2], v1[3]);
                    *(GAS u32x4*)(rowp + bj * HALF) = w; } }
    }
};
struct EpiResid {
    static constexpr bool PERM = false;
    GAS bf16_t* X; int row_off; const GAS float* mod;
    const GAS float* src_ctx; const GAS float* src_lat;
    __device__ __forceinline__ void operator()(const f32x4 (&acc)[2][2][4][2], const Unit& u, int wr, int wc, int fr, int fq) const {
        const int row0 = row_off + u.pm * BM + wr * 64 + fr, col0 = u.pn * BM + wc * 32 + 4 * fq;
        f32x4 gv[2][2];
        { const GAS float* gp = mod + (size_t)bidx_of_row(row_off + u.pm * BM) * 6144 + col0;
#pragma unroll
            for (int bj = 0; bj < 2; ++bj)
#pragma unroll
                for (int n = 0; n < 2; ++n) gv[bj][n] = *(const GAS f32x4*)(gp + bj * HALF + n * 16); }
#pragma unroll
        for (int ai = 0; ai < 2; ++ai)
#pragma unroll
            for (int m = 0; m < 4; ++m) { const int row = row0 + ai * HALF + m * 16; GAS bf16_t* rowp = X + (size_t)row * D + col0;
                const GAS float* bp = src_lat ? (row < NCTX ? src_ctx + (size_t)row * D + col0 : src_lat + (size_t)(row - NCTX) * D + col0) : (const GAS float*)nullptr;
#pragma unroll
                for (int bj = 0; bj < 2; ++bj)
#pragma unroll
                    for (int n = 0; n < 2; ++n) { const f32x4 g = gv[bj][n];
                        f32x4 x = src_lat ? *(const GAS f32x4*)(bp + bj * HALF + n * 16) : bf4f(*(const GAS v2u*)(rowp + bj * HALF + n * 16));
                        x = x + g * acc[ai][bj][m][n]; *(GAS v2u*)(rowp + bj * HALF + n * 16) = f4bf(x); } }
    }
};
struct EpiGateUp {
    static constexpr bool PERM = true;
    GAS bf16_t* O; unsigned nbytes;
    __device__ __forceinline__ void operator()(const f32x4 (&acc)[2][2][4][2], const Unit& u, int wr, int wc, int fr, int fq) const {
        const int row0 = u.pm * BM + wr * 64 + fr, col0 = u.pn * HALF + wc * 32 + 8 * fq;
        const __amdgpu_buffer_rsrc_t rsrc = __builtin_amdgcn_make_buffer_rsrc((void*)O, 0, (int)nbytes, 0x00020000);
#pragma unroll
        for (int ai = 0; ai < 2; ++ai)
#pragma unroll
            for (int m = 0; m < 4; ++m) { const unsigned off = (unsigned)((row0 + ai * HALF + m * 16) * 256 + col0) * 2u;
                float r[8];
#pragma unroll
                for (int n = 0; n < 2; ++n)
#pragma unroll
                    for (int j = 0; j < 4; ++j) { const float g = acc[ai][0][m][n][j], up = acc[ai][1][m][n][j]; r[n * 4 + j] = g * __builtin_amdgcn_rcpf(1.f + __expf(-g)) * up; }
                u32x4 w; w.x = cvt_pk_bf16(r[0], r[1]); w.y = cvt_pk_bf16(r[2], r[3]); w.z = cvt_pk_bf16(r[4], r[5]); w.w = cvt_pk_bf16(r[6], r[7]);
                __builtin_amdgcn_raw_buffer_store_b128(w, rsrc, (int)off, 0, 16); }
    }
};

template <class Epi, class Sched, class Rows = LinearRows>
__device__ __forceinline__ void gemm_phase(PG8_LAS unsigned char* lds, const Gemm g, const Sched& S, const Epi& E, const Rows RM = Rows()) {
    const int tid = threadIdx.x, wid = __builtin_amdgcn_readfirstlane(tid >> 6), lane = tid & 63, wr = wid >> 2, wc = wid & 3, fr = lane & 15, fq = lane >> 4;
    const int K = g.K, nt = K / BK;
    unsigned voffB[2]; int rA[2], cA2[2];
#pragma unroll
    for (int i = 0; i < 2; ++i) { int R, C; stage_rc(tid * 16 + i * 8192, R, C); const int Rb = Epi::PERM ? ((R & ~31) + perm32(R & 31)) : R;
        rA[i] = R; cA2[i] = C * 2; voffB[i] = (unsigned)(Rb * K + C) * 2u; }
    unsigned oAc[2][2], oAn[2][2];
#define PG8_AOFF(dst, u) do { _Pragma("unroll") for (int _h = 0; _h < 2; ++_h) _Pragma("unroll") for (int _i = 0; _i < 2; ++_i) dst[_h][_i] = (unsigned)RM(u, _h * HALF + rA[_i]) * (unsigned)(K * 2) + (unsigned)cA2[_i]; } while (0)
#define PG8_STAGE_A(bufoff, o2, kbyte) do { _Pragma("unroll") for (int _i = 0; _i < 2; ++_i) \
        __builtin_amdgcn_global_load_lds((const unsigned*)((const char*)g.A + (size_t)(kbyte) + (o2)[_i]), (PG8_LAS unsigned*)(lds + (bufoff) + ldsw + _i * 8192), 16, 0, 0); } while (0)
    const size_t kstep = (size_t)(BK * 2);
    const size_t hstep = (size_t)HALF * K * 2;
    const size_t tstep = 2 * hstep;
    const unsigned ldsw = (unsigned)wid * 1024u;
    const int aoff = lds_byte(wr * 64 + fr, fq * 8), boff = lds_byte(wc * 32 + fr, fq * 8);
#define PG8_SA(b, h) (((b) * 2 + (h)) * HTB)
#define PG8_SB(b, h) ((4 + (b) * 2 + (h)) * HTB)
#define PG8_STAGE(bufoff, gbase, voff) do { _Pragma("unroll") for (int _i = 0; _i < 2; ++_i) \
        __builtin_amdgcn_global_load_lds((const unsigned*)((const char*)(gbase) + (voff)[_i]), (PG8_LAS unsigned*)(lds + (bufoff) + ldsw + _i * 8192), 16, 0, 0); } while (0)
#define PG8_LDA(dst, b, h) do { _Pragma("unroll") for (int m = 0; m < 4; ++m) _Pragma("unroll") for (int k = 0; k < 2; ++k) dst[m][k] = *(const PG8_LAS bf16x8*)(lds + PG8_SA(b, h) + aoff + m * 2048 + k * 1024); } while (0)
#define PG8_LDB(dst, b, h) do { _Pragma("unroll") for (int n = 0; n < 2; ++n) _Pragma("unroll") for (int k = 0; k < 2; ++k) dst[n][k] = *(const PG8_LAS bf16x8*)(lds + PG8_SB(b, h) + boff + n * 2048 + k * 1024); } while (0)
#define PG8_MMA(ai, bj, At, Bt) do { __builtin_amdgcn_s_setprio(1); _Pragma("unroll") for (int m = 0; m < 4; ++m) _Pragma("unroll") for (int n = 0; n < 2; ++n) _Pragma("unroll") for (int k = 0; k < 2; ++k) \
        acc[ai][bj][m][n] = __builtin_amdgcn_mfma_f32_16x16x32_bf16(Bt[n][k], At[m][k], acc[ai][bj][m][n], 0, 0, 0); __builtin_amdgcn_s_setprio(0); } while (0)
#define PG8_WAIT_V(n) asm volatile("s_waitcnt vmcnt(" #n ")" ::: "memory")
#define PG8_WAIT_L(n) asm volatile("s_waitcnt lgkmcnt(" #n ")" ::: "memory")
#define PG8_BAR __builtin_amdgcn_s_barrier()
#define PG8_SCHED __builtin_amdgcn_sched_barrier(0)
    Unit cur, nxt; int ui = 0;
    if (!S.next(0, cur)) return;
    f32x4 acc[2][2][4][2];
#pragma unroll
    for (int a = 0; a < 2; ++a)
#pragma unroll
        for (int b = 0; b < 2; ++b)
#pragma unroll
            for (int m = 0; m < 4; ++m)
#pragma unroll
                for (int n = 0; n < 2; ++n) acc[a][b][m][n] = (f32x4){0.f, 0.f, 0.f, 0.f};
    bf16x8 At[4][2], B0[2][2], B1[2][2];
    const char* cB = (const char*)g.Bt + cur.bo + (size_t)cur.pn * tstep;
    S.a_ready(cur);
    PG8_AOFF(oAc, cur);
    PG8_STAGE(PG8_SB(0, 0), cB, voffB); PG8_STAGE_A(PG8_SA(0, 0), oAc[0], 0); PG8_STAGE(PG8_SB(0, 1), cB + hstep, voffB); PG8_STAGE_A(PG8_SA(0, 1), oAc[1], 0);
    if (wr == 1) PG8_BAR;
    PG8_WAIT_V(4); PG8_BAR;
    PG8_STAGE(PG8_SB(1, 0), cB + kstep, voffB); PG8_STAGE_A(PG8_SA(1, 0), oAc[0], kstep); PG8_STAGE(PG8_SB(1, 1), cB + hstep + kstep, voffB);
    PG8_WAIT_V(6); PG8_BAR;
    for (;;) {
        const bool has_next = S.next(ui + 1, nxt);
        const char* nB = has_next ? (const char*)g.Bt + nxt.bo + (size_t)nxt.pn * tstep : cB;
        unsigned dAn = 0u;
        if constexpr (Rows::LINEAR) { if (has_next) dAn = (unsigned)(nxt.pm - cur.pm) * (unsigned)(BM * K * 2); }
        else { if (has_next) PG8_AOFF(oAn, nxt);
            else {
#pragma unroll
                for (int _h = 0; _h < 2; ++_h)
#pragma unroll
                    for (int _i = 0; _i < 2; ++_i) oAn[_h][_i] = oAc[_h][_i]; } }
        for (int t = 0; t < nt; t += 2) {
            const bool last = (t == nt - 2);
            const size_t k1 = (size_t)(t + 1) * kstep, k2 = last ? 0 : (size_t)(t + 2) * kstep, k3 = k2 + kstep;
            unsigned o20[2], o21[2];
#pragma unroll
            for (int _i = 0; _i < 2; ++_i) { if constexpr (Rows::LINEAR) { o20[_i] = oAc[0][_i] + (last ? dAn : 0u); o21[_i] = oAc[1][_i] + (last ? dAn : 0u); }
                else { o20[_i] = last ? oAn[0][_i] : oAc[0][_i]; o21[_i] = last ? oAn[1][_i] : oAc[1][_i]; } }
            const char* b2 = last ? nB : cB + (size_t)(t + 2) * kstep;
            const char* b3 = b2 + kstep;
            if (last && has_next) S.a_ready(nxt);
            PG8_LDB(B0, 0, 0); PG8_SCHED; PG8_LDA(At, 0, 0); PG8_STAGE_A(PG8_SA(1, 1), oAc[1], k1);
            PG8_WAIT_L(8); PG8_BAR; PG8_WAIT_L(0); PG8_MMA(0, 0, At, B0); PG8_BAR; PG8_SCHED;
            PG8_LDB(B1, 0, 1); PG8_STAGE(PG8_SB(0, 0), b2, voffB);
            PG8_BAR; PG8_WAIT_L(0); PG8_MMA(0, 1, At, B1); PG8_BAR;
            PG8_LDA(At, 0, 1); PG8_STAGE_A(PG8_SA(0, 0), o20, k2);
            PG8_BAR; PG8_WAIT_L(0); PG8_MMA(1, 0, At, B0); PG8_BAR; PG8_SCHED;
            PG8_STAGE(PG8_SB(0, 1), b2 + hstep, voffB);
            PG8_WAIT_V(6); PG8_BAR; PG8_MMA(1, 1, At, B1); PG8_BAR;
            PG8_LDB(B0, 1, 0); PG8_SCHED; PG8_LDA(At, 1, 0); PG8_STAGE_A(PG8_SA(0, 1), o21, k2);
            PG8_WAIT_L(8); PG8_BAR; PG8_WAIT_L(0); PG8_MMA(0, 0, At, B0); PG8_BAR; PG8_SCHED;
            PG8_LDB(B1, 1, 1); PG8_STAGE(PG8_SB(1, 0), b3, voffB);
            PG8_BAR; PG8_WAIT_L(0); PG8_MMA(0, 1, At, B1); PG8_BAR;
            PG8_LDA(At, 1, 1); PG8_STAGE_A(PG8_SA(1, 0), o20, k3);
            PG8_BAR; PG8_WAIT_L(0); PG8_MMA(1, 0, At, B0); PG8_BAR; PG8_SCHED;
            PG8_STAGE(PG8_SB(1, 1), b3 + hstep, voffB);
            PG8_WAIT_V(6); PG8_BAR; PG8_MMA(1, 1, At, B1); PG8_BAR;
        }
        E(acc, cur, wr, wc, fr, fq); S.done(cur);
        if (!has_next) break;
#pragma unroll
        for (int a = 0; a < 2; ++a)
#pragma unroll
            for (int b = 0; b < 2; ++b)
#pragma unroll
                for (int m = 0; m < 4; ++m)
#pragma unroll
                    for (int n = 0; n < 2; ++n) acc[a][b][m][n] = (f32x4){0.f, 0.f, 0.f, 0.f};
        cur = nxt; cB = nB; ++ui;
#pragma unroll
        for (int _h = 0; _h < 2; ++_h)
#pragma unroll
            for (int _i = 0; _i < 2; ++_i) { if constexpr (Rows::LINEAR) oAc[_h][_i] += dAn; else oAc[_h][_i] = oAn[_h][_i]; }
    }
    PG8_WAIT_V(0);
    if (wr == 0) PG8_BAR;
    PG8_BAR;
#undef PG8_SA
#undef PG8_SB
#undef PG8_STAGE
#undef PG8_STAGE_A
#undef PG8_AOFF
#undef PG8_LDA
#undef PG8_LDB
#undef PG8_MMA
#undef PG8_WAIT_V
#undef PG8_WAIT_L
#undef PG8_BAR
#undef PG8_SCHED
}
}

#define XB_TMO      128
#define XB_XCNT(j)  (256  + 64 * (j))
#define XB_XSUB(j)  (1280 + 64 * (j))
#define XB_XGEN(j)  (2304 + 64 * (j))
#define XB_TOP      3328
#define XB_TOPGEN   3392
#define XCD_BAR_WORDS 3456
#define XB_SPIN_CAP (1u << 18)
__device__ __forceinline__ unsigned xb_ld(unsigned* p)              { return __hip_atomic_load(p, __ATOMIC_RELAXED, __HIP_MEMORY_SCOPE_AGENT); }
__device__ __forceinline__ unsigned xb_add(unsigned* p, unsigned v) { return __hip_atomic_fetch_add(p, v, __ATOMIC_RELAXED, __HIP_MEMORY_SCOPE_AGENT); }
__device__ __forceinline__ unsigned xb_xcc_id() { return (unsigned)__builtin_amdgcn_s_getreg((3 << 11) | 20) & 0xFu; }
#define XB_SPIN(cond, bar) do { unsigned _sp = 0; while (cond) { __builtin_amdgcn_s_sleep(1); \
    if ((++_sp & 255u) == 0u) { if (xb_ld(&(bar)[XB_TMO])) break; if (_sp > XB_SPIN_CAP) { atomicAdd(&(bar)[XB_TMO], 1u); break; } } } } while (0)
struct XcdBarrier { unsigned* bar; unsigned x; volatile LAS unsigned* st; };
__device__ __forceinline__ XcdBarrier xcd_barrier_post(unsigned* bar, volatile LAS unsigned* st) {
    XcdBarrier b; b.bar = bar; b.x = xb_xcc_id(); b.st = st;
    if (threadIdx.x == 0) (void)xb_add(&bar[XB_XCNT(b.x)], 1u);
    return b;
}
__device__ __forceinline__ void xcd_barrier_complete(unsigned* bar, unsigned x, unsigned& nloc, unsigned& nx) {
    const unsigned G = gridDim.x * gridDim.y * gridDim.z;
    unsigned sum, cnt, mine, sp = 0u;
    for (;;) {
        sum = 0u; cnt = 0u; mine = 0u;
#pragma unroll
        for (unsigned j = 0; j < 16; ++j) { const unsigned c = xb_ld(&bar[XB_XCNT(j)]); sum += c; cnt += (c > 0u) ? 1u : 0u; mine = (j == x) ? c : mine; }
        if (sum == G) break;
        __builtin_amdgcn_s_sleep(1);
        if ((++sp & 255u) == 0u) { if (xb_ld(&bar[XB_TMO])) break; if (sp > XB_SPIN_CAP) { atomicAdd(&bar[XB_TMO], 1u); break; } }
    }
    nloc = mine > 0u ? mine : 1u; nx = cnt > 0u ? cnt : 1u;
}
__device__ __forceinline__ void xcd_barrier(const XcdBarrier& b) {
    asm volatile("s_waitcnt vmcnt(0)" ::: "memory");
    __syncthreads();
    if (threadIdx.x == 0) {
        unsigned* bar = b.bar;
        __builtin_amdgcn_s_waitcnt(0);
        unsigned nloc = b.st[0], nx = b.st[1];
        if (nloc == 0u) { xcd_barrier_complete(bar, b.x, nloc, nx); b.st[0] = nloc; b.st[1] = nx; }
        const unsigned old = xb_add(&bar[XB_XSUB(b.x)], 1u);
        const unsigned gen = old / nloc;
        if (old + 1u == (gen + 1u) * nloc) {
            __builtin_amdgcn_fence(__ATOMIC_RELEASE, "agent");
            asm volatile("s_waitcnt vmcnt(0)" ::: "memory");
            const unsigned og = xb_add(&bar[XB_TOP], 1u);
            const unsigned tg = og / nx;
            if (og + 1u == (tg + 1u) * nx) xb_add(&bar[XB_TOPGEN], 1u);
            else XB_SPIN(xb_ld(&bar[XB_TOPGEN]) == tg, bar);
            __builtin_amdgcn_fence(__ATOMIC_ACQUIRE, "agent");
            xb_add(&bar[XB_XGEN(b.x)], 1u);
            asm volatile("s_waitcnt vmcnt(0)" ::: "memory");
        } else {
            XB_SPIN(xb_ld(&bar[XB_XGEN(b.x)]) == gen, bar);
            __builtin_amdgcn_fence(__ATOMIC_ACQUIRE, "agent");
            asm volatile("s_waitcnt vmcnt(0)" ::: "memory");
        }
    }
    __syncthreads();
}

struct Args { const float* in[N_IN]; float* out; unsigned char* ws; int ph_lo, ph_hi; int pad0, pad1; };
extern __shared__ __attribute__((aligned(16))) unsigned char lds_raw[];
constexpr int PTR_OFF = MISC_OFF + 2048;
struct Ctx {
    DI unsigned long long raw(int i) const { volatile LAS unsigned* t = (volatile LAS unsigned*)((LAS unsigned char*)lds_raw + PTR_OFF) + 2 * i;
        const unsigned lo = __builtin_amdgcn_readfirstlane(t[0]), hi = __builtin_amdgcn_readfirstlane(t[1]); return ((unsigned long long)hi << 32) | lo; }
    DI const GAS float* in(int i) const { return (const GAS float*)raw(i); }
    DI GAS float* out() const { return (GAS float*)raw(N_IN); }
    DI GAS unsigned char* ws() const { return (GAS unsigned char*)raw(N_IN + 1); }
};

DI void transpose_item(const GAS float* W, int N, int k0, int n0, GAS bf16* WT, int Kd, int drow0, LAS float* scr, int lane) {
    float wv[32];
#pragma unroll
    for (int i = 0; i < 32; ++i) wv[i] = W[(size_t)(k0 + 2 * i + (lane >> 5)) * N + n0 + (lane & 31)];
#pragma unroll
    for (int i = 0; i < 32; ++i) scr[(2 * i + (lane >> 5)) * 33 + (lane & 31)] = wv[i];
    LDS_WAIT(); asm volatile("" ::: "memory");
    const int c = lane & 7;
#pragma unroll
    for (int j = 0; j < 4; ++j) { const int n = (lane >> 3) + 8 * j; const LAS float* s = scr + (8 * c) * 33 + n;
        v4u o; o.x = pk2(s[0 * 33], s[1 * 33]); o.y = pk2(s[2 * 33], s[3 * 33]); o.z = pk2(s[4 * 33], s[5 * 33]); o.w = pk2(s[6 * 33], s[7 * 33]);
        *(GAS v4u*)(WT + (size_t)(drow0 + n) * Kd + k0 + 8 * c) = o; }
    LDS_WAIT(); asm volatile("" ::: "memory");
}

DI void weight_copies(const Ctx& a, int l, LAS unsigned char* lds, int tid, int lane, int wave, int gwv, int ngw, int gt, int ngt) {
    GAS unsigned char* ws = a.ws();
    for (int i = gt; i < 128 * 1024 / 8; i += ngt) *(GAS v4u*)(ws + WS_WTIN + (size_t)l * WTIN_L + (size_t)3200 * D * 2 + (size_t)i * 16) = (v4u){0u, 0u, 0u, 0u};
    LAS float* scr = (LAS float*)(lds + wave * 16384);
    constexpr int IT_IN = 16 * 100, IT_OUT = 16 * 32, IT_UQ = 3 * 12, IT_UKV = 2 * 16, IT_GU = 32 * 16 * 16, IT_DN = 32 * 4 * 32;
    constexpr int NITEMS = IT_IN + IT_OUT + IT_UQ + IT_UKV + IT_GU + IT_DN;
    for (int it = gwv; it < NITEMS; it += ngw) {
        int r = it;
        if (r < IT_IN) { const int kb = r / 100, nb = r % 100;
            transpose_item(a.in(I_WIN) + (size_t)l * D * DIN, DIN, kb * 64, nb * 32, (GAS bf16*)(ws + WS_WTIN + (size_t)l * WTIN_L), D, nb * 32, scr, lane); continue; } r -= IT_IN;
        if (r < IT_OUT) { const int kb = r / 32, nb = r % 32;
            transpose_item(a.in(I_WOUT) + (size_t)l * D * D, D, kb * 64, nb * 32, (GAS bf16*)(ws + WS_WTOUT + (size_t)l * D * D * 2), D, nb * 32, scr, lane); continue; } r -= IT_OUT;
        if (r < IT_UQ) { const int kb = r / 12, nb = r % 12;
            transpose_item(a.in(I_WUQ) + (size_t)l * 192 * 384, 384, kb * 64, nb * 32, (GAS bf16*)(ws + WS_WTUQ + (size_t)l * 384 * 192 * 2), 192, nb * 32, scr, lane); continue; } r -= IT_UQ;
        if (r < IT_UKV) { const int kb = r / 16, nb = r % 16;
            transpose_item(a.in(I_WUKV) + (size_t)l * 128 * 512, 512, kb * 64, nb * 32, (GAS bf16*)(ws + WS_WTUKV + (size_t)l * 512 * 128 * 2), 128, nb * 32, scr, lane); continue; } r -= IT_UKV;
        if (r < IT_GU) { const int le = l * 32 + r / 256, q = r % 256, kb = q / 16, nb = q % 16; const int n0 = nb * 32, c0 = n0 & 255, isup = n0 >> 8;
            const int drow0 = (c0 >> 7) * 256 + isup * 128 + (c0 & 127);
            transpose_item(a.in(I_WGU) + (size_t)le * D * 512, 512, kb * 64, n0, (GAS bf16*)(ws + WS_WTGU + (size_t)le * 512 * D * 2), D, drow0, scr, lane); continue; } r -= IT_GU;
        { const int le = l * 32 + r / 128, q = r % 128, kb = q / 32, nb = q % 32;
            transpose_item(a.in(I_WDN) + (size_t)le * 256 * D, D, kb * 64, nb * 32, (GAS bf16*)(ws + WS_WTDN + (size_t)le * D * 256 * 2), 256, nb * 32, scr, lane); }
    }
}

DI void phase_prologue(const Ctx& a, LAS unsigned char* lds, int tid, int lane, int wave, int bid, int G) {
    GAS unsigned char* ws = a.ws();
    GAS float* MOD = (GAS float*)(ws + WS_MOD);
    {
        LAS float* S = (LAS float*)lds;
        LAS float* R = (LAS float*)(lds + 5 * 1024 * 4);
        if (bid < 192) {
            const GAS float* cvec = a.in(I_C); const GAS float* cctx = a.in(I_CCTX);
            for (int i = tid; i < 5 * 1024; i += 512) { const int r = i >> 10, k = i & 1023; const float v = r < 4 ? cvec[r * 1024 + k] : cctx[k]; S[i] = silu_(v); }
        }
        __syncthreads();
        for (int u = bid; u < 192; u += G) {
            const int l = u / 96, cl = tid & 63, n = (u % 96) * 64 + cl, ks = tid >> 6;
            const GAS float* W = a.in(I_WMOD) + (size_t)l * 1024 * 6144 + n; const GAS float* bmod = a.in(I_BMOD);
            float acc[5] = {0.f, 0.f, 0.f, 0.f, 0.f};
            for (int k = ks * 128; k < ks * 128 + 128; ++k) { const float w = W[(size_t)k * 6144];
#pragma unroll
                for (int r = 0; r < 5; ++r) acc[r] += S[r * 1024 + k] * w; }
#pragma unroll
            for (int r = 0; r < 5; ++r) R[(ks * 5 + r) * 64 + cl] = acc[r];
            __syncthreads();
            if (tid < 320) { const int r = tid >> 6; float s = 0.f;
#pragma unroll
                for (int k2 = 0; k2 < 8; ++k2) s += R[(k2 * 5 + r) * 64 + cl];
                MOD[(size_t)(l * 5 + r) * 6144 + n] = s + bmod[l * 6144 + n]; }
            __syncthreads();
        }
    }
    for (int i = bid * 512 + tid; i < 2 * 48 * 1024; i += G * 512) { const int l = i / (48 * 1024), r = i % (48 * 1024), c = r >> 10, k = r & 1023;
        const float w = c < 4 ? a.in(I_WRG)[(size_t)l * D * 4 + k * 4 + c] : (c < 36 ? a.in(I_WRE)[(size_t)l * D * 32 + k * 32 + (c - 4)] : 0.f);
        const unsigned hi = f2bf(w); const float lo = w - bf2f(hi);
        GAS bf16* WR = (GAS bf16*)(ws + WS_WR) + (size_t)l * 2 * 48 * 1024;
        WR[c * 1024 + k] = (bf16)hi; WR[48 * 1024 + c * 1024 + k] = (bf16)f2bf(lo); }
    weight_copies(a, 0, lds, tid, lane, wave, bid * 8 + wave, G * 8, bid * 512 + tid, G * 512);
}

DI void norm_row_store(const f32x4 (&v)[4], const GAS float* g, const GAS float* shift, const GAS float* scale, GAS bf16* hrow, int lane) {
    float ss = 0.f;
#pragma unroll
    for (int j = 0; j < 4; ++j) ss += (v[j].x * v[j].x + v[j].y * v[j].y) + (v[j].z * v[j].z + v[j].w * v[j].w);
    const float rstd = rsqrtf(wave_sum(ss) * (1.f / D) + EPS);
#pragma unroll
    for (int j = 0; j < 4; ++j) { const int c = 4 * lane + 256 * j;
        const f32x4 gg = *(const GAS f32x4*)(g + c), sh = *(const GAS f32x4*)(shift + c), sc = *(const GAS f32x4*)(scale + c);
        const f32x4 y = v[j] * rstd * gg * (1.f + sc) + sh;
        v2u o; o.x = pk2(y.x, y.y); o.y = pk2(y.z, y.w); *(GAS v2u*)(hrow + c) = o; }
}

struct NormPar { f32x4 w[4], sh[4]; };
DI void load_normpar(NormPar& p, const GAS float* g, const GAS float* shift, const GAS float* scale, int lane) {
#pragma unroll
    for (int j = 0; j < 4; ++j) { const int c = 4 * lane + 256 * j; const f32x4 gg = *(const GAS f32x4*)(g + c), sc = *(const GAS f32x4*)(scale + c); p.w[j] = gg * (1.f + sc); p.sh[j] = *(const GAS f32x4*)(shift + c); }
}
DI void norm_row_store_c(const f32x4 (&v)[4], const NormPar& p, GAS bf16* hrow, int lane) {
    float ss = 0.f;
#pragma unroll
    for (int j = 0; j < 4; ++j) ss += (v[j].x * v[j].x + v[j].y * v[j].y) + (v[j].z * v[j].z + v[j].w * v[j].w);
    const float rstd = rsqrtf(wave_sum(ss) * (1.f / D) + EPS);
#pragma unroll
    for (int j = 0; j < 4; ++j) { const f32x4 y = v[j] * rstd * p.w[j] + p.sh[j]; v2u o; o.x = pk2(y.x, y.y); o.y = pk2(y.z, y.w); *(GAS v2u*)(hrow + 4 * lane + 256 * j) = o; }
}

DI void phase_norm1_l0(const Ctx& a, int lane, int gw, int NGW) {
    GAS unsigned char* ws = a.ws(); GAS bf16* H = (GAS bf16*)(ws + WS_H); const GAS float* MOD = (const GAS float*)(ws + WS_MOD);
    const GAS float* xin = a.in(I_X); const GAS float* cin = a.in(I_CTX); const GAS float* n1g = a.in(I_N1G);
    const int nwg = NGW >> 3, R = (MTOK + nwg - 1) / nwg, m_beg = (gw >> 3) * R + (gw & 7), m_end = min(((gw >> 3) + 1) * R, MTOK);
    NormPar np; int cb = -1;
#pragma unroll 1
    for (int m = m_beg; m < m_end; m += 8) {
        const GAS float* src = m < NCTX ? cin + (size_t)m * D : xin + (size_t)(m - NCTX) * D;
        f32x4 v[4];
#pragma unroll
        for (int j = 0; j < 4; ++j) v[j] = *(const GAS f32x4*)(src + 4 * lane + 256 * j);
        const int b = bidx_of_row(m);
        if (b != cb) { const GAS float* mb = MOD + (size_t)b * 6144; load_normpar(np, n1g, mb, mb + 1024, lane); cb = b; }
        norm_row_store_c(v, np, H + (size_t)m * D, lane);
    }
}

DI bf16x8 ld8(const LAS bf16* p) { return *(const LAS bf16x8*)p; }
DI bf16x8 ld8(const GAS bf16* p) { return *(const GAS bf16x8*)p; }
template <class PA, class PB>
DI f32x4 mma16(PA A, int lda, PB B, int ldb, int K, int lane) {
    f32x4 acc = {0.f, 0.f, 0.f, 0.f};
    const int r = lane & 15, q = (lane >> 4) * 8;
    for (int k = 0; k < K; k += 32) {
        const bf16x8 av = ld8(A + r * lda + k + q);
        const bf16x8 bv = ld8(B + r * ldb + k + q);
        acc = __builtin_amdgcn_mfma_f32_16x16x32_bf16(av, bv, acc, 0, 0, 0);
    }
    return acc;
}

constexpr int CQ_P = 200, CKV_P = 136, STG_P = 520;
constexpr int PR = 64, PL_CQ = 0, PL_CKV = 25600, PL_RK = 43008, PL_STG = 47104, PL_T = PL_STG;
DI float rope_ang(int t, int ri) { const int ax = ri >> 4, f = ri & 7; const float p = (float)(ax == 0 ? (t >> 6) : (t & 63)); return p * __builtin_amdgcn_exp2f(-1.6609640474436813f * (float)f) * 0.15915494309189535f; }
DI void prep_unit(const Ctx& a, int l, int unit, LAS unsigned char* lds, int tid, int lane, int wave) {
    GAS unsigned char* ws = a.ws();
    const GAS bf16* P = (const GAS bf16*)(ws + WS_P);
    LAS bf16* CQ = (LAS bf16*)(lds + PL_CQ); LAS bf16* CKV = (LAS bf16*)(lds + PL_CKV); LAS bf16* STG = (LAS bf16*)(lds + PL_STG); LAS bf16* RK = (LAS bf16*)(lds + PL_RK); LAS bf16* T = (LAS bf16*)(lds + PL_T);
    const int m0 = unit * PR;
    const bool isctx = m0 < NCTX;
    const int bb = isctx ? (m0 >> 8) : ((m0 - NCTX) >> 12);
    const int pos0 = isctx ? (m0 & 255) : (256 + ((m0 - NCTX) & 4095));
    const int t0 = isctx ? 0 : ((m0 - NCTX) & 4095);
    { const GAS float* gq = a.in(I_QNG) + l * 192; const GAS float* gkv = a.in(I_KVNG) + l * 128;
        const bool isq = lane < 24, iskv = lane >= 24 && lane < 40; const int pc = isq ? lane : lane - 24;
        float gn[8];
#pragma unroll
        for (int e = 0; e < 8; ++e) gn[e] = isq ? gq[pc * 8 + e] : (iskv ? gkv[pc * 8 + e] : 0.f);
#pragma unroll
        for (int rr = 0; rr < PR / 8; ++rr) { const int r = wave * (PR / 8) + rr; float x[8];
            v4u w = (v4u){0u, 0u, 0u, 0u}; if (lane < 40) w = *(const GAS v4u*)(P + (size_t)(m0 + r) * PP + (isq ? CD_Q : CD_KV) + pc * 8);
            unpack8(w, x); float ss = 0.f;
#pragma unroll
            for (int e = 0; e < 8; ++e) ss += x[e] * x[e];
            const float sq = wave_sum(isq ? ss : 0.f), skv = wave_sum(iskv ? ss : 0.f);
            const float rs = isq ? rsqrtf(sq * (1.f / 192.f) + EPS) : rsqrtf(skv * (1.f / 128.f) + EPS);
#pragma unroll
            for (int e = 0; e < 8; ++e) x[e] *= rs * gn[e];
            const v4u o = (v4u){pk2(x[0], x[1]), pk2(x[2], x[3]), pk2(x[4], x[5]), pk2(x[6], x[7])};
            if (isq) *(LAS v4u*)(CQ + r * CQ_P + pc * 8) = o; else if (iskv) *(LAS v4u*)(CKV + r * CKV_P + pc * 8) = o; } }
    for (int e = tid; e < PR * 32; e += 512) { const int r = e >> 5, ri = e & 31; const GAS bf16* prow = P + (size_t)(m0 + r) * PP + CD_R;
        float v = bf2f(prow[ri]);
        if (!isctx) { const float pv = bf2f(prow[ri ^ 8]); const float ang = rope_ang(t0 + r, ri); const float cs = __builtin_amdgcn_cosf(ang), sn = __builtin_amdgcn_sinf(ang);
            v = ((ri >> 3) & 1) == 0 ? (v * cs - pv * sn) : (pv * sn + v * cs); }
        RK[r * 32 + ri] = (bf16)f2bf(v); }
    for (int e = tid; e < PR * 32; e += 512) { const int r = e >> 5, c8 = e & 31; *(LAS v4u*)(T + r * 264 + c8 * 8) = *(const GAS v4u*)(P + (size_t)(m0 + r) * PP + CB_V + c8 * 8); }
    __syncthreads();
    GAS bf16* QM = (GAS bf16*)(ws + WS_QM); GAS bf16* KM = (GAS bf16*)(ws + WS_KM); GAS bf16* VM = (GAS bf16*)(ws + WS_VM); GAS bf16* VNT = (GAS bf16*)(ws + WS_VNT);
    const GAS bf16* WTQ = (const GAS bf16*)(ws + WS_WTUQ + (size_t)l * 384 * 192 * 2);
    const GAS bf16* WTKV = (const GAS bf16*)(ws + WS_WTUKV + (size_t)l * 512 * 128 * 2);
    const float qs = 0.10206207261596575f * LOG2E;
    const int fr = lane & 15, fq = lane >> 4;
    for (int e = tid; e < 256 * (PR / 8); e += 512) { const int col = e / (PR / 8), p8 = e % (PR / 8); unsigned hv[8];
#pragma unroll
        for (int j = 0; j < 8; ++j) hv[j] = T[(p8 * 8 + j) * 264 + col];
        *(GAS v4u*)(VNT + ((size_t)(bb * 4) * 64 + col) * NKEY + pos0 + p8 * 8) = (v4u){hv[0] | (hv[1] << 16), hv[2] | (hv[3] << 16), hv[4] | (hv[5] << 16), hv[6] | (hv[7] << 16)}; }
    __syncthreads();
    { bf16x8 bfr[3][6];
#pragma unroll
      for (int i = 0; i < 3; ++i)
#pragma unroll
        for (int ks = 0; ks < 6; ++ks) bfr[i][ks] = *(const GAS bf16x8*)(WTQ + (size_t)((wave + 8 * i) * 16 + fr) * 192 + ks * 32 + fq * 8);
#pragma unroll
      for (int i = 0; i < 3; ++i) { const int nb = wave + 8 * i;
        const int c = nb * 16 + fr, within = c % 96;
#pragma unroll
        for (int mb = 0; mb < PR / 16; ++mb) { f32x4 acc = {0.f, 0.f, 0.f, 0.f};
#pragma unroll
            for (int ks = 0; ks < 6; ++ks) acc = __builtin_amdgcn_mfma_f32_16x16x32_bf16(*(const LAS bf16x8*)(CQ + (mb * 16 + fr) * CQ_P + ks * 32 + fq * 8), bfr[i][ks], acc, 0, 0, 0);
#pragma unroll
            for (int j = 0; j < 4; ++j) { const int r = mb * 16 + 4 * fq + j; float v = acc[j]; const float pv = __shfl_xor(v, 8);
                if (within >= 64 && !isctx) { const int ri = within - 64; const float ang = rope_ang(t0 + r, ri); const float cs = __builtin_amdgcn_cosf(ang), sn = __builtin_amdgcn_sinf(ang);
                    v = ((ri >> 3) & 1) == 0 ? (v * cs - pv * sn) : (pv * sn + v * cs); }
                STG[r * STG_P + c] = (bf16)f2bf(v * qs); } } } }
    __syncthreads();
    for (int e = tid; e < PR * 48; e += 512) { const int r = e / 48, hp = e % 48, hd = hp / 12, pc = hp % 12;
        *(GAS v4u*)(QM + ((size_t)(bb * 4 + hd) * NKEY + pos0 + r) * 96 + pc * 8) = *(const LAS v4u*)(STG + r * STG_P + hd * 96 + pc * 8); }
    __syncthreads();
    { bf16x8 bfr[4][4];
#pragma unroll
      for (int i = 0; i < 4; ++i)
#pragma unroll
        for (int ks = 0; ks < 4; ++ks) bfr[i][ks] = *(const GAS bf16x8*)(WTKV + (size_t)((wave + 8 * i) * 16 + fr) * 128 + ks * 32 + fq * 8);
#pragma unroll
      for (int i = 0; i < 4; ++i) { const int nb = wave + 8 * i;
#pragma unroll
        for (int mb = 0; mb < PR / 16; ++mb) { f32x4 acc = {0.f, 0.f, 0.f, 0.f};
#pragma unroll
            for (int ks = 0; ks < 4; ++ks) acc = __builtin_amdgcn_mfma_f32_16x16x32_bf16(*(const LAS bf16x8*)(CKV + (mb * 16 + fr) * CKV_P + ks * 32 + fq * 8), bfr[i][ks], acc, 0, 0, 0);
#pragma unroll
            for (int j = 0; j < 4; ++j) STG[(mb * 16 + 4 * fq + j) * STG_P + nb * 16 + fr] = (bf16)f2bf(acc[j]); } } }
    __syncthreads();
    for (int e = tid; e < PR * 48; e += 512) { const int r = e / 48, hp = e % 48, hd = hp / 12, pc = hp % 12;
        const v4u v = pc < 8 ? *(const LAS v4u*)(STG + r * STG_P + hd * 128 + pc * 8) : *(const LAS v4u*)(RK + r * 32 + (pc - 8) * 8);
        *(GAS v4u*)(KM + ((size_t)(bb * 4 + hd) * NKEY + pos0 + r) * 96 + pc * 8) = v; }
    for (int e = tid; e < 256 * (PR / 8); e += 512) { const int col = e / (PR / 8), p8 = e % (PR / 8), hd = col >> 6, dv = col & 63; unsigned hv[8];
#pragma unroll
        for (int j = 0; j < 8; ++j) hv[j] = STG[(p8 * 8 + j) * STG_P + hd * 128 + 64 + dv];
        *(GAS v4u*)(VM + ((size_t)(bb * 4 + hd) * 64 + dv) * NKEY + pos0 + p8 * 8) = (v4u){hv[0] | (hv[1] << 16), hv[2] | (hv[3] << 16), hv[4] | (hv[5] << 16), hv[6] | (hv[7] << 16)}; }
    __syncthreads();
}

constexpr int RP = 65;
DI int scan_row(int b, int dir, int c, int i) {
    const int s = 64 * c + i;
    if (dir == 0) return s < 256 ? b * 256 + s : NCTX + b * SEQ + (s - 256);
    return s < 256 ? b * 256 + 255 - s : NCTX + b * SEQ + SEQ - 1 - (s - 256);
}
#ifndef BAR_LDS
#define BAR_LDS() asm volatile("s_waitcnt lgkmcnt(0)\n\ts_barrier" ::: "memory")
#endif
constexpr int RC_P = 68;
constexpr int L_C = 0, L_QD = 17408, L_QE = 26624, L_KD = 35840, L_VT = 58880, L_ST = 68096, L_ATT = 77312, L_O = 86528, L_T = 103168;
template <int MIX> struct RecCfg { static constexpr int DK = MIX == 0 ? 64 : 32, DKP = DK + 8, NP = DK / 8, CPT = DK / 8; };
template <int MIX> struct RecPre {
    v4u fk;
    v4u zg[MIX == 1 ? 2 : 1];
    v4u qp;
    v4u vp; f32x4 s0, s1;
};
template <int MIX, bool R3>
DI void rec_fetch(RecPre<MIX>& R, const GAS bf16* P, const GAS float* RSbase, int b, int h, int dir, int c, int tid) {
    constexpr int DK = RecCfg<MIX>::DK;
    const int lane = tid & 63, wave = tid >> 6;
    const GAS bf16* prow = P + (size_t)scan_row(b, dir, c, lane) * PP;
    if (MIX == 0) { R.fk = *(const GAS v4u*)(prow + (dir ? CA_FB : CA_FF) + h * 64 + 8 * wave); if (R3) R.qp = *(const GAS v4u*)(prow + CA_Q + h * 64 + 8 * wave); }
    else { const GAS bf16* zr = prow + (dir ? CC_ZB : CC_ZF); R.zg[0] = *(const GAS v4u*)zr; R.zg[1] = *(const GAS v4u*)(zr + 8);
        const v2u kk = *(const GAS v2u*)(prow + CC_K + h * 32 + 4 * wave); R.fk = (v4u){kk.x, kk.y, 0u, 0u};
        if (R3) { const v2u qq = *(const GAS v2u*)(prow + CC_Q + h * 32 + 4 * wave); R.qp = (v4u){qq.x, qq.y, 0u, 0u}; } }
    R.vp = *(const GAS v4u*)(P + (size_t)scan_row(b, dir, c, tid >> 3) * PP + (MIX == 0 ? CA_I : CC_V) + h * 64 + (tid & 7) * 8);
    if (R3 && tid < DK * 8) { const GAS float* rs = RSbase + (size_t)(((b * 4 + h) * 2 + dir) * NCHUNK + c) * DK * 64 + (tid >> 3) * 64 + (tid & 7) * 8; R.s0 = *(const GAS f32x4*)rs; R.s1 = *(const GAS f32x4*)(rs + 4); }
}
DI float dpp_shr_(float v, int ctrl_sel) { const int iv = __builtin_bit_cast(int, v); int r;
    switch (ctrl_sel) { case 1: r = __builtin_amdgcn_update_dpp(0, iv, 0x111, 0xf, 0xf, true); break; case 2: r = __builtin_amdgcn_update_dpp(0, iv, 0x112, 0xf, 0xf, true); break;
                        case 4: r = __builtin_amdgcn_update_dpp(0, iv, 0x114, 0xf, 0xf, true); break; default: r = __builtin_amdgcn_update_dpp(0, iv, 0x118, 0xf, 0xf, true); break; }
    return __builtin_bit_cast(float, r); }
DI float scan64(float v) {
    v += dpp_shr_(v, 1); v += dpp_shr_(v, 2); v += dpp_shr_(v, 4); v += dpp_shr_(v, 8);
    v += __builtin_bit_cast(float, __builtin_amdgcn_update_dpp(0, __builtin_bit_cast(int, v), 0x142, 0xa, 0xf, false));
    v += __builtin_bit_cast(float, __builtin_amdgcn_update_dpp(0, __builtin_bit_cast(int, v), 0x143, 0xc, 0xf, false));
    return v; }
DI float lane_read(float v, int ln) { return __builtin_bit_cast(float, __builtin_amdgcn_readlane(__builtin_bit_cast(int, v), ln)); }
template <int MIX>
DI void rec_front(const RecPre<MIX>& R, const GAS float* lg, const GAS float* wgp, const GAS float* bgp, int l, int h, int dir, int wave, float (&kv)[RecCfg<MIX>::CPT], float (&cum)[RecCfg<MIX>::CPT]) {
    if (MIX == 0) { float z[8]; unpack8(R.fk, z);
#pragma unroll
        for (int e = 0; e < 8; ++e) { const int ch = h * 64 + 8 * wave + e; float lb = 0.f; if (l == 1) lb = sigmoid_(lg[512 + dir * 256 + ch] - lg[dir * 256 + ch]);
            const float f = lb + (1.f - lb) * sigmoid_(z[e]); cum[e] = scan64(__logf(f)); kv[e] = (1.f - lb) * sigmoid_(-z[e]); }
    } else { float z[16], kk[8]; unpack8(R.zg[0], z); unpack8(R.zg[1], z + 8); unpack8(R.fk, kk);
#pragma unroll
        for (int c = 0; c < 4; ++c) { const int ch = h * 32 + 4 * wave + c; float sacc = bgp[ch];
#pragma unroll
            for (int r = 0; r < 16; ++r) sacc += z[r] * wgp[r * 128 + ch];
            cum[c] = scan64(logsigmoid_(sacc) * (1.f / 16.f)); kv[c] = kk[c]; } }
}
template <int N> DI void st_bf16(LAS bf16* p, const float (&v)[N]) {
    if (N == 8) *(LAS v4u*)p = (v4u){pk2(v[0], v[1]), pk2(v[2], v[3]), pk2(v[4], v[5]), pk2(v[6], v[7])};
    else *(LAS v2u*)p = (v2u){pk2(v[0], v[1]), pk2(v[2], v[3])};
}
DI void rec_vt_store(const v4u vp, LAS bf16* VT, int tid) { const int j = tid >> 3, v8 = tid & 7; const unsigned ww[4] = {vp.x, vp.y, vp.z, vp.w};
#pragma unroll
    for (int e = 0; e < 8; ++e) VT[(v8 * 8 + e) * 72 + j] = (bf16)((ww[e >> 1] >> ((e & 1) * 16)) & 0xffffu); }

template <int MIX>
DI void rec_r1_run(const Ctx& a, int l, LAS unsigned char* lds, int tid, int bid, int G) {
    constexpr int DK = RecCfg<MIX>::DK, CPT = RecCfg<MIX>::CPT;
    const int lane = tid & 63, wave = __builtin_amdgcn_readfirstlane(tid >> 6);
    LAS bf16* KT = (LAS bf16*)(lds + L_KD); LAS bf16* VT = (LAS bf16*)(lds + L_VT);
    GAS unsigned char* wsb = a.ws(); const GAS bf16* P = (const GAS bf16*)(wsb + WS_P);
    GAS float* RSb = (GAS float*)(wsb + (MIX == 0 ? WS_RSH : WS_RSG)); GAS float* RAb = (GAS float*)(wsb + (MIX == 0 ? WS_RAH : WS_RAG));
    const GAS float* lg = a.in(I_LBL);
    const GAS float* wgF = a.in(I_WGF) + l * 16 * 128; const GAS float* wgB = a.in(I_WGB) + l * 16 * 128; const GAS float* bgF = a.in(I_BGF) + l * 128; const GAS float* bgB = a.in(I_BGB) + l * 128;
    constexpr int NU = 32 * NCHUNK;
    const bool rebal = (MIX == 0) && (G == 256);
    const int n0 = (rebal && bid < 16) ? 8 : 0, nn = (NU - 1 - bid) / G + 1, n1 = nn + ((rebal && bid >= 128) ? 1 : 0);
    auto unit_at = [&](int n) { if (n >= n1) return NU; if (n < nn) return bid + G * n; const int e = bid - 128; return (e & 15) + G * (e >> 4); };
    RecPre<MIX> Rs[2];
    int nidx = n0;
    int u0 = unit_at(nidx), u1 = unit_at(nidx + 1);
#pragma unroll
    for (int par = 0; par < 2; ++par) { const int unit = par ? u1 : u0; if (unit < NU) { const int c = unit % NCHUNK, chain = unit / NCHUNK; rec_fetch<MIX, false>(Rs[par], P, RSb, chain >> 3, (chain >> 1) & 3, chain & 1, c, tid); } }
    BAR_LDS();
#pragma unroll 1
    while (u0 < NU) {
        const int n2 = unit_at(nidx + 2), n3 = unit_at(nidx + 3);
#pragma unroll
        for (int par = 0; par < 2; ++par) { const int unit = par ? u1 : u0; if (unit < NU) { RecPre<MIX>& R = Rs[par];
            LAS bf16* KTp = par ? (LAS bf16*)(lds + L_ST) : KT; LAS bf16* VTp = par ? (LAS bf16*)(lds + L_ATT) : VT;
            const int c = unit % NCHUNK, chain = unit / NCHUNK, dir = chain & 1, h = (chain >> 1) & 3;
            { float kv[CPT], cum[CPT]; rec_front<MIX>(R, lg, dir ? wgB : wgF, dir ? bgB : bgF, l, h, dir, wave, kv, cum);
#pragma unroll
                for (int e = 0; e < CPT; ++e) { const float last = lane_read(cum[e], 63); KTp[(CPT * wave + e) * 72 + lane] = (bf16)f2bf(kv[e] * __expf(last - cum[e]));
                    if (lane == 63) RAb[(size_t)(chain * NCHUNK + c) * DK + CPT * wave + e] = __expf(cum[e]); } }
            rec_vt_store(R.vp, VTp, tid);
            { const int nu = par ? n3 : n2; if (nu < NU) { const int c2 = nu % NCHUNK, ch2 = nu / NCHUNK; rec_fetch<MIX, false>(R, P, RSb, ch2 >> 3, (ch2 >> 1) & 3, ch2 & 1, c2, tid); } } } }
        BAR_LDS();
#pragma unroll
        for (int par = 0; par < 2; ++par) { const int unit = par ? u1 : u0; if (unit < NU) {
            const LAS bf16* KTp = par ? (const LAS bf16*)(lds + L_ST) : KT; const LAS bf16* VTp = par ? (const LAS bf16*)(lds + L_ATT) : VT;
            const int c = unit % NCHUNK, chain = unit / NCHUNK;
            GAS float* RS = RSb + (size_t)(chain * NCHUNK + c) * DK * 64;
#pragma unroll 1
            for (int tl = wave; tl < (DK / 16) * 4; tl += 8) { const int kb = tl >> 2, vb = tl & 3;
                const f32x4 acc = mma16(KTp + kb * 16 * 72, 72, VTp + vb * 16 * 72, 72, 64, lane);
#pragma unroll
                for (int j = 0; j < 4; ++j) RS[(kb * 16 + 4 * (lane >> 4) + j) * 64 + vb * 16 + (lane & 15)] = acc[j]; } } }
        BAR_LDS();
        nidx += 2; u0 = n2; u1 = n3;
    }
}

DI void rec_r2(const Ctx& a, int gtid, int gthreads) {
    GAS unsigned char* wsb = a.ws();
#pragma unroll 1
    for (int e = gtid; e < 32 * 4096 + 32 * 2048; e += gthreads) {
        const bool g = e >= 32 * 4096; const int ee = g ? e - 32 * 4096 : e; const int DK = g ? 32 : 64, per = DK * 64;
        const int chain = ee / per, kv = ee % per, k = kv >> 6;
        GAS float* RS = (GAS float*)(wsb + (g ? WS_RSG : WS_RSH)) + (size_t)chain * NCHUNK * per + kv;
        const GAS float* RA = (const GAS float*)(wsb + (g ? WS_RAG : WS_RAH)) + (size_t)chain * NCHUNK * DK + k;
        float S = 0.f;
#pragma unroll 1
        for (int c = 0; c < NCHUNK; c += 4) { float U[4], A[4];
#pragma unroll
            for (int u = 0; u < 4; ++u) { U[u] = RS[(size_t)(c + u) * per]; A[u] = RA[(c + u) * DK]; }
#pragma unroll
            for (int u = 0; u < 4; ++u) { RS[(size_t)(c + u) * per] = S; S = A[u] * S + U[u]; } }
    }
}

template <int MIX>
DI void rec_r3_run(const Ctx& a, int l, LAS unsigned char* lds, int tid, int bid, int G, bool keep_ctx) {
    constexpr int DK = RecCfg<MIX>::DK, DKP = RecCfg<MIX>::DKP, CPT = RecCfg<MIX>::CPT;
    const int lane = tid & 63, wave = __builtin_amdgcn_readfirstlane(tid >> 6);
    LAS bf16* QD = (LAS bf16*)(lds + L_QD); LAS bf16* QE = (LAS bf16*)(lds + L_QE); LAS bf16* KD = (LAS bf16*)(lds + L_KD);
    LAS bf16* VT = (LAS bf16*)(lds + L_VT); LAS bf16* ST = (LAS bf16*)(lds + L_ST); LAS bf16* ATT = (LAS bf16*)(lds + L_ATT); LAS float* Ob = (LAS float*)(lds + L_O);
    GAS unsigned char* wsb = a.ws(); const GAS bf16* P = (const GAS bf16*)(wsb + WS_P); GAS bf16* CAT = (GAS bf16*)(wsb + WS_CAT);
    const GAS float* RSb = (const GAS float*)(wsb + (MIX == 0 ? WS_RSH : WS_RSG));
    const GAS float* lg = a.in(I_LBL); const GAS float* ngb = a.in(MIX == 0 ? I_HNG : I_GNG) + l * 256;
    const GAS float* wgF = a.in(I_WGF) + l * 16 * 128; const GAS float* wgB = a.in(I_WGB) + l * 16 * 128; const GAS float* bgF = a.in(I_BGF) + l * 128; const GAS float* bgB = a.in(I_BGB) + l * 128;
    constexpr int nR = 16 * NCHUNK;
    const int nAct = keep_ctx ? nR : 16 * 64, first = (bid + (MIX == 0 ? 0 : G - 64)) % G;
    auto unit_of = [&](int a) { return a >= nAct ? nR : (keep_ctx ? a : (a >> 6) * NCHUNK + 4 + (a & 63)); };
    auto scanc = [&](int tc, int dir) { return dir == 0 ? tc : (tc < 4 ? 3 - tc : 71 - tc); };
    RecPre<MIX> Rs[2];
    int aidx = first;
    int unit = unit_of(aidx);
    if (unit < nR) { const int tc = unit % NCHUNK, bh = unit / NCHUNK; rec_fetch<MIX, true>(Rs[0], P, RSb, bh >> 2, bh & 3, 0, scanc(tc, 0), tid); rec_fetch<MIX, true>(Rs[1], P, RSb, bh >> 2, bh & 3, 1, scanc(tc, 1), tid); }
    BAR_LDS();
#pragma unroll 1
    while (unit < nR) {
        const int tc = unit % NCHUNK, bh = unit / NCHUNK, h = bh & 3, b = bh >> 2;
        const int nunit = unit_of(aidx + G);
        v4u gatep = (v4u){0u, 0u, 0u, 0u};
#pragma unroll
        for (int dir = 0; dir < 2; ++dir) { RecPre<MIX>& R = Rs[dir];
            if (tid < DK * 8) { const int k = tid >> 3, v8 = tid & 7;
#pragma unroll
                for (int e = 0; e < 4; ++e) { ST[(v8 * 8 + e) * DKP + k] = (bf16)f2bf(R.s0[e]); ST[(v8 * 8 + 4 + e) * DKP + k] = (bf16)f2bf(R.s1[e]); } }
            rec_vt_store(R.vp, VT, tid);
            { const int ri = lane, I = ri >> 4; float kv[CPT], cm[CPT], qv[CPT], e8[CPT];
                rec_front<MIX>(R, lg, dir ? wgB : wgF, dir ? bgB : bgF, l, h, dir, wave, kv, cm);
                { float q8[8]; unpack8(R.qp, q8);
#pragma unroll
                    for (int e = 0; e < CPT; ++e) qv[e] = MIX == 0 ? silu_(q8[e]) * 0.125f : q8[e] * 0.17677669529663687f; }
#pragma unroll
                for (int e = 0; e < CPT; ++e) e8[e] = qv[e] * __expf(cm[e]);
                st_bf16<CPT>(QE + ri * DKP + CPT * wave, e8);
#pragma unroll
                for (int I2 = 0; I2 < 4; ++I2) {
                    float rf[CPT];
#pragma unroll
                    for (int e = 0; e < CPT; ++e) rf[e] = I2 == 0 ? 0.f : lane_read(cm[e], 16 * I2 - 1);
                    if (I2 >= I) {
                        if (I2 == I) {
#pragma unroll
                            for (int e = 0; e < CPT; ++e) e8[e] = qv[e] * __expf(cm[e] - rf[e]);
                            st_bf16<CPT>(QD + ri * DKP + CPT * wave, e8); }
#pragma unroll
                        for (int e = 0; e < CPT; ++e) e8[e] = kv[e] * __expf(fminf(rf[e] - cm[e], 80.f));
                        const int rowbase = I2 == 0 ? 0 : (I2 == 1 ? 16 : (I2 == 2 ? 48 : 96));
                        st_bf16<CPT>(KD + (rowbase + ri) * DKP + CPT * wave, e8); } } }
            if (dir == 0) {
                const int row = (tc < 4 ? b * 256 + tc * 64 : NCTX + b * SEQ + (tc - 4) * 64) + (tid >> 3);
                gatep = *(const GAS v4u*)(P + (size_t)row * PP + (MIX == 0 ? CA_G : CC_G) + h * 64 + (tid & 7) * 8); }
            if (nunit < nR) { const int tc2 = nunit % NCHUNK, bh2 = nunit / NCHUNK; rec_fetch<MIX, true>(R, P, RSb, bh2 >> 2, bh2 & 3, dir, scanc(tc2, dir), tid); }
            BAR_LDS();
            { const int I = wave >> 1, g = lane >> 4, c16 = lane & 15;
                const int rowbase = I == 0 ? 0 : (I == 1 ? 16 : (I == 2 ? 48 : 96));
                bf16x8 Bq[2];
#pragma unroll
                for (int m = 0; m < 2; ++m) {
                    f32x4 t0 = mma16(KD + (rowbase + 2 * m * 16) * DKP, DKP, QD + I * 16 * DKP, DKP, DK, lane);
                    f32x4 t1 = mma16(KD + (rowbase + (2 * m + 1) * 16) * DKP, DKP, QD + I * 16 * DKP, DKP, DK, lane);
#pragma unroll
                    for (int jj = 0; jj < 4; ++jj) { const bool up = 4 * g + jj > c16;
                        t0[jj] = (2 * m > I || (2 * m == I && up)) ? 0.f : t0[jj]; t1[jj] = (2 * m + 1 > I || (2 * m + 1 == I && up)) ? 0.f : t1[jj]; }
                    Bq[m] = pack8(t0[0], t0[1], t0[2], t0[3], t1[0], t1[1], t1[2], t1[3]); }
#pragma unroll
                for (int u = 0; u < 2; ++u) { const int vb = 2 * (wave & 1) + u; f32x4 acc = {0.f, 0.f, 0.f, 0.f};
#pragma unroll
                    for (int m = 0; m < 2; ++m) { const LAS bf16* vr = VT + (vb * 16 + c16) * 72 + 32 * m + 4 * g;
                        const v2u lo = *(const LAS v2u*)vr, hi = *(const LAS v2u*)(vr + 16);
                        acc = __builtin_amdgcn_mfma_f32_16x16x32_bf16(__builtin_bit_cast(bf16x8, (v4u){lo.x, lo.y, hi.x, hi.y}), Bq[m], acc, 0, 0, 0); }
                    const f32x4 acc2 = mma16(ST + vb * 16 * DKP, DKP, QE + I * 16 * DKP, DKP, DK, lane);
#pragma unroll
                    for (int jj = 0; jj < 4; ++jj) { const int i = I * 16 + c16, v = vb * 16 + 4 * g + jj; const float o = acc[jj] + acc2[jj];
                        if (dir == 0) Ob[i * RP + v] = o; else Ob[(63 - i) * RP + v] += o; } } }
            BAR_LDS();
        }
        { const int tl = tid >> 3, jg = tid & 7; float x[8]; float ss = 0.f;
#pragma unroll
            for (int vv = 0; vv < 8; ++vv) { x[vv] = Ob[tl * RP + jg * 8 + vv]; ss += x[vv] * x[vv]; }
            ss += __shfl_xor(ss, 1); ss += __shfl_xor(ss, 2); ss += __shfl_xor(ss, 4);
            const float rstd = rsqrtf(ss * (1.f / 64.f) + EPS);
            const int row = tc < 4 ? b * 256 + tc * 64 + tl : NCTX + b * SEQ + (tc - 4) * 64 + tl;
            const GAS float* ng = ngb + h * 64 + jg * 8;
            float gt[8]; unpack8(gatep, gt);
            float y[8];
#pragma unroll
            for (int vv = 0; vv < 8; ++vv) y[vv] = x[vv] * rstd * ng[vv] * silu_(gt[vv]);
            v4u ow; ow.x = pk2(y[0], y[1]); ow.y = pk2(y[2], y[3]); ow.z = pk2(y[4], y[5]); ow.w = pk2(y[6], y[7]);
            *(GAS v4u*)(CAT + (size_t)row * D + (MIX == 0 ? 0 : 512) + h * 64 + jg * 8) = ow; }
        unit = nunit; aidx += G;
    }
    __syncthreads();
}

typedef float f32x16 __attribute__((ext_vector_type(16)));
DI int swap23(int r) { return (r & 19) | ((r & 4) << 1) | ((r & 8) >> 1); }
struct AttnDesc {
    const GAS bf16* q; int qpitch;
    const GAS bf16* k; int kpitch;
    const GAS bf16* vt;
    GAS bf16* o; int opitch;
    int ntiles; float scale;
    int b, r0, rs0;
    const LAS float* rpb;
};
template <int DQK, bool NA>
DI void attn_mfma_unit(LAS unsigned char* lds, const AttnDesc& A, int tid, int lane, int wave) {
    constexpr int KP = DQK + 8, VP = 72, NS = DQK / 16, KPIECES = 64 * (DQK / 8);
    constexpr int BUF = 64 * KP * 2 + 64 * VP * 2;
    const int q = lane & 31, g = lane >> 5;
    auto tpos = [&](int t) { return NA ? (t < 4 ? 64 * t : 256 + 64 * (A.rs0 + t - 4)) : 64 * t; };
    auto krow = [&](int pos) { return NA ? (pos < 256 ? A.b * 256 + pos : NCTX + A.b * SEQ + (pos - 256)) : pos; };
    const int qi = NA ? (2 * (wave >> 2) + (q >> 4)) * 64 + 16 * (wave & 3) + (q & 15) : wave * 32 + q;
    const int kc0 = NA ? min(max(16 * (wave & 3) - 8, 0), 32) : 0;
    bf16x8 Qf[NS];
    { const GAS bf16* qp = A.q + (size_t)qi * A.qpitch + 8 * g;
#pragma unroll
        for (int s2 = 0; s2 < NS; ++s2) Qf[s2] = *(const GAS bf16x8*)(qp + 16 * s2); }
    f32x16 O[2];
#pragma unroll
    for (int db = 0; db < 2; ++db)
#pragma unroll
        for (int i = 0; i < 16; ++i) O[db][i] = 0.f;
    float mrun = -1e30f, lrun = 0.f;
    const int qr = NA ? A.r0 + (qi >> 6) : 0, qc = NA ? (qi & 63) : 0;
    const int wrs = NA ? min(max(qr - 4, 0), 56) : 0, cs = NA ? min(max(qc - 8, 0), 48) : 0;
    const int qr0 = NA ? A.r0 + 2 * (wave >> 2) : 0, wlo = NA ? min(max(qr0 - 4, 0), 56) : 0, whi = NA ? min(max(qr0 + 1 - 4, 0), 56) + 8 : 0;
    v4u kreg[2], vreg;
    auto gload = [&](int t) { const int pos = tpos(t);
#pragma unroll
        for (int u = 0; u < 2; ++u) { const int p = tid + 512 * u; if (p < KPIECES) { const int key = p / (DQK / 8), d8 = p % (DQK / 8); kreg[u] = *(const GAS v4u*)(A.k + (size_t)krow(pos + key) * A.kpitch + d8 * 8); } }
        vreg = *(const GAS v4u*)(A.vt + (size_t)(tid >> 3) * NKEY + pos + (tid & 7) * 8); };
    auto lstore = [&](int buf) { LAS bf16* Kt = (LAS bf16*)(lds + buf * BUF); LAS bf16* Vt = Kt + 64 * KP;
#pragma unroll
        for (int u = 0; u < 2; ++u) { const int p = tid + 512 * u; if (p < KPIECES) { const int key = p / (DQK / 8), d8 = p % (DQK / 8); *(LAS v4u*)(Kt + key * KP + d8 * 8) = kreg[u]; } }
        *(LAS v4u*)(Vt + (tid >> 3) * VP + (tid & 7) * 8) = vreg; };
    __syncthreads();
    gload(0); lstore(0);
    __syncthreads();
#pragma unroll 1
    for (int t = 0; t < A.ntiles; ++t) {
        const bool more = t + 1 < A.ntiles;
        if (more) gload(t + 1);
        bool active = true, rowok = true; int dr = 0;
        const bool win = NA && t >= 4;
        if (win) { const int wr = A.rs0 + t - 4; active = (wr >= wlo) && (wr < whi); rowok = (wr >= wrs) && (wr < wrs + 8); dr = min(max(wr - qr + 7, 0), 14); }
        if (active) {
            const LAS bf16* Kt = (const LAS bf16*)(lds + (t & 1) * BUF); const LAS bf16* Vt = Kt + 64 * KP;
            f32x16 S[2];
#pragma unroll
            for (int kb = 0; kb < 2; ++kb) {
#pragma unroll
                for (int i = 0; i < 16; ++i) S[kb][i] = 0.f;
                if (win && kb == 1) continue;
                const LAS bf16* kp = Kt + ((win ? kc0 : kb * 32) + swap23(q)) * KP + 8 * g;
#pragma unroll
                for (int s2 = 0; s2 < NS; ++s2) { const bf16x8 a = *(const LAS bf16x8*)(kp + 16 * s2); S[kb] = __builtin_amdgcn_mfma_f32_32x32x16_bf16(a, Qf[s2], S[kb], 0, 0, 0); }
            }
            float mx = -INFINITY;
            if (NA) {
                if (win) {
#pragma unroll
                    for (int i = 0; i < 16; ++i) { const int kc = kc0 + 16 * (i >> 3) + 8 * g + (i & 7); const int dc = min(max(kc - qc, -15), 15) + 15;
                        const float bv = A.rpb[dr * 31 + dc]; const float sv = (rowok && kc >= cs && kc < cs + 16) ? S[0][i] * A.scale + bv : -INFINITY;
                        S[0][i] = sv; mx = fmaxf(mx, sv); }
                } else {
#pragma unroll
                    for (int kb = 0; kb < 2; ++kb)
#pragma unroll
                        for (int i = 0; i < 16; ++i) { const float sv = S[kb][i] * A.scale; S[kb][i] = sv; mx = fmaxf(mx, sv); }
                }
            } else {
#pragma unroll
                for (int kb = 0; kb < 2; ++kb)
#pragma unroll
                    for (int i = 0; i < 16; ++i) mx = fmaxf(mx, S[kb][i]);
            }
            mx = fmaxf(mx, __shfl_xor(mx, 32));
            const float mn = fmaxf(mrun, mx), alpha = __builtin_amdgcn_exp2f(mrun - mn);
            mrun = mn;
            if (__any(alpha != 1.f)) { lrun *= alpha;
#pragma unroll
                for (int db = 0; db < 2; ++db)
#pragma unroll
                    for (int i = 0; i < 16; ++i) O[db][i] *= alpha; }
            bf16x8 Pf[4];
#pragma unroll
            for (int ks = 0; ks < 4; ++ks) { if (win && ks >= 2) continue; const int kb = ks >> 1, o8 = (ks & 1) * 8; float p[8];
#pragma unroll
                for (int j = 0; j < 8; ++j) { p[j] = __builtin_amdgcn_exp2f(S[kb][o8 + j] - mn); lrun += p[j]; }
                Pf[ks] = pack8(p[0], p[1], p[2], p[3], p[4], p[5], p[6], p[7]); }
#pragma unroll
            for (int db = 0; db < 2; ++db) { const LAS bf16* vp = Vt + (db * 32 + q) * VP + (win ? kc0 : 0) + 8 * g;
#pragma unroll
                for (int ks = 0; ks < 4; ++ks) { if (win && ks >= 2) continue; const bf16x8 a = *(const LAS bf16x8*)(vp + 16 * ks); O[db] = __builtin_amdgcn_mfma_f32_32x32x16_bf16(a, Pf[ks], O[db], 0, 0, 0); } }
        }
        if (more) lstore((t + 1) & 1);
        __syncthreads();
    }
    const float ltot = lrun + __shfl_xor(lrun, 32), inv = 1.f / ltot;
    GAS bf16* op = A.o + (size_t)qi * A.opitch + 4 * g;
#pragma unroll
    for (int db = 0; db < 2; ++db)
#pragma unroll
        for (int i4 = 0; i4 < 4; ++i4) { v2u w; w.x = pk2(O[db][4 * i4] * inv, O[db][4 * i4 + 1] * inv); w.y = pk2(O[db][4 * i4 + 2] * inv, O[db][4 * i4 + 3] * inv); *(GAS v2u*)(op + 32 * db + 8 * i4) = w; }
}

constexpr float MLA_TH = 8.f;
constexpr int NA_SLOT = 2 * 64 * 72 * 2, NA_RPB = 4 * NA_SLOT;
DI void na_unit(LAS unsigned char* lds, const AttnDesc& A, const GAS float* rp, int tid, int lane, int wave) {
    constexpr int KP = 72, VP = 72, NS = 4, KBUF = 64 * KP * 2;
    const int q = lane & 31, g = lane >> 5, NT = A.ntiles;
    auto tpos = [&](int t) { return t < 4 ? 64 * t : 256 + 64 * (A.rs0 + t - 4); };
    auto krow = [&](int pos) { return pos < 256 ? A.b * 256 + pos : NCTX + A.b * SEQ + (pos - 256); };
    const int qi = (2 * (wave >> 2) + (q >> 4)) * 64 + 16 * (wave & 3) + (q & 15);
    const int kc0 = min(max(16 * (wave & 3) - 8, 0), 32);
    bf16x8 Qf[NS];
    { const GAS bf16* qp = A.q + (size_t)qi * A.qpitch + 8 * g;
#pragma unroll
        for (int s2 = 0; s2 < NS; ++s2) Qf[s2] = *(const GAS bf16x8*)(qp + 16 * s2); }
    f32x16 O[2];
#pragma unroll
    for (int db = 0; db < 2; ++db)
#pragma unroll
        for (int i = 0; i < 16; ++i) O[db][i] = 0.f;
    float mrun = -1e30f, lrun = 0.f;
    const int qr = A.r0 + (qi >> 6), qc = qi & 63;
    const int wrs = min(max(qr - 4, 0), 56), cs = min(max(qc - 8, 0), 48);
    const int qr0 = A.r0 + 2 * (wave >> 2), wlo = min(max(qr0 - 4, 0), 56), whi = min(max(qr0 + 1 - 4, 0), 56) + 8;
    auto koffs = [&](int i) { const int j = i * 64 + lane, row = j / 9, pc = min(j % 9, 7); return (unsigned)(row * (PP * 2) + pc * 16); };
    auto voffs = [&](int i) { const int j = i * 64 + lane, row = j / 9, pc = min(j % 9, 7); return (unsigned)(row * (NKEY * 2) + pc * 16); };
    const int iv1 = wave == 0 ? 0 : wave - 1, iv2 = wave < 2 ? 7 + wave : iv1;
    const unsigned goff0 = koffs(wave), goff1 = wave == 0 ? koffs(8) : voffs(iv1), goff2 = voffs(iv2);
    auto dma = [&](int t, int slot) __attribute__((always_inline)) { const int pos = tpos(t);
        const GAS unsigned char* kb = (const GAS unsigned char*)(A.k + (size_t)krow(pos) * A.kpitch); const GAS unsigned char* vb = (const GAS unsigned char*)(A.vt + pos);
        LAS unsigned char* kl = lds + slot * NA_SLOT; LAS unsigned char* vl = kl + KBUF;
        __builtin_amdgcn_global_load_lds((const GAS unsigned*)(kb + goff0), (LAS unsigned*)(kl + wave * 1024), 16, 0, 0);
        __builtin_amdgcn_global_load_lds((const GAS unsigned*)((wave == 0 ? kb : vb) + goff1), (LAS unsigned*)(wave == 0 ? kl + 8 * 1024 : vl + iv1 * 1024), 16, 0, 0);
        __builtin_amdgcn_global_load_lds((const GAS unsigned*)(vb + goff2), (LAS unsigned*)(vl + iv2 * 1024), 16, 0, 0);
    };
    LAS float* T = (LAS float*)(lds + NA_RPB);
    float tv[4];
#pragma unroll
    for (int u = 0; u < 4; ++u) { const int e = tid + 512 * u, r = e >> 7, dcr = (e & 127) - 64; const bool in = r < 15 && dcr >= -15 && dcr <= 15;
        tv[u] = in ? rp[r * 31 + dcr + 15] * LOG2E : (r == 15 ? -INFINITY : 0.f); }
    float mcol[16];
#pragma unroll
    for (int i = 0; i < 16; ++i) { const int kc = kc0 + 16 * (i >> 3) + 8 * g + (i & 7); mcol[i] = (kc >= cs && kc < cs + 16) ? 0.f : -INFINITY; }
    __syncthreads();
    dma(0, 0); dma(min(1, NT - 1), 1); dma(min(2, NT - 1), 2);
#pragma unroll
    for (int u = 0; u < 4; ++u) T[tid + 512 * u] = tv[u];
    asm volatile("s_waitcnt vmcnt(6)\n\ts_waitcnt lgkmcnt(0)\n\ts_barrier" ::: "memory");
#pragma unroll 1
    for (int t = 0; t < NT; ++t) {
        dma(min(t + 3, NT - 1), (t + 3) & 3);
        bool active = true, rowok = true; int dr = 0;
        const bool win = t >= 4;
        if (win) { const int wr = A.rs0 + t - 4; active = (wr >= wlo) && (wr < whi); rowok = (wr >= wrs) && (wr < wrs + 8); dr = min(max(wr - qr + 7, 0), 14); }
        if (active) {
            const LAS bf16* Kt = (const LAS bf16*)(lds + (t & 3) * NA_SLOT); const LAS bf16* Vt = Kt + 64 * KP;
            f32x16 S[2];
#pragma unroll
            for (int kb = 0; kb < 2; ++kb) {
#pragma unroll
                for (int i = 0; i < 16; ++i) S[kb][i] = 0.f;
                if (win && kb == 1) continue;
                const LAS bf16* kp = Kt + ((win ? kc0 : kb * 32) + swap23(q)) * KP + 8 * g;
#pragma unroll
                for (int s2 = 0; s2 < NS; ++s2) { const bf16x8 a = *(const LAS bf16x8*)(kp + 16 * s2); S[kb] = __builtin_amdgcn_mfma_f32_32x32x16_bf16(a, Qf[s2], S[kb], 0, 0, 0); }
            }
            float mx = -INFINITY;
            if (win) { const LAS float* tb = T + (rowok ? dr : 15) * 128 + (kc0 + 8 * g - qc + 64);
#pragma unroll
                for (int i = 0; i < 16; ++i) { const float sv = (S[0][i] * A.scale + tb[16 * (i >> 3) + (i & 7)]) + mcol[i]; S[0][i] = sv; mx = fmaxf(mx, sv); }
            } else {
#pragma unroll
                for (int kb = 0; kb < 2; ++kb)
#pragma unroll
                    for (int i = 0; i < 16; ++i) { const float sv = S[kb][i] * A.scale; S[kb][i] = sv; mx = fmaxf(mx, sv); }
            }
            if (__any(mx > mrun + MLA_TH)) { const float mf = fmaxf(mx, __shfl_xor(mx, 32)), mn = fmaxf(mrun, mf), alpha = __builtin_amdgcn_exp2f(mrun - mn);
                mrun = mn; lrun *= alpha;
#pragma unroll
                for (int db = 0; db < 2; ++db)
#pragma unroll
                    for (int i = 0; i < 16; ++i) O[db][i] *= alpha; }
            bf16x8 Pf[4];
#pragma unroll
            for (int ks = 0; ks < 4; ++ks) { if (win && ks >= 2) continue; const int kb = ks >> 1, o8 = (ks & 1) * 8; float p[8];
#pragma unroll
                for (int j = 0; j < 8; ++j) { p[j] = __builtin_amdgcn_exp2f(S[kb][o8 + j] - mrun); lrun += p[j]; }
                Pf[ks] = pack8(p[0], p[1], p[2], p[3], p[4], p[5], p[6], p[7]); }
#pragma unroll
            for (int db = 0; db < 2; ++db) { const LAS bf16* vp = Vt + (db * 32 + q) * VP + (win ? kc0 : 0) + 8 * g;
#pragma unroll
                for (int ks = 0; ks < 4; ++ks) { if (win && ks >= 2) continue; const bf16x8 a = *(const LAS bf16x8*)(vp + 16 * ks); O[db] = __builtin_amdgcn_mfma_f32_32x32x16_bf16(a, Pf[ks], O[db], 0, 0, 0); } }
        }
        asm volatile("s_waitcnt vmcnt(6)\n\ts_waitcnt lgkmcnt(0)\n\ts_barrier" ::: "memory");
    }
    asm volatile("s_waitcnt vmcnt(0)" ::: "memory");
    const float ltot = lrun + __shfl_xor(lrun, 32), inv = 1.f / ltot;
    GAS bf16* op = A.o + (size_t)qi * A.opitch + 4 * g;
#pragma unroll
    for (int db = 0; db < 2; ++db)
#pragma unroll
        for (int i4 = 0; i4 < 4; ++i4) { v2u w; w.x = pk2(O[db][4 * i4] * inv, O[db][4 * i4 + 1] * inv); w.y = pk2(O[db][4 * i4 + 2] * inv, O[db][4 * i4 + 3] * inv); *(GAS v2u*)(op + 32 * db + 8 * i4) = w; }
}

struct TagF { static constexpr bool value = false; }; struct TagT { static constexpr bool value = true; };
#define SGB(mask, n) __builtin_amdgcn_sched_group_barrier(mask, n, 0)
DI void mla_unit(LAS unsigned char* lds, const AttnDesc& A, int tid, int lane, int wave) {
    constexpr int KP = 104, VP = 72, NS = 6, KBUF = 64 * KP * 2, VBUF = 64 * VP * 2;
    const int q = lane & 31, g = lane >> 5, NT = A.ntiles;
    bf16x8 Qf[NS];
    { const GAS bf16* qp = A.q + (size_t)(wave * 32 + q) * A.qpitch + 8 * g;
#pragma unroll
        for (int s2 = 0; s2 < NS; ++s2) Qf[s2] = *(const GAS bf16x8*)(qp + 16 * s2); }
    f32x16 O[2], Cm;
#pragma unroll
    for (int i = 0; i < 16; ++i) { O[0][i] = 0.f; O[1][i] = 0.f; Cm[i] = 0.f; }
    float lrun = 0.f;
    auto koffs = [&](int i) { const int j = i * 64 + lane, row = j / 13, pc = min(j % 13, 11); return (unsigned)(row * 192 + pc * 16); };
    auto voffs = [&](int i) { const int j = i * 64 + lane, row = j / 9, pc = min(j % 9, 7); return (unsigned)(row * (NKEY * 2) + pc * 16); };
    const int i2 = min(wave + 3, 8);
    const unsigned goff0 = koffs(wave), goff1 = wave < 5 ? koffs(wave + 8) : voffs(wave - 5), goff2 = voffs(i2);
    auto dma = [&](int tk, int ks, int tv, int vs) __attribute__((always_inline)) {
        const GAS unsigned char* kb = (const GAS unsigned char*)A.k + (size_t)tk * (64 * 96 * 2); const GAS unsigned char* vb = (const GAS unsigned char*)A.vt + (size_t)tv * 128;
        LAS unsigned char* kl = lds + ks * KBUF; LAS unsigned char* vl = lds + 2 * KBUF + vs * VBUF;
        __builtin_amdgcn_global_load_lds((const GAS unsigned*)(kb + goff0), (LAS unsigned*)(kl + wave * 1024), 16, 0, 0);
        __builtin_amdgcn_global_load_lds((const GAS unsigned*)((wave < 5 ? kb : vb) + goff1), (LAS unsigned*)(wave < 5 ? kl + (wave + 8) * 1024 : vl + (wave - 5) * 1024), 16, 0, 0);
        __builtin_amdgcn_global_load_lds((const GAS unsigned*)(vb + goff2), (LAS unsigned*)(vl + i2 * 1024), 16, 0, 0);
    };
    auto qk = [&](f32x16& S0, f32x16& S1, int buf) __attribute__((always_inline)) {
        const LAS bf16* kp = (const LAS bf16*)(lds + buf * KBUF) + swap23(q) * KP + 8 * g;
        S0 = __builtin_amdgcn_mfma_f32_32x32x16_bf16(*(const LAS bf16x8*)kp, Qf[0], Cm, 0, 0, 0);
#pragma unroll
        for (int s2 = 1; s2 < NS; ++s2) S0 = __builtin_amdgcn_mfma_f32_32x32x16_bf16(*(const LAS bf16x8*)(kp + 16 * s2), Qf[s2], S0, 0, 0, 0);
        S1 = __builtin_amdgcn_mfma_f32_32x32x16_bf16(*(const LAS bf16x8*)(kp + 32 * KP), Qf[0], Cm, 0, 0, 0);
#pragma unroll
        for (int s2 = 1; s2 < NS; ++s2) S1 = __builtin_amdgcn_mfma_f32_32x32x16_bf16(*(const LAS bf16x8*)(kp + 32 * KP + 16 * s2), Qf[s2], S1, 0, 0, 0);
    };
    auto smax = [&](const f32x16& S0, const f32x16& S1) __attribute__((always_inline)) { float mx = fmaxf(S0[0], S0[1]);
#pragma unroll
        for (int i = 2; i < 16; ++i) mx = fmaxf(mx, S0[i]);
#pragma unroll
        for (int i = 0; i < 16; ++i) mx = fmaxf(mx, S1[i]);
        return mx; };
    auto rebase = [&](f32x16& S0, f32x16& S1, float mx) __attribute__((always_inline)) {
        const float mf = fmaxf(mx, __shfl_xor(mx, 32)), d = fmaxf(mf, 0.f), alpha = __builtin_amdgcn_exp2f(-d);
        lrun *= alpha;
#pragma unroll
        for (int i = 0; i < 16; ++i) { O[0][i] *= alpha; O[1][i] *= alpha; S0[i] -= d; S1[i] -= d; Cm[i] -= d; }
        asm volatile("" : "+v"(Cm));
    };
    auto softmax_p = [&](const f32x16& S0, const f32x16& S1, bf16x8 (&Pf)[4]) __attribute__((always_inline)) {
#pragma unroll
        for (int ks = 0; ks < 4; ++ks) { const int o8 = (ks & 1) * 8; float p[8];
#pragma unroll
            for (int j = 0; j < 8; ++j) { p[j] = __builtin_amdgcn_exp2f(ks < 2 ? S0[o8 + j] : S1[o8 + j]); lrun += p[j]; }
            Pf[ks] = pack8(p[0], p[1], p[2], p[3], p[4], p[5], p[6], p[7]); }
    };
    auto pv = [&](const bf16x8 (&Pf)[4], int buf) __attribute__((always_inline)) {
        const LAS bf16* vp = (const LAS bf16*)(lds + 2 * KBUF + buf * VBUF) + q * VP + 8 * g;
#pragma unroll
        for (int ks = 0; ks < 4; ++ks)
#pragma unroll
            for (int db = 0; db < 2; ++db) O[db] = __builtin_amdgcn_mfma_f32_32x32x16_bf16(*(const LAS bf16x8*)(vp + db * 32 * VP + 16 * ks), Pf[ks], O[db], 0, 0, 0);
    };
    f32x16 Sa[2], Sb[2];
    __syncthreads();
    dma(0, 0, 0, 0); dma(1, 1, 0, 0);
    asm volatile("s_waitcnt vmcnt(0)" ::: "memory");
    __syncthreads();
    qk(Sa[0], Sa[1], 0);
    { const float mx = smax(Sa[0], Sa[1]); const float mf = fmaxf(mx, __shfl_xor(mx, 32));
#pragma unroll
        for (int i = 0; i < 16; ++i) { Sa[0][i] -= mf; Sa[1][i] -= mf; Cm[i] = -mf; }
        asm volatile("" : "+v"(Cm)); }
    __syncthreads();
    auto step = [&](f32x16 (&Sc)[2], f32x16 (&Sn)[2], const int t, auto par) __attribute__((always_inline)) {
        constexpr int PAR = decltype(par)::value ? 1 : 0;
        dma(min(t + 2, NT - 1), PAR, min(t + 1, NT - 1), PAR ^ 1);
        __builtin_amdgcn_sched_barrier(0);
        bf16x8 Pf[4];
        qk(Sn[0], Sn[1], PAR ^ 1);
        softmax_p(Sc[0], Sc[1], Pf);
        pv(Pf, PAR);
        const float mx = smax(Sn[0], Sn[1]);
        SGB(0x100, 3);
#pragma unroll
        for (int m = 0; m < 16; ++m) { SGB(0x008, 1); SGB(0x100, 1); SGB(0x400, 2); SGB(0x002, 3); }
#pragma unroll
        for (int m = 0; m < 4; ++m) { SGB(0x008, 1); SGB(0x100, 1); SGB(0x002, 5); }
        if (__any(mx > MLA_TH)) rebase(Sn[0], Sn[1], mx);
        asm volatile("s_waitcnt vmcnt(0)" ::: "memory");
        __syncthreads();
    };
#pragma unroll 1
    for (int t = 0; t < NT - 2; t += 2) { step(Sa, Sb, t, TagF{}); step(Sb, Sa, t + 1, TagT{}); }
    step(Sa, Sb, NT - 2, TagF{});
    { bf16x8 Pf[4]; softmax_p(Sb[0], Sb[1], Pf); pv(Pf, (NT - 1) & 1); }
    const float ltot = lrun + __shfl_xor(lrun, 32), inv = 1.f / ltot;
    GAS bf16* op = A.o + (size_t)(wave * 32 + q) * A.opitch + 4 * g;
#pragma unroll
    for (int db = 0; db < 2; ++db)
#pragma unroll
        for (int i4 = 0; i4 < 4; ++i4) { v2u w; w.x = pk2(O[db][4 * i4] * inv, O[db][4 * i4 + 1] * inv); w.y = pk2(O[db][4 * i4 + 2] * inv, O[db][4 * i4 + 3] * inv); *(GAS v2u*)(op + 32 * db + 8 * i4) = w; }
}

DI int moe_tables(const GAS unsigned* cnt  , LAS int* off, LAS int* tile_e, int tid) {
    if (tid == 0) { int o = 0; for (int e = 0; e < 32; ++e) { off[e] = o; o += ((int)cnt[e * 64] + 255) & ~255; } off[32] = o; }
    __syncthreads();
    if (tid < MOE_MAXT) { const int r = tid * 256; int ex = 0; for (int e = 0; e < 32; ++e) if (r >= off[e + 1]) ex = e + 1; tile_e[tid] = ex < 32 ? ex : 31; }
    __syncthreads();
    return off[32] >> 8;
}

#define TIDS const int tid = threadIdx.x, lane = tid & 63, wave = __builtin_amdgcn_readfirstlane(tid >> 6), bid = blockIdx.x, G = gridDim.x, gw = bid * 8 + wave, NGW = G * 8; (void)lane; (void)gw; (void)NGW
DI void ph_gemm_in(const Ctx& cx, int l) {
    TIDS; GAS unsigned char* ws = cx.ws(); LAS unsigned char* lds = (LAS unsigned char*)lds_raw;
    pg8::Gemm g{(const GAS bf16*)(ws + WS_H), (const GAS bf16*)(ws + WS_WTIN + (size_t)l * WTIN_L), MTOK, PP, D}; pg8::StaticOrder S; S.init(MTOK, PP, G, bid);
    pg8::EpiStoreBf16 E{(GAS bf16*)(ws + WS_P), PP};
    pg8::gemm_phase(lds, g, S, E);
}
DI void ph_prep_r1(const Ctx& cx, int l) {
    TIDS; LAS unsigned char* lds = (LAS unsigned char*)lds_raw;
#pragma unroll 1
    for (int u = bid; u < MTOK / PR; u += G) prep_unit(cx, l, u, lds, tid, lane, wave);
    __syncthreads();
    rec_r1_run<0>(cx, l, lds, tid, bid, G); rec_r1_run<1>(cx, l, lds, tid, bid, G);
    __syncthreads();
}
DI void ph_mixers(const Ctx& cx, int l) {
    TIDS; GAS unsigned char* ws = cx.ws(); LAS unsigned char* lds = (LAS unsigned char*)lds_raw;
    const bool keep_ctx = (l == 0);
    GAS bf16* CAT = (GAS bf16*)(ws + WS_CAT); const GAS bf16* P = (const GAS bf16*)(ws + WS_P);
    const int nATT = 256 + (keep_ctx ? 16 : 0), nR = 16 * NCHUNK;
    const int vc = (G % 8 == 0) ? (bid % 8) * (G / 8) + bid / 8 : bid;
    const bool r3first = ((bid >> 3) & 1) != 0;
    if (r3first) { rec_r3_run<0>(cx, l, lds, tid, bid, G, keep_ctx); rec_r3_run<1>(cx, l, lds, tid, bid, G, keep_ctx); __syncthreads(); }
#pragma unroll 1
    for (int it = 0; it < 2; ++it) { const int u = it == 0 ? vc : (G == 256 && bid >= 128 && bid < 144 ? 256 + bid - 128 : (G == 256 ? nATT : bid + G)); if (u >= nATT) continue;
        const GAS bf16* QM = (const GAS bf16*)(ws + WS_QM); const GAS bf16* KM = (const GAS bf16*)(ws + WS_KM); const GAS bf16* VM = (const GAS bf16*)(ws + WS_VM);
        AttnDesc A{}; int bh, b, h;
        if (u < 256) { bh = u >> 4; b = bh >> 2; h = bh & 3; const int qb = u & 15; A.q = QM + ((size_t)bh * NKEY + 256 + qb * 256) * 96; A.ntiles = NKEY / 64; A.o = CAT + (size_t)(NCTX + b * SEQ + qb * 256) * D + 768 + h * 64; }
        else { bh = u - 256; b = bh >> 2; h = bh & 3; A.q = QM + (size_t)bh * NKEY * 96; A.ntiles = 4; A.o = CAT + (size_t)(b * 256) * D + 768 + h * 64; }
        A.qpitch = 96; A.k = KM + (size_t)bh * NKEY * 96; A.kpitch = 96; A.vt = VM + (size_t)bh * 64 * NKEY; A.opitch = D; A.scale = 1.f;
        mla_unit(lds, A, tid, lane, wave);
    }
#pragma unroll 1
    for (int it = 0; it < 2; ++it) { const int u = it == 0 ? vc : (G == 256 && bid >= 160 && bid < 176 ? 256 + bid - 160 : (G == 256 ? nATT : bid + G)); if (u >= nATT) continue;
        LAS float* rpb = (LAS float*)(lds + NA_RPB);
        AttnDesc A{}; int bh, b, h; size_t qrow;
        if (u < 256) { bh = u >> 4; b = bh >> 2; h = bh & 3; const int rq = u & 15; A.r0 = rq * 4; A.rs0 = min(max(A.r0 - 4, 0), 56); const int rsl = min(max(A.r0 + 3 - 4, 0), 56);
            A.ntiles = 4 + (rsl + 8 - A.rs0); qrow = (size_t)NCTX + b * SEQ + A.r0 * 64; }
        else { bh = u - 256; b = bh >> 2; h = bh & 3; A.ntiles = 4; qrow = (size_t)b * 256; }
        const GAS float* rp = cx.in(I_RPB) + (size_t)(l * 4 + h) * 465;
        A.q = P + qrow * PP + CB_Q + h * 64; A.qpitch = PP; A.k = P + CB_K + h * 64; A.kpitch = PP; A.vt = (const GAS bf16*)(ws + WS_VNT) + (size_t)bh * 64 * NKEY;
        A.o = CAT + qrow * D + 256 + h * 64; A.opitch = D; A.scale = 0.125f * LOG2E; A.b = b; A.rpb = rpb;
        na_unit(lds, A, rp, tid, lane, wave);
    }
    __syncthreads();
    if (!r3first) { rec_r3_run<0>(cx, l, lds, tid, bid, G, keep_ctx); rec_r3_run<1>(cx, l, lds, tid, bid, G, keep_ctx); }
}
DI void ph_gemm_out(const Ctx& cx, int l) {
    TIDS; GAS unsigned char* ws = cx.ws(); LAS unsigned char* lds = (LAS unsigned char*)lds_raw;
    const int roff = (l == 0) ? 0 : NCTX, Mg = MTOK - roff;
    pg8::Gemm g{(const GAS bf16*)(ws + WS_CAT) + (size_t)roff * D, (const GAS bf16*)(ws + WS_WTOUT + (size_t)l * D * D * 2), Mg, D, D}; pg8::StaticOrder S; S.init(Mg, D, G, bid);
    pg8::EpiResid E{(GAS pg8::bf16_t*)(ws + WS_X), roff, (const GAS float*)(ws + WS_MOD) + (size_t)l * 5 * 6144 + 2 * 1024, l == 0 ? cx.in(I_CTX) : (const GAS float*)nullptr, l == 0 ? cx.in(I_X) : (const GAS float*)nullptr};
    pg8::gemm_phase(lds, g, S, E);
    if (l == 0) { const int nbusy = (Mg / 256) * (D / 256) - G;
        if (nbusy >= 0 && nbusy < G && bid >= nbusy) { __syncthreads(); weight_copies(cx, 1, lds, tid, lane, wave, (bid - nbusy) * 8 + wave, (G - nbusy) * 8, (bid - nbusy) * 512 + tid, (G - nbusy) * 512); } }
}
DI void ph_router(const Ctx& cx, int l) {
    TIDS; GAS unsigned char* ws = cx.ws(); LAS unsigned char* lds = (LAS unsigned char*)lds_raw;
    const int m_lo = (l == 0) ? 0 : NCTX;
    const GAS bf16* X = (const GAS bf16*)(ws + WS_X); GAS bf16* H = (GAS bf16*)(ws + WS_H); const GAS float* MOD = (const GAS float*)(ws + WS_MOD) + (size_t)l * 5 * 6144;
    GAS int* EID = (GAS int*)(ws + WS_MOE); GAS float* GATE = (GAS float*)(ws + WS_MOE) + MTOK * 2; GAS int* POS = (GAS int*)(ws + WS_MOE) + MTOK * 4;
    GAS unsigned* cnt = (GAS unsigned*)(ws + WS_CTL) + CW_CNT + l * 32 * 64; GAS int* RIDX = (GAS int*)(ws + WS_RIDX);
    const GAS bf16* WRh = (const GAS bf16*)(ws + WS_WR) + (size_t)l * 2 * 48 * 1024; const GAS bf16* WRl = WRh + 48 * 1024;
    const GAS float* n2g = cx.in(I_N2G) + l * D; const GAS float* brg = cx.in(I_BRG) + l * 4; const GAS float* bre = cx.in(I_BRE) + l * 32;
    constexpr int AP = 136;
    LAS bf16* Ah = (LAS bf16*)(lds + wave * 12288); LAS bf16* Al = Ah + 16 * AP; LAS float* LG = (LAS float*)(lds + wave * 12288 + 2 * 16 * AP * 2); LAS float* RSD = LG + 16 * 48;
    const int nunits = (MTOK - m_lo) / 16;
#pragma unroll 1
    for (int unit = wave * G + bid; unit < nunits; unit += NGW) {
        const int m0 = m_lo + unit * 16; const GAS float* mb = MOD + (size_t)bidx_of_row(m0) * 6144;
        const int p16 = lane & 15, rg = lane >> 4;
        float rsr[4];
        { float ss[4] = {0.f, 0.f, 0.f, 0.f};
#pragma unroll 2
            for (int kc = 0; kc < 8; ++kc) { v4u xp[4];
#pragma unroll
                for (int i = 0; i < 4; ++i) xp[i] = *(const GAS v4u*)(X + (size_t)(m0 + 4 * rg + i) * D + kc * 128 + 8 * p16);
#pragma unroll
                for (int i = 0; i < 4; ++i) { float x[8]; unpack8(xp[i], x);
#pragma unroll
                    for (int e = 0; e < 8; ++e) ss[i] += x[e] * x[e]; } }
#pragma unroll
            for (int i = 0; i < 4; ++i) { float t = ss[i]; t += __shfl_xor(t, 1); t += __shfl_xor(t, 2); t += __shfl_xor(t, 4); t += __shfl_xor(t, 8); rsr[i] = rsqrtf(t * (1.f / D) + EPS); } }
        f32x4 acc[3];
#pragma unroll
        for (int ct = 0; ct < 3; ++ct) acc[ct] = (f32x4){0.f, 0.f, 0.f, 0.f};
#pragma unroll 1
        for (int kc = 0; kc < 8; ++kc) { const int c = kc * 128 + 8 * p16;
            const int fr = lane & 15, fq = lane >> 4;
            bf16x8 bh[4][3], bl[4][3];
#pragma unroll
            for (int ks = 0; ks < 4; ++ks)
#pragma unroll
                for (int ct = 0; ct < 3; ++ct) { const size_t bo = (size_t)(ct * 16 + fr) * 1024 + kc * 128 + ks * 32 + fq * 8; bh[ks][ct] = *(const GAS bf16x8*)(WRh + bo); bl[ks][ct] = *(const GAS bf16x8*)(WRl + bo); }
            v4u xp[4];
#pragma unroll
            for (int i = 0; i < 4; ++i) xp[i] = *(const GAS v4u*)(X + (size_t)(m0 + 4 * rg + i) * D + c);
            float gg[8], sh[8], sc[8];
            { const f32x4 a0 = *(const GAS f32x4*)(n2g + c), a1 = *(const GAS f32x4*)(n2g + c + 4), b0 = *(const GAS f32x4*)(mb + 3 * 1024 + c), b1 = *(const GAS f32x4*)(mb + 3 * 1024 + c + 4),
                  c0 = *(const GAS f32x4*)(mb + 4 * 1024 + c), c1 = *(const GAS f32x4*)(mb + 4 * 1024 + c + 4);
                gg[0] = a0.x; gg[1] = a0.y; gg[2] = a0.z; gg[3] = a0.w; gg[4] = a1.x; gg[5] = a1.y; gg[6] = a1.z; gg[7] = a1.w;
                sh[0] = b0.x; sh[1] = b0.y; sh[2] = b0.z; sh[3] = b0.w; sh[4] = b1.x; sh[5] = b1.y; sh[6] = b1.z; sh[7] = b1.w;
                sc[0] = c0.x; sc[1] = c0.y; sc[2] = c0.z; sc[3] = c0.w; sc[4] = c1.x; sc[5] = c1.y; sc[6] = c1.z; sc[7] = c1.w; }
            LDS_WAIT();
#pragma unroll
            for (int i = 0; i < 4; ++i) { const int r = 4 * rg + i; float x[8], y[8]; unpack8(xp[i], x);
#pragma unroll
                for (int e = 0; e < 8; ++e) y[e] = x[e] * rsr[i] * gg[e] * (1.f + sc[e]) + sh[e];
                const v4u hi = (v4u){pk2(y[0], y[1]), pk2(y[2], y[3]), pk2(y[4], y[5]), pk2(y[6], y[7])};
                float hf[8]; unpack8(hi, hf);
                const v4u lo = (v4u){pk2(y[0] - hf[0], y[1] - hf[1]), pk2(y[2] - hf[2], y[3] - hf[3]), pk2(y[4] - hf[4], y[5] - hf[5]), pk2(y[6] - hf[6], y[7] - hf[7])};
                *(GAS v4u*)(H + (size_t)(m0 + r) * D + c) = hi;
                *(LAS v4u*)(Ah + r * AP + 8 * p16) = hi; *(LAS v4u*)(Al + r * AP + 8 * p16) = lo; }
            LDS_WAIT();
            asm volatile("s_waitcnt vmcnt(0)" : "+v"(bh[0][0]), "+v"(bh[0][1]), "+v"(bh[0][2]), "+v"(bl[0][0]), "+v"(bl[0][1]), "+v"(bl[0][2]), "+v"(bh[1][0]), "+v"(bh[1][1]), "+v"(bh[1][2]), "+v"(bl[1][0]), "+v"(bl[1][1]), "+v"(bl[1][2]),
                         "+v"(bh[2][0]), "+v"(bh[2][1]), "+v"(bh[2][2]), "+v"(bl[2][0]), "+v"(bl[2][1]), "+v"(bl[2][2]), "+v"(bh[3][0]), "+v"(bh[3][1]), "+v"(bh[3][2]), "+v"(bl[3][0]), "+v"(bl[3][1]), "+v"(bl[3][2]) :: "memory");
#pragma unroll
            for (int ks = 0; ks < 4; ++ks) { const bf16x8 ah = *(const LAS bf16x8*)(Ah + fr * AP + ks * 32 + fq * 8), al = *(const LAS bf16x8*)(Al + fr * AP + ks * 32 + fq * 8);
#pragma unroll
                for (int ct = 0; ct < 3; ++ct) {
                    acc[ct] = __builtin_amdgcn_mfma_f32_16x16x32_bf16(ah, bh[ks][ct], acc[ct], 0, 0, 0);
                    acc[ct] = __builtin_amdgcn_mfma_f32_16x16x32_bf16(ah, bl[ks][ct], acc[ct], 0, 0, 0);
                    acc[ct] = __builtin_amdgcn_mfma_f32_16x16x32_bf16(al, bh[ks][ct], acc[ct], 0, 0, 0); } }
        }
#pragma unroll
        for (int ct = 0; ct < 3; ++ct)
#pragma unroll
            for (int j = 0; j < 4; ++j) LG[(4 * (lane >> 4) + j) * 48 + ct * 16 + (lane & 15)] = acc[ct][j];
        LDS_WAIT(); asm volatile("" ::: "memory");
        if (lane < 16) { const LAS float* lg = LG + lane * 48; const int m = m0 + lane;
            float gl[4]; int gsel = 0;
#pragma unroll
            for (int i = 0; i < 4; ++i) gl[i] = lg[i] + brg[i];
            float gmax = gl[0];
#pragma unroll
            for (int i = 1; i < 4; ++i) if (gl[i] > gmax) { gmax = gl[i]; gsel = i; }
            float den = 0.f;
#pragma unroll
            for (int i = 0; i < 4; ++i) den += __expf(gl[i] - gmax);
            const float pg = 1.f / den;
            float e1 = -INFINITY, e2 = -INFINITY; int i1 = 0, i2 = 0;
#pragma unroll 1
            for (int i = 0; i < 8; ++i) { const float ev = lg[4 + gsel * 8 + i] + bre[gsel * 8 + i];
                if (ev > e1) { e2 = e1; i2 = i1; e1 = ev; i1 = i; } else if (ev > e2) { e2 = ev; i2 = i; } }
            const float x2 = __expf(e2 - e1), w1 = pg / (1.f + x2), w2 = pg * x2 / (1.f + x2);
            const int ex1 = gsel * 8 + i1, ex2 = gsel * 8 + i2;
            const int p1 = (int)__hip_atomic_fetch_add(cnt + ex1 * 64, 1u, __ATOMIC_RELAXED, __HIP_MEMORY_SCOPE_AGENT), p2 = (int)__hip_atomic_fetch_add(cnt + ex2 * 64, 1u, __ATOMIC_RELAXED, __HIP_MEMORY_SCOPE_AGENT);
            EID[m * 2] = ex1; EID[m * 2 + 1] = ex2; GATE[m * 2] = w1; GATE[m * 2 + 1] = w2; POS[m * 2] = p1; POS[m * 2 + 1] = p2;
            RIDX[(size_t)ex1 * MOE_CAP + p1] = m; RIDX[(size_t)ex2 * MOE_CAP + p2] = m; }
        LDS_WAIT(); asm volatile("" ::: "memory");
    }
}
DI void ph_gemm_gu(const Ctx& cx, int l) {
    TIDS; GAS unsigned char* ws = cx.ws(); LAS unsigned char* lds = (LAS unsigned char*)lds_raw;
    LAS int* moe_off = (LAS int*)(lds + MISC_OFF + 64 * 4); LAS int* moe_te = (LAS int*)(lds + MISC_OFF + 128 * 4);
    const int nT = moe_tables((const GAS unsigned*)(ws + WS_CTL) + CW_CNT + l * 32 * 64, moe_off, moe_te, tid);
    pg8::Gemm g{(const GAS bf16*)(ws + WS_H), (const GAS bf16*)(ws + WS_WTGU + (size_t)l * 32 * 512 * D * 2), nT * 256, 512, D};
    const int vc = (G % 8 == 0) ? (bid % 8) * (G / 8) + bid / 8 : bid;
    pg8::GroupedPublish S{{nT, 2, G, vc, moe_te, (size_t)512 * D * 2}, (GAS unsigned*)(ws + WS_CTL) + CW_GUC + l * MOE_MAXT * 64};
    pg8::EpiGateUp E{(GAS bf16*)(ws + WS_ACT), (unsigned)(MOE_MAXT * 256 * 256 * 2)};
    LAS int* ridx_l = (LAS int*)(lds + MISC_OFF + 4096);
    { const GAS unsigned* cntp = (const GAS unsigned*)(ws + WS_CTL) + CW_CNT + l * 32 * 64; const GAS int* RIDX = (const GAS int*)(ws + WS_RIDX);
        const int vcl = (G % 8 == 0) ? (bid % 8) * (G / 8) + bid / 8 : bid; const int i = tid >> 8, r = tid & 255, L = vcl + i * G;
        if (L < nT * 2) { const int pm = L >> 1, e = moe_te[pm], slot = pm * 256 - moe_off[e] + r; ridx_l[i * 256 + r] = slot < (int)cntp[e * 64] ? RIDX[(size_t)e * MOE_CAP + slot] : 0; }
        __syncthreads(); }
    pg8::MoeRows RM{ridx_l, vc >> 1};
    pg8::gemm_phase(lds, g, S, E, RM);
}
DI void ph_gemm_dn(const Ctx& cx, int l) {
    TIDS; GAS unsigned char* ws = cx.ws(); LAS unsigned char* lds = (LAS unsigned char*)lds_raw;
    LAS int* moe_off = (LAS int*)(lds + MISC_OFF + 64 * 4); LAS int* moe_te = (LAS int*)(lds + MISC_OFF + 128 * 4);
    const int nT = moe_tables((const GAS unsigned*)(ws + WS_CTL) + CW_CNT + l * 32 * 64, moe_off, moe_te, tid);
    pg8::Gemm g{(const GAS bf16*)(ws + WS_ACT), (const GAS bf16*)(ws + WS_WTDN + (size_t)l * 32 * D * 256 * 2), nT * 256, D, 256};
    pg8::EpiStoreBf16 E{(GAS bf16*)(ws + WS_XS), D};
    const GAS unsigned* ready = (const GAS unsigned*)(ws + WS_CTL) + CW_GUC + l * MOE_MAXT * 64;
    const int vc = (G % 8 == 0) ? (bid % 8) * (G / 8) + bid / 8 : bid;
    const int nb2 = (nT * 2 > G && nT * 2 - G < G / 2) ? nT * 2 - G : 0, Gd = G - nb2, cd = vc - nb2;
    const int pmE = nb2 ? G / 2 : nT, nE = pmE * 4, nL = (nT - pmE) * 4;
    const int cl = cd < 0 ? -1 : (cd - nE % Gd + Gd) % Gd;
    pg8::GroupedOrder S1{pmE, 4, Gd, cd, moe_te, (size_t)D * 256 * 2, 0};
    pg8::GroupedOrder S2{nT - pmE, 4, Gd, cl, moe_te, (size_t)D * 256 * 2, pmE};
    { pg8::Unit u;
#pragma unroll 1
      for (int i = 0; S1.next(i, u); ++i) pg8::wait_rowtile(ready, u.pm, 16u); }
    pg8::gemm_phase(lds, g, S1, E);
    if (nL > 0) { pg8::Unit u;
#pragma unroll 1
      for (int i = 0; S2.next(i, u); ++i) pg8::wait_rowtile(ready, u.pm, 16u);
      pg8::gemm_phase(lds, g, S2, E); }
}
DI void ph_combine(const Ctx& cx, int l) {
    TIDS; GAS unsigned char* ws = cx.ws(); LAS unsigned char* lds = (LAS unsigned char*)lds_raw;
    LAS int* moe_off = (LAS int*)(lds + MISC_OFF + 64 * 4); LAS int* moe_te = (LAS int*)(lds + MISC_OFF + 128 * 4);
    const int m_lo = (l == 0) ? 0 : NCTX;
    moe_tables((const GAS unsigned*)(ws + WS_CTL) + CW_CNT + l * 32 * 64, moe_off, moe_te, tid);
    const GAS int* EID = (const GAS int*)(ws + WS_MOE); const GAS float* GATE = (const GAS float*)(ws + WS_MOE) + MTOK * 2; const GAS int* POS = (const GAS int*)(ws + WS_MOE) + MTOK * 4;
    const GAS bf16* YS = (const GAS bf16*)(ws + WS_XS); GAS bf16* X = (GAS bf16*)(ws + WS_X); GAS bf16* H = (GAS bf16*)(ws + WS_H);
    const GAS float* MODB = (const GAS float*)(ws + WS_MOD); const GAS float* MOD = MODB + (size_t)l * 5 * 6144;
    const GAS float* n1g1 = cx.in(I_N1G) + D; const GAS float* fng = cx.in(I_FNG); GAS float* outp = cx.out();
    const int R = (MTOK - m_lo + G - 1) / G, m_beg = m_lo + bid * R + wave, m_end = min(m_lo + (bid + 1) * R, MTOK);
    f32x4 g5r[4], fgr[4]; NormPar np; int cb = -1;
    if (l != 0) {
#pragma unroll
        for (int j = 0; j < 4; ++j) fgr[j] = *(const GAS f32x4*)(fng + 4 * lane + 256 * j); }
#pragma unroll 1
    for (int m = m_beg; m < m_end; m += 8) {
        const int d0 = moe_off[EID[m * 2]] + POS[m * 2], d1 = moe_off[EID[m * 2 + 1]] + POS[m * 2 + 1];
        const float w0 = GATE[m * 2], w1 = GATE[m * 2 + 1];
        { const int b = bidx_of_row(m);
            if (b != cb) { const GAS float* mb = MOD + (size_t)b * 6144;
#pragma unroll
                for (int j = 0; j < 4; ++j) g5r[j] = *(const GAS f32x4*)(mb + 5 * 1024 + 4 * lane + 256 * j);
                if (l == 0) { const GAS float* mb1 = MODB + (size_t)(5 + b) * 6144; load_normpar(np, n1g1, mb1, mb1 + 1024, lane); }
                cb = b; } }
        f32x4 v[4];
#pragma unroll
        for (int j = 0; j < 4; ++j) { const int c = 4 * lane + 256 * j;
            const v2u a0 = *(const GAS v2u*)(YS + (size_t)d0 * D + c), a1 = *(const GAS v2u*)(YS + (size_t)d1 * D + c);
            f32x4 y; y.x = w0 * bf2f(a0.x & 0xffffu) + w1 * bf2f(a1.x & 0xffffu); y.y = w0 * bf2f(a0.x >> 16) + w1 * bf2f(a1.x >> 16);
            y.z = w0 * bf2f(a0.y & 0xffffu) + w1 * bf2f(a1.y & 0xffffu); y.w = w0 * bf2f(a0.y >> 16) + w1 * bf2f(a1.y >> 16);
            v[j] = bf4f(*(const GAS v2u*)(X + (size_t)m * D + c)) + g5r[j] * y; }
        if (l == 0) {
#pragma unroll
            for (int j = 0; j < 4; ++j) *(GAS v2u*)(X + (size_t)m * D + 4 * lane + 256 * j) = f4bf(v[j]);
            norm_row_store_c(v, np, H + (size_t)m * D, lane);
        } else {
            float ss = 0.f;
#pragma unroll
            for (int j = 0; j < 4; ++j) ss += (v[j].x * v[j].x + v[j].y * v[j].y) + (v[j].z * v[j].z + v[j].w * v[j].w);
            const float rstd = rsqrtf(wave_sum(ss) * (1.f / D) + EPS);
#pragma unroll
            for (int j = 0; j < 4; ++j) { const int c = 4 * lane + 256 * j;
                *(GAS f32x4*)(outp + (size_t)(m - NCTX) * D + c) = v[j] * rstd * fgr[j]; }
        }
    }
}

#ifndef PH_MASK
#define PH_MASK 0xFFF
#endif
#define PHON(j) (((PH_MASK) >> (j)) & 1)
__global__ void __launch_bounds__(512, 2) fwd_kernel(Args args) {
    LAS unsigned char* lds = (LAS unsigned char*)lds_raw;
    volatile LAS unsigned* MISC = (volatile LAS unsigned*)(lds + MISC_OFF);
    {
        const int tid = threadIdx.x;
        for (int u = tid; u < (LDS_BYTES - MISC_OFF) / 4; u += 512) MISC[u] = 0u;
        __syncthreads();
        if (tid == 0) { volatile LAS unsigned long long* t = (volatile LAS unsigned long long*)(lds + PTR_OFF);
#pragma unroll
            for (int i = 0; i < N_IN; ++i) t[i] = (unsigned long long)args.in[i];
            t[N_IN] = (unsigned long long)args.out; t[N_IN + 1] = (unsigned long long)args.ws; }
        __syncthreads();
    }
    const Ctx cx;
#if MK_ONE_LAUNCH
    XcdBarrier bar = xcd_barrier_post((unsigned*)(cx.ws() + WS_CTL) + CW_BAR, MISC + 8);
#define GRID_BAR() xcd_barrier(bar)
#else
#define GRID_BAR() do { } while (0)
#endif
    const int lo = args.ph_lo, hi = args.ph_hi;
#define IN(k) (lo <= (k) && (k) < hi)
#define BOTH(k) (IN(k) && IN((k) + 1))
    if (PHON(0) && IN(0)) { TIDS; phase_prologue(cx, lds, tid, lane, wave, bid, G); if (BOTH(0)) GRID_BAR(); }
    if (PHON(1) && IN(1)) { TIDS; phase_norm1_l0(cx, lane, gw, NGW); if (BOTH(1)) GRID_BAR(); }
#define LAYER(L) { constexpr int l = L; constexpr int pb = 2 + 10 * l; \
        if (PHON(2) && IN(pb + 0)) { ph_gemm_in(cx, l); if (BOTH(pb + 0)) GRID_BAR(); } \
        if (PHON(3) && IN(pb + 1)) { ph_prep_r1(cx, l); if (BOTH(pb + 1)) GRID_BAR(); } \
        if (PHON(4) && IN(pb + 2)) { rec_r2(cx, blockIdx.x * 512 + threadIdx.x, gridDim.x * 512); if (BOTH(pb + 2)) GRID_BAR(); } \
        if (PHON(5) && IN(pb + 3)) { ph_mixers(cx, l); if (BOTH(pb + 3)) GRID_BAR(); } \
        if (PHON(6) && IN(pb + 4)) { ph_gemm_out(cx, l); if (BOTH(pb + 4)) GRID_BAR(); } \
        if (PHON(7) && IN(pb + 5)) { ph_router(cx, l); if (BOTH(pb + 5)) GRID_BAR(); } \
        if (PHON(9) && IN(pb + 7)) { ph_gemm_gu(cx, l);   } \
        if (PHON(10) && IN(pb + 8)) { ph_gemm_dn(cx, l); if (BOTH(pb + 8)) GRID_BAR(); } \
        if (PHON(11) && IN(pb + 9)) { ph_combine(cx, l); if (BOTH(pb + 9)) GRID_BAR(); } }
    LAYER(0)
    LAYER(1)
#undef LAYER
#undef IN
#undef BOTH
}

constexpr int NPHASES = 22;
extern "C" void kernel_launch(void* const* d_in, const int* in_sizes, int n_in, void* d_out, int out_size, void* d_ws, size_t ws_size, hipStream_t stream) {
    static int grid = 0;
    if (grid == 0) {
        if (n_in != N_IN || out_size != NLAT * D || ws_size < WS_END) { fprintf(stderr, "kernel_launch: unexpected problem (n_in %d, out %d, ws %zu)\n", n_in, out_size, ws_size); grid = -1; return; }
        int dev = 0, cus = 0, per_cu = 0;
        if (hipGetDevice(&dev) != hipSuccess || hipDeviceGetAttribute(&cus, hipDeviceAttributeMultiprocessorCount, dev) != hipSuccess) { grid = -1; return; }
        if (hipFuncSetAttribute((const void*)fwd_kernel, hipFuncAttributeMaxDynamicSharedMemorySize, LDS_BYTES) != hipSuccess) { fprintf(stderr, "kernel_launch: hipFuncSetAttribute failed\n"); grid = -1; return; }
        if (hipOccupancyMaxActiveBlocksPerMultiprocessor(&per_cu, (const void*)fwd_kernel, 512, LDS_BYTES) != hipSuccess || per_cu < 1) fprintf(stderr, "kernel_launch: occupancy query reports %d\n", per_cu);
        (void)hipGetLastError();
        grid = cus;
    }
    if (grid < 0) return;
    (void)hipMemsetAsync((char*)d_ws + WS_CTL, 0, CTL_BYTES, stream);
    Args a{};
    for (int i = 0; i < N_IN; ++i) a.in[i] = (const float*)d_in[i];
    a.out = (float*)d_out; a.ws = (unsigned char*)d_ws;
#if MK_ONE_LAUNCH
    a.ph_lo = 0; a.ph_hi = NPHASES;
    hipLaunchKernelGGL(fwd_kernel, dim3(grid), dim3(512), LDS_BYTES, stream, a);
#else
    for (int p = 0; p < NPHASES; ++p) { a.ph_lo = p; a.ph_hi = p + 1; hipLaunchKernelGGL(fwd_kernel, dim3(grid), dim3(512), LDS_BYTES, stream, a); }
#endif
}
```

```cpp
#include <hip/hip_runtime.h>
#include <cstdio>
#include <cstdint>

#ifndef MK_ONE_LAUNCH
#define MK_ONE_LAUNCH 1
#endif

#define DI __device__ __forceinline__
#define GAS __attribute__((address_space(1)))
#define LAS __attribute__((address_space(3)))
typedef unsigned short bf16;
typedef unsigned v4u __attribute__((ext_vector_type(4)));
typedef unsigned v2u __attribute__((ext_vector_type(2)));
typedef float f32x4 __attribute__((ext_vector_type(4)));
typedef short bf16x8 __attribute__((ext_vector_type(8)));
#define LDS_WAIT() asm volatile("s_waitcnt lgkmcnt(0)" ::: "memory")

constexpr int D = 1024, NB = 4, SEQ = 4096, LCTX = 256, NCTX = NB * LCTX, NLAT = NB * SEQ, MTOK = NCTX + NLAT;
constexpr int DIN = 3200, PP = 3328;
constexpr int CA_Q = 0, CA_I = 256, CA_FF = 512, CA_FB = 768, CA_G = 1024;
constexpr int CB_Q = 1280, CB_K = 1536, CB_V = 1792;
constexpr int CC_Q = 2048, CC_K = 2176, CC_V = 2304, CC_G = 2560, CC_ZF = 2816, CC_ZB = 2832;
constexpr int CD_Q = 2848, CD_KV = 3040, CD_R = 3168;
constexpr int NKEY = LCTX + SEQ;
constexpr int NCHUNK = NKEY / 64;
constexpr float EPS = 1e-6f;
constexpr float LOG2E = 1.4426950408889634f;
constexpr int MOE_MAXT = 168;
constexpr int MOE_CAP = 2 * 17408;

enum { I_X = 0, I_C, I_CTX, I_CCTX, I_WMOD, I_BMOD, I_N1G, I_N2G, I_WIN, I_WOUT, I_LBL, I_HNG, I_RPB, I_WGF, I_BGF, I_WGB, I_BGB, I_GNG, I_QNG, I_WUQ, I_KVNG, I_WUKV,
       I_WRG, I_BRG, I_WRE, I_BRE, I_WGU, I_WDN, I_FNG, N_IN };

constexpr size_t MiB = 1u << 20;
constexpr size_t WS_CTL = 0, CTL_BYTES = 2 * MiB;
constexpr size_t WS_WTIN = 2 * MiB;
constexpr size_t WTIN_L = (size_t)PP * D * 2;
constexpr size_t WS_WTOUT = 16 * MiB;
constexpr size_t WS_WTUQ = 20 * MiB;
constexpr size_t WS_WTUKV = WS_WTUQ + 512 * 1024;
constexpr size_t WS_MOD = 21 * MiB;
constexpr size_t WS_WR = WS_MOD + 512 * 1024;
constexpr size_t WS_WTGU = 22 * MiB;
constexpr size_t WS_WTDN = 86 * MiB;
constexpr size_t WS_X = 118 * MiB;
constexpr size_t WS_H = 186 * MiB;
constexpr size_t WS_CAT = 220 * MiB;
constexpr size_t WS_P = 254 * MiB;
constexpr size_t WS_XS = WS_P;
constexpr size_t WS_ACT = 338 * MiB;
constexpr size_t WS_QM = 366 * MiB;
constexpr size_t WS_KM = 379 * MiB;
constexpr size_t WS_VM = 392 * MiB;
constexpr size_t WS_RSH = 401 * MiB;
constexpr size_t WS_RSG = 435 * MiB;
constexpr size_t WS_RAH = 452 * MiB;
constexpr size_t WS_RAG = WS_RAH + 600 * 1024;
constexpr size_t WS_MOE = 453 * MiB;
constexpr size_t WS_VNT = 454 * MiB;
constexpr size_t WS_RIDX = 463 * MiB;
constexpr size_t WS_END = 468 * MiB;
constexpr int CW_BAR = 4096;
constexpr int CW_CNT = 16384;
constexpr int CW_GUC = 32768;
constexpr int CW_TMO = 64;

constexpr int RING_BYTES = 131072;
constexpr int MISC_OFF = RING_BYTES;
constexpr int LDS_BYTES = 147456;

DI float bf2f(unsigned v) { return __uint_as_float(v << 16); }
DI unsigned f2bf(float f) { unsigned u = __float_as_uint(f); return (u + 0x7fffu + ((u >> 16) & 1u)) >> 16; }
typedef __bf16 bf16v2 __attribute__((ext_vector_type(2)));
typedef float f32x2 __attribute__((ext_vector_type(2)));
DI unsigned pk2(float lo, float hi) { const f32x2 v = {lo, hi}; return __builtin_bit_cast(unsigned, __builtin_convertvector(v, bf16v2)); }
DI f32x4 bf4f(v2u w) { f32x4 r; r.x = __uint_as_float(w.x << 16); r.y = __uint_as_float(w.x & 0xffff0000u); r.z = __uint_as_float(w.y << 16); r.w = __uint_as_float(w.y & 0xffff0000u); return r; }
DI v2u f4bf(f32x4 v) { return (v2u){pk2(v.x, v.y), pk2(v.z, v.w)}; }
DI bf16x8 pack8(float a0, float a1, float a2, float a3, float a4, float a5, float a6, float a7) {
    v4u p; p.x = pk2(a0, a1); p.y = pk2(a2, a3); p.z = pk2(a4, a5); p.w = pk2(a6, a7);
    return __builtin_bit_cast(bf16x8, p);
}
DI float wave_sum(float v) {
#pragma unroll
    for (int o = 1; o < 64; o <<= 1) v += __shfl_xor(v, o);
    return v;
}
DI float frcp_(float x) { return __builtin_amdgcn_rcpf(x); }
DI float sigmoid_(float x) { return frcp_(1.f + __expf(-x)); }
DI float silu_(float x) { return x * frcp_(1.f + __expf(-x)); }
DI float logsigmoid_(float x) { return fminf(x, 0.f) - __logf(1.f + __expf(-fabsf(x))); }
DI void unpack8(v4u w, float* f) {
    f[0] = __uint_as_float(w.x << 16); f[1] = __uint_as_float(w.x & 0xffff0000u);
    f[2] = __uint_as_float(w.y << 16); f[3] = __uint_as_float(w.y & 0xffff0000u);
    f[4] = __uint_as_float(w.z << 16); f[5] = __uint_as_float(w.z & 0xffff0000u);
    f[6] = __uint_as_float(w.w << 16); f[7] = __uint_as_float(w.w & 0xffff0000u);
}
DI int bidx_of_row(int m) { return m < NCTX ? 4 : ((m - NCTX) >> 12); }

namespace pg8 {
#define PG8_LAS __attribute__((address_space(3)))
typedef unsigned short bf16_t;
typedef unsigned u32x4 __attribute__((ext_vector_type(4)));
constexpr int BM = 256, BK = 64, HALF = 128, HTB = HALF * BK * 2, STAGE_BYTES = 8 * HTB, NXCD = 8, WGM = 8;
__host__ __device__ __forceinline__ int lds_byte(int r, int c) { const int st = (r >> 4) * 2 + (c >> 5), rr = r & 15, cc = c & 31, ob = rr * 64 + cc * 2; return st * 1024 + (ob ^ (((ob >> 9) & 1) << 5)); }
__host__ __device__ __forceinline__ void stage_rc(int b, int& R, int& C) { const int st = b / 1024, sb = b % 1024, swz = sb ^ (((sb >> 9) & 1) << 5); R = (st >> 1) * 16 + swz / 64; C = (st & 1) * 32 + (swz % 64) / 2; }
__host__ __device__ __forceinline__ int perm32(int rho) { const int n = rho >> 4, i = rho & 15; return 8 * (i >> 2) + 4 * n + (i & 3); }
struct Unit { int pm, pn; size_t bo; };
struct LinearRows { static constexpr bool LINEAR = true; __device__ __forceinline__ int operator()(const Unit& u, int r) const { return u.pm * BM + r; } };
struct MoeRows { static constexpr bool LINEAR = false; const PG8_LAS int* idx; int pm0;
    __device__ __forceinline__ int operator()(const Unit& u, int r) const { return idx[(u.pm == pm0 ? 0 : 256) + r]; } };
struct Gemm { const GAS bf16_t* A; const GAS bf16_t* Bt; int M, N, K; };
struct StaticOrder {
    int nM, nN, nwg, G, c;
    __device__ void init(int M, int N, int G_, int c_) { nM = M / BM; nN = N / BM; nwg = nM * nN; G = G_; c = c_; }
    __device__ bool next(int i, Unit& u) const {
        const long L = (long)i * G + c; if (L >= nwg) return false;
        int wgid = (int)L; { const int q = nwg / NXCD, r = nwg % NXCD, xcd = wgid % NXCD, off = wgid / NXCD; wgid = (xcd < r ? xcd * (q + 1) : r * (q + 1) + (xcd - r) * q) + off; }
        const int nig = WGM * nN, gid = wgid / nig, fm = gid * WGM, gsz = (nM - fm) < WGM ? (nM - fm) : WGM;
        u.pm = fm + ((wgid % nig) % gsz); u.pn = (wgid % nig) / gsz; u.bo = 0; return true;
    }
    __device__ __forceinline__ void a_ready(const Unit&) const {}
    __device__ __forceinline__ void done(const Unit&) const {}
};
struct GroupedOrder {
    int nT, nN, G, c; const PG8_LAS int* tile_e; size_t estride; int pm0 = 0;
    __device__ bool next(int i, Unit& u) const {
        if (c < 0) return false;
        const long L = (long)i * G + c; if (L >= (long)nT * nN) return false;
        u.pm = pm0 + (int)(L / nN); u.pn = (int)(L % nN); u.bo = (size_t)__builtin_amdgcn_readfirstlane(tile_e[u.pm]) * estride; return true;
    }
    __device__ __forceinline__ void a_ready(const Unit&) const {}
    __device__ __forceinline__ void done(const Unit&) const {}
};
struct GroupedPublish : GroupedOrder { GAS unsigned* done_cnt;
    __device__ __forceinline__ void done(const Unit& u) const { asm volatile("s_waitcnt vmcnt(0)" ::: "memory");
        if ((threadIdx.x & 63) == 0) __hip_atomic_fetch_add(done_cnt + 64 * u.pm, 1u, __ATOMIC_RELAXED, __HIP_MEMORY_SCOPE_AGENT); } };
__device__ __forceinline__ void wait_rowtile(const GAS unsigned* ready, int pm, unsigned need) {
    if (threadIdx.x < 64) {
        unsigned spins = 0;
        while ((unsigned)__builtin_amdgcn_readfirstlane(__hip_atomic_load(ready + 64 * pm, __ATOMIC_RELAXED, __HIP_MEMORY_SCOPE_AGENT)) < need && ++spins < (1u << 22)) __builtin_amdgcn_s_sleep(2);
        __builtin_amdgcn_fence(__ATOMIC_ACQUIRE, "agent");
        asm volatile("s_waitcnt vmcnt(0)" ::: "memory");
    }
    __syncthreads();
}
__device__ __forceinline__ unsigned cvt_pk_bf16(float lo, float hi) { unsigned r; asm volatile("v_cvt_pk_bf16_f32 %0, %1, %2" : "=v"(r) : "v"(lo), "v"(hi)); return r; }

struct EpiStoreBf16 {
    static constexpr bool PERM = true;
    GAS bf16_t* O; int ldc;
    __device__ __forceinline__ void operator()(const f32x4 (&acc)[2][2][4][2], const Unit& u, int wr, int wc, int fr, int fq) const {
        const int row0 = u.pm * BM + wr * 64 + fr, col0 = u.pn * BM + wc * 32 + 8 * fq;
#pragma unroll
        for (int ai = 0; ai < 2; ++ai)
#pragma unroll
            for (int m = 0; m < 4; ++m) { GAS bf16_t* rowp = O + (size_t)(row0 + ai * HALF + m * 16) * ldc + col0;
#pragma unroll
                for (int bj = 0; bj < 2; ++bj) { const f32x4 v0 = acc[ai][bj][m][0], v1 = acc[ai][bj][m][1];
                    u32x4 w; w.x = cvt_pk_bf16(v0[0], v0[1]); w.y = cvt_pk_bf16(v0[2], v0[3]); w.z = cvt_pk_bf16(v1[0], v1[1]); w.w = cvt_pk_bf16(v1[2], v1[3]);
                    *(GAS u32x4*)(rowp + bj * HALF) = w; } }
    }
};
struct EpiResid {
    static constexpr bool PERM = true;
    GAS bf16_t* X; int row_off; const GAS float* mod;
    const GAS float* src_ctx; const GAS float* src_lat;
    __device__ __forceinline__ void operator()(const f32x4 (&acc)[2][2][4][2], const Unit& u, int wr, int wc, int fr, int fq) const {
        const int row0 = row_off + u.pm * BM + wr * 64 + fr, col0 = u.pn * BM + wc * 32 + 8 * fq;
        f32x4 gv[2][2];
        { const GAS float* gp = mod + (size_t)bidx_of_row(row_off + u.pm * BM) * 6144 + col0;
#pragma unroll
            for (int bj = 0; bj < 2; ++bj)
#pragma unroll
                for (int n = 0; n < 2; ++n) gv[bj][n] = *(const GAS f32x4*)(gp + bj * HALF + n * 4); }
#pragma unroll
        for (int ai = 0; ai < 2; ++ai)
#pragma unroll
            for (int m = 0; m < 4; ++m) { const int row = row0 + ai * HALF + m * 16; GAS bf16_t* rowp = X + (size_t)row * D + col0;
                const GAS float* bp = src_lat ? (row < NCTX ? src_ctx + (size_t)row * D + col0 : src_lat + (size_t)(row - NCTX) * D + col0) : (const GAS float*)nullptr;
#pragma unroll
                for (int bj = 0; bj < 2; ++bj) { f32x4 x0, x1;
                    if (src_lat) { x0 = *(const GAS f32x4*)(bp + bj * HALF); x1 = *(const GAS f32x4*)(bp + bj * HALF + 4); }
                    else { const u32x4 w = *(const GAS u32x4*)(rowp + bj * HALF); x0 = bf4f((v2u){w.x, w.y}); x1 = bf4f((v2u){w.z, w.w}); }
                    x0 = x0 + gv[bj][0] * acc[ai][bj][m][0]; x1 = x1 + gv[bj][1] * acc[ai][bj][m][1];
                    const v2u o0 = f4bf(x0), o1 = f4bf(x1); *(GAS u32x4*)(rowp + bj * HALF) = (u32x4){o0.x, o0.y, o1.x, o1.y}; } }
    }
};
struct EpiGateUp {
    static constexpr bool PERM = true;
    GAS bf16_t* O; unsigned nbytes;
    __device__ __forceinline__ void operator()(const f32x4 (&acc)[2][2][4][2], const Unit& u, int wr, int wc, int fr, int fq) const {
        const int row0 = u.pm * BM + wr * 64 + fr, col0 = u.pn * HALF + wc * 32 + 8 * fq;
        const __amdgpu_buffer_rsrc_t rsrc = __builtin_amdgcn_make_buffer_rsrc((void*)O, 0, (int)nbytes, 0x00020000);
#pragma unroll
        for (int ai = 0; ai < 2; ++ai)
#pragma unroll
            for (int m = 0; m < 4; ++m) { const unsigned off = (unsigned)((row0 + ai * HALF + m * 16) * 256 + col0) * 2u;
                float r[8];
#pragma unroll
                for (int n = 0; n < 2; ++n)
#pragma unroll
                    for (int j = 0; j < 4; ++j) { const float g = acc[ai][0][m][n][j], up = acc[ai][1][m][n][j]; r[n * 4 + j] = g * __builtin_amdgcn_rcpf(1.f + __expf(-g)) * up; }
                u32x4 w; w.x = cvt_pk_bf16(r[0], r[1]); w.y = cvt_pk_bf16(r[2], r[3]); w.z = cvt_pk_bf16(r[4], r[5]); w.w = cvt_pk_bf16(r[6], r[7]);
                __builtin_amdgcn_raw_buffer_store_b128(w, rsrc, (int)off, 0, 16); }
    }
};

template <class Epi, class Sched, class Rows = LinearRows>
__device__ __forceinline__ void gemm_phase(PG8_LAS unsigned char* lds, const Gemm g, const Sched& S, const Epi& E, const Rows RM = Rows()) {
    const int tid = threadIdx.x, wid = __builtin_amdgcn_readfirstlane(tid >> 6), lane = tid & 63, wr = wid >> 2, wc = wid & 3, fr = lane & 15, fq = lane >> 4;
    const int K = g.K, nt = K / BK;
    unsigned voffB[2]; int rA[2], cA2[2];
#pragma unroll
    for (int i = 0; i < 2; ++i) { int R, C; stage_rc(tid * 16 + i * 8192, R, C); const int Rb = Epi::PERM ? ((R & ~31) + perm32(R & 31)) : R;
        rA[i] = R; cA2[i] = C * 2; voffB[i] = (unsigned)(Rb * K + C) * 2u; }
    unsigned oAc[2][2], oAn[2][2];
#define PG8_AOFF(dst, u) do { _Pragma("unroll") for (int _h = 0; _h < 2; ++_h) _Pragma("unroll") for (int _i = 0; _i < 2; ++_i) dst[_h][_i] = (unsigned)RM(u, _h * HALF + rA[_i]) * (unsigned)(K * 2) + (unsigned)cA2[_i]; } while (0)
#define PG8_STAGE_A(bufoff, o2, kbyte) do { _Pragma("unroll") for (int _i = 0; _i < 2; ++_i) \
        __builtin_amdgcn_global_load_lds((const unsigned*)((const char*)g.A + (size_t)(kbyte) + (o2)[_i]), (PG8_LAS unsigned*)(lds + (bufoff) + ldsw + _i * 8192), 16, 0, 0); } while (0)
    const size_t kstep = (size_t)(BK * 2);
    const size_t hstep = (size_t)HALF * K * 2;
    const size_t tstep = 2 * hstep;
    const unsigned ldsw = (unsigned)wid * 1024u;
    const int aoff = lds_byte(wr * 64 + fr, fq * 8), boff = lds_byte(wc * 32 + fr, fq * 8);
#define PG8_SA(b, h) (((b) * 2 + (h)) * HTB)
#define PG8_SB(b, h) ((4 + (b) * 2 + (h)) * HTB)
#define PG8_STAGE(bufoff, gbase, voff) do { _Pragma("unroll") for (int _i = 0; _i < 2; ++_i) \
        __builtin_amdgcn_global_load_lds((const unsigned*)((const char*)(gbase) + (voff)[_i]), (PG8_LAS unsigned*)(lds + (bufoff) + ldsw + _i * 8192), 16, 0, 0); } while (0)
#define PG8_LDA(dst, b, h) do { _Pragma("unroll") for (int m = 0; m < 4; ++m) _Pragma("unroll") for (int k = 0; k < 2; ++k) dst[m][k] = *(const PG8_LAS bf16x8*)(lds + PG8_SA(b, h) + aoff + m * 2048 + k * 1024); } while (0)
#define PG8_LDB(dst, b, h) do { _Pragma("unroll") for (int n = 0; n < 2; ++n) _Pragma("unroll") for (int k = 0; k < 2; ++k) dst[n][k] = *(const PG8_LAS bf16x8*)(lds + PG8_SB(b, h) + boff + n * 2048 + k * 1024); } while (0)
#define PG8_MMA(ai, bj, At, Bt) do { __builtin_amdgcn_s_setprio(1); _Pragma("unroll") for (int m = 0; m < 4; ++m) _Pragma("unroll") for (int n = 0; n < 2; ++n) _Pragma("unroll") for (int k = 0; k < 2; ++k) \
        acc[ai][bj][m][n] = __builtin_amdgcn_mfma_f32_16x16x32_bf16(Bt[n][k], At[m][k], acc[ai][bj][m][n], 0, 0, 0); __builtin_amdgcn_s_setprio(0); } while (0)
#define PG8_WAIT_V(n) asm volatile("s_waitcnt vmcnt(" #n ")" ::: "memory")
#define PG8_WAIT_L(n) asm volatile("s_waitcnt lgkmcnt(" #n ")" ::: "memory")
#define PG8_BAR __builtin_amdgcn_s_barrier()
#define PG8_SCHED __builtin_amdgcn_sched_barrier(0)
    Unit cur, nxt; int ui = 0;
    if (!S.next(0, cur)) return;
    f32x4 acc[2][2][4][2];
#pragma unroll
    for (int a = 0; a < 2; ++a)
#pragma unroll
        for (int b = 0; b < 2; ++b)
#pragma unroll
            for (int m = 0; m < 4; ++m)
#pragma unroll
                for (int n = 0; n < 2; ++n) acc[a][b][m][n] = (f32x4){0.f, 0.f, 0.f, 0.f};
    bf16x8 At[4][2], B0[2][2], B1[2][2];
    const char* cB = (const char*)g.Bt + cur.bo + (size_t)cur.pn * tstep;
    S.a_ready(cur);
    PG8_AOFF(oAc, cur);
    PG8_STAGE(PG8_SB(0, 0), cB, voffB); PG8_STAGE_A(PG8_SA(0, 0), oAc[0], 0); PG8_STAGE(PG8_SB(0, 1), cB + hstep, voffB); PG8_STAGE_A(PG8_SA(0, 1), oAc[1], 0);
    if (wr == 1) PG8_BAR;
    PG8_WAIT_V(4); PG8_BAR;
    PG8_STAGE(PG8_SB(1, 0), cB + kstep, voffB); PG8_STAGE_A(PG8_SA(1, 0), oAc[0], kstep); PG8_STAGE(PG8_SB(1, 1), cB + hstep + kstep, voffB);
    PG8_WAIT_V(6); PG8_BAR;
    for (;;) {
        const bool has_next = S.next(ui + 1, nxt);
        const char* nB = has_next ? (const char*)g.Bt + nxt.bo + (size_t)nxt.pn * tstep : cB;
        unsigned dAn = 0u;
        if constexpr (Rows::LINEAR) { if (has_next) dAn = (unsigned)(nxt.pm - cur.pm) * (unsigned)(BM * K * 2); }
        else { if (has_next) PG8_AOFF(oAn, nxt);
            else {
#pragma unroll
                for (int _h = 0; _h < 2; ++_h)
#pragma unroll
                    for (int _i = 0; _i < 2; ++_i) oAn[_h][_i] = oAc[_h][_i]; } }
        for (int t = 0; t < nt; t += 2) {
            const bool last = (t == nt - 2);
            const size_t k1 = (size_t)(t + 1) * kstep, k2 = last ? 0 : (size_t)(t + 2) * kstep, k3 = k2 + kstep;
            unsigned o20[2], o21[2];
#pragma unroll
            for (int _i = 0; _i < 2; ++_i) { if constexpr (Rows::LINEAR) { o20[_i] = oAc[0][_i] + (last ? dAn : 0u); o21[_i] = oAc[1][_i] + (last ? dAn : 0u); }
                else { o20[_i] = last ? oAn[0][_i] : oAc[0][_i]; o21[_i] = last ? oAn[1][_i] : oAc[1][_i]; } }
            const char* b2 = last ? nB : cB + (size_t)(t + 2) * kstep;
            const char* b3 = b2 + kstep;
            if (last && has_next) S.a_ready(nxt);
            PG8_LDB(B0, 0, 0); PG8_SCHED; PG8_LDA(At, 0, 0); PG8_STAGE_A(PG8_SA(1, 1), oAc[1], k1);
            PG8_WAIT_L(8); PG8_BAR; PG8_WAIT_L(0); PG8_MMA(0, 0, At, B0); PG8_BAR; PG8_SCHED;
            PG8_LDB(B1, 0, 1); PG8_STAGE(PG8_SB(0, 0), b2, voffB);
            PG8_BAR; PG8_WAIT_L(0); PG8_MMA(0, 1, At, B1); PG8_BAR;
            PG8_LDA(At, 0, 1); PG8_STAGE_A(PG8_SA(0, 0), o20, k2);
            PG8_BAR; PG8_WAIT_L(0); PG8_MMA(1, 0, At, B0); PG8_BAR; PG8_SCHED;
            PG8_STAGE(PG8_SB(0, 1), b2 + hstep, voffB);
            PG8_WAIT_V(6); PG8_BAR; PG8_MMA(1, 1, At, B1); PG8_BAR;
            PG8_LDB(B0, 1, 0); PG8_SCHED; PG8_LDA(At, 1, 0); PG8_STAGE_A(PG8_SA(0, 1), o21, k2);
            PG8_WAIT_L(8); PG8_BAR; PG8_WAIT_L(0); PG8_MMA(0, 0, At, B0); PG8_BAR; PG8_SCHED;
            PG8_LDB(B1, 1, 1); PG8_STAGE(PG8_SB(1, 0), b3, voffB);
            PG8_BAR; PG8_WAIT_L(0); PG8_MMA(0, 1, At, B1); PG8_BAR;
            PG8_LDA(At, 1, 1); PG8_STAGE_A(PG8_SA(1, 0), o20, k3);
            PG8_BAR; PG8_WAIT_L(0); PG8_MMA(1, 0, At, B0); PG8_BAR; PG8_SCHED;
            PG8_STAGE(PG8_SB(1, 1), b3 + hstep, voffB);
            PG8_WAIT_V(6); PG8_BAR; PG8_MMA(1, 1, At, B1); PG8_BAR;
        }
        E(acc, cur, wr, wc, fr, fq); S.done(cur);
        if (!has_next) break;
#pragma unroll
        for (int a = 0; a < 2; ++a)
#pragma unroll
            for (int b = 0; b < 2; ++b)
#pragma unroll
                for (int m = 0; m < 4; ++m)
#pragma unroll
                    for (int n = 0; n < 2; ++n) acc[a][b][m][n] = (f32x4){0.f, 0.f, 0.f, 0.f};
        cur = nxt; cB = nB; ++ui;
#pragma unroll
        for (int _h = 0; _h < 2; ++_h)
#pragma unroll
            for (int _i = 0; _i < 2; ++_i) { if constexpr (Rows::LINEAR) oAc[_h][_i] += dAn; else oAc[_h][_i] = oAn[_h][_i]; }
    }
    PG8_WAIT_V(0);
    if (wr == 0) PG8_BAR;
    PG8_BAR;
#undef PG8_SA
#undef PG8_SB
#undef PG8_STAGE
#undef PG8_STAGE_A
#undef PG8_AOFF
#undef PG8_LDA
#undef PG8_LDB
#undef PG8_MMA
#undef PG8_WAIT_V
#undef PG8_WAIT_L
#undef PG8_BAR
#undef PG8_SCHED
}
}

#define XB_TMO      128
#define XB_XCNT(j)  (256  + 64 * (j))
#define XB_XSUB(j)  (1280 + 64 * (j))
#define XB_XGEN(j)  (2304 + 64 * (j))
#define XB_TOP      3328
#define XB_TOPGEN   3392
#define XCD_BAR_WORDS 3456
#define XB_SPIN_CAP (1u << 18)
__device__ __forceinline__ unsigned xb_ld(unsigned* p)              { return __hip_atomic_load(p, __ATOMIC_RELAXED, __HIP_MEMORY_SCOPE_AGENT); }
__device__ __forceinline__ unsigned xb_add(unsigned* p, unsigned v) { return __hip_atomic_fetch_add(p, v, __ATOMIC_RELAXED, __HIP_MEMORY_SCOPE_AGENT); }
__device__ __forceinline__ unsigned xb_xcc_id() { return (unsigned)__builtin_amdgcn_s_getreg((3 << 11) | 20) & 0xFu; }
#define XB_SPIN(cond, bar) do { unsigned _sp = 0; while (cond) { __builtin_amdgcn_s_sleep(1); \
    if ((++_sp & 255u) == 0u) { if (xb_ld(&(bar)[XB_TMO])) break; if (_sp > XB_SPIN_CAP) { atomicAdd(&(bar)[XB_TMO], 1u); break; } } } } while (0)
struct XcdBarrier { unsigned* bar; unsigned x; volatile LAS unsigned* st; };
__device__ __forceinline__ XcdBarrier xcd_barrier_post(unsigned* bar, volatile LAS unsigned* st) {
    XcdBarrier b; b.bar = bar; b.x = xb_xcc_id(); b.st = st;
    if (threadIdx.x == 0) (void)xb_add(&bar[XB_XCNT(b.x)], 1u);
    return b;
}
__device__ __forceinline__ void xcd_barrier_complete(unsigned* bar, unsigned x, unsigned& nloc, unsigned& nx) {
    const unsigned G = gridDim.x * gridDim.y * gridDim.z;
    unsigned sum, cnt, mine, sp = 0u;
    for (;;) {
        sum = 0u; cnt = 0u; mine = 0u;
#pragma unroll
        for (unsigned j = 0; j < 16; ++j) { const unsigned c = xb_ld(&bar[XB_XCNT(j)]); sum += c; cnt += (c > 0u) ? 1u : 0u; mine = (j == x) ? c : mine; }
        if (sum == G) break;
        __builtin_amdgcn_s_sleep(1);
        if ((++sp & 255u) == 0u) { if (xb_ld(&bar[XB_TMO])) break; if (sp > XB_SPIN_CAP) { atomicAdd(&bar[XB_TMO], 1u); break; } }
    }
    nloc = mine > 0u ? mine : 1u; nx = cnt > 0u ? cnt : 1u;
}
__device__ __forceinline__ void xcd_barrier(const XcdBarrier& b) {
    asm volatile("s_waitcnt vmcnt(0)" ::: "memory");
    __syncthreads();
    if (threadIdx.x == 0) {
        unsigned* bar = b.bar;
        __builtin_amdgcn_s_waitcnt(0);
        unsigned nloc = b.st[0], nx = b.st[1];
        if (nloc == 0u) { xcd_barrier_complete(bar, b.x, nloc, nx); b.st[0] = nloc; b.st[1] = nx; }
        const unsigned old = xb_add(&bar[XB_XSUB(b.x)], 1u);
        const unsigned gen = old / nloc;
        if (old + 1u == (gen + 1u) * nloc) {
            __builtin_amdgcn_fence(__ATOMIC_RELEASE, "agent");
            asm volatile("s_waitcnt vmcnt(0)" ::: "memory");
            const unsigned og = xb_add(&bar[XB_TOP], 1u);
            const unsigned tg = og / nx;
            if (og + 1u == (tg + 1u) * nx) xb_add(&bar[XB_TOPGEN], 1u);
            else XB_SPIN(xb_ld(&bar[XB_TOPGEN]) == tg, bar);
            __builtin_amdgcn_fence(__ATOMIC_ACQUIRE, "agent");
            xb_add(&bar[XB_XGEN(b.x)], 1u);
            asm volatile("s_waitcnt vmcnt(0)" ::: "memory");
        } else {
            XB_SPIN(xb_ld(&bar[XB_XGEN(b.x)]) == gen, bar);
            __builtin_amdgcn_fence(__ATOMIC_ACQUIRE, "agent");
            asm volatile("s_waitcnt vmcnt(0)" ::: "memory");
        }
    }
    __syncthreads();
}

struct Args { const float* in[N_IN]; float* out; unsigned char* ws; int ph_lo, ph_hi; int pad0, pad1; };
extern __shared__ __attribute__((aligned(16))) unsigned char lds_raw[];
constexpr int PTR_OFF = MISC_OFF + 2048;
struct Ctx {
    DI unsigned long long raw(int i) const { volatile LAS unsigned* t = (volatile LAS unsigned*)((LAS unsigned char*)lds_raw + PTR_OFF) + 2 * i;
        const unsigned lo = __builtin_amdgcn_readfirstlane(t[0]), hi = __builtin_amdgcn_readfirstlane(t[1]); return ((unsigned long long)hi << 32) | lo; }
    DI const GAS float* in(int i) const { return (const GAS float*)raw(i); }
    DI GAS float* out() const { return (GAS float*)raw(N_IN); }
    DI GAS unsigned char* ws() const { return (GAS unsigned char*)raw(N_IN + 1); }
};

DI void transpose_item(const GAS float* W, int N, int k0, int n0, GAS bf16* WT, int Kd, int drow0, LAS float* scr, int lane) {
    float wv[32];
#pragma unroll
    for (int i = 0; i < 32; ++i) wv[i] = W[(size_t)(k0 + 2 * i + (lane >> 5)) * N + n0 + (lane & 31)];
#pragma unroll
    for (int i = 0; i < 32; ++i) scr[(2 * i + (lane >> 5)) * 33 + (lane & 31)] = wv[i];
    LDS_WAIT(); asm volatile("" ::: "memory");
    const int c = lane & 7;
#pragma unroll
    for (int j = 0; j < 4; ++j) { const int n = (lane >> 3) + 8 * j; const LAS float* s = scr + (8 * c) * 33 + n;
        v4u o; o.x = pk2(s[0 * 33], s[1 * 33]); o.y = pk2(s[2 * 33], s[3 * 33]); o.z = pk2(s[4 * 33], s[5 * 33]); o.w = pk2(s[6 * 33], s[7 * 33]);
        *(GAS v4u*)(WT + (size_t)(drow0 + n) * Kd + k0 + 8 * c) = o; }
    LDS_WAIT(); asm volatile("" ::: "memory");
}

DI void weight_copies(const Ctx& a, int l, LAS unsigned char* lds, int tid, int lane, int wave, int gwv, int ngw, int gt, int ngt) {
    GAS unsigned char* ws = a.ws();
    for (int i = gt; i < 128 * 1024 / 8; i += ngt) *(GAS v4u*)(ws + WS_WTIN + (size_t)l * WTIN_L + (size_t)3200 * D * 2 + (size_t)i * 16) = (v4u){0u, 0u, 0u, 0u};
    LAS float* scr = (LAS float*)(lds + wave * 16384);
    constexpr int IT_IN = 16 * 100, IT_OUT = 16 * 32, IT_UQ = 3 * 12, IT_UKV = 2 * 16, IT_GU = 32 * 16 * 16, IT_DN = 32 * 4 * 32;
    constexpr int NITEMS = IT_IN + IT_OUT + IT_UQ + IT_UKV + IT_GU + IT_DN;
    for (int it = gwv; it < NITEMS; it += ngw) {
        int r = it;
        if (r < IT_IN) { const int kb = r / 100, nb = r % 100;
            transpose_item(a.in(I_WIN) + (size_t)l * D * DIN, DIN, kb * 64, nb * 32, (GAS bf16*)(ws + WS_WTIN + (size_t)l * WTIN_L), D, nb * 32, scr, lane); continue; } r -= IT_IN;
        if (r < IT_OUT) { const int kb = r / 32, nb = r % 32;
            transpose_item(a.in(I_WOUT) + (size_t)l * D * D, D, kb * 64, nb * 32, (GAS bf16*)(ws + WS_WTOUT + (size_t)l * D * D * 2), D, nb * 32, scr, lane); continue; } r -= IT_OUT;
        if (r < IT_UQ) { const int kb = r / 12, nb = r % 12;
            transpose_item(a.in(I_WUQ) + (size_t)l * 192 * 384, 384, kb * 64, nb * 32, (GAS bf16*)(ws + WS_WTUQ + (size_t)l * 384 * 192 * 2), 192, nb * 32, scr, lane); continue; } r -= IT_UQ;
        if (r < IT_UKV) { const int kb = r / 16, nb = r % 16;
            transpose_item(a.in(I_WUKV) + (size_t)l * 128 * 512, 512, kb * 64, nb * 32, (GAS bf16*)(ws + WS_WTUKV + (size_t)l * 512 * 128 * 2), 128, nb * 32, scr, lane); continue; } r -= IT_UKV;
        if (r < IT_GU) { const int le = l * 32 + r / 256, q = r % 256, kb = q / 16, nb = q % 16; const int n0 = nb * 32, c0 = n0 & 255, isup = n0 >> 8;
            const int drow0 = (c0 >> 7) * 256 + isup * 128 + (c0 & 127);
            transpose_item(a.in(I_WGU) + (size_t)le * D * 512, 512, kb * 64, n0, (GAS bf16*)(ws + WS_WTGU + (size_t)le * 512 * D * 2), D, drow0, scr, lane); continue; } r -= IT_GU;
        { const int le = l * 32 + r / 128, q = r % 128, kb = q / 32, nb = q % 32;
            transpose_item(a.in(I_WDN) + (size_t)le * 256 * D, D, kb * 64, nb * 32, (GAS bf16*)(ws + WS_WTDN + (size_t)le * D * 256 * 2), 256, nb * 32, scr, lane); }
    }
}

DI void phase_prologue(const Ctx& a, LAS unsigned char* lds, int tid, int lane, int wave, int bid, int G) {
    GAS unsigned char* ws = a.ws();
    GAS float* MOD = (GAS float*)(ws + WS_MOD);
    {
        LAS float* S = (LAS float*)lds;
        LAS float* R = (LAS float*)(lds + 5 * 1024 * 4);
        if (bid < 192) {
            const GAS float* cvec = a.in(I_C); const GAS float* cctx = a.in(I_CCTX);
            for (int i = tid; i < 5 * 1024; i += 512) { const int r = i >> 10, k = i & 1023; const float v = r < 4 ? cvec[r * 1024 + k] : cctx[k]; S[i] = silu_(v); }
        }
        __syncthreads();
        for (int u = bid; u < 192; u += G) {
            const int l = u / 96, cl = tid & 63, n = (u % 96) * 64 + cl, ks = tid >> 6;
            const GAS float* W = a.in(I_WMOD) + (size_t)l * 1024 * 6144 + n; const GAS float* bmod = a.in(I_BMOD);
            float acc[5] = {0.f, 0.f, 0.f, 0.f, 0.f};
            for (int k = ks * 128; k < ks * 128 + 128; ++k) { const float w = W[(size_t)k * 6144];
#pragma unroll
                for (int r = 0; r < 5; ++r) acc[r] += S[r * 1024 + k] * w; }
#pragma unroll
            for (int r = 0; r < 5; ++r) R[(ks * 5 + r) * 64 + cl] = acc[r];
            __syncthreads();
            if (tid < 320) { const int r = tid >> 6; float s = 0.f;
#pragma unroll
                for (int k2 = 0; k2 < 8; ++k2) s += R[(k2 * 5 + r) * 64 + cl];
                MOD[(size_t)(l * 5 + r) * 6144 + n] = s + bmod[l * 6144 + n]; }
            __syncthreads();
        }
    }
    for (int i = bid * 512 + tid; i < 2 * 48 * 1024; i += G * 512) { const int l = i / (48 * 1024), r = i % (48 * 1024), c = r >> 10, k = r & 1023;
        const float w = c < 4 ? a.in(I_WRG)[(size_t)l * D * 4 + k * 4 + c] : (c < 36 ? a.in(I_WRE)[(size_t)l * D * 32 + k * 32 + (c - 4)] : 0.f);
        const unsigned hi = f2bf(w); const float lo = w - bf2f(hi);
        GAS bf16* WR = (GAS bf16*)(ws + WS_WR) + (size_t)l * 2 * 48 * 1024;
        WR[c * 1024 + k] = (bf16)hi; WR[48 * 1024 + c * 1024 + k] = (bf16)f2bf(lo); }
    weight_copies(a, 0, lds, tid, lane, wave, bid * 8 + wave, G * 8, bid * 512 + tid, G * 512);
}

DI void norm_row_store(const f32x4 (&v)[4], const GAS float* g, const GAS float* shift, const GAS float* scale, GAS bf16* hrow, int lane) {
    float ss = 0.f;
#pragma unroll
    for (int j = 0; j < 4; ++j) ss += (v[j].x * v[j].x + v[j].y * v[j].y) + (v[j].z * v[j].z + v[j].w * v[j].w);
    const float rstd = rsqrtf(wave_sum(ss) * (1.f / D) + EPS);
#pragma unroll
    for (int j = 0; j < 4; ++j) { const int c = 4 * lane + 256 * j;
        const f32x4 gg = *(const GAS f32x4*)(g + c), sh = *(const GAS f32x4*)(shift + c), sc = *(const GAS f32x4*)(scale + c);
        const f32x4 y = v[j] * rstd * gg * (1.f + sc) + sh;
        v2u o; o.x = pk2(y.x, y.y); o.y = pk2(y.z, y.w); *(GAS v2u*)(hrow + c) = o; }
}

struct NormPar { f32x4 w[4], sh[4]; };
DI void load_normpar(NormPar& p, const GAS float* g, const GAS float* shift, const GAS float* scale, int lane) {
#pragma unroll
    for (int j = 0; j < 4; ++j) { const int c = 4 * lane + 256 * j; const f32x4 gg = *(const GAS f32x4*)(g + c), sc = *(const GAS f32x4*)(scale + c); p.w[j] = gg * (1.f + sc); p.sh[j] = *(const GAS f32x4*)(shift + c); }
}
DI void norm_row_store_c(const f32x4 (&v)[4], const NormPar& p, GAS bf16* hrow, int lane) {
    float ss = 0.f;
#pragma unroll
    for (int j = 0; j < 4; ++j) ss += (v[j].x * v[j].x + v[j].y * v[j].y) + (v[j].z * v[j].z + v[j].w * v[j].w);
    const float rstd = rsqrtf(wave_sum(ss) * (1.f / D) + EPS);
#pragma unroll
    for (int j = 0; j < 4; ++j) { const f32x4 y = v[j] * rstd * p.w[j] + p.sh[j]; v2u o; o.x = pk2(y.x, y.y); o.y = pk2(y.z, y.w); *(GAS v2u*)(hrow + 4 * lane + 256 * j) = o; }
}

DI void phase_norm1_l0(const Ctx& a, int lane, int gw, int NGW) {
    GAS unsigned char* ws = a.ws(); GAS bf16* H = (GAS bf16*)(ws + WS_H); const GAS float* MOD = (const GAS float*)(ws + WS_MOD);
    const GAS float* xin = a.in(I_X); const GAS float* cin = a.in(I_CTX); const GAS float* n1g = a.in(I_N1G);
    const int nwg = NGW >> 3, R = (MTOK + nwg - 1) / nwg, m_beg = (gw >> 3) * R + (gw & 7), m_end = min(((gw >> 3) + 1) * R, MTOK);
    NormPar np; int cb = -1;
#pragma unroll 1
    for (int m = m_beg; m < m_end; m += 8) {
        const GAS float* src = m < NCTX ? cin + (size_t)m * D : xin + (size_t)(m - NCTX) * D;
        f32x4 v[4];
#pragma unroll
        for (int j = 0; j < 4; ++j) v[j] = *(const GAS f32x4*)(src + 4 * lane + 256 * j);
        const int b = bidx_of_row(m);
        if (b != cb) { const GAS float* mb = MOD + (size_t)b * 6144; load_normpar(np, n1g, mb, mb + 1024, lane); cb = b; }
        norm_row_store_c(v, np, H + (size_t)m * D, lane);
    }
}

DI bf16x8 ld8(const LAS bf16* p) { return *(const LAS bf16x8*)p; }
DI bf16x8 ld8(const GAS bf16* p) { return *(const GAS bf16x8*)p; }
template <class PA, class PB>
DI f32x4 mma16(PA A, int lda, PB B, int ldb, int K, int lane) {
    f32x4 acc = {0.f, 0.f, 0.f, 0.f};
    const int r = lane & 15, q = (lane >> 4) * 8;
    for (int k = 0; k < K; k += 32) {
        const bf16x8 av = ld8(A + r * lda + k + q);
        const bf16x8 bv = ld8(B + r * ldb + k + q);
        acc = __builtin_amdgcn_mfma_f32_16x16x32_bf16(av, bv, acc, 0, 0, 0);
    }
    return acc;
}

constexpr int CQ_P = 200, CKV_P = 136, STG_P = 520;
constexpr int PR = 64, PL_CQ = 0, PL_CKV = 25600, PL_RK = 43008, PL_STG = 47104, PL_T = PL_STG;
DI float rope_ang(int t, int ri) { const int ax = ri >> 4, f = ri & 7; const float p = (float)(ax == 0 ? (t >> 6) : (t & 63)); return p * __builtin_amdgcn_exp2f(-1.6609640474436813f * (float)f) * 0.15915494309189535f; }
DI void prep_unit(const Ctx& a, int l, int unit, LAS unsigned char* lds, int tid, int lane, int wave) {
    GAS unsigned char* ws = a.ws();
    const GAS bf16* P = (const GAS bf16*)(ws + WS_P);
    LAS bf16* CQ = (LAS bf16*)(lds + PL_CQ); LAS bf16* CKV = (LAS bf16*)(lds + PL_CKV); LAS bf16* STG = (LAS bf16*)(lds + PL_STG); LAS bf16* RK = (LAS bf16*)(lds + PL_RK); LAS bf16* T = (LAS bf16*)(lds + PL_T);
    const int m0 = unit * PR;
    const bool isctx = m0 < NCTX;
    const int bb = isctx ? (m0 >> 8) : ((m0 - NCTX) >> 12);
    const int pos0 = isctx ? (m0 & 255) : (256 + ((m0 - NCTX) & 4095));
    const int t0 = isctx ? 0 : ((m0 - NCTX) & 4095);
    { const GAS float* gq = a.in(I_QNG) + l * 192; const GAS float* gkv = a.in(I_KVNG) + l * 128;
        const bool isq = lane < 24, iskv = lane >= 24 && lane < 40; const int pc = isq ? lane : lane - 24;
        float gn[8];
#pragma unroll
        for (int e = 0; e < 8; ++e) gn[e] = isq ? gq[pc * 8 + e] : (iskv ? gkv[pc * 8 + e] : 0.f);
#pragma unroll
        for (int rr = 0; rr < PR / 8; ++rr) { const int r = wave * (PR / 8) + rr; float x[8];
            v4u w = (v4u){0u, 0u, 0u, 0u}; if (lane < 40) w = *(const GAS v4u*)(P + (size_t)(m0 + r) * PP + (isq ? CD_Q : CD_KV) + pc * 8);
            unpack8(w, x); float ss = 0.f;
#pragma unroll
            for (int e = 0; e < 8; ++e) ss += x[e] * x[e];
            const float sq = wave_sum(isq ? ss : 0.f), skv = wave_sum(iskv ? ss : 0.f);
            const float rs = isq ? rsqrtf(sq * (1.f / 192.f) + EPS) : rsqrtf(skv * (1.f / 128.f) + EPS);
#pragma unroll
            for (int e = 0; e < 8; ++e) x[e] *= rs * gn[e];
            const v4u o = (v4u){pk2(x[0], x[1]), pk2(x[2], x[3]), pk2(x[4], x[5]), pk2(x[6], x[7])};
            if (isq) *(LAS v4u*)(CQ + r * CQ_P + pc * 8) = o; else if (iskv) *(LAS v4u*)(CKV + r * CKV_P + pc * 8) = o; } }
    for (int e = tid; e < PR * 32; e += 512) { const int r = e >> 5, ri = e & 31; const GAS bf16* prow = P + (size_t)(m0 + r) * PP + CD_R;
        float v = bf2f(prow[ri]);
        if (!isctx) { const float pv = bf2f(prow[ri ^ 8]); const float ang = rope_ang(t0 + r, ri); const float cs = __builtin_amdgcn_cosf(ang), sn = __builtin_amdgcn_sinf(ang);
            v = ((ri >> 3) & 1) == 0 ? (v * cs - pv * sn) : (pv * sn + v * cs); }
        RK[r * 32 + ri] = (bf16)f2bf(v); }
    for (int e = tid; e < PR * 32; e += 512) { const int r = e >> 5, c8 = e & 31; *(LAS v4u*)(T + r * 264 + c8 * 8) = *(const GAS v4u*)(P + (size_t)(m0 + r) * PP + CB_V + c8 * 8); }
    __syncthreads();
    GAS bf16* QM = (GAS bf16*)(ws + WS_QM); GAS bf16* KM = (GAS bf16*)(ws + WS_KM); GAS bf16* VM = (GAS bf16*)(ws + WS_VM); GAS bf16* VNT = (GAS bf16*)(ws + WS_VNT);
    const GAS bf16* WTQ = (const GAS bf16*)(ws + WS_WTUQ + (size_t)l * 384 * 192 * 2);
    const GAS bf16* WTKV = (const GAS bf16*)(ws + WS_WTUKV + (size_t)l * 512 * 128 * 2);
    const float qs = 0.10206207261596575f * LOG2E;
    const int fr = lane & 15, fq = lane >> 4;
    for (int e = tid; e < 256 * (PR / 8); e += 512) { const int col = e / (PR / 8), p8 = e % (PR / 8); unsigned hv[8];
#pragma unroll
        for (int j = 0; j < 8; ++j) hv[j] = T[(p8 * 8 + j) * 264 + col];
        *(GAS v4u*)(VNT + ((size_t)(bb * 4) * 64 + col) * NKEY + pos0 + p8 * 8) = (v4u){hv[0] | (hv[1] << 16), hv[2] | (hv[3] << 16), hv[4] | (hv[5] << 16), hv[6] | (hv[7] << 16)}; }
    __syncthreads();
    { bf16x8 bfr[3][6];
#pragma unroll
      for (int i = 0; i < 3; ++i)
#pragma unroll
        for (int ks = 0; ks < 6; ++ks) bfr[i][ks] = *(const GAS bf16x8*)(WTQ + (size_t)((wave + 8 * i) * 16 + fr) * 192 + ks * 32 + fq * 8);
#pragma unroll
      for (int i = 0; i < 3; ++i) { const int nb = wave + 8 * i;
        const int c = nb * 16 + fr, within = c % 96;
#pragma unroll
        for (int mb = 0; mb < PR / 16; ++mb) { f32x4 acc = {0.f, 0.f, 0.f, 0.f};
#pragma unroll
            for (int ks = 0; ks < 6; ++ks) acc = __builtin_amdgcn_mfma_f32_16x16x32_bf16(*(const LAS bf16x8*)(CQ + (mb * 16 + fr) * CQ_P + ks * 32 + fq * 8), bfr[i][ks], acc, 0, 0, 0);
#pragma unroll
            for (int j = 0; j < 4; ++j) { const int r = mb * 16 + 4 * fq + j; float v = acc[j]; const float pv = __shfl_xor(v, 8);
                if (within >= 64 && !isctx) { const int ri = within - 64; const float ang = rope_ang(t0 + r, ri); const float cs = __builtin_amdgcn_cosf(ang), sn = __builtin_amdgcn_sinf(ang);
                    v = ((ri >> 3) & 1) == 0 ? (v * cs - pv * sn) : (pv * sn + v * cs); }
                STG[r * STG_P + c] = (bf16)f2bf(v * qs); } } } }
    __syncthreads();
    for (int e = tid; e < PR * 48; e += 512) { const int r = e / 48, hp = e % 48, hd = hp / 12, pc = hp % 12;
        *(GAS v4u*)(QM + ((size_t)(bb * 4 + hd) * NKEY + pos0 + r) * 96 + pc * 8) = *(const LAS v4u*)(STG + r * STG_P + hd * 96 + pc * 8); }
    __syncthreads();
    { bf16x8 bfr[4][4];
#pragma unroll
      for (int i = 0; i < 4; ++i)
#pragma unroll
        for (int ks = 0; ks < 4; ++ks) bfr[i][ks] = *(const GAS bf16x8*)(WTKV + (size_t)((wave + 8 * i) * 16 + fr) * 128 + ks * 32 + fq * 8);
#pragma unroll
      for (int i = 0; i < 4; ++i) { const int nb = wave + 8 * i;
#pragma unroll
        for (int mb = 0; mb < PR / 16; ++mb) { f32x4 acc = {0.f, 0.f, 0.f, 0.f};
#pragma unroll
            for (int ks = 0; ks < 4; ++ks) acc = __builtin_amdgcn_mfma_f32_16x16x32_bf16(*(const LAS bf16x8*)(CKV + (mb * 16 + fr) * CKV_P + ks * 32 + fq * 8), bfr[i][ks], acc, 0, 0, 0);
#pragma unroll
            for (int j = 0; j < 4; ++j) STG[(mb * 16 + 4 * fq + j) * STG_P + nb * 16 + fr] = (bf16)f2bf(acc[j]); } } }
    __syncthreads();
    for (int e = tid; e < PR * 48; e += 512) { const int r = e / 48, hp = e % 48, hd = hp / 12, pc = hp % 12;
        const v4u v = pc < 8 ? *(const LAS v4u*)(STG + r * STG_P + hd * 128 + pc * 8) : *(const LAS v4u*)(RK + r * 32 + (pc - 8) * 8);
        *(GAS v4u*)(KM + ((size_t)(bb * 4 + hd) * NKEY + pos0 + r) * 96 + pc * 8) = v; }
    for (int e = tid; e < 256 * (PR / 8); e += 512) { const int col = e / (PR / 8), p8 = e % (PR / 8), hd = col >> 6, dv = col & 63; unsigned hv[8];
#pragma unroll
        for (int j = 0; j < 8; ++j) hv[j] = STG[(p8 * 8 + j) * STG_P + hd * 128 + 64 + dv];
        *(GAS v4u*)(VM + ((size_t)(bb * 4 + hd) * 64 + dv) * NKEY + pos0 + p8 * 8) = (v4u){hv[0] | (hv[1] << 16), hv[2] | (hv[3] << 16), hv[4] | (hv[5] << 16), hv[6] | (hv[7] << 16)}; }
    __syncthreads();
}

constexpr int RP = 65;
DI int scan_row(int b, int dir, int c, int i) {
    const int s = 64 * c + i;
    if (dir == 0) return s < 256 ? b * 256 + s : NCTX + b * SEQ + (s - 256);
    return s < 256 ? b * 256 + 255 - s : NCTX + b * SEQ + SEQ - 1 - (s - 256);
}
#ifndef BAR_LDS
#define BAR_LDS() asm volatile("s_waitcnt lgkmcnt(0)\n\ts_barrier" ::: "memory")
#endif
constexpr int RC_P = 68;
constexpr int L_C = 0, L_QD = 17408, L_QE = 26624, L_KD = 35840, L_VT = 58880, L_ST = 68096, L_ATT = 77312, L_O = 86528, L_T = 103168;
template <int MIX> struct RecCfg { static constexpr int DK = MIX == 0 ? 64 : 32, DKP = DK + 8, NP = DK / 8, CPT = DK / 8; };
template <int MIX> struct RecPre {
    v4u fk;
    v4u zg[MIX == 1 ? 2 : 1];
    v4u qp;
    v4u vp; f32x4 s0, s1;
};
template <int MIX, bool R3>
DI void rec_fetch(RecPre<MIX>& R, const GAS bf16* P, const GAS float* RSbase, int b, int h, int dir, int c, int tid) {
    constexpr int DK = RecCfg<MIX>::DK;
    const int lane = tid & 63, wave = tid >> 6;
    const GAS bf16* prow = P + (size_t)scan_row(b, dir, c, lane) * PP;
    if (MIX == 0) { R.fk = *(const GAS v4u*)(prow + (dir ? CA_FB : CA_FF) + h * 64 + 8 * wave); if (R3) R.qp = *(const GAS v4u*)(prow + CA_Q + h * 64 + 8 * wave); }
    else { const GAS bf16* zr = prow + (dir ? CC_ZB : CC_ZF); R.zg[0] = *(const GAS v4u*)zr; R.zg[1] = *(const GAS v4u*)(zr + 8);
        const v2u kk = *(const GAS v2u*)(prow + CC_K + h * 32 + 4 * wave); R.fk = (v4u){kk.x, kk.y, 0u, 0u};
        if (R3) { const v2u qq = *(const GAS v2u*)(prow + CC_Q + h * 32 + 4 * wave); R.qp = (v4u){qq.x, qq.y, 0u, 0u}; } }
    R.vp = *(const GAS v4u*)(P + (size_t)scan_row(b, dir, c, tid >> 3) * PP + (MIX == 0 ? CA_I : CC_V) + h * 64 + (tid & 7) * 8);
    if (R3 && tid < DK * 8) { const GAS float* rs = RSbase + (size_t)(((b * 4 + h) * 2 + dir) * NCHUNK + c) * DK * 64 + (tid >> 3) * 64 + (tid & 7) * 8; R.s0 = *(const GAS f32x4*)rs; R.s1 = *(const GAS f32x4*)(rs + 4); }
}
DI float dpp_shr_(float v, int ctrl_sel) { const int iv = __builtin_bit_cast(int, v); int r;
    switch (ctrl_sel) { case 1: r = __builtin_amdgcn_update_dpp(0, iv, 0x111, 0xf, 0xf, true); break; case 2: r = __builtin_amdgcn_update_dpp(0, iv, 0x112, 0xf, 0xf, true); break;
                        case 4: r = __builtin_amdgcn_update_dpp(0, iv, 0x114, 0xf, 0xf, true); break; default: r = __builtin_amdgcn_update_dpp(0, iv, 0x118, 0xf, 0xf, true); break; }
    return __builtin_bit_cast(float, r); }
DI float scan64(float v) {
    v += dpp_shr_(v, 1); v += dpp_shr_(v, 2); v += dpp_shr_(v, 4); v += dpp_shr_(v, 8);
    v += __builtin_bit_cast(float, __builtin_amdgcn_update_dpp(0, __builtin_bit_cast(int, v), 0x142, 0xa, 0xf, false));
    v += __builtin_bit_cast(float, __builtin_amdgcn_update_dpp(0, __builtin_bit_cast(int, v), 0x143, 0xc, 0xf, false));
    return v; }
DI float lane_read(float v, int ln) { return __builtin_bit_cast(float, __builtin_amdgcn_readlane(__builtin_bit_cast(int, v), ln)); }
template <int MIX>
DI void rec_front(const RecPre<MIX>& R, const GAS float* lg, const GAS float* wgp, const GAS float* bgp, int l, int h, int dir, int wave, float (&kv)[RecCfg<MIX>::CPT], float (&cum)[RecCfg<MIX>::CPT]) {
    if (MIX == 0) { float z[8]; unpack8(R.fk, z);
#pragma unroll
        for (int e = 0; e < 8; ++e) { const int ch = h * 64 + 8 * wave + e; float lb = 0.f; if (l == 1) lb = sigmoid_(lg[512 + dir * 256 + ch] - lg[dir * 256 + ch]);
            const float f = lb + (1.f - lb) * sigmoid_(z[e]); cum[e] = scan64(__logf(f)); kv[e] = (1.f - lb) * sigmoid_(-z[e]); }
    } else { float z[16], kk[8]; unpack8(R.zg[0], z); unpack8(R.zg[1], z + 8); unpack8(R.fk, kk);
#pragma unroll
        for (int c = 0; c < 4; ++c) { const int ch = h * 32 + 4 * wave + c; float sacc = bgp[ch];
#pragma unroll
            for (int r = 0; r < 16; ++r) sacc += z[r] * wgp[r * 128 + ch];
            cum[c] = scan64(logsigmoid_(sacc) * (1.f / 16.f)); kv[c] = kk[c]; } }
}
template <int N> DI void st_bf16(LAS bf16* p, const float (&v)[N]) {
    if (N == 8) *(LAS v4u*)p = (v4u){pk2(v[0], v[1]), pk2(v[2], v[3]), pk2(v[4], v[5]), pk2(v[6], v[7])};
    else *(LAS v2u*)p = (v2u){pk2(v[0], v[1]), pk2(v[2], v[3])};
}
DI void rec_vt_store(const v4u vp, LAS bf16* VT, int tid) { const int j = tid >> 3, v8 = tid & 7; const unsigned ww[4] = {vp.x, vp.y, vp.z, vp.w};
#pragma unroll
    for (int e = 0; e < 8; ++e) VT[(v8 * 8 + e) * 72 + j] = (bf16)((ww[e >> 1] >> ((e & 1) * 16)) & 0xffffu); }

template <int MIX>
DI void rec_r1_run(const Ctx& a, int l, LAS unsigned char* lds, int tid, int bid, int G) {
    constexpr int DK = RecCfg<MIX>::DK, CPT = RecCfg<MIX>::CPT;
    const int lane = tid & 63, wave = __builtin_amdgcn_readfirstlane(tid >> 6);
    LAS bf16* KT = (LAS bf16*)(lds + L_KD); LAS bf16* VT = (LAS bf16*)(lds + L_VT);
    GAS unsigned char* wsb = a.ws(); const GAS bf16* P = (const GAS bf16*)(wsb + WS_P);
    GAS float* RSb = (GAS float*)(wsb + (MIX == 0 ? WS_RSH : WS_RSG)); GAS float* RAb = (GAS float*)(wsb + (MIX == 0 ? WS_RAH : WS_RAG));
    const GAS float* lg = a.in(I_LBL);
    const GAS float* wgF = a.in(I_WGF) + l * 16 * 128; const GAS float* wgB = a.in(I_WGB) + l * 16 * 128; const GAS float* bgF = a.in(I_BGF) + l * 128; const GAS float* bgB = a.in(I_BGB) + l * 128;
    constexpr int NU = 32 * NCHUNK;
    const bool rebal = (MIX == 0) && (G == 256);
    const int n0 = (rebal && bid < 16) ? 8 : 0, nn = (NU - 1 - bid) / G + 1, n1 = nn + ((rebal && bid >= 128) ? 1 : 0);
    auto unit_at = [&](int n) { if (n >= n1) return NU; if (n < nn) return bid + G * n; const int e = bid - 128; return (e & 15) + G * (e >> 4); };
    RecPre<MIX> Rs[2];
    int nidx = n0;
    int u0 = unit_at(nidx), u1 = unit_at(nidx + 1);
#pragma unroll
    for (int par = 0; par < 2; ++par) { const int unit = par ? u1 : u0; if (unit < NU) { const int c = unit % NCHUNK, chain = unit / NCHUNK; rec_fetch<MIX, false>(Rs[par], P, RSb, chain >> 3, (chain >> 1) & 3, chain & 1, c, tid); } }
    BAR_LDS();
#pragma unroll 1
    while (u0 < NU) {
        const int n2 = unit_at(nidx + 2), n3 = unit_at(nidx + 3);
#pragma unroll
        for (int par = 0; par < 2; ++par) { const int unit = par ? u1 : u0; if (unit < NU) { RecPre<MIX>& R = Rs[par];
            LAS bf16* KTp = par ? (LAS bf16*)(lds + L_ST) : KT; LAS bf16* VTp = par ? (LAS bf16*)(lds + L_ATT) : VT;
            const int c = unit % NCHUNK, chain = unit / NCHUNK, dir = chain & 1, h = (chain >> 1) & 3;
            { float kv[CPT], cum[CPT]; rec_front<MIX>(R, lg, dir ? wgB : wgF, dir ? bgB : bgF, l, h, dir, wave, kv, cum);
#pragma unroll
                for (int e = 0; e < CPT; ++e) { const float last = lane_read(cum[e], 63); KTp[(CPT * wave + e) * 72 + lane] = (bf16)f2bf(kv[e] * __expf(last - cum[e]));
                    if (lane == 63) RAb[(size_t)(chain * NCHUNK + c) * DK + CPT * wave + e] = __expf(cum[e]); } }
            rec_vt_store(R.vp, VTp, tid);
            { const int nu = par ? n3 : n2; if (nu < NU) { const int c2 = nu % NCHUNK, ch2 = nu / NCHUNK; rec_fetch<MIX, false>(R, P, RSb, ch2 >> 3, (ch2 >> 1) & 3, ch2 & 1, c2, tid); } } } }
        BAR_LDS();
#pragma unroll
        for (int par = 0; par < 2; ++par) { const int unit = par ? u1 : u0; if (unit < NU) {
            const LAS bf16* KTp = par ? (const LAS bf16*)(lds + L_ST) : KT; const LAS bf16* VTp = par ? (const LAS bf16*)(lds + L_ATT) : VT;
            const int c = unit % NCHUNK, chain = unit / NCHUNK;
            GAS float* RS = RSb + (size_t)(chain * NCHUNK + c) * DK * 64;
#pragma unroll 1
            for (int tl = wave; tl < (DK / 16) * 4; tl += 8) { const int kb = tl >> 2, vb = tl & 3;
                const f32x4 acc = mma16(KTp + kb * 16 * 72, 72, VTp + vb * 16 * 72, 72, 64, lane);
#pragma unroll
                for (int j = 0; j < 4; ++j) RS[(kb * 16 + 4 * (lane >> 4) + j) * 64 + vb * 16 + (lane & 15)] = acc[j]; } } }
        BAR_LDS();
        nidx += 2; u0 = n2; u1 = n3;
    }
}

DI void rec_r2(const Ctx& a, int gtid, int gthreads) {
    GAS unsigned char* wsb = a.ws();
#pragma unroll 1
    for (int e = gtid; e < 32 * 4096 + 32 * 2048; e += gthreads) {
        const bool g = e >= 32 * 4096; const int ee = g ? e - 32 * 4096 : e; const int DK = g ? 32 : 64, per = DK * 64;
        const int chain = ee / per, kv = ee % per, k = kv >> 6;
        GAS float* RS = (GAS float*)(wsb + (g ? WS_RSG : WS_RSH)) + (size_t)chain * NCHUNK * per + kv;
        const GAS float* RA = (const GAS float*)(wsb + (g ? WS_RAG : WS_RAH)) + (size_t)chain * NCHUNK * DK + k;
        float S = 0.f;
#pragma unroll 1
        for (int c = 0; c < NCHUNK; c += 4) { float U[4], A[4];
#pragma unroll
            for (int u = 0; u < 4; ++u) { U[u] = RS[(size_t)(c + u) * per]; A[u] = RA[(c + u) * DK]; }
#pragma unroll
            for (int u = 0; u < 4; ++u) { RS[(size_t)(c + u) * per] = S; S = A[u] * S + U[u]; } }
    }
}

template <int MIX>
DI void rec_r3_run(const Ctx& a, int l, LAS unsigned char* lds, int tid, int bid, int G, bool keep_ctx) {
    constexpr int DK = RecCfg<MIX>::DK, DKP = RecCfg<MIX>::DKP, CPT = RecCfg<MIX>::CPT;
    const int lane = tid & 63, wave = __builtin_amdgcn_readfirstlane(tid >> 6);
    LAS bf16* QD = (LAS bf16*)(lds + L_QD); LAS bf16* QE = (LAS bf16*)(lds + L_QE); LAS bf16* KD = (LAS bf16*)(lds + L_KD);
    LAS bf16* VT = (LAS bf16*)(lds + L_VT); LAS bf16* ST = (LAS bf16*)(lds + L_ST); LAS bf16* ATT = (LAS bf16*)(lds + L_ATT); LAS float* Ob = (LAS float*)(lds + L_O);
    GAS unsigned char* wsb = a.ws(); const GAS bf16* P = (const GAS bf16*)(wsb + WS_P); GAS bf16* CAT = (GAS bf16*)(wsb + WS_CAT);
    const GAS float* RSb = (const GAS float*)(wsb + (MIX == 0 ? WS_RSH : WS_RSG));
    const GAS float* lg = a.in(I_LBL); const GAS float* ngb = a.in(MIX == 0 ? I_HNG : I_GNG) + l * 256;
    const GAS float* wgF = a.in(I_WGF) + l * 16 * 128; const GAS float* wgB = a.in(I_WGB) + l * 16 * 128; const GAS float* bgF = a.in(I_BGF) + l * 128; const GAS float* bgB = a.in(I_BGB) + l * 128;
    constexpr int nR = 16 * NCHUNK;
    const int nAct = keep_ctx ? nR : 16 * 64, first = (bid + (MIX == 0 ? 0 : G - 64)) % G;
    auto unit_of = [&](int a) { return a >= nAct ? nR : (keep_ctx ? a : (a >> 6) * NCHUNK + 4 + (a & 63)); };
    auto scanc = [&](int tc, int dir) { return dir == 0 ? tc : (tc < 4 ? 3 - tc : 71 - tc); };
    RecPre<MIX> Rs[2];
    int aidx = first;
    int unit = unit_of(aidx);
    if (unit < nR) { const int tc = unit % NCHUNK, bh = unit / NCHUNK; rec_fetch<MIX, true>(Rs[0], P, RSb, bh >> 2, bh & 3, 0, scanc(tc, 0), tid); rec_fetch<MIX, true>(Rs[1], P, RSb, bh >> 2, bh & 3, 1, scanc(tc, 1), tid); }
    BAR_LDS();
#pragma unroll 1
    while (unit < nR) {
        const int tc = unit % NCHUNK, bh = unit / NCHUNK, h = bh & 3, b = bh >> 2;
        const int nunit = unit_of(aidx + G);
        v4u gatep = (v4u){0u, 0u, 0u, 0u};
#pragma unroll
        for (int dir = 0; dir < 2; ++dir) { RecPre<MIX>& R = Rs[dir];
            if (tid < DK * 8) { const int k = tid >> 3, v8 = tid & 7;
#pragma unroll
                for (int e = 0; e < 4; ++e) { ST[(v8 * 8 + e) * DKP + k] = (bf16)f2bf(R.s0[e]); ST[(v8 * 8 + 4 + e) * DKP + k] = (bf16)f2bf(R.s1[e]); } }
            rec_vt_store(R.vp, VT, tid);
            { const int ri = lane, I = ri >> 4; float kv[CPT], cm[CPT], qv[CPT], e8[CPT];
                rec_front<MIX>(R, lg, dir ? wgB : wgF, dir ? bgB : bgF, l, h, dir, wave, kv, cm);
                { float q8[8]; unpack8(R.qp, q8);
#pragma unroll
                    for (int e = 0; e < CPT; ++e) qv[e] = MIX == 0 ? silu_(q8[e]) * 0.125f : q8[e] * 0.17677669529663687f; }
#pragma unroll
                for (int e = 0; e < CPT; ++e) e8[e] = qv[e] * __expf(cm[e]);
                st_bf16<CPT>(QE + ri * DKP + CPT * wave, e8);
#pragma unroll
                for (int I2 = 0; I2 < 4; ++I2) {
                    float rf[CPT];
#pragma unroll
                    for (int e = 0; e < CPT; ++e) rf[e] = I2 == 0 ? 0.f : lane_read(cm[e], 16 * I2 - 1);
                    if (I2 >= I) {
                        if (I2 == I) {
#pragma unroll
                            for (int e = 0; e < CPT; ++e) e8[e] = qv[e] * __expf(cm[e] - rf[e]);
                            st_bf16<CPT>(QD + ri * DKP + CPT * wave, e8); }
#pragma unroll
                        for (int e = 0; e < CPT; ++e) e8[e] = kv[e] * __expf(fminf(rf[e] - cm[e], 80.f));
                        const int rowbase = I2 == 0 ? 0 : (I2 == 1 ? 16 : (I2 == 2 ? 48 : 96));
                        st_bf16<CPT>(KD + (rowbase + ri) * DKP + CPT * wave, e8); } } }
            if (dir == 0) {
                const int row = (tc < 4 ? b * 256 + tc * 64 : NCTX + b * SEQ + (tc - 4) * 64) + (tid >> 3);
                gatep = *(const GAS v4u*)(P + (size_t)row * PP + (MIX == 0 ? CA_G : CC_G) + h * 64 + (tid & 7) * 8); }
            if (nunit < nR) { const int tc2 = nunit % NCHUNK, bh2 = nunit / NCHUNK; rec_fetch<MIX, true>(R, P, RSb, bh2 >> 2, bh2 & 3, dir, scanc(tc2, dir), tid); }
            BAR_LDS();
            { const int I = wave >> 1, g = lane >> 4, c16 = lane & 15;
                const int rowbase = I == 0 ? 0 : (I == 1 ? 16 : (I == 2 ? 48 : 96));
                bf16x8 Bq[2];
#pragma unroll
                for (int m = 0; m < 2; ++m) {
                    f32x4 t0 = mma16(KD + (rowbase + 2 * m * 16) * DKP, DKP, QD + I * 16 * DKP, DKP, DK, lane);
                    f32x4 t1 = mma16(KD + (rowbase + (2 * m + 1) * 16) * DKP, DKP, QD + I * 16 * DKP, DKP, DK, lane);
#pragma unroll
                    for (int jj = 0; jj < 4; ++jj) { const bool up = 4 * g + jj > c16;
                        t0[jj] = (2 * m > I || (2 * m == I && up)) ? 0.f : t0[jj]; t1[jj] = (2 * m + 1 > I || (2 * m + 1 == I && up)) ? 0.f : t1[jj]; }
                    Bq[m] = pack8(t0[0], t0[1], t0[2], t0[3], t1[0], t1[1], t1[2], t1[3]); }
#pragma unroll
                for (int u = 0; u < 2; ++u) { const int vb = 2 * (wave & 1) + u; f32x4 acc = {0.f, 0.f, 0.f, 0.f};
#pragma unroll
                    for (int m = 0; m < 2; ++m) { const LAS bf16* vr = VT + (vb * 16 + c16) * 72 + 32 * m + 4 * g;
                        const v2u lo = *(const LAS v2u*)vr, hi = *(const LAS v2u*)(vr + 16);
                        acc = __builtin_amdgcn_mfma_f32_16x16x32_bf16(__builtin_bit_cast(bf16x8, (v4u){lo.x, lo.y, hi.x, hi.y}), Bq[m], acc, 0, 0, 0); }
                    const f32x4 acc2 = mma16(ST + vb * 16 * DKP, DKP, QE + I * 16 * DKP, DKP, DK, lane);
#pragma unroll
                    for (int jj = 0; jj < 4; ++jj) { const int i = I * 16 + c16, v = vb * 16 + 4 * g + jj; const float o = acc[jj] + acc2[jj];
                        if (dir == 0) Ob[i * RP + v] = o; else Ob[(63 - i) * RP + v] += o; } } }
            BAR_LDS();
        }
        { const int tl = tid >> 3, jg = tid & 7; float x[8]; float ss = 0.f;
#pragma unroll
            for (int vv = 0; vv < 8; ++vv) { x[vv] = Ob[tl * RP + jg * 8 + vv]; ss += x[vv] * x[vv]; }
            ss += __shfl_xor(ss, 1); ss += __shfl_xor(ss, 2); ss += __shfl_xor(ss, 4);
            const float rstd = rsqrtf(ss * (1.f / 64.f) + EPS);
            const int row = tc < 4 ? b * 256 + tc * 64 + tl : NCTX + b * SEQ + (tc - 4) * 64 + tl;
            const GAS float* ng = ngb + h * 64 + jg * 8;
            float gt[8]; unpack8(gatep, gt);
            float y[8];
#pragma unroll
            for (int vv = 0; vv < 8; ++vv) y[vv] = x[vv] * rstd * ng[vv] * silu_(gt[vv]);
            v4u ow; ow.x = pk2(y[0], y[1]); ow.y = pk2(y[2], y[3]); ow.z = pk2(y[4], y[5]); ow.w = pk2(y[6], y[7]);
            *(GAS v4u*)(CAT + (size_t)row * D + (MIX == 0 ? 0 : 512) + h * 64 + jg * 8) = ow; }
        unit = nunit; aidx += G;
    }
    __syncthreads();
}

typedef float f32x16 __attribute__((ext_vector_type(16)));
DI int swap23(int r) { return (r & 19) | ((r & 4) << 1) | ((r & 8) >> 1); }
struct AttnDesc {
    const GAS bf16* q; int qpitch;
    const GAS bf16* k; int kpitch;
    const GAS bf16* vt;
    GAS bf16* o; int opitch;
    int ntiles; float scale;
    int b, r0, rs0;
    const LAS float* rpb;
};
template <int DQK, bool NA>
DI void attn_mfma_unit(LAS unsigned char* lds, const AttnDesc& A, int tid, int lane, int wave) {
    constexpr int KP = DQK + 8, VP = 72, NS = DQK / 16, KPIECES = 64 * (DQK / 8);
    constexpr int BUF = 64 * KP * 2 + 64 * VP * 2;
    const int q = lane & 31, g = lane >> 5;
    auto tpos = [&](int t) { return NA ? (t < 4 ? 64 * t : 256 + 64 * (A.rs0 + t - 4)) : 64 * t; };
    auto krow = [&](int pos) { return NA ? (pos < 256 ? A.b * 256 + pos : NCTX + A.b * SEQ + (pos - 256)) : pos; };
    const int qi = NA ? (2 * (wave >> 2) + (q >> 4)) * 64 + 16 * (wave & 3) + (q & 15) : wave * 32 + q;
    const int kc0 = NA ? min(max(16 * (wave & 3) - 8, 0), 32) : 0;
    bf16x8 Qf[NS];
    { const GAS bf16* qp = A.q + (size_t)qi * A.qpitch + 8 * g;
#pragma unroll
        for (int s2 = 0; s2 < NS; ++s2) Qf[s2] = *(const GAS bf16x8*)(qp + 16 * s2); }
    f32x16 O[2];
#pragma unroll
    for (int db = 0; db < 2; ++db)
#pragma unroll
        for (int i = 0; i < 16; ++i) O[db][i] = 0.f;
    float mrun = -1e30f, lrun = 0.f;
    const int qr = NA ? A.r0 + (qi >> 6) : 0, qc = NA ? (qi & 63) : 0;
    const int wrs = NA ? min(max(qr - 4, 0), 56) : 0, cs = NA ? min(max(qc - 8, 0), 48) : 0;
    const int qr0 = NA ? A.r0 + 2 * (wave >> 2) : 0, wlo = NA ? min(max(qr0 - 4, 0), 56) : 0, whi = NA ? min(max(qr0 + 1 - 4, 0), 56) + 8 : 0;
    v4u kreg[2], vreg;
    auto gload = [&](int t) { const int pos = tpos(t);
#pragma unroll
        for (int u = 0; u < 2; ++u) { const int p = tid + 512 * u; if (p < KPIECES) { const int key = p / (DQK / 8), d8 = p % (DQK / 8); kreg[u] = *(const GAS v4u*)(A.k + (size_t)krow(pos + key) * A.kpitch + d8 * 8); } }
        vreg = *(const GAS v4u*)(A.vt + (size_t)(tid >> 3) * NKEY + pos + (tid & 7) * 8); };
    auto lstore = [&](int buf) { LAS bf16* Kt = (LAS bf16*)(lds + buf * BUF); LAS bf16* Vt = Kt + 64 * KP;
#pragma unroll
        for (int u = 0; u < 2; ++u) { const int p = tid + 512 * u; if (p < KPIECES) { const int key = p / (DQK / 8), d8 = p % (DQK / 8); *(LAS v4u*)(Kt + key * KP + d8 * 8) = kreg[u]; } }
        *(LAS v4u*)(Vt + (tid >> 3) * VP + (tid & 7) * 8) = vreg; };
    __syncthreads();
    gload(0); lstore(0);
    __syncthreads();
#pragma unroll 1
    for (int t = 0; t < A.ntiles; ++t) {
        const bool more = t + 1 < A.ntiles;
        if (more) gload(t + 1);
        bool active = true, rowok = true; int dr = 0;
        const bool win = NA && t >= 4;
        if (win) { const int wr = A.rs0 + t - 4; active = (wr >= wlo) && (wr < whi); rowok = (wr >= wrs) && (wr < wrs + 8); dr = min(max(wr - qr + 7, 0), 14); }
        if (active) {
            const LAS bf16* Kt = (const LAS bf16*)(lds + (t & 1) * BUF); const LAS bf16* Vt = Kt + 64 * KP;
            f32x16 S[2];
#pragma unroll
            for (int kb = 0; kb < 2; ++kb) {
#pragma unroll
                for (int i = 0; i < 16; ++i) S[kb][i] = 0.f;
                if (win && kb == 1) continue;
                const LAS bf16* kp = Kt + ((win ? kc0 : kb * 32) + swap23(q)) * KP + 8 * g;
#pragma unroll
                for (int s2 = 0; s2 < NS; ++s2) { const bf16x8 a = *(const LAS bf16x8*)(kp + 16 * s2); S[kb] = __builtin_amdgcn_mfma_f32_32x32x16_bf16(a, Qf[s2], S[kb], 0, 0, 0); }
            }
            float mx = -INFINITY;
            if (NA) {
                if (win) {
#pragma unroll
                    for (int i = 0; i < 16; ++i) { const int kc = kc0 + 16 * (i >> 3) + 8 * g + (i & 7); const int dc = min(max(kc - qc, -15), 15) + 15;
                        const float bv = A.rpb[dr * 31 + dc]; const float sv = (rowok && kc >= cs && kc < cs + 16) ? S[0][i] * A.scale + bv : -INFINITY;
                        S[0][i] = sv; mx = fmaxf(mx, sv); }
                } else {
#pragma unroll
                    for (int kb = 0; kb < 2; ++kb)
#pragma unroll
                        for (int i = 0; i < 16; ++i) { const float sv = S[kb][i] * A.scale; S[kb][i] = sv; mx = fmaxf(mx, sv); }
                }
            } else {
#pragma unroll
                for (int kb = 0; kb < 2; ++kb)
#pragma unroll
                    for (int i = 0; i < 16; ++i) mx = fmaxf(mx, S[kb][i]);
            }
            mx = fmaxf(mx, __shfl_xor(mx, 32));
            const float mn = fmaxf(mrun, mx), alpha = __builtin_amdgcn_exp2f(mrun - mn);
            mrun = mn;
            if (__any(alpha != 1.f)) { lrun *= alpha;
#pragma unroll
                for (int db = 0; db < 2; ++db)
#pragma unroll
                    for (int i = 0; i < 16; ++i) O[db][i] *= alpha; }
            bf16x8 Pf[4];
#pragma unroll
            for (int ks = 0; ks < 4; ++ks) { if (win && ks >= 2) continue; const int kb = ks >> 1, o8 = (ks & 1) * 8; float p[8];
#pragma unroll
                for (int j = 0; j < 8; ++j) { p[j] = __builtin_amdgcn_exp2f(S[kb][o8 + j] - mn); lrun += p[j]; }
                Pf[ks] = pack8(p[0], p[1], p[2], p[3], p[4], p[5], p[6], p[7]); }
#pragma unroll
            for (int db = 0; db < 2; ++db) { const LAS bf16* vp = Vt + (db * 32 + q) * VP + (win ? kc0 : 0) + 8 * g;
#pragma unroll
                for (int ks = 0; ks < 4; ++ks) { if (win && ks >= 2) continue; const bf16x8 a = *(const LAS bf16x8*)(vp + 16 * ks); O[db] = __builtin_amdgcn_mfma_f32_32x32x16_bf16(a, Pf[ks], O[db], 0, 0, 0); } }
        }
        if (more) lstore((t + 1) & 1);
        __syncthreads();
    }
    const float ltot = lrun + __shfl_xor(lrun, 32), inv = 1.f / ltot;
    GAS bf16* op = A.o + (size_t)qi * A.opitch + 4 * g;
#pragma unroll
    for (int db = 0; db < 2; ++db)
#pragma unroll
        for (int i4 = 0; i4 < 4; ++i4) { v2u w; w.x = pk2(O[db][4 * i4] * inv, O[db][4 * i4 + 1] * inv); w.y = pk2(O[db][4 * i4 + 2] * inv, O[db][4 * i4 + 3] * inv); *(GAS v2u*)(op + 32 * db + 8 * i4) = w; }
}

constexpr float MLA_TH = 8.f;
constexpr int NA_SLOT = 2 * 64 * 72 * 2, NA_RPB = 4 * NA_SLOT;
DI void na_unit(LAS unsigned char* lds, const AttnDesc& A, const GAS float* rp, int tid, int lane, int wave) {
    constexpr int KP = 72, VP = 72, NS = 4, KBUF = 64 * KP * 2;
    const int q = lane & 31, g = lane >> 5, NT = A.ntiles;
    auto tpos = [&](int t) { return t < 4 ? 64 * t : 256 + 64 * (A.rs0 + t - 4); };
    auto krow = [&](int pos) { return pos < 256 ? A.b * 256 + pos : NCTX + A.b * SEQ + (pos - 256); };
    const int qi = (2 * (wave >> 2) + (q >> 4)) * 64 + 16 * (wave & 3) + (q & 15);
    const int kc0 = min(max(16 * (wave & 3) - 8, 0), 32);
    bf16x8 Qf[NS];
    { const GAS bf16* qp = A.q + (size_t)qi * A.qpitch + 8 * g;
#pragma unroll
        for (int s2 = 0; s2 < NS; ++s2) Qf[s2] = *(const GAS bf16x8*)(qp + 16 * s2); }
    f32x16 O[2];
#pragma unroll
    for (int db = 0; db < 2; ++db)
#pragma unroll
        for (int i = 0; i < 16; ++i) O[db][i] = 0.f;
    float mrun = -1e30f, lrun = 0.f;
    const int qr = A.r0 + (qi >> 6), qc = qi & 63;
    const int wrs = min(max(qr - 4, 0), 56), cs = min(max(qc - 8, 0), 48);
    const int qr0 = A.r0 + 2 * (wave >> 2), wlo = min(max(qr0 - 4, 0), 56), whi = min(max(qr0 + 1 - 4, 0), 56) + 8;
    auto koffs = [&](int i) { const int j = i * 64 + lane, row = j / 9, pc = min(j % 9, 7); return (unsigned)(row * (PP * 2) + pc * 16); };
    auto voffs = [&](int i) { const int j = i * 64 + lane, row = j / 9, pc = min(j % 9, 7); return (unsigned)(row * (NKEY * 2) + pc * 16); };
    const int iv1 = wave == 0 ? 0 : wave - 1, iv2 = wave < 2 ? 7 + wave : iv1;
    const unsigned goff0 = koffs(wave), goff1 = wave == 0 ? koffs(8) : voffs(iv1), goff2 = voffs(iv2);
    auto dma = [&](int t, int slot) __attribute__((always_inline)) { const int pos = tpos(t);
        const GAS unsigned char* kb = (const GAS unsigned char*)(A.k + (size_t)krow(pos) * A.kpitch); const GAS unsigned char* vb = (const GAS unsigned char*)(A.vt + pos);
        LAS unsigned char* kl = lds + slot * NA_SLOT; LAS unsigned char* vl = kl + KBUF;
        __builtin_amdgcn_global_load_lds((const GAS unsigned*)(kb + goff0), (LAS unsigned*)(kl + wave * 1024), 16, 0, 0);
        __builtin_amdgcn_global_load_lds((const GAS unsigned*)((wave == 0 ? kb : vb) + goff1), (LAS unsigned*)(wave == 0 ? kl + 8 * 1024 : vl + iv1 * 1024), 16, 0, 0);
        __builtin_amdgcn_global_load_lds((const GAS unsigned*)(vb + goff2), (LAS unsigned*)(vl + iv2 * 1024), 16, 0, 0);
    };
    LAS float* T = (LAS float*)(lds + NA_RPB);
    float tv[4];
#pragma unroll
    for (int u = 0; u < 4; ++u) { const int e = tid + 512 * u, r = e >> 7, dcr = (e & 127) - 64; const bool in = r < 15 && dcr >= -15 && dcr <= 15;
        tv[u] = in ? rp[r * 31 + dcr + 15] * LOG2E : (r == 15 ? -INFINITY : 0.f); }
    float mcol[16];
#pragma unroll
    for (int i = 0; i < 16; ++i) { const int kc = kc0 + 16 * (i >> 3) + 8 * g + (i & 7); mcol[i] = (kc >= cs && kc < cs + 16) ? 0.f : -INFINITY; }
    __syncthreads();
    dma(0, 0); dma(min(1, NT - 1), 1); dma(min(2, NT - 1), 2);
#pragma unroll
    for (int u = 0; u < 4; ++u) T[tid + 512 * u] = tv[u];
    asm volatile("s_waitcnt vmcnt(6)\n\ts_waitcnt lgkmcnt(0)\n\ts_barrier" ::: "memory");
#pragma unroll 1
    for (int t = 0; t < NT; ++t) {
        dma(min(t + 3, NT - 1), (t + 3) & 3);
        bool active = true, rowok = true; int dr = 0;
        const bool win = t >= 4;
        if (win) { const int wr = A.rs0 + t - 4; active = (wr >= wlo) && (wr < whi); rowok = (wr >= wrs) && (wr < wrs + 8); dr = min(max(wr - qr + 7, 0), 14); }
        if (active) {
            const LAS bf16* Kt = (const LAS bf16*)(lds + (t & 3) * NA_SLOT); const LAS bf16* Vt = Kt + 64 * KP;
            f32x16 S[2];
#pragma unroll
            for (int kb = 0; kb < 2; ++kb) {
#pragma unroll
                for (int i = 0; i < 16; ++i) S[kb][i] = 0.f;
                if (win && kb == 1) continue;
                const LAS bf16* kp = Kt + ((win ? kc0 : kb * 32) + swap23(q)) * KP + 8 * g;
#pragma unroll
                for (int s2 = 0; s2 < NS; ++s2) { const bf16x8 a = *(const LAS bf16x8*)(kp + 16 * s2); S[kb] = __builtin_amdgcn_mfma_f32_32x32x16_bf16(a, Qf[s2], S[kb], 0, 0, 0); }
            }
            float mx = -INFINITY;
            if (win) { const LAS float* tb = T + (rowok ? dr : 15) * 128 + (kc0 + 8 * g - qc + 64);
#pragma unroll
                for (int i = 0; i < 16; ++i) { const float sv = (S[0][i] * A.scale + tb[16 * (i >> 3) + (i & 7)]) + mcol[i]; S[0][i] = sv; mx = fmaxf(mx, sv); }
            } else {
#pragma unroll
                for (int kb = 0; kb < 2; ++kb)
#pragma unroll
                    for (int i = 0; i < 16; ++i) { const float sv = S[kb][i] * A.scale; S[kb][i] = sv; mx = fmaxf(mx, sv); }
            }
            if (__any(mx > mrun + MLA_TH)) { const float mf = fmaxf(mx, __shfl_xor(mx, 32)), mn = fmaxf(mrun, mf), alpha = __builtin_amdgcn_exp2f(mrun - mn);
                mrun = mn; lrun *= alpha;
#pragma unroll
                for (int db = 0; db < 2; ++db)
#pragma unroll
                    for (int i = 0; i < 16; ++i) O[db][i] *= alpha; }
            bf16x8 Pf[4];
#pragma unroll
            for (int ks = 0; ks < 4; ++ks) { if (win && ks >= 2) continue; const int kb = ks >> 1, o8 = (ks & 1) * 8; float p[8];
#pragma unroll
                for (int j = 0; j < 8; ++j) { p[j] = __builtin_amdgcn_exp2f(S[kb][o8 + j] - mrun); lrun += p[j]; }
                Pf[ks] = pack8(p[0], p[1], p[2], p[3], p[4], p[5], p[6], p[7]); }
#pragma unroll
            for (int db = 0; db < 2; ++db) { const LAS bf16* vp = Vt + (db * 32 + q) * VP + (win ? kc0 : 0) + 8 * g;
#pragma unroll
                for (int ks = 0; ks < 4; ++ks) { if (win && ks >= 2) continue; const bf16x8 a = *(const LAS bf16x8*)(vp + 16 * ks); O[db] = __builtin_amdgcn_mfma_f32_32x32x16_bf16(a, Pf[ks], O[db], 0, 0, 0); } }
        }
        asm volatile("s_waitcnt vmcnt(6)\n\ts_waitcnt lgkmcnt(0)\n\ts_barrier" ::: "memory");
    }
    asm volatile("s_waitcnt vmcnt(0)" ::: "memory");
    const float ltot = lrun + __shfl_xor(lrun, 32), inv = 1.f / ltot;
    GAS bf16* op = A.o + (size_t)qi * A.opitch + 4 * g;
#pragma unroll
    for (int db = 0; db < 2; ++db)
#pragma unroll
        for (int i4 = 0; i4 < 4; ++i4) { v2u w; w.x = pk2(O[db][4 * i4] * inv, O[db][4 * i4 + 1] * inv); w.y = pk2(O[db][4 * i4 + 2] * inv, O[db][4 * i4 + 3] * inv); *(GAS v2u*)(op + 32 * db + 8 * i4) = w; }
}

struct TagF { static constexpr bool value = false; }; struct TagT { static constexpr bool value = true; };
#define SGB(mask, n) __builtin_amdgcn_sched_group_barrier(mask, n, 0)
DI void mla_unit(LAS unsigned char* lds, const AttnDesc& A, int tid, int lane, int wave) {
    constexpr int KP = 104, VP = 72, NS = 6, KBUF = 64 * KP * 2, VBUF = 64 * VP * 2;
    const int q = lane & 31, g = lane >> 5, NT = A.ntiles;
    bf16x8 Qf[NS];
    { const GAS bf16* qp = A.q + (size_t)(wave * 32 + q) * A.qpitch + 8 * g;
#pragma unroll
        for (int s2 = 0; s2 < NS; ++s2) Qf[s2] = *(const GAS bf16x8*)(qp + 16 * s2); }
    f32x16 O[2], Cm;
#pragma unroll
    for (int i = 0; i < 16; ++i) { O[0][i] = 0.f; O[1][i] = 0.f; Cm[i] = 0.f; }
    float lrun = 0.f;
    auto koffs = [&](int i) { const int j = i * 64 + lane, row = j / 13, pc = min(j % 13, 11); return (unsigned)(row * 192 + pc * 16); };
    auto voffs = [&](int i) { const int j = i * 64 + lane, row = j / 9, pc = min(j % 9, 7); return (unsigned)(row * (NKEY * 2) + pc * 16); };
    const int i2 = min(wave + 3, 8);
    const unsigned goff0 = koffs(wave), goff1 = wave < 5 ? koffs(wave + 8) : voffs(wave - 5), goff2 = voffs(i2);
    auto dma = [&](int tk, int ks, int tv, int vs) __attribute__((always_inline)) {
        const GAS unsigned char* kb = (const GAS unsigned char*)A.k + (size_t)tk * (64 * 96 * 2); const GAS unsigned char* vb = (const GAS unsigned char*)A.vt + (size_t)tv * 128;
        LAS unsigned char* kl = lds + ks * KBUF; LAS unsigned char* vl = lds + 2 * KBUF + vs * VBUF;
        __builtin_amdgcn_global_load_lds((const GAS unsigned*)(kb + goff0), (LAS unsigned*)(kl + wave * 1024), 16, 0, 0);
        __builtin_amdgcn_global_load_lds((const GAS unsigned*)((wave < 5 ? kb : vb) + goff1), (LAS unsigned*)(wave < 5 ? kl + (wave + 8) * 1024 : vl + (wave - 5) * 1024), 16, 0, 0);
        __builtin_amdgcn_global_load_lds((const GAS unsigned*)(vb + goff2), (LAS unsigned*)(vl + i2 * 1024), 16, 0, 0);
    };
    auto qk = [&](f32x16& S0, f32x16& S1, int buf) __attribute__((always_inline)) {
        const LAS bf16* kp = (const LAS bf16*)(lds + buf * KBUF) + swap23(q) * KP + 8 * g;
        S0 = __builtin_amdgcn_mfma_f32_32x32x16_bf16(*(const LAS bf16x8*)kp, Qf[0], Cm, 0, 0, 0);
#pragma unroll
        for (int s2 = 1; s2 < NS; ++s2) S0 = __builtin_amdgcn_mfma_f32_32x32x16_bf16(*(const LAS bf16x8*)(kp + 16 * s2), Qf[s2], S0, 0, 0, 0);
        S1 = __builtin_amdgcn_mfma_f32_32x32x16_bf16(*(const LAS bf16x8*)(kp + 32 * KP), Qf[0], Cm, 0, 0, 0);
#pragma unroll
        for (int s2 = 1; s2 < NS; ++s2) S1 = __builtin_amdgcn_mfma_f32_32x32x16_bf16(*(const LAS bf16x8*)(kp + 32 * KP + 16 * s2), Qf[s2], S1, 0, 0, 0);
    };
    auto smax = [&](const f32x16& S0, const f32x16& S1) __attribute__((always_inline)) { float mx = fmaxf(S0[0], S0[1]);
#pragma unroll
        for (int i = 2; i < 16; ++i) mx = fmaxf(mx, S0[i]);
#pragma unroll
        for (int i = 0; i < 16; ++i) mx = fmaxf(mx, S1[i]);
        return mx; };
    auto rebase = [&](f32x16& S0, f32x16& S1, float mx) __attribute__((always_inline)) {
        const float mf = fmaxf(mx, __shfl_xor(mx, 32)), d = fmaxf(mf, 0.f), alpha = __builtin_amdgcn_exp2f(-d);
        lrun *= alpha;
#pragma unroll
        for (int i = 0; i < 16; ++i) { O[0][i] *= alpha; O[1][i] *= alpha; S0[i] -= d; S1[i] -= d; Cm[i] -= d; }
        asm volatile("" : "+v"(Cm));
    };
    auto softmax_p = [&](const f32x16& S0, const f32x16& S1, bf16x8 (&Pf)[4]) __attribute__((always_inline)) {
#pragma unroll
        for (int ks = 0; ks < 4; ++ks) { const int o8 = (ks & 1) * 8; float p[8];
#pragma unroll
            for (int j = 0; j < 8; ++j) { p[j] = __builtin_amdgcn_exp2f(ks < 2 ? S0[o8 + j] : S1[o8 + j]); lrun += p[j]; }
            Pf[ks] = pack8(p[0], p[1], p[2], p[3], p[4], p[5], p[6], p[7]); }
    };
    auto pv = [&](const bf16x8 (&Pf)[4], int buf) __attribute__((always_inline)) {
        const LAS bf16* vp = (const LAS bf16*)(lds + 2 * KBUF + buf * VBUF) + q * VP + 8 * g;
#pragma unroll
        for (int ks = 0; ks < 4; ++ks)
#pragma unroll
            for (int db = 0; db < 2; ++db) O[db] = __builtin_amdgcn_mfma_f32_32x32x16_bf16(*(const LAS bf16x8*)(vp + db * 32 * VP + 16 * ks), Pf[ks], O[db], 0, 0, 0);
    };
    f32x16 Sa[2], Sb[2];
    __syncthreads();
    dma(0, 0, 0, 0); dma(1, 1, 0, 0);
    asm volatile("s_waitcnt vmcnt(0)" ::: "memory");
    __syncthreads();
    qk(Sa[0], Sa[1], 0);
    { const float mx = smax(Sa[0], Sa[1]); const float mf = fmaxf(mx, __shfl_xor(mx, 32));
#pragma unroll
        for (int i = 0; i < 16; ++i) { Sa[0][i] -= mf; Sa[1][i] -= mf; Cm[i] = -mf; }
        asm volatile("" : "+v"(Cm)); }
    __syncthreads();
    auto step = [&](f32x16 (&Sc)[2], f32x16 (&Sn)[2], const int t, auto par) __attribute__((always_inline)) {
        constexpr int PAR = decltype(par)::value ? 1 : 0;
        dma(min(t + 2, NT - 1), PAR, min(t + 1, NT - 1), PAR ^ 1);
        __builtin_amdgcn_sched_barrier(0);
        bf16x8 Pf[4];
        qk(Sn[0], Sn[1], PAR ^ 1);
        softmax_p(Sc[0], Sc[1], Pf);
        pv(Pf, PAR);
        const float mx = smax(Sn[0], Sn[1]);
        SGB(0x100, 3);
#pragma unroll
        for (int m = 0; m < 16; ++m) { SGB(0x008, 1); SGB(0x100, 1); SGB(0x400, 2); SGB(0x002, 3); }
#pragma unroll
        for (int m = 0; m < 4; ++m) { SGB(0x008, 1); SGB(0x100, 1); SGB(0x002, 5); }
        if (__any(mx > MLA_TH)) rebase(Sn[0], Sn[1], mx);
        asm volatile("s_waitcnt vmcnt(0)" ::: "memory");
        __syncthreads();
    };
#pragma unroll 1
    for (int t = 0; t < NT - 2; t += 2) { step(Sa, Sb, t, TagF{}); step(Sb, Sa, t + 1, TagT{}); }
    step(Sa, Sb, NT - 2, TagF{});
    { bf16x8 Pf[4]; softmax_p(Sb[0], Sb[1], Pf); pv(Pf, (NT - 1) & 1); }
    const float ltot = lrun + __shfl_xor(lrun, 32), inv = 1.f / ltot;
    GAS bf16* op = A.o + (size_t)(wave * 32 + q) * A.opitch + 4 * g;
#pragma unroll
    for (int db = 0; db < 2; ++db)
#pragma unroll
        for (int i4 = 0; i4 < 4; ++i4) { v2u w; w.x = pk2(O[db][4 * i4] * inv, O[db][4 * i4 + 1] * inv); w.y = pk2(O[db][4 * i4 + 2] * inv, O[db][4 * i4 + 3] * inv); *(GAS v2u*)(op + 32 * db + 8 * i4) = w; }
}

DI int moe_tables(const GAS unsigned* cnt  , LAS int* off, LAS int* tile_e, int tid) {
    if (tid == 0) { int o = 0; for (int e = 0; e < 32; ++e) { off[e] = o; o += ((int)cnt[e * 64] + 255) & ~255; } off[32] = o; }
    __syncthreads();
    if (tid < MOE_MAXT) { const int r = tid * 256; int ex = 0; for (int e = 0; e < 32; ++e) if (r >= off[e + 1]) ex = e + 1; tile_e[tid] = ex < 32 ? ex : 31; }
    __syncthreads();
    return off[32] >> 8;
}

#define TIDS const int tid = threadIdx.x, lane = tid & 63, wave = __builtin_amdgcn_readfirstlane(tid >> 6), bid = blockIdx.x, G = gridDim.x, gw = bid * 8 + wave, NGW = G * 8; (void)lane; (void)gw; (void)NGW
DI void ph_gemm_in(const Ctx& cx, int l) {
    TIDS; GAS unsigned char* ws = cx.ws(); LAS unsigned char* lds = (LAS unsigned char*)lds_raw;
    pg8::Gemm g{(const GAS bf16*)(ws + WS_H), (const GAS bf16*)(ws + WS_WTIN + (size_t)l * WTIN_L), MTOK, PP, D}; pg8::StaticOrder S; S.init(MTOK, PP, G, bid);
    pg8::EpiStoreBf16 E{(GAS bf16*)(ws + WS_P), PP};
    pg8::gemm_phase(lds, g, S, E);
}
DI void ph_prep_r1(const Ctx& cx, int l) {
    TIDS; LAS unsigned char* lds = (LAS unsigned char*)lds_raw;
#pragma unroll 1
    for (int u = bid; u < MTOK / PR; u += G) prep_unit(cx, l, u, lds, tid, lane, wave);
    __syncthreads();
    rec_r1_run<0>(cx, l, lds, tid, bid, G); rec_r1_run<1>(cx, l, lds, tid, bid, G);
    __syncthreads();
}
DI void ph_mixers(const Ctx& cx, int l) {
    TIDS; GAS unsigned char* ws = cx.ws(); LAS unsigned char* lds = (LAS unsigned char*)lds_raw;
    const bool keep_ctx = (l == 0);
    GAS bf16* CAT = (GAS bf16*)(ws + WS_CAT); const GAS bf16* P = (const GAS bf16*)(ws + WS_P);
    const int nATT = 256 + (keep_ctx ? 16 : 0), nR = 16 * NCHUNK;
    const int vc = (G % 8 == 0) ? (bid % 8) * (G / 8) + bid / 8 : bid;
    const bool r3first = ((bid >> 3) & 1) != 0;
    if (r3first) { rec_r3_run<0>(cx, l, lds, tid, bid, G, keep_ctx); rec_r3_run<1>(cx, l, lds, tid, bid, G, keep_ctx); __syncthreads(); }
#pragma unroll 1
    for (int it = 0; it < 2; ++it) { const int u = it == 0 ? vc : (G == 256 && bid >= 128 && bid < 144 ? 256 + bid - 128 : (G == 256 ? nATT : bid + G)); if (u >= nATT) continue;
        const GAS bf16* QM = (const GAS bf16*)(ws + WS_QM); const GAS bf16* KM = (const GAS bf16*)(ws + WS_KM); const GAS bf16* VM = (const GAS bf16*)(ws + WS_VM);
        AttnDesc A{}; int bh, b, h;
        if (u < 256) { bh = u >> 4; b = bh >> 2; h = bh & 3; const int qb = u & 15; A.q = QM + ((size_t)bh * NKEY + 256 + qb * 256) * 96; A.ntiles = NKEY / 64; A.o = CAT + (size_t)(NCTX + b * SEQ + qb * 256) * D + 768 + h * 64; }
        else { bh = u - 256; b = bh >> 2; h = bh & 3; A.q = QM + (size_t)bh * NKEY * 96; A.ntiles = 4; A.o = CAT + (size_t)(b * 256) * D + 768 + h * 64; }
        A.qpitch = 96; A.k = KM + (size_t)bh * NKEY * 96; A.kpitch = 96; A.vt = VM + (size_t)bh * 64 * NKEY; A.opitch = D; A.scale = 1.f;
        mla_unit(lds, A, tid, lane, wave);
    }
#pragma unroll 1
    for (int it = 0; it < 2; ++it) { const int u = it == 0 ? vc : (G == 256 && bid >= 160 && bid < 176 ? 256 + bid - 160 : (G == 256 ? nATT : bid + G)); if (u >= nATT) continue;
        LAS float* rpb = (LAS float*)(lds + NA_RPB);
        AttnDesc A{}; int bh, b, h; size_t qrow;
        if (u < 256) { bh = u >> 4; b = bh >> 2; h = bh & 3; const int rq = u & 15; A.r0 = rq * 4; A.rs0 = min(max(A.r0 - 4, 0), 56); const int rsl = min(max(A.r0 + 3 - 4, 0), 56);
            A.ntiles = 4 + (rsl + 8 - A.rs0); qrow = (size_t)NCTX + b * SEQ + A.r0 * 64; }
        else { bh = u - 256; b = bh >> 2; h = bh & 3; A.ntiles = 4; qrow = (size_t)b * 256; }
        const GAS float* rp = cx.in(I_RPB) + (size_t)(l * 4 + h) * 465;
        A.q = P + qrow * PP + CB_Q + h * 64; A.qpitch = PP; A.k = P + CB_K + h * 64; A.kpitch = PP; A.vt = (const GAS bf16*)(ws + WS_VNT) + (size_t)bh * 64 * NKEY;
        A.o = CAT + qrow * D + 256 + h * 64; A.opitch = D; A.scale = 0.125f * LOG2E; A.b = b; A.rpb = rpb;
        na_unit(lds, A, rp, tid, lane, wave);
    }
    __syncthreads();
    if (!r3first) { rec_r3_run<0>(cx, l, lds, tid, bid, G, keep_ctx); rec_r3_run<1>(cx, l, lds, tid, bid, G, keep_ctx); }
}
DI void ph_gemm_out(const Ctx& cx, int l) {
    TIDS; GAS unsigned char* ws = cx.ws(); LAS unsigned char* lds = (LAS unsigned char*)lds_raw;
    const int roff = (l == 0) ? 0 : NCTX, Mg = MTOK - roff;
    pg8::Gemm g{(const GAS bf16*)(ws + WS_CAT) + (size_t)roff * D, (const GAS bf16*)(ws + WS_WTOUT + (size_t)l * D * D * 2), Mg, D, D}; pg8::StaticOrder S; S.init(Mg, D, G, bid);
    pg8::EpiResid E{(GAS pg8::bf16_t*)(ws + WS_X), roff, (const GAS float*)(ws + WS_MOD) + (size_t)l * 5 * 6144 + 2 * 1024, l == 0 ? cx.in(I_CTX) : (const GAS float*)nullptr, l == 0 ? cx.in(I_X) : (const GAS float*)nullptr};
    pg8::gemm_phase(lds, g, S, E);
    if (l == 0) { const int nbusy = (Mg / 256) * (D / 256) - G;
        if (nbusy >= 0 && nbusy < G && bid >= nbusy) { __syncthreads(); weight_copies(cx, 1, lds, tid, lane, wave, (bid - nbusy) * 8 + wave, (G - nbusy) * 8, (bid - nbusy) * 512 + tid, (G - nbusy) * 512); } }
}
DI void ph_router(const Ctx& cx, int l) {
    TIDS; GAS unsigned char* ws = cx.ws(); LAS unsigned char* lds = (LAS unsigned char*)lds_raw;
    const int m_lo = (l == 0) ? 0 : NCTX;
    const GAS bf16* X = (const GAS bf16*)(ws + WS_X); GAS bf16* H = (GAS bf16*)(ws + WS_H); const GAS float* MOD = (const GAS float*)(ws + WS_MOD) + (size_t)l * 5 * 6144;
    GAS int* EID = (GAS int*)(ws + WS_MOE); GAS float* GATE = (GAS float*)(ws + WS_MOE) + MTOK * 2; GAS int* POS = (GAS int*)(ws + WS_MOE) + MTOK * 4;
    GAS unsigned* cnt = (GAS unsigned*)(ws + WS_CTL) + CW_CNT + l * 32 * 64; GAS int* RIDX = (GAS int*)(ws + WS_RIDX);
    const GAS bf16* WRh = (const GAS bf16*)(ws + WS_WR) + (size_t)l * 2 * 48 * 1024; const GAS bf16* WRl = WRh + 48 * 1024;
    const GAS float* n2g = cx.in(I_N2G) + l * D; const GAS float* brg = cx.in(I_BRG) + l * 4; const GAS float* bre = cx.in(I_BRE) + l * 32;
    constexpr int AP = 136;
    LAS bf16* Ah = (LAS bf16*)(lds + wave * 12288); LAS bf16* Al = Ah + 16 * AP; LAS float* LG = (LAS float*)(lds + wave * 12288 + 2 * 16 * AP * 2); LAS float* RSD = LG + 16 * 48;
    const int nunits = (MTOK - m_lo) / 16;
#pragma unroll 1
    for (int unit = wave * G + bid; unit < nunits; unit += NGW) {
        const int m0 = m_lo + unit * 16; const GAS float* mb = MOD + (size_t)bidx_of_row(m0) * 6144;
        const int p16 = lane & 15, rg = lane >> 4;
        float rsr[4];
        { float ss[4] = {0.f, 0.f, 0.f, 0.f};
#pragma unroll 2
            for (int kc = 0; kc < 8; ++kc) { v4u xp[4];
#pragma unroll
                for (int i = 0; i < 4; ++i) xp[i] = *(const GAS v4u*)(X + (size_t)(m0 + 4 * rg + i) * D + kc * 128 + 8 * p16);
#pragma unroll
                for (int i = 0; i < 4; ++i) { float x[8]; unpack8(xp[i], x);
#pragma unroll
                    for (int e = 0; e < 8; ++e) ss[i] += x[e] * x[e]; } }
#pragma unroll
            for (int i = 0; i < 4; ++i) { float t = ss[i]; t += __shfl_xor(t, 1); t += __shfl_xor(t, 2); t += __shfl_xor(t, 4); t += __shfl_xor(t, 8); rsr[i] = rsqrtf(t * (1.f / D) + EPS); } }
        f32x4 acc[3];
#pragma unroll
        for (int ct = 0; ct < 3; ++ct) acc[ct] = (f32x4){0.f, 0.f, 0.f, 0.f};
#pragma unroll 1
        for (int kc = 0; kc < 8; ++kc) { const int c = kc * 128 + 8 * p16;
            const int fr = lane & 15, fq = lane >> 4;
            bf16x8 bh[4][3], bl[4][3];
#pragma unroll
            for (int ks = 0; ks < 4; ++ks)
#pragma unroll
                for (int ct = 0; ct < 3; ++ct) { const size_t bo = (size_t)(ct * 16 + fr) * 1024 + kc * 128 + ks * 32 + fq * 8; bh[ks][ct] = *(const GAS bf16x8*)(WRh + bo); bl[ks][ct] = *(const GAS bf16x8*)(WRl + bo); }
            v4u xp[4];
#pragma unroll
            for (int i = 0; i < 4; ++i) xp[i] = *(const GAS v4u*)(X + (size_t)(m0 + 4 * rg + i) * D + c);
            float gg[8], sh[8], sc[8];
            { const f32x4 a0 = *(const GAS f32x4*)(n2g + c), a1 = *(const GAS f32x4*)(n2g + c + 4), b0 = *(const GAS f32x4*)(mb + 3 * 1024 + c), b1 = *(const GAS f32x4*)(mb + 3 * 1024 + c + 4),
                  c0 = *(const GAS f32x4*)(mb + 4 * 1024 + c), c1 = *(const GAS f32x4*)(mb + 4 * 1024 + c + 4);
                gg[0] = a0.x; gg[1] = a0.y; gg[2] = a0.z; gg[3] = a0.w; gg[4] = a1.x; gg[5] = a1.y; gg[6] = a1.z; gg[7] = a1.w;
                sh[0] = b0.x; sh[1] = b0.y; sh[2] = b0.z; sh[3] = b0.w; sh[4] = b1.x; sh[5] = b1.y; sh[6] = b1.z; sh[7] = b1.w;
                sc[0] = c0.x; sc[1] = c0.y; sc[2] = c0.z; sc[3] = c0.w; sc[4] = c1.x; sc[5] = c1.y; sc[6] = c1.z; sc[7] = c1.w; }
            LDS_WAIT();
#pragma unroll
            for (int i = 0; i < 4; ++i) { const int r = 4 * rg + i; float x[8], y[8]; unpack8(xp[i], x);
#pragma unroll
                for (int e = 0; e < 8; ++e) y[e] = x[e] * rsr[i] * gg[e] * (1.f + sc[e]) + sh[e];
                const v4u hi = (v4u){pk2(y[0], y[1]), pk2(y[2], y[3]), pk2(y[4], y[5]), pk2(y[6], y[7])};
                float hf[8]; unpack8(hi, hf);
                const v4u lo = (v4u){pk2(y[0] - hf[0], y[1] - hf[1]), pk2(y[2] - hf[2], y[3] - hf[3]), pk2(y[4] - hf[4], y[5] - hf[5]), pk2(y[6] - hf[6], y[7] - hf[7])};
                *(GAS v4u*)(H + (size_t)(m0 + r) * D + c) = hi;
                *(LAS v4u*)(Ah + r * AP + 8 * p16) = hi; *(LAS v4u*)(Al + r * AP + 8 * p16) = lo; }
            LDS_WAIT();
            asm volatile("s_waitcnt vmcnt(0)" : "+v"(bh[0][0]), "+v"(bh[0][1]), "+v"(bh[0][2]), "+v"(bl[0][0]), "+v"(bl[0][1]), "+v"(bl[0][2]), "+v"(bh[1][0]), "+v"(bh[1][1]), "+v"(bh[1][2]), "+v"(bl[1][0]), "+v"(bl[1][1]), "+v"(bl[1][2]),
                         "+v"(bh[2][0]), "+v"(bh[2][1]), "+v"(bh[2][2]), "+v"(bl[2][0]), "+v"(bl[2][1]), "+v"(bl[2][2]), "+v"(bh[3][0]), "+v"(bh[3][1]), "+v"(bh[3][2]), "+v"(bl[3][0]), "+v"(bl[3][1]), "+v"(bl[3][2]) :: "memory");
#pragma unroll
            for (int ks = 0; ks < 4; ++ks) { const bf16x8 ah = *(const LAS bf16x8*)(Ah + fr * AP + ks * 32 + fq * 8), al = *(const LAS bf16x8*)(Al + fr * AP + ks * 32 + fq * 8);
#pragma unroll
                for (int ct = 0; ct < 3; ++ct) {
                    acc[ct] = __builtin_amdgcn_mfma_f32_16x16x32_bf16(ah, bh[ks][ct], acc[ct], 0, 0, 0);
                    acc[ct] = __builtin_amdgcn_mfma_f32_16x16x32_bf16(ah, bl[ks][ct], acc[ct], 0, 0, 0);
                    acc[ct] = __builtin_amdgcn_mfma_f32_16x16x32_bf16(al, bh[ks][ct], acc[ct], 0, 0, 0); } }
        }
#pragma unroll
        for (int ct = 0; ct < 3; ++ct)
#pragma unroll
            for (int j = 0; j < 4; ++j) LG[(4 * (lane >> 4) + j) * 48 + ct * 16 + (lane & 15)] = acc[ct][j];
        LDS_WAIT(); asm volatile("" ::: "memory");
        if (lane < 16) { const LAS float* lg = LG + lane * 48; const int m = m0 + lane;
            float gl[4]; int gsel = 0;
#pragma unroll
            for (int i = 0; i < 4; ++i) gl[i] = lg[i] + brg[i];
            float gmax = gl[0];
#pragma unroll
            for (int i = 1; i < 4; ++i) if (gl[i] > gmax) { gmax = gl[i]; gsel = i; }
            float den = 0.f;
#pragma unroll
            for (int i = 0; i < 4; ++i) den += __expf(gl[i] - gmax);
            const float pg = 1.f / den;
            float e1 = -INFINITY, e2 = -INFINITY; int i1 = 0, i2 = 0;
#pragma unroll 1
            for (int i = 0; i < 8; ++i) { const float ev = lg[4 + gsel * 8 + i] + bre[gsel * 8 + i];
                if (ev > e1) { e2 = e1; i2 = i1; e1 = ev; i1 = i; } else if (ev > e2) { e2 = ev; i2 = i; } }
            const float x2 = __expf(e2 - e1), w1 = pg / (1.f + x2), w2 = pg * x2 / (1.f + x2);
            const int ex1 = gsel * 8 + i1, ex2 = gsel * 8 + i2;
            const int p1 = (int)__hip_atomic_fetch_add(cnt + ex1 * 64, 1u, __ATOMIC_RELAXED, __HIP_MEMORY_SCOPE_AGENT), p2 = (int)__hip_atomic_fetch_add(cnt + ex2 * 64, 1u, __ATOMIC_RELAXED, __HIP_MEMORY_SCOPE_AGENT);
            EID[m * 2] = ex1; EID[m * 2 + 1] = ex2; GATE[m * 2] = w1; GATE[m * 2 + 1] = w2; POS[m * 2] = p1; POS[m * 2 + 1] = p2;
            RIDX[(size_t)ex1 * MOE_CAP + p1] = m; RIDX[(size_t)ex2 * MOE_CAP + p2] = m; }
        LDS_WAIT(); asm volatile("" ::: "memory");
    }
}
DI void ph_gemm_gu(const Ctx& cx, int l) {
    TIDS; GAS unsigned char* ws = cx.ws(); LAS unsigned char* lds = (LAS unsigned char*)lds_raw;
    LAS int* moe_off = (LAS int*)(lds + MISC_OFF + 64 * 4); LAS int* moe_te = (LAS int*)(lds + MISC_OFF + 128 * 4);
    const int nT = moe_tables((const GAS unsigned*)(ws + WS_CTL) + CW_CNT + l * 32 * 64, moe_off, moe_te, tid);
    pg8::Gemm g{(const GAS bf16*)(ws + WS_H), (const GAS bf16*)(ws + WS_WTGU + (size_t)l * 32 * 512 * D * 2), nT * 256, 512, D};
    const int vc = (G % 8 == 0) ? (bid % 8) * (G / 8) + bid / 8 : bid;
    pg8::GroupedPublish S{{nT, 2, G, vc, moe_te, (size_t)512 * D * 2}, (GAS unsigned*)(ws + WS_CTL) + CW_GUC + l * MOE_MAXT * 64};
    pg8::EpiGateUp E{(GAS bf16*)(ws + WS_ACT), (unsigned)(MOE_MAXT * 256 * 256 * 2)};
    LAS int* ridx_l = (LAS int*)(lds + MISC_OFF + 4096);
    { const GAS unsigned* cntp = (const GAS unsigned*)(ws + WS_CTL) + CW_CNT + l * 32 * 64; const GAS int* RIDX = (const GAS int*)(ws + WS_RIDX);
        const int vcl = (G % 8 == 0) ? (bid % 8) * (G / 8) + bid / 8 : bid; const int i = tid >> 8, r = tid & 255, L = vcl + i * G;
        if (L < nT * 2) { const int pm = L >> 1, e = moe_te[pm], slot = pm * 256 - moe_off[e] + r; ridx_l[i * 256 + r] = slot < (int)cntp[e * 64] ? RIDX[(size_t)e * MOE_CAP + slot] : 0; }
        __syncthreads(); }
    pg8::MoeRows RM{ridx_l, vc >> 1};
    pg8::gemm_phase(lds, g, S, E, RM);
}
DI void ph_gemm_dn(const Ctx& cx, int l) {
    TIDS; GAS unsigned char* ws = cx.ws(); LAS unsigned char* lds = (LAS unsigned char*)lds_raw;
    LAS int* moe_off = (LAS int*)(lds + MISC_OFF + 64 * 4); LAS int* moe_te = (LAS int*)(lds + MISC_OFF + 128 * 4);
    const int nT = moe_tables((const GAS unsigned*)(ws + WS_CTL) + CW_CNT + l * 32 * 64, moe_off, moe_te, tid);
    pg8::Gemm g{(const GAS bf16*)(ws + WS_ACT), (const GAS bf16*)(ws + WS_WTDN + (size_t)l * 32 * D * 256 * 2), nT * 256, D, 256};
    pg8::EpiStoreBf16 E{(GAS bf16*)(ws + WS_XS), D};
    const GAS unsigned* ready = (const GAS unsigned*)(ws + WS_CTL) + CW_GUC + l * MOE_MAXT * 64;
    const int vc = (G % 8 == 0) ? (bid % 8) * (G / 8) + bid / 8 : bid;
    const int nb2 = (nT * 2 > G && nT * 2 - G < G / 2) ? nT * 2 - G : 0, Gd = G - nb2, cd = vc - nb2;
    const int pmE = nb2 ? G / 2 : nT, nE = pmE * 4, nL = (nT - pmE) * 4;
    const int cl = cd < 0 ? -1 : (cd - nE % Gd + Gd) % Gd;
    pg8::GroupedOrder S1{pmE, 4, Gd, cd, moe_te, (size_t)D * 256 * 2, 0};
    pg8::GroupedOrder S2{nT - pmE, 4, Gd, cl, moe_te, (size_t)D * 256 * 2, pmE};
    { pg8::Unit u;
#pragma unroll 1
      for (int i = 0; S1.next(i, u); ++i) pg8::wait_rowtile(ready, u.pm, 16u); }
    pg8::gemm_phase(lds, g, S1, E);
    if (nL > 0) { pg8::Unit u;
#pragma unroll 1
      for (int i = 0; S2.next(i, u); ++i) pg8::wait_rowtile(ready, u.pm, 16u);
      pg8::gemm_phase(lds, g, S2, E); }
}
DI void ph_combine(const Ctx& cx, int l) {
    TIDS; GAS unsigned char* ws = cx.ws(); LAS unsigned char* lds = (LAS unsigned char*)lds_raw;
    LAS int* moe_off = (LAS int*)(lds + MISC_OFF + 64 * 4); LAS int* moe_te = (LAS int*)(lds + MISC_OFF + 128 * 4);
    const int m_lo = (l == 0) ? 0 : NCTX;
    moe_tables((const GAS unsigned*)(ws + WS_CTL) + CW_CNT + l * 32 * 64, moe_off, moe_te, tid);
    const GAS int* EID = (const GAS int*)(ws + WS_MOE); const GAS float* GATE = (const GAS float*)(ws + WS_MOE) + MTOK * 2; const GAS int* POS = (const GAS int*)(ws + WS_MOE) + MTOK * 4;
    const GAS bf16* YS = (const GAS bf16*)(ws + WS_XS); GAS bf16* X = (GAS bf16*)(ws + WS_X); GAS bf16* H = (GAS bf16*)(ws + WS_H);
    const GAS float* MODB = (const GAS float*)(ws + WS_MOD); const GAS float* MOD = MODB + (size_t)l * 5 * 6144;
    const GAS float* n1g1 = cx.in(I_N1G) + D; const GAS float* fng = cx.in(I_FNG); GAS float* outp = cx.out();
    const int R = (MTOK - m_lo + G - 1) / G, m_beg = m_lo + bid * R + wave, m_end = min(m_lo + (bid + 1) * R, MTOK);
    f32x4 g5r[4], fgr[4]; NormPar np; int cb = -1;
    if (l != 0) {
#pragma unroll
        for (int j = 0; j < 4; ++j) fgr[j] = *(const GAS f32x4*)(fng + 4 * lane + 256 * j); }
#pragma unroll 1
    for (int m = m_beg; m < m_end; m += 8) {
        const int d0 = moe_off[EID[m * 2]] + POS[m * 2], d1 = moe_off[EID[m * 2 + 1]] + POS[m * 2 + 1];
        const float w0 = GATE[m * 2], w1 = GATE[m * 2 + 1];
        { const int b = bidx_of_row(m);
            if (b != cb) { const GAS float* mb = MOD + (size_t)b * 6144;
#pragma unroll
                for (int j = 0; j < 4; ++j) g5r[j] = *(const GAS f32x4*)(mb + 5 * 1024 + 4 * lane + 256 * j);
                if (l == 0) { const GAS float* mb1 = MODB + (size_t)(5 + b) * 6144; load_normpar(np, n1g1, mb1, mb1 + 1024, lane); }
                cb = b; } }
        f32x4 v[4];
#pragma unroll
        for (int j = 0; j < 4; ++j) { const int c = 4 * lane + 256 * j;
            const v2u a0 = *(const GAS v2u*)(YS + (size_t)d0 * D + c), a1 = *(const GAS v2u*)(YS + (size_t)d1 * D + c);
            f32x4 y; y.x = w0 * bf2f(a0.x & 0xffffu) + w1 * bf2f(a1.x & 0xffffu); y.y = w0 * bf2f(a0.x >> 16) + w1 * bf2f(a1.x >> 16);
            y.z = w0 * bf2f(a0.y & 0xffffu) + w1 * bf2f(a1.y & 0xffffu); y.w = w0 * bf2f(a0.y >> 16) + w1 * bf2f(a1.y >> 16);
            v[j] = bf4f(*(const GAS v2u*)(X + (size_t)m * D + c)) + g5r[j] * y; }
        if (l == 0) {
#pragma unroll
            for (int j = 0; j < 4; ++j) *(GAS v2u*)(X + (size_t)m * D + 4 * lane + 256 * j) = f4bf(v[j]);
            norm_row_store_c(v, np, H + (size_t)m * D, lane);
        } else {
            float ss = 0.f;
#pragma unroll
            for (int j = 0; j < 4; ++j) ss += (v[j].x * v[j].x + v[j].y * v[j].y) + (v[j].z * v[j].z + v[j].w * v[j].w);
            const float rstd = rsqrtf(wave_sum(ss) * (1.f / D) + EPS);
#pragma unroll
            for (int j = 0; j < 4; ++j) { const int c = 4 * lane + 256 * j;
                *(GAS f32x4*)(outp + (size_t)(m - NCTX) * D + c) = v[j] * rstd * fgr[j]; }
        }
    }
}

#ifndef PH_MASK
#define PH_MASK 0xFFF
#endif
#define PHON(j) (((PH_MASK) >> (j)) & 1)
__global__ void __launch_bounds__(512, 2) fwd_kernel(Args args) {
    LAS unsigned char* lds = (LAS unsigned char*)lds_raw;
    volatile LAS unsigned* MISC = (volatile LAS unsigned*)(lds + MISC_OFF);
    {
        const int tid = threadIdx.x;
        for (int u = tid; u < (LDS_BYTES - MISC_OFF) / 4; u += 512) MISC[u] = 0u;
        __syncthreads();
        if (tid == 0) { volatile LAS unsigned long long* t = (volatile LAS unsigned long long*)(lds + PTR_OFF);
#pragma unroll
            for (int i = 0; i < N_IN; ++i) t[i] = (unsigned long long)args.in[i];
            t[N_IN] = (unsigned long long)args.out; t[N_IN + 1] = (unsigned long long)args.ws; }
        __syncthreads();
    }
    const Ctx cx;
#if MK_ONE_LAUNCH
    XcdBarrier bar = xcd_barrier_post((unsigned*)(cx.ws() + WS_CTL) + CW_BAR, MISC + 8);
#define GRID_BAR() xcd_barrier(bar)
#else
#define GRID_BAR() do { } while (0)
#endif
    const int lo = args.ph_lo, hi = args.ph_hi;
#define IN(k) (lo <= (k) && (k) < hi)
#define BOTH(k) (IN(k) && IN((k) + 1))
    if (PHON(0) && IN(0)) { TIDS; phase_prologue(cx, lds, tid, lane, wave, bid, G); if (BOTH(0)) GRID_BAR(); }
    if (PHON(1) && IN(1)) { TIDS; phase_norm1_l0(cx, lane, gw, NGW); if (BOTH(1)) GRID_BAR(); }
#define LAYER(L) { constexpr int l = L; constexpr int pb = 2 + 10 * l; \
        if (PHON(2) && IN(pb + 0)) { ph_gemm_in(cx, l); if (BOTH(pb + 0)) GRID_BAR(); } \
        if (PHON(3) && IN(pb + 1)) { ph_prep_r1(cx, l); if (BOTH(pb + 1)) GRID_BAR(); } \
        if (PHON(4) && IN(pb + 2)) { rec_r2(cx, blockIdx.x * 512 + threadIdx.x, gridDim.x * 512); if (BOTH(pb + 2)) GRID_BAR(); } \
        if (PHON(5) && IN(pb + 3)) { ph_mixers(cx, l); if (BOTH(pb + 3)) GRID_BAR(); } \
        if (PHON(6) && IN(pb + 4)) { ph_gemm_out(cx, l); if (BOTH(pb + 4)) GRID_BAR(); } \
        if (PHON(7) && IN(pb + 5)) { ph_router(cx, l); if (BOTH(pb + 5)) GRID_BAR(); } \
        if (PHON(9) && IN(pb + 7)) { ph_gemm_gu(cx, l);   } \
        if (PHON(10) && IN(pb + 8)) { ph_gemm_dn(cx, l); if (BOTH(pb + 8)) GRID_BAR(); } \
        if (PHON(11) && IN(pb + 9)) { ph_combine(cx, l); if (BOTH(pb + 9)) GRID_BAR(); } }
    LAYER(0)
    LAYER(1)
#undef LAYER
#undef IN
#undef BOTH
}

constexpr int NPHASES = 22;
extern "C" void kernel_launch(void* const* d_in, const int* in_sizes, int n_in, void* d_out, int out_size, void* d_ws, size_t ws_size, hipStream_t stream) {
    static int grid = 0;
    if (grid == 0) {
        if (n_in != N_IN || out_size != NLAT * D || ws_size < WS_END) { fprintf(stderr, "kernel_launch: unexpected problem (n_in %d, out %d, ws %zu)\n", n_in, out_size, ws_size); grid = -1; return; }
        int dev = 0, cus = 0, per_cu = 0;
        if (hipGetDevice(&dev) != hipSuccess || hipDeviceGetAttribute(&cus, hipDeviceAttributeMultiprocessorCount, dev) != hipSuccess) { grid = -1; return; }
        if (hipFuncSetAttribute((const void*)fwd_kernel, hipFuncAttributeMaxDynamicSharedMemorySize, LDS_BYTES) != hipSuccess) { fprintf(stderr, "kernel_launch: hipFuncSetAttribute failed\n"); grid = -1; return; }
        if (hipOccupancyMaxActiveBlocksPerMultiprocessor(&per_cu, (const void*)fwd_kernel, 512, LDS_BYTES) != hipSuccess || per_cu < 1) fprintf(stderr, "kernel_launch: occupancy query reports %d\n", per_cu);
        (void)hipGetLastError();
        grid = cus;
    }
    if (grid < 0) return;
    (void)hipMemsetAsync((char*)d_ws + WS_CTL, 0, CTL_BYTES, stream);
    Args a{};
    for (int i = 0; i < N_IN; ++i) a.in[i] = (const float*)d_in[i];
    a.out = (float*)d_out; a.ws = (unsigned char*)d_ws;
#if MK_ONE_LAUNCH
    a.ph_lo = 0; a.ph_hi = NPHASES;
    hipLaunchKernelGGL(fwd_kernel, dim3(grid), dim3(512), LDS_BYTES, stream, a);
#else
    for (int p = 0; p < NPHASES; ++p) { a.ph_lo = p; a.ph_hi = p + 1; hipLaunchKernelGGL(fwd_kernel, dim3(grid), dim3(512), LDS_BYTES, stream, a); }
#endif
}
```

```cpp
#include <hip/hip_runtime.h>
#include <cstdio>
#include <cstdint>

#ifndef MK_ONE_LAUNCH
#define MK_ONE_LAUNCH 1
#endif

#define DI __device__ __forceinline__
#define GAS __attribute__((address_space(1)))
#define LAS __attribute__((address_space(3)))
typedef unsigned short bf16;
typedef unsigned v4u __attribute__((ext_vector_type(4)));
typedef unsigned v2u __attribute__((ext_vector_type(2)));
typedef float f32x4 __attribute__((ext_vector_type(4)));
typedef short bf16x8 __attribute__((ext_vector_type(8)));
#define LDS_WAIT() asm volatile("s_waitcnt lgkmcnt(0)" ::: "memory")

constexpr int D = 1024, NB = 4, SEQ = 4096, LCTX = 256, NCTX = NB * LCTX, NLAT = NB * SEQ, MTOK = NCTX + NLAT;
constexpr int DIN = 3200, PP = 3328;
constexpr int CA_Q = 0, CA_I = 256, CA_FF = 512, CA_FB = 768, CA_G = 1024;
constexpr int CB_Q = 1280, CB_K = 1536, CB_V = 1792;
constexpr int CC_Q = 2048, CC_K = 2176, CC_V = 2304, CC_G = 2560, CC_ZF = 2816, CC_ZB = 2832;
constexpr int CD_Q = 2848, CD_KV = 3040, CD_R = 3168;
constexpr int NKEY = LCTX + SEQ;
constexpr int NCHUNK = NKEY / 64;
constexpr float EPS = 1e-6f;
constexpr float LOG2E = 1.4426950408889634f;
constexpr int MOE_MAXT = 168;
constexpr int MOE_CAP = 2 * 17408;

enum { I_X = 0, I_C, I_CTX, I_CCTX, I_WMOD, I_BMOD, I_N1G, I_N2G, I_WIN, I_WOUT, I_LBL, I_HNG, I_RPB, I_WGF, I_BGF, I_WGB, I_BGB, I_GNG, I_QNG, I_WUQ, I_KVNG, I_WUKV,
       I_WRG, I_BRG, I_WRE, I_BRE, I_WGU, I_WDN, I_FNG, N_IN };

constexpr size_t MiB = 1u << 20;
constexpr size_t WS_CTL = 0, CTL_BYTES = 2 * MiB;
constexpr size_t WS_WTIN = 2 * MiB;
constexpr size_t WTIN_L = (size_t)PP * D * 2;
constexpr size_t WS_WTOUT = 16 * MiB;
constexpr size_t WS_WTUQ = 20 * MiB;
constexpr size_t WS_WTUKV = WS_WTUQ + 512 * 1024;
constexpr size_t WS_MOD = 21 * MiB;
constexpr size_t WS_WR = WS_MOD + 512 * 1024;
constexpr size_t WS_WTGU = 22 * MiB;
constexpr size_t WS_WTDN = 86 * MiB;
constexpr size_t WS_X = 118 * MiB;
constexpr size_t WS_H = 186 * MiB;
constexpr size_t WS_CAT = 220 * MiB;
constexpr size_t WS_P = 254 * MiB;
constexpr size_t WS_XS = WS_P;
constexpr size_t WS_ACT = 338 * MiB;
constexpr size_t WS_QM = 366 * MiB;
constexpr size_t WS_KM = 379 * MiB;
constexpr size_t WS_VM = 392 * MiB;
constexpr size_t WS_RSH = 401 * MiB;
constexpr size_t WS_RSG = 435 * MiB;
constexpr size_t WS_RAH = 452 * MiB;
constexpr size_t WS_RAG = WS_RAH + 600 * 1024;
constexpr size_t WS_MOE = 453 * MiB;
constexpr size_t WS_VNT = 454 * MiB;
constexpr size_t WS_RIDX = 463 * MiB;
constexpr size_t WS_END = 468 * MiB;
constexpr int CW_BAR = 4096;
constexpr int CW_CNT = 16384;
constexpr int CW_GUC = 32768;
constexpr int CW_TMO = 64;

constexpr int RING_BYTES = 131072;
constexpr int MISC_OFF = RING_BYTES;
constexpr int LDS_BYTES = 147456;

DI float bf2f(unsigned v) { return __uint_as_float(v << 16); }
DI unsigned f2bf(float f) { unsigned u = __float_as_uint(f); return (u + 0x7fffu + ((u >> 16) & 1u)) >> 16; }
typedef __bf16 bf16v2 __attribute__((ext_vector_type(2)));
typedef float f32x2 __attribute__((ext_vector_type(2)));
DI unsigned pk2(float lo, float hi) { const f32x2 v = {lo, hi}; return __builtin_bit_cast(unsigned, __builtin_convertvector(v, bf16v2)); }
DI f32x4 bf4f(v2u w) { f32x4 r; r.x = __uint_as_float(w.x << 16); r.y = __uint_as_float(w.x & 0xffff0000u); r.z = __uint_as_float(w.y << 16); r.w = __uint_as_float(w.y & 0xffff0000u); return r; }
DI v2u f4bf(f32x4 v) { return (v2u){pk2(v.x, v.y), pk2(v.z, v.w)}; }
DI bf16x8 pack8(float a0, float a1, float a2, float a3, float a4, float a5, float a6, float a7) {
    v4u p; p.x = pk2(a0, a1); p.y = pk2(a2, a3); p.z = pk2(a4, a5); p.w = pk2(a6, a7);
    return __builtin_bit_cast(bf16x8, p);
}
DI float wave_sum(float v) {
#pragma unroll
    for (int o = 1; o < 64; o <<= 1) v += __shfl_xor(v, o);
    return v;
}
DI float frcp_(float x) { return __builtin_amdgcn_rcpf(x); }
DI float sigmoid_(float x) { return frcp_(1.f + __expf(-x)); }
DI float silu_(float x) { return x * frcp_(1.f + __expf(-x)); }
DI float logsigmoid_(float x) { return fminf(x, 0.f) - __logf(1.f + __expf(-fabsf(x))); }
DI void unpack8(v4u w, float* f) {
    f[0] = __uint_as_float(w.x << 16); f[1] = __uint_as_float(w.x & 0xffff0000u);
    f[2] = __uint_as_float(w.y << 16); f[3] = __uint_as_float(w.y & 0xffff0000u);
    f[4] = __uint_as_float(w.z << 16); f[5] = __uint_as_float(w.z & 0xffff0000u);
    f[6] = __uint_as_float(w.w << 16); f[7] = __uint_as_float(w.w & 0xffff0000u);
}
DI int bidx_of_row(int m) { return m < NCTX ? 4 : ((m - NCTX) >> 12); }

namespace pg8 {
#define PG8_LAS __attribute__((address_space(3)))
typedef unsigned short bf16_t;
typedef unsigned u32x4 __attribute__((ext_vector_type(4)));
constexpr int BM = 256, BK = 64, HALF = 128, HTB = HALF * BK * 2, STAGE_BYTES = 8 * HTB, NXCD = 8, WGM = 8;
__host__ __device__ __forceinline__ int lds_byte(int r, int c) { const int st = (r >> 4) * 2 + (c >> 5), rr = r & 15, cc = c & 31, ob = rr * 64 + cc * 2; return st * 1024 + (ob ^ (((ob >> 9) & 1) << 5)); }
__host__ __device__ __forceinline__ void stage_rc(int b, int& R, int& C) { const int st = b / 1024, sb = b % 1024, swz = sb ^ (((sb >> 9) & 1) << 5); R = (st >> 1) * 16 + swz / 64; C = (st & 1) * 32 + (swz % 64) / 2; }
__host__ __device__ __forceinline__ int perm32(int rho) { const int n = rho >> 4, i = rho & 15; return 8 * (i >> 2) + 4 * n + (i & 3); }
struct Unit { int pm, pn; size_t bo; };
struct LinearRows { static constexpr bool LINEAR = true; __device__ __forceinline__ int operator()(const Unit& u, int r) const { return u.pm * BM + r; } };
struct MoeRows { static constexpr bool LINEAR = false; const PG8_LAS int* idx; int pm0;
    __device__ __forceinline__ int operator()(const Unit& u, int r) const { return idx[(u.pm == pm0 ? 0 : 256) + r]; } };
struct Gemm { const GAS bf16_t* A; const GAS bf16_t* Bt; int M, N, K; };
struct StaticOrder {
    int nM, nN, nwg, G, c;
    __device__ void init(int M, int N, int G_, int c_) { nM = M / BM; nN = N / BM; nwg = nM * nN; G = G_; c = c_; }
    __device__ bool next(int i, Unit& u) const {
        const long L = (long)i * G + c; if (L >= nwg) return false;
        int wgid = (int)L; { const int q = nwg / NXCD, r = nwg % NXCD, xcd = wgid % NXCD, off = wgid / NXCD; wgid = (xcd < r ? xcd * (q + 1) : r * (q + 1) + (xcd - r) * q) + off; }
        const int nig = WGM * nN, gid = wgid / nig, fm = gid * WGM, gsz = (nM - fm) < WGM ? (nM - fm) : WGM;
        u.pm = fm + ((wgid % nig) % gsz); u.pn = (wgid % nig) / gsz; u.bo = 0; return true;
    }
    __device__ __forceinline__ void a_ready(const Unit&) const {}
    __device__ __forceinline__ void done(const Unit&) const {}
};
struct GroupedOrder {
    int nT, nN, G, c; const PG8_LAS int* tile_e; size_t estride; int pm0 = 0;
    __device__ bool next(int i, Unit& u) const {
        if (c < 0) return false;
        const long L = (long)i * G + c; if (L >= (long)nT * nN) return false;
        u.pm = pm0 + (int)(L / nN); u.pn = (int)(L % nN); u.bo = (size_t)__builtin_amdgcn_readfirstlane(tile_e[u.pm]) * estride; return true;
    }
    __device__ __forceinline__ void a_ready(const Unit&) const {}
    __device__ __forceinline__ void done(const Unit&) const {}
};
struct GroupedPublish : GroupedOrder { GAS unsigned* done_cnt;
    __device__ __forceinline__ void done(const Unit& u) const { asm volatile("s_waitcnt vmcnt(0)" ::: "memory");
        if ((threadIdx.x & 63) == 0) __hip_atomic_fetch_add(done_cnt + 64 * u.pm, 1u, __ATOMIC_RELAXED, __HIP_MEMORY_SCOPE_AGENT); } };
__device__ __forceinline__ void wait_rowtile(const GAS unsigned* ready, int pm, unsigned need) {
    if (threadIdx.x < 64) {
        unsigned spins = 0;
        while ((unsigned)__builtin_amdgcn_readfirstlane(__hip_atomic_load(ready + 64 * pm, __ATOMIC_RELAXED, __HIP_MEMORY_SCOPE_AGENT)) < need && ++spins < (1u << 22)) __builtin_amdgcn_s_sleep(2);
        __builtin_amdgcn_fence(__ATOMIC_ACQUIRE, "agent");
        asm volatile("s_waitcnt vmcnt(0)" ::: "memory");
    }
    __syncthreads();
}
__device__ __forceinline__ unsigned cvt_pk_bf16(float lo, float hi) { unsigned r; asm volatile("v_cvt_pk_bf16_f32 %0, %1, %2" : "=v"(r) : "v"(lo), "v"(hi)); return r; }

struct EpiStoreBf16 {
    static constexpr bool PERM = true;
    GAS bf16_t* O; int ldc;
    __device__ __forceinline__ void operator()(const f32x4 (&acc)[2][2][4][2], const Unit& u, int wr, int wc, int fr, int fq) const {
        const int row0 = u.pm * BM + wr * 64 + fr, col0 = u.pn * BM + wc * 32 + 8 * fq;
#pragma unroll
        for (int ai = 0; ai < 2; ++ai)
#pragma unroll
            for (int m = 0; m < 4; ++m) { GAS bf16_t* rowp = O + (size_t)(row0 + ai * HALF + m * 16) * ldc + col0;
#pragma unroll
                for (int bj = 0; bj < 2; ++bj) { const f32x4 v0 = acc[ai][bj][m][0], v1 = acc[ai][bj][m][1];
                    u32x4 w; w.x = cvt_pk_bf16(v0[0], v0[1]); w.y = cvt_pk_bf16(v0[2], v0[3]); w.z = cvt_pk_bf16(v1[0], v1[1]); w.w = cvt_pk_bf16(v1[2], v1[3]);
                    *(GAS u32x4*)(rowp + bj * HALF) = w; } }
    }
};
struct EpiResid {
    static constexpr bool PERM = true;
    GAS bf16_t* X; int row_off; const GAS float* mod;
    const GAS float* src_ctx; const GAS float* src_lat;
    __device__ __forceinline__ void operator()(const f32x4 (&acc)[2][2][4][2], const Unit& u, int wr, int wc, int fr, int fq) const {
        const int row0 = row_off + u.pm * BM + wr * 64 + fr, col0 = u.pn * BM + wc * 32 + 8 * fq;
        f32x4 gv[2][2];
        { const GAS float* gp = mod + (size_t)bidx_of_row(row_off + u.pm * BM) * 6144 + col0;
#pragma unroll
            for (int bj = 0; bj < 2; ++bj)
#pragma unroll
                for (int n = 0; n < 2; ++n) gv[bj][n] = *(const GAS f32x4*)(gp + bj * HALF + n * 4); }
#pragma unroll
        for (int ai = 0; ai < 2; ++ai)
#pragma unroll
            for (int m = 0; m < 4; ++m) { const int row = row0 + ai * HALF + m * 16; GAS bf16_t* rowp = X + (size_t)row * D + col0;
                const GAS float* bp = src_lat ? (row < NCTX ? src_ctx + (size_t)row * D + col0 : src_lat + (size_t)(row - NCTX) * D + col0) : (const GAS float*)nullptr;
#pragma unroll
                for (int bj = 0; bj < 2; ++bj) { f32x4 x0, x1;
                    if (src_lat) { x0 = *(const GAS f32x4*)(bp + bj * HALF); x1 = *(const GAS f32x4*)(bp + bj * HALF + 4); }
                    else { const u32x4 w = *(const GAS u32x4*)(rowp + bj * HALF); x0 = bf4f((v2u){w.x, w.y}); x1 = bf4f((v2u){w.z, w.w}); }
                    x0 = x0 + gv[bj][0] * acc[ai][bj][m][0]; x1 = x1 + gv[bj][1] * acc[ai][bj][m][1];
                    const v2u o0 = f4bf(x0), o1 = f4bf(x1); *(GAS u32x4*)(rowp + bj * HALF) = (u32x4){o0.x, o0.y, o1.x, o1.y}; } }
    }
};
struct EpiGateUp {
    static constexpr bool PERM = true;
    GAS bf16_t* O; unsigned nbytes;
    __device__ __forceinline__ void operator()(const f32x4 (&acc)[2][2][4][2], const Unit& u, int wr, int wc, int fr, int fq) const {
        const int row0 = u.pm * BM + wr * 64 + fr, col0 = u.pn * HALF + wc * 32 + 8 * fq;
        const __amdgpu_buffer_rsrc_t rsrc = __builtin_amdgcn_make_buffer_rsrc((void*)O, 0, (int)nbytes, 0x00020000);
#pragma unroll
        for (int ai = 0; ai < 2; ++ai)
#pragma unroll
            for (int m = 0; m < 4; ++m) { const unsigned off = (unsigned)((row0 + ai * HALF + m * 16) * 256 + col0) * 2u;
                float r[8];
#pragma unroll
                for (int n = 0; n < 2; ++n)
#pragma unroll
                    for (int j = 0; j < 4; ++j) { const float g = acc[ai][0][m][n][j], up = acc[ai][1][m][n][j]; r[n * 4 + j] = g * __builtin_amdgcn_rcpf(1.f + __expf(-g)) * up; }
                u32x4 w; w.x = cvt_pk_bf16(r[0], r[1]); w.y = cvt_pk_bf16(r[2], r[3]); w.z = cvt_pk_bf16(r[4], r[5]); w.w = cvt_pk_bf16(r[6], r[7]);
                __builtin_amdgcn_raw_buffer_store_b128(w, rsrc, (int)off, 0, 16); }
    }
};

template <class Epi, class Sched, class Rows = LinearRows>
__device__ __forceinline__ void gemm_phase(PG8_LAS unsigned char* lds, const Gemm g, const Sched& S, const Epi& E, const Rows RM = Rows()) {
    const int tid = threadIdx.x, wid = __builtin_amdgcn_readfirstlane(tid >> 6), lane = tid & 63, wr = wid >> 2, wc = wid & 3, fr = lane & 15, fq = lane >> 4;
    const int K = g.K, nt = K / BK;
    unsigned voffB[2]; int rA[2], cA2[2];
#pragma unroll
    for (int i = 0; i < 2; ++i) { int R, C; stage_rc(tid * 16 + i * 8192, R, C); const int Rb = Epi::PERM ? ((R & ~31) + perm32(R & 31)) : R;
        rA[i] = R; cA2[i] = C * 2; voffB[i] = (unsigned)(Rb * K + C) * 2u; }
    unsigned oAc[2][2], oAn[2][2];
#define PG8_AOFF(dst, u) do { _Pragma("unroll") for (int _h = 0; _h < 2; ++_h) _Pragma("unroll") for (int _i = 0; _i < 2; ++_i) dst[_h][_i] = (unsigned)RM(u, _h * HALF + rA[_i]) * (unsigned)(K * 2) + (unsigned)cA2[_i]; } while (0)
#define PG8_STAGE_A(bufoff, o2, kbyte) do { _Pragma("unroll") for (int _i = 0; _i < 2; ++_i) \
        __builtin_amdgcn_global_load_lds((const unsigned*)((const char*)g.A + (size_t)(kbyte) + (o2)[_i]), (PG8_LAS unsigned*)(lds + (bufoff) + ldsw + _i * 8192), 16, 0, 0); } while (0)
    const size_t kstep = (size_t)(BK * 2);
    const size_t hstep = (size_t)HALF * K * 2;
    const size_t tstep = 2 * hstep;
    const unsigned ldsw = (unsigned)wid * 1024u;
    const int aoff = lds_byte(wr * 64 + fr, fq * 8), boff = lds_byte(wc * 32 + fr, fq * 8);
#define PG8_SA(b, h) (((b) * 2 + (h)) * HTB)
#define PG8_SB(b, h) ((4 + (b) * 2 + (h)) * HTB)
#define PG8_STAGE(bufoff, gbase, voff) do { _Pragma("unroll") for (int _i = 0; _i < 2; ++_i) \
        __builtin_amdgcn_global_load_lds((const unsigned*)((const char*)(gbase) + (voff)[_i]), (PG8_LAS unsigned*)(lds + (bufoff) + ldsw + _i * 8192), 16, 0, 0); } while (0)
#define PG8_LDA(dst, b, h) do { _Pragma("unroll") for (int m = 0; m < 4; ++m) _Pragma("unroll") for (int k = 0; k < 2; ++k) dst[m][k] = *(const PG8_LAS bf16x8*)(lds + PG8_SA(b, h) + aoff + m * 2048 + k * 1024); } while (0)
#define PG8_LDB(dst, b, h) do { _Pragma("unroll") for (int n = 0; n < 2; ++n) _Pragma("unroll") for (int k = 0; k < 2; ++k) dst[n][k] = *(const PG8_LAS bf16x8*)(lds + PG8_SB(b, h) + boff + n * 2048 + k * 1024); } while (0)
#define PG8_MMA(ai, bj, At, Bt) do { __builtin_amdgcn_s_setprio(1); _Pragma("unroll") for (int m = 0; m < 4; ++m) _Pragma("unroll") for (int n = 0; n < 2; ++n) _Pragma("unroll") for (int k = 0; k < 2; ++k) \
        acc[ai][bj][m][n] = __builtin_amdgcn_mfma_f32_16x16x32_bf16(Bt[n][k], At[m][k], acc[ai][bj][m][n], 0, 0, 0); __builtin_amdgcn_s_setprio(0); } while (0)
#define PG8_WAIT_V(n) asm volatile("s_waitcnt vmcnt(" #n ")" ::: "memory")
#define PG8_WAIT_L(n) asm volatile("s_waitcnt lgkmcnt(" #n ")" ::: "memory")
#define PG8_BAR __builtin_amdgcn_s_barrier()
#define PG8_SCHED __builtin_amdgcn_sched_barrier(0)
    Unit cur, nxt; int ui = 0;
    if (!S.next(0, cur)) return;
    f32x4 acc[2][2][4][2];
#pragma unroll
    for (int a = 0; a < 2; ++a)
#pragma unroll
        for (int b = 0; b < 2; ++b)
#pragma unroll
            for (int m = 0; m < 4; ++m)
#pragma unroll
                for (int n = 0; n < 2; ++n) acc[a][b][m][n] = (f32x4){0.f, 0.f, 0.f, 0.f};
    bf16x8 At[4][2], B0[2][2], B1[2][2];
    const char* cB = (const char*)g.Bt + cur.bo + (size_t)cur.pn * tstep;
    S.a_ready(cur);
    PG8_AOFF(oAc, cur);
    PG8_STAGE(PG8_SB(0, 0), cB, voffB); PG8_STAGE_A(PG8_SA(0, 0), oAc[0], 0); PG8_STAGE(PG8_SB(0, 1), cB + hstep, voffB); PG8_STAGE_A(PG8_SA(0, 1), oAc[1], 0);
    if (wr == 1) PG8_BAR;
    PG8_WAIT_V(4); PG8_BAR;
    PG8_STAGE(PG8_SB(1, 0), cB + kstep, voffB); PG8_STAGE_A(PG8_SA(1, 0), oAc[0], kstep); PG8_STAGE(PG8_SB(1, 1), cB + hstep + kstep, voffB);
    PG8_WAIT_V(6); PG8_BAR;
    for (;;) {
        const bool has_next = S.next(ui + 1, nxt);
        const char* nB = has_next ? (const char*)g.Bt + nxt.bo + (size_t)nxt.pn * tstep : cB;
        unsigned dAn = 0u;
        if constexpr (Rows::LINEAR) { if (has_next) dAn = (unsigned)(nxt.pm - cur.pm) * (unsigned)(BM * K * 2); }
        else { if (has_next) PG8_AOFF(oAn, nxt);
            else {
#pragma unroll
                for (int _h = 0; _h < 2; ++_h)
#pragma unroll
                    for (int _i = 0; _i < 2; ++_i) oAn[_h][_i] = oAc[_h][_i]; } }
        for (int t = 0; t < nt; t += 2) {
            const bool last = (t == nt - 2);
            const size_t k1 = (size_t)(t + 1) * kstep, k2 = last ? 0 : (size_t)(t + 2) * kstep, k3 = k2 + kstep;
            unsigned o20[2], o21[2];
#pragma unroll
            for (int _i = 0; _i < 2; ++_i) { if constexpr (Rows::LINEAR) { o20[_i] = oAc[0][_i] + (last ? dAn : 0u); o21[_i] = oAc[1][_i] + (last ? dAn : 0u); }
                else { o20[_i] = last ? oAn[0][_i] : oAc[0][_i]; o21[_i] = last ? oAn[1][_i] : oAc[1][_i]; } }
            const char* b2 = last ? nB : cB + (size_t)(t + 2) * kstep;
            const char* b3 = b2 + kstep;
            if (last && has_next) S.a_ready(nxt);
            PG8_LDB(B0, 0, 0); PG8_SCHED; PG8_LDA(At, 0, 0); PG8_STAGE_A(PG8_SA(1, 1), oAc[1], k1);
            PG8_WAIT_L(8); PG8_BAR; PG8_WAIT_L(0); PG8_MMA(0, 0, At, B0); PG8_BAR; PG8_SCHED;
            PG8_LDB(B1, 0, 1); PG8_STAGE(PG8_SB(0, 0), b2, voffB);
            PG8_BAR; PG8_WAIT_L(0); PG8_MMA(0, 1, At, B1); PG8_BAR;
            PG8_LDA(At, 0, 1); PG8_STAGE_A(PG8_SA(0, 0), o20, k2);
            PG8_BAR; PG8_WAIT_L(0); PG8_MMA(1, 0, At, B0); PG8_BAR; PG8_SCHED;
            PG8_STAGE(PG8_SB(0, 1), b2 + hstep, voffB);
            PG8_WAIT_V(6); PG8_BAR; PG8_MMA(1, 1, At, B1); PG8_BAR;
            PG8_LDB(B0, 1, 0); PG8_SCHED; PG8_LDA(At, 1, 0); PG8_STAGE_A(PG8_SA(0, 1), o21, k2);
            PG8_WAIT_L(8); PG8_BAR; PG8_WAIT_L(0); PG8_MMA(0, 0, At, B0); PG8_BAR; PG8_SCHED;
            PG8_LDB(B1, 1, 1); PG8_STAGE(PG8_SB(1, 0), b3, voffB);
            PG8_BAR; PG8_WAIT_L(0); PG8_MMA(0, 1, At, B1); PG8_BAR;
            PG8_LDA(At, 1, 1); PG8_STAGE_A(PG8_SA(1, 0), o20, k3);
            PG8_BAR; PG8_WAIT_L(0); PG8_MMA(1, 0, At, B0); PG8_BAR; PG8_SCHED;
            PG8_STAGE(PG8_SB(1, 1), b3 + hstep, voffB);
            PG8_WAIT_V(6); PG8_BAR; PG8_MMA(1, 1, At, B1); PG8_BAR;
        }
        E(acc, cur, wr, wc, fr, fq); S.done(cur);
        if (!has_next) break;
#pragma unroll
        for (int a = 0; a < 2; ++a)
#pragma unroll
            for (int b = 0; b < 2; ++b)
#pragma unroll
                for (int m = 0; m < 4; ++m)
#pragma unroll
                    for (int n = 0; n < 2; ++n) acc[a][b][m][n] = (f32x4){0.f, 0.f, 0.f, 0.f};
        cur = nxt; cB = nB; ++ui;
#pragma unroll
        for (int _h = 0; _h < 2; ++_h)
#pragma unroll
            for (int _i = 0; _i < 2; ++_i) { if constexpr (Rows::LINEAR) oAc[_h][_i] += dAn; else oAc[_h][_i] = oAn[_h][_i]; }
    }
    PG8_WAIT_V(0);
    if (wr == 0) PG8_BAR;
    PG8_BAR;
#undef PG8_SA
#undef PG8_SB
#undef PG8_STAGE
#undef PG8_STAGE_A
#undef PG8_AOFF
#undef PG8_LDA
#undef PG8_LDB
#undef PG8_MMA
#undef PG8_WAIT_V
#undef PG8_WAIT_L
#undef PG8_BAR
#undef PG8_SCHED
}
}

#define XB_TMO      128
#define XB_XCNT(j)  (256  + 64 * (j))
#define XB_XSUB(j)  (1280 + 64 * (j))
#define XB_XGEN(j)  (2304 + 64 * (j))
#define XB_TOP      3328
#define XB_TOPGEN   3392
#define XCD_BAR_WORDS 3456
#define XB_SPIN_CAP (1u << 18)
__device__ __forceinline__ unsigned xb_ld(unsigned* p)              { return __hip_atomic_load(p, __ATOMIC_RELAXED, __HIP_MEMORY_SCOPE_AGENT); }
__device__ __forceinline__ unsigned xb_add(unsigned* p, unsigned v) { return __hip_atomic_fetch_add(p, v, __ATOMIC_RELAXED, __HIP_MEMORY_SCOPE_AGENT); }
__device__ __forceinline__ unsigned xb_xcc_id() { return (unsigned)__builtin_amdgcn_s_getreg((3 << 11) | 20) & 0xFu; }
#define XB_SPIN(cond, bar) do { unsigned _sp = 0; while (cond) { __builtin_amdgcn_s_sleep(1); \
    if ((++_sp & 255u) == 0u) { if (xb_ld(&(bar)[XB_TMO])) break; if (_sp > XB_SPIN_CAP) { atomicAdd(&(bar)[XB_TMO], 1u); break; } } } } while (0)
struct XcdBarrier { unsigned* bar; unsigned x; volatile LAS unsigned* st; };
__device__ __forceinline__ XcdBarrier xcd_barrier_post(unsigned* bar, volatile LAS unsigned* st) {
    XcdBarrier b; b.bar = bar; b.x = xb_xcc_id(); b.st = st;
    if (threadIdx.x == 0) (void)xb_add(&bar[XB_XCNT(b.x)], 1u);
    return b;
}
__device__ __forceinline__ void xcd_barrier_complete(unsigned* bar, unsigned x, unsigned& nloc, unsigned& nx) {
    const unsigned G = gridDim.x * gridDim.y * gridDim.z;
    unsigned sum, cnt, mine, sp = 0u;
    for (;;) {
        sum = 0u; cnt = 0u; mine = 0u;
#pragma unroll
        for (unsigned j = 0; j < 16; ++j) { const unsigned c = xb_ld(&bar[XB_XCNT(j)]); sum += c; cnt += (c > 0u) ? 1u : 0u; mine = (j == x) ? c : mine; }
        if (sum == G) break;
        __builtin_amdgcn_s_sleep(1);
        if ((++sp & 255u) == 0u) { if (xb_ld(&bar[XB_TMO])) break; if (sp > XB_SPIN_CAP) { atomicAdd(&bar[XB_TMO], 1u); break; } }
    }
    nloc = mine > 0u ? mine : 1u; nx = cnt > 0u ? cnt : 1u;
}
__device__ __forceinline__ void xcd_barrier(const XcdBarrier& b) {
    asm volatile("s_waitcnt vmcnt(0)" ::: "memory");
    __syncthreads();
    if (threadIdx.x == 0) {
        unsigned* bar = b.bar;
        __builtin_amdgcn_s_waitcnt(0);
        unsigned nloc = b.st[0], nx = b.st[1];
        if (nloc == 0u) { xcd_barrier_complete(bar, b.x, nloc, nx); b.st[0] = nloc; b.st[1] = nx; }
        const unsigned old = xb_add(&bar[XB_XSUB(b.x)], 1u);
        const unsigned gen = old / nloc;
        if (old + 1u == (gen + 1u) * nloc) {
            __builtin_amdgcn_fence(__ATOMIC_RELEASE, "agent");
            asm volatile("s_waitcnt vmcnt(0)" ::: "memory");
            const unsigned og = xb_add(&bar[XB_TOP], 1u);
            const unsigned tg = og / nx;
            if (og + 1u == (tg + 1u) * nx) xb_add(&bar[XB_TOPGEN], 1u);
            else XB_SPIN(xb_ld(&bar[XB_TOPGEN]) == tg, bar);
            __builtin_amdgcn_fence(__ATOMIC_ACQUIRE, "agent");
            xb_add(&bar[XB_XGEN(b.x)], 1u);
            asm volatile("s_waitcnt vmcnt(0)" ::: "memory");
        } else {
            XB_SPIN(xb_ld(&bar[XB_XGEN(b.x)]) == gen, bar);
            __builtin_amdgcn_fence(__ATOMIC_ACQUIRE, "agent");
            asm volatile("s_waitcnt vmcnt(0)" ::: "memory");
        }
    }
    __syncthreads();
}

struct Args { const float* in[N_IN]; float* out; unsigned char* ws; int ph_lo, ph_hi; int pad0, pad1; };
extern __shared__ __attribute__((aligned(16))) unsigned char lds_raw[];
constexpr int PTR_OFF = MISC_OFF + 2048;
struct Ctx {
    DI unsigned long long raw(int i) const { volatile LAS unsigned* t = (volatile LAS unsigned*)((LAS unsigned char*)lds_raw + PTR_OFF) + 2 * i;
        const unsigned lo = __builtin_amdgcn_readfirstlane(t[0]), hi = __builtin_amdgcn_readfirstlane(t[1]); return ((unsigned long long)hi << 32) | lo; }
    DI const GAS float* in(int i) const { return (const GAS float*)raw(i); }
    DI GAS float* out() const { return (GAS float*)raw(N_IN); }
    DI GAS unsigned char* ws() const { return (GAS unsigned char*)raw(N_IN + 1); }
};

DI void transpose_item(const GAS float* W, int N, int k0, int n0, GAS bf16* WT, int Kd, int drow0, LAS float* scr, int lane) {
    float wv[32];
#pragma unroll
    for (int i = 0; i < 32; ++i) wv[i] = W[(size_t)(k0 + 2 * i + (lane >> 5)) * N + n0 + (lane & 31)];
#pragma unroll
    for (int i = 0; i < 32; ++i) scr[(2 * i + (lane >> 5)) * 33 + (lane & 31)] = wv[i];
    LDS_WAIT(); asm volatile("" ::: "memory");
    const int c = lane & 7;
#pragma unroll
    for (int j = 0; j < 4; ++j) { const int n = (lane >> 3) + 8 * j; const LAS float* s = scr + (8 * c) * 33 + n;
        v4u o; o.x = pk2(s[0 * 33], s[1 * 33]); o.y = pk2(s[2 * 33], s[3 * 33]); o.z = pk2(s[4 * 33], s[5 * 33]); o.w = pk2(s[6 * 33], s[7 * 33]);
        *(GAS v4u*)(WT + (size_t)(drow0 + n) * Kd + k0 + 8 * c) = o; }
    LDS_WAIT(); asm volatile("" ::: "memory");
}

DI void weight_copies(const Ctx& a, int l, LAS unsigned char* lds, int tid, int lane, int wave, int gwv, int ngw, int gt, int ngt, int part = 0) {
    GAS unsigned char* ws = a.ws();
    if (part != 2) for (int i = gt; i < 128 * 1024 / 8; i += ngt) *(GAS v4u*)(ws + WS_WTIN + (size_t)l * WTIN_L + (size_t)3200 * D * 2 + (size_t)i * 16) = (v4u){0u, 0u, 0u, 0u};
    LAS float* scr = (LAS float*)(lds + wave * 16384);
    constexpr int IT_IN = 16 * 100, IT_OUT = 16 * 32, IT_UQ = 3 * 12, IT_UKV = 2 * 16, IT_GU = 32 * 16 * 16, IT_DN = 32 * 4 * 32;
    constexpr int NITEMS = IT_IN + IT_OUT + IT_UQ + IT_UKV + IT_GU + IT_DN;
    const int it_lo = part == 2 ? NITEMS - IT_GU - IT_DN : 0, it_hi = part == 2 ? NITEMS - IT_DN : NITEMS;
    for (int it = it_lo + gwv; it < it_hi; it += ngw) {
        if (part == 1 && it >= NITEMS - IT_GU - IT_DN && it < NITEMS - IT_DN) { it += ((NITEMS - IT_DN - it + ngw - 1) / ngw) * ngw - ngw; continue; }
        int r = it;
        if (r < IT_IN) { const int kb = r / 100, nb = r % 100;
            transpose_item(a.in(I_WIN) + (size_t)l * D * DIN, DIN, kb * 64, nb * 32, (GAS bf16*)(ws + WS_WTIN + (size_t)l * WTIN_L), D, nb * 32, scr, lane); continue; } r -= IT_IN;
        if (r < IT_OUT) { const int kb = r / 32, nb = r % 32;
            transpose_item(a.in(I_WOUT) + (size_t)l * D * D, D, kb * 64, nb * 32, (GAS bf16*)(ws + WS_WTOUT + (size_t)l * D * D * 2), D, nb * 32, scr, lane); continue; } r -= IT_OUT;
        if (r < IT_UQ) { const int kb = r / 12, nb = r % 12;
            transpose_item(a.in(I_WUQ) + (size_t)l * 192 * 384, 384, kb * 64, nb * 32, (GAS bf16*)(ws + WS_WTUQ + (size_t)l * 384 * 192 * 2), 192, nb * 32, scr, lane); continue; } r -= IT_UQ;
        if (r < IT_UKV) { const int kb = r / 16, nb = r % 16;
            transpose_item(a.in(I_WUKV) + (size_t)l * 128 * 512, 512, kb * 64, nb * 32, (GAS bf16*)(ws + WS_WTUKV + (size_t)l * 512 * 128 * 2), 128, nb * 32, scr, lane); continue; } r -= IT_UKV;
        if (r < IT_GU) { const int le = l * 32 + r / 256, q = r % 256, kb = q / 16, nb = q % 16; const int n0 = nb * 32, c0 = n0 & 255, isup = n0 >> 8;
            const int drow0 = (c0 >> 7) * 256 + isup * 128 + (c0 & 127);
            transpose_item(a.in(I_WGU) + (size_t)le * D * 512, 512, kb * 64, n0, (GAS bf16*)(ws + WS_WTGU + (size_t)le * 512 * D * 2), D, drow0, scr, lane); continue; } r -= IT_GU;
        { const int le = l * 32 + r / 128, q = r % 128, kb = q / 32, nb = q % 32;
            transpose_item(a.in(I_WDN) + (size_t)le * 256 * D, D, kb * 64, nb * 32, (GAS bf16*)(ws + WS_WTDN + (size_t)le * D * 256 * 2), 256, nb * 32, scr, lane); }
    }
}

DI void phase_prologue(const Ctx& a, LAS unsigned char* lds, int tid, int lane, int wave, int bid, int G) {
    GAS unsigned char* ws = a.ws();
    GAS float* MOD = (GAS float*)(ws + WS_MOD);
    {
        LAS float* S = (LAS float*)lds;
        LAS float* R = (LAS float*)(lds + 5 * 1024 * 4);
        if (bid < 192) {
            const GAS float* cvec = a.in(I_C); const GAS float* cctx = a.in(I_CCTX);
            for (int i = tid; i < 5 * 1024; i += 512) { const int r = i >> 10, k = i & 1023; const float v = r < 4 ? cvec[r * 1024 + k] : cctx[k]; S[i] = silu_(v); }
        }
        __syncthreads();
        for (int u = bid; u < 192; u += G) {
            const int l = u / 96, cl = tid & 63, n = (u % 96) * 64 + cl, ks = tid >> 6;
            const GAS float* W = a.in(I_WMOD) + (size_t)l * 1024 * 6144 + n; const GAS float* bmod = a.in(I_BMOD);
            float acc[5] = {0.f, 0.f, 0.f, 0.f, 0.f};
            for (int k = ks * 128; k < ks * 128 + 128; ++k) { const float w = W[(size_t)k * 6144];
#pragma unroll
                for (int r = 0; r < 5; ++r) acc[r] += S[r * 1024 + k] * w; }
#pragma unroll
            for (int r = 0; r < 5; ++r) R[(ks * 5 + r) * 64 + cl] = acc[r];
            __syncthreads();
            if (tid < 320) { const int r = tid >> 6; float s = 0.f;
#pragma unroll
                for (int k2 = 0; k2 < 8; ++k2) s += R[(k2 * 5 + r) * 64 + cl];
                MOD[(size_t)(l * 5 + r) * 6144 + n] = s + bmod[l * 6144 + n]; }
            __syncthreads();
        }
    }
    for (int i = bid * 512 + tid; i < 2 * 48 * 1024; i += G * 512) { const int l = i / (48 * 1024), r = i % (48 * 1024), c = r >> 10, k = r & 1023;
        const float w = c < 4 ? a.in(I_WRG)[(size_t)l * D * 4 + k * 4 + c] : (c < 36 ? a.in(I_WRE)[(size_t)l * D * 32 + k * 32 + (c - 4)] : 0.f);
        const unsigned hi = f2bf(w); const float lo = w - bf2f(hi);
        GAS bf16* WR = (GAS bf16*)(ws + WS_WR) + (size_t)l * 2 * 48 * 1024;
        WR[c * 1024 + k] = (bf16)hi; WR[48 * 1024 + c * 1024 + k] = (bf16)f2bf(lo); }
    weight_copies(a, 0, lds, tid, lane, wave, bid * 8 + wave, G * 8, bid * 512 + tid, G * 512, 1);
}

DI void norm_row_store(const f32x4 (&v)[4], const GAS float* g, const GAS float* shift, const GAS float* scale, GAS bf16* hrow, int lane) {
    float ss = 0.f;
#pragma unroll
    for (int j = 0; j < 4; ++j) ss += (v[j].x * v[j].x + v[j].y * v[j].y) + (v[j].z * v[j].z + v[j].w * v[j].w);
    const float rstd = rsqrtf(wave_sum(ss) * (1.f / D) + EPS);
#pragma unroll
    for (int j = 0; j < 4; ++j) { const int c = 4 * lane + 256 * j;
        const f32x4 gg = *(const GAS f32x4*)(g + c), sh = *(const GAS f32x4*)(shift + c), sc = *(const GAS f32x4*)(scale + c);
        const f32x4 y = v[j] * rstd * gg * (1.f + sc) + sh;
        v2u o; o.x = pk2(y.x, y.y); o.y = pk2(y.z, y.w); *(GAS v2u*)(hrow + c) = o; }
}

struct NormPar { f32x4 w[4], sh[4]; };
DI void load_normpar(NormPar& p, const GAS float* g, const GAS float* shift, const GAS float* scale, int lane) {
#pragma unroll
    for (int j = 0; j < 4; ++j) { const int c = 4 * lane + 256 * j; const f32x4 gg = *(const GAS f32x4*)(g + c), sc = *(const GAS f32x4*)(scale + c); p.w[j] = gg * (1.f + sc); p.sh[j] = *(const GAS f32x4*)(shift + c); }
}
DI void norm_row_store_c(const f32x4 (&v)[4], const NormPar& p, GAS bf16* hrow, int lane) {
    float ss = 0.f;
#pragma unroll
    for (int j = 0; j < 4; ++j) ss += (v[j].x * v[j].x + v[j].y * v[j].y) + (v[j].z * v[j].z + v[j].w * v[j].w);
    const float rstd = rsqrtf(wave_sum(ss) * (1.f / D) + EPS);
#pragma unroll
    for (int j = 0; j < 4; ++j) { const f32x4 y = v[j] * rstd * p.w[j] + p.sh[j]; v2u o; o.x = pk2(y.x, y.y); o.y = pk2(y.z, y.w); *(GAS v2u*)(hrow + 4 * lane + 256 * j) = o; }
}

DI void phase_norm1_l0(const Ctx& a, int lane, int gw, int NGW) {
    GAS unsigned char* ws = a.ws(); GAS bf16* H = (GAS bf16*)(ws + WS_H); const GAS float* MOD = (const GAS float*)(ws + WS_MOD);
    const GAS float* xin = a.in(I_X); const GAS float* cin = a.in(I_CTX); const GAS float* n1g = a.in(I_N1G);
    const int nwg = NGW >> 3, R = (MTOK + nwg - 1) / nwg, m_beg = (gw >> 3) * R + (gw & 7), m_end = min(((gw >> 3) + 1) * R, MTOK);
    NormPar np; int cb = -1;
#pragma unroll 1
    for (int m = m_beg; m < m_end; m += 8) {
        const GAS float* src = m < NCTX ? cin + (size_t)m * D : xin + (size_t)(m - NCTX) * D;
        f32x4 v[4];
#pragma unroll
        for (int j = 0; j < 4; ++j) v[j] = *(const GAS f32x4*)(src + 4 * lane + 256 * j);
        const int b = bidx_of_row(m);
        if (b != cb) { const GAS float* mb = MOD + (size_t)b * 6144; load_normpar(np, n1g, mb, mb + 1024, lane); cb = b; }
        norm_row_store_c(v, np, H + (size_t)m * D, lane);
    }
}

DI bf16x8 ld8(const LAS bf16* p) { return *(const LAS bf16x8*)p; }
DI bf16x8 ld8(const GAS bf16* p) { return *(const GAS bf16x8*)p; }
template <class PA, class PB>
DI f32x4 mma16(PA A, int lda, PB B, int ldb, int K, int lane) {
    f32x4 acc = {0.f, 0.f, 0.f, 0.f};
    const int r = lane & 15, q = (lane >> 4) * 8;
    for (int k = 0; k < K; k += 32) {
        const bf16x8 av = ld8(A + r * lda + k + q);
        const bf16x8 bv = ld8(B + r * ldb + k + q);
        acc = __builtin_amdgcn_mfma_f32_16x16x32_bf16(av, bv, acc, 0, 0, 0);
    }
    return acc;
}

constexpr int CQ_P = 200, CKV_P = 136, STG_P = 520;
constexpr int PR = 64, PL_CQ = 0, PL_CKV = 25600, PL_RK = 43008, PL_STG = 47104, PL_T = PL_STG;
DI float rope_ang(int t, int ri) { const int ax = ri >> 4, f = ri & 7; const float p = (float)(ax == 0 ? (t >> 6) : (t & 63)); return p * __builtin_amdgcn_exp2f(-1.6609640474436813f * (float)f) * 0.15915494309189535f; }
DI void prep_unit(const Ctx& a, int l, int unit, LAS unsigned char* lds, int tid, int lane, int wave) {
    GAS unsigned char* ws = a.ws();
    const GAS bf16* P = (const GAS bf16*)(ws + WS_P);
    LAS bf16* CQ = (LAS bf16*)(lds + PL_CQ); LAS bf16* CKV = (LAS bf16*)(lds + PL_CKV); LAS bf16* STG = (LAS bf16*)(lds + PL_STG); LAS bf16* RK = (LAS bf16*)(lds + PL_RK); LAS bf16* T = (LAS bf16*)(lds + PL_T);
    const int m0 = unit * PR;
    const bool isctx = m0 < NCTX;
    const int bb = isctx ? (m0 >> 8) : ((m0 - NCTX) >> 12);
    const int pos0 = isctx ? (m0 & 255) : (256 + ((m0 - NCTX) & 4095));
    const int t0 = isctx ? 0 : ((m0 - NCTX) & 4095);
    { const GAS float* gq = a.in(I_QNG) + l * 192; const GAS float* gkv = a.in(I_KVNG) + l * 128;
        const bool isq = lane < 24, iskv = lane >= 24 && lane < 40; const int pc = isq ? lane : lane - 24;
        float gn[8];
#pragma unroll
        for (int e = 0; e < 8; ++e) gn[e] = isq ? gq[pc * 8 + e] : (iskv ? gkv[pc * 8 + e] : 0.f);
#pragma unroll
        for (int rr = 0; rr < PR / 8; ++rr) { const int r = wave * (PR / 8) + rr; float x[8];
            v4u w = (v4u){0u, 0u, 0u, 0u}; if (lane < 40) w = *(const GAS v4u*)(P + (size_t)(m0 + r) * PP + (isq ? CD_Q : CD_KV) + pc * 8);
            unpack8(w, x); float ss = 0.f;
#pragma unroll
            for (int e = 0; e < 8; ++e) ss += x[e] * x[e];
            const float sq = wave_sum(isq ? ss : 0.f), skv = wave_sum(iskv ? ss : 0.f);
            const float rs = isq ? rsqrtf(sq * (1.f / 192.f) + EPS) : rsqrtf(skv * (1.f / 128.f) + EPS);
#pragma unroll
            for (int e = 0; e < 8; ++e) x[e] *= rs * gn[e];
            const v4u o = (v4u){pk2(x[0], x[1]), pk2(x[2], x[3]), pk2(x[4], x[5]), pk2(x[6], x[7])};
            if (isq) *(LAS v4u*)(CQ + r * CQ_P + pc * 8) = o; else if (iskv) *(LAS v4u*)(CKV + r * CKV_P + pc * 8) = o; } }
    for (int e = tid; e < PR * 32; e += 512) { const int r = e >> 5, ri = e & 31; const GAS bf16* prow = P + (size_t)(m0 + r) * PP + CD_R;
        float v = bf2f(prow[ri]);
        if (!isctx) { const float pv = bf2f(prow[ri ^ 8]); const float ang = rope_ang(t0 + r, ri); const float cs = __builtin_amdgcn_cosf(ang), sn = __builtin_amdgcn_sinf(ang);
            v = ((ri >> 3) & 1) == 0 ? (v * cs - pv * sn) : (pv * sn + v * cs); }
        RK[r * 32 + ri] = (bf16)f2bf(v); }
    for (int e = tid; e < PR * 32; e += 512) { const int r = e >> 5, c8 = e & 31; *(LAS v4u*)(T + r * 264 + c8 * 8) = *(const GAS v4u*)(P + (size_t)(m0 + r) * PP + CB_V + c8 * 8); }
    __syncthreads();
    GAS bf16* QM = (GAS bf16*)(ws + WS_QM); GAS bf16* KM = (GAS bf16*)(ws + WS_KM); GAS bf16* VM = (GAS bf16*)(ws + WS_VM); GAS bf16* VNT = (GAS bf16*)(ws + WS_VNT);
    const GAS bf16* WTQ = (const GAS bf16*)(ws + WS_WTUQ + (size_t)l * 384 * 192 * 2);
    const GAS bf16* WTKV = (const GAS bf16*)(ws + WS_WTUKV + (size_t)l * 512 * 128 * 2);
    const float qs = 0.10206207261596575f * LOG2E;
    const int fr = lane & 15, fq = lane >> 4;
    for (int e = tid; e < 256 * (PR / 8); e += 512) { const int col = e / (PR / 8), p8 = e % (PR / 8); unsigned hv[8];
#pragma unroll
        for (int j = 0; j < 8; ++j) hv[j] = T[(p8 * 8 + j) * 264 + col];
        *(GAS v4u*)(VNT + ((size_t)(bb * 4) * 64 + col) * NKEY + pos0 + p8 * 8) = (v4u){hv[0] | (hv[1] << 16), hv[2] | (hv[3] << 16), hv[4] | (hv[5] << 16), hv[6] | (hv[7] << 16)}; }
    __syncthreads();
    { bf16x8 bfr[3][6];
#pragma unroll
      for (int i = 0; i < 3; ++i)
#pragma unroll
        for (int ks = 0; ks < 6; ++ks) bfr[i][ks] = *(const GAS bf16x8*)(WTQ + (size_t)((wave + 8 * i) * 16 + fr) * 192 + ks * 32 + fq * 8);
#pragma unroll
      for (int i = 0; i < 3; ++i) { const int nb = wave + 8 * i;
        const int c = nb * 16 + fr, within = c % 96;
#pragma unroll
        for (int mb = 0; mb < PR / 16; ++mb) { f32x4 acc = {0.f, 0.f, 0.f, 0.f};
#pragma unroll
            for (int ks = 0; ks < 6; ++ks) acc = __builtin_amdgcn_mfma_f32_16x16x32_bf16(*(const LAS bf16x8*)(CQ + (mb * 16 + fr) * CQ_P + ks * 32 + fq * 8), bfr[i][ks], acc, 0, 0, 0);
#pragma unroll
            for (int j = 0; j < 4; ++j) { const int r = mb * 16 + 4 * fq + j; float v = acc[j]; const float pv = __shfl_xor(v, 8);
                if (within >= 64 && !isctx) { const int ri = within - 64; const float ang = rope_ang(t0 + r, ri); const float cs = __builtin_amdgcn_cosf(ang), sn = __builtin_amdgcn_sinf(ang);
                    v = ((ri >> 3) & 1) == 0 ? (v * cs - pv * sn) : (pv * sn + v * cs); }
                STG[r * STG_P + c] = (bf16)f2bf(v * qs); } } } }
    __syncthreads();
    for (int e = tid; e < PR * 48; e += 512) { const int r = e / 48, hp = e % 48, hd = hp / 12, pc = hp % 12;
        *(GAS v4u*)(QM + ((size_t)(bb * 4 + hd) * NKEY + pos0 + r) * 96 + pc * 8) = *(const LAS v4u*)(STG + r * STG_P + hd * 96 + pc * 8); }
    __syncthreads();
    { bf16x8 bfr[4][4];
#pragma unroll
      for (int i = 0; i < 4; ++i)
#pragma unroll
        for (int ks = 0; ks < 4; ++ks) bfr[i][ks] = *(const GAS bf16x8*)(WTKV + (size_t)((wave + 8 * i) * 16 + fr) * 128 + ks * 32 + fq * 8);
#pragma unroll
      for (int i = 0; i < 4; ++i) { const int nb = wave + 8 * i;
#pragma unroll
        for (int mb = 0; mb < PR / 16; ++mb) { f32x4 acc = {0.f, 0.f, 0.f, 0.f};
#pragma unroll
            for (int ks = 0; ks < 4; ++ks) acc = __builtin_amdgcn_mfma_f32_16x16x32_bf16(*(const LAS bf16x8*)(CKV + (mb * 16 + fr) * CKV_P + ks * 32 + fq * 8), bfr[i][ks], acc, 0, 0, 0);
#pragma unroll
            for (int j = 0; j < 4; ++j) STG[(mb * 16 + 4 * fq + j) * STG_P + nb * 16 + fr] = (bf16)f2bf(acc[j]); } } }
    __syncthreads();
    for (int e = tid; e < PR * 48; e += 512) { const int r = e / 48, hp = e % 48, hd = hp / 12, pc = hp % 12;
        const v4u v = pc < 8 ? *(const LAS v4u*)(STG + r * STG_P + hd * 128 + pc * 8) : *(const LAS v4u*)(RK + r * 32 + (pc - 8) * 8);
        *(GAS v4u*)(KM + ((size_t)(bb * 4 + hd) * NKEY + pos0 + r) * 96 + pc * 8) = v; }
    for (int e = tid; e < 256 * (PR / 8); e += 512) { const int col = e / (PR / 8), p8 = e % (PR / 8), hd = col >> 6, dv = col & 63; unsigned hv[8];
#pragma unroll
        for (int j = 0; j < 8; ++j) hv[j] = STG[(p8 * 8 + j) * STG_P + hd * 128 + 64 + dv];
        *(GAS v4u*)(VM + ((size_t)(bb * 4 + hd) * 64 + dv) * NKEY + pos0 + p8 * 8) = (v4u){hv[0] | (hv[1] << 16), hv[2] | (hv[3] << 16), hv[4] | (hv[5] << 16), hv[6] | (hv[7] << 16)}; }
    __syncthreads();
}

constexpr int RP = 65;
DI int scan_row(int b, int dir, int c, int i) {
    const int s = 64 * c + i;
    if (dir == 0) return s < 256 ? b * 256 + s : NCTX + b * SEQ + (s - 256);
    return s < 256 ? b * 256 + 255 - s : NCTX + b * SEQ + SEQ - 1 - (s - 256);
}
#ifndef BAR_LDS
#define BAR_LDS() asm volatile("s_waitcnt lgkmcnt(0)\n\ts_barrier" ::: "memory")
#endif
constexpr int RC_P = 68;
constexpr int L_C = 0, L_QD = 17408, L_QE = 26624, L_KD = 35840, L_VT = 58880, L_ST = 68096, L_ATT = 77312, L_O = 86528, L_T = 103168;
template <int MIX> struct RecCfg { static constexpr int DK = MIX == 0 ? 64 : 32, DKP = DK + 8, NP = DK / 8, CPT = DK / 8; };
template <int MIX> struct RecPre {
    v4u fk;
    v4u zg[MIX == 1 ? 2 : 1];
    v4u qp;
    v4u vp; f32x4 s0, s1;
};
template <int MIX, bool R3>
DI void rec_fetch(RecPre<MIX>& R, const GAS bf16* P, const GAS float* RSbase, int b, int h, int dir, int c, int tid) {
    constexpr int DK = RecCfg<MIX>::DK;
    const int lane = tid & 63, wave = tid >> 6;
    const GAS bf16* prow = P + (size_t)scan_row(b, dir, c, lane) * PP;
    if (MIX == 0) { R.fk = *(const GAS v4u*)(prow + (dir ? CA_FB : CA_FF) + h * 64 + 8 * wave); if (R3) R.qp = *(const GAS v4u*)(prow + CA_Q + h * 64 + 8 * wave); }
    else { const GAS bf16* zr = prow + (dir ? CC_ZB : CC_ZF); R.zg[0] = *(const GAS v4u*)zr; R.zg[1] = *(const GAS v4u*)(zr + 8);
        const v2u kk = *(const GAS v2u*)(prow + CC_K + h * 32 + 4 * wave); R.fk = (v4u){kk.x, kk.y, 0u, 0u};
        if (R3) { const v2u qq = *(const GAS v2u*)(prow + CC_Q + h * 32 + 4 * wave); R.qp = (v4u){qq.x, qq.y, 0u, 0u}; } }
    R.vp = *(const GAS v4u*)(P + (size_t)scan_row(b, dir, c, tid >> 3) * PP + (MIX == 0 ? CA_I : CC_V) + h * 64 + (tid & 7) * 8);
    if (R3 && tid < DK * 8) { const GAS float* rs = RSbase + (size_t)(((b * 4 + h) * 2 + dir) * NCHUNK + c) * DK * 64 + (tid >> 3) * 64 + (tid & 7) * 8; R.s0 = *(const GAS f32x4*)rs; R.s1 = *(const GAS f32x4*)(rs + 4); }
}
DI float dpp_shr_(float v, int ctrl_sel) { const int iv = __builtin_bit_cast(int, v); int r;
    switch (ctrl_sel) { case 1: r = __builtin_amdgcn_update_dpp(0, iv, 0x111, 0xf, 0xf, true); break; case 2: r = __builtin_amdgcn_update_dpp(0, iv, 0x112, 0xf, 0xf, true); break;
                        case 4: r = __builtin_amdgcn_update_dpp(0, iv, 0x114, 0xf, 0xf, true); break; default: r = __builtin_amdgcn_update_dpp(0, iv, 0x118, 0xf, 0xf, true); break; }
    return __builtin_bit_cast(float, r); }
DI float scan64(float v) {
    v += dpp_shr_(v, 1); v += dpp_shr_(v, 2); v += dpp_shr_(v, 4); v += dpp_shr_(v, 8);
    v += __builtin_bit_cast(float, __builtin_amdgcn_update_dpp(0, __builtin_bit_cast(int, v), 0x142, 0xa, 0xf, false));
    v += __builtin_bit_cast(float, __builtin_amdgcn_update_dpp(0, __builtin_bit_cast(int, v), 0x143, 0xc, 0xf, false));
    return v; }
DI float lane_read(float v, int ln) { return __builtin_bit_cast(float, __builtin_amdgcn_readlane(__builtin_bit_cast(int, v), ln)); }
template <int MIX>
DI void rec_front(const RecPre<MIX>& R, const GAS float* lg, const GAS float* wgp, const GAS float* bgp, int l, int h, int dir, int wave, float (&kv)[RecCfg<MIX>::CPT], float (&cum)[RecCfg<MIX>::CPT]) {
    if (MIX == 0) { float z[8]; unpack8(R.fk, z);
#pragma unroll
        for (int e = 0; e < 8; ++e) { const int ch = h * 64 + 8 * wave + e; float lb = 0.f; if (l == 1) lb = sigmoid_(lg[512 + dir * 256 + ch] - lg[dir * 256 + ch]);
            const float f = lb + (1.f - lb) * sigmoid_(z[e]); cum[e] = scan64(__logf(f)); kv[e] = (1.f - lb) * sigmoid_(-z[e]); }
    } else { float z[16], kk[8]; unpack8(R.zg[0], z); unpack8(R.zg[1], z + 8); unpack8(R.fk, kk);
#pragma unroll
        for (int c = 0; c < 4; ++c) { const int ch = h * 32 + 4 * wave + c; float sacc = bgp[ch];
#pragma unroll
            for (int r = 0; r < 16; ++r) sacc += z[r] * wgp[r * 128 + ch];
            cum[c] = scan64(logsigmoid_(sacc) * (1.f / 16.f)); kv[c] = kk[c]; } }
}
template <int N> DI void st_bf16(LAS bf16* p, const float (&v)[N]) {
    if (N == 8) *(LAS v4u*)p = (v4u){pk2(v[0], v[1]), pk2(v[2], v[3]), pk2(v[4], v[5]), pk2(v[6], v[7])};
    else *(LAS v2u*)p = (v2u){pk2(v[0], v[1]), pk2(v[2], v[3])};
}
DI void rec_vt_store(const v4u vp, LAS bf16* VT, int tid) { const int j = tid >> 3, v8 = tid & 7; const unsigned ww[4] = {vp.x, vp.y, vp.z, vp.w};
#pragma unroll
    for (int e = 0; e < 8; ++e) VT[(v8 * 8 + e) * 72 + j] = (bf16)((ww[e >> 1] >> ((e & 1) * 16)) & 0xffffu); }

template <int MIX>
DI void rec_r1_run(const Ctx& a, int l, LAS unsigned char* lds, int tid, int bid, int G) {
    constexpr int DK = RecCfg<MIX>::DK, CPT = RecCfg<MIX>::CPT;
    const int lane = tid & 63, wave = __builtin_amdgcn_readfirstlane(tid >> 6);
    LAS bf16* KT = (LAS bf16*)(lds + L_KD); LAS bf16* VT = (LAS bf16*)(lds + L_VT);
    GAS unsigned char* wsb = a.ws(); const GAS bf16* P = (const GAS bf16*)(wsb + WS_P);
    GAS float* RSb = (GAS float*)(wsb + (MIX == 0 ? WS_RSH : WS_RSG)); GAS float* RAb = (GAS float*)(wsb + (MIX == 0 ? WS_RAH : WS_RAG));
    const GAS float* lg = a.in(I_LBL);
    const GAS float* wgF = a.in(I_WGF) + l * 16 * 128; const GAS float* wgB = a.in(I_WGB) + l * 16 * 128; const GAS float* bgF = a.in(I_BGF) + l * 128; const GAS float* bgB = a.in(I_BGB) + l * 128;
    constexpr int NU = 32 * NCHUNK;
    const bool rebal = (MIX == 0) && (G == 256);
    const int n0 = (rebal && bid < 16) ? 8 : 0, nn = (NU - 1 - bid) / G + 1, n1 = nn + ((rebal && bid >= 128) ? 1 : 0);
    auto unit_at = [&](int n) { if (n >= n1) return NU; if (n < nn) return bid + G * n; const int e = bid - 128; return (e & 15) + G * (e >> 4); };
    RecPre<MIX> Rs[2];
    int nidx = n0;
    int u0 = unit_at(nidx), u1 = unit_at(nidx + 1);
#pragma unroll
    for (int par = 0; par < 2; ++par) { const int unit = par ? u1 : u0; if (unit < NU) { const int c = unit % NCHUNK, chain = unit / NCHUNK; rec_fetch<MIX, false>(Rs[par], P, RSb, chain >> 3, (chain >> 1) & 3, chain & 1, c, tid); } }
    BAR_LDS();
#pragma unroll 1
    while (u0 < NU) {
        const int n2 = unit_at(nidx + 2), n3 = unit_at(nidx + 3);
#pragma unroll
        for (int par = 0; par < 2; ++par) { const int unit = par ? u1 : u0; if (unit < NU) { RecPre<MIX>& R = Rs[par];
            LAS bf16* KTp = par ? (LAS bf16*)(lds + L_ST) : KT; LAS bf16* VTp = par ? (LAS bf16*)(lds + L_ATT) : VT;
            const int c = unit % NCHUNK, chain = unit / NCHUNK, dir = chain & 1, h = (chain >> 1) & 3;
            { float kv[CPT], cum[CPT]; rec_front<MIX>(R, lg, dir ? wgB : wgF, dir ? bgB : bgF, l, h, dir, wave, kv, cum);
#pragma unroll
                for (int e = 0; e < CPT; ++e) { const float last = lane_read(cum[e], 63); KTp[(CPT * wave + e) * 72 + lane] = (bf16)f2bf(kv[e] * __expf(last - cum[e]));
                    if (lane == 63) RAb[(size_t)(chain * NCHUNK + c) * DK + CPT * wave + e] = __expf(cum[e]); } }
            rec_vt_store(R.vp, VTp, tid);
            { const int nu = par ? n3 : n2; if (nu < NU) { const int c2 = nu % NCHUNK, ch2 = nu / NCHUNK; rec_fetch<MIX, false>(R, P, RSb, ch2 >> 3, (ch2 >> 1) & 3, ch2 & 1, c2, tid); } } } }
        BAR_LDS();
#pragma unroll
        for (int par = 0; par < 2; ++par) { const int unit = par ? u1 : u0; if (unit < NU) {
            const LAS bf16* KTp = par ? (const LAS bf16*)(lds + L_ST) : KT; const LAS bf16* VTp = par ? (const LAS bf16*)(lds + L_ATT) : VT;
            const int c = unit % NCHUNK, chain = unit / NCHUNK;
            GAS float* RS = RSb + (size_t)(chain * NCHUNK + c) * DK * 64;
#pragma unroll 1
            for (int tl = wave; tl < (DK / 16) * 4; tl += 8) { const int kb = tl >> 2, vb = tl & 3;
                const f32x4 acc = mma16(KTp + kb * 16 * 72, 72, VTp + vb * 16 * 72, 72, 64, lane);
#pragma unroll
                for (int j = 0; j < 4; ++j) RS[(kb * 16 + 4 * (lane >> 4) + j) * 64 + vb * 16 + (lane & 15)] = acc[j]; } } }
        BAR_LDS();
        nidx += 2; u0 = n2; u1 = n3;
    }
}

DI void rec_r2(const Ctx& a, int gtid, int gthreads) {
    GAS unsigned char* wsb = a.ws();
#pragma unroll 1
    for (int e = gtid; e < 32 * 4096 + 32 * 2048; e += gthreads) {
        const bool g = e >= 32 * 4096; const int ee = g ? e - 32 * 4096 : e; const int DK = g ? 32 : 64, per = DK * 64;
        const int chain = ee / per, kv = ee % per, k = kv >> 6;
        GAS float* RS = (GAS float*)(wsb + (g ? WS_RSG : WS_RSH)) + (size_t)chain * NCHUNK * per + kv;
        const GAS float* RA = (const GAS float*)(wsb + (g ? WS_RAG : WS_RAH)) + (size_t)chain * NCHUNK * DK + k;
        float S = 0.f;
#pragma unroll 1
        for (int c = 0; c < NCHUNK; c += 4) { float U[4], A[4];
#pragma unroll
            for (int u = 0; u < 4; ++u) { U[u] = RS[(size_t)(c + u) * per]; A[u] = RA[(c + u) * DK]; }
#pragma unroll
            for (int u = 0; u < 4; ++u) { RS[(size_t)(c + u) * per] = S; S = A[u] * S + U[u]; } }
    }
}

template <int MIX>
DI void rec_r3_run(const Ctx& a, int l, LAS unsigned char* lds, int tid, int bid, int G, bool keep_ctx) {
    constexpr int DK = RecCfg<MIX>::DK, DKP = RecCfg<MIX>::DKP, CPT = RecCfg<MIX>::CPT;
    const int lane = tid & 63, wave = __builtin_amdgcn_readfirstlane(tid >> 6);
    LAS bf16* QD = (LAS bf16*)(lds + L_QD); LAS bf16* QE = (LAS bf16*)(lds + L_QE); LAS bf16* KD = (LAS bf16*)(lds + L_KD);
    LAS bf16* VT = (LAS bf16*)(lds + L_VT); LAS bf16* ST = (LAS bf16*)(lds + L_ST); LAS bf16* ATT = (LAS bf16*)(lds + L_ATT); LAS float* Ob = (LAS float*)(lds + L_O);
    GAS unsigned char* wsb = a.ws(); const GAS bf16* P = (const GAS bf16*)(wsb + WS_P); GAS bf16* CAT = (GAS bf16*)(wsb + WS_CAT);
    const GAS float* RSb = (const GAS float*)(wsb + (MIX == 0 ? WS_RSH : WS_RSG));
    const GAS float* lg = a.in(I_LBL); const GAS float* ngb = a.in(MIX == 0 ? I_HNG : I_GNG) + l * 256;
    const GAS float* wgF = a.in(I_WGF) + l * 16 * 128; const GAS float* wgB = a.in(I_WGB) + l * 16 * 128; const GAS float* bgF = a.in(I_BGF) + l * 128; const GAS float* bgB = a.in(I_BGB) + l * 128;
    constexpr int nR = 16 * NCHUNK;
    const int nAct = keep_ctx ? nR : 16 * 64, first = (bid + (MIX == 0 ? 0 : G - 64)) % G;
    auto unit_of = [&](int a) { return a >= nAct ? nR : (keep_ctx ? a : (a >> 6) * NCHUNK + 4 + (a & 63)); };
    auto scanc = [&](int tc, int dir) { return dir == 0 ? tc : (tc < 4 ? 3 - tc : 71 - tc); };
    RecPre<MIX> Rs[2];
    int aidx = first;
    int unit = unit_of(aidx);
    if (unit < nR) { const int tc = unit % NCHUNK, bh = unit / NCHUNK; rec_fetch<MIX, true>(Rs[0], P, RSb, bh >> 2, bh & 3, 0, scanc(tc, 0), tid); rec_fetch<MIX, true>(Rs[1], P, RSb, bh >> 2, bh & 3, 1, scanc(tc, 1), tid); }
    BAR_LDS();
#pragma unroll 1
    while (unit < nR) {
        const int tc = unit % NCHUNK, bh = unit / NCHUNK, h = bh & 3, b = bh >> 2;
        const int nunit = unit_of(aidx + G);
        v4u gatep = (v4u){0u, 0u, 0u, 0u};
#pragma unroll
        for (int dir = 0; dir < 2; ++dir) { RecPre<MIX>& R = Rs[dir];
            if (tid < DK * 8) { const int k = tid >> 3, v8 = tid & 7;
#pragma unroll
                for (int e = 0; e < 4; ++e) { ST[(v8 * 8 + e) * DKP + k] = (bf16)f2bf(R.s0[e]); ST[(v8 * 8 + 4 + e) * DKP + k] = (bf16)f2bf(R.s1[e]); } }
            rec_vt_store(R.vp, VT, tid);
            { const int ri = lane, I = ri >> 4; float kv[CPT], cm[CPT], qv[CPT], e8[CPT];
                rec_front<MIX>(R, lg, dir ? wgB : wgF, dir ? bgB : bgF, l, h, dir, wave, kv, cm);
                { float q8[8]; unpack8(R.qp, q8);
#pragma unroll
                    for (int e = 0; e < CPT; ++e) qv[e] = MIX == 0 ? silu_(q8[e]) * 0.125f : q8[e] * 0.17677669529663687f; }
#pragma unroll
                for (int e = 0; e < CPT; ++e) e8[e] = qv[e] * __expf(cm[e]);
                st_bf16<CPT>(QE + ri * DKP + CPT * wave, e8);
#pragma unroll
                for (int I2 = 0; I2 < 4; ++I2) {
                    float rf[CPT];
#pragma unroll
                    for (int e = 0; e < CPT; ++e) rf[e] = I2 == 0 ? 0.f : lane_read(cm[e], 16 * I2 - 1);
                    if (I2 >= I) {
                        if (I2 == I) {
#pragma unroll
                            for (int e = 0; e < CPT; ++e) e8[e] = qv[e] * __expf(cm[e] - rf[e]);
                            st_bf16<CPT>(QD + ri * DKP + CPT * wave, e8); }
#pragma unroll
                        for (int e = 0; e < CPT; ++e) e8[e] = kv[e] * __expf(fminf(rf[e] - cm[e], 80.f));
                        const int rowbase = I2 == 0 ? 0 : (I2 == 1 ? 16 : (I2 == 2 ? 48 : 96));
                        st_bf16<CPT>(KD + (rowbase + ri) * DKP + CPT * wave, e8); } } }
            if (dir == 0) {
                const int row = (tc < 4 ? b * 256 + tc * 64 : NCTX + b * SEQ + (tc - 4) * 64) + (tid >> 3);
                gatep = *(const GAS v4u*)(P + (size_t)row * PP + (MIX == 0 ? CA_G : CC_G) + h * 64 + (tid & 7) * 8); }
            if (nunit < nR) { const int tc2 = nunit % NCHUNK, bh2 = nunit / NCHUNK; rec_fetch<MIX, true>(R, P, RSb, bh2 >> 2, bh2 & 3, dir, scanc(tc2, dir), tid); }
            BAR_LDS();
            { const int I = wave >> 1, g = lane >> 4, c16 = lane & 15;
                const int rowbase = I == 0 ? 0 : (I == 1 ? 16 : (I == 2 ? 48 : 96));
                bf16x8 Bq[2];
#pragma unroll
                for (int m = 0; m < 2; ++m) {
                    f32x4 t0 = mma16(KD + (rowbase + 2 * m * 16) * DKP, DKP, QD + I * 16 * DKP, DKP, DK, lane);
                    f32x4 t1 = mma16(KD + (rowbase + (2 * m + 1) * 16) * DKP, DKP, QD + I * 16 * DKP, DKP, DK, lane);
#pragma unroll
                    for (int jj = 0; jj < 4; ++jj) { const bool up = 4 * g + jj > c16;
                        t0[jj] = (2 * m > I || (2 * m == I && up)) ? 0.f : t0[jj]; t1[jj] = (2 * m + 1 > I || (2 * m + 1 == I && up)) ? 0.f : t1[jj]; }
                    Bq[m] = pack8(t0[0], t0[1], t0[2], t0[3], t1[0], t1[1], t1[2], t1[3]); }
#pragma unroll
                for (int u = 0; u < 2; ++u) { const int vb = 2 * (wave & 1) + u; f32x4 acc = {0.f, 0.f, 0.f, 0.f};
#pragma unroll
                    for (int m = 0; m < 2; ++m) { const LAS bf16* vr = VT + (vb * 16 + c16) * 72 + 32 * m + 4 * g;
                        const v2u lo = *(const LAS v2u*)vr, hi = *(const LAS v2u*)(vr + 16);
                        acc = __builtin_amdgcn_mfma_f32_16x16x32_bf16(__builtin_bit_cast(bf16x8, (v4u){lo.x, lo.y, hi.x, hi.y}), Bq[m], acc, 0, 0, 0); }
                    const f32x4 acc2 = mma16(ST + vb * 16 * DKP, DKP, QE + I * 16 * DKP, DKP, DK, lane);
#pragma unroll
                    for (int jj = 0; jj < 4; ++jj) { const int i = I * 16 + c16, v = vb * 16 + 4 * g + jj; const float o = acc[jj] + acc2[jj];
                        if (dir == 0) Ob[i * RP + v] = o; else Ob[(63 - i) * RP + v] += o; } } }
            BAR_LDS();
        }
        { const int tl = tid >> 3, jg = tid & 7; float x[8]; float ss = 0.f;
#pragma unroll
            for (int vv = 0; vv < 8; ++vv) { x[vv] = Ob[tl * RP + jg * 8 + vv]; ss += x[vv] * x[vv]; }
            ss += __shfl_xor(ss, 1); ss += __shfl_xor(ss, 2); ss += __shfl_xor(ss, 4);
            const float rstd = rsqrtf(ss * (1.f / 64.f) + EPS);
            const int row = tc < 4 ? b * 256 + tc * 64 + tl : NCTX + b * SEQ + (tc - 4) * 64 + tl;
            const GAS float* ng = ngb + h * 64 + jg * 8;
            float gt[8]; unpack8(gatep, gt);
            float y[8];
#pragma unroll
            for (int vv = 0; vv < 8; ++vv) y[vv] = x[vv] * rstd * ng[vv] * silu_(gt[vv]);
            v4u ow; ow.x = pk2(y[0], y[1]); ow.y = pk2(y[2], y[3]); ow.z = pk2(y[4], y[5]); ow.w = pk2(y[6], y[7]);
            *(GAS v4u*)(CAT + (size_t)row * D + (MIX == 0 ? 0 : 512) + h * 64 + jg * 8) = ow; }
        unit = nunit; aidx += G;
    }
    __syncthreads();
}

typedef float f32x16 __attribute__((ext_vector_type(16)));
DI int swap23(int r) { return (r & 19) | ((r & 4) << 1) | ((r & 8) >> 1); }
struct AttnDesc {
    const GAS bf16* q; int qpitch;
    const GAS bf16* k; int kpitch;
    const GAS bf16* vt;
    GAS bf16* o; int opitch;
    int ntiles; float scale;
    int b, r0, rs0;
    const LAS float* rpb;
};
template <int DQK, bool NA>
DI void attn_mfma_unit(LAS unsigned char* lds, const AttnDesc& A, int tid, int lane, int wave) {
    constexpr int KP = DQK + 8, VP = 72, NS = DQK / 16, KPIECES = 64 * (DQK / 8);
    constexpr int BUF = 64 * KP * 2 + 64 * VP * 2;
    const int q = lane & 31, g = lane >> 5;
    auto tpos = [&](int t) { return NA ? (t < 4 ? 64 * t : 256 + 64 * (A.rs0 + t - 4)) : 64 * t; };
    auto krow = [&](int pos) { return NA ? (pos < 256 ? A.b * 256 + pos : NCTX + A.b * SEQ + (pos - 256)) : pos; };
    const int qi = NA ? (2 * (wave >> 2) + (q >> 4)) * 64 + 16 * (wave & 3) + (q & 15) : wave * 32 + q;
    const int kc0 = NA ? min(max(16 * (wave & 3) - 8, 0), 32) : 0;
    bf16x8 Qf[NS];
    { const GAS bf16* qp = A.q + (size_t)qi * A.qpitch + 8 * g;
#pragma unroll
        for (int s2 = 0; s2 < NS; ++s2) Qf[s2] = *(const GAS bf16x8*)(qp + 16 * s2); }
    f32x16 O[2];
#pragma unroll
    for (int db = 0; db < 2; ++db)
#pragma unroll
        for (int i = 0; i < 16; ++i) O[db][i] = 0.f;
    float mrun = -1e30f, lrun = 0.f;
    const int qr = NA ? A.r0 + (qi >> 6) : 0, qc = NA ? (qi & 63) : 0;
    const int wrs = NA ? min(max(qr - 4, 0), 56) : 0, cs = NA ? min(max(qc - 8, 0), 48) : 0;
    const int qr0 = NA ? A.r0 + 2 * (wave >> 2) : 0, wlo = NA ? min(max(qr0 - 4, 0), 56) : 0, whi = NA ? min(max(qr0 + 1 - 4, 0), 56) + 8 : 0;
    v4u kreg[2], vreg;
    auto gload = [&](int t) { const int pos = tpos(t);
#pragma unroll
        for (int u = 0; u < 2; ++u) { const int p = tid + 512 * u; if (p < KPIECES) { const int key = p / (DQK / 8), d8 = p % (DQK / 8); kreg[u] = *(const GAS v4u*)(A.k + (size_t)krow(pos + key) * A.kpitch + d8 * 8); } }
        vreg = *(const GAS v4u*)(A.vt + (size_t)(tid >> 3) * NKEY + pos + (tid & 7) * 8); };
    auto lstore = [&](int buf) { LAS bf16* Kt = (LAS bf16*)(lds + buf * BUF); LAS bf16* Vt = Kt + 64 * KP;
#pragma unroll
        for (int u = 0; u < 2; ++u) { const int p = tid + 512 * u; if (p < KPIECES) { const int key = p / (DQK / 8), d8 = p % (DQK / 8); *(LAS v4u*)(Kt + key * KP + d8 * 8) = kreg[u]; } }
        *(LAS v4u*)(Vt + (tid >> 3) * VP + (tid & 7) * 8) = vreg; };
    __syncthreads();
    gload(0); lstore(0);
    __syncthreads();
#pragma unroll 1
    for (int t = 0; t < A.ntiles; ++t) {
        const bool more = t + 1 < A.ntiles;
        if (more) gload(t + 1);
        bool active = true, rowok = true; int dr = 0;
        const bool win = NA && t >= 4;
        if (win) { const int wr = A.rs0 + t - 4; active = (wr >= wlo) && (wr < whi); rowok = (wr >= wrs) && (wr < wrs + 8); dr = min(max(wr - qr + 7, 0), 14); }
        if (active) {
            const LAS bf16* Kt = (const LAS bf16*)(lds + (t & 1) * BUF); const LAS bf16* Vt = Kt + 64 * KP;
            f32x16 S[2];
#pragma unroll
            for (int kb = 0; kb < 2; ++kb) {
#pragma unroll
                for (int i = 0; i < 16; ++i) S[kb][i] = 0.f;
                if (win && kb == 1) continue;
                const LAS bf16* kp = Kt + ((win ? kc0 : kb * 32) + swap23(q)) * KP + 8 * g;
#pragma unroll
                for (int s2 = 0; s2 < NS; ++s2) { const bf16x8 a = *(const LAS bf16x8*)(kp + 16 * s2); S[kb] = __builtin_amdgcn_mfma_f32_32x32x16_bf16(a, Qf[s2], S[kb], 0, 0, 0); }
            }
            float mx = -INFINITY;
            if (NA) {
                if (win) {
#pragma unroll
                    for (int i = 0; i < 16; ++i) { const int kc = kc0 + 16 * (i >> 3) + 8 * g + (i & 7); const int dc = min(max(kc - qc, -15), 15) + 15;
                        const float bv = A.rpb[dr * 31 + dc]; const float sv = (rowok && kc >= cs && kc < cs + 16) ? S[0][i] * A.scale + bv : -INFINITY;
                        S[0][i] = sv; mx = fmaxf(mx, sv); }
                } else {
#pragma unroll
                    for (int kb = 0; kb < 2; ++kb)
#pragma unroll
                        for (int i = 0; i < 16; ++i) { const float sv = S[kb][i] * A.scale; S[kb][i] = sv; mx = fmaxf(mx, sv); }
                }
            } else {
#pragma unroll
                for (int kb = 0; kb < 2; ++kb)
#pragma unroll
                    for (int i = 0; i < 16; ++i) mx = fmaxf(mx, S[kb][i]);
            }
            mx = fmaxf(mx, __shfl_xor(mx, 32));
            const float mn = fmaxf(mrun, mx), alpha = __builtin_amdgcn_exp2f(mrun - mn);
            mrun = mn;
            if (__any(alpha != 1.f)) { lrun *= alpha;
#pragma unroll
                for (int db = 0; db < 2; ++db)
#pragma unroll
                    for (int i = 0; i < 16; ++i) O[db][i] *= alpha; }
            bf16x8 Pf[4];
#pragma unroll
            for (int ks = 0; ks < 4; ++ks) { if (win && ks >= 2) continue; const int kb = ks >> 1, o8 = (ks & 1) * 8; float p[8];
#pragma unroll
                for (int j = 0; j < 8; ++j) { p[j] = __builtin_amdgcn_exp2f(S[kb][o8 + j] - mn); lrun += p[j]; }
                Pf[ks] = pack8(p[0], p[1], p[2], p[3], p[4], p[5], p[6], p[7]); }
#pragma unroll
            for (int db = 0; db < 2; ++db) { const LAS bf16* vp = Vt + (db * 32 + q) * VP + (win ? kc0 : 0) + 8 * g;
#pragma unroll
                for (int ks = 0; ks < 4; ++ks) { if (win && ks >= 2) continue; const bf16x8 a = *(const LAS bf16x8*)(vp + 16 * ks); O[db] = __builtin_amdgcn_mfma_f32_32x32x16_bf16(a, Pf[ks], O[db], 0, 0, 0); } }
        }
        if (more) lstore((t + 1) & 1);
        __syncthreads();
    }
    const float ltot = lrun + __shfl_xor(lrun, 32), inv = 1.f / ltot;
    GAS bf16* op = A.o + (size_t)qi * A.opitch + 4 * g;
#pragma unroll
    for (int db = 0; db < 2; ++db)
#pragma unroll
        for (int i4 = 0; i4 < 4; ++i4) { v2u w; w.x = pk2(O[db][4 * i4] * inv, O[db][4 * i4 + 1] * inv); w.y = pk2(O[db][4 * i4 + 2] * inv, O[db][4 * i4 + 3] * inv); *(GAS v2u*)(op + 32 * db + 8 * i4) = w; }
}

constexpr float MLA_TH = 8.f;
constexpr int NA_SLOT = 2 * 64 * 72 * 2, NA_RPB = 4 * NA_SLOT;
DI void na_unit(LAS unsigned char* lds, const AttnDesc& A, const GAS float* rp, int tid, int lane, int wave) {
    constexpr int KP = 72, VP = 72, NS = 4, KBUF = 64 * KP * 2;
    const int q = lane & 31, g = lane >> 5, NT = A.ntiles;
    auto tpos = [&](int t) { return t < 4 ? 64 * t : 256 + 64 * (A.rs0 + t - 4); };
    auto krow = [&](int pos) { return pos < 256 ? A.b * 256 + pos : NCTX + A.b * SEQ + (pos - 256); };
    const int qi = (2 * (wave >> 2) + (q >> 4)) * 64 + 16 * (wave & 3) + (q & 15);
    const int kc0 = min(max(16 * (wave & 3) - 8, 0), 32);
    bf16x8 Qf[NS];
    { const GAS bf16* qp = A.q + (size_t)qi * A.qpitch + 8 * g;
#pragma unroll
        for (int s2 = 0; s2 < NS; ++s2) Qf[s2] = *(const GAS bf16x8*)(qp + 16 * s2); }
    f32x16 O[2];
#pragma unroll
    for (int db = 0; db < 2; ++db)
#pragma unroll
        for (int i = 0; i < 16; ++i) O[db][i] = 0.f;
    float mrun = -1e30f, lrun = 0.f;
    const int qr = A.r0 + (qi >> 6), qc = qi & 63;
    const int wrs = min(max(qr - 4, 0), 56), cs = min(max(qc - 8, 0), 48);
    const int qr0 = A.r0 + 2 * (wave >> 2), wlo = min(max(qr0 - 4, 0), 56), whi = min(max(qr0 + 1 - 4, 0), 56) + 8;
    auto koffs = [&](int i) { const int j = i * 64 + lane, row = j / 9, pc = min(j % 9, 7); return (unsigned)(row * (PP * 2) + pc * 16); };
    auto voffs = [&](int i) { const int j = i * 64 + lane, row = j / 9, pc = min(j % 9, 7); return (unsigned)(row * (NKEY * 2) + pc * 16); };
    const int iv1 = wave == 0 ? 0 : wave - 1, iv2 = wave < 2 ? 7 + wave : iv1;
    const unsigned goff0 = koffs(wave), goff1 = wave == 0 ? koffs(8) : voffs(iv1), goff2 = voffs(iv2);
    auto dma = [&](int t, int slot) __attribute__((always_inline)) { const int pos = tpos(t);
        const GAS unsigned char* kb = (const GAS unsigned char*)(A.k + (size_t)krow(pos) * A.kpitch); const GAS unsigned char* vb = (const GAS unsigned char*)(A.vt + pos);
        LAS unsigned char* kl = lds + slot * NA_SLOT; LAS unsigned char* vl = kl + KBUF;
        __builtin_amdgcn_global_load_lds((const GAS unsigned*)(kb + goff0), (LAS unsigned*)(kl + wave * 1024), 16, 0, 0);
        __builtin_amdgcn_global_load_lds((const GAS unsigned*)((wave == 0 ? kb : vb) + goff1), (LAS unsigned*)(wave == 0 ? kl + 8 * 1024 : vl + iv1 * 1024), 16, 0, 0);
        __builtin_amdgcn_global_load_lds((const GAS unsigned*)(vb + goff2), (LAS unsigned*)(vl + iv2 * 1024), 16, 0, 0);
    };
    LAS float* T = (LAS float*)(lds + NA_RPB);
    float tv[4];
#pragma unroll
    for (int u = 0; u < 4; ++u) { const int e = tid + 512 * u, r = e >> 7, dcr = (e & 127) - 64; const bool in = r < 15 && dcr >= -15 && dcr <= 15;
        tv[u] = in ? rp[r * 31 + dcr + 15] * LOG2E : (r == 15 ? -INFINITY : 0.f); }
    float mcol[16];
#pragma unroll
    for (int i = 0; i < 16; ++i) { const int kc = kc0 + 16 * (i >> 3) + 8 * g + (i & 7); mcol[i] = (kc >= cs && kc < cs + 16) ? 0.f : -INFINITY; }
    __syncthreads();
    dma(0, 0); dma(min(1, NT - 1), 1); dma(min(2, NT - 1), 2);
#pragma unroll
    for (int u = 0; u < 4; ++u) T[tid + 512 * u] = tv[u];
    asm volatile("s_waitcnt vmcnt(6)\n\ts_waitcnt lgkmcnt(0)\n\ts_barrier" ::: "memory");
#pragma unroll 1
    for (int t = 0; t < NT; ++t) {
        dma(min(t + 3, NT - 1), (t + 3) & 3);
        bool active = true, rowok = true; int dr = 0;
        const bool win = t >= 4;
        if (win) { const int wr = A.rs0 + t - 4; active = (wr >= wlo) && (wr < whi); rowok = (wr >= wrs) && (wr < wrs + 8); dr = min(max(wr - qr + 7, 0), 14); }
        if (active) {
            const LAS bf16* Kt = (const LAS bf16*)(lds + (t & 3) * NA_SLOT); const LAS bf16* Vt = Kt + 64 * KP;
            f32x16 S[2];
#pragma unroll
            for (int kb = 0; kb < 2; ++kb) {
#pragma unroll
                for (int i = 0; i < 16; ++i) S[kb][i] = 0.f;
                if (win && kb == 1) continue;
                const LAS bf16* kp = Kt + ((win ? kc0 : kb * 32) + swap23(q)) * KP + 8 * g;
#pragma unroll
                for (int s2 = 0; s2 < NS; ++s2) { const bf16x8 a = *(const LAS bf16x8*)(kp + 16 * s2); S[kb] = __builtin_amdgcn_mfma_f32_32x32x16_bf16(a, Qf[s2], S[kb], 0, 0, 0); }
            }
            float mx = -INFINITY;
            if (win) { const LAS float* tb = T + (rowok ? dr : 15) * 128 + (kc0 + 8 * g - qc + 64);
#pragma unroll
                for (int i = 0; i < 16; ++i) { const float sv = (S[0][i] * A.scale + tb[16 * (i >> 3) + (i & 7)]) + mcol[i]; S[0][i] = sv; mx = fmaxf(mx, sv); }
            } else {
#pragma unroll
                for (int kb = 0; kb < 2; ++kb)
#pragma unroll
                    for (int i = 0; i < 16; ++i) { const float sv = S[kb][i] * A.scale; S[kb][i] = sv; mx = fmaxf(mx, sv); }
            }
            if (__any(mx > mrun + MLA_TH)) { const float mf = fmaxf(mx, __shfl_xor(mx, 32)), mn = fmaxf(mrun, mf), alpha = __builtin_amdgcn_exp2f(mrun - mn);
                mrun = mn; lrun *= alpha;
#pragma unroll
                for (int db = 0; db < 2; ++db)
#pragma unroll
                    for (int i = 0; i < 16; ++i) O[db][i] *= alpha; }
            bf16x8 Pf[4];
#pragma unroll
            for (int ks = 0; ks < 4; ++ks) { if (win && ks >= 2) continue; const int kb = ks >> 1, o8 = (ks & 1) * 8; float p[8];
#pragma unroll
                for (int j = 0; j < 8; ++j) { p[j] = __builtin_amdgcn_exp2f(S[kb][o8 + j] - mrun); lrun += p[j]; }
                Pf[ks] = pack8(p[0], p[1], p[2], p[3], p[4], p[5], p[6], p[7]); }
#pragma unroll
            for (int db = 0; db < 2; ++db) { const LAS bf16* vp = Vt + (db * 32 + q) * VP + (win ? kc0 : 0) + 8 * g;
#pragma unroll
                for (int ks = 0; ks < 4; ++ks) { if (win && ks >= 2) continue; const bf16x8 a = *(const LAS bf16x8*)(vp + 16 * ks); O[db] = __builtin_amdgcn_mfma_f32_32x32x16_bf16(a, Pf[ks], O[db], 0, 0, 0); } }
        }
        asm volatile("s_waitcnt vmcnt(6)\n\ts_waitcnt lgkmcnt(0)\n\ts_barrier" ::: "memory");
    }
    asm volatile("s_waitcnt vmcnt(0)" ::: "memory");
    const float ltot = lrun + __shfl_xor(lrun, 32), inv = 1.f / ltot;
    GAS bf16* op = A.o + (size_t)qi * A.opitch + 4 * g;
#pragma unroll
    for (int db = 0; db < 2; ++db)
#pragma unroll
        for (int i4 = 0; i4 < 4; ++i4) { v2u w; w.x = pk2(O[db][4 * i4] * inv, O[db][4 * i4 + 1] * inv); w.y = pk2(O[db][4 * i4 + 2] * inv, O[db][4 * i4 + 3] * inv); *(GAS v2u*)(op + 32 * db + 8 * i4) = w; }
}

struct TagF { static constexpr bool value = false; }; struct TagT { static constexpr bool value = true; };
#define SGB(mask, n) __builtin_amdgcn_sched_group_barrier(mask, n, 0)
DI void mla_unit(LAS unsigned char* lds, const AttnDesc& A, int tid, int lane, int wave) {
    constexpr int KP = 104, VP = 72, NS = 6, KBUF = 64 * KP * 2, VBUF = 64 * VP * 2;
    const int q = lane & 31, g = lane >> 5, NT = A.ntiles;
    bf16x8 Qf[NS];
    { const GAS bf16* qp = A.q + (size_t)(wave * 32 + q) * A.qpitch + 8 * g;
#pragma unroll
        for (int s2 = 0; s2 < NS; ++s2) Qf[s2] = *(const GAS bf16x8*)(qp + 16 * s2); }
    f32x16 O[2], Cm;
#pragma unroll
    for (int i = 0; i < 16; ++i) { O[0][i] = 0.f; O[1][i] = 0.f; Cm[i] = 0.f; }
    float lrun = 0.f;
    auto koffs = [&](int i) { const int j = i * 64 + lane, row = j / 13, pc = min(j % 13, 11); return (unsigned)(row * 192 + pc * 16); };
    auto voffs = [&](int i) { const int j = i * 64 + lane, row = j / 9, pc = min(j % 9, 7); return (unsigned)(row * (NKEY * 2) + pc * 16); };
    const int i2 = min(wave + 3, 8);
    const unsigned goff0 = koffs(wave), goff1 = wave < 5 ? koffs(wave + 8) : voffs(wave - 5), goff2 = voffs(i2);
    auto dma = [&](int tk, int ks, int tv, int vs) __attribute__((always_inline)) {
        const GAS unsigned char* kb = (const GAS unsigned char*)A.k + (size_t)tk * (64 * 96 * 2); const GAS unsigned char* vb = (const GAS unsigned char*)A.vt + (size_t)tv * 128;
        LAS unsigned char* kl = lds + ks * KBUF; LAS unsigned char* vl = lds + 2 * KBUF + vs * VBUF;
        __builtin_amdgcn_global_load_lds((const GAS unsigned*)(kb + goff0), (LAS unsigned*)(kl + wave * 1024), 16, 0, 0);
        __builtin_amdgcn_global_load_lds((const GAS unsigned*)((wave < 5 ? kb : vb) + goff1), (LAS unsigned*)(wave < 5 ? kl + (wave + 8) * 1024 : vl + (wave - 5) * 1024), 16, 0, 0);
        __builtin_amdgcn_global_load_lds((const GAS unsigned*)(vb + goff2), (LAS unsigned*)(vl + i2 * 1024), 16, 0, 0);
    };
    auto qk = [&](f32x16& S0, f32x16& S1, int buf) __attribute__((always_inline)) {
        const LAS bf16* kp = (const LAS bf16*)(lds + buf * KBUF) + swap23(q) * KP + 8 * g;
        S0 = __builtin_amdgcn_mfma_f32_32x32x16_bf16(*(const LAS bf16x8*)kp, Qf[0], Cm, 0, 0, 0);
#pragma unroll
        for (int s2 = 1; s2 < NS; ++s2) S0 = __builtin_amdgcn_mfma_f32_32x32x16_bf16(*(const LAS bf16x8*)(kp + 16 * s2), Qf[s2], S0, 0, 0, 0);
        S1 = __builtin_amdgcn_mfma_f32_32x32x16_bf16(*(const LAS bf16x8*)(kp + 32 * KP), Qf[0], Cm, 0, 0, 0);
#pragma unroll
        for (int s2 = 1; s2 < NS; ++s2) S1 = __builtin_amdgcn_mfma_f32_32x32x16_bf16(*(const LAS bf16x8*)(kp + 32 * KP + 16 * s2), Qf[s2], S1, 0, 0, 0);
    };
    auto smax = [&](const f32x16& S0, const f32x16& S1) __attribute__((always_inline)) { float mx = fmaxf(S0[0], S0[1]);
#pragma unroll
        for (int i = 2; i < 16; ++i) mx = fmaxf(mx, S0[i]);
#pragma unroll
        for (int i = 0; i < 16; ++i) mx = fmaxf(mx, S1[i]);
        return mx; };
    auto rebase = [&](f32x16& S0, f32x16& S1, float mx) __attribute__((always_inline)) {
        const float mf = fmaxf(mx, __shfl_xor(mx, 32)), d = fmaxf(mf, 0.f), alpha = __builtin_amdgcn_exp2f(-d);
        lrun *= alpha;
#pragma unroll
        for (int i = 0; i < 16; ++i) { O[0][i] *= alpha; O[1][i] *= alpha; S0[i] -= d; S1[i] -= d; Cm[i] -= d; }
        asm volatile("" : "+v"(Cm));
    };
    auto softmax_p = [&](const f32x16& S0, const f32x16& S1, bf16x8 (&Pf)[4]) __attribute__((always_inline)) {
#pragma unroll
        for (int ks = 0; ks < 4; ++ks) { const int o8 = (ks & 1) * 8; float p[8];
#pragma unroll
            for (int j = 0; j < 8; ++j) { p[j] = __builtin_amdgcn_exp2f(ks < 2 ? S0[o8 + j] : S1[o8 + j]); lrun += p[j]; }
            Pf[ks] = pack8(p[0], p[1], p[2], p[3], p[4], p[5], p[6], p[7]); }
    };
    auto pv = [&](const bf16x8 (&Pf)[4], int buf) __attribute__((always_inline)) {
        const LAS bf16* vp = (const LAS bf16*)(lds + 2 * KBUF + buf * VBUF) + q * VP + 8 * g;
#pragma unroll
        for (int ks = 0; ks < 4; ++ks)
#pragma unroll
            for (int db = 0; db < 2; ++db) O[db] = __builtin_amdgcn_mfma_f32_32x32x16_bf16(*(const LAS bf16x8*)(vp + db * 32 * VP + 16 * ks), Pf[ks], O[db], 0, 0, 0);
    };
    f32x16 Sa[2], Sb[2];
    __syncthreads();
    dma(0, 0, 0, 0); dma(1, 1, 0, 0);
    asm volatile("s_waitcnt vmcnt(0)" ::: "memory");
    __syncthreads();
    qk(Sa[0], Sa[1], 0);
    { const float mx = smax(Sa[0], Sa[1]); const float mf = fmaxf(mx, __shfl_xor(mx, 32));
#pragma unroll
        for (int i = 0; i < 16; ++i) { Sa[0][i] -= mf; Sa[1][i] -= mf; Cm[i] = -mf; }
        asm volatile("" : "+v"(Cm)); }
    __syncthreads();
    auto step = [&](f32x16 (&Sc)[2], f32x16 (&Sn)[2], const int t, auto par) __attribute__((always_inline)) {
        constexpr int PAR = decltype(par)::value ? 1 : 0;
        dma(min(t + 2, NT - 1), PAR, min(t + 1, NT - 1), PAR ^ 1);
        __builtin_amdgcn_sched_barrier(0);
        bf16x8 Pf[4];
        qk(Sn[0], Sn[1], PAR ^ 1);
        softmax_p(Sc[0], Sc[1], Pf);
        pv(Pf, PAR);
        const float mx = smax(Sn[0], Sn[1]);
        SGB(0x100, 3);
#pragma unroll
        for (int m = 0; m < 16; ++m) { SGB(0x008, 1); SGB(0x100, 1); SGB(0x400, 2); SGB(0x002, 3); }
#pragma unroll
        for (int m = 0; m < 4; ++m) { SGB(0x008, 1); SGB(0x100, 1); SGB(0x002, 5); }
        if (__any(mx > MLA_TH)) rebase(Sn[0], Sn[1], mx);
        asm volatile("s_waitcnt vmcnt(0)" ::: "memory");
        __syncthreads();
    };
#pragma unroll 1
    for (int t = 0; t < NT - 2; t += 2) { step(Sa, Sb, t, TagF{}); step(Sb, Sa, t + 1, TagT{}); }
    step(Sa, Sb, NT - 2, TagF{});
    { bf16x8 Pf[4]; softmax_p(Sb[0], Sb[1], Pf); pv(Pf, (NT - 1) & 1); }
    const float ltot = lrun + __shfl_xor(lrun, 32), inv = 1.f / ltot;
    GAS bf16* op = A.o + (size_t)(wave * 32 + q) * A.opitch + 4 * g;
#pragma unroll
    for (int db = 0; db < 2; ++db)
#pragma unroll
        for (int i4 = 0; i4 < 4; ++i4) { v2u w; w.x = pk2(O[db][4 * i4] * inv, O[db][4 * i4 + 1] * inv); w.y = pk2(O[db][4 * i4 + 2] * inv, O[db][4 * i4 + 3] * inv); *(GAS v2u*)(op + 32 * db + 8 * i4) = w; }
}

DI int moe_tables(const GAS unsigned* cnt  , LAS int* off, LAS int* tile_e, int tid) {
    if (tid == 0) { int o = 0; for (int e = 0; e < 32; ++e) { off[e] = o; o += ((int)cnt[e * 64] + 255) & ~255; } off[32] = o; }
    __syncthreads();
    if (tid < MOE_MAXT) { const int r = tid * 256; int ex = 0; for (int e = 0; e < 32; ++e) if (r >= off[e + 1]) ex = e + 1; tile_e[tid] = ex < 32 ? ex : 31; }
    __syncthreads();
    return off[32] >> 8;
}

#define TIDS const int tid = threadIdx.x, lane = tid & 63, wave = __builtin_amdgcn_readfirstlane(tid >> 6), bid = blockIdx.x, G = gridDim.x, gw = bid * 8 + wave, NGW = G * 8; (void)lane; (void)gw; (void)NGW
DI void ph_gemm_in(const Ctx& cx, int l) {
    TIDS; GAS unsigned char* ws = cx.ws(); LAS unsigned char* lds = (LAS unsigned char*)lds_raw;
    pg8::Gemm g{(const GAS bf16*)(ws + WS_H), (const GAS bf16*)(ws + WS_WTIN + (size_t)l * WTIN_L), MTOK, PP, D}; pg8::StaticOrder S; S.init(MTOK, PP, G, bid);
    pg8::EpiStoreBf16 E{(GAS bf16*)(ws + WS_P), PP};
    pg8::gemm_phase(lds, g, S, E);
    if (l == 0) { const int ntile = (MTOK / 256) * (PP / 256), nlast = ntile % G;
        if (nlast > 0 && bid >= nlast) { __syncthreads(); weight_copies(cx, 0, lds, tid, lane, wave, (bid - nlast) * 8 + wave, (G - nlast) * 8, (bid - nlast) * 512 + tid, (G - nlast) * 512, 2); }
        else if (nlast == 0) { __syncthreads(); weight_copies(cx, 0, lds, tid, lane, wave, bid * 8 + wave, G * 8, bid * 512 + tid, G * 512, 2); } }
}
DI void ph_prep_r1(const Ctx& cx, int l) {
    TIDS; LAS unsigned char* lds = (LAS unsigned char*)lds_raw;
#pragma unroll 1
    for (int u = bid; u < MTOK / PR; u += G) prep_unit(cx, l, u, lds, tid, lane, wave);
    __syncthreads();
    rec_r1_run<0>(cx, l, lds, tid, bid, G); rec_r1_run<1>(cx, l, lds, tid, bid, G);
    __syncthreads();
}
DI void ph_mixers(const Ctx& cx, int l) {
    TIDS; GAS unsigned char* ws = cx.ws(); LAS unsigned char* lds = (LAS unsigned char*)lds_raw;
    const bool keep_ctx = (l == 0);
    GAS bf16* CAT = (GAS bf16*)(ws + WS_CAT); const GAS bf16* P = (const GAS bf16*)(ws + WS_P);
    const int nATT = 256 + (keep_ctx ? 16 : 0), nR = 16 * NCHUNK;
    const int vc = (G % 8 == 0) ? (bid % 8) * (G / 8) + bid / 8 : bid;
    const bool r3first = ((bid >> 3) & 1) != 0;
    if (r3first) { rec_r3_run<0>(cx, l, lds, tid, bid, G, keep_ctx); rec_r3_run<1>(cx, l, lds, tid, bid, G, keep_ctx); __syncthreads(); }
#pragma unroll 1
    for (int it = 0; it < 2; ++it) { const int u = it == 0 ? vc : (G == 256 && bid >= 128 && bid < 144 ? 256 + bid - 128 : (G == 256 ? nATT : bid + G)); if (u >= nATT) continue;
        const GAS bf16* QM = (const GAS bf16*)(ws + WS_QM); const GAS bf16* KM = (const GAS bf16*)(ws + WS_KM); const GAS bf16* VM = (const GAS bf16*)(ws + WS_VM);
        AttnDesc A{}; int bh, b, h;
        if (u < 256) { bh = u >> 4; b = bh >> 2; h = bh & 3; const int qb = u & 15; A.q = QM + ((size_t)bh * NKEY + 256 + qb * 256) * 96; A.ntiles = NKEY / 64; A.o = CAT + (size_t)(NCTX + b * SEQ + qb * 256) * D + 768 + h * 64; }
        else { bh = u - 256; b = bh >> 2; h = bh & 3; A.q = QM + (size_t)bh * NKEY * 96; A.ntiles = 4; A.o = CAT + (size_t)(b * 256) * D + 768 + h * 64; }
        A.qpitch = 96; A.k = KM + (size_t)bh * NKEY * 96; A.kpitch = 96; A.vt = VM + (size_t)bh * 64 * NKEY; A.opitch = D; A.scale = 1.f;
        mla_unit(lds, A, tid, lane, wave);
    }
#pragma unroll 1
    for (int it = 0; it < 2; ++it) { const int u = it == 0 ? vc : (G == 256 && bid >= 160 && bid < 176 ? 256 + bid - 160 : (G == 256 ? nATT : bid + G)); if (u >= nATT) continue;
        LAS float* rpb = (LAS float*)(lds + NA_RPB);
        AttnDesc A{}; int bh, b, h; size_t qrow;
        if (u < 256) { bh = u >> 4; b = bh >> 2; h = bh & 3; const int rq = u & 15; A.r0 = rq * 4; A.rs0 = min(max(A.r0 - 4, 0), 56); const int rsl = min(max(A.r0 + 3 - 4, 0), 56);
            A.ntiles = 4 + (rsl + 8 - A.rs0); qrow = (size_t)NCTX + b * SEQ + A.r0 * 64; }
        else { bh = u - 256; b = bh >> 2; h = bh & 3; A.ntiles = 4; qrow = (size_t)b * 256; }
        const GAS float* rp = cx.in(I_RPB) + (size_t)(l * 4 + h) * 465;
        A.q = P + qrow * PP + CB_Q + h * 64; A.qpitch = PP; A.k = P + CB_K + h * 64; A.kpitch = PP; A.vt = (const GAS bf16*)(ws + WS_VNT) + (size_t)bh * 64 * NKEY;
        A.o = CAT + qrow * D + 256 + h * 64; A.opitch = D; A.scale = 0.125f * LOG2E; A.b = b; A.rpb = rpb;
        na_unit(lds, A, rp, tid, lane, wave);
    }
    __syncthreads();
    if (!r3first) { rec_r3_run<0>(cx, l, lds, tid, bid, G, keep_ctx); rec_r3_run<1>(cx, l, lds, tid, bid, G, keep_ctx); }
}
DI void ph_gemm_out(const Ctx& cx, int l) {
    TIDS; GAS unsigned char* ws = cx.ws(); LAS unsigned char* lds = (LAS unsigned char*)lds_raw;
    const int roff = (l == 0) ? 0 : NCTX, Mg = MTOK - roff;
    pg8::Gemm g{(const GAS bf16*)(ws + WS_CAT) + (size_t)roff * D, (const GAS bf16*)(ws + WS_WTOUT + (size_t)l * D * D * 2), Mg, D, D}; pg8::StaticOrder S; S.init(Mg, D, G, bid);
    pg8::EpiResid E{(GAS pg8::bf16_t*)(ws + WS_X), roff, (const GAS float*)(ws + WS_MOD) + (size_t)l * 5 * 6144 + 2 * 1024, l == 0 ? cx.in(I_CTX) : (const GAS float*)nullptr, l == 0 ? cx.in(I_X) : (const GAS float*)nullptr};
    pg8::gemm_phase(lds, g, S, E);
    if (l == 0) { const int nbusy = (Mg / 256) * (D / 256) - G;
        if (nbusy >= 0 && nbusy < G && bid >= nbusy) { __syncthreads(); weight_copies(cx, 1, lds, tid, lane, wave, (bid - nbusy) * 8 + wave, (G - nbusy) * 8, (bid - nbusy) * 512 + tid, (G - nbusy) * 512); } }
}
DI void ph_router(const Ctx& cx, int l) {
    TIDS; GAS unsigned char* ws = cx.ws(); LAS unsigned char* lds = (LAS unsigned char*)lds_raw;
    const int m_lo = (l == 0) ? 0 : NCTX;
    const GAS bf16* X = (const GAS bf16*)(ws + WS_X); GAS bf16* H = (GAS bf16*)(ws + WS_H); const GAS float* MOD = (const GAS float*)(ws + WS_MOD) + (size_t)l * 5 * 6144;
    GAS int* EID = (GAS int*)(ws + WS_MOE); GAS float* GATE = (GAS float*)(ws + WS_MOE) + MTOK * 2; GAS int* POS = (GAS int*)(ws + WS_MOE) + MTOK * 4;
    GAS unsigned* cnt = (GAS unsigned*)(ws + WS_CTL) + CW_CNT + l * 32 * 64; GAS int* RIDX = (GAS int*)(ws + WS_RIDX);
    const GAS bf16* WRh = (const GAS bf16*)(ws + WS_WR) + (size_t)l * 2 * 48 * 1024; const GAS bf16* WRl = WRh + 48 * 1024;
    const GAS float* n2g = cx.in(I_N2G) + l * D; const GAS float* brg = cx.in(I_BRG) + l * 4; const GAS float* bre = cx.in(I_BRE) + l * 32;
    constexpr int AP = 136;
    LAS bf16* Ah = (LAS bf16*)(lds + wave * 12288); LAS bf16* Al = Ah + 16 * AP; LAS float* LG = (LAS float*)(lds + wave * 12288 + 2 * 16 * AP * 2); LAS float* RSD = LG + 16 * 48;
    const int nunits = (MTOK - m_lo) / 16;
#pragma unroll 1
    for (int unit = wave * G + bid; unit < nunits; unit += NGW) {
        const int m0 = m_lo + unit * 16; const GAS float* mb = MOD + (size_t)bidx_of_row(m0) * 6144;
        const int p16 = lane & 15, rg = lane >> 4;
        float rsr[4];
        { float ss[4] = {0.f, 0.f, 0.f, 0.f};
#pragma unroll 2
            for (int kc = 0; kc < 8; ++kc) { v4u xp[4];
#pragma unroll
                for (int i = 0; i < 4; ++i) xp[i] = *(const GAS v4u*)(X + (size_t)(m0 + 4 * rg + i) * D + kc * 128 + 8 * p16);
#pragma unroll
                for (int i = 0; i < 4; ++i) { float x[8]; unpack8(xp[i], x);
#pragma unroll
                    for (int e = 0; e < 8; ++e) ss[i] += x[e] * x[e]; } }
#pragma unroll
            for (int i = 0; i < 4; ++i) { float t = ss[i]; t += __shfl_xor(t, 1); t += __shfl_xor(t, 2); t += __shfl_xor(t, 4); t += __shfl_xor(t, 8); rsr[i] = rsqrtf(t * (1.f / D) + EPS); } }
        f32x4 acc[3];
#pragma unroll
        for (int ct = 0; ct < 3; ++ct) acc[ct] = (f32x4){0.f, 0.f, 0.f, 0.f};
#pragma unroll 1
        for (int kc = 0; kc < 8; ++kc) { const int c = kc * 128 + 8 * p16;
            const int fr = lane & 15, fq = lane >> 4;
            bf16x8 bh[4][3], bl[4][3];
#pragma unroll
            for (int ks = 0; ks < 4; ++ks)
#pragma unroll
                for (int ct = 0; ct < 3; ++ct) { const size_t bo = (size_t)(ct * 16 + fr) * 1024 + kc * 128 + ks * 32 + fq * 8; bh[ks][ct] = *(const GAS bf16x8*)(WRh + bo); bl[ks][ct] = *(const GAS bf16x8*)(WRl + bo); }
            v4u xp[4];
#pragma unroll
            for (int i = 0; i < 4; ++i) xp[i] = *(const GAS v4u*)(X + (size_t)(m0 + 4 * rg + i) * D + c);
            float gg[8], sh[8], sc[8];
            { const f32x4 a0 = *(const GAS f32x4*)(n2g + c), a1 = *(const GAS f32x4*)(n2g + c + 4), b0 = *(const GAS f32x4*)(mb + 3 * 1024 + c), b1 = *(const GAS f32x4*)(mb + 3 * 1024 + c + 4),
                  c0 = *(const GAS f32x4*)(mb + 4 * 1024 + c), c1 = *(const GAS f32x4*)(mb + 4 * 1024 + c + 4);
                gg[0] = a0.x; gg[1] = a0.y; gg[2] = a0.z; gg[3] = a0.w; gg[4] = a1.x; gg[5] = a1.y; gg[6] = a1.z; gg[7] = a1.w;
                sh[0] = b0.x; sh[1] = b0.y; sh[2] = b0.z; sh[3] = b0.w; sh[4] = b1.x; sh[5] = b1.y; sh[6] = b1.z; sh[7] = b1.w;
                sc[0] = c0.x; sc[1] = c0.y; sc[2] = c0.z; sc[3] = c0.w; sc[4] = c1.x; sc[5] = c1.y; sc[6] = c1.z; sc[7] = c1.w; }
            LDS_WAIT();
#pragma unroll
            for (int i = 0; i < 4; ++i) { const int r = 4 * rg + i; float x[8], y[8]; unpack8(xp[i], x);
#pragma unroll
                for (int e = 0; e < 8; ++e) y[e] = x[e] * rsr[i] * gg[e] * (1.f + sc[e]) + sh[e];
                const v4u hi = (v4u){pk2(y[0], y[1]), pk2(y[2], y[3]), pk2(y[4], y[5]), pk2(y[6], y[7])};
                float hf[8]; unpack8(hi, hf);
                const v4u lo = (v4u){pk2(y[0] - hf[0], y[1] - hf[1]), pk2(y[2] - hf[2], y[3] - hf[3]), pk2(y[4] - hf[4], y[5] - hf[5]), pk2(y[6] - hf[6], y[7] - hf[7])};
                *(GAS v4u*)(H + (size_t)(m0 + r) * D + c) = hi;
                *(LAS v4u*)(Ah + r * AP + 8 * p16) = hi; *(LAS v4u*)(Al + r * AP + 8 * p16) = lo; }
            LDS_WAIT();
            asm volatile("s_waitcnt vmcnt(0)" : "+v"(bh[0][0]), "+v"(bh[0][1]), "+v"(bh[0][2]), "+v"(bl[0][0]), "+v"(bl[0][1]), "+v"(bl[0][2]), "+v"(bh[1][0]), "+v"(bh[1][1]), "+v"(bh[1][2]), "+v"(bl[1][0]), "+v"(bl[1][1]), "+v"(bl[1][2]),
                         "+v"(bh[2][0]), "+v"(bh[2][1]), "+v"(bh[2][2]), "+v"(bl[2][0]), "+v"(bl[2][1]), "+v"(bl[2][2]), "+v"(bh[3][0]), "+v"(bh[3][1]), "+v"(bh[3][2]), "+v"(bl[3][0]), "+v"(bl[3][1]), "+v"(bl[3][2]) :: "memory");
#pragma unroll
            for (int ks = 0; ks < 4; ++ks) { const bf16x8 ah = *(const LAS bf16x8*)(Ah + fr * AP + ks * 32 + fq * 8), al = *(const LAS bf16x8*)(Al + fr * AP + ks * 32 + fq * 8);
#pragma unroll
                for (int ct = 0; ct < 3; ++ct) {
                    acc[ct] = __builtin_amdgcn_mfma_f32_16x16x32_bf16(ah, bh[ks][ct], acc[ct], 0, 0, 0);
                    acc[ct] = __builtin_amdgcn_mfma_f32_16x16x32_bf16(ah, bl[ks][ct], acc[ct], 0, 0, 0);
                    acc[ct] = __builtin_amdgcn_mfma_f32_16x16x32_bf16(al, bh[ks][ct], acc[ct], 0, 0, 0); } }
        }
#pragma unroll
        for (int ct = 0; ct < 3; ++ct)
#pragma unroll
            for (int j = 0; j < 4; ++j) LG[(4 * (lane >> 4) + j) * 48 + ct * 16 + (lane & 15)] = acc[ct][j];
        LDS_WAIT(); asm volatile("" ::: "memory");
        if (lane < 16) { const LAS float* lg = LG + lane * 48; const int m = m0 + lane;
            float gl[4]; int gsel = 0;
#pragma unroll
            for (int i = 0; i < 4; ++i) gl[i] = lg[i] + brg[i];
            float gmax = gl[0];
#pragma unroll
            for (int i = 1; i < 4; ++i) if (gl[i] > gmax) { gmax = gl[i]; gsel = i; }
            float den = 0.f;
#pragma unroll
            for (int i = 0; i < 4; ++i) den += __expf(gl[i] - gmax);
            const float pg = 1.f / den;
            float e1 = -INFINITY, e2 = -INFINITY; int i1 = 0, i2 = 0;
#pragma unroll 1
            for (int i = 0; i < 8; ++i) { const float ev = lg[4 + gsel * 8 + i] + bre[gsel * 8 + i];
                if (ev > e1) { e2 = e1; i2 = i1; e1 = ev; i1 = i; } else if (ev > e2) { e2 = ev; i2 = i; } }
            const float x2 = __expf(e2 - e1), w1 = pg / (1.f + x2), w2 = pg * x2 / (1.f + x2);
            const int ex1 = gsel * 8 + i1, ex2 = gsel * 8 + i2;
            const int p1 = (int)__hip_atomic_fetch_add(cnt + ex1 * 64, 1u, __ATOMIC_RELAXED, __HIP_MEMORY_SCOPE_AGENT), p2 = (int)__hip_atomic_fetch_add(cnt + ex2 * 64, 1u, __ATOMIC_RELAXED, __HIP_MEMORY_SCOPE_AGENT);
            EID[m * 2] = ex1; EID[m * 2 + 1] = ex2; GATE[m * 2] = w1; GATE[m * 2 + 1] = w2; POS[m * 2] = p1; POS[m * 2 + 1] = p2;
            RIDX[(size_t)ex1 * MOE_CAP + p1] = m; RIDX[(size_t)ex2 * MOE_CAP + p2] = m; }
        LDS_WAIT(); asm volatile("" ::: "memory");
    }
}
DI void ph_gemm_gu(const Ctx& cx, int l) {
    TIDS; GAS unsigned char* ws = cx.ws(); LAS unsigned char* lds = (LAS unsigned char*)lds_raw;
    LAS int* moe_off = (LAS int*)(lds + MISC_OFF + 64 * 4); LAS int* moe_te = (LAS int*)(lds + MISC_OFF + 128 * 4);
    const int nT = moe_tables((const GAS unsigned*)(ws + WS_CTL) + CW_CNT + l * 32 * 64, moe_off, moe_te, tid);
    pg8::Gemm g{(const GAS bf16*)(ws + WS_H), (const GAS bf16*)(ws + WS_WTGU + (size_t)l * 32 * 512 * D * 2), nT * 256, 512, D};
    const int vc = (G % 8 == 0) ? (bid % 8) * (G / 8) + bid / 8 : bid;
    pg8::GroupedPublish S{{nT, 2, G, vc, moe_te, (size_t)512 * D * 2}, (GAS unsigned*)(ws + WS_CTL) + CW_GUC + l * MOE_MAXT * 64};
    pg8::EpiGateUp E{(GAS bf16*)(ws + WS_ACT), (unsigned)(MOE_MAXT * 256 * 256 * 2)};
    LAS int* ridx_l = (LAS int*)(lds + MISC_OFF + 4096);
    { const GAS unsigned* cntp = (const GAS unsigned*)(ws + WS_CTL) + CW_CNT + l * 32 * 64; const GAS int* RIDX = (const GAS int*)(ws + WS_RIDX);
        const int vcl = (G % 8 == 0) ? (bid % 8) * (G / 8) + bid / 8 : bid; const int i = tid >> 8, r = tid & 255, L = vcl + i * G;
        if (L < nT * 2) { const int pm = L >> 1, e = moe_te[pm], slot = pm * 256 - moe_off[e] + r; ridx_l[i * 256 + r] = slot < (int)cntp[e * 64] ? RIDX[(size_t)e * MOE_CAP + slot] : 0; }
        __syncthreads(); }
    pg8::MoeRows RM{ridx_l, vc >> 1};
    pg8::gemm_phase(lds, g, S, E, RM);
}
DI void ph_gemm_dn(const Ctx& cx, int l) {
    TIDS; GAS unsigned char* ws = cx.ws(); LAS unsigned char* lds = (LAS unsigned char*)lds_raw;
    LAS int* moe_off = (LAS int*)(lds + MISC_OFF + 64 * 4); LAS int* moe_te = (LAS int*)(lds + MISC_OFF + 128 * 4);
    const int nT = moe_tables((const GAS unsigned*)(ws + WS_CTL) + CW_CNT + l * 32 * 64, moe_off, moe_te, tid);
    pg8::Gemm g{(const GAS bf16*)(ws + WS_ACT), (const GAS bf16*)(ws + WS_WTDN + (size_t)l * 32 * D * 256 * 2), nT * 256, D, 256};
    pg8::EpiStoreBf16 E{(GAS bf16*)(ws + WS_XS), D};
    const GAS unsigned* ready = (const GAS unsigned*)(ws + WS_CTL) + CW_GUC + l * MOE_MAXT * 64;
    const int vc = (G % 8 == 0) ? (bid % 8) * (G / 8) + bid / 8 : bid;
    const int nb2 = (nT * 2 > G && nT * 2 - G < G / 2) ? nT * 2 - G : 0, Gd = G - nb2, cd = vc - nb2;
    const int pmE = nb2 ? G / 2 : nT, nE = pmE * 4, nL = (nT - pmE) * 4;
    const int cl = cd < 0 ? -1 : (cd - nE % Gd + Gd) % Gd;
    pg8::GroupedOrder S1{pmE, 4, Gd, cd, moe_te, (size_t)D * 256 * 2, 0};
    pg8::GroupedOrder S2{nT - pmE, 4, Gd, cl, moe_te, (size_t)D * 256 * 2, pmE};
    { pg8::Unit u;
#pragma unroll 1
      for (int i = 0; S1.next(i, u); ++i) pg8::wait_rowtile(ready, u.pm, 16u); }
    pg8::gemm_phase(lds, g, S1, E);
    if (nL > 0) { pg8::Unit u;
#pragma unroll 1
      for (int i = 0; S2.next(i, u); ++i) pg8::wait_rowtile(ready, u.pm, 16u);
      pg8::gemm_phase(lds, g, S2, E); }
}
DI void ph_combine(const Ctx& cx, int l) {
    TIDS; GAS unsigned char* ws = cx.ws(); LAS unsigned char* lds = (LAS unsigned char*)lds_raw;
    LAS int* moe_off = (LAS int*)(lds + MISC_OFF + 64 * 4); LAS int* moe_te = (LAS int*)(lds + MISC_OFF + 128 * 4);
    const int m_lo = (l == 0) ? 0 : NCTX;
    moe_tables((const GAS unsigned*)(ws + WS_CTL) + CW_CNT + l * 32 * 64, moe_off, moe_te, tid);
    const GAS int* EID = (const GAS int*)(ws + WS_MOE); const GAS float* GATE = (const GAS float*)(ws + WS_MOE) + MTOK * 2; const GAS int* POS = (const GAS int*)(ws + WS_MOE) + MTOK * 4;
    const GAS bf16* YS = (const GAS bf16*)(ws + WS_XS); GAS bf16* X = (GAS bf16*)(ws + WS_X); GAS bf16* H = (GAS bf16*)(ws + WS_H);
    const GAS float* MODB = (const GAS float*)(ws + WS_MOD); const GAS float* MOD = MODB + (size_t)l * 5 * 6144;
    const GAS float* n1g1 = cx.in(I_N1G) + D; const GAS float* fng = cx.in(I_FNG); GAS float* outp = cx.out();
    const int R = (MTOK - m_lo + G - 1) / G, m_beg = m_lo + bid * R + wave, m_end = min(m_lo + (bid + 1) * R, MTOK);
    f32x4 g5r[4], fgr[4]; NormPar np; int cb = -1;
    if (l != 0) {
#pragma unroll
        for (int j = 0; j < 4; ++j) fgr[j] = *(const GAS f32x4*)(fng + 4 * lane + 256 * j); }
#pragma unroll 1
    for (int m = m_beg; m < m_end; m += 8) {
        const int d0 = moe_off[EID[m * 2]] + POS[m * 2], d1 = moe_off[EID[m * 2 + 1]] + POS[m * 2 + 1];
        const float w0 = GATE[m * 2], w1 = GATE[m * 2 + 1];
        { const int b = bidx_of_row(m);
            if (b != cb) { const GAS float* mb = MOD + (size_t)b * 6144;
#pragma unroll
                for (int j = 0; j < 4; ++j) g5r[j] = *(const GAS f32x4*)(mb + 5 * 1024 + 4 * lane + 256 * j);
                if (l == 0) { const GAS float* mb1 = MODB + (size_t)(5 + b) * 6144; load_normpar(np, n1g1, mb1, mb1 + 1024, lane); }
                cb = b; } }
        f32x4 v[4];
#pragma unroll
        for (int j = 0; j < 4; ++j) { const int c = 4 * lane + 256 * j;
            const v2u a0 = *(const GAS v2u*)(YS + (size_t)d0 * D + c), a1 = *(const GAS v2u*)(YS + (size_t)d1 * D + c);
            f32x4 y; y.x = w0 * bf2f(a0.x & 0xffffu) + w1 * bf2f(a1.x & 0xffffu); y.y = w0 * bf2f(a0.x >> 16) + w1 * bf2f(a1.x >> 16);
            y.z = w0 * bf2f(a0.y & 0xffffu) + w1 * bf2f(a1.y & 0xffffu); y.w = w0 * bf2f(a0.y >> 16) + w1 * bf2f(a1.y >> 16);
            v[j] = bf4f(*(const GAS v2u*)(X + (size_t)m * D + c)) + g5r[j] * y; }
        if (l == 0) {
#pragma unroll
            for (int j = 0; j < 4; ++j) *(GAS v2u*)(X + (size_t)m * D + 4 * lane + 256 * j) = f4bf(v[j]);
            norm_row_store_c(v, np, H + (size_t)m * D, lane);
        } else {
            float ss = 0.f;
#pragma unroll
            for (int j = 0; j < 4; ++j) ss += (v[j].x * v[j].x + v[j].y * v[j].y) + (v[j].z * v[j].z + v[j].w * v[j].w);
            const float rstd = rsqrtf(wave_sum(ss) * (1.f / D) + EPS);
#pragma unroll
            for (int j = 0; j < 4; ++j) { const int c = 4 * lane + 256 * j;
                *(GAS f32x4*)(outp + (size_t)(m - NCTX) * D + c) = v[j] * rstd * fgr[j]; }
        }
    }
}

#ifndef PH_MASK
#define PH_MASK 0xFFF
#endif
#define PHON(j) (((PH_MASK) >> (j)) & 1)
__global__ void __launch_bounds__(512, 2) fwd_kernel(Args args) {
    LAS unsigned char* lds = (LAS unsigned char*)lds_raw;
    volatile LAS unsigned* MISC = (volatile LAS unsigned*)(lds + MISC_OFF);
    {
        const int tid = threadIdx.x;
        for (int u = tid; u < (LDS_BYTES - MISC_OFF) / 4; u += 512) MISC[u] = 0u;
        __syncthreads();
        if (tid == 0) { volatile LAS unsigned long long* t = (volatile LAS unsigned long long*)(lds + PTR_OFF);
#pragma unroll
            for (int i = 0; i < N_IN; ++i) t[i] = (unsigned long long)args.in[i];
            t[N_IN] = (unsigned long long)args.out; t[N_IN + 1] = (unsigned long long)args.ws; }
        __syncthreads();
    }
    const Ctx cx;
#if MK_ONE_LAUNCH
    XcdBarrier bar = xcd_barrier_post((unsigned*)(cx.ws() + WS_CTL) + CW_BAR, MISC + 8);
#define GRID_BAR() xcd_barrier(bar)
#else
#define GRID_BAR() do { } while (0)
#endif
    const int lo = args.ph_lo, hi = args.ph_hi;
#define IN(k) (lo <= (k) && (k) < hi)
#define BOTH(k) (IN(k) && IN((k) + 1))
    if (PHON(0) && IN(0)) { TIDS; phase_prologue(cx, lds, tid, lane, wave, bid, G); if (BOTH(0)) GRID_BAR(); }
    if (PHON(1) && IN(1)) { TIDS; phase_norm1_l0(cx, lane, gw, NGW); if (BOTH(1)) GRID_BAR(); }
#define LAYER(L) { constexpr int l = L; constexpr int pb = 2 + 10 * l; \
        if (PHON(2) && IN(pb + 0)) { ph_gemm_in(cx, l); if (BOTH(pb + 0)) GRID_BAR(); } \
        if (PHON(3) && IN(pb + 1)) { ph_prep_r1(cx, l); if (BOTH(pb + 1)) GRID_BAR(); } \
        if (PHON(4) && IN(pb + 2)) { rec_r2(cx, blockIdx.x * 512 + threadIdx.x, gridDim.x * 512); if (BOTH(pb + 2)) GRID_BAR(); } \
        if (PHON(5) && IN(pb + 3)) { ph_mixers(cx, l); if (BOTH(pb + 3)) GRID_BAR(); } \
        if (PHON(6) && IN(pb + 4)) { ph_gemm_out(cx, l); if (BOTH(pb + 4)) GRID_BAR(); } \
        if (PHON(7) && IN(pb + 5)) { ph_router(cx, l); if (BOTH(pb + 5)) GRID_BAR(); } \
        if (PHON(9) && IN(pb + 7)) { ph_gemm_gu(cx, l);   } \
        if (PHON(10) && IN(pb + 8)) { ph_gemm_dn(cx, l); if (BOTH(pb + 8)) GRID_BAR(); } \
        if (PHON(11) && IN(pb + 9)) { ph_combine(cx, l); if (BOTH(pb + 9)) GRID_BAR(); } }
    LAYER(0)
    LAYER(1)
#undef LAYER
#undef IN
#undef BOTH
}

constexpr int NPHASES = 22;
extern "C" void kernel_launch(void* const* d_in, const int* in_sizes, int n_in, void* d_out, int out_size, void* d_ws, size_t ws_size, hipStream_t stream) {
    static int grid = 0;
    if (grid == 0) {
        if (n_in != N_IN || out_size != NLAT * D || ws_size < WS_END) { fprintf(stderr, "kernel_launch: unexpected problem (n_in %d, out %d, ws %zu)\n", n_in, out_size, ws_size); grid = -1; return; }
        int dev = 0, cus = 0, per_cu = 0;
        if (hipGetDevice(&dev) != hipSuccess || hipDeviceGetAttribute(&cus, hipDeviceAttributeMultiprocessorCount, dev) != hipSuccess) { grid = -1; return; }
        if (hipFuncSetAttribute((const void*)fwd_kernel, hipFuncAttributeMaxDynamicSharedMemorySize, LDS_BYTES) != hipSuccess) { fprintf(stderr, "kernel_launch: hipFuncSetAttribute failed\n"); grid = -1; return; }
        if (hipOccupancyMaxActiveBlocksPerMultiprocessor(&per_cu, (const void*)fwd_kernel, 512, LDS_BYTES) != hipSuccess || per_cu < 1) fprintf(stderr, "kernel_launch: occupancy query reports %d\n", per_cu);
        (void)hipGetLastError();
        grid = cus;
    }
    if (grid < 0) return;
    (void)hipMemsetAsync((char*)d_ws + WS_CTL, 0, CTL_BYTES, stream);
    Args a{};
    for (int i = 0; i < N_IN; ++i) a.in[i] = (const float*)d_in[i];
    a.out = (float*)d_out; a.ws = (unsigned char*)d_ws;
#if MK_ONE_LAUNCH
    a.ph_lo = 0; a.ph_hi = NPHASES;
    hipLaunchKernelGGL(fwd_kernel, dim3(grid), dim3(512), LDS_BYTES, stream, a);
#else
    for (int p = 0; p < NPHASES; ++p) { a.ph_lo = p; a.ph_hi = p + 1; hipLaunchKernelGGL(fwd_kernel, dim3(grid), dim3(512), LDS_BYTES, stream, a); }
#endif
}
```

```cpp
#include <hip/hip_runtime.h>
#include <cstdio>
#include <cstdint>

#ifndef MK_ONE_LAUNCH
#define MK_ONE_LAUNCH 1
#endif

#define DI __device__ __forceinline__
#define GAS __attribute__((address_space(1)))
#define LAS __attribute__((address_space(3)))
typedef unsigned short bf16;
typedef unsigned v4u __attribute__((ext_vector_type(4)));
typedef unsigned v2u __attribute__((ext_vector_type(2)));
typedef float f32x4 __attribute__((ext_vector_type(4)));
typedef short bf16x8 __attribute__((ext_vector_type(8)));
#define LDS_WAIT() asm volatile("s_waitcnt lgkmcnt(0)" ::: "memory")

constexpr int D = 1024, NB = 4, SEQ = 4096, LCTX = 256, NCTX = NB * LCTX, NLAT = NB * SEQ, MTOK = NCTX + NLAT;
constexpr int DIN = 3200, PP = 3328;
constexpr int CA_Q = 0, CA_I = 256, CA_FF = 512, CA_FB = 768, CA_G = 1024;
constexpr int CB_Q = 1280, CB_K = 1536, CB_V = 1792;
constexpr int CC_Q = 2048, CC_K = 2176, CC_V = 2304, CC_G = 2560, CC_ZF = 2816, CC_ZB = 2832;
constexpr int CD_Q = 2848, CD_KV = 3040, CD_R = 3168;
constexpr int NKEY = LCTX + SEQ;
constexpr int NCHUNK = NKEY / 64;
constexpr float EPS = 1e-6f;
constexpr float LOG2E = 1.4426950408889634f;
constexpr int MOE_MAXT = 168;
constexpr int MOE_CAP = 2 * 17408;

enum { I_X = 0, I_C, I_CTX, I_CCTX, I_WMOD, I_BMOD, I_N1G, I_N2G, I_WIN, I_WOUT, I_LBL, I_HNG, I_RPB, I_WGF, I_BGF, I_WGB, I_BGB, I_GNG, I_QNG, I_WUQ, I_KVNG, I_WUKV,
       I_WRG, I_BRG, I_WRE, I_BRE, I_WGU, I_WDN, I_FNG, N_IN };

constexpr size_t MiB = 1u << 20;
constexpr size_t WS_CTL = 0, CTL_BYTES = 2 * MiB;
constexpr size_t WS_WTIN = 2 * MiB;
constexpr size_t WTIN_L = (size_t)PP * D * 2;
constexpr size_t WS_WTOUT = 16 * MiB;
constexpr size_t WS_WTUQ = 20 * MiB;
constexpr size_t WS_WTUKV = WS_WTUQ + 512 * 1024;
constexpr size_t WS_MOD = 21 * MiB;
constexpr size_t WS_WR = WS_MOD + 512 * 1024;
constexpr size_t WS_WTGU = 22 * MiB;
constexpr size_t WS_WTDN = 86 * MiB;
constexpr size_t WS_X = 118 * MiB;
constexpr size_t WS_H = 186 * MiB;
constexpr size_t WS_CAT = 220 * MiB;
constexpr size_t WS_P = 254 * MiB;
constexpr size_t WS_XS = WS_P;
constexpr size_t WS_ACT = 338 * MiB;
constexpr size_t WS_QM = 366 * MiB;
constexpr size_t WS_KM = 379 * MiB;
constexpr size_t WS_VM = 392 * MiB;
constexpr size_t WS_RSH = 401 * MiB;
constexpr size_t WS_RSG = 435 * MiB;
constexpr size_t WS_RAH = 452 * MiB;
constexpr size_t WS_RAG = WS_RAH + 600 * 1024;
constexpr size_t WS_MOE = 453 * MiB;
constexpr size_t WS_VNT = 454 * MiB;
constexpr size_t WS_RIDX = 463 * MiB;
constexpr size_t WS_END = 468 * MiB;
constexpr int CW_BAR = 4096;
constexpr int CW_CNT = 16384;
constexpr int CW_GUC = 32768;
constexpr int CW_TMO = 64;

constexpr int RING_BYTES = 131072;
constexpr int MISC_OFF = RING_BYTES;
constexpr int LDS_BYTES = 147456;

DI float bf2f(unsigned v) { return __uint_as_float(v << 16); }
DI unsigned f2bf(float f) { unsigned u = __float_as_uint(f); return (u + 0x7fffu + ((u >> 16) & 1u)) >> 16; }
typedef __bf16 bf16v2 __attribute__((ext_vector_type(2)));
typedef float f32x2 __attribute__((ext_vector_type(2)));
DI unsigned pk2(float lo, float hi) { const f32x2 v = {lo, hi}; return __builtin_bit_cast(unsigned, __builtin_convertvector(v, bf16v2)); }
DI f32x4 bf4f(v2u w) { f32x4 r; r.x = __uint_as_float(w.x << 16); r.y = __uint_as_float(w.x & 0xffff0000u); r.z = __uint_as_float(w.y << 16); r.w = __uint_as_float(w.y & 0xffff0000u); return r; }
DI v2u f4bf(f32x4 v) { return (v2u){pk2(v.x, v.y), pk2(v.z, v.w)}; }
DI bf16x8 pack8(float a0, float a1, float a2, float a3, float a4, float a5, float a6, float a7) {
    v4u p; p.x = pk2(a0, a1); p.y = pk2(a2, a3); p.z = pk2(a4, a5); p.w = pk2(a6, a7);
    return __builtin_bit_cast(bf16x8, p);
}
DI float wave_sum(float v) {
#pragma unroll
    for (int o = 1; o < 64; o <<= 1) v += __shfl_xor(v, o);
    return v;
}
DI float frcp_(float x) { return __builtin_amdgcn_rcpf(x); }
DI float sigmoid_(float x) { return frcp_(1.f + __expf(-x)); }
DI float silu_(float x) { return x * frcp_(1.f + __expf(-x)); }
DI float logsigmoid_(float x) { return fminf(x, 0.f) - __logf(1.f + __expf(-fabsf(x))); }
DI void unpack8(v4u w, float* f) {
    f[0] = __uint_as_float(w.x << 16); f[1] = __uint_as_float(w.x & 0xffff0000u);
    f[2] = __uint_as_float(w.y << 16); f[3] = __uint_as_float(w.y & 0xffff0000u);
    f[4] = __uint_as_float(w.z << 16); f[5] = __uint_as_float(w.z & 0xffff0000u);
    f[6] = __uint_as_float(w.w << 16); f[7] = __uint_as_float(w.w & 0xffff0000u);
}
DI int bidx_of_row(int m) { return m < NCTX ? 4 : ((m - NCTX) >> 12); }

namespace pg8 {
#define PG8_LAS __attribute__((address_space(3)))
typedef unsigned short bf16_t;
typedef unsigned u32x4 __attribute__((ext_vector_type(4)));
constexpr int BM = 256, BK = 64, HALF = 128, HTB = HALF * BK * 2, STAGE_BYTES = 8 * HTB, NXCD = 8, WGM = 8;
__host__ __device__ __forceinline__ int lds_byte(int r, int c) { const int st = (r >> 4) * 2 + (c >> 5), rr = r & 15, cc = c & 31, ob = rr * 64 + cc * 2; return st * 1024 + (ob ^ (((ob >> 9) & 1) << 5)); }
__host__ __device__ __forceinline__ void stage_rc(int b, int& R, int& C) { const int st = b / 1024, sb = b % 1024, swz = sb ^ (((sb >> 9) & 1) << 5); R = (st >> 1) * 16 + swz / 64; C = (st & 1) * 32 + (swz % 64) / 2; }
__host__ __device__ __forceinline__ int perm32(int rho) { const int n = rho >> 4, i = rho & 15; return 8 * (i >> 2) + 4 * n + (i & 3); }
struct Unit { int pm, pn; size_t bo; };
struct LinearRows { static constexpr bool LINEAR = true; __device__ __forceinline__ int operator()(const Unit& u, int r) const { return u.pm * BM + r; } };
struct MoeRows { static constexpr bool LINEAR = false; const PG8_LAS int* idx; int pm0;
    __device__ __forceinline__ int operator()(const Unit& u, int r) const { return idx[(u.pm == pm0 ? 0 : 256) + r]; } };
struct Gemm { const GAS bf16_t* A; const GAS bf16_t* Bt; int M, N, K; };
struct StaticOrder {
    int nM, nN, nwg, G, c;
    __device__ void init(int M, int N, int G_, int c_) { nM = M / BM; nN = N / BM; nwg = nM * nN; G = G_; c = c_; }
    __device__ bool next(int i, Unit& u) const {
        const long L = (long)i * G + c; if (L >= nwg) return false;
        int wgid = (int)L; { const int q = nwg / NXCD, r = nwg % NXCD, xcd = wgid % NXCD, off = wgid / NXCD; wgid = (xcd < r ? xcd * (q + 1) : r * (q + 1) + (xcd - r) * q) + off; }
        const int nig = WGM * nN, gid = wgid / nig, fm = gid * WGM, gsz = (nM - fm) < WGM ? (nM - fm) : WGM;
        u.pm = fm + ((wgid % nig) % gsz); u.pn = (wgid % nig) / gsz; u.bo = 0; return true;
    }
    __device__ __forceinline__ void a_ready(const Unit&) const {}
    __device__ __forceinline__ void done(const Unit&) const {}
};
struct GroupedOrder {
    int nT, nN, G, c; const PG8_LAS int* tile_e; size_t estride; int pm0 = 0;
    __device__ bool next(int i, Unit& u) const {
        if (c < 0) return false;
        const long L = (long)i * G + c; if (L >= (long)nT * nN) return false;
        u.pm = pm0 + (int)(L / nN); u.pn = (int)(L % nN); u.bo = (size_t)__builtin_amdgcn_readfirstlane(tile_e[u.pm]) * estride; return true;
    }
    __device__ __forceinline__ void a_ready(const Unit&) const {}
    __device__ __forceinline__ void done(const Unit&) const {}
};
struct GroupedPublish : GroupedOrder { GAS unsigned* done_cnt;
    __device__ __forceinline__ void done(const Unit& u) const { asm volatile("s_waitcnt vmcnt(0)" ::: "memory");
        if ((threadIdx.x & 63) == 0) __hip_atomic_fetch_add(done_cnt + 64 * u.pm, 1u, __ATOMIC_RELAXED, __HIP_MEMORY_SCOPE_AGENT); } };
__device__ __forceinline__ void wait_rowtile(const GAS unsigned* ready, int pm, unsigned need) {
    if (threadIdx.x < 64) {
        unsigned spins = 0;
        while ((unsigned)__builtin_amdgcn_readfirstlane(__hip_atomic_load(ready + 64 * pm, __ATOMIC_RELAXED, __HIP_MEMORY_SCOPE_AGENT)) < need && ++spins < (1u << 22)) __builtin_amdgcn_s_sleep(2);
        __builtin_amdgcn_fence(__ATOMIC_ACQUIRE, "agent");
        asm volatile("s_waitcnt vmcnt(0)" ::: "memory");
    }
    __syncthreads();
}
__device__ __forceinline__ unsigned cvt_pk_bf16(float lo, float hi) { unsigned r; asm volatile("v_cvt_pk_bf16_f32 %0, %1, %2" : "=v"(r) : "v"(lo), "v"(hi)); return r; }

struct EpiStoreBf16 {
    static constexpr bool PERM = true;
    GAS bf16_t* O; int ldc;
    __device__ __forceinline__ void operator()(const f32x4 (&acc)[2][2][4][2], const Unit& u, int wr, int wc, int fr, int fq) const {
        const int row0 = u.pm * BM + wr * 64 + fr, col0 = u.pn * BM + wc * 32 + 8 * fq;
#pragma unroll
        for (int ai = 0; ai < 2; ++ai)
#pragma unroll
            for (int m = 0; m < 4; ++m) { GAS bf16_t* rowp = O + (size_t)(row0 + ai * HALF + m * 16) * ldc + col0;
#pragma unroll
                for (int bj = 0; bj < 2; ++bj) { const f32x4 v0 = acc[ai][bj][m][0], v1 = acc[ai][bj][m][1];
                    u32x4 w; w.x = cvt_pk_bf16(v0[0], v0[1]); w.y = cvt_pk_bf16(v0[2], v0[3]); w.z = cvt_pk_bf16(v1[0], v1[1]); w.w = cvt_pk_bf16(v1[2], v1[3]);
                    *(GAS u32x4*)(rowp + bj * HALF) = w; } }
    }
};
struct EpiResid {
    static constexpr bool PERM = true;
    GAS bf16_t* X; int row_off; const GAS float* mod;
    const GAS float* src_ctx; const GAS float* src_lat;
    __device__ __forceinline__ void operator()(const f32x4 (&acc)[2][2][4][2], const Unit& u, int wr, int wc, int fr, int fq) const {
        const int row0 = row_off + u.pm * BM + wr * 64 + fr, col0 = u.pn * BM + wc * 32 + 8 * fq;
        f32x4 gv[2][2];
        { const GAS float* gp = mod + (size_t)bidx_of_row(row_off + u.pm * BM) * 6144 + col0;
#pragma unroll
            for (int bj = 0; bj < 2; ++bj)
#pragma unroll
                for (int n = 0; n < 2; ++n) gv[bj][n] = *(const GAS f32x4*)(gp + bj * HALF + n * 4); }
#pragma unroll
        for (int ai = 0; ai < 2; ++ai)
#pragma unroll
            for (int m = 0; m < 4; ++m) { const int row = row0 + ai * HALF + m * 16; GAS bf16_t* rowp = X + (size_t)row * D + col0;
                const GAS float* bp = src_lat ? (row < NCTX ? src_ctx + (size_t)row * D + col0 : src_lat + (size_t)(row - NCTX) * D + col0) : (const GAS float*)nullptr;
#pragma unroll
                for (int bj = 0; bj < 2; ++bj) { f32x4 x0, x1;
                    if (src_lat) { x0 = *(const GAS f32x4*)(bp + bj * HALF); x1 = *(const GAS f32x4*)(bp + bj * HALF + 4); }
                    else { const u32x4 w = *(const GAS u32x4*)(rowp + bj * HALF); x0 = bf4f((v2u){w.x, w.y}); x1 = bf4f((v2u){w.z, w.w}); }
                    x0 = x0 + gv[bj][0] * acc[ai][bj][m][0]; x1 = x1 + gv[bj][1] * acc[ai][bj][m][1];
                    const v2u o0 = f4bf(x0), o1 = f4bf(x1); *(GAS u32x4*)(rowp + bj * HALF) = (u32x4){o0.x, o0.y, o1.x, o1.y}; } }
    }
};
struct EpiGateUp {
    static constexpr bool PERM = true;
    GAS bf16_t* O; unsigned nbytes;
    __device__ __forceinline__ void operator()(const f32x4 (&acc)[2][2][4][2], const Unit& u, int wr, int wc, int fr, int fq) const {
        const int row0 = u.pm * BM + wr * 64 + fr, col0 = u.pn * HALF + wc * 32 + 8 * fq;
        const __amdgpu_buffer_rsrc_t rsrc = __builtin_amdgcn_make_buffer_rsrc((void*)O, 0, (int)nbytes, 0x00020000);
#pragma unroll
        for (int ai = 0; ai < 2; ++ai)
#pragma unroll
            for (int m = 0; m < 4; ++m) { const unsigned off = (unsigned)((row0 + ai * HALF + m * 16) * 256 + col0) * 2u;
                float r[8];
#pragma unroll
                for (int n = 0; n < 2; ++n)
#pragma unroll
                    for (int j = 0; j < 4; ++j) { const float g = acc[ai][0][m][n][j], up = acc[ai][1][m][n][j]; r[n * 4 + j] = g * __builtin_amdgcn_rcpf(1.f + __expf(-g)) * up; }
                u32x4 w; w.x = cvt_pk_bf16(r[0], r[1]); w.y = cvt_pk_bf16(r[2], r[3]); w.z = cvt_pk_bf16(r[4], r[5]); w.w = cvt_pk_bf16(r[6], r[7]);
                __builtin_amdgcn_raw_buffer_store_b128(w, rsrc, (int)off, 0, 16); }
    }
};

template <class Epi, class Sched, class Rows = LinearRows>
__device__ __forceinline__ void gemm_phase(PG8_LAS unsigned char* lds, const Gemm g, const Sched& S, const Epi& E, const Rows RM = Rows()) {
    const int tid = threadIdx.x, wid = __builtin_amdgcn_readfirstlane(tid >> 6), lane = tid & 63, wr = wid >> 2, wc = wid & 3, fr = lane & 15, fq = lane >> 4;
    const int K = g.K, nt = K / BK;
    unsigned voffB[2]; int rA[2], cA2[2];
#pragma unroll
    for (int i = 0; i < 2; ++i) { int R, C; stage_rc(tid * 16 + i * 8192, R, C); const int Rb = Epi::PERM ? ((R & ~31) + perm32(R & 31)) : R;
        rA[i] = R; cA2[i] = C * 2; voffB[i] = (unsigned)(Rb * K + C) * 2u; }
    unsigned oAc[2][2], oAn[2][2];
#define PG8_AOFF(dst, u) do { _Pragma("unroll") for (int _h = 0; _h < 2; ++_h) _Pragma("unroll") for (int _i = 0; _i < 2; ++_i) dst[_h][_i] = (unsigned)RM(u, _h * HALF + rA[_i]) * (unsigned)(K * 2) + (unsigned)cA2[_i]; } while (0)
#define PG8_STAGE_A(bufoff, o2, kbyte) do { _Pragma("unroll") for (int _i = 0; _i < 2; ++_i) \
        __builtin_amdgcn_global_load_lds((const unsigned*)((const char*)g.A + (size_t)(kbyte) + (o2)[_i]), (PG8_LAS unsigned*)(lds + (bufoff) + ldsw + _i * 8192), 16, 0, 0); } while (0)
    const size_t kstep = (size_t)(BK * 2);
    const size_t hstep = (size_t)HALF * K * 2;
    const size_t tstep = 2 * hstep;
    const unsigned ldsw = (unsigned)wid * 1024u;
    const int aoff = lds_byte(wr * 64 + fr, fq * 8), boff = lds_byte(wc * 32 + fr, fq * 8);
#define PG8_SA(b, h) (((b) * 2 + (h)) * HTB)
#define PG8_SB(b, h) ((4 + (b) * 2 + (h)) * HTB)
#define PG8_STAGE(bufoff, gbase, voff) do { _Pragma("unroll") for (int _i = 0; _i < 2; ++_i) \
        __builtin_amdgcn_global_load_lds((const unsigned*)((const char*)(gbase) + (voff)[_i]), (PG8_LAS unsigned*)(lds + (bufoff) + ldsw + _i * 8192), 16, 0, 0); } while (0)
#define PG8_LDA(dst, b, h) do { _Pragma("unroll") for (int m = 0; m < 4; ++m) _Pragma("unroll") for (int k = 0; k < 2; ++k) dst[m][k] = *(const PG8_LAS bf16x8*)(lds + PG8_SA(b, h) + aoff + m * 2048 + k * 1024); } while (0)
#define PG8_LDB(dst, b, h) do { _Pragma("unroll") for (int n = 0; n < 2; ++n) _Pragma("unroll") for (int k = 0; k < 2; ++k) dst[n][k] = *(const PG8_LAS bf16x8*)(lds + PG8_SB(b, h) + boff + n * 2048 + k * 1024); } while (0)
#define PG8_MMA(ai, bj, At, Bt) do { __builtin_amdgcn_s_setprio(1); _Pragma("unroll") for (int m = 0; m < 4; ++m) _Pragma("unroll") for (int n = 0; n < 2; ++n) _Pragma("unroll") for (int k = 0; k < 2; ++k) \
        acc[ai][bj][m][n] = __builtin_amdgcn_mfma_f32_16x16x32_bf16(Bt[n][k], At[m][k], acc[ai][bj][m][n], 0, 0, 0); __builtin_amdgcn_s_setprio(0); } while (0)
#define PG8_WAIT_V(n) asm volatile("s_waitcnt vmcnt(" #n ")" ::: "memory")
#define PG8_WAIT_L(n) asm volatile("s_waitcnt lgkmcnt(" #n ")" ::: "memory")
#define PG8_BAR __builtin_amdgcn_s_barrier()
#define PG8_SCHED __builtin_amdgcn_sched_barrier(0)
    Unit cur, nxt; int ui = 0;
    if (!S.next(0, cur)) return;
    f32x4 acc[2][2][4][2];
#pragma unroll
    for (int a = 0; a < 2; ++a)
#pragma unroll
        for (int b = 0; b < 2; ++b)
#pragma unroll
            for (int m = 0; m < 4; ++m)
#pragma unroll
                for (int n = 0; n < 2; ++n) acc[a][b][m][n] = (f32x4){0.f, 0.f, 0.f, 0.f};
    bf16x8 At[4][2], B0[2][2], B1[2][2];
    const char* cB = (const char*)g.Bt + cur.bo + (size_t)cur.pn * tstep;
    S.a_ready(cur);
    PG8_AOFF(oAc, cur);
    PG8_STAGE(PG8_SB(0, 0), cB, voffB); PG8_STAGE_A(PG8_SA(0, 0), oAc[0], 0); PG8_STAGE(PG8_SB(0, 1), cB + hstep, voffB); PG8_STAGE_A(PG8_SA(0, 1), oAc[1], 0);
    if (wr == 1) PG8_BAR;
    PG8_WAIT_V(4); PG8_BAR;
    PG8_STAGE(PG8_SB(1, 0), cB + kstep, voffB); PG8_STAGE_A(PG8_SA(1, 0), oAc[0], kstep); PG8_STAGE(PG8_SB(1, 1), cB + hstep + kstep, voffB);
    PG8_WAIT_V(6); PG8_BAR;
    for (;;) {
        const bool has_next = S.next(ui + 1, nxt);
        const char* nB = has_next ? (const char*)g.Bt + nxt.bo + (size_t)nxt.pn * tstep : cB;
        unsigned dAn = 0u;
        if constexpr (Rows::LINEAR) { if (has_next) dAn = (unsigned)(nxt.pm - cur.pm) * (unsigned)(BM * K * 2); }
        else { if (has_next) PG8_AOFF(oAn, nxt);
            else {
#pragma unroll
                for (int _h = 0; _h < 2; ++_h)
#pragma unroll
                    for (int _i = 0; _i < 2; ++_i) oAn[_h][_i] = oAc[_h][_i]; } }
        for (int t = 0; t < nt; t += 2) {
            const bool last = (t == nt - 2);
            const size_t k1 = (size_t)(t + 1) * kstep, k2 = last ? 0 : (size_t)(t + 2) * kstep, k3 = k2 + kstep;
            unsigned o20[2], o21[2];
#pragma unroll
            for (int _i = 0; _i < 2; ++_i) { if constexpr (Rows::LINEAR) { o20[_i] = oAc[0][_i] + (last ? dAn : 0u); o21[_i] = oAc[1][_i] + (last ? dAn : 0u); }
                else { o20[_i] = last ? oAn[0][_i] : oAc[0][_i]; o21[_i] = last ? oAn[1][_i] : oAc[1][_i]; } }
            const char* b2 = last ? nB : cB + (size_t)(t + 2) * kstep;
            const char* b3 = b2 + kstep;
            if (last && has_next) S.a_ready(nxt);
            PG8_LDB(B0, 0, 0); PG8_SCHED; PG8_LDA(At, 0, 0); PG8_STAGE_A(PG8_SA(1, 1), oAc[1], k1);
            PG8_WAIT_L(8); PG8_BAR; PG8_WAIT_L(0); PG8_MMA(0, 0, At, B0); PG8_BAR; PG8_SCHED;
            PG8_LDB(B1, 0, 1); PG8_STAGE(PG8_SB(0, 0), b2, voffB);
            PG8_BAR; PG8_WAIT_L(0); PG8_MMA(0, 1, At, B1); PG8_BAR;
            PG8_LDA(At, 0, 1); PG8_STAGE_A(PG8_SA(0, 0), o20, k2);
            PG8_BAR; PG8_WAIT_L(0); PG8_MMA(1, 0, At, B0); PG8_BAR; PG8_SCHED;
            PG8_STAGE(PG8_SB(0, 1), b2 + hstep, voffB);
            PG8_WAIT_V(6); PG8_BAR; PG8_MMA(1, 1, At, B1); PG8_BAR;
            PG8_LDB(B0, 1, 0); PG8_SCHED; PG8_LDA(At, 1, 0); PG8_STAGE_A(PG8_SA(0, 1), o21, k2);
            PG8_WAIT_L(8); PG8_BAR; PG8_WAIT_L(0); PG8_MMA(0, 0, At, B0); PG8_BAR; PG8_SCHED;
            PG8_LDB(B1, 1, 1); PG8_STAGE(PG8_SB(1, 0), b3, voffB);
            PG8_BAR; PG8_WAIT_L(0); PG8_MMA(0, 1, At, B1); PG8_BAR;
            PG8_LDA(At, 1, 1); PG8_STAGE_A(PG8_SA(1, 0), o20, k3);
            PG8_BAR; PG8_WAIT_L(0); PG8_MMA(1, 0, At, B0); PG8_BAR; PG8_SCHED;
            PG8_STAGE(PG8_SB(1, 1), b3 + hstep, voffB);
            PG8_WAIT_V(6); PG8_BAR; PG8_MMA(1, 1, At, B1); PG8_BAR;
        }
        E(acc, cur, wr, wc, fr, fq); S.done(cur);
        if (!has_next) break;
#pragma unroll
        for (int a = 0; a < 2; ++a)
#pragma unroll
            for (int b = 0; b < 2; ++b)
#pragma unroll
                for (int m = 0; m < 4; ++m)
#pragma unroll
                    for (int n = 0; n < 2; ++n) acc[a][b][m][n] = (f32x4){0.f, 0.f, 0.f, 0.f};
        cur = nxt; cB = nB; ++ui;
#pragma unroll
        for (int _h = 0; _h < 2; ++_h)
#pragma unroll
            for (int _i = 0; _i < 2; ++_i) { if constexpr (Rows::LINEAR) oAc[_h][_i] += dAn; else oAc[_h][_i] = oAn[_h][_i]; }
    }
    PG8_WAIT_V(0);
    if (wr == 0) PG8_BAR;
    PG8_BAR;
#undef PG8_SA
#undef PG8_SB
#undef PG8_STAGE
#undef PG8_STAGE_A
#undef PG8_AOFF
#undef PG8_LDA
#undef PG8_LDB
#undef PG8_MMA
#undef PG8_WAIT_V
#undef PG8_WAIT_L
#undef PG8_BAR
#undef PG8_SCHED
}
}

#define XB_TMO      128
#define XB_XCNT(j)  (256  + 64 * (j))
#define XB_XSUB(j)  (1280 + 64 * (j))
#define XB_XGEN(j)  (2304 + 64 * (j))
#define XB_TOP      3328
#define XB_TOPGEN   3392
#define XCD_BAR_WORDS 3456
#define XB_SPIN_CAP (1u << 18)
__device__ __forceinline__ unsigned xb_ld(unsigned* p)              { return __hip_atomic_load(p, __ATOMIC_RELAXED, __HIP_MEMORY_SCOPE_AGENT); }
__device__ __forceinline__ unsigned xb_add(unsigned* p, unsigned v) { return __hip_atomic_fetch_add(p, v, __ATOMIC_RELAXED, __HIP_MEMORY_SCOPE_AGENT); }
__device__ __forceinline__ unsigned xb_xcc_id() { return (unsigned)__builtin_amdgcn_s_getreg((3 << 11) | 20) & 0xFu; }
#define XB_SPIN(cond, bar) do { unsigned _sp = 0; while (cond) { __builtin_amdgcn_s_sleep(1); \
    if ((++_sp & 255u) == 0u) { if (xb_ld(&(bar)[XB_TMO])) break; if (_sp > XB_SPIN_CAP) { atomicAdd(&(bar)[XB_TMO], 1u); break; } } } } while (0)
struct XcdBarrier { unsigned* bar; unsigned x; volatile LAS unsigned* st; };
__device__ __forceinline__ XcdBarrier xcd_barrier_post(unsigned* bar, volatile LAS unsigned* st) {
    XcdBarrier b; b.bar = bar; b.x = xb_xcc_id(); b.st = st;
    if (threadIdx.x == 0) (void)xb_add(&bar[XB_XCNT(b.x)], 1u);
    return b;
}
__device__ __forceinline__ void xcd_barrier_complete(unsigned* bar, unsigned x, unsigned& nloc, unsigned& nx) {
    const unsigned G = gridDim.x * gridDim.y * gridDim.z;
    unsigned sum, cnt, mine, sp = 0u;
    for (;;) {
        sum = 0u; cnt = 0u; mine = 0u;
#pragma unroll
        for (unsigned j = 0; j < 16; ++j) { const unsigned c = xb_ld(&bar[XB_XCNT(j)]); sum += c; cnt += (c > 0u) ? 1u : 0u; mine = (j == x) ? c : mine; }
        if (sum == G) break;
        __builtin_amdgcn_s_sleep(1);
        if ((++sp & 255u) == 0u) { if (xb_ld(&bar[XB_TMO])) break; if (sp > XB_SPIN_CAP) { atomicAdd(&bar[XB_TMO], 1u); break; } }
    }
    nloc = mine > 0u ? mine : 1u; nx = cnt > 0u ? cnt : 1u;
}
__device__ __forceinline__ void xcd_barrier(const XcdBarrier& b) {
    asm volatile("s_waitcnt vmcnt(0)" ::: "memory");
    __syncthreads();
    if (threadIdx.x == 0) {
        unsigned* bar = b.bar;
        __builtin_amdgcn_s_waitcnt(0);
        unsigned nloc = b.st[0], nx = b.st[1];
        if (nloc == 0u) { xcd_barrier_complete(bar, b.x, nloc, nx); b.st[0] = nloc; b.st[1] = nx; }
        const unsigned old = xb_add(&bar[XB_XSUB(b.x)], 1u);
        const unsigned gen = old / nloc;
        if (old + 1u == (gen + 1u) * nloc) {
            __builtin_amdgcn_fence(__ATOMIC_RELEASE, "agent");
            asm volatile("s_waitcnt vmcnt(0)" ::: "memory");
            const unsigned og = xb_add(&bar[XB_TOP], 1u);
            const unsigned tg = og / nx;
            if (og + 1u == (tg + 1u) * nx) xb_add(&bar[XB_TOPGEN], 1u);
            else XB_SPIN(xb_ld(&bar[XB_TOPGEN]) == tg, bar);
            __builtin_amdgcn_fence(__ATOMIC_ACQUIRE, "agent");
            xb_add(&bar[XB_XGEN(b.x)], 1u);
            asm volatile("s_waitcnt vmcnt(0)" ::: "memory");
        } else {
            XB_SPIN(xb_ld(&bar[XB_XGEN(b.x)]) == gen, bar);
            __builtin_amdgcn_fence(__ATOMIC_ACQUIRE, "agent");
            asm volatile("s_waitcnt vmcnt(0)" ::: "memory");
        }
    }
    __syncthreads();
}

struct Args { const float* in[N_IN]; float* out; unsigned char* ws; int ph_lo, ph_hi; int pad0, pad1; };
extern __shared__ __attribute__((aligned(16))) unsigned char lds_raw[];
constexpr int PTR_OFF = MISC_OFF + 2048;
struct Ctx {
    DI unsigned long long raw(int i) const { volatile LAS unsigned* t = (volatile LAS unsigned*)((LAS unsigned char*)lds_raw + PTR_OFF) + 2 * i;
        const unsigned lo = __builtin_amdgcn_readfirstlane(t[0]), hi = __builtin_amdgcn_readfirstlane(t[1]); return ((unsigned long long)hi << 32) | lo; }
    DI const GAS float* in(int i) const { return (const GAS float*)raw(i); }
    DI GAS float* out() const { return (GAS float*)raw(N_IN); }
    DI GAS unsigned char* ws() const { return (GAS unsigned char*)raw(N_IN + 1); }
};

DI void transpose_item(const GAS float* W, int N, int k0, int n0, GAS bf16* WT, int Kd, int drow0, LAS float* scr, int lane) {
    float wv[32];
#pragma unroll
    for (int i = 0; i < 32; ++i) wv[i] = W[(size_t)(k0 + 2 * i + (lane >> 5)) * N + n0 + (lane & 31)];
#pragma unroll
    for (int i = 0; i < 32; ++i) scr[(2 * i + (lane >> 5)) * 33 + (lane & 31)] = wv[i];
    LDS_WAIT(); asm volatile("" ::: "memory");
    const int c = lane & 7;
#pragma unroll
    for (int j = 0; j < 4; ++j) { const int n = (lane >> 3) + 8 * j; const LAS float* s = scr + (8 * c) * 33 + n;
        v4u o; o.x = pk2(s[0 * 33], s[1 * 33]); o.y = pk2(s[2 * 33], s[3 * 33]); o.z = pk2(s[4 * 33], s[5 * 33]); o.w = pk2(s[6 * 33], s[7 * 33]);
        *(GAS v4u*)(WT + (size_t)(drow0 + n) * Kd + k0 + 8 * c) = o; }
    LDS_WAIT(); asm volatile("" ::: "memory");
}

DI void weight_copies(const Ctx& a, int l, LAS unsigned char* lds, int tid, int lane, int wave, int gwv, int ngw, int gt, int ngt, int part = 0) {
    GAS unsigned char* ws = a.ws();
    if (part != 2) for (int i = gt; i < 128 * 1024 / 8; i += ngt) *(GAS v4u*)(ws + WS_WTIN + (size_t)l * WTIN_L + (size_t)3200 * D * 2 + (size_t)i * 16) = (v4u){0u, 0u, 0u, 0u};
    LAS float* scr = (LAS float*)(lds + wave * 16384);
    constexpr int IT_IN = 16 * 100, IT_OUT = 16 * 32, IT_UQ = 3 * 12, IT_UKV = 2 * 16, IT_GU = 32 * 16 * 16, IT_DN = 32 * 4 * 32;
    constexpr int NITEMS = IT_IN + IT_OUT + IT_UQ + IT_UKV + IT_GU + IT_DN;
    const int it_lo = part == 2 ? NITEMS - IT_GU - IT_DN : 0, it_hi = part == 2 ? NITEMS - IT_DN : NITEMS;
    for (int it = it_lo + gwv; it < it_hi; it += ngw) {
        if (part == 1 && it >= NITEMS - IT_GU - IT_DN && it < NITEMS - IT_DN) { it += ((NITEMS - IT_DN - it + ngw - 1) / ngw) * ngw - ngw; continue; }
        int r = it;
        if (r < IT_IN) { const int kb = r / 100, nb = r % 100;
            transpose_item(a.in(I_WIN) + (size_t)l * D * DIN, DIN, kb * 64, nb * 32, (GAS bf16*)(ws + WS_WTIN + (size_t)l * WTIN_L), D, nb * 32, scr, lane); continue; } r -= IT_IN;
        if (r < IT_OUT) { const int kb = r / 32, nb = r % 32;
            transpose_item(a.in(I_WOUT) + (size_t)l * D * D, D, kb * 64, nb * 32, (GAS bf16*)(ws + WS_WTOUT + (size_t)l * D * D * 2), D, nb * 32, scr, lane); continue; } r -= IT_OUT;
        if (r < IT_UQ) { const int kb = r / 12, nb = r % 12;
            transpose_item(a.in(I_WUQ) + (size_t)l * 192 * 384, 384, kb * 64, nb * 32, (GAS bf16*)(ws + WS_WTUQ + (size_t)l * 384 * 192 * 2), 192, nb * 32, scr, lane); continue; } r -= IT_UQ;
        if (r < IT_UKV) { const int kb = r / 16, nb = r % 16;
            transpose_item(a.in(I_WUKV) + (size_t)l * 128 * 512, 512, kb * 64, nb * 32, (GAS bf16*)(ws + WS_WTUKV + (size_t)l * 512 * 128 * 2), 128, nb * 32, scr, lane); continue; } r -= IT_UKV;
        if (r < IT_GU) { const int le = l * 32 + r / 256, q = r % 256, kb = q / 16, nb = q % 16; const int n0 = nb * 32, c0 = n0 & 255, isup = n0 >> 8;
            const int drow0 = (c0 >> 7) * 256 + isup * 128 + (c0 & 127);
            transpose_item(a.in(I_WGU) + (size_t)le * D * 512, 512, kb * 64, n0, (GAS bf16*)(ws + WS_WTGU + (size_t)le * 512 * D * 2), D, drow0, scr, lane); continue; } r -= IT_GU;
        { const int le = l * 32 + r / 128, q = r % 128, kb = q / 32, nb = q % 32;
            transpose_item(a.in(I_WDN) + (size_t)le * 256 * D, D, kb * 64, nb * 32, (GAS bf16*)(ws + WS_WTDN + (size_t)le * D * 256 * 2), 256, nb * 32, scr, lane); }
    }
}

DI void phase_prologue(const Ctx& a, LAS unsigned char* lds, int tid, int lane, int wave, int bid, int G) {
    GAS unsigned char* ws = a.ws();
    GAS float* MOD = (GAS float*)(ws + WS_MOD);
    {
        LAS float* S = (LAS float*)lds;
        LAS float* R = (LAS float*)(lds + 5 * 1024 * 4);
        if (bid < 192) {
            const GAS float* cvec = a.in(I_C); const GAS float* cctx = a.in(I_CCTX);
            for (int i = tid; i < 5 * 1024; i += 512) { const int r = i >> 10, k = i & 1023; const float v = r < 4 ? cvec[r * 1024 + k] : cctx[k]; S[i] = silu_(v); }
        }
        __syncthreads();
        for (int u = bid; u < 192; u += G) {
            const int l = u / 96, cl = tid & 63, n = (u % 96) * 64 + cl, ks = tid >> 6;
            const GAS float* W = a.in(I_WMOD) + (size_t)l * 1024 * 6144 + n; const GAS float* bmod = a.in(I_BMOD);
            float acc[5] = {0.f, 0.f, 0.f, 0.f, 0.f};
            for (int k = ks * 128; k < ks * 128 + 128; ++k) { const float w = W[(size_t)k * 6144];
#pragma unroll
                for (int r = 0; r < 5; ++r) acc[r] += S[r * 1024 + k] * w; }
#pragma unroll
            for (int r = 0; r < 5; ++r) R[(ks * 5 + r) * 64 + cl] = acc[r];
            __syncthreads();
            if (tid < 320) { const int r = tid >> 6; float s = 0.f;
#pragma unroll
                for (int k2 = 0; k2 < 8; ++k2) s += R[(k2 * 5 + r) * 64 + cl];
                MOD[(size_t)(l * 5 + r) * 6144 + n] = s + bmod[l * 6144 + n]; }
            __syncthreads();
        }
    }
    for (int i = bid * 512 + tid; i < 2 * 48 * 1024; i += G * 512) { const int l = i / (48 * 1024), r = i % (48 * 1024), c = r >> 10, k = r & 1023;
        const float w = c < 4 ? a.in(I_WRG)[(size_t)l * D * 4 + k * 4 + c] : (c < 36 ? a.in(I_WRE)[(size_t)l * D * 32 + k * 32 + (c - 4)] : 0.f);
        const unsigned hi = f2bf(w); const float lo = w - bf2f(hi);
        GAS bf16* WR = (GAS bf16*)(ws + WS_WR) + (size_t)l * 2 * 48 * 1024;
        WR[c * 1024 + k] = (bf16)hi; WR[48 * 1024 + c * 1024 + k] = (bf16)f2bf(lo); }
    weight_copies(a, 0, lds, tid, lane, wave, bid * 8 + wave, G * 8, bid * 512 + tid, G * 512, 1);
}

DI void norm_row_store(const f32x4 (&v)[4], const GAS float* g, const GAS float* shift, const GAS float* scale, GAS bf16* hrow, int lane) {
    float ss = 0.f;
#pragma unroll
    for (int j = 0; j < 4; ++j) ss += (v[j].x * v[j].x + v[j].y * v[j].y) + (v[j].z * v[j].z + v[j].w * v[j].w);
    const float rstd = rsqrtf(wave_sum(ss) * (1.f / D) + EPS);
#pragma unroll
    for (int j = 0; j < 4; ++j) { const int c = 4 * lane + 256 * j;
        const f32x4 gg = *(const GAS f32x4*)(g + c), sh = *(const GAS f32x4*)(shift + c), sc = *(const GAS f32x4*)(scale + c);
        const f32x4 y = v[j] * rstd * gg * (1.f + sc) + sh;
        v2u o; o.x = pk2(y.x, y.y); o.y = pk2(y.z, y.w); *(GAS v2u*)(hrow + c) = o; }
}

struct NormPar { f32x4 w[4], sh[4]; };
DI void load_normpar(NormPar& p, const GAS float* g, const GAS float* shift, const GAS float* scale, int lane) {
#pragma unroll
    for (int j = 0; j < 4; ++j) { const int c = 4 * lane + 256 * j; const f32x4 gg = *(const GAS f32x4*)(g + c), sc = *(const GAS f32x4*)(scale + c); p.w[j] = gg * (1.f + sc); p.sh[j] = *(const GAS f32x4*)(shift + c); }
}
DI void norm_row_store_c(const f32x4 (&v)[4], const NormPar& p, GAS bf16* hrow, int lane) {
    float ss = 0.f;
#pragma unroll
    for (int j = 0; j < 4; ++j) ss += (v[j].x * v[j].x + v[j].y * v[j].y) + (v[j].z * v[j].z + v[j].w * v[j].w);
    const float rstd = rsqrtf(wave_sum(ss) * (1.f / D) + EPS);
#pragma unroll
    for (int j = 0; j < 4; ++j) { const f32x4 y = v[j] * rstd * p.w[j] + p.sh[j]; v2u o; o.x = pk2(y.x, y.y); o.y = pk2(y.z, y.w); *(GAS v2u*)(hrow + 4 * lane + 256 * j) = o; }
}

DI void phase_norm1_l0(const Ctx& a, int lane, int gw, int NGW) {
    GAS unsigned char* ws = a.ws(); GAS bf16* H = (GAS bf16*)(ws + WS_H); const GAS float* MOD = (const GAS float*)(ws + WS_MOD);
    const GAS float* xin = a.in(I_X); const GAS float* cin = a.in(I_CTX); const GAS float* n1g = a.in(I_N1G);
    const int nwg = NGW >> 3, R = (MTOK + nwg - 1) / nwg, m_beg = (gw >> 3) * R + (gw & 7), m_end = min(((gw >> 3) + 1) * R, MTOK);
    NormPar np; int cb = -1;
#pragma unroll 1
    for (int m = m_beg; m < m_end; m += 8) {
        const GAS float* src = m < NCTX ? cin + (size_t)m * D : xin + (size_t)(m - NCTX) * D;
        f32x4 v[4];
#pragma unroll
        for (int j = 0; j < 4; ++j) v[j] = *(const GAS f32x4*)(src + 4 * lane + 256 * j);
        const int b = bidx_of_row(m);
        if (b != cb) { const GAS float* mb = MOD + (size_t)b * 6144; load_normpar(np, n1g, mb, mb + 1024, lane); cb = b; }
        norm_row_store_c(v, np, H + (size_t)m * D, lane);
    }
}

DI bf16x8 ld8(const LAS bf16* p) { return *(const LAS bf16x8*)p; }
DI bf16x8 ld8(const GAS bf16* p) { return *(const GAS bf16x8*)p; }
template <class PA, class PB>
DI f32x4 mma16(PA A, int lda, PB B, int ldb, int K, int lane) {
    f32x4 acc = {0.f, 0.f, 0.f, 0.f};
    const int r = lane & 15, q = (lane >> 4) * 8;
    for (int k = 0; k < K; k += 32) {
        const bf16x8 av = ld8(A + r * lda + k + q);
        const bf16x8 bv = ld8(B + r * ldb + k + q);
        acc = __builtin_amdgcn_mfma_f32_16x16x32_bf16(av, bv, acc, 0, 0, 0);
    }
    return acc;
}

constexpr int CQ_P = 200, CKV_P = 136, STG_P = 520;
constexpr int PR = 64, PL_CQ = 0, PL_CKV = 25600, PL_RK = 43008, PL_STG = 47104, PL_T = PL_STG;
DI float rope_ang(int t, int ri) { const int ax = ri >> 4, f = ri & 7; const float p = (float)(ax == 0 ? (t >> 6) : (t & 63)); return p * __builtin_amdgcn_exp2f(-1.6609640474436813f * (float)f) * 0.15915494309189535f; }
DI void prep_unit(const Ctx& a, int l, int unit, LAS unsigned char* lds, int tid, int lane, int wave) {
    GAS unsigned char* ws = a.ws();
    const GAS bf16* P = (const GAS bf16*)(ws + WS_P);
    LAS bf16* CQ = (LAS bf16*)(lds + PL_CQ); LAS bf16* CKV = (LAS bf16*)(lds + PL_CKV); LAS bf16* STG = (LAS bf16*)(lds + PL_STG); LAS bf16* RK = (LAS bf16*)(lds + PL_RK); LAS bf16* T = (LAS bf16*)(lds + PL_T);
    const int m0 = unit * PR;
    const bool isctx = m0 < NCTX;
    const int bb = isctx ? (m0 >> 8) : ((m0 - NCTX) >> 12);
    const int pos0 = isctx ? (m0 & 255) : (256 + ((m0 - NCTX) & 4095));
    const int t0 = isctx ? 0 : ((m0 - NCTX) & 4095);
    { const GAS float* gq = a.in(I_QNG) + l * 192; const GAS float* gkv = a.in(I_KVNG) + l * 128;
        const bool isq = lane < 24, iskv = lane >= 24 && lane < 40; const int pc = isq ? lane : lane - 24;
        float gn[8];
#pragma unroll
        for (int e = 0; e < 8; ++e) gn[e] = isq ? gq[pc * 8 + e] : (iskv ? gkv[pc * 8 + e] : 0.f);
#pragma unroll
        for (int rr = 0; rr < PR / 8; ++rr) { const int r = wave * (PR / 8) + rr; float x[8];
            v4u w = (v4u){0u, 0u, 0u, 0u}; if (lane < 40) w = *(const GAS v4u*)(P + (size_t)(m0 + r) * PP + (isq ? CD_Q : CD_KV) + pc * 8);
            unpack8(w, x); float ss = 0.f;
#pragma unroll
            for (int e = 0; e < 8; ++e) ss += x[e] * x[e];
            const float sq = wave_sum(isq ? ss : 0.f), skv = wave_sum(iskv ? ss : 0.f);
            const float rs = isq ? rsqrtf(sq * (1.f / 192.f) + EPS) : rsqrtf(skv * (1.f / 128.f) + EPS);
#pragma unroll
            for (int e = 0; e < 8; ++e) x[e] *= rs * gn[e];
            const v4u o = (v4u){pk2(x[0], x[1]), pk2(x[2], x[3]), pk2(x[4], x[5]), pk2(x[6], x[7])};
            if (isq) *(LAS v4u*)(CQ + r * CQ_P + pc * 8) = o; else if (iskv) *(LAS v4u*)(CKV + r * CKV_P + pc * 8) = o; } }
    for (int e = tid; e < PR * 32; e += 512) { const int r = e >> 5, ri = e & 31; const GAS bf16* prow = P + (size_t)(m0 + r) * PP + CD_R;
        float v = bf2f(prow[ri]);
        if (!isctx) { const float pv = bf2f(prow[ri ^ 8]); const float ang = rope_ang(t0 + r, ri); const float cs = __builtin_amdgcn_cosf(ang), sn = __builtin_amdgcn_sinf(ang);
            v = ((ri >> 3) & 1) == 0 ? (v * cs - pv * sn) : (pv * sn + v * cs); }
        RK[r * 32 + ri] = (bf16)f2bf(v); }
    for (int e = tid; e < PR * 32; e += 512) { const int r = e >> 5, c8 = e & 31; *(LAS v4u*)(T + r * 264 + c8 * 8) = *(const GAS v4u*)(P + (size_t)(m0 + r) * PP + CB_V + c8 * 8); }
    __syncthreads();
    GAS bf16* QM = (GAS bf16*)(ws + WS_QM); GAS bf16* KM = (GAS bf16*)(ws + WS_KM); GAS bf16* VM = (GAS bf16*)(ws + WS_VM); GAS bf16* VNT = (GAS bf16*)(ws + WS_VNT);
    const GAS bf16* WTQ = (const GAS bf16*)(ws + WS_WTUQ + (size_t)l * 384 * 192 * 2);
    const GAS bf16* WTKV = (const GAS bf16*)(ws + WS_WTUKV + (size_t)l * 512 * 128 * 2);
    const float qs = 0.10206207261596575f * LOG2E;
    const int fr = lane & 15, fq = lane >> 4;
    for (int e = tid; e < 256 * (PR / 8); e += 512) { const int col = e / (PR / 8), p8 = e % (PR / 8); unsigned hv[8];
#pragma unroll
        for (int j = 0; j < 8; ++j) hv[j] = T[(p8 * 8 + j) * 264 + col];
        *(GAS v4u*)(VNT + ((size_t)(bb * 4) * 64 + col) * NKEY + pos0 + p8 * 8) = (v4u){hv[0] | (hv[1] << 16), hv[2] | (hv[3] << 16), hv[4] | (hv[5] << 16), hv[6] | (hv[7] << 16)}; }
    __syncthreads();
    { bf16x8 bfr[3][6];
#pragma unroll
      for (int i = 0; i < 3; ++i)
#pragma unroll
        for (int ks = 0; ks < 6; ++ks) bfr[i][ks] = *(const GAS bf16x8*)(WTQ + (size_t)((wave + 8 * i) * 16 + fr) * 192 + ks * 32 + fq * 8);
#pragma unroll
      for (int i = 0; i < 3; ++i) { const int nb = wave + 8 * i;
        const int c = nb * 16 + fr, within = c % 96;
#pragma unroll
        for (int mb = 0; mb < PR / 16; ++mb) { f32x4 acc = {0.f, 0.f, 0.f, 0.f};
#pragma unroll
            for (int ks = 0; ks < 6; ++ks) acc = __builtin_amdgcn_mfma_f32_16x16x32_bf16(*(const LAS bf16x8*)(CQ + (mb * 16 + fr) * CQ_P + ks * 32 + fq * 8), bfr[i][ks], acc, 0, 0, 0);
#pragma unroll
            for (int j = 0; j < 4; ++j) { const int r = mb * 16 + 4 * fq + j; float v = acc[j]; const float pv = __shfl_xor(v, 8);
                if (within >= 64 && !isctx) { const int ri = within - 64; const float ang = rope_ang(t0 + r, ri); const float cs = __builtin_amdgcn_cosf(ang), sn = __builtin_amdgcn_sinf(ang);
                    v = ((ri >> 3) & 1) == 0 ? (v * cs - pv * sn) : (pv * sn + v * cs); }
                STG[r * STG_P + c] = (bf16)f2bf(v * qs); } } } }
    __syncthreads();
    for (int e = tid; e < PR * 48; e += 512) { const int r = e / 48, hp = e % 48, hd = hp / 12, pc = hp % 12;
        *(GAS v4u*)(QM + ((size_t)(bb * 4 + hd) * NKEY + pos0 + r) * 96 + pc * 8) = *(const LAS v4u*)(STG + r * STG_P + hd * 96 + pc * 8); }
    __syncthreads();
    { bf16x8 bfr[4][4];
#pragma unroll
      for (int i = 0; i < 4; ++i)
#pragma unroll
        for (int ks = 0; ks < 4; ++ks) bfr[i][ks] = *(const GAS bf16x8*)(WTKV + (size_t)((wave + 8 * i) * 16 + fr) * 128 + ks * 32 + fq * 8);
#pragma unroll
      for (int i = 0; i < 4; ++i) { const int nb = wave + 8 * i;
#pragma unroll
        for (int mb = 0; mb < PR / 16; ++mb) { f32x4 acc = {0.f, 0.f, 0.f, 0.f};
#pragma unroll
            for (int ks = 0; ks < 4; ++ks) acc = __builtin_amdgcn_mfma_f32_16x16x32_bf16(*(const LAS bf16x8*)(CKV + (mb * 16 + fr) * CKV_P + ks * 32 + fq * 8), bfr[i][ks], acc, 0, 0, 0);
#pragma unroll
            for (int j = 0; j < 4; ++j) STG[(mb * 16 + 4 * fq + j) * STG_P + nb * 16 + fr] = (bf16)f2bf(acc[j]); } } }
    __syncthreads();
    for (int e = tid; e < PR * 48; e += 512) { const int r = e / 48, hp = e % 48, hd = hp / 12, pc = hp % 12;
        const v4u v = pc < 8 ? *(const LAS v4u*)(STG + r * STG_P + hd * 128 + pc * 8) : *(const LAS v4u*)(RK + r * 32 + (pc - 8) * 8);
        *(GAS v4u*)(KM + ((size_t)(bb * 4 + hd) * NKEY + pos0 + r) * 96 + pc * 8) = v; }
    for (int e = tid; e < 256 * (PR / 8); e += 512) { const int col = e / (PR / 8), p8 = e % (PR / 8), hd = col >> 6, dv = col & 63; unsigned hv[8];
#pragma unroll
        for (int j = 0; j < 8; ++j) hv[j] = STG[(p8 * 8 + j) * STG_P + hd * 128 + 64 + dv];
        *(GAS v4u*)(VM + ((size_t)(bb * 4 + hd) * 64 + dv) * NKEY + pos0 + p8 * 8) = (v4u){hv[0] | (hv[1] << 16), hv[2] | (hv[3] << 16), hv[4] | (hv[5] << 16), hv[6] | (hv[7] << 16)}; }
    __syncthreads();
}

constexpr int RP = 65;
DI int scan_row(int b, int dir, int c, int i) {
    const int s = 64 * c + i;
    if (dir == 0) return s < 256 ? b * 256 + s : NCTX + b * SEQ + (s - 256);
    return s < 256 ? b * 256 + 255 - s : NCTX + b * SEQ + SEQ - 1 - (s - 256);
}
#ifndef BAR_LDS
#define BAR_LDS() asm volatile("s_waitcnt lgkmcnt(0)\n\ts_barrier" ::: "memory")
#endif
constexpr int RC_P = 68;
constexpr int L_C = 0, L_QD = 17408, L_QE = 26624, L_KD = 35840, L_VT = 58880, L_ST = 68096, L_ATT = 77312, L_O = 86528, L_T = 103168;
template <int MIX> struct RecCfg { static constexpr int DK = MIX == 0 ? 64 : 32, DKP = DK + 8, NP = DK / 8, CPT = DK / 8; };
template <int MIX> struct RecPre {
    v4u fk;
    v4u zg[MIX == 1 ? 2 : 1];
    v4u qp;
    v4u vp; f32x4 s0, s1;
};
template <int MIX, bool R3>
DI void rec_fetch(RecPre<MIX>& R, const GAS bf16* P, const GAS float* RSbase, int b, int h, int dir, int c, int tid) {
    constexpr int DK = RecCfg<MIX>::DK;
    const int lane = tid & 63, wave = tid >> 6;
    const GAS bf16* prow = P + (size_t)scan_row(b, dir, c, lane) * PP;
    if (MIX == 0) { R.fk = *(const GAS v4u*)(prow + (dir ? CA_FB : CA_FF) + h * 64 + 8 * wave); if (R3) R.qp = *(const GAS v4u*)(prow + CA_Q + h * 64 + 8 * wave); }
    else { const GAS bf16* zr = prow + (dir ? CC_ZB : CC_ZF); R.zg[0] = *(const GAS v4u*)zr; R.zg[1] = *(const GAS v4u*)(zr + 8);
        const v2u kk = *(const GAS v2u*)(prow + CC_K + h * 32 + 4 * wave); R.fk = (v4u){kk.x, kk.y, 0u, 0u};
        if (R3) { const v2u qq = *(const GAS v2u*)(prow + CC_Q + h * 32 + 4 * wave); R.qp = (v4u){qq.x, qq.y, 0u, 0u}; } }
    R.vp = *(const GAS v4u*)(P + (size_t)scan_row(b, dir, c, tid >> 3) * PP + (MIX == 0 ? CA_I : CC_V) + h * 64 + (tid & 7) * 8);
    if (R3 && tid < DK * 8) { const GAS float* rs = RSbase + (size_t)(((b * 4 + h) * 2 + dir) * NCHUNK + c) * DK * 64 + (tid >> 3) * 64 + (tid & 7) * 8; R.s0 = *(const GAS f32x4*)rs; R.s1 = *(const GAS f32x4*)(rs + 4); }
}
DI float dpp_shr_(float v, int ctrl_sel) { const int iv = __builtin_bit_cast(int, v); int r;
    switch (ctrl_sel) { case 1: r = __builtin_amdgcn_update_dpp(0, iv, 0x111, 0xf, 0xf, true); break; case 2: r = __builtin_amdgcn_update_dpp(0, iv, 0x112, 0xf, 0xf, true); break;
                        case 4: r = __builtin_amdgcn_update_dpp(0, iv, 0x114, 0xf, 0xf, true); break; default: r = __builtin_amdgcn_update_dpp(0, iv, 0x118, 0xf, 0xf, true); break; }
    return __builtin_bit_cast(float, r); }
DI float scan64(float v) {
    v += dpp_shr_(v, 1); v += dpp_shr_(v, 2); v += dpp_shr_(v, 4); v += dpp_shr_(v, 8);
    v += __builtin_bit_cast(float, __builtin_amdgcn_update_dpp(0, __builtin_bit_cast(int, v), 0x142, 0xa, 0xf, false));
    v += __builtin_bit_cast(float, __builtin_amdgcn_update_dpp(0, __builtin_bit_cast(int, v), 0x143, 0xc, 0xf, false));
    return v; }
DI float lane_read(float v, int ln) { return __builtin_bit_cast(float, __builtin_amdgcn_readlane(__builtin_bit_cast(int, v), ln)); }
template <int MIX>
DI void rec_front(const RecPre<MIX>& R, const GAS float* lg, const GAS float* wgp, const GAS float* bgp, int l, int h, int dir, int wave, float (&kv)[RecCfg<MIX>::CPT], float (&cum)[RecCfg<MIX>::CPT]) {
    if (MIX == 0) { float z[8]; unpack8(R.fk, z);
#pragma unroll
        for (int e = 0; e < 8; ++e) { const int ch = h * 64 + 8 * wave + e; float lb = 0.f; if (l == 1) lb = sigmoid_(lg[512 + dir * 256 + ch] - lg[dir * 256 + ch]);
            const float f = lb + (1.f - lb) * sigmoid_(z[e]); cum[e] = scan64(__logf(f)); kv[e] = (1.f - lb) * sigmoid_(-z[e]); }
    } else { float z[16], kk[8]; unpack8(R.zg[0], z); unpack8(R.zg[1], z + 8); unpack8(R.fk, kk);
#pragma unroll
        for (int c = 0; c < 4; ++c) { const int ch = h * 32 + 4 * wave + c; float sacc = bgp[ch];
#pragma unroll
            for (int r = 0; r < 16; ++r) sacc += z[r] * wgp[r * 128 + ch];
            cum[c] = scan64(logsigmoid_(sacc) * (1.f / 16.f)); kv[c] = kk[c]; } }
}
template <int N> DI void st_bf16(LAS bf16* p, const float (&v)[N]) {
    if (N == 8) *(LAS v4u*)p = (v4u){pk2(v[0], v[1]), pk2(v[2], v[3]), pk2(v[4], v[5]), pk2(v[6], v[7])};
    else *(LAS v2u*)p = (v2u){pk2(v[0], v[1]), pk2(v[2], v[3])};
}
DI void rec_vt_store(const v4u vp, LAS bf16* VT, int tid) { const int j = tid >> 3, v8 = tid & 7; const unsigned ww[4] = {vp.x, vp.y, vp.z, vp.w};
#pragma unroll
    for (int e = 0; e < 8; ++e) VT[(v8 * 8 + e) * 72 + j] = (bf16)((ww[e >> 1] >> ((e & 1) * 16)) & 0xffffu); }

template <int MIX>
DI void rec_r1_run(const Ctx& a, int l, LAS unsigned char* lds, int tid, int bid, int G) {
    constexpr int DK = RecCfg<MIX>::DK, CPT = RecCfg<MIX>::CPT;
    const int lane = tid & 63, wave = __builtin_amdgcn_readfirstlane(tid >> 6);
    LAS bf16* KT = (LAS bf16*)(lds + L_KD); LAS bf16* VT = (LAS bf16*)(lds + L_VT);
    GAS unsigned char* wsb = a.ws(); const GAS bf16* P = (const GAS bf16*)(wsb + WS_P);
    GAS float* RSb = (GAS float*)(wsb + (MIX == 0 ? WS_RSH : WS_RSG)); GAS float* RAb = (GAS float*)(wsb + (MIX == 0 ? WS_RAH : WS_RAG));
    const GAS float* lg = a.in(I_LBL);
    const GAS float* wgF = a.in(I_WGF) + l * 16 * 128; const GAS float* wgB = a.in(I_WGB) + l * 16 * 128; const GAS float* bgF = a.in(I_BGF) + l * 128; const GAS float* bgB = a.in(I_BGB) + l * 128;
    constexpr int NU = 32 * NCHUNK;
    const bool rebal = (MIX == 0) && (G == 256);
    const int n0 = (rebal && bid < 16) ? 8 : 0, nn = (NU - 1 - bid) / G + 1, n1 = nn + ((rebal && bid >= 128) ? 1 : 0);
    auto unit_at = [&](int n) { if (n >= n1) return NU; if (n < nn) return bid + G * n; const int e = bid - 128; return (e & 15) + G * (e >> 4); };
    RecPre<MIX> Rs[2];
    int nidx = n0;
    int u0 = unit_at(nidx), u1 = unit_at(nidx + 1);
#pragma unroll
    for (int par = 0; par < 2; ++par) { const int unit = par ? u1 : u0; if (unit < NU) { const int c = unit % NCHUNK, chain = unit / NCHUNK; rec_fetch<MIX, false>(Rs[par], P, RSb, chain >> 3, (chain >> 1) & 3, chain & 1, c, tid); } }
    BAR_LDS();
#pragma unroll 1
    while (u0 < NU) {
        const int n2 = unit_at(nidx + 2), n3 = unit_at(nidx + 3);
#pragma unroll
        for (int par = 0; par < 2; ++par) { const int unit = par ? u1 : u0; if (unit < NU) { RecPre<MIX>& R = Rs[par];
            LAS bf16* KTp = par ? (LAS bf16*)(lds + L_ST) : KT; LAS bf16* VTp = par ? (LAS bf16*)(lds + L_ATT) : VT;
            const int c = unit % NCHUNK, chain = unit / NCHUNK, dir = chain & 1, h = (chain >> 1) & 3;
            { float kv[CPT], cum[CPT]; rec_front<MIX>(R, lg, dir ? wgB : wgF, dir ? bgB : bgF, l, h, dir, wave, kv, cum);
#pragma unroll
                for (int e = 0; e < CPT; ++e) { const float last = lane_read(cum[e], 63); KTp[(CPT * wave + e) * 72 + lane] = (bf16)f2bf(kv[e] * __expf(last - cum[e]));
                    if (lane == 63) RAb[(size_t)(chain * NCHUNK + c) * DK + CPT * wave + e] = __expf(cum[e]); } }
            rec_vt_store(R.vp, VTp, tid);
            { const int nu = par ? n3 : n2; if (nu < NU) { const int c2 = nu % NCHUNK, ch2 = nu / NCHUNK; rec_fetch<MIX, false>(R, P, RSb, ch2 >> 3, (ch2 >> 1) & 3, ch2 & 1, c2, tid); } } } }
        BAR_LDS();
#pragma unroll
        for (int par = 0; par < 2; ++par) { const int unit = par ? u1 : u0; if (unit < NU) {
            const LAS bf16* KTp = par ? (const LAS bf16*)(lds + L_ST) : KT; const LAS bf16* VTp = par ? (const LAS bf16*)(lds + L_ATT) : VT;
            const int c = unit % NCHUNK, chain = unit / NCHUNK;
            GAS float* RS = RSb + (size_t)(chain * NCHUNK + c) * DK * 64;
#pragma unroll 1
            for (int tl = wave; tl < (DK / 16) * 4; tl += 8) { const int kb = tl >> 2, vb = tl & 3;
                const f32x4 acc = mma16(KTp + kb * 16 * 72, 72, VTp + vb * 16 * 72, 72, 64, lane);
#pragma unroll
                for (int j = 0; j < 4; ++j) RS[(kb * 16 + 4 * (lane >> 4) + j) * 64 + vb * 16 + (lane & 15)] = acc[j]; } } }
        BAR_LDS();
        nidx += 2; u0 = n2; u1 = n3;
    }
}

DI void rec_r2(const Ctx& a, int gtid, int gthreads) {
    GAS unsigned char* wsb = a.ws();
#pragma unroll 1
    for (int e = gtid; e < 32 * 4096 + 32 * 2048; e += gthreads) {
        const bool g = e >= 32 * 4096; const int ee = g ? e - 32 * 4096 : e; const int DK = g ? 32 : 64, per = DK * 64;
        const int chain = ee / per, kv = ee % per, k = kv >> 6;
        GAS float* RS = (GAS float*)(wsb + (g ? WS_RSG : WS_RSH)) + (size_t)chain * NCHUNK * per + kv;
        const GAS float* RA = (const GAS float*)(wsb + (g ? WS_RAG : WS_RAH)) + (size_t)chain * NCHUNK * DK + k;
        float S = 0.f;
#pragma unroll 1
        for (int c = 0; c < NCHUNK; c += 4) { float U[4], A[4];
#pragma unroll
            for (int u = 0; u < 4; ++u) { U[u] = RS[(size_t)(c + u) * per]; A[u] = RA[(c + u) * DK]; }
#pragma unroll
            for (int u = 0; u < 4; ++u) { RS[(size_t)(c + u) * per] = S; S = A[u] * S + U[u]; } }
    }
}

template <int MIX>
DI void rec_r3_run(const Ctx& a, int l, LAS unsigned char* lds, int tid, int bid, int G, bool keep_ctx) {
    constexpr int DK = RecCfg<MIX>::DK, DKP = RecCfg<MIX>::DKP, CPT = RecCfg<MIX>::CPT;
    const int lane = tid & 63, wave = __builtin_amdgcn_readfirstlane(tid >> 6);
    LAS bf16* QD = (LAS bf16*)(lds + L_QD); LAS bf16* QE = (LAS bf16*)(lds + L_QE); LAS bf16* KD = (LAS bf16*)(lds + L_KD);
    LAS bf16* VT = (LAS bf16*)(lds + L_VT); LAS bf16* ST = (LAS bf16*)(lds + L_ST); LAS bf16* ATT = (LAS bf16*)(lds + L_ATT); LAS float* Ob = (LAS float*)(lds + L_O);
    GAS unsigned char* wsb = a.ws(); const GAS bf16* P = (const GAS bf16*)(wsb + WS_P); GAS bf16* CAT = (GAS bf16*)(wsb + WS_CAT);
    const GAS float* RSb = (const GAS float*)(wsb + (MIX == 0 ? WS_RSH : WS_RSG));
    const GAS float* lg = a.in(I_LBL); const GAS float* ngb = a.in(MIX == 0 ? I_HNG : I_GNG) + l * 256;
    const GAS float* wgF = a.in(I_WGF) + l * 16 * 128; const GAS float* wgB = a.in(I_WGB) + l * 16 * 128; const GAS float* bgF = a.in(I_BGF) + l * 128; const GAS float* bgB = a.in(I_BGB) + l * 128;
    constexpr int nR = 16 * NCHUNK;
    const int nAct = keep_ctx ? nR : 16 * 64, first = (bid + (MIX == 0 ? 0 : G - 64)) % G;
    auto unit_of = [&](int a) { return a >= nAct ? nR : (keep_ctx ? a : (a >> 6) * NCHUNK + 4 + (a & 63)); };
    auto scanc = [&](int tc, int dir) { return dir == 0 ? tc : (tc < 4 ? 3 - tc : 71 - tc); };
    RecPre<MIX> Rs[2];
    int aidx = first;
    int unit = unit_of(aidx);
    if (unit < nR) { const int tc = unit % NCHUNK, bh = unit / NCHUNK; rec_fetch<MIX, true>(Rs[0], P, RSb, bh >> 2, bh & 3, 0, scanc(tc, 0), tid); rec_fetch<MIX, true>(Rs[1], P, RSb, bh >> 2, bh & 3, 1, scanc(tc, 1), tid); }
    BAR_LDS();
#pragma unroll 1
    while (unit < nR) {
        const int tc = unit % NCHUNK, bh = unit / NCHUNK, h = bh & 3, b = bh >> 2;
        const int nunit = unit_of(aidx + G);
        v4u gatep = (v4u){0u, 0u, 0u, 0u};
#pragma unroll
        for (int dir = 0; dir < 2; ++dir) { RecPre<MIX>& R = Rs[dir];
            if (tid < DK * 8) { const int k = tid >> 3, v8 = tid & 7;
#pragma unroll
                for (int e = 0; e < 4; ++e) { ST[(v8 * 8 + e) * DKP + k] = (bf16)f2bf(R.s0[e]); ST[(v8 * 8 + 4 + e) * DKP + k] = (bf16)f2bf(R.s1[e]); } }
            rec_vt_store(R.vp, VT, tid);
            { const int ri = lane, I = ri >> 4; float kv[CPT], cm[CPT], qv[CPT], e8[CPT];
                rec_front<MIX>(R, lg, dir ? wgB : wgF, dir ? bgB : bgF, l, h, dir, wave, kv, cm);
                { float q8[8]; unpack8(R.qp, q8);
#pragma unroll
                    for (int e = 0; e < CPT; ++e) qv[e] = MIX == 0 ? silu_(q8[e]) * 0.125f : q8[e] * 0.17677669529663687f; }
#pragma unroll
                for (int e = 0; e < CPT; ++e) e8[e] = qv[e] * __expf(cm[e]);
                st_bf16<CPT>(QE + ri * DKP + CPT * wave, e8);
#pragma unroll
                for (int I2 = 0; I2 < 4; ++I2) {
                    float rf[CPT];
#pragma unroll
                    for (int e = 0; e < CPT; ++e) rf[e] = I2 == 0 ? 0.f : lane_read(cm[e], 16 * I2 - 1);
                    if (I2 >= I) {
                        if (I2 == I) {
#pragma unroll
                            for (int e = 0; e < CPT; ++e) e8[e] = qv[e] * __expf(cm[e] - rf[e]);
                            st_bf16<CPT>(QD + ri * DKP + CPT * wave, e8); }
#pragma unroll
                        for (int e = 0; e < CPT; ++e) e8[e] = kv[e] * __expf(fminf(rf[e] - cm[e], 80.f));
                        const int rowbase = I2 == 0 ? 0 : (I2 == 1 ? 16 : (I2 == 2 ? 48 : 96));
                        st_bf16<CPT>(KD + (rowbase + ri) * DKP + CPT * wave, e8); } } }
            if (dir == 0) {
                const int row = (tc < 4 ? b * 256 + tc * 64 : NCTX + b * SEQ + (tc - 4) * 64) + (tid >> 3);
                gatep = *(const GAS v4u*)(P + (size_t)row * PP + (MIX == 0 ? CA_G : CC_G) + h * 64 + (tid & 7) * 8); }
            if (nunit < nR) { const int tc2 = nunit % NCHUNK, bh2 = nunit / NCHUNK; rec_fetch<MIX, true>(R, P, RSb, bh2 >> 2, bh2 & 3, dir, scanc(tc2, dir), tid); }
            BAR_LDS();
            { const int I = wave >> 1, g = lane >> 4, c16 = lane & 15;
                const int rowbase = I == 0 ? 0 : (I == 1 ? 16 : (I == 2 ? 48 : 96));
                bf16x8 Bq[2];
#pragma unroll
                for (int m = 0; m < 2; ++m) {
                    f32x4 t0 = mma16(KD + (rowbase + 2 * m * 16) * DKP, DKP, QD + I * 16 * DKP, DKP, DK, lane);
                    f32x4 t1 = mma16(KD + (rowbase + (2 * m + 1) * 16) * DKP, DKP, QD + I * 16 * DKP, DKP, DK, lane);
#pragma unroll
                    for (int jj = 0; jj < 4; ++jj) { const bool up = 4 * g + jj > c16;
                        t0[jj] = (2 * m > I || (2 * m == I && up)) ? 0.f : t0[jj]; t1[jj] = (2 * m + 1 > I || (2 * m + 1 == I && up)) ? 0.f : t1[jj]; }
                    Bq[m] = pack8(t0[0], t0[1], t0[2], t0[3], t1[0], t1[1], t1[2], t1[3]); }
#pragma unroll
                for (int u = 0; u < 2; ++u) { const int vb = 2 * (wave & 1) + u; f32x4 acc = {0.f, 0.f, 0.f, 0.f};
#pragma unroll
                    for (int m = 0; m < 2; ++m) { const LAS bf16* vr = VT + (vb * 16 + c16) * 72 + 32 * m + 4 * g;
                        const v2u lo = *(const LAS v2u*)vr, hi = *(const LAS v2u*)(vr + 16);
                        acc = __builtin_amdgcn_mfma_f32_16x16x32_bf16(__builtin_bit_cast(bf16x8, (v4u){lo.x, lo.y, hi.x, hi.y}), Bq[m], acc, 0, 0, 0); }
                    const f32x4 acc2 = mma16(ST + vb * 16 * DKP, DKP, QE + I * 16 * DKP, DKP, DK, lane);
#pragma unroll
                    for (int jj = 0; jj < 4; ++jj) { const int i = I * 16 + c16, v = vb * 16 + 4 * g + jj; const float o = acc[jj] + acc2[jj];
                        if (dir == 0) Ob[i * RP + v] = o; else Ob[(63 - i) * RP + v] += o; } } }
            BAR_LDS();
        }
        { const int tl = tid >> 3, jg = tid & 7; float x[8]; float ss = 0.f;
#pragma unroll
            for (int vv = 0; vv < 8; ++vv) { x[vv] = Ob[tl * RP + jg * 8 + vv]; ss += x[vv] * x[vv]; }
            ss += __shfl_xor(ss, 1); ss += __shfl_xor(ss, 2); ss += __shfl_xor(ss, 4);
            const float rstd = rsqrtf(ss * (1.f / 64.f) + EPS);
            const int row = tc < 4 ? b * 256 + tc * 64 + tl : NCTX + b * SEQ + (tc - 4) * 64 + tl;
            const GAS float* ng = ngb + h * 64 + jg * 8;
            float gt[8]; unpack8(gatep, gt);
            float y[8];
#pragma unroll
            for (int vv = 0; vv < 8; ++vv) y[vv] = x[vv] * rstd * ng[vv] * silu_(gt[vv]);
            v4u ow; ow.x = pk2(y[0], y[1]); ow.y = pk2(y[2], y[3]); ow.z = pk2(y[4], y[5]); ow.w = pk2(y[6], y[7]);
            *(GAS v4u*)(CAT + (size_t)row * D + (MIX == 0 ? 0 : 512) + h * 64 + jg * 8) = ow; }
        unit = nunit; aidx += G;
    }
    __syncthreads();
}

typedef float f32x16 __attribute__((ext_vector_type(16)));
DI int swap23(int r) { return (r & 19) | ((r & 4) << 1) | ((r & 8) >> 1); }
struct AttnDesc {
    const GAS bf16* q; int qpitch;
    const GAS bf16* k; int kpitch;
    const GAS bf16* vt;
    GAS bf16* o; int opitch;
    int ntiles; float scale;
    int b, r0, rs0;
    const LAS float* rpb;
};
template <int DQK, bool NA>
DI void attn_mfma_unit(LAS unsigned char* lds, const AttnDesc& A, int tid, int lane, int wave) {
    constexpr int KP = DQK + 8, VP = 72, NS = DQK / 16, KPIECES = 64 * (DQK / 8);
    constexpr int BUF = 64 * KP * 2 + 64 * VP * 2;
    const int q = lane & 31, g = lane >> 5;
    auto tpos = [&](int t) { return NA ? (t < 4 ? 64 * t : 256 + 64 * (A.rs0 + t - 4)) : 64 * t; };
    auto krow = [&](int pos) { return NA ? (pos < 256 ? A.b * 256 + pos : NCTX + A.b * SEQ + (pos - 256)) : pos; };
    const int qi = NA ? (2 * (wave >> 2) + (q >> 4)) * 64 + 16 * (wave & 3) + (q & 15) : wave * 32 + q;
    const int kc0 = NA ? min(max(16 * (wave & 3) - 8, 0), 32) : 0;
    bf16x8 Qf[NS];
    { const GAS bf16* qp = A.q + (size_t)qi * A.qpitch + 8 * g;
#pragma unroll
        for (int s2 = 0; s2 < NS; ++s2) Qf[s2] = *(const GAS bf16x8*)(qp + 16 * s2); }
    f32x16 O[2];
#pragma unroll
    for (int db = 0; db < 2; ++db)
#pragma unroll
        for (int i = 0; i < 16; ++i) O[db][i] = 0.f;
    float mrun = -1e30f, lrun = 0.f;
    const int qr = NA ? A.r0 + (qi >> 6) : 0, qc = NA ? (qi & 63) : 0;
    const int wrs = NA ? min(max(qr - 4, 0), 56) : 0, cs = NA ? min(max(qc - 8, 0), 48) : 0;
    const int qr0 = NA ? A.r0 + 2 * (wave >> 2) : 0, wlo = NA ? min(max(qr0 - 4, 0), 56) : 0, whi = NA ? min(max(qr0 + 1 - 4, 0), 56) + 8 : 0;
    v4u kreg[2], vreg;
    auto gload = [&](int t) { const int pos = tpos(t);
#pragma unroll
        for (int u = 0; u < 2; ++u) { const int p = tid + 512 * u; if (p < KPIECES) { const int key = p / (DQK / 8), d8 = p % (DQK / 8); kreg[u] = *(const GAS v4u*)(A.k + (size_t)krow(pos + key) * A.kpitch + d8 * 8); } }
        vreg = *(const GAS v4u*)(A.vt + (size_t)(tid >> 3) * NKEY + pos + (tid & 7) * 8); };
    auto lstore = [&](int buf) { LAS bf16* Kt = (LAS bf16*)(lds + buf * BUF); LAS bf16* Vt = Kt + 64 * KP;
#pragma unroll
        for (int u = 0; u < 2; ++u) { const int p = tid + 512 * u; if (p < KPIECES) { const int key = p / (DQK / 8), d8 = p % (DQK / 8); *(LAS v4u*)(Kt + key * KP + d8 * 8) = kreg[u]; } }
        *(LAS v4u*)(Vt + (tid >> 3) * VP + (tid & 7) * 8) = vreg; };
    __syncthreads();
    gload(0); lstore(0);
    __syncthreads();
#pragma unroll 1
    for (int t = 0; t < A.ntiles; ++t) {
        const bool more = t + 1 < A.ntiles;
        if (more) gload(t + 1);
        bool active = true, rowok = true; int dr = 0;
        const bool win = NA && t >= 4;
        if (win) { const int wr = A.rs0 + t - 4; active = (wr >= wlo) && (wr < whi); rowok = (wr >= wrs) && (wr < wrs + 8); dr = min(max(wr - qr + 7, 0), 14); }
        if (active) {
            const LAS bf16* Kt = (const LAS bf16*)(lds + (t & 1) * BUF); const LAS bf16* Vt = Kt + 64 * KP;
            f32x16 S[2];
#pragma unroll
            for (int kb = 0; kb < 2; ++kb) {
#pragma unroll
                for (int i = 0; i < 16; ++i) S[kb][i] = 0.f;
                if (win && kb == 1) continue;
                const LAS bf16* kp = Kt + ((win ? kc0 : kb * 32) + swap23(q)) * KP + 8 * g;
#pragma unroll
                for (int s2 = 0; s2 < NS; ++s2) { const bf16x8 a = *(const LAS bf16x8*)(kp + 16 * s2); S[kb] = __builtin_amdgcn_mfma_f32_32x32x16_bf16(a, Qf[s2], S[kb], 0, 0, 0); }
            }
            float mx = -INFINITY;
            if (NA) {
                if (win) {
#pragma unroll
                    for (int i = 0; i < 16; ++i) { const int kc = kc0 + 16 * (i >> 3) + 8 * g + (i & 7); const int dc = min(max(kc - qc, -15), 15) + 15;
                        const float bv = A.rpb[dr * 31 + dc]; const float sv = (rowok && kc >= cs && kc < cs + 16) ? S[0][i] * A.scale + bv : -INFINITY;
                        S[0][i] = sv; mx = fmaxf(mx, sv); }
                } else {
#pragma unroll
                    for (int kb = 0; kb < 2; ++kb)
#pragma unroll
                        for (int i = 0; i < 16; ++i) { const float sv = S[kb][i] * A.scale; S[kb][i] = sv; mx = fmaxf(mx, sv); }
                }
            } else {
#pragma unroll
                for (int kb = 0; kb < 2; ++kb)
#pragma unroll
                    for (int i = 0; i < 16; ++i) mx = fmaxf(mx, S[kb][i]);
            }
            mx = fmaxf(mx, __shfl_xor(mx, 32));
            const float mn = fmaxf(mrun, mx), alpha = __builtin_amdgcn_exp2f(mrun - mn);
            mrun = mn;
            if (__any(alpha != 1.f)) { lrun *= alpha;
#pragma unroll
                for (int db = 0; db < 2; ++db)
#pragma unroll
                    for (int i = 0; i < 16; ++i) O[db][i] *= alpha; }
            bf16x8 Pf[4];
#pragma unroll
            for (int ks = 0; ks < 4; ++ks) { if (win && ks >= 2) continue; const int kb = ks >> 1, o8 = (ks & 1) * 8; float p[8];
#pragma unroll
                for (int j = 0; j < 8; ++j) { p[j] = __builtin_amdgcn_exp2f(S[kb][o8 + j] - mn); lrun += p[j]; }
                Pf[ks] = pack8(p[0], p[1], p[2], p[3], p[4], p[5], p[6], p[7]); }
#pragma unroll
            for (int db = 0; db < 2; ++db) { const LAS bf16* vp = Vt + (db * 32 + q) * VP + (win ? kc0 : 0) + 8 * g;
#pragma unroll
                for (int ks = 0; ks < 4; ++ks) { if (win && ks >= 2) continue; const bf16x8 a = *(const LAS bf16x8*)(vp + 16 * ks); O[db] = __builtin_amdgcn_mfma_f32_32x32x16_bf16(a, Pf[ks], O[db], 0, 0, 0); } }
        }
        if (more) lstore((t + 1) & 1);
        __syncthreads();
    }
    const float ltot = lrun + __shfl_xor(lrun, 32), inv = 1.f / ltot;
    GAS bf16* op = A.o + (size_t)qi * A.opitch + 4 * g;
#pragma unroll
    for (int db = 0; db < 2; ++db)
#pragma unroll
        for (int i4 = 0; i4 < 4; ++i4) { v2u w; w.x = pk2(O[db][4 * i4] * inv, O[db][4 * i4 + 1] * inv); w.y = pk2(O[db][4 * i4 + 2] * inv, O[db][4 * i4 + 3] * inv); *(GAS v2u*)(op + 32 * db + 8 * i4) = w; }
}

constexpr float MLA_TH = 8.f;
constexpr int NA_SLOT = 2 * 64 * 72 * 2, NA_RPB = 4 * NA_SLOT;
DI void na_unit(LAS unsigned char* lds, const AttnDesc& A, const GAS float* rp, int tid, int lane, int wave) {
    constexpr int KP = 72, VP = 72, NS = 4, KBUF = 64 * KP * 2;
    const int q = lane & 31, g = lane >> 5, NT = A.ntiles;
    auto tpos = [&](int t) { return t < 4 ? 64 * t : 256 + 64 * (A.rs0 + t - 4); };
    auto krow = [&](int pos) { return pos < 256 ? A.b * 256 + pos : NCTX + A.b * SEQ + (pos - 256); };
    const int qi = (2 * (wave >> 2) + (q >> 4)) * 64 + 16 * (wave & 3) + (q & 15);
    const int kc0 = min(max(16 * (wave & 3) - 8, 0), 32);
    bf16x8 Qf[NS];
    { const GAS bf16* qp = A.q + (size_t)qi * A.qpitch + 8 * g;
#pragma unroll
        for (int s2 = 0; s2 < NS; ++s2) Qf[s2] = *(const GAS bf16x8*)(qp + 16 * s2); }
    f32x16 O[2];
#pragma unroll
    for (int db = 0; db < 2; ++db)
#pragma unroll
        for (int i = 0; i < 16; ++i) O[db][i] = 0.f;
    float mrun = -1e30f, lrun = 0.f;
    const int qr = A.r0 + (qi >> 6), qc = qi & 63;
    const int wrs = min(max(qr - 4, 0), 56), cs = min(max(qc - 8, 0), 48);
    const int qr0 = A.r0 + 2 * (wave >> 2), wlo = min(max(qr0 - 4, 0), 56), whi = min(max(qr0 + 1 - 4, 0), 56) + 8;
    auto koffs = [&](int i) { const int j = i * 64 + lane, row = j / 9, pc = min(j % 9, 7); return (unsigned)(row * (PP * 2) + pc * 16); };
    auto voffs = [&](int i) { const int j = i * 64 + lane, row = j / 9, pc = min(j % 9, 7); return (unsigned)(row * (NKEY * 2) + pc * 16); };
    const int iv1 = wave == 0 ? 0 : wave - 1, iv2 = wave < 2 ? 7 + wave : iv1;
    const unsigned goff0 = koffs(wave), goff1 = wave == 0 ? koffs(8) : voffs(iv1), goff2 = voffs(iv2);
    auto dma = [&](int t, int slot) __attribute__((always_inline)) { const int pos = tpos(t);
        const GAS unsigned char* kb = (const GAS unsigned char*)(A.k + (size_t)krow(pos) * A.kpitch); const GAS unsigned char* vb = (const GAS unsigned char*)(A.vt + pos);
        LAS unsigned char* kl = lds + slot * NA_SLOT; LAS unsigned char* vl = kl + KBUF;
        __builtin_amdgcn_global_load_lds((const GAS unsigned*)(kb + goff0), (LAS unsigned*)(kl + wave * 1024), 16, 0, 0);
        __builtin_amdgcn_global_load_lds((const GAS unsigned*)((wave == 0 ? kb : vb) + goff1), (LAS unsigned*)(wave == 0 ? kl + 8 * 1024 : vl + iv1 * 1024), 16, 0, 0);
        __builtin_amdgcn_global_load_lds((const GAS unsigned*)(vb + goff2), (LAS unsigned*)(vl + iv2 * 1024), 16, 0, 0);
    };
    LAS float* T = (LAS float*)(lds + NA_RPB);
    float tv[4];
#pragma unroll
    for (int u = 0; u < 4; ++u) { const int e = tid + 512 * u, r = e >> 7, dcr = (e & 127) - 64; const bool in = r < 15 && dcr >= -15 && dcr <= 15;
        tv[u] = in ? rp[r * 31 + dcr + 15] * LOG2E : (r == 15 ? -INFINITY : 0.f); }
    float mcol[16];
#pragma unroll
    for (int i = 0; i < 16; ++i) { const int kc = kc0 + 16 * (i >> 3) + 8 * g + (i & 7); mcol[i] = (kc >= cs && kc < cs + 16) ? 0.f : -INFINITY; }
    __syncthreads();
    dma(0, 0); dma(min(1, NT - 1), 1); dma(min(2, NT - 1), 2);
#pragma unroll
    for (int u = 0; u < 4; ++u) T[tid + 512 * u] = tv[u];
    asm volatile("s_waitcnt vmcnt(6)\n\ts_waitcnt lgkmcnt(0)\n\ts_barrier" ::: "memory");
#pragma unroll 1
    for (int t = 0; t < NT; ++t) {
        dma(min(t + 3, NT - 1), (t + 3) & 3);
        bool active = true, rowok = true; int dr = 0;
        const bool win = t >= 4;
        if (win) { const int wr = A.rs0 + t - 4; active = (wr >= wlo) && (wr < whi); rowok = (wr >= wrs) && (wr < wrs + 8); dr = min(max(wr - qr + 7, 0), 14); }
        if (active) {
            const LAS bf16* Kt = (const LAS bf16*)(lds + (t & 3) * NA_SLOT); const LAS bf16* Vt = Kt + 64 * KP;
            f32x16 S[2];
#pragma unroll
            for (int kb = 0; kb < 2; ++kb) {
#pragma unroll
                for (int i = 0; i < 16; ++i) S[kb][i] = 0.f;
                if (win && kb == 1) continue;
                const LAS bf16* kp = Kt + ((win ? kc0 : kb * 32) + swap23(q)) * KP + 8 * g;
#pragma unroll
                for (int s2 = 0; s2 < NS; ++s2) { const bf16x8 a = *(const LAS bf16x8*)(kp + 16 * s2); S[kb] = __builtin_amdgcn_mfma_f32_32x32x16_bf16(a, Qf[s2], S[kb], 0, 0, 0); }
            }
            float mx = -INFINITY;
            if (win) { const LAS float* tb = T + (rowok ? dr : 15) * 128 + (kc0 + 8 * g - qc + 64);
#pragma unroll
                for (int i = 0; i < 16; ++i) { const float sv = (S[0][i] * A.scale + tb[16 * (i >> 3) + (i & 7)]) + mcol[i]; S[0][i] = sv; mx = fmaxf(mx, sv); }
            } else {
#pragma unroll
                for (int kb = 0; kb < 2; ++kb)
#pragma unroll
                    for (int i = 0; i < 16; ++i) { const float sv = S[kb][i] * A.scale; S[kb][i] = sv; mx = fmaxf(mx, sv); }
            }
            if (__any(mx > mrun + MLA_TH)) { const float mf = fmaxf(mx, __shfl_xor(mx, 32)), mn = fmaxf(mrun, mf), alpha = __builtin_amdgcn_exp2f(mrun - mn);
                mrun = mn; lrun *= alpha;
#pragma unroll
                for (int db = 0; db < 2; ++db)
#pragma unroll
                    for (int i = 0; i < 16; ++i) O[db][i] *= alpha; }
            bf16x8 Pf[4];
#pragma unroll
            for (int ks = 0; ks < 4; ++ks) { if (win && ks >= 2) continue; const int kb = ks >> 1, o8 = (ks & 1) * 8; float p[8];
#pragma unroll
                for (int j = 0; j < 8; ++j) { p[j] = __builtin_amdgcn_exp2f(S[kb][o8 + j] - mrun); lrun += p[j]; }
                Pf[ks] = pack8(p[0], p[1], p[2], p[3], p[4], p[5], p[6], p[7]); }
#pragma unroll
            for (int db = 0; db < 2; ++db) { const LAS bf16* vp = Vt + (db * 32 + q) * VP + (win ? kc0 : 0) + 8 * g;
#pragma unroll
                for (int ks = 0; ks < 4; ++ks) { if (win && ks >= 2) continue; const bf16x8 a = *(const LAS bf16x8*)(vp + 16 * ks); O[db] = __builtin_amdgcn_mfma_f32_32x32x16_bf16(a, Pf[ks], O[db], 0, 0, 0); } }
        }
        asm volatile("s_waitcnt vmcnt(6)\n\ts_waitcnt lgkmcnt(0)\n\ts_barrier" ::: "memory");
    }
    asm volatile("s_waitcnt vmcnt(0)" ::: "memory");
    const float ltot = lrun + __shfl_xor(lrun, 32), inv = 1.f / ltot;
    GAS bf16* op = A.o + (size_t)qi * A.opitch + 4 * g;
#pragma unroll
    for (int db = 0; db < 2; ++db)
#pragma unroll
        for (int i4 = 0; i4 < 4; ++i4) { v2u w; w.x = pk2(O[db][4 * i4] * inv, O[db][4 * i4 + 1] * inv); w.y = pk2(O[db][4 * i4 + 2] * inv, O[db][4 * i4 + 3] * inv); *(GAS v2u*)(op + 32 * db + 8 * i4) = w; }
}

struct TagF { static constexpr bool value = false; }; struct TagT { static constexpr bool value = true; };
#define SGB(mask, n) __builtin_amdgcn_sched_group_barrier(mask, n, 0)
DI void mla_unit(LAS unsigned char* lds, const AttnDesc& A, int tid, int lane, int wave) {
    constexpr int KP = 104, VP = 72, NS = 6, KBUF = 64 * KP * 2, VBUF = 64 * VP * 2;
    const int q = lane & 31, g = lane >> 5, NT = A.ntiles;
    bf16x8 Qf[NS];
    { const GAS bf16* qp = A.q + (size_t)(wave * 32 + q) * A.qpitch + 8 * g;
#pragma unroll
        for (int s2 = 0; s2 < NS; ++s2) Qf[s2] = *(const GAS bf16x8*)(qp + 16 * s2); }
    f32x16 O[2], Cm;
#pragma unroll
    for (int i = 0; i < 16; ++i) { O[0][i] = 0.f; O[1][i] = 0.f; Cm[i] = 0.f; }
    float lrun = 0.f;
    auto koffs = [&](int i) { const int j = i * 64 + lane, row = j / 13, pc = min(j % 13, 11); return (unsigned)(row * 192 + pc * 16); };
    auto voffs = [&](int i) { const int j = i * 64 + lane, row = j / 9, pc = min(j % 9, 7); return (unsigned)(row * (NKEY * 2) + pc * 16); };
    const int i2 = min(wave + 3, 8);
    const unsigned goff0 = koffs(wave), goff1 = wave < 5 ? koffs(wave + 8) : voffs(wave - 5), goff2 = voffs(i2);
    auto dma = [&](int tk, int ks, int tv, int vs) __attribute__((always_inline)) {
        const GAS unsigned char* kb = (const GAS unsigned char*)A.k + (size_t)tk * (64 * 96 * 2); const GAS unsigned char* vb = (const GAS unsigned char*)A.vt + (size_t)tv * 128;
        LAS unsigned char* kl = lds + ks * KBUF; LAS unsigned char* vl = lds + 2 * KBUF + vs * VBUF;
        __builtin_amdgcn_global_load_lds((const GAS unsigned*)(kb + goff0), (LAS unsigned*)(kl + wave * 1024), 16, 0, 0);
        __builtin_amdgcn_global_load_lds((const GAS unsigned*)((wave < 5 ? kb : vb) + goff1), (LAS unsigned*)(wave < 5 ? kl + (wave + 8) * 1024 : vl + (wave - 5) * 1024), 16, 0, 0);
        __builtin_amdgcn_global_load_lds((const GAS unsigned*)(vb + goff2), (LAS unsigned*)(vl + i2 * 1024), 16, 0, 0);
    };
    auto qk = [&](f32x16& S0, f32x16& S1, int buf) __attribute__((always_inline)) {
        const LAS bf16* kp = (const LAS bf16*)(lds + buf * KBUF) + swap23(q) * KP + 8 * g;
        S0 = __builtin_amdgcn_mfma_f32_32x32x16_bf16(*(const LAS bf16x8*)kp, Qf[0], Cm, 0, 0, 0);
#pragma unroll
        for (int s2 = 1; s2 < NS; ++s2) S0 = __builtin_amdgcn_mfma_f32_32x32x16_bf16(*(const LAS bf16x8*)(kp + 16 * s2), Qf[s2], S0, 0, 0, 0);
        S1 = __builtin_amdgcn_mfma_f32_32x32x16_bf16(*(const LAS bf16x8*)(kp + 32 * KP), Qf[0], Cm, 0, 0, 0);
#pragma unroll
        for (int s2 = 1; s2 < NS; ++s2) S1 = __builtin_amdgcn_mfma_f32_32x32x16_bf16(*(const LAS bf16x8*)(kp + 32 * KP + 16 * s2), Qf[s2], S1, 0, 0, 0);
    };
    auto smax = [&](const f32x16& S0, const f32x16& S1) __attribute__((always_inline)) { float mx = fmaxf(S0[0], S0[1]);
#pragma unroll
        for (int i = 2; i < 16; ++i) mx = fmaxf(mx, S0[i]);
#pragma unroll
        for (int i = 0; i < 16; ++i) mx = fmaxf(mx, S1[i]);
        return mx; };
    auto rebase = [&](f32x16& S0, f32x16& S1, float mx) __attribute__((always_inline)) {
        const float mf = fmaxf(mx, __shfl_xor(mx, 32)), d = fmaxf(mf, 0.f), alpha = __builtin_amdgcn_exp2f(-d);
        lrun *= alpha;
#pragma unroll
        for (int i = 0; i < 16; ++i) { O[0][i] *= alpha; O[1][i] *= alpha; S0[i] -= d; S1[i] -= d; Cm[i] -= d; }
        asm volatile("" : "+v"(Cm));
    };
    auto softmax_p = [&](const f32x16& S0, const f32x16& S1, bf16x8 (&Pf)[4]) __attribute__((always_inline)) {
#pragma unroll
        for (int ks = 0; ks < 4; ++ks) { const int o8 = (ks & 1) * 8; float p[8];
#pragma unroll
            for (int j = 0; j < 8; ++j) { p[j] = __builtin_amdgcn_exp2f(ks < 2 ? S0[o8 + j] : S1[o8 + j]); lrun += p[j]; }
            Pf[ks] = pack8(p[0], p[1], p[2], p[3], p[4], p[5], p[6], p[7]); }
    };
    auto pv = [&](const bf16x8 (&Pf)[4], int buf) __attribute__((always_inline)) {
        const LAS bf16* vp = (const LAS bf16*)(lds + 2 * KBUF + buf * VBUF) + q * VP + 8 * g;
#pragma unroll
        for (int ks = 0; ks < 4; ++ks)
#pragma unroll
            for (int db = 0; db < 2; ++db) O[db] = __builtin_amdgcn_mfma_f32_32x32x16_bf16(*(const LAS bf16x8*)(vp + db * 32 * VP + 16 * ks), Pf[ks], O[db], 0, 0, 0);
    };
    f32x16 Sa[2], Sb[2];
    __syncthreads();
    dma(0, 0, 0, 0); dma(1, 1, 0, 0);
    asm volatile("s_waitcnt vmcnt(0)" ::: "memory");
    __syncthreads();
    qk(Sa[0], Sa[1], 0);
    { const float mx = smax(Sa[0], Sa[1]); const float mf = fmaxf(mx, __shfl_xor(mx, 32));
#pragma unroll
        for (int i = 0; i < 16; ++i) { Sa[0][i] -= mf; Sa[1][i] -= mf; Cm[i] = -mf; }
        asm volatile("" : "+v"(Cm)); }
    __syncthreads();
    auto step = [&](f32x16 (&Sc)[2], f32x16 (&Sn)[2], const int t, auto par) __attribute__((always_inline)) {
        constexpr int PAR = decltype(par)::value ? 1 : 0;
        dma(min(t + 2, NT - 1), PAR, min(t + 1, NT - 1), PAR ^ 1);
        __builtin_amdgcn_sched_barrier(0);
        bf16x8 Pf[4];
        qk(Sn[0], Sn[1], PAR ^ 1);
        softmax_p(Sc[0], Sc[1], Pf);
        pv(Pf, PAR);
        const float mx = smax(Sn[0], Sn[1]);
        SGB(0x100, 3);
#pragma unroll
        for (int m = 0; m < 16; ++m) { SGB(0x008, 1); SGB(0x100, 1); SGB(0x400, 2); SGB(0x002, 3); }
#pragma unroll
        for (int m = 0; m < 4; ++m) { SGB(0x008, 1); SGB(0x100, 1); SGB(0x002, 5); }
        if (__any(mx > MLA_TH)) rebase(Sn[0], Sn[1], mx);
        asm volatile("s_waitcnt vmcnt(0)" ::: "memory");
        __syncthreads();
    };
#pragma unroll 1
    for (int t = 0; t < NT - 2; t += 2) { step(Sa, Sb, t, TagF{}); step(Sb, Sa, t + 1, TagT{}); }
    step(Sa, Sb, NT - 2, TagF{});
    { bf16x8 Pf[4]; softmax_p(Sb[0], Sb[1], Pf); pv(Pf, (NT - 1) & 1); }
    const float ltot = lrun + __shfl_xor(lrun, 32), inv = 1.f / ltot;
    GAS bf16* op = A.o + (size_t)(wave * 32 + q) * A.opitch + 4 * g;
#pragma unroll
    for (int db = 0; db < 2; ++db)
#pragma unroll
        for (int i4 = 0; i4 < 4; ++i4) { v2u w; w.x = pk2(O[db][4 * i4] * inv, O[db][4 * i4 + 1] * inv); w.y = pk2(O[db][4 * i4 + 2] * inv, O[db][4 * i4 + 3] * inv); *(GAS v2u*)(op + 32 * db + 8 * i4) = w; }
}

DI int moe_tables(const GAS unsigned* cnt  , LAS int* off, LAS int* tile_e, int tid) {
    if (tid == 0) { int o = 0; for (int e = 0; e < 32; ++e) { off[e] = o; o += ((int)cnt[e * 64] + 255) & ~255; } off[32] = o; }
    __syncthreads();
    if (tid < MOE_MAXT) { const int r = tid * 256; int ex = 0; for (int e = 0; e < 32; ++e) if (r >= off[e + 1]) ex = e + 1; tile_e[tid] = ex < 32 ? ex : 31; }
    __syncthreads();
    return off[32] >> 8;
}

#define TIDS const int tid = threadIdx.x, lane = tid & 63, wave = __builtin_amdgcn_readfirstlane(tid >> 6), bid = blockIdx.x, G = gridDim.x, gw = bid * 8 + wave, NGW = G * 8; (void)lane; (void)gw; (void)NGW
DI void ph_gemm_in(const Ctx& cx, int l) {
    TIDS; GAS unsigned char* ws = cx.ws(); LAS unsigned char* lds = (LAS unsigned char*)lds_raw;
    pg8::Gemm g{(const GAS bf16*)(ws + WS_H), (const GAS bf16*)(ws + WS_WTIN + (size_t)l * WTIN_L), MTOK, PP, D}; pg8::StaticOrder S; S.init(MTOK, PP, G, bid);
    pg8::EpiStoreBf16 E{(GAS bf16*)(ws + WS_P), PP};
    pg8::gemm_phase(lds, g, S, E);
    if (l == 0) { const int ntile = (MTOK / 256) * (PP / 256), nlast = ntile % G;
        if (nlast > 0 && bid >= nlast) { __syncthreads(); weight_copies(cx, 0, lds, tid, lane, wave, (bid - nlast) * 8 + wave, (G - nlast) * 8, (bid - nlast) * 512 + tid, (G - nlast) * 512, 2); }
        else if (nlast == 0) { __syncthreads(); weight_copies(cx, 0, lds, tid, lane, wave, bid * 8 + wave, G * 8, bid * 512 + tid, G * 512, 2); } }
}
DI void ph_prep_r1(const Ctx& cx, int l) {
    TIDS; LAS unsigned char* lds = (LAS unsigned char*)lds_raw;
#pragma unroll 1
    for (int u = bid; u < MTOK / PR; u += G) prep_unit(cx, l, u, lds, tid, lane, wave);
    __syncthreads();
    rec_r1_run<0>(cx, l, lds, tid, bid, G); rec_r1_run<1>(cx, l, lds, tid, bid, G);
    __syncthreads();
}
DI void ph_mixers(const Ctx& cx, int l) {
    TIDS; GAS unsigned char* ws = cx.ws(); LAS unsigned char* lds = (LAS unsigned char*)lds_raw;
    const bool keep_ctx = (l == 0);
    GAS bf16* CAT = (GAS bf16*)(ws + WS_CAT); const GAS bf16* P = (const GAS bf16*)(ws + WS_P);
    const int nATT = 256 + (keep_ctx ? 16 : 0), nR = 16 * NCHUNK;
    const int vc = (G % 8 == 0) ? (bid % 8) * (G / 8) + bid / 8 : bid;
    const bool r3first = ((bid >> 3) & 1) != 0;
    if (r3first) { rec_r3_run<0>(cx, l, lds, tid, bid, G, keep_ctx); rec_r3_run<1>(cx, l, lds, tid, bid, G, keep_ctx); __syncthreads(); }
#pragma unroll 1
    for (int it = 0; it < 2; ++it) { const int u = it == 0 ? vc : (G == 256 && bid >= 128 && bid < 144 ? 256 + bid - 128 : (G == 256 ? nATT : bid + G)); if (u >= nATT) continue;
        const GAS bf16* QM = (const GAS bf16*)(ws + WS_QM); const GAS bf16* KM = (const GAS bf16*)(ws + WS_KM); const GAS bf16* VM = (const GAS bf16*)(ws + WS_VM);
        AttnDesc A{}; int bh, b, h;
        if (u < 256) { bh = u >> 4; b = bh >> 2; h = bh & 3; const int qb = u & 15; A.q = QM + ((size_t)bh * NKEY + 256 + qb * 256) * 96; A.ntiles = NKEY / 64; A.o = CAT + (size_t)(NCTX + b * SEQ + qb * 256) * D + 768 + h * 64; }
        else { bh = u - 256; b = bh >> 2; h = bh & 3; A.q = QM + (size_t)bh * NKEY * 96; A.ntiles = 4; A.o = CAT + (size_t)(b * 256) * D + 768 + h * 64; }
        A.qpitch = 96; A.k = KM + (size_t)bh * NKEY * 96; A.kpitch = 96; A.vt = VM + (size_t)bh * 64 * NKEY; A.opitch = D; A.scale = 1.f;
        mla_unit(lds, A, tid, lane, wave);
    }
#pragma unroll 1
    for (int it = 0; it < 2; ++it) { const int u = it == 0 ? vc : (G == 256 && bid >= 160 && bid < 176 ? 256 + bid - 160 : (G == 256 ? nATT : bid + G)); if (u >= nATT) continue;
        LAS float* rpb = (LAS float*)(lds + NA_RPB);
        AttnDesc A{}; int bh, b, h; size_t qrow;
        if (u < 256) { bh = u >> 4; b = bh >> 2; h = bh & 3; const int rq = u & 15; A.r0 = rq * 4; A.rs0 = min(max(A.r0 - 4, 0), 56); const int rsl = min(max(A.r0 + 3 - 4, 0), 56);
            A.ntiles = 4 + (rsl + 8 - A.rs0); qrow = (size_t)NCTX + b * SEQ + A.r0 * 64; }
        else { bh = u - 256; b = bh >> 2; h = bh & 3; A.ntiles = 4; qrow = (size_t)b * 256; }
        const GAS float* rp = cx.in(I_RPB) + (size_t)(l * 4 + h) * 465;
        A.q = P + qrow * PP + CB_Q + h * 64; A.qpitch = PP; A.k = P + CB_K + h * 64; A.kpitch = PP; A.vt = (const GAS bf16*)(ws + WS_VNT) + (size_t)bh * 64 * NKEY;
        A.o = CAT + qrow * D + 256 + h * 64; A.opitch = D; A.scale = 0.125f * LOG2E; A.b = b; A.rpb = rpb;
        na_unit(lds, A, rp, tid, lane, wave);
    }
    __syncthreads();
    if (!r3first) { rec_r3_run<0>(cx, l, lds, tid, bid, G, keep_ctx); rec_r3_run<1>(cx, l, lds, tid, bid, G, keep_ctx); }
}
DI void ph_gemm_out(const Ctx& cx, int l) {
    TIDS; GAS unsigned char* ws = cx.ws(); LAS unsigned char* lds = (LAS unsigned char*)lds_raw;
    const int roff = (l == 0) ? 0 : NCTX, Mg = MTOK - roff;
    pg8::Gemm g{(const GAS bf16*)(ws + WS_CAT) + (size_t)roff * D, (const GAS bf16*)(ws + WS_WTOUT + (size_t)l * D * D * 2), Mg, D, D}; pg8::StaticOrder S; S.init(Mg, D, G, bid);
    pg8::EpiResid E{(GAS pg8::bf16_t*)(ws + WS_X), roff, (const GAS float*)(ws + WS_MOD) + (size_t)l * 5 * 6144 + 2 * 1024, l == 0 ? cx.in(I_CTX) : (const GAS float*)nullptr, l == 0 ? cx.in(I_X) : (const GAS float*)nullptr};
    pg8::gemm_phase(lds, g, S, E);
    if (l == 0) { const int nbusy = (Mg / 256) * (D / 256) - G;
        if (nbusy >= 0 && nbusy < G && bid >= nbusy) { __syncthreads(); weight_copies(cx, 1, lds, tid, lane, wave, (bid - nbusy) * 8 + wave, (G - nbusy) * 8, (bid - nbusy) * 512 + tid, (G - nbusy) * 512); } }
}
DI void ph_router(const Ctx& cx, int l) {
    TIDS; GAS unsigned char* ws = cx.ws(); LAS unsigned char* lds = (LAS unsigned char*)lds_raw;
    const int m_lo = (l == 0) ? 0 : NCTX;
    const GAS bf16* X = (const GAS bf16*)(ws + WS_X); GAS bf16* H = (GAS bf16*)(ws + WS_H); const GAS float* MOD = (const GAS float*)(ws + WS_MOD) + (size_t)l * 5 * 6144;
    GAS int* EID = (GAS int*)(ws + WS_MOE); GAS float* GATE = (GAS float*)(ws + WS_MOE) + MTOK * 2; GAS int* POS = (GAS int*)(ws + WS_MOE) + MTOK * 4;
    GAS unsigned* cnt = (GAS unsigned*)(ws + WS_CTL) + CW_CNT + l * 32 * 64; GAS int* RIDX = (GAS int*)(ws + WS_RIDX);
    const GAS bf16* WRh = (const GAS bf16*)(ws + WS_WR) + (size_t)l * 2 * 48 * 1024; const GAS bf16* WRl = WRh + 48 * 1024;
    const GAS float* n2g = cx.in(I_N2G) + l * D; const GAS float* brg = cx.in(I_BRG) + l * 4; const GAS float* bre = cx.in(I_BRE) + l * 32;
    constexpr int AP = 136;
    LAS bf16* Ah = (LAS bf16*)(lds + wave * 12288); LAS bf16* Al = Ah + 16 * AP; LAS float* LG = (LAS float*)(lds + wave * 12288 + 2 * 16 * AP * 2); LAS float* RSD = LG + 16 * 48;
    const int nunits = (MTOK - m_lo) / 16;
#pragma unroll 1
    for (int unit = wave * G + bid; unit < nunits; unit += NGW) {
        const int m0 = m_lo + unit * 16; const GAS float* mb = MOD + (size_t)bidx_of_row(m0) * 6144;
        const int p16 = lane & 15, rg = lane >> 4;
        float rsr[4];
        { float ss[4] = {0.f, 0.f, 0.f, 0.f};
#pragma unroll 2
            for (int kc = 0; kc < 8; ++kc) { v4u xp[4];
#pragma unroll
                for (int i = 0; i < 4; ++i) xp[i] = *(const GAS v4u*)(X + (size_t)(m0 + 4 * rg + i) * D + kc * 128 + 8 * p16);
#pragma unroll
                for (int i = 0; i < 4; ++i) { float x[8]; unpack8(xp[i], x);
#pragma unroll
                    for (int e = 0; e < 8; ++e) ss[i] += x[e] * x[e]; } }
#pragma unroll
            for (int i = 0; i < 4; ++i) { float t = ss[i]; t += __shfl_xor(t, 1); t += __shfl_xor(t, 2); t += __shfl_xor(t, 4); t += __shfl_xor(t, 8); rsr[i] = rsqrtf(t * (1.f / D) + EPS); } }
        f32x4 acc[3];
#pragma unroll
        for (int ct = 0; ct < 3; ++ct) acc[ct] = (f32x4){0.f, 0.f, 0.f, 0.f};
#pragma unroll 1
        for (int kc = 0; kc < 8; ++kc) { const int c = kc * 128 + 8 * p16;
            const int fr = lane & 15, fq = lane >> 4;
            bf16x8 bh[4][3], bl[4][3];
#pragma unroll
            for (int ks = 0; ks < 4; ++ks)
#pragma unroll
                for (int ct = 0; ct < 3; ++ct) { const size_t bo = (size_t)(ct * 16 + fr) * 1024 + kc * 128 + ks * 32 + fq * 8; bh[ks][ct] = *(const GAS bf16x8*)(WRh + bo); bl[ks][ct] = *(const GAS bf16x8*)(WRl + bo); }
            v4u xp[4];
#pragma unroll
            for (int i = 0; i < 4; ++i) xp[i] = *(const GAS v4u*)(X + (size_t)(m0 + 4 * rg + i) * D + c);
            float gg[8], sh[8], sc[8];
            { const f32x4 a0 = *(const GAS f32x4*)(n2g + c), a1 = *(const GAS f32x4*)(n2g + c + 4), b0 = *(const GAS f32x4*)(mb + 3 * 1024 + c), b1 = *(const GAS f32x4*)(mb + 3 * 1024 + c + 4),
                  c0 = *(const GAS f32x4*)(mb + 4 * 1024 + c), c1 = *(const GAS f32x4*)(mb + 4 * 1024 + c + 4);
                gg[0] = a0.x; gg[1] = a0.y; gg[2] = a0.z; gg[3] = a0.w; gg[4] = a1.x; gg[5] = a1.y; gg[6] = a1.z; gg[7] = a1.w;
                sh[0] = b0.x; sh[1] = b0.y; sh[2] = b0.z; sh[3] = b0.w; sh[4] = b1.x; sh[5] = b1.y; sh[6] = b1.z; sh[7] = b1.w;
                sc[0] = c0.x; sc[1] = c0.y; sc[2] = c0.z; sc[3] = c0.w; sc[4] = c1.x; sc[5] = c1.y; sc[6] = c1.z; sc[7] = c1.w; }
            LDS_WAIT();
#pragma unroll
            for (int i = 0; i < 4; ++i) { const int r = 4 * rg + i; float x[8], y[8]; unpack8(xp[i], x);
#pragma unroll
                for (int e = 0; e < 8; ++e) y[e] = x[e] * rsr[i] * gg[e] * (1.f + sc[e]) + sh[e];
                const v4u hi = (v4u){pk2(y[0], y[1]), pk2(y[2], y[3]), pk2(y[4], y[5]), pk2(y[6], y[7])};
                float hf[8]; unpack8(hi, hf);
                const v4u lo = (v4u){pk2(y[0] - hf[0], y[1] - hf[1]), pk2(y[2] - hf[2], y[3] - hf[3]), pk2(y[4] - hf[4], y[5] - hf[5]), pk2(y[6] - hf[6], y[7] - hf[7])};
                *(GAS v4u*)(H + (size_t)(m0 + r) * D + c) = hi;
                *(LAS v4u*)(Ah + r * AP + 8 * p16) = hi; *(LAS v4u*)(Al + r * AP + 8 * p16) = lo; }
            LDS_WAIT();
            asm volatile("s_waitcnt vmcnt(0)" : "+v"(bh[0][0]), "+v"(bh[0][1]), "+v"(bh[0][2]), "+v"(bl[0][0]), "+v"(bl[0][1]), "+v"(bl[0][2]), "+v"(bh[1][0]), "+v"(bh[1][1]), "+v"(bh[1][2]), "+v"(bl[1][0]), "+v"(bl[1][1]), "+v"(bl[1][2]),
                         "+v"(bh[2][0]), "+v"(bh[2][1]), "+v"(bh[2][2]), "+v"(bl[2][0]), "+v"(bl[2][1]), "+v"(bl[2][2]), "+v"(bh[3][0]), "+v"(bh[3][1]), "+v"(bh[3][2]), "+v"(bl[3][0]), "+v"(bl[3][1]), "+v"(bl[3][2]) :: "memory");
#pragma unroll
            for (int ks = 0; ks < 4; ++ks) { const bf16x8 ah = *(const LAS bf16x8*)(Ah + fr * AP + ks * 32 + fq * 8), al = *(const LAS bf16x8*)(Al + fr * AP + ks * 32 + fq * 8);
#pragma unroll
                for (int ct = 0; ct < 3; ++ct) {
                    acc[ct] = __builtin_amdgcn_mfma_f32_16x16x32_bf16(ah, bh[ks][ct], acc[ct], 0, 0, 0);
                    acc[ct] = __builtin_amdgcn_mfma_f32_16x16x32_bf16(ah, bl[ks][ct], acc[ct], 0, 0, 0);
                    acc[ct] = __builtin_amdgcn_mfma_f32_16x16x32_bf16(al, bh[ks][ct], acc[ct], 0, 0, 0); } }
        }
#pragma unroll
        for (int ct = 0; ct < 3; ++ct)
#pragma unroll
            for (int j = 0; j < 4; ++j) LG[(4 * (lane >> 4) + j) * 48 + ct * 16 + (lane & 15)] = acc[ct][j];
        LDS_WAIT(); asm volatile("" ::: "memory");
        if (lane < 16) { const LAS float* lg = LG + lane * 48; const int m = m0 + lane;
            float gl[4]; int gsel = 0;
#pragma unroll
            for (int i = 0; i < 4; ++i) gl[i] = lg[i] + brg[i];
            float gmax = gl[0];
#pragma unroll
            for (int i = 1; i < 4; ++i) if (gl[i] > gmax) { gmax = gl[i]; gsel = i; }
            float den = 0.f;
#pragma unroll
            for (int i = 0; i < 4; ++i) den += __expf(gl[i] - gmax);
            const float pg = 1.f / den;
            float e1 = -INFINITY, e2 = -INFINITY; int i1 = 0, i2 = 0;
#pragma unroll 1
            for (int i = 0; i < 8; ++i) { const float ev = lg[4 + gsel * 8 + i] + bre[gsel * 8 + i];
                if (ev > e1) { e2 = e1; i2 = i1; e1 = ev; i1 = i; } else if (ev > e2) { e2 = ev; i2 = i; } }
            const float x2 = __expf(e2 - e1), w1 = pg / (1.f + x2), w2 = pg * x2 / (1.f + x2);
            const int ex1 = gsel * 8 + i1, ex2 = gsel * 8 + i2;
            const int p1 = (int)__hip_atomic_fetch_add(cnt + ex1 * 64, 1u, __ATOMIC_RELAXED, __HIP_MEMORY_SCOPE_AGENT), p2 = (int)__hip_atomic_fetch_add(cnt + ex2 * 64, 1u, __ATOMIC_RELAXED, __HIP_MEMORY_SCOPE_AGENT);
            EID[m * 2] = ex1; EID[m * 2 + 1] = ex2; GATE[m * 2] = w1; GATE[m * 2 + 1] = w2; POS[m * 2] = p1; POS[m * 2 + 1] = p2;
            RIDX[(size_t)ex1 * MOE_CAP + p1] = m; RIDX[(size_t)ex2 * MOE_CAP + p2] = m; }
        LDS_WAIT(); asm volatile("" ::: "memory");
    }
}
DI void ph_gemm_gu(const Ctx& cx, int l) {
    TIDS; GAS unsigned char* ws = cx.ws(); LAS unsigned char* lds = (LAS unsigned char*)lds_raw;
    LAS int* moe_off = (LAS int*)(lds + MISC_OFF + 64 * 4); LAS int* moe_te = (LAS int*)(lds + MISC_OFF + 128 * 4);
    const int nT = moe_tables((const GAS unsigned*)(ws + WS_CTL) + CW_CNT + l * 32 * 64, moe_off, moe_te, tid);
    pg8::Gemm g{(const GAS bf16*)(ws + WS_H), (const GAS bf16*)(ws + WS_WTGU + (size_t)l * 32 * 512 * D * 2), nT * 256, 512, D};
    const int vc = (G % 8 == 0) ? (bid % 8) * (G / 8) + bid / 8 : bid;
    pg8::GroupedPublish S{{nT, 2, G, vc, moe_te, (size_t)512 * D * 2}, (GAS unsigned*)(ws + WS_CTL) + CW_GUC + l * MOE_MAXT * 64};
    pg8::EpiGateUp E{(GAS bf16*)(ws + WS_ACT), (unsigned)(MOE_MAXT * 256 * 256 * 2)};
    LAS int* ridx_l = (LAS int*)(lds + MISC_OFF + 4096);
    { const GAS unsigned* cntp = (const GAS unsigned*)(ws + WS_CTL) + CW_CNT + l * 32 * 64; const GAS int* RIDX = (const GAS int*)(ws + WS_RIDX);
        const int vcl = (G % 8 == 0) ? (bid % 8) * (G / 8) + bid / 8 : bid; const int i = tid >> 8, r = tid & 255, L = vcl + i * G;
        if (L < nT * 2) { const int pm = L >> 1, e = moe_te[pm], slot = pm * 256 - moe_off[e] + r; ridx_l[i * 256 + r] = slot < (int)cntp[e * 64] ? RIDX[(size_t)e * MOE_CAP + slot] : 0; }
        __syncthreads(); }
    pg8::MoeRows RM{ridx_l, vc >> 1};
    pg8::gemm_phase(lds, g, S, E, RM);
}
DI void ph_gemm_dn(const Ctx& cx, int l) {
    TIDS; GAS unsigned char* ws = cx.ws(); LAS unsigned char* lds = (LAS unsigned char*)lds_raw;
    LAS int* moe_off = (LAS int*)(lds + MISC_OFF + 64 * 4); LAS int* moe_te = (LAS int*)(lds + MISC_OFF + 128 * 4);
    const int nT = moe_tables((const GAS unsigned*)(ws + WS_CTL) + CW_CNT + l * 32 * 64, moe_off, moe_te, tid);
    pg8::Gemm g{(const GAS bf16*)(ws + WS_ACT), (const GAS bf16*)(ws + WS_WTDN + (size_t)l * 32 * D * 256 * 2), nT * 256, D, 256};
    pg8::EpiStoreBf16 E{(GAS bf16*)(ws + WS_XS), D};
    const GAS unsigned* ready = (const GAS unsigned*)(ws + WS_CTL) + CW_GUC + l * MOE_MAXT * 64;
    const int vc = (G % 8 == 0) ? (bid % 8) * (G / 8) + bid / 8 : bid;
    const int nb2 = (nT * 2 > G && nT * 2 - G < G / 2) ? nT * 2 - G : 0, Gd = G - nb2, cd = vc - nb2;
    const int pmE = nb2 ? G / 2 : nT, nE = pmE * 4, nL = (nT - pmE) * 4;
    const int cl = cd < 0 ? -1 : (cd - nE % Gd + Gd) % Gd;
    pg8::GroupedOrder S1{pmE, 4, Gd, cd, moe_te, (size_t)D * 256 * 2, 0};
    pg8::GroupedOrder S2{nT - pmE, 4, Gd, cl, moe_te, (size_t)D * 256 * 2, pmE};
    { pg8::Unit u;
#pragma unroll 1
      for (int i = 0; S1.next(i, u); ++i) pg8::wait_rowtile(ready, u.pm, 16u); }
    pg8::gemm_phase(lds, g, S1, E);
    if (nL > 0) { pg8::Unit u;
#pragma unroll 1
      for (int i = 0; S2.next(i, u); ++i) pg8::wait_rowtile(ready, u.pm, 16u);
      pg8::gemm_phase(lds, g, S2, E); }
}
DI void ph_combine(const Ctx& cx, int l) {
    TIDS; GAS unsigned char* ws = cx.ws(); LAS unsigned char* lds = (LAS unsigned char*)lds_raw;
    LAS int* moe_off = (LAS int*)(lds + MISC_OFF + 64 * 4); LAS int* moe_te = (LAS int*)(lds + MISC_OFF + 128 * 4);
    const int m_lo = (l == 0) ? 0 : NCTX;
    moe_tables((const GAS unsigned*)(ws + WS_CTL) + CW_CNT + l * 32 * 64, moe_off, moe_te, tid);
    const GAS int* EID = (const GAS int*)(ws + WS_MOE); const GAS float* GATE = (const GAS float*)(ws + WS_MOE) + MTOK * 2; const GAS int* POS = (const GAS int*)(ws + WS_MOE) + MTOK * 4;
    const GAS bf16* YS = (const GAS bf16*)(ws + WS_XS); GAS bf16* X = (GAS bf16*)(ws + WS_X); GAS bf16* H = (GAS bf16*)(ws + WS_H);
    const GAS float* MODB = (const GAS float*)(ws + WS_MOD); const GAS float* MOD = MODB + (size_t)l * 5 * 6144;
    const GAS float* n1g1 = cx.in(I_N1G) + D; const GAS float* fng = cx.in(I_FNG); GAS float* outp = cx.out();
    const int R = (MTOK - m_lo + G - 1) / G, m_beg = m_lo + bid * R + wave, m_end = min(m_lo + (bid + 1) * R, MTOK);
    f32x4 g5r[4], fgr[4]; NormPar np; int cb = -1;
    if (l != 0) {
#pragma unroll
        for (int j = 0; j < 4; ++j) fgr[j] = *(const GAS f32x4*)(fng + 4 * lane + 256 * j); }
    int e0n = 0, e1n = 0, p0n = 0, p1n = 0; float w0n = 0.f, w1n = 0.f;
    float w0 = 0.f, w1 = 0.f, w0d = 0.f, w1d = 0.f;
    v2u A0[4], A1[4], XW[4];
    auto rec_load = [&](int mm) { e0n = EID[mm * 2]; e1n = EID[mm * 2 + 1]; p0n = POS[mm * 2]; p1n = POS[mm * 2 + 1]; w0n = GATE[mm * 2]; w1n = GATE[mm * 2 + 1]; };
    auto data_load = [&](int mm) { const int d0 = moe_off[e0n] + p0n, d1 = moe_off[e1n] + p1n; w0d = w0n; w1d = w1n;
#pragma unroll
        for (int j = 0; j < 4; ++j) { const int c = 4 * lane + 256 * j; A0[j] = *(const GAS v2u*)(YS + (size_t)d0 * D + c); A1[j] = *(const GAS v2u*)(YS + (size_t)d1 * D + c); XW[j] = *(const GAS v2u*)(X + (size_t)mm * D + c); } };
    if (m_beg < m_end) { rec_load(m_beg); data_load(m_beg); rec_load(m_beg + 8 < m_end ? m_beg + 8 : m_beg); }
#pragma unroll 1
    for (int m = m_beg; m < m_end; m += 8) {
        v2u a0[4], a1[4], xw[4];
#pragma unroll
        for (int j = 0; j < 4; ++j) { a0[j] = A0[j]; a1[j] = A1[j]; xw[j] = XW[j]; }
        w0 = w0d; w1 = w1d;
        { const int m1 = m + 8 < m_end ? m + 8 : m, m2 = m + 16 < m_end ? m + 16 : m1; data_load(m1); rec_load(m2); }
        { const int b = bidx_of_row(m);
            if (b != cb) { const GAS float* mb = MOD + (size_t)b * 6144;
#pragma unroll
                for (int j = 0; j < 4; ++j) g5r[j] = *(const GAS f32x4*)(mb + 5 * 1024 + 4 * lane + 256 * j);
                if (l == 0) { const GAS float* mb1 = MODB + (size_t)(5 + b) * 6144; load_normpar(np, n1g1, mb1, mb1 + 1024, lane); }
                cb = b; } }
        f32x4 v[4];
#pragma unroll
        for (int j = 0; j < 4; ++j) { const f32x4 y = w0 * bf4f(a0[j]) + w1 * bf4f(a1[j]); v[j] = bf4f(xw[j]) + g5r[j] * y; }
        if (l == 0) {
#pragma unroll
            for (int j = 0; j < 4; ++j) *(GAS v2u*)(X + (size_t)m * D + 4 * lane + 256 * j) = f4bf(v[j]);
            norm_row_store_c(v, np, H + (size_t)m * D, lane);
        } else {
            float ss = 0.f;
#pragma unroll
            for (int j = 0; j < 4; ++j) ss += (v[j].x * v[j].x + v[j].y * v[j].y) + (v[j].z * v[j].z + v[j].w * v[j].w);
            const float rstd = rsqrtf(wave_sum(ss) * (1.f / D) + EPS);
#pragma unroll
            for (int j = 0; j < 4; ++j) { const int c = 4 * lane + 256 * j;
                *(GAS f32x4*)(outp + (size_t)(m - NCTX) * D + c) = v[j] * rstd * fgr[j]; }
        }
    }
}

#ifndef PH_MASK
#define PH_MASK 0xFFF
#endif
#define PHON(j) (((PH_MASK) >> (j)) & 1)
__global__ void __launch_bounds__(512, 2) fwd_kernel(Args args) {
    LAS unsigned char* lds = (LAS unsigned char*)lds_raw;
    volatile LAS unsigned* MISC = (volatile LAS unsigned*)(lds + MISC_OFF);
    {
        const int tid = threadIdx.x;
        for (int u = tid; u < (LDS_BYTES - MISC_OFF) / 4; u += 512) MISC[u] = 0u;
        __syncthreads();
        if (tid == 0) { volatile LAS unsigned long long* t = (volatile LAS unsigned long long*)(lds + PTR_OFF);
#pragma unroll
            for (int i = 0; i < N_IN; ++i) t[i] = (unsigned long long)args.in[i];
            t[N_IN] = (unsigned long long)args.out; t[N_IN + 1] = (unsigned long long)args.ws; }
        __syncthreads();
    }
    const Ctx cx;
#if MK_ONE_LAUNCH
    XcdBarrier bar = xcd_barrier_post((unsigned*)(cx.ws() + WS_CTL) + CW_BAR, MISC + 8);
#define GRID_BAR() xcd_barrier(bar)
#else
#define GRID_BAR() do { } while (0)
#endif
    const int lo = args.ph_lo, hi = args.ph_hi;
#define IN(k) (lo <= (k) && (k) < hi)
#define BOTH(k) (IN(k) && IN((k) + 1))
    if (PHON(0) && IN(0)) { TIDS; phase_prologue(cx, lds, tid, lane, wave, bid, G); if (BOTH(0)) GRID_BAR(); }
    if (PHON(1) && IN(1)) { TIDS; phase_norm1_l0(cx, lane, gw, NGW); if (BOTH(1)) GRID_BAR(); }
#define LAYER(L) { constexpr int l = L; constexpr int pb = 2 + 10 * l; \
        if (PHON(2) && IN(pb + 0)) { ph_gemm_in(cx, l); if (BOTH(pb + 0)) GRID_BAR(); } \
        if (PHON(3) && IN(pb + 1)) { ph_prep_r1(cx, l); if (BOTH(pb + 1)) GRID_BAR(); } \
        if (PHON(4) && IN(pb + 2)) { rec_r2(cx, blockIdx.x * 512 + threadIdx.x, gridDim.x * 512); if (BOTH(pb + 2)) GRID_BAR(); } \
        if (PHON(5) && IN(pb + 3)) { ph_mixers(cx, l); if (BOTH(pb + 3)) GRID_BAR(); } \
        if (PHON(6) && IN(pb + 4)) { ph_gemm_out(cx, l); if (BOTH(pb + 4)) GRID_BAR(); } \
        if (PHON(7) && IN(pb + 5)) { ph_router(cx, l); if (BOTH(pb + 5)) GRID_BAR(); } \
        if (PHON(9) && IN(pb + 7)) { ph_gemm_gu(cx, l);   } \
        if (PHON(10) && IN(pb + 8)) { ph_gemm_dn(cx, l); if (BOTH(pb + 8)) GRID_BAR(); } \
        if (PHON(11) && IN(pb + 9)) { ph_combine(cx, l); if (BOTH(pb + 9)) GRID_BAR(); } }
    LAYER(0)
    LAYER(1)
#undef LAYER
#undef IN
#undef BOTH
}

constexpr int NPHASES = 22;
extern "C" void kernel_launch(void* const* d_in, const int* in_sizes, int n_in, void* d_out, int out_size, void* d_ws, size_t ws_size, hipStream_t stream) {
    static int grid = 0;
    if (grid == 0) {
        if (n_in != N_IN || out_size != NLAT * D || ws_size < WS_END) { fprintf(stderr, "kernel_launch: unexpected problem (n_in %d, out %d, ws %zu)\n", n_in, out_size, ws_size); grid = -1; return; }
        int dev = 0, cus = 0, per_cu = 0;
        if (hipGetDevice(&dev) != hipSuccess || hipDeviceGetAttribute(&cus, hipDeviceAttributeMultiprocessorCount, dev) != hipSuccess) { grid = -1; return; }
        if (hipFuncSetAttribute((const void*)fwd_kernel, hipFuncAttributeMaxDynamicSharedMemorySize, LDS_BYTES) != hipSuccess) { fprintf(stderr, "kernel_launch: hipFuncSetAttribute failed\n"); grid = -1; return; }
        if (hipOccupancyMaxActiveBlocksPerMultiprocessor(&per_cu, (const void*)fwd_kernel, 512, LDS_BYTES) != hipSuccess || per_cu < 1) fprintf(stderr, "kernel_launch: occupancy query reports %d\n", per_cu);
        (void)hipGetLastError();
        grid = cus;
    }
    if (grid < 0) return;
    (void)hipMemsetAsync((char*)d_ws + WS_CTL, 0, CTL_BYTES, stream);
    Args a{};
    for (int i = 0; i < N_IN; ++i) a.in[i] = (const float*)d_in[i];
    a.out = (float*)d_out; a.ws = (unsigned char*)d_ws;
#if MK_ONE_LAUNCH
    a.ph_lo = 0; a.ph_hi = NPHASES;
    hipLaunchKernelGGL(fwd_kernel, dim3(grid), dim3(512), LDS_BYTES, stream, a);
#else
    for (int p = 0; p < NPHASES; ++p) { a.ph_lo = p; a.ph_hi = p + 1; hipLaunchKernelGGL(fwd_kernel, dim3(grid), dim3(512), LDS_BYTES, stream, a); }
#endif
}
```

```cpp
#include <hip/hip_runtime.h>
#include <cstdio>
#include <cstdint>

#ifndef MK_ONE_LAUNCH
#define MK_ONE_LAUNCH 1
#endif

#define DI __device__ __forceinline__
#define GAS __attribute__((address_space(1)))
#define LAS __attribute__((address_space(3)))
typedef unsigned short bf16;
typedef unsigned v4u __attribute__((ext_vector_type(4)));
typedef unsigned v2u __attribute__((ext_vector_type(2)));
typedef float f32x4 __attribute__((ext_vector_type(4)));
typedef short bf16x8 __attribute__((ext_vector_type(8)));
#define LDS_WAIT() asm volatile("s_waitcnt lgkmcnt(0)" ::: "memory")

constexpr int D = 1024, NB = 4, SEQ = 4096, LCTX = 256, NCTX = NB * LCTX, NLAT = NB * SEQ, MTOK = NCTX + NLAT;
constexpr int DIN = 3200, PP = 3328;
constexpr int CA_Q = 0, CA_I = 256, CA_FF = 512, CA_FB = 768, CA_G = 1024;
constexpr int CB_Q = 1280, CB_K = 1536, CB_V = 1792;
constexpr int CC_Q = 2048, CC_K = 2176, CC_V = 2304, CC_G = 2560, CC_ZF = 2816, CC_ZB = 2832;
constexpr int CD_Q = 2848, CD_KV = 3040, CD_R = 3168;
constexpr int NKEY = LCTX + SEQ;
constexpr int NCHUNK = NKEY / 64;
constexpr float EPS = 1e-6f;
constexpr float LOG2E = 1.4426950408889634f;
constexpr int MOE_MAXT = 168;
constexpr int MOE_CAP = 2 * 17408;

enum { I_X = 0, I_C, I_CTX, I_CCTX, I_WMOD, I_BMOD, I_N1G, I_N2G, I_WIN, I_WOUT, I_LBL, I_HNG, I_RPB, I_WGF, I_BGF, I_WGB, I_BGB, I_GNG, I_QNG, I_WUQ, I_KVNG, I_WUKV,
       I_WRG, I_BRG, I_WRE, I_BRE, I_WGU, I_WDN, I_FNG, N_IN };

constexpr size_t MiB = 1u << 20;
constexpr size_t WS_CTL = 0, CTL_BYTES = 256 * 1024;
constexpr size_t WS_WTIN = 2 * MiB;
constexpr size_t WTIN_L = (size_t)PP * D * 2;
constexpr size_t WS_WTOUT = 16 * MiB;
constexpr size_t WS_WTUQ = 20 * MiB;
constexpr size_t WS_WTUKV = WS_WTUQ + 512 * 1024;
constexpr size_t WS_MOD = 21 * MiB;
constexpr size_t WS_WR = WS_MOD + 512 * 1024;
constexpr size_t WS_WTGU = 22 * MiB;
constexpr size_t WS_WTDN = 86 * MiB;
constexpr size_t WS_X = 118 * MiB;
constexpr size_t WS_H = 186 * MiB;
constexpr size_t WS_CAT = 220 * MiB;
constexpr size_t WS_P = 254 * MiB;
constexpr size_t WS_XS = WS_P;
constexpr size_t WS_ACT = 338 * MiB;
constexpr size_t WS_QM = 366 * MiB;
constexpr size_t WS_KM = 379 * MiB;
constexpr size_t WS_VM = 392 * MiB;
constexpr size_t WS_SBH = 152 * MiB, WS_SBG = 170 * MiB;
constexpr size_t WS_RSH = 401 * MiB;
constexpr size_t WS_RSG = 435 * MiB;
constexpr size_t WS_RAH = 452 * MiB;
constexpr size_t WS_RAG = WS_RAH + 600 * 1024;
constexpr size_t WS_MOE = 453 * MiB;
constexpr size_t WS_VNT = 454 * MiB;
constexpr size_t WS_RIDX = 463 * MiB;
constexpr size_t WS_END = 468 * MiB;
constexpr int CW_BAR = 4096;
constexpr int CW_CNT = 16384;
constexpr int CW_GUC = 32768;
constexpr int CW_TMO = 64;

constexpr int RING_BYTES = 131072;
constexpr int MISC_OFF = RING_BYTES;
constexpr int LDS_BYTES = 147456;

DI float bf2f(unsigned v) { return __uint_as_float(v << 16); }
DI unsigned f2bf(float f) { unsigned u = __float_as_uint(f); return (u + 0x7fffu + ((u >> 16) & 1u)) >> 16; }
typedef __bf16 bf16v2 __attribute__((ext_vector_type(2)));
typedef float f32x2 __attribute__((ext_vector_type(2)));
DI unsigned pk2(float lo, float hi) { const f32x2 v = {lo, hi}; return __builtin_bit_cast(unsigned, __builtin_convertvector(v, bf16v2)); }
DI f32x4 bf4f(v2u w) { f32x4 r; r.x = __uint_as_float(w.x << 16); r.y = __uint_as_float(w.x & 0xffff0000u); r.z = __uint_as_float(w.y << 16); r.w = __uint_as_float(w.y & 0xffff0000u); return r; }
DI v2u f4bf(f32x4 v) { return (v2u){pk2(v.x, v.y), pk2(v.z, v.w)}; }
DI bf16x8 pack8(float a0, float a1, float a2, float a3, float a4, float a5, float a6, float a7) {
    v4u p; p.x = pk2(a0, a1); p.y = pk2(a2, a3); p.z = pk2(a4, a5); p.w = pk2(a6, a7);
    return __builtin_bit_cast(bf16x8, p);
}
DI float wave_sum(float v) {
#pragma unroll
    for (int o = 1; o < 64; o <<= 1) v += __shfl_xor(v, o);
    return v;
}
DI float frcp_(float x) { return __builtin_amdgcn_rcpf(x); }
DI float sigmoid_(float x) { return frcp_(1.f + __expf(-x)); }
DI float silu_(float x) { return x * frcp_(1.f + __expf(-x)); }
DI float logsigmoid_(float x) { return fminf(x, 0.f) - __logf(1.f + __expf(-fabsf(x))); }
DI void unpack8(v4u w, float* f) {
    f[0] = __uint_as_float(w.x << 16); f[1] = __uint_as_float(w.x & 0xffff0000u);
    f[2] = __uint_as_float(w.y << 16); f[3] = __uint_as_float(w.y & 0xffff0000u);
    f[4] = __uint_as_float(w.z << 16); f[5] = __uint_as_float(w.z & 0xffff0000u);
    f[6] = __uint_as_float(w.w << 16); f[7] = __uint_as_float(w.w & 0xffff0000u);
}
DI int bidx_of_row(int m) { return m < NCTX ? 4 : ((m - NCTX) >> 12); }

namespace pg8 {
#define PG8_LAS __attribute__((address_space(3)))
typedef unsigned short bf16_t;
typedef unsigned u32x4 __attribute__((ext_vector_type(4)));
constexpr int BM = 256, BK = 64, HALF = 128, HTB = HALF * BK * 2, STAGE_BYTES = 8 * HTB, NXCD = 8, WGM = 4;
__host__ __device__ __forceinline__ int lds_byte(int r, int c) { const int st = (r >> 4) * 2 + (c >> 5), rr = r & 15, cc = c & 31, ob = rr * 64 + cc * 2; return st * 1024 + (ob ^ (((ob >> 9) & 1) << 5)); }
__host__ __device__ __forceinline__ void stage_rc(int b, int& R, int& C) { const int st = b / 1024, sb = b % 1024, swz = sb ^ (((sb >> 9) & 1) << 5); R = (st >> 1) * 16 + swz / 64; C = (st & 1) * 32 + (swz % 64) / 2; }
__host__ __device__ __forceinline__ int perm32(int rho) { const int n = rho >> 4, i = rho & 15; return 8 * (i >> 2) + 4 * n + (i & 3); }
struct Unit { int pm, pn; size_t bo; };
struct LinearRows { static constexpr bool LINEAR = true; __device__ __forceinline__ int operator()(const Unit& u, int r) const { return u.pm * BM + r; } };
struct MoeRows { static constexpr bool LINEAR = false; const PG8_LAS int* idx; int pm0;
    __device__ __forceinline__ int operator()(const Unit& u, int r) const { return idx[(u.pm == pm0 ? 0 : 256) + r]; } };
struct Gemm { const GAS bf16_t* A; const GAS bf16_t* Bt; int M, N, K; };
struct StaticOrder {
    int nM, nN, nwg, G, c, imax, wgm;
    __device__ void init(int M, int N, int G_, int c_) { nM = M / BM; nN = N / BM; nwg = nM * nN; G = G_; c = c_; imax = 1 << 30; wgm = WGM; }
    __device__ void map(int wgid, Unit& u) const {
        { const int q = nwg / NXCD, r = nwg % NXCD, xcd = wgid % NXCD, off = wgid / NXCD; wgid = (xcd < r ? xcd * (q + 1) : r * (q + 1) + (xcd - r) * q) + off; }
        const int nig = wgm * nN, gid = wgid / nig, fm = gid * wgm, gsz = (nM - fm) < wgm ? (nM - fm) : wgm;
        u.pm = fm + ((wgid % nig) % gsz); u.pn = (wgid % nig) / gsz; u.bo = 0;
    }
    __device__ bool next(int i, Unit& u) const {
        const long L = (long)i * G + c; if (i >= imax || L >= nwg) return false;
        map((int)L, u); return true;
    }
    __device__ __forceinline__ void a_ready(const Unit&) const {}
    __device__ __forceinline__ void done(const Unit&) const {}
};
struct TailOrder { StaticOrder S; int L;
    __device__ bool next(int i, Unit& u) const { if (i > 0 || L < 0) return false; S.map(L, u); return true; }
    __device__ __forceinline__ void a_ready(const Unit&) const {}
    __device__ __forceinline__ void done(const Unit&) const {}
};
struct TailRows { static constexpr bool LINEAR = true; int off; __device__ __forceinline__ int operator()(const Unit& u, int r) const { return u.pm * BM + off + (r & (HALF - 1)); } };
struct GroupedOrder {
    int nT, nN, G, c; const PG8_LAS int* tile_e; size_t estride; int pm0 = 0, imax = 1 << 30;
    __device__ bool next(int i, Unit& u) const {
        if (c < 0 || i >= imax) return false;
        const long L = (long)i * G + c; if (L >= (long)nT * nN) return false;
        u.pm = pm0 + (int)(L / nN); u.pn = (int)(L % nN); u.bo = (size_t)__builtin_amdgcn_readfirstlane(tile_e[u.pm]) * estride; return true;
    }
    __device__ __forceinline__ void a_ready(const Unit&) const {}
    __device__ __forceinline__ void done(const Unit&) const {}
};
struct GroupedPublish : GroupedOrder { GAS unsigned* done_cnt;
    __device__ __forceinline__ void done(const Unit& u) const { asm volatile("s_waitcnt vmcnt(0)" ::: "memory");
        if ((threadIdx.x & 63) == 0) __hip_atomic_fetch_add(done_cnt + 64 * u.pm, 1u, __ATOMIC_RELAXED, __HIP_MEMORY_SCOPE_AGENT); } };
__device__ __forceinline__ void wait_rowtile(const GAS unsigned* ready, int pm, unsigned need) {
    if (threadIdx.x < 64) {
        unsigned spins = 0;
        while ((unsigned)__builtin_amdgcn_readfirstlane(__hip_atomic_load(ready + 64 * pm, __ATOMIC_RELAXED, __HIP_MEMORY_SCOPE_AGENT)) < need && ++spins < (1u << 22)) __builtin_amdgcn_s_sleep(2);
        __builtin_amdgcn_fence(__ATOMIC_ACQUIRE, "agent");
        asm volatile("s_waitcnt vmcnt(0)" ::: "memory");
    }
    __syncthreads();
}
__device__ __forceinline__ unsigned cvt_pk_bf16(float lo, float hi) { unsigned r; asm volatile("v_cvt_pk_bf16_f32 %0, %1, %2" : "=v"(r) : "v"(lo), "v"(hi)); return r; }

struct GroupedTailPublish { int L, nN; const PG8_LAS int* tile_e; size_t estride; GAS unsigned* done_cnt;
    __device__ bool next(int i, Unit& u) const { if (i > 0 || L < 0) return false; u.pm = L / nN; u.pn = L % nN; u.bo = (size_t)__builtin_amdgcn_readfirstlane(tile_e[u.pm]) * estride; return true; }
    __device__ __forceinline__ void a_ready(const Unit&) const {}
    __device__ __forceinline__ void done(const Unit& u) const { asm volatile("s_waitcnt vmcnt(0)" ::: "memory");
        if ((threadIdx.x & 63) == 0) __hip_atomic_fetch_add(done_cnt + 64 * u.pm, 1u, __ATOMIC_RELAXED, __HIP_MEMORY_SCOPE_AGENT); } };
struct MoeRowsH { static constexpr bool LINEAR = false; const PG8_LAS int* idx; int off;
    __device__ __forceinline__ int operator()(const Unit&, int r) const { return idx[256 + off + (r & (HALF - 1))]; } };
struct EpiStoreBf16 {
    static constexpr bool PERM = true;
    GAS bf16_t* O; int ldc;
    __device__ __forceinline__ void operator()(const f32x4 (&acc)[2][2][4][2], const Unit& u, int wr, int wc, int fr, int fq) const {
        const int row0 = u.pm * BM + wr * 64 + fr, col0 = u.pn * BM + wc * 32 + 8 * fq;
#pragma unroll
        for (int ai = 0; ai < 2; ++ai)
#pragma unroll
            for (int m = 0; m < 4; ++m) { GAS bf16_t* rowp = O + (size_t)(row0 + ai * HALF + m * 16) * ldc + col0;
#pragma unroll
                for (int bj = 0; bj < 2; ++bj) { const f32x4 v0 = acc[ai][bj][m][0], v1 = acc[ai][bj][m][1];
                    u32x4 w; w.x = cvt_pk_bf16(v0[0], v0[1]); w.y = cvt_pk_bf16(v0[2], v0[3]); w.z = cvt_pk_bf16(v1[0], v1[1]); w.w = cvt_pk_bf16(v1[2], v1[3]);
                    *(GAS u32x4*)(rowp + bj * HALF) = w; } }
    }
};
struct EpiStoreBf16H {
    static constexpr bool PERM = true;
    GAS bf16_t* O; int ldc, off;
    __device__ __forceinline__ void operator()(const f32x4 (&acc)[2][2][4][2], const Unit& u, int wr, int wc, int fr, int fq) const {
        const int row0 = u.pm * BM + off + wr * 64 + fr, col0 = u.pn * BM + wc * 32 + 8 * fq;
#pragma unroll
        for (int m = 0; m < 4; ++m) { GAS bf16_t* rowp = O + (size_t)(row0 + m * 16) * ldc + col0;
#pragma unroll
            for (int bj = 0; bj < 2; ++bj) { const f32x4 v0 = acc[0][bj][m][0], v1 = acc[0][bj][m][1];
                u32x4 w; w.x = cvt_pk_bf16(v0[0], v0[1]); w.y = cvt_pk_bf16(v0[2], v0[3]); w.z = cvt_pk_bf16(v1[0], v1[1]); w.w = cvt_pk_bf16(v1[2], v1[3]);
                *(GAS u32x4*)(rowp + bj * HALF) = w; } }
    }
};
struct EpiResid {
    static constexpr bool PERM = true;
    GAS bf16_t* X; int row_off; const GAS float* mod;
    const GAS float* src_ctx; const GAS float* src_lat;
    __device__ __forceinline__ void operator()(const f32x4 (&acc)[2][2][4][2], const Unit& u, int wr, int wc, int fr, int fq) const {
        const int row0 = row_off + u.pm * BM + wr * 64 + fr, col0 = u.pn * BM + wc * 32 + 8 * fq;
        f32x4 gv[2][2];
        { const GAS float* gp = mod + (size_t)bidx_of_row(row_off + u.pm * BM) * 6144 + col0;
#pragma unroll
            for (int bj = 0; bj < 2; ++bj)
#pragma unroll
                for (int n = 0; n < 2; ++n) gv[bj][n] = *(const GAS f32x4*)(gp + bj * HALF + n * 4); }
#pragma unroll
        for (int ai = 0; ai < 2; ++ai)
#pragma unroll
            for (int m = 0; m < 4; ++m) { const int row = row0 + ai * HALF + m * 16; GAS bf16_t* rowp = X + (size_t)row * D + col0;
                const GAS float* bp = src_lat ? (row < NCTX ? src_ctx + (size_t)row * D + col0 : src_lat + (size_t)(row - NCTX) * D + col0) : (const GAS float*)nullptr;
#pragma unroll
                for (int bj = 0; bj < 2; ++bj) { f32x4 x0, x1;
                    if (src_lat) { x0 = *(const GAS f32x4*)(bp + bj * HALF); x1 = *(const GAS f32x4*)(bp + bj * HALF + 4); }
                    else { const u32x4 w = *(const GAS u32x4*)(rowp + bj * HALF); x0 = bf4f((v2u){w.x, w.y}); x1 = bf4f((v2u){w.z, w.w}); }
                    x0 = x0 + gv[bj][0] * acc[ai][bj][m][0]; x1 = x1 + gv[bj][1] * acc[ai][bj][m][1];
                    const v2u o0 = f4bf(x0), o1 = f4bf(x1); *(GAS u32x4*)(rowp + bj * HALF) = (u32x4){o0.x, o0.y, o1.x, o1.y}; } }
    }
};
struct EpiResidH {
    static constexpr bool PERM = true;
    GAS bf16_t* X; int row_off; const GAS float* mod; const GAS float* src_ctx; const GAS float* src_lat; int off;
    __device__ __forceinline__ void operator()(const f32x4 (&acc)[2][2][4][2], const Unit& u, int wr, int wc, int fr, int fq) const {
        const int row0 = row_off + u.pm * BM + off + wr * 64 + fr, col0 = u.pn * BM + wc * 32 + 8 * fq;
        f32x4 gv[2][2];
        { const GAS float* gp = mod + (size_t)bidx_of_row(row_off + u.pm * BM) * 6144 + col0;
#pragma unroll
            for (int bj = 0; bj < 2; ++bj)
#pragma unroll
                for (int n = 0; n < 2; ++n) gv[bj][n] = *(const GAS f32x4*)(gp + bj * HALF + n * 4); }
#pragma unroll
        for (int m = 0; m < 4; ++m) { const int row = row0 + m * 16; GAS bf16_t* rowp = X + (size_t)row * D + col0;
            const GAS float* bp = src_lat ? (row < NCTX ? src_ctx + (size_t)row * D + col0 : src_lat + (size_t)(row - NCTX) * D + col0) : (const GAS float*)nullptr;
#pragma unroll
            for (int bj = 0; bj < 2; ++bj) { f32x4 x0, x1;
                if (src_lat) { x0 = *(const GAS f32x4*)(bp + bj * HALF); x1 = *(const GAS f32x4*)(bp + bj * HALF + 4); }
                else { const u32x4 w = *(const GAS u32x4*)(rowp + bj * HALF); x0 = bf4f((v2u){w.x, w.y}); x1 = bf4f((v2u){w.z, w.w}); }
                x0 = x0 + gv[bj][0] * acc[0][bj][m][0]; x1 = x1 + gv[bj][1] * acc[0][bj][m][1];
                const v2u o0 = f4bf(x0), o1 = f4bf(x1); *(GAS u32x4*)(rowp + bj * HALF) = (u32x4){o0.x, o0.y, o1.x, o1.y}; } }
    }
};
struct EpiGateUp {
    static constexpr bool PERM = true;
    GAS bf16_t* O; unsigned nbytes;
    __device__ __forceinline__ void operator()(const f32x4 (&acc)[2][2][4][2], const Unit& u, int wr, int wc, int fr, int fq) const {
        const int row0 = u.pm * BM + wr * 64 + fr, col0 = u.pn * HALF + wc * 32 + 8 * fq;
        const __amdgpu_buffer_rsrc_t rsrc = __builtin_amdgcn_make_buffer_rsrc((void*)O, 0, (int)nbytes, 0x00020000);
#pragma unroll
        for (int ai = 0; ai < 2; ++ai)
#pragma unroll
            for (int m = 0; m < 4; ++m) { const unsigned off = (unsigned)((row0 + ai * HALF + m * 16) * 256 + col0) * 2u;
                float r[8];
#pragma unroll
                for (int n = 0; n < 2; ++n)
#pragma unroll
                    for (int j = 0; j < 4; ++j) { const float g = acc[ai][0][m][n][j], up = acc[ai][1][m][n][j]; r[n * 4 + j] = g * __builtin_amdgcn_rcpf(1.f + __expf(-g)) * up; }
                u32x4 w; w.x = cvt_pk_bf16(r[0], r[1]); w.y = cvt_pk_bf16(r[2], r[3]); w.z = cvt_pk_bf16(r[4], r[5]); w.w = cvt_pk_bf16(r[6], r[7]);
                __builtin_amdgcn_raw_buffer_store_b128(w, rsrc, (int)off, 0, 16); }
    }
};

struct EpiGateUpH {
    static constexpr bool PERM = true;
    GAS bf16_t* O; unsigned nbytes; int off;
    __device__ __forceinline__ void operator()(const f32x4 (&acc)[2][2][4][2], const Unit& u, int wr, int wc, int fr, int fq) const {
        const int row0 = u.pm * BM + off + wr * 64 + fr, col0 = u.pn * HALF + wc * 32 + 8 * fq;
        const __amdgpu_buffer_rsrc_t rsrc = __builtin_amdgcn_make_buffer_rsrc((void*)O, 0, (int)nbytes, 0x00020000);
#pragma unroll
        for (int m = 0; m < 4; ++m) { const unsigned boff = (unsigned)((row0 + m * 16) * 256 + col0) * 2u;
            float r[8];
#pragma unroll
            for (int n = 0; n < 2; ++n)
#pragma unroll
                for (int j = 0; j < 4; ++j) { const float g = acc[0][0][m][n][j], up = acc[0][1][m][n][j]; r[n * 4 + j] = g * __builtin_amdgcn_rcpf(1.f + __expf(-g)) * up; }
            u32x4 w; w.x = cvt_pk_bf16(r[0], r[1]); w.y = cvt_pk_bf16(r[2], r[3]); w.z = cvt_pk_bf16(r[4], r[5]); w.w = cvt_pk_bf16(r[6], r[7]);
            __builtin_amdgcn_raw_buffer_store_b128(w, rsrc, (int)boff, 0, 16); }
    }
};

template <class Epi, class Sched, class Rows = LinearRows, bool HALFM = false>
__device__ __forceinline__ void gemm_phase(PG8_LAS unsigned char* lds, const Gemm g, const Sched& S, const Epi& E, const Rows RM = Rows()) {
    const int tid = threadIdx.x, wid = __builtin_amdgcn_readfirstlane(tid >> 6), lane = tid & 63, wr = wid >> 2, wc = wid & 3, fr = lane & 15, fq = lane >> 4;
    const int K = g.K, nt = K / BK;
    unsigned voffB[2]; int rA[2], cA2[2];
#pragma unroll
    for (int i = 0; i < 2; ++i) { int R, C; stage_rc(tid * 16 + i * 8192, R, C); const int Rb = Epi::PERM ? ((R & ~31) + perm32(R & 31)) : R;
        rA[i] = R; cA2[i] = C * 2; voffB[i] = (unsigned)(Rb * K + C) * 2u; }
    unsigned oAc[2][2], oAn[2][2];
#define PG8_AOFF(dst, u) do { _Pragma("unroll") for (int _h = 0; _h < 2; ++_h) _Pragma("unroll") for (int _i = 0; _i < 2; ++_i) dst[_h][_i] = (unsigned)RM(u, _h * HALF + rA[_i]) * (unsigned)(K * 2) + (unsigned)cA2[_i]; } while (0)
#define PG8_STAGE_A(bufoff, o2, kbyte) do { _Pragma("unroll") for (int _i = 0; _i < 2; ++_i) \
        __builtin_amdgcn_global_load_lds((const unsigned*)((const char*)g.A + (size_t)(kbyte) + (o2)[_i]), (PG8_LAS unsigned*)(lds + (bufoff) + ldsw + _i * 8192), 16, 0, 0); } while (0)
    const size_t kstep = (size_t)(BK * 2);
    const size_t hstep = (size_t)HALF * K * 2;
    const size_t tstep = 2 * hstep;
    const unsigned ldsw = (unsigned)wid * 1024u;
    const int aoff = lds_byte(wr * 64 + fr, fq * 8), boff = lds_byte(wc * 32 + fr, fq * 8);
#define PG8_SA(b, h) (((b) * 2 + (h)) * HTB)
#define PG8_SB(b, h) ((4 + (b) * 2 + (h)) * HTB)
#define PG8_STAGE(bufoff, gbase, voff) do { _Pragma("unroll") for (int _i = 0; _i < 2; ++_i) \
        __builtin_amdgcn_global_load_lds((const unsigned*)((const char*)(gbase) + (voff)[_i]), (PG8_LAS unsigned*)(lds + (bufoff) + ldsw + _i * 8192), 16, 0, 0); } while (0)
#define PG8_LDA(dst, b, h) do { _Pragma("unroll") for (int m = 0; m < 4; ++m) _Pragma("unroll") for (int k = 0; k < 2; ++k) dst[m][k] = *(const PG8_LAS bf16x8*)(lds + PG8_SA(b, h) + aoff + m * 2048 + k * 1024); } while (0)
#define PG8_LDB(dst, b, h) do { _Pragma("unroll") for (int n = 0; n < 2; ++n) _Pragma("unroll") for (int k = 0; k < 2; ++k) dst[n][k] = *(const PG8_LAS bf16x8*)(lds + PG8_SB(b, h) + boff + n * 2048 + k * 1024); } while (0)
#define PG8_MMA(ai, bj, At, Bt) do { __builtin_amdgcn_s_setprio(1); _Pragma("unroll") for (int m = 0; m < 4; ++m) _Pragma("unroll") for (int n = 0; n < 2; ++n) _Pragma("unroll") for (int k = 0; k < 2; ++k) \
        acc[ai][bj][m][n] = __builtin_amdgcn_mfma_f32_16x16x32_bf16(Bt[n][k], At[m][k], acc[ai][bj][m][n], 0, 0, 0); __builtin_amdgcn_s_setprio(0); } while (0)
#define PG8_WAIT_V(n) asm volatile("s_waitcnt vmcnt(" #n ")" ::: "memory")
#define PG8_WAIT_L(n) asm volatile("s_waitcnt lgkmcnt(" #n ")" ::: "memory")
#define PG8_BAR __builtin_amdgcn_s_barrier()
#define PG8_SCHED __builtin_amdgcn_sched_barrier(0)
    Unit cur, nxt; int ui = 0;
    if (!S.next(0, cur)) return;
    f32x4 acc[2][2][4][2];
#pragma unroll
    for (int a = 0; a < 2; ++a)
#pragma unroll
        for (int b = 0; b < 2; ++b)
#pragma unroll
            for (int m = 0; m < 4; ++m)
#pragma unroll
                for (int n = 0; n < 2; ++n) acc[a][b][m][n] = (f32x4){0.f, 0.f, 0.f, 0.f};
    bf16x8 At[4][2], B0[2][2], B1[2][2];
    const char* cB = (const char*)g.Bt + cur.bo + (size_t)cur.pn * tstep;
    S.a_ready(cur);
    PG8_AOFF(oAc, cur);
    PG8_STAGE(PG8_SB(0, 0), cB, voffB); PG8_STAGE_A(PG8_SA(0, 0), oAc[0], 0); PG8_STAGE(PG8_SB(0, 1), cB + hstep, voffB); if constexpr (!HALFM) PG8_STAGE_A(PG8_SA(0, 1), oAc[1], 0);
    if (wr == 1) PG8_BAR;
    if constexpr (HALFM) PG8_WAIT_V(2); else PG8_WAIT_V(4);
    PG8_BAR;
    PG8_STAGE(PG8_SB(1, 0), cB + kstep, voffB); PG8_STAGE_A(PG8_SA(1, 0), oAc[0], kstep); PG8_STAGE(PG8_SB(1, 1), cB + hstep + kstep, voffB);
    PG8_WAIT_V(6); PG8_BAR;
    for (;;) {
        const bool has_next = S.next(ui + 1, nxt);
        const char* nB = has_next ? (const char*)g.Bt + nxt.bo + (size_t)nxt.pn * tstep : cB;
        unsigned dAn = 0u;
        if constexpr (Rows::LINEAR) { if (has_next) dAn = (unsigned)(nxt.pm - cur.pm) * (unsigned)(BM * K * 2); }
        else { if (has_next) PG8_AOFF(oAn, nxt);
            else {
#pragma unroll
                for (int _h = 0; _h < 2; ++_h)
#pragma unroll
                    for (int _i = 0; _i < 2; ++_i) oAn[_h][_i] = oAc[_h][_i]; } }
        for (int t = 0; t < nt; t += 2) {
            const bool last = (t == nt - 2);
            const size_t k1 = (size_t)(t + 1) * kstep, k2 = last ? 0 : (size_t)(t + 2) * kstep, k3 = k2 + kstep;
            unsigned o20[2], o21[2];
#pragma unroll
            for (int _i = 0; _i < 2; ++_i) { if constexpr (Rows::LINEAR) { o20[_i] = oAc[0][_i] + (last ? dAn : 0u); o21[_i] = oAc[1][_i] + (last ? dAn : 0u); }
                else { o20[_i] = last ? oAn[0][_i] : oAc[0][_i]; o21[_i] = last ? oAn[1][_i] : oAc[1][_i]; } }
            const char* b2 = last ? nB : cB + (size_t)(t + 2) * kstep;
            const char* b3 = b2 + kstep;
            if (last && has_next) S.a_ready(nxt);
            PG8_LDB(B0, 0, 0); PG8_SCHED; PG8_LDA(At, 0, 0); if constexpr (!HALFM) PG8_STAGE_A(PG8_SA(1, 1), oAc[1], k1);
            PG8_WAIT_L(8); PG8_BAR; PG8_WAIT_L(0); PG8_MMA(0, 0, At, B0); PG8_BAR; PG8_SCHED;
            PG8_LDB(B1, 0, 1); PG8_STAGE(PG8_SB(0, 0), b2, voffB);
            PG8_BAR; PG8_WAIT_L(0); PG8_MMA(0, 1, At, B1); PG8_BAR;
            if constexpr (!HALFM) PG8_LDA(At, 0, 1);
            PG8_STAGE_A(PG8_SA(0, 0), o20, k2);
            PG8_BAR; PG8_WAIT_L(0); if constexpr (!HALFM) PG8_MMA(1, 0, At, B0);
            PG8_BAR; PG8_SCHED;
            PG8_STAGE(PG8_SB(0, 1), b2 + hstep, voffB);
            PG8_WAIT_V(6); PG8_BAR; if constexpr (!HALFM) PG8_MMA(1, 1, At, B1);
            PG8_BAR;
            PG8_LDB(B0, 1, 0); PG8_SCHED; PG8_LDA(At, 1, 0); if constexpr (!HALFM) PG8_STAGE_A(PG8_SA(0, 1), o21, k2);
            PG8_WAIT_L(8); PG8_BAR; PG8_WAIT_L(0); PG8_MMA(0, 0, At, B0); PG8_BAR; PG8_SCHED;
            PG8_LDB(B1, 1, 1); PG8_STAGE(PG8_SB(1, 0), b3, voffB);
            PG8_BAR; PG8_WAIT_L(0); PG8_MMA(0, 1, At, B1); PG8_BAR;
            if constexpr (!HALFM) PG8_LDA(At, 1, 1);
            PG8_STAGE_A(PG8_SA(1, 0), o20, k3);
            PG8_BAR; PG8_WAIT_L(0); if constexpr (!HALFM) PG8_MMA(1, 0, At, B0);
            PG8_BAR; PG8_SCHED;
            PG8_STAGE(PG8_SB(1, 1), b3 + hstep, voffB);
            PG8_WAIT_V(6); PG8_BAR; if constexpr (!HALFM) PG8_MMA(1, 1, At, B1);
            PG8_BAR;
        }
        E(acc, cur, wr, wc, fr, fq); S.done(cur);
        if (!has_next) break;
#pragma unroll
        for (int a = 0; a < 2; ++a)
#pragma unroll
            for (int b = 0; b < 2; ++b)
#pragma unroll
                for (int m = 0; m < 4; ++m)
#pragma unroll
                    for (int n = 0; n < 2; ++n) acc[a][b][m][n] = (f32x4){0.f, 0.f, 0.f, 0.f};
        cur = nxt; cB = nB; ++ui;
#pragma unroll
        for (int _h = 0; _h < 2; ++_h)
#pragma unroll
            for (int _i = 0; _i < 2; ++_i) { if constexpr (Rows::LINEAR) oAc[_h][_i] += dAn; else oAc[_h][_i] = oAn[_h][_i]; }
    }
    PG8_WAIT_V(0);
    if (wr == 0) PG8_BAR;
    PG8_BAR;
#undef PG8_SA
#undef PG8_SB
#undef PG8_STAGE
#undef PG8_STAGE_A
#undef PG8_AOFF
#undef PG8_LDA
#undef PG8_LDB
#undef PG8_MMA
#undef PG8_WAIT_V
#undef PG8_WAIT_L
#undef PG8_BAR
#undef PG8_SCHED
}
}

#define XB_TMO      128
#define XB_XCNT(j)  (256  + 64 * (j))
#define XB_XSUB(j)  (1280 + 64 * (j))
#define XB_XGEN(j)  (2304 + 64 * (j))
#define XB_TOP      3328
#define XB_TOPGEN   3392
#define XCD_BAR_WORDS 3456
#define XB_SPIN_CAP (1u << 18)
__device__ __forceinline__ unsigned xb_ld(unsigned* p)              { return __hip_atomic_load(p, __ATOMIC_RELAXED, __HIP_MEMORY_SCOPE_AGENT); }
__device__ __forceinline__ unsigned xb_add(unsigned* p, unsigned v) { return __hip_atomic_fetch_add(p, v, __ATOMIC_RELAXED, __HIP_MEMORY_SCOPE_AGENT); }
__device__ __forceinline__ unsigned xb_xcc_id() { return (unsigned)__builtin_amdgcn_s_getreg((3 << 11) | 20) & 0xFu; }
#define XB_SPIN(cond, bar) do { unsigned _sp = 0; while (cond) { __builtin_amdgcn_s_sleep(1); \
    if ((++_sp & 255u) == 0u) { if (xb_ld(&(bar)[XB_TMO])) break; if (_sp > XB_SPIN_CAP) { atomicAdd(&(bar)[XB_TMO], 1u); break; } } } } while (0)
struct XcdBarrier { unsigned* bar; unsigned x; volatile LAS unsigned* st; };
__device__ __forceinline__ XcdBarrier xcd_barrier_post(unsigned* bar, volatile LAS unsigned* st) {
    XcdBarrier b; b.bar = bar; b.x = xb_xcc_id(); b.st = st;
    if (threadIdx.x == 0) (void)xb_add(&bar[XB_XCNT(b.x)], 1u);
    return b;
}
__device__ __forceinline__ void xcd_barrier_complete(unsigned* bar, unsigned x, unsigned& nloc, unsigned& nx) {
    const unsigned G = gridDim.x * gridDim.y * gridDim.z;
    unsigned sum, cnt, mine, sp = 0u;
    for (;;) {
        sum = 0u; cnt = 0u; mine = 0u;
#pragma unroll
        for (unsigned j = 0; j < 16; ++j) { const unsigned c = xb_ld(&bar[XB_XCNT(j)]); sum += c; cnt += (c > 0u) ? 1u : 0u; mine = (j == x) ? c : mine; }
        if (sum == G) break;
        __builtin_amdgcn_s_sleep(1);
        if ((++sp & 255u) == 0u) { if (xb_ld(&bar[XB_TMO])) break; if (sp > XB_SPIN_CAP) { atomicAdd(&bar[XB_TMO], 1u); break; } }
    }
    nloc = mine > 0u ? mine : 1u; nx = cnt > 0u ? cnt : 1u;
}
__device__ __forceinline__ void xcd_barrier(const XcdBarrier& b) {
    asm volatile("s_waitcnt vmcnt(0)" ::: "memory");
    __syncthreads();
    if (threadIdx.x == 0) {
        unsigned* bar = b.bar;
        __builtin_amdgcn_s_waitcnt(0);
        unsigned nloc = b.st[0], nx = b.st[1];
        if (nloc == 0u) { xcd_barrier_complete(bar, b.x, nloc, nx); b.st[0] = nloc; b.st[1] = nx; }
        const unsigned old = xb_add(&bar[XB_XSUB(b.x)], 1u);
        const unsigned gen = old / nloc;
        if (old + 1u == (gen + 1u) * nloc) {
            __builtin_amdgcn_fence(__ATOMIC_RELEASE, "agent");
            asm volatile("s_waitcnt vmcnt(0)" ::: "memory");
            const unsigned og = xb_add(&bar[XB_TOP], 1u);
            const unsigned tg = og / nx;
            if (og + 1u == (tg + 1u) * nx) xb_add(&bar[XB_TOPGEN], 1u);
            else XB_SPIN(xb_ld(&bar[XB_TOPGEN]) == tg, bar);
            __builtin_amdgcn_fence(__ATOMIC_ACQUIRE, "agent");
            xb_add(&bar[XB_XGEN(b.x)], 1u);
            asm volatile("s_waitcnt vmcnt(0)" ::: "memory");
        } else {
            XB_SPIN(xb_ld(&bar[XB_XGEN(b.x)]) == gen, bar);
            __builtin_amdgcn_fence(__ATOMIC_ACQUIRE, "agent");
            asm volatile("s_waitcnt vmcnt(0)" ::: "memory");
        }
    }
    __syncthreads();
}

struct Args { const float* in[N_IN]; float* out; unsigned char* ws; int ph_lo, ph_hi; int pad0, pad1; };
extern __shared__ __attribute__((aligned(16))) unsigned char lds_raw[];
constexpr int PTR_OFF = MISC_OFF + 2048;
struct Ctx {
    DI unsigned long long raw(int i) const { volatile LAS unsigned* t = (volatile LAS unsigned*)((LAS unsigned char*)lds_raw + PTR_OFF) + 2 * i;
        const unsigned lo = __builtin_amdgcn_readfirstlane(t[0]), hi = __builtin_amdgcn_readfirstlane(t[1]); return ((unsigned long long)hi << 32) | lo; }
    DI const GAS float* in(int i) const { return (const GAS float*)raw(i); }
    DI GAS float* out() const { return (GAS float*)raw(N_IN); }
    DI GAS unsigned char* ws() const { return (GAS unsigned char*)raw(N_IN + 1); }
};

DI void transpose_item(const GAS float* W, int N, int k0, int n0, GAS bf16* WT, int Kd, int drow0, LAS float* scr, int lane) {
    float wv[32];
#pragma unroll
    for (int i = 0; i < 32; ++i) wv[i] = W[(size_t)(k0 + 2 * i + (lane >> 5)) * N + n0 + (lane & 31)];
#pragma unroll
    for (int i = 0; i < 32; ++i) scr[(2 * i + (lane >> 5)) * 33 + (lane & 31)] = wv[i];
    LDS_WAIT(); asm volatile("" ::: "memory");
    const int c = lane & 7;
#pragma unroll
    for (int j = 0; j < 4; ++j) { const int n = (lane >> 3) + 8 * j; const LAS float* s = scr + (8 * c) * 33 + n;
        v4u o; o.x = pk2(s[0 * 33], s[1 * 33]); o.y = pk2(s[2 * 33], s[3 * 33]); o.z = pk2(s[4 * 33], s[5 * 33]); o.w = pk2(s[6 * 33], s[7 * 33]);
        *(GAS v4u*)(WT + (size_t)(drow0 + n) * Kd + k0 + 8 * c) = o; }
    LDS_WAIT(); asm volatile("" ::: "memory");
}

DI void weight_copies(const Ctx& a, int l, LAS unsigned char* lds, int tid, int lane, int wave, int gwv, int ngw, int gt, int ngt, int part = 0, int frk = -1, int nfree = 0, int pre = 0) {
    GAS unsigned char* ws = a.ws();
    if (part != 2 && part != 3) for (int i = gt; i < 128 * 1024 / 8; i += ngt) *(GAS v4u*)(ws + WS_WTIN + (size_t)l * WTIN_L + (size_t)3200 * D * 2 + (size_t)i * 16) = (v4u){0u, 0u, 0u, 0u};
    LAS float* scr = (LAS float*)(lds + wave * 16384);
    constexpr int IT_IN = 16 * 100, IT_OUT = 16 * 32, IT_UQ = 3 * 12, IT_UKV = 2 * 16, IT_GU = 32 * 16 * 16, IT_DN = 32 * 4 * 32;
    constexpr int NITEMS = IT_IN + IT_OUT + IT_UQ + IT_UKV + IT_GU + IT_DN;
    const bool p1 = part == 1 || part == 5;
    const int it_lo = part == 2 ? NITEMS - IT_GU - IT_DN : (part == 3 ? NITEMS - IT_DN : 0), it_hi = part == 2 ? NITEMS - IT_DN : NITEMS, NC = NITEMS - IT_GU - (part == 5 ? IT_DN : 0);
    const int npre = (p1 && frk >= 0 && nfree > 0 && frk < pre) ? (pre - frk + nfree - 1) / nfree : 0;
    for (int n = 0; ; ++n) { int it;
        if (p1) { const int ci = n < npre ? frk + nfree * n : pre + gwv + ngw * (n - npre); if (ci >= NC) break; it = ci < NITEMS - IT_GU - IT_DN ? ci : ci + IT_GU; }
        else { it = it_lo + gwv + ngw * n; if (it >= it_hi) break; }
        int r = it;
        if (r < IT_IN) { const int kb = r / 100, nb = r % 100;
            transpose_item(a.in(I_WIN) + (size_t)l * D * DIN, DIN, kb * 64, nb * 32, (GAS bf16*)(ws + WS_WTIN + (size_t)l * WTIN_L), D, nb * 32, scr, lane); continue; } r -= IT_IN;
        if (r < IT_OUT) { const int kb = r / 32, nb = r % 32;
            transpose_item(a.in(I_WOUT) + (size_t)l * D * D, D, kb * 64, nb * 32, (GAS bf16*)(ws + WS_WTOUT + (size_t)l * D * D * 2), D, nb * 32, scr, lane); continue; } r -= IT_OUT;
        if (r < IT_UQ) { const int kb = r / 12, nb = r % 12;
            transpose_item(a.in(I_WUQ) + (size_t)l * 192 * 384, 384, kb * 64, nb * 32, (GAS bf16*)(ws + WS_WTUQ + (size_t)l * 384 * 192 * 2), 192, nb * 32, scr, lane); continue; } r -= IT_UQ;
        if (r < IT_UKV) { const int kb = r / 16, nb = r % 16;
            transpose_item(a.in(I_WUKV) + (size_t)l * 128 * 512, 512, kb * 64, nb * 32, (GAS bf16*)(ws + WS_WTUKV + (size_t)l * 512 * 128 * 2), 128, nb * 32, scr, lane); continue; } r -= IT_UKV;
        if (r < IT_GU) { const int le = l * 32 + r / 256, q = r % 256, kb = q / 16, nb = q % 16; const int n0 = nb * 32, c0 = n0 & 255, isup = n0 >> 8;
            const int drow0 = (c0 >> 7) * 256 + isup * 128 + (c0 & 127);
            transpose_item(a.in(I_WGU) + (size_t)le * D * 512, 512, kb * 64, n0, (GAS bf16*)(ws + WS_WTGU + (size_t)le * 512 * D * 2), D, drow0, scr, lane); continue; } r -= IT_GU;
        { const int le = l * 32 + r / 128, q = r % 128, kb = q / 32, nb = q % 32;
            transpose_item(a.in(I_WDN) + (size_t)le * 256 * D, D, kb * 64, nb * 32, (GAS bf16*)(ws + WS_WTDN + (size_t)le * D * 256 * 2), 256, nb * 32, scr, lane); }
    }
}

DI void mod_fill(const Ctx& a, LAS unsigned char* lds, int tid) {
    LAS float* S = (LAS float*)lds; const GAS float* cvec = a.in(I_C); const GAS float* cctx = a.in(I_CCTX);
    for (int i = tid; i < 5 * 1024; i += 512) { const int r = i >> 10, k = i & 1023; const float v = r < 4 ? cvec[r * 1024 + k] : cctx[k]; S[i] = silu_(v); }
}
DI void mod_unit(const Ctx& a, LAS unsigned char* lds, int tid, int u) {
    GAS float* MOD = (GAS float*)(a.ws() + WS_MOD);
    LAS float* S = (LAS float*)lds;
    LAS float* R = (LAS float*)(lds + 5 * 1024 * 4);
    const int l = u / 96, cl = tid & 63, n = (u % 96) * 64 + cl, ks = tid >> 6;
    const GAS float* W = a.in(I_WMOD) + (size_t)l * 1024 * 6144 + n; const GAS float* bmod = a.in(I_BMOD);
    float acc[5] = {0.f, 0.f, 0.f, 0.f, 0.f};
#pragma unroll 2
    for (int k = ks * 128; k < ks * 128 + 128; k += 8) { float w[8];
#pragma unroll
        for (int j = 0; j < 8; ++j) w[j] = W[(size_t)(k + j) * 6144];
#pragma unroll
        for (int r = 0; r < 5; ++r) { const f32x4 s0 = *(const LAS f32x4*)(S + r * 1024 + k), s1 = *(const LAS f32x4*)(S + r * 1024 + k + 4);
            acc[r] += ((s0.x * w[0] + s0.y * w[1]) + (s0.z * w[2] + s0.w * w[3])) + ((s1.x * w[4] + s1.y * w[5]) + (s1.z * w[6] + s1.w * w[7])); } }
#pragma unroll
    for (int r = 0; r < 5; ++r) R[(ks * 5 + r) * 64 + cl] = acc[r];
    __syncthreads();
    if (tid < 320) { const int r = tid >> 6; float s = 0.f;
#pragma unroll
        for (int k2 = 0; k2 < 8; ++k2) s += R[(k2 * 5 + r) * 64 + cl];
        MOD[(size_t)(l * 5 + r) * 6144 + n] = s + bmod[l * 6144 + n]; }
    __syncthreads();
}
DI bool mod_l1_deferred(int G) { return G == 256; }
DI void phase_prologue(const Ctx& a, LAS unsigned char* lds, int tid, int lane, int wave, int bid, int G) {
    GAS unsigned char* ws = a.ws();
    const int nmod = mod_l1_deferred(G) ? 96 : 192;
    {
        if (bid < nmod) mod_fill(a, lds, tid);
        __syncthreads();
        for (int u = bid; u < nmod; u += G) mod_unit(a, lds, tid, u);
    }
    for (int i = bid * 512 + tid; i < 2 * 48 * 1024; i += G * 512) { const int l = i / (48 * 1024), r = i % (48 * 1024), c = r >> 10, k = r & 1023;
        const float w = c < 4 ? a.in(I_WRG)[(size_t)l * D * 4 + k * 4 + c] : (c < 36 ? a.in(I_WRE)[(size_t)l * D * 32 + k * 32 + (c - 4)] : 0.f);
        const unsigned hi = f2bf(w); const float lo = w - bf2f(hi);
        GAS bf16* WR = (GAS bf16*)(ws + WS_WR) + (size_t)l * 2 * 48 * 1024;
        WR[c * 1024 + k] = (bf16)hi; WR[48 * 1024 + c * 1024 + k] = (bf16)f2bf(lo); }
    weight_copies(a, 0, lds, tid, lane, wave, bid * 8 + wave, G * 8, bid * 512 + tid, G * 512, 5, (G == 256 && bid >= 96) ? (bid - 96) * 8 + wave : -1, 1280, G == 256 ? 4096 : 0);
}

DI void norm_row_store(const f32x4 (&v)[4], const GAS float* g, const GAS float* shift, const GAS float* scale, GAS bf16* hrow, int lane) {
    float ss = 0.f;
#pragma unroll
    for (int j = 0; j < 4; ++j) ss += (v[j].x * v[j].x + v[j].y * v[j].y) + (v[j].z * v[j].z + v[j].w * v[j].w);
    const float rstd = rsqrtf(wave_sum(ss) * (1.f / D) + EPS);
#pragma unroll
    for (int j = 0; j < 4; ++j) { const int c = 4 * lane + 256 * j;
        const f32x4 gg = *(const GAS f32x4*)(g + c), sh = *(const GAS f32x4*)(shift + c), sc = *(const GAS f32x4*)(scale + c);
        const f32x4 y = v[j] * rstd * gg * (1.f + sc) + sh;
        v2u o; o.x = pk2(y.x, y.y); o.y = pk2(y.z, y.w); *(GAS v2u*)(hrow + c) = o; }
}

struct NormPar { f32x4 w[4], sh[4]; };
DI void load_normpar(NormPar& p, const GAS float* g, const GAS float* shift, const GAS float* scale, int lane) {
#pragma unroll
    for (int j = 0; j < 4; ++j) { const int c = 4 * lane + 256 * j; const f32x4 gg = *(const GAS f32x4*)(g + c), sc = *(const GAS f32x4*)(scale + c); p.w[j] = gg * (1.f + sc); p.sh[j] = *(const GAS f32x4*)(shift + c); }
}
DI void norm_row_store_c(const f32x4 (&v)[4], const NormPar& p, GAS bf16* hrow, int lane) {
    float ss = 0.f;
#pragma unroll
    for (int j = 0; j < 4; ++j) ss += (v[j].x * v[j].x + v[j].y * v[j].y) + (v[j].z * v[j].z + v[j].w * v[j].w);
    const float rstd = rsqrtf(wave_sum(ss) * (1.f / D) + EPS);
#pragma unroll
    for (int j = 0; j < 4; ++j) { const f32x4 y = v[j] * rstd * p.w[j] + p.sh[j]; v2u o; o.x = pk2(y.x, y.y); o.y = pk2(y.z, y.w); *(GAS v2u*)(hrow + 4 * lane + 256 * j) = o; }
}

DI void phase_norm1_l0(const Ctx& a, int lane, int gw, int NGW) {
    GAS unsigned char* ws = a.ws(); GAS bf16* H = (GAS bf16*)(ws + WS_H); const GAS float* MOD = (const GAS float*)(ws + WS_MOD);
    const GAS float* xin = a.in(I_X); const GAS float* cin = a.in(I_CTX); const GAS float* n1g = a.in(I_N1G);
    const int nwg = NGW >> 3, R = (MTOK + nwg - 1) / nwg, m_beg = (gw >> 3) * R + (gw & 7), m_end = min(((gw >> 3) + 1) * R, MTOK);
    NormPar np; int cb = -1;
#pragma unroll 1
    for (int m = m_beg; m < m_end; m += 8) {
        const GAS float* src = m < NCTX ? cin + (size_t)m * D : xin + (size_t)(m - NCTX) * D;
        f32x4 v[4];
#pragma unroll
        for (int j = 0; j < 4; ++j) v[j] = *(const GAS f32x4*)(src + 4 * lane + 256 * j);
        const int b = bidx_of_row(m);
        if (b != cb) { const GAS float* mb = MOD + (size_t)b * 6144; load_normpar(np, n1g, mb, mb + 1024, lane); cb = b; }
        norm_row_store_c(v, np, H + (size_t)m * D, lane);
    }
}

DI bf16x8 ld8(const LAS bf16* p) { return *(const LAS bf16x8*)p; }
DI bf16x8 ld8(const GAS bf16* p) { return *(const GAS bf16x8*)p; }
template <class PA, class PB>
DI f32x4 mma16(PA A, int lda, PB B, int ldb, int K, int lane) {
    f32x4 acc = {0.f, 0.f, 0.f, 0.f};
    const int r = lane & 15, q = (lane >> 4) * 8;
    for (int k = 0; k < K; k += 32) {
        const bf16x8 av = ld8(A + r * lda + k + q);
        const bf16x8 bv = ld8(B + r * ldb + k + q);
        acc = __builtin_amdgcn_mfma_f32_16x16x32_bf16(av, bv, acc, 0, 0, 0);
    }
    return acc;
}

constexpr int CQ_P = 200, CKV_P = 136, STG_P = 520;
constexpr int PR = 64, PL_CQ = 0, PL_CKV = 25600, PL_RK = 43008, PL_STG = 47104, PL_T = PL_STG;
DI float rope_ang(int t, int ri) { const int ax = ri >> 4, f = ri & 7; const float p = (float)(ax == 0 ? (t >> 6) : (t & 63)); return p * __builtin_amdgcn_exp2f(-1.6609640474436813f * (float)f) * 0.15915494309189535f; }
DI void prep_unit(const Ctx& a, int l, int unit, LAS unsigned char* lds, int tid, int lane, int wave) {
    GAS unsigned char* ws = a.ws();
    const GAS bf16* P = (const GAS bf16*)(ws + WS_P);
    LAS bf16* CQ = (LAS bf16*)(lds + PL_CQ); LAS bf16* CKV = (LAS bf16*)(lds + PL_CKV); LAS bf16* STG = (LAS bf16*)(lds + PL_STG); LAS bf16* RK = (LAS bf16*)(lds + PL_RK); LAS bf16* T = (LAS bf16*)(lds + PL_T);
    const int m0 = unit * PR;
    const bool isctx = m0 < NCTX;
    const int bb = isctx ? (m0 >> 8) : ((m0 - NCTX) >> 12);
    const int pos0 = isctx ? (m0 & 255) : (256 + ((m0 - NCTX) & 4095));
    const int t0 = isctx ? 0 : ((m0 - NCTX) & 4095);
    { const GAS float* gq = a.in(I_QNG) + l * 192; const GAS float* gkv = a.in(I_KVNG) + l * 128;
        const bool isq = lane < 24, iskv = lane >= 24 && lane < 40; const int pc = isq ? lane : lane - 24;
        float gn[8];
#pragma unroll
        for (int e = 0; e < 8; ++e) gn[e] = isq ? gq[pc * 8 + e] : (iskv ? gkv[pc * 8 + e] : 0.f);
#pragma unroll
        for (int rr = 0; rr < PR / 8; ++rr) { const int r = wave * (PR / 8) + rr; float x[8];
            v4u w = (v4u){0u, 0u, 0u, 0u}; if (lane < 40) w = *(const GAS v4u*)(P + (size_t)(m0 + r) * PP + (isq ? CD_Q : CD_KV) + pc * 8);
            unpack8(w, x); float ss = 0.f;
#pragma unroll
            for (int e = 0; e < 8; ++e) ss += x[e] * x[e];
            const float sq = wave_sum(isq ? ss : 0.f), skv = wave_sum(iskv ? ss : 0.f);
            const float rs = isq ? rsqrtf(sq * (1.f / 192.f) + EPS) : rsqrtf(skv * (1.f / 128.f) + EPS);
#pragma unroll
            for (int e = 0; e < 8; ++e) x[e] *= rs * gn[e];
            const v4u o = (v4u){pk2(x[0], x[1]), pk2(x[2], x[3]), pk2(x[4], x[5]), pk2(x[6], x[7])};
            if (isq) *(LAS v4u*)(CQ + r * CQ_P + pc * 8) = o; else if (iskv) *(LAS v4u*)(CKV + r * CKV_P + pc * 8) = o; } }
    for (int e = tid; e < PR * 32; e += 512) { const int r = e >> 5, ri = e & 31; const GAS bf16* prow = P + (size_t)(m0 + r) * PP + CD_R;
        float v = bf2f(prow[ri]);
        if (!isctx) { const float pv = bf2f(prow[ri ^ 8]); const float ang = rope_ang(t0 + r, ri); const float cs = __builtin_amdgcn_cosf(ang), sn = __builtin_amdgcn_sinf(ang);
            v = ((ri >> 3) & 1) == 0 ? (v * cs - pv * sn) : (pv * sn + v * cs); }
        RK[r * 32 + ri] = (bf16)f2bf(v); }
    for (int e = tid; e < PR * 32; e += 512) { const int r = e >> 5, c8 = e & 31; *(LAS v4u*)(T + r * 264 + c8 * 8) = *(const GAS v4u*)(P + (size_t)(m0 + r) * PP + CB_V + c8 * 8); }
    __syncthreads();
    GAS bf16* QM = (GAS bf16*)(ws + WS_QM); GAS bf16* KM = (GAS bf16*)(ws + WS_KM); GAS bf16* VM = (GAS bf16*)(ws + WS_VM); GAS bf16* VNT = (GAS bf16*)(ws + WS_VNT);
    const GAS bf16* WTQ = (const GAS bf16*)(ws + WS_WTUQ + (size_t)l * 384 * 192 * 2);
    const GAS bf16* WTKV = (const GAS bf16*)(ws + WS_WTUKV + (size_t)l * 512 * 128 * 2);
    const float qs = 0.10206207261596575f * LOG2E;
    const int fr = lane & 15, fq = lane >> 4;
    for (int e = tid; e < 256 * (PR / 8); e += 512) { const int col = e / (PR / 8), p8 = e % (PR / 8); unsigned hv[8];
#pragma unroll
        for (int j = 0; j < 8; ++j) hv[j] = T[(p8 * 8 + j) * 264 + col];
        *(GAS v4u*)(VNT + ((size_t)(bb * 4) * 64 + col) * NKEY + pos0 + p8 * 8) = (v4u){hv[0] | (hv[1] << 16), hv[2] | (hv[3] << 16), hv[4] | (hv[5] << 16), hv[6] | (hv[7] << 16)}; }
    __syncthreads();
    { bf16x8 bfr[3][6];
#pragma unroll
      for (int i = 0; i < 3; ++i)
#pragma unroll
        for (int ks = 0; ks < 6; ++ks) bfr[i][ks] = *(const GAS bf16x8*)(WTQ + (size_t)((wave + 8 * i) * 16 + fr) * 192 + ks * 32 + fq * 8);
#pragma unroll
      for (int i = 0; i < 3; ++i) { const int nb = wave + 8 * i;
        const int c = nb * 16 + fr, within = c % 96;
#pragma unroll
        for (int mb = 0; mb < PR / 16; ++mb) { f32x4 acc = {0.f, 0.f, 0.f, 0.f};
#pragma unroll
            for (int ks = 0; ks < 6; ++ks) acc = __builtin_amdgcn_mfma_f32_16x16x32_bf16(*(const LAS bf16x8*)(CQ + (mb * 16 + fr) * CQ_P + ks * 32 + fq * 8), bfr[i][ks], acc, 0, 0, 0);
#pragma unroll
            for (int j = 0; j < 4; ++j) { const int r = mb * 16 + 4 * fq + j; float v = acc[j]; const float pv = __shfl_xor(v, 8);
                if (within >= 64 && !isctx) { const int ri = within - 64; const float ang = rope_ang(t0 + r, ri); const float cs = __builtin_amdgcn_cosf(ang), sn = __builtin_amdgcn_sinf(ang);
                    v = ((ri >> 3) & 1) == 0 ? (v * cs - pv * sn) : (pv * sn + v * cs); }
                STG[r * STG_P + c] = (bf16)f2bf(v * qs); } } } }
    __syncthreads();
    for (int e = tid; e < PR * 48; e += 512) { const int r = e / 48, hp = e % 48, hd = hp / 12, pc = hp % 12;
        *(GAS v4u*)(QM + ((size_t)(bb * 4 + hd) * NKEY + pos0 + r) * 96 + pc * 8) = *(const LAS v4u*)(STG + r * STG_P + hd * 96 + pc * 8); }
    __syncthreads();
    { bf16x8 bfr[4][4];
#pragma unroll
      for (int i = 0; i < 4; ++i)
#pragma unroll
        for (int ks = 0; ks < 4; ++ks) bfr[i][ks] = *(const GAS bf16x8*)(WTKV + (size_t)((wave + 8 * i) * 16 + fr) * 128 + ks * 32 + fq * 8);
#pragma unroll
      for (int i = 0; i < 4; ++i) { const int nb = wave + 8 * i;
#pragma unroll
        for (int mb = 0; mb < PR / 16; ++mb) { f32x4 acc = {0.f, 0.f, 0.f, 0.f};
#pragma unroll
            for (int ks = 0; ks < 4; ++ks) acc = __builtin_amdgcn_mfma_f32_16x16x32_bf16(*(const LAS bf16x8*)(CKV + (mb * 16 + fr) * CKV_P + ks * 32 + fq * 8), bfr[i][ks], acc, 0, 0, 0);
#pragma unroll
            for (int j = 0; j < 4; ++j) STG[(mb * 16 + 4 * fq + j) * STG_P + nb * 16 + fr] = (bf16)f2bf(acc[j]); } } }
    __syncthreads();
    for (int e = tid; e < PR * 48; e += 512) { const int r = e / 48, hp = e % 48, hd = hp / 12, pc = hp % 12;
        const v4u v = pc < 8 ? *(const LAS v4u*)(STG + r * STG_P + hd * 128 + pc * 8) : *(const LAS v4u*)(RK + r * 32 + (pc - 8) * 8);
        *(GAS v4u*)(KM + ((size_t)(bb * 4 + hd) * NKEY + pos0 + r) * 96 + pc * 8) = v; }
    for (int e = tid; e < 256 * (PR / 8); e += 512) { const int col = e / (PR / 8), p8 = e % (PR / 8), hd = col >> 6, dv = col & 63; unsigned hv[8];
#pragma unroll
        for (int j = 0; j < 8; ++j) hv[j] = STG[(p8 * 8 + j) * STG_P + hd * 128 + 64 + dv];
        *(GAS v4u*)(VM + ((size_t)(bb * 4 + hd) * 64 + dv) * NKEY + pos0 + p8 * 8) = (v4u){hv[0] | (hv[1] << 16), hv[2] | (hv[3] << 16), hv[4] | (hv[5] << 16), hv[6] | (hv[7] << 16)}; }
    __syncthreads();
}

constexpr int RP = 65;
DI int scan_row(int b, int dir, int c, int i) {
    const int s = 64 * c + i;
    if (dir == 0) return s < 256 ? b * 256 + s : NCTX + b * SEQ + (s - 256);
    return s < 256 ? b * 256 + 255 - s : NCTX + b * SEQ + SEQ - 1 - (s - 256);
}
#ifndef BAR_LDS
#define BAR_LDS() asm volatile("s_waitcnt lgkmcnt(0)\n\ts_barrier" ::: "memory")
#endif
constexpr int RC_P = 68;
constexpr int L_C = 0, L_QD = 17408, L_QE = 26624, L_KD = 35840, L_VT = 58880, L_ST = 68096, L_ATT = 77312, L_O = 86528, L_T = 103168;
template <int MIX> struct RecCfg { static constexpr int DK = MIX == 0 ? 64 : 32, DKP = DK + 8, NP = DK / 8, CPT = DK / 8; };
template <int MIX> struct RecPre {
    v4u fk;
    v4u zg[MIX == 1 ? 2 : 1];
    v4u qp;
    v4u vp; v4u sb;
};
template <int MIX, bool R3>
DI void rec_fetch(RecPre<MIX>& R, const GAS bf16* P, const GAS float* RSbase, int b, int h, int dir, int c, int tid) {
    constexpr int DK = RecCfg<MIX>::DK;
    const int lane = tid & 63, wave = tid >> 6;
    const GAS bf16* prow = P + (size_t)scan_row(b, dir, c, lane) * PP;
    if (MIX == 0) { R.fk = *(const GAS v4u*)(prow + (dir ? CA_FB : CA_FF) + h * 64 + 8 * wave); if (R3) R.qp = *(const GAS v4u*)(prow + CA_Q + h * 64 + 8 * wave); }
    else { const GAS bf16* zr = prow + (dir ? CC_ZB : CC_ZF); R.zg[0] = *(const GAS v4u*)zr; R.zg[1] = *(const GAS v4u*)(zr + 8);
        const v2u kk = *(const GAS v2u*)(prow + CC_K + h * 32 + 4 * wave); R.fk = (v4u){kk.x, kk.y, 0u, 0u};
        if (R3) { const v2u qq = *(const GAS v2u*)(prow + CC_Q + h * 32 + 4 * wave); R.qp = (v4u){qq.x, qq.y, 0u, 0u}; } }
    R.vp = *(const GAS v4u*)(P + (size_t)scan_row(b, dir, c, tid >> 3) * PP + (MIX == 0 ? CA_I : CC_V) + h * 64 + (tid & 7) * 8);
    if (R3 && tid < DK * 8) { const GAS bf16* rs = (const GAS bf16*)RSbase + (size_t)(((b * 4 + h) * 2 + dir) * NCHUNK + c) * DK * 64 + (tid >> 3) * 64 + (tid & 7) * 8; R.sb = *(const GAS v4u*)rs; }
}
DI float dpp_shr_(float v, int ctrl_sel) { const int iv = __builtin_bit_cast(int, v); int r;
    switch (ctrl_sel) { case 1: r = __builtin_amdgcn_update_dpp(0, iv, 0x111, 0xf, 0xf, true); break; case 2: r = __builtin_amdgcn_update_dpp(0, iv, 0x112, 0xf, 0xf, true); break;
                        case 4: r = __builtin_amdgcn_update_dpp(0, iv, 0x114, 0xf, 0xf, true); break; default: r = __builtin_amdgcn_update_dpp(0, iv, 0x118, 0xf, 0xf, true); break; }
    return __builtin_bit_cast(float, r); }
DI float scan64(float v) {
    v += dpp_shr_(v, 1); v += dpp_shr_(v, 2); v += dpp_shr_(v, 4); v += dpp_shr_(v, 8);
    v += __builtin_bit_cast(float, __builtin_amdgcn_update_dpp(0, __builtin_bit_cast(int, v), 0x142, 0xa, 0xf, false));
    v += __builtin_bit_cast(float, __builtin_amdgcn_update_dpp(0, __builtin_bit_cast(int, v), 0x143, 0xc, 0xf, false));
    return v; }
DI float lane_read(float v, int ln) { return __builtin_bit_cast(float, __builtin_amdgcn_readlane(__builtin_bit_cast(int, v), ln)); }
template <int MIX>
DI void rec_front(const RecPre<MIX>& R, const GAS float* lg, const GAS float* wgp, const GAS float* bgp, int l, int h, int dir, int wave, float (&kv)[RecCfg<MIX>::CPT], float (&cum)[RecCfg<MIX>::CPT]) {
    if (MIX == 0) { float z[8]; unpack8(R.fk, z);
#pragma unroll
        for (int e = 0; e < 8; ++e) { const int ch = h * 64 + 8 * wave + e; float lb = 0.f; if (l == 1) lb = sigmoid_(lg[512 + dir * 256 + ch] - lg[dir * 256 + ch]);
            const float f = lb + (1.f - lb) * sigmoid_(z[e]); cum[e] = scan64(__logf(f)); kv[e] = (1.f - lb) * sigmoid_(-z[e]); }
    } else { float z[16], kk[8]; unpack8(R.zg[0], z); unpack8(R.zg[1], z + 8); unpack8(R.fk, kk);
#pragma unroll
        for (int c = 0; c < 4; ++c) { const int ch = h * 32 + 4 * wave + c; float sacc = bgp[ch];
#pragma unroll
            for (int r = 0; r < 16; ++r) sacc += z[r] * wgp[r * 128 + ch];
            cum[c] = scan64(logsigmoid_(sacc) * (1.f / 16.f)); kv[c] = kk[c]; } }
}
template <int N> DI void st_bf16(LAS bf16* p, const float (&v)[N]) {
    if (N == 8) *(LAS v4u*)p = (v4u){pk2(v[0], v[1]), pk2(v[2], v[3]), pk2(v[4], v[5]), pk2(v[6], v[7])};
    else *(LAS v2u*)p = (v2u){pk2(v[0], v[1]), pk2(v[2], v[3])};
}
DI void rec_vt_store(const v4u vp, LAS bf16* VT, int tid) { const int j = tid >> 3, v8 = tid & 7; const unsigned ww[4] = {vp.x, vp.y, vp.z, vp.w};
#pragma unroll
    for (int e = 0; e < 8; ++e) VT[(v8 * 8 + e) * 72 + j] = (bf16)((ww[e >> 1] >> ((e & 1) * 16)) & 0xffffu); }

template <int MIX>
DI void rec_r1_run(const Ctx& a, int l, LAS unsigned char* lds, int tid, int bid, int G) {
    constexpr int DK = RecCfg<MIX>::DK, CPT = RecCfg<MIX>::CPT;
    const int lane = tid & 63, wave = __builtin_amdgcn_readfirstlane(tid >> 6);
    LAS bf16* KT = (LAS bf16*)(lds + L_KD); LAS bf16* VT = (LAS bf16*)(lds + L_VT);
    GAS unsigned char* wsb = a.ws(); const GAS bf16* P = (const GAS bf16*)(wsb + WS_P);
    GAS float* RSb = (GAS float*)(wsb + (MIX == 0 ? WS_RSH : WS_RSG)); GAS float* RAb = (GAS float*)(wsb + (MIX == 0 ? WS_RAH : WS_RAG));
    const GAS float* lg = a.in(I_LBL);
    const GAS float* wgF = a.in(I_WGF) + l * 16 * 128; const GAS float* wgB = a.in(I_WGB) + l * 16 * 128; const GAS float* bgF = a.in(I_BGF) + l * 128; const GAS float* bgB = a.in(I_BGB) + l * 128;
    constexpr int NU = 32 * NCHUNK;
    const bool rebal = (MIX == 0) && (G == 256);
    const int n0 = (rebal && bid < 16) ? 8 : 0, nn = (NU - 1 - bid) / G + 1, n1 = nn + ((rebal && bid >= 128) ? 1 : 0);
    auto unit_at = [&](int n) { if (n >= n1) return NU; if (n < nn) return bid + G * n; const int e = bid - 128; return (e & 15) + G * (e >> 4); };
    RecPre<MIX> Rs[2];
    int nidx = n0;
    int u0 = unit_at(nidx), u1 = unit_at(nidx + 1);
#pragma unroll
    for (int par = 0; par < 2; ++par) { const int unit = par ? u1 : u0; if (unit < NU) { const int c = unit % NCHUNK, chain = unit / NCHUNK; rec_fetch<MIX, false>(Rs[par], P, RSb, chain >> 3, (chain >> 1) & 3, chain & 1, c, tid); } }
    BAR_LDS();
#pragma unroll 1
    while (u0 < NU) {
        const int n2 = unit_at(nidx + 2), n3 = unit_at(nidx + 3);
#pragma unroll
        for (int par = 0; par < 2; ++par) { const int unit = par ? u1 : u0; if (unit < NU) { RecPre<MIX>& R = Rs[par];
            LAS bf16* KTp = par ? (LAS bf16*)(lds + L_ST) : KT; LAS bf16* VTp = par ? (LAS bf16*)(lds + L_ATT) : VT;
            const int c = unit % NCHUNK, chain = unit / NCHUNK, dir = chain & 1, h = (chain >> 1) & 3;
            { float kv[CPT], cum[CPT]; rec_front<MIX>(R, lg, dir ? wgB : wgF, dir ? bgB : bgF, l, h, dir, wave, kv, cum);
#pragma unroll
                for (int e = 0; e < CPT; ++e) { const float last = lane_read(cum[e], 63); KTp[(CPT * wave + e) * 72 + lane] = (bf16)f2bf(kv[e] * __expf(last - cum[e]));
                    if (lane == 63) RAb[(size_t)(chain * NCHUNK + c) * DK + CPT * wave + e] = __expf(cum[e]); } }
            rec_vt_store(R.vp, VTp, tid);
            { const int nu = par ? n3 : n2; if (nu < NU) { const int c2 = nu % NCHUNK, ch2 = nu / NCHUNK; rec_fetch<MIX, false>(R, P, RSb, ch2 >> 3, (ch2 >> 1) & 3, ch2 & 1, c2, tid); } } } }
        BAR_LDS();
#pragma unroll
        for (int par = 0; par < 2; ++par) { const int unit = par ? u1 : u0; if (unit < NU) {
            const LAS bf16* KTp = par ? (const LAS bf16*)(lds + L_ST) : KT; const LAS bf16* VTp = par ? (const LAS bf16*)(lds + L_ATT) : VT;
            const int c = unit % NCHUNK, chain = unit / NCHUNK;
            GAS bf16* RS = (GAS bf16*)RSb + (size_t)(chain * NCHUNK + c) * DK * 64;
#pragma unroll 1
            for (int tl = wave; tl < (DK / 16) * 4; tl += 8) { const int kb = tl >> 2, vb = tl & 3;
                const f32x4 acc = mma16(VTp + vb * 16 * 72, 72, KTp + kb * 16 * 72, 72, 64, lane);
                *(GAS v2u*)(RS + (kb * 16 + (lane & 15)) * 64 + vb * 16 + 4 * (lane >> 4)) = f4bf(acc); } } }
        BAR_LDS();
        nidx += 2; u0 = n2; u1 = n3;
    }
}

DI void rec_r2(const Ctx& a, int gtid, int gthreads) {
    GAS unsigned char* wsb = a.ws();
    const int G_ = gthreads >> 9, bid_ = gtid >> 9, wave_ = (gtid & 511) >> 6, lane_ = gtid & 63;
#pragma unroll 1
    for (int sl = wave_ * G_ + bid_; sl < (32 * 4096 + 32 * 2048) / 4 / 64; sl += G_ * 8) { const int e4 = sl * 64 + lane_; const int e = e4 * 4;
        const bool g = e >= 32 * 4096; const int ee = g ? e - 32 * 4096 : e; const int DK = g ? 32 : 64, per = DK * 64;
        const int chain = ee / per, kv = ee % per, k = kv >> 6;
        const GAS bf16* RS = (const GAS bf16*)(wsb + (g ? WS_RSG : WS_RSH)) + (size_t)chain * NCHUNK * per + kv;
        GAS bf16* SB = (GAS bf16*)(wsb + (g ? WS_SBG : WS_SBH)) + (size_t)chain * NCHUNK * per + kv;
        const GAS float* RA = (const GAS float*)(wsb + (g ? WS_RAG : WS_RAH)) + (size_t)chain * NCHUNK * DK + k;
        f32x4 S = {0.f, 0.f, 0.f, 0.f};
#pragma unroll 1
        for (int c = 0; c < NCHUNK; c += 4) { f32x4 U[4]; float A[4];
#pragma unroll
            for (int u = 0; u < 4; ++u) { U[u] = bf4f(*(const GAS v2u*)(RS + (size_t)(c + u) * per)); A[u] = RA[(c + u) * DK]; }
#pragma unroll
            for (int u = 0; u < 4; ++u) { *(GAS v2u*)(SB + (size_t)(c + u) * per) = (v2u){f2bf(S.x) | (f2bf(S.y) << 16), f2bf(S.z) | (f2bf(S.w) << 16)}; S = A[u] * S + U[u]; } }
    }
}

template <int MIX>
DI void rec_r3_run(const Ctx& a, int l, LAS unsigned char* lds, int tid, int bid, int G, bool keep_ctx) {
    constexpr int DK = RecCfg<MIX>::DK, DKP = RecCfg<MIX>::DKP, CPT = RecCfg<MIX>::CPT;
    const int lane = tid & 63, wave = __builtin_amdgcn_readfirstlane(tid >> 6);
    LAS bf16* QD = (LAS bf16*)(lds + L_QD); LAS bf16* QE = (LAS bf16*)(lds + L_QE); LAS bf16* KD = (LAS bf16*)(lds + L_KD);
    LAS bf16* VT = (LAS bf16*)(lds + L_VT); LAS bf16* ST = (LAS bf16*)(lds + L_ST); LAS bf16* ATT = (LAS bf16*)(lds + L_ATT); LAS float* Ob = (LAS float*)(lds + L_O);
    GAS unsigned char* wsb = a.ws(); const GAS bf16* P = (const GAS bf16*)(wsb + WS_P); GAS bf16* CAT = (GAS bf16*)(wsb + WS_CAT);
    const GAS float* RSb = (const GAS float*)(wsb + (MIX == 0 ? WS_SBH : WS_SBG));
    const GAS float* lg = a.in(I_LBL); const GAS float* ngb = a.in(MIX == 0 ? I_HNG : I_GNG) + l * 256;
    const GAS float* wgF = a.in(I_WGF) + l * 16 * 128; const GAS float* wgB = a.in(I_WGB) + l * 16 * 128; const GAS float* bgF = a.in(I_BGF) + l * 128; const GAS float* bgB = a.in(I_BGB) + l * 128;
    constexpr int nR = 16 * NCHUNK;
    const int nAct = keep_ctx ? nR : 16 * 64, first = (bid + (MIX == 0 ? 0 : G - 64)) % G;
    auto unit_of = [&](int a) { return a >= nAct ? nR : (keep_ctx ? a : (a >> 6) * NCHUNK + 4 + (a & 63)); };
    auto scanc = [&](int tc, int dir) { return dir == 0 ? tc : (tc < 4 ? 3 - tc : 71 - tc); };
    RecPre<MIX> Rs[2];
    int aidx = first;
    int unit = unit_of(aidx);
    if (unit < nR) { const int tc = unit % NCHUNK, bh = unit / NCHUNK; rec_fetch<MIX, true>(Rs[0], P, RSb, bh >> 2, bh & 3, 0, scanc(tc, 0), tid); rec_fetch<MIX, true>(Rs[1], P, RSb, bh >> 2, bh & 3, 1, scanc(tc, 1), tid); }
    BAR_LDS();
#pragma unroll 1
    while (unit < nR) {
        const int tc = unit % NCHUNK, bh = unit / NCHUNK, h = bh & 3, b = bh >> 2;
        const int nunit = unit_of(aidx + G);
        v4u gatep = (v4u){0u, 0u, 0u, 0u};
#pragma unroll
        for (int dir = 0; dir < 2; ++dir) { RecPre<MIX>& R = Rs[dir];
            if (tid < DK * 8) { const int k = tid >> 3, v8 = tid & 7;
#pragma unroll
                for (int e = 0; e < 4; ++e) { const unsigned w = e == 0 ? R.sb.x : (e == 1 ? R.sb.y : (e == 2 ? R.sb.z : R.sb.w)); ST[(v8 * 8 + 2 * e) * DKP + k] = (bf16)(w & 0xffffu); ST[(v8 * 8 + 2 * e + 1) * DKP + k] = (bf16)(w >> 16); } }
            rec_vt_store(R.vp, VT, tid);
            { const int ri = lane, I = ri >> 4; float kv[CPT], cm[CPT], qv[CPT], e8[CPT];
                rec_front<MIX>(R, lg, dir ? wgB : wgF, dir ? bgB : bgF, l, h, dir, wave, kv, cm);
                { float q8[8]; unpack8(R.qp, q8);
#pragma unroll
                    for (int e = 0; e < CPT; ++e) qv[e] = MIX == 0 ? silu_(q8[e]) * 0.125f : q8[e] * 0.17677669529663687f; }
#pragma unroll
                for (int e = 0; e < CPT; ++e) e8[e] = qv[e] * __expf(cm[e]);
                st_bf16<CPT>(QE + ri * DKP + CPT * wave, e8);
#pragma unroll
                for (int I2 = 0; I2 < 4; ++I2) {
                    float rf[CPT];
#pragma unroll
                    for (int e = 0; e < CPT; ++e) rf[e] = I2 == 0 ? 0.f : lane_read(cm[e], 16 * I2 - 1);
                    if (I2 >= I) {
                        if (I2 == I) {
#pragma unroll
                            for (int e = 0; e < CPT; ++e) e8[e] = qv[e] * __expf(cm[e] - rf[e]);
                            st_bf16<CPT>(QD + ri * DKP + CPT * wave, e8); }
#pragma unroll
                        for (int e = 0; e < CPT; ++e) e8[e] = kv[e] * __expf(fminf(rf[e] - cm[e], 80.f));
                        const int rowbase = I2 == 0 ? 0 : (I2 == 1 ? 16 : (I2 == 2 ? 48 : 96));
                        st_bf16<CPT>(KD + (rowbase + ri) * DKP + CPT * wave, e8); } } }
            if (dir == 0) {
                const int row = (tc < 4 ? b * 256 + tc * 64 : NCTX + b * SEQ + (tc - 4) * 64) + (tid >> 3);
                gatep = *(const GAS v4u*)(P + (size_t)row * PP + (MIX == 0 ? CA_G : CC_G) + h * 64 + (tid & 7) * 8); }
            if (nunit < nR) { const int tc2 = nunit % NCHUNK, bh2 = nunit / NCHUNK; rec_fetch<MIX, true>(R, P, RSb, bh2 >> 2, bh2 & 3, dir, scanc(tc2, dir), tid); }
            BAR_LDS();
            { const int I = wave >> 1, g = lane >> 4, c16 = lane & 15;
                const int rowbase = I == 0 ? 0 : (I == 1 ? 16 : (I == 2 ? 48 : 96));
                bf16x8 Bq[2];
#pragma unroll
                for (int m = 0; m < 2; ++m) {
                    f32x4 t0 = mma16(KD + (rowbase + 2 * m * 16) * DKP, DKP, QD + I * 16 * DKP, DKP, DK, lane);
                    f32x4 t1 = mma16(KD + (rowbase + (2 * m + 1) * 16) * DKP, DKP, QD + I * 16 * DKP, DKP, DK, lane);
#pragma unroll
                    for (int jj = 0; jj < 4; ++jj) { const bool up = 4 * g + jj > c16;
                        t0[jj] = (2 * m > I || (2 * m == I && up)) ? 0.f : t0[jj]; t1[jj] = (2 * m + 1 > I || (2 * m + 1 == I && up)) ? 0.f : t1[jj]; }
                    Bq[m] = pack8(t0[0], t0[1], t0[2], t0[3], t1[0], t1[1], t1[2], t1[3]); }
#pragma unroll
                for (int u = 0; u < 2; ++u) { const int vb = 2 * (wave & 1) + u; f32x4 acc = {0.f, 0.f, 0.f, 0.f};
#pragma unroll
                    for (int m = 0; m < 2; ++m) { const LAS bf16* vr = VT + (vb * 16 + c16) * 72 + 32 * m + 4 * g;
                        const v2u lo = *(const LAS v2u*)vr, hi = *(const LAS v2u*)(vr + 16);
                        acc = __builtin_amdgcn_mfma_f32_16x16x32_bf16(__builtin_bit_cast(bf16x8, (v4u){lo.x, lo.y, hi.x, hi.y}), Bq[m], acc, 0, 0, 0); }
                    const f32x4 acc2 = mma16(ST + vb * 16 * DKP, DKP, QE + I * 16 * DKP, DKP, DK, lane);
#pragma unroll
                    for (int jj = 0; jj < 4; ++jj) { const int i = I * 16 + c16, v = vb * 16 + 4 * g + jj; const float o = acc[jj] + acc2[jj];
                        if (dir == 0) Ob[i * RP + v] = o; else Ob[(63 - i) * RP + v] += o; } } }
            BAR_LDS();
        }
        { const int tl = tid >> 3, jg = tid & 7; float x[8]; float ss = 0.f;
#pragma unroll
            for (int vv = 0; vv < 8; ++vv) { x[vv] = Ob[tl * RP + jg * 8 + vv]; ss += x[vv] * x[vv]; }
            ss += __shfl_xor(ss, 1); ss += __shfl_xor(ss, 2); ss += __shfl_xor(ss, 4);
            const float rstd = rsqrtf(ss * (1.f / 64.f) + EPS);
            const int row = tc < 4 ? b * 256 + tc * 64 + tl : NCTX + b * SEQ + (tc - 4) * 64 + tl;
            const GAS float* ng = ngb + h * 64 + jg * 8;
            float gt[8]; unpack8(gatep, gt);
            float y[8];
#pragma unroll
            for (int vv = 0; vv < 8; ++vv) y[vv] = x[vv] * rstd * ng[vv] * silu_(gt[vv]);
            v4u ow; ow.x = pk2(y[0], y[1]); ow.y = pk2(y[2], y[3]); ow.z = pk2(y[4], y[5]); ow.w = pk2(y[6], y[7]);
            *(GAS v4u*)(CAT + (size_t)row * D + (MIX == 0 ? 0 : 512) + h * 64 + jg * 8) = ow; }
        unit = nunit; aidx += G;
    }
    __syncthreads();
}

typedef float f32x16 __attribute__((ext_vector_type(16)));
DI int swap23(int r) { return (r & 19) | ((r & 4) << 1) | ((r & 8) >> 1); }
struct AttnDesc {
    const GAS bf16* q; int qpitch;
    const GAS bf16* k; int kpitch;
    const GAS bf16* vt;
    GAS bf16* o; int opitch;
    int ntiles; float scale;
    int b, r0, rs0;
    const LAS float* rpb;
};
template <int DQK, bool NA>
DI void attn_mfma_unit(LAS unsigned char* lds, const AttnDesc& A, int tid, int lane, int wave) {
    constexpr int KP = DQK + 8, VP = 72, NS = DQK / 16, KPIECES = 64 * (DQK / 8);
    constexpr int BUF = 64 * KP * 2 + 64 * VP * 2;
    const int q = lane & 31, g = lane >> 5;
    auto tpos = [&](int t) { return NA ? (t < 4 ? 64 * t : 256 + 64 * (A.rs0 + t - 4)) : 64 * t; };
    auto krow = [&](int pos) { return NA ? (pos < 256 ? A.b * 256 + pos : NCTX + A.b * SEQ + (pos - 256)) : pos; };
    const int qi = NA ? (2 * (wave >> 2) + (q >> 4)) * 64 + 16 * (wave & 3) + (q & 15) : wave * 32 + q;
    const int kc0 = NA ? min(max(16 * (wave & 3) - 8, 0), 32) : 0;
    bf16x8 Qf[NS];
    { const GAS bf16* qp = A.q + (size_t)qi * A.qpitch + 8 * g;
#pragma unroll
        for (int s2 = 0; s2 < NS; ++s2) Qf[s2] = *(const GAS bf16x8*)(qp + 16 * s2); }
    f32x16 O[2];
#pragma unroll
    for (int db = 0; db < 2; ++db)
#pragma unroll
        for (int i = 0; i < 16; ++i) O[db][i] = 0.f;
    float mrun = -1e30f, lrun = 0.f;
    const int qr = NA ? A.r0 + (qi >> 6) : 0, qc = NA ? (qi & 63) : 0;
    const int wrs = NA ? min(max(qr - 4, 0), 56) : 0, cs = NA ? min(max(qc - 8, 0), 48) : 0;
    const int qr0 = NA ? A.r0 + 2 * (wave >> 2) : 0, wlo = NA ? min(max(qr0 - 4, 0), 56) : 0, whi = NA ? min(max(qr0 + 1 - 4, 0), 56) + 8 : 0;
    v4u kreg[2], vreg;
    auto gload = [&](int t) { const int pos = tpos(t);
#pragma unroll
        for (int u = 0; u < 2; ++u) { const int p = tid + 512 * u; if (p < KPIECES) { const int key = p / (DQK / 8), d8 = p % (DQK / 8); kreg[u] = *(const GAS v4u*)(A.k + (size_t)krow(pos + key) * A.kpitch + d8 * 8); } }
        vreg = *(const GAS v4u*)(A.vt + (size_t)(tid >> 3) * NKEY + pos + (tid & 7) * 8); };
    auto lstore = [&](int buf) { LAS bf16* Kt = (LAS bf16*)(lds + buf * BUF); LAS bf16* Vt = Kt + 64 * KP;
#pragma unroll
        for (int u = 0; u < 2; ++u) { const int p = tid + 512 * u; if (p < KPIECES) { const int key = p / (DQK / 8), d8 = p % (DQK / 8); *(LAS v4u*)(Kt + key * KP + d8 * 8) = kreg[u]; } }
        *(LAS v4u*)(Vt + (tid >> 3) * VP + (tid & 7) * 8) = vreg; };
    __syncthreads();
    gload(0); lstore(0);
    __syncthreads();
#pragma unroll 1
    for (int t = 0; t < A.ntiles; ++t) {
        const bool more = t + 1 < A.ntiles;
        if (more) gload(t + 1);
        bool active = true, rowok = true; int dr = 0;
        const bool win = NA && t >= 4;
        if (win) { const int wr = A.rs0 + t - 4; active = (wr >= wlo) && (wr < whi); rowok = (wr >= wrs) && (wr < wrs + 8); dr = min(max(wr - qr + 7, 0), 14); }
        if (active) {
            const LAS bf16* Kt = (const LAS bf16*)(lds + (t & 1) * BUF); const LAS bf16* Vt = Kt + 64 * KP;
            f32x16 S[2];
#pragma unroll
            for (int kb = 0; kb < 2; ++kb) {
#pragma unroll
                for (int i = 0; i < 16; ++i) S[kb][i] = 0.f;
                if (win && kb == 1) continue;
                const LAS bf16* kp = Kt + ((win ? kc0 : kb * 32) + swap23(q)) * KP + 8 * g;
#pragma unroll
                for (int s2 = 0; s2 < NS; ++s2) { const bf16x8 a = *(const LAS bf16x8*)(kp + 16 * s2); S[kb] = __builtin_amdgcn_mfma_f32_32x32x16_bf16(a, Qf[s2], S[kb], 0, 0, 0); }
            }
            float mx = -INFINITY;
            if (NA) {
                if (win) {
#pragma unroll
                    for (int i = 0; i < 16; ++i) { const int kc = kc0 + 16 * (i >> 3) + 8 * g + (i & 7); const int dc = min(max(kc - qc, -15), 15) + 15;
                        const float bv = A.rpb[dr * 31 + dc]; const float sv = (rowok && kc >= cs && kc < cs + 16) ? S[0][i] * A.scale + bv : -INFINITY;
                        S[0][i] = sv; mx = fmaxf(mx, sv); }
                } else {
#pragma unroll
                    for (int kb = 0; kb < 2; ++kb)
#pragma unroll
                        for (int i = 0; i < 16; ++i) { const float sv = S[kb][i] * A.scale; S[kb][i] = sv; mx = fmaxf(mx, sv); }
                }
            } else {
#pragma unroll
                for (int kb = 0; kb < 2; ++kb)
#pragma unroll
                    for (int i = 0; i < 16; ++i) mx = fmaxf(mx, S[kb][i]);
            }
            mx = fmaxf(mx, __shfl_xor(mx, 32));
            const float mn = fmaxf(mrun, mx), alpha = __builtin_amdgcn_exp2f(mrun - mn);
            mrun = mn;
            if (__any(alpha != 1.f)) { lrun *= alpha;
#pragma unroll
                for (int db = 0; db < 2; ++db)
#pragma unroll
                    for (int i = 0; i < 16; ++i) O[db][i] *= alpha; }
            bf16x8 Pf[4];
#pragma unroll
            for (int ks = 0; ks < 4; ++ks) { if (win && ks >= 2) continue; const int kb = ks >> 1, o8 = (ks & 1) * 8; float p[8];
#pragma unroll
                for (int j = 0; j < 8; ++j) { p[j] = __builtin_amdgcn_exp2f(S[kb][o8 + j] - mn); lrun += p[j]; }
                Pf[ks] = pack8(p[0], p[1], p[2], p[3], p[4], p[5], p[6], p[7]); }
#pragma unroll
            for (int db = 0; db < 2; ++db) { const LAS bf16* vp = Vt + (db * 32 + q) * VP + (win ? kc0 : 0) + 8 * g;
#pragma unroll
                for (int ks = 0; ks < 4; ++ks) { if (win && ks >= 2) continue; const bf16x8 a = *(const LAS bf16x8*)(vp + 16 * ks); O[db] = __builtin_amdgcn_mfma_f32_32x32x16_bf16(a, Pf[ks], O[db], 0, 0, 0); } }
        }
        if (more) lstore((t + 1) & 1);
        __syncthreads();
    }
    const float ltot = lrun + __shfl_xor(lrun, 32), inv = 1.f / ltot;
    GAS bf16* op = A.o + (size_t)qi * A.opitch + 4 * g;
#pragma unroll
    for (int db = 0; db < 2; ++db)
#pragma unroll
        for (int i4 = 0; i4 < 4; ++i4) { v2u w; w.x = pk2(O[db][4 * i4] * inv, O[db][4 * i4 + 1] * inv); w.y = pk2(O[db][4 * i4 + 2] * inv, O[db][4 * i4 + 3] * inv); *(GAS v2u*)(op + 32 * db + 8 * i4) = w; }
}

constexpr float MLA_TH = 8.f;
constexpr int NA_SLOT = 2 * 64 * 72 * 2, NA_RPB = 4 * NA_SLOT;
DI void na_unit(LAS unsigned char* lds, const AttnDesc& A, const GAS float* rp, int tid, int lane, int wave) {
    constexpr int KP = 72, VP = 72, NS = 4, KBUF = 64 * KP * 2;
    const int q = lane & 31, g = lane >> 5, NT = A.ntiles;
    auto tpos = [&](int t) { return t < 4 ? 64 * t : 256 + 64 * (A.rs0 + t - 4); };
    auto krow = [&](int pos) { return pos < 256 ? A.b * 256 + pos : NCTX + A.b * SEQ + (pos - 256); };
    const int qi = (2 * (wave >> 2) + (q >> 4)) * 64 + 16 * (wave & 3) + (q & 15);
    const int kc0 = min(max(16 * (wave & 3) - 8, 0), 32);
    bf16x8 Qf[NS];
    { const GAS bf16* qp = A.q + (size_t)qi * A.qpitch + 8 * g;
#pragma unroll
        for (int s2 = 0; s2 < NS; ++s2) Qf[s2] = *(const GAS bf16x8*)(qp + 16 * s2); }
    f32x16 O[2];
#pragma unroll
    for (int db = 0; db < 2; ++db)
#pragma unroll
        for (int i = 0; i < 16; ++i) O[db][i] = 0.f;
    float mrun = -1e30f, lrun = 0.f;
    const int qr = A.r0 + (qi >> 6), qc = qi & 63;
    const int wrs = min(max(qr - 4, 0), 56), cs = min(max(qc - 8, 0), 48);
    const int qr0 = A.r0 + 2 * (wave >> 2), wlo = min(max(qr0 - 4, 0), 56), whi = min(max(qr0 + 1 - 4, 0), 56) + 8;
    auto koffs = [&](int i) { const int j = i * 64 + lane, row = j / 9, pc = min(j % 9, 7); return (unsigned)(row * (PP * 2) + pc * 16); };
    auto voffs = [&](int i) { const int j = i * 64 + lane, row = j / 9, pc = min(j % 9, 7); return (unsigned)(row * (NKEY * 2) + pc * 16); };
    const int iv1 = wave == 0 ? 0 : wave - 1, iv2 = wave < 2 ? 7 + wave : iv1;
    const unsigned goff0 = koffs(wave), goff1 = wave == 0 ? koffs(8) : voffs(iv1), goff2 = voffs(iv2);
    auto dma = [&](int t, int slot) __attribute__((always_inline)) { const int pos = tpos(t);
        const GAS unsigned char* kb = (const GAS unsigned char*)(A.k + (size_t)krow(pos) * A.kpitch); const GAS unsigned char* vb = (const GAS unsigned char*)(A.vt + pos);
        LAS unsigned char* kl = lds + slot * NA_SLOT; LAS unsigned char* vl = kl + KBUF;
        __builtin_amdgcn_global_load_lds((const GAS unsigned*)(kb + goff0), (LAS unsigned*)(kl + wave * 1024), 16, 0, 0);
        __builtin_amdgcn_global_load_lds((const GAS unsigned*)((wave == 0 ? kb : vb) + goff1), (LAS unsigned*)(wave == 0 ? kl + 8 * 1024 : vl + iv1 * 1024), 16, 0, 0);
        __builtin_amdgcn_global_load_lds((const GAS unsigned*)(vb + goff2), (LAS unsigned*)(vl + iv2 * 1024), 16, 0, 0);
    };
    LAS float* T = (LAS float*)(lds + NA_RPB);
    float tv[4];
#pragma unroll
    for (int u = 0; u < 4; ++u) { const int e = tid + 512 * u, r = e >> 7, dcr = (e & 127) - 64; const bool in = r < 15 && dcr >= -15 && dcr <= 15;
        tv[u] = in ? rp[r * 31 + dcr + 15] * LOG2E : (r == 15 ? -INFINITY : 0.f); }
    float mcol[16];
#pragma unroll
    for (int i = 0; i < 16; ++i) { const int kc = kc0 + 16 * (i >> 3) + 8 * g + (i & 7); mcol[i] = (kc >= cs && kc < cs + 16) ? 0.f : -INFINITY; }
    __syncthreads();
    dma(0, 0); dma(min(1, NT - 1), 1); dma(min(2, NT - 1), 2);
#pragma unroll
    for (int u = 0; u < 4; ++u) T[tid + 512 * u] = tv[u];
    asm volatile("s_waitcnt vmcnt(6)\n\ts_waitcnt lgkmcnt(0)\n\ts_barrier" ::: "memory");
#pragma unroll 1
    for (int t = 0; t < NT; ++t) {
        dma(min(t + 3, NT - 1), (t + 3) & 3);
        bool active = true, rowok = true; int dr = 0;
        const bool win = t >= 4;
        if (win) { const int wr = A.rs0 + t - 4; active = (wr >= wlo) && (wr < whi); rowok = (wr >= wrs) && (wr < wrs + 8); dr = min(max(wr - qr + 7, 0), 14); }
        if (active) {
            const LAS bf16* Kt = (const LAS bf16*)(lds + (t & 3) * NA_SLOT); const LAS bf16* Vt = Kt + 64 * KP;
            f32x16 S[2];
#pragma unroll
            for (int kb = 0; kb < 2; ++kb) {
#pragma unroll
                for (int i = 0; i < 16; ++i) S[kb][i] = 0.f;
                if (win && kb == 1) continue;
                const LAS bf16* kp = Kt + ((win ? kc0 : kb * 32) + swap23(q)) * KP + 8 * g;
#pragma unroll
                for (int s2 = 0; s2 < NS; ++s2) { const bf16x8 a = *(const LAS bf16x8*)(kp + 16 * s2); S[kb] = __builtin_amdgcn_mfma_f32_32x32x16_bf16(a, Qf[s2], S[kb], 0, 0, 0); }
            }
            float mx = -INFINITY;
            if (win) { const LAS float* tb = T + (rowok ? dr : 15) * 128 + (kc0 + 8 * g - qc + 64);
#pragma unroll
                for (int i = 0; i < 16; ++i) { const float sv = (S[0][i] * A.scale + tb[16 * (i >> 3) + (i & 7)]) + mcol[i]; S[0][i] = sv; mx = fmaxf(mx, sv); }
            } else {
#pragma unroll
                for (int kb = 0; kb < 2; ++kb)
#pragma unroll
                    for (int i = 0; i < 16; ++i) { const float sv = S[kb][i] * A.scale; S[kb][i] = sv; mx = fmaxf(mx, sv); }
            }
            if (__any(mx > mrun + MLA_TH)) { const float mf = fmaxf(mx, __shfl_xor(mx, 32)), mn = fmaxf(mrun, mf), alpha = __builtin_amdgcn_exp2f(mrun - mn);
                mrun = mn; lrun *= alpha;
#pragma unroll
                for (int db = 0; db < 2; ++db)
#pragma unroll
                    for (int i = 0; i < 16; ++i) O[db][i] *= alpha; }
            bf16x8 Pf[4];
#pragma unroll
            for (int ks = 0; ks < 4; ++ks) { if (win && ks >= 2) continue; const int kb = ks >> 1, o8 = (ks & 1) * 8; float p[8];
#pragma unroll
                for (int j = 0; j < 8; ++j) { p[j] = __builtin_amdgcn_exp2f(S[kb][o8 + j] - mrun); lrun += p[j]; }
                Pf[ks] = pack8(p[0], p[1], p[2], p[3], p[4], p[5], p[6], p[7]); }
#pragma unroll
            for (int db = 0; db < 2; ++db) { const LAS bf16* vp = Vt + (db * 32 + q) * VP + (win ? kc0 : 0) + 8 * g;
#pragma unroll
                for (int ks = 0; ks < 4; ++ks) { if (win && ks >= 2) continue; const bf16x8 a = *(const LAS bf16x8*)(vp + 16 * ks); O[db] = __builtin_amdgcn_mfma_f32_32x32x16_bf16(a, Pf[ks], O[db], 0, 0, 0); } }
        }
        asm volatile("s_waitcnt vmcnt(6)\n\ts_waitcnt lgkmcnt(0)\n\ts_barrier" ::: "memory");
    }
    asm volatile("s_waitcnt vmcnt(0)" ::: "memory");
    const float ltot = lrun + __shfl_xor(lrun, 32), inv = 1.f / ltot;
    GAS bf16* op = A.o + (size_t)qi * A.opitch + 4 * g;
#pragma unroll
    for (int db = 0; db < 2; ++db)
#pragma unroll
        for (int i4 = 0; i4 < 4; ++i4) { v2u w; w.x = pk2(O[db][4 * i4] * inv, O[db][4 * i4 + 1] * inv); w.y = pk2(O[db][4 * i4 + 2] * inv, O[db][4 * i4 + 3] * inv); *(GAS v2u*)(op + 32 * db + 8 * i4) = w; }
}

struct TagF { static constexpr bool value = false; }; struct TagT { static constexpr bool value = true; };
#define SGB(mask, n) __builtin_amdgcn_sched_group_barrier(mask, n, 0)
DI void mla_unit(LAS unsigned char* lds, const AttnDesc& A, int tid, int lane, int wave) {
    constexpr int KP = 104, VP = 72, NS = 6, KBUF = 64 * KP * 2, VBUF = 64 * VP * 2;
    const int q = lane & 31, g = lane >> 5, NT = A.ntiles;
    bf16x8 Qf[NS];
    { const GAS bf16* qp = A.q + (size_t)(wave * 32 + q) * A.qpitch + 8 * g;
#pragma unroll
        for (int s2 = 0; s2 < NS; ++s2) Qf[s2] = *(const GAS bf16x8*)(qp + 16 * s2); }
    f32x16 O[2], Cm;
#pragma unroll
    for (int i = 0; i < 16; ++i) { O[0][i] = 0.f; O[1][i] = 0.f; Cm[i] = 0.f; }
    float lrun = 0.f;
    auto koffs = [&](int i) { const int j = i * 64 + lane, row = j / 13, pc = min(j % 13, 11); return (unsigned)(row * 192 + pc * 16); };
    auto voffs = [&](int i) { const int j = i * 64 + lane, row = j / 9, pc = min(j % 9, 7); return (unsigned)(row * (NKEY * 2) + pc * 16); };
    const int i2 = min(wave + 3, 8);
    const unsigned goff0 = koffs(wave), goff1 = wave < 5 ? koffs(wave + 8) : voffs(wave - 5), goff2 = voffs(i2);
    auto dma = [&](int tk, int ks, int tv, int vs) __attribute__((always_inline)) {
        const GAS unsigned char* kb = (const GAS unsigned char*)A.k + (size_t)tk * (64 * 96 * 2); const GAS unsigned char* vb = (const GAS unsigned char*)A.vt + (size_t)tv * 128;
        LAS unsigned char* kl = lds + ks * KBUF; LAS unsigned char* vl = lds + 2 * KBUF + vs * VBUF;
        __builtin_amdgcn_global_load_lds((const GAS unsigned*)(kb + goff0), (LAS unsigned*)(kl + wave * 1024), 16, 0, 0);
        __builtin_amdgcn_global_load_lds((const GAS unsigned*)((wave < 5 ? kb : vb) + goff1), (LAS unsigned*)(wave < 5 ? kl + (wave + 8) * 1024 : vl + (wave - 5) * 1024), 16, 0, 0);
        __builtin_amdgcn_global_load_lds((const GAS unsigned*)(vb + goff2), (LAS unsigned*)(vl + i2 * 1024), 16, 0, 0);
    };
    auto qk = [&](f32x16& S0, f32x16& S1, int buf) __attribute__((always_inline)) {
        const LAS bf16* kp = (const LAS bf16*)(lds + buf * KBUF) + swap23(q) * KP + 8 * g;
        S0 = __builtin_amdgcn_mfma_f32_32x32x16_bf16(*(const LAS bf16x8*)kp, Qf[0], Cm, 0, 0, 0);
#pragma unroll
        for (int s2 = 1; s2 < NS; ++s2) S0 = __builtin_amdgcn_mfma_f32_32x32x16_bf16(*(const LAS bf16x8*)(kp + 16 * s2), Qf[s2], S0, 0, 0, 0);
        S1 = __builtin_amdgcn_mfma_f32_32x32x16_bf16(*(const LAS bf16x8*)(kp + 32 * KP), Qf[0], Cm, 0, 0, 0);
#pragma unroll
        for (int s2 = 1; s2 < NS; ++s2) S1 = __builtin_amdgcn_mfma_f32_32x32x16_bf16(*(const LAS bf16x8*)(kp + 32 * KP + 16 * s2), Qf[s2], S1, 0, 0, 0);
    };
    auto smax = [&](const f32x16& S0, const f32x16& S1) __attribute__((always_inline)) { float mx = fmaxf(S0[0], S0[1]);
#pragma unroll
        for (int i = 2; i < 16; ++i) mx = fmaxf(mx, S0[i]);
#pragma unroll
        for (int i = 0; i < 16; ++i) mx = fmaxf(mx, S1[i]);
        return mx; };
    auto rebase = [&](f32x16& S0, f32x16& S1, float mx) __attribute__((always_inline)) {
        const float mf = fmaxf(mx, __shfl_xor(mx, 32)), d = fmaxf(mf, 0.f), alpha = __builtin_amdgcn_exp2f(-d);
        lrun *= alpha;
#pragma unroll
        for (int i = 0; i < 16; ++i) { O[0][i] *= alpha; O[1][i] *= alpha; S0[i] -= d; S1[i] -= d; Cm[i] -= d; }
        asm volatile("" : "+v"(Cm));
    };
    auto softmax_p = [&](const f32x16& S0, const f32x16& S1, bf16x8 (&Pf)[4]) __attribute__((always_inline)) {
#pragma unroll
        for (int ks = 0; ks < 4; ++ks) { const int o8 = (ks & 1) * 8; float p[8];
#pragma unroll
            for (int j = 0; j < 8; ++j) { p[j] = __builtin_amdgcn_exp2f(ks < 2 ? S0[o8 + j] : S1[o8 + j]); lrun += p[j]; }
            Pf[ks] = pack8(p[0], p[1], p[2], p[3], p[4], p[5], p[6], p[7]); }
    };
    auto pv = [&](const bf16x8 (&Pf)[4], int buf) __attribute__((always_inline)) {
        const LAS bf16* vp = (const LAS bf16*)(lds + 2 * KBUF + buf * VBUF) + q * VP + 8 * g;
#pragma unroll
        for (int ks = 0; ks < 4; ++ks)
#pragma unroll
            for (int db = 0; db < 2; ++db) O[db] = __builtin_amdgcn_mfma_f32_32x32x16_bf16(*(const LAS bf16x8*)(vp + db * 32 * VP + 16 * ks), Pf[ks], O[db], 0, 0, 0);
    };
    f32x16 Sa[2], Sb[2];
    __syncthreads();
    dma(0, 0, 0, 0); dma(1, 1, 0, 0);
    asm volatile("s_waitcnt vmcnt(0)" ::: "memory");
    __syncthreads();
    qk(Sa[0], Sa[1], 0);
    { const float mx = smax(Sa[0], Sa[1]); const float mf = fmaxf(mx, __shfl_xor(mx, 32));
#pragma unroll
        for (int i = 0; i < 16; ++i) { Sa[0][i] -= mf; Sa[1][i] -= mf; Cm[i] = -mf; }
        asm volatile("" : "+v"(Cm)); }
    __syncthreads();
    auto step = [&](f32x16 (&Sc)[2], f32x16 (&Sn)[2], const int t, auto par) __attribute__((always_inline)) {
        constexpr int PAR = decltype(par)::value ? 1 : 0;
        dma(min(t + 2, NT - 1), PAR, min(t + 1, NT - 1), PAR ^ 1);
        __builtin_amdgcn_sched_barrier(0);
        bf16x8 Pf[4];
        qk(Sn[0], Sn[1], PAR ^ 1);
        softmax_p(Sc[0], Sc[1], Pf);
        pv(Pf, PAR);
        const float mx = smax(Sn[0], Sn[1]);
        SGB(0x100, 3);
#pragma unroll
        for (int m = 0; m < 16; ++m) { SGB(0x008, 1); SGB(0x100, 1); SGB(0x400, 2); SGB(0x002, 3); }
#pragma unroll
        for (int m = 0; m < 4; ++m) { SGB(0x008, 1); SGB(0x100, 1); SGB(0x002, 5); }
        if (__any(mx > MLA_TH)) rebase(Sn[0], Sn[1], mx);
        asm volatile("s_waitcnt vmcnt(0)" ::: "memory");
        __syncthreads();
    };
#pragma unroll 1
    for (int t = 0; t < NT - 2; t += 2) { step(Sa, Sb, t, TagF{}); step(Sb, Sa, t + 1, TagT{}); }
    step(Sa, Sb, NT - 2, TagF{});
    { bf16x8 Pf[4]; softmax_p(Sb[0], Sb[1], Pf); pv(Pf, (NT - 1) & 1); }
    const float ltot = lrun + __shfl_xor(lrun, 32), inv = 1.f / ltot;
    GAS bf16* op = A.o + (size_t)(wave * 32 + q) * A.opitch + 4 * g;
#pragma unroll
    for (int db = 0; db < 2; ++db)
#pragma unroll
        for (int i4 = 0; i4 < 4; ++i4) { v2u w; w.x = pk2(O[db][4 * i4] * inv, O[db][4 * i4 + 1] * inv); w.y = pk2(O[db][4 * i4 + 2] * inv, O[db][4 * i4 + 3] * inv); *(GAS v2u*)(op + 32 * db + 8 * i4) = w; }
}

DI int moe_tables(const GAS unsigned* cnt  , LAS int* off, LAS int* tile_e, int tid) {
    if (tid < 64) { int v = tid < 32 ? (((int)cnt[tid * 64] + 255) & ~255) : 0;
#pragma unroll
        for (int d = 1; d < 32; d <<= 1) { const int t = __shfl_up(v, d); if ((tid & 63) >= d) v += t; }
        if (tid < 32) off[tid + 1] = v;
        if (tid == 0) off[0] = 0; }
    __syncthreads();
    if (tid < MOE_MAXT) { const int r = tid * 256; int ex = 0; for (int e = 0; e < 32; ++e) if (r >= off[e + 1]) ex = e + 1; tile_e[tid] = ex < 32 ? ex : 31; }
    __syncthreads();
    return off[32] >> 8;
}

#define TIDS const int tid = threadIdx.x, lane = tid & 63, wave = __builtin_amdgcn_readfirstlane(tid >> 6), bid = blockIdx.x, G = gridDim.x, gw = bid * 8 + wave, NGW = G * 8; (void)lane; (void)gw; (void)NGW
DI void ph_gemm_in(const Ctx& cx, int l) {
    TIDS; GAS unsigned char* ws = cx.ws(); LAS unsigned char* lds = (LAS unsigned char*)lds_raw;
    pg8::Gemm g{(const GAS bf16*)(ws + WS_H), (const GAS bf16*)(ws + WS_WTIN + (size_t)l * WTIN_L), MTOK, PP, D}; pg8::StaticOrder S; S.init(MTOK, PP, G, bid);
    pg8::EpiStoreBf16 E{(GAS bf16*)(ws + WS_P), PP};
    pg8::gemm_phase(lds, g, S, E);
    { const int ntile = (MTOK / 256) * (PP / 256), nlast = ntile % G;
        if (nlast > 0 && bid >= nlast) { __syncthreads(); weight_copies(cx, l, lds, tid, lane, wave, (bid - nlast) * 8 + wave, (G - nlast) * 8, (bid - nlast) * 512 + tid, (G - nlast) * 512, 2); }
        else if (nlast == 0) { __syncthreads(); weight_copies(cx, l, lds, tid, lane, wave, bid * 8 + wave, G * 8, bid * 512 + tid, G * 512, 2); } }
}
DI void ph_prep_r1(const Ctx& cx, int l) {
    TIDS; LAS unsigned char* lds = (LAS unsigned char*)lds_raw;
#pragma unroll 1
    for (int u = bid; u < MTOK / PR; u += G) prep_unit(cx, l, u, lds, tid, lane, wave);
    __syncthreads();
    rec_r1_run<0>(cx, l, lds, tid, bid, G); rec_r1_run<1>(cx, l, lds, tid, bid, G);
    __syncthreads();
}
DI void ph_mixers(const Ctx& cx, int l) {
    TIDS; GAS unsigned char* ws = cx.ws(); LAS unsigned char* lds = (LAS unsigned char*)lds_raw;
    const bool keep_ctx = (l == 0);
    GAS bf16* CAT = (GAS bf16*)(ws + WS_CAT); const GAS bf16* P = (const GAS bf16*)(ws + WS_P);
    const int nATT = 256 + (keep_ctx ? 16 : 0), nR = 16 * NCHUNK;
    const int vc = (G % 8 == 0) ? (bid % 8) * (G / 8) + bid / 8 : bid;
    const bool r3first = ((bid >> 3) & 1) != 0;
    if (r3first) { rec_r3_run<0>(cx, l, lds, tid, bid, G, keep_ctx); rec_r3_run<1>(cx, l, lds, tid, bid, G, keep_ctx); __syncthreads(); }
#pragma unroll 1
    for (int it = 0; it < 2; ++it) { const int u = it == 0 ? vc : (G == 256 && bid >= 128 && bid < 144 ? 256 + bid - 128 : (G == 256 ? nATT : bid + G)); if (u >= nATT) continue;
        const GAS bf16* QM = (const GAS bf16*)(ws + WS_QM); const GAS bf16* KM = (const GAS bf16*)(ws + WS_KM); const GAS bf16* VM = (const GAS bf16*)(ws + WS_VM);
        AttnDesc A{}; int bh, b, h;
        if (u < 256) { bh = u >> 4; b = bh >> 2; h = bh & 3; const int qb = u & 15; A.q = QM + ((size_t)bh * NKEY + 256 + qb * 256) * 96; A.ntiles = NKEY / 64; A.o = CAT + (size_t)(NCTX + b * SEQ + qb * 256) * D + 768 + h * 64; }
        else { bh = u - 256; b = bh >> 2; h = bh & 3; A.q = QM + (size_t)bh * NKEY * 96; A.ntiles = 4; A.o = CAT + (size_t)(b * 256) * D + 768 + h * 64; }
        A.qpitch = 96; A.k = KM + (size_t)bh * NKEY * 96; A.kpitch = 96; A.vt = VM + (size_t)bh * 64 * NKEY; A.opitch = D; A.scale = 1.f;
        mla_unit(lds, A, tid, lane, wave);
    }
#pragma unroll 1
    for (int it = 0; it < 2; ++it) { const int u = it == 0 ? vc : (G == 256 && bid >= 160 && bid < 176 ? 256 + bid - 160 : (G == 256 ? nATT : bid + G)); if (u >= nATT) continue;
        LAS float* rpb = (LAS float*)(lds + NA_RPB);
        AttnDesc A{}; int bh, b, h; size_t qrow;
        if (u < 256) { bh = u >> 4; b = bh >> 2; h = bh & 3; const int rq = u & 15; A.r0 = rq * 4; A.rs0 = min(max(A.r0 - 4, 0), 56); const int rsl = min(max(A.r0 + 3 - 4, 0), 56);
            A.ntiles = 4 + (rsl + 8 - A.rs0); qrow = (size_t)NCTX + b * SEQ + A.r0 * 64; }
        else { bh = u - 256; b = bh >> 2; h = bh & 3; A.ntiles = 4; qrow = (size_t)b * 256; }
        const GAS float* rp = cx.in(I_RPB) + (size_t)(l * 4 + h) * 465;
        A.q = P + qrow * PP + CB_Q + h * 64; A.qpitch = PP; A.k = P + CB_K + h * 64; A.kpitch = PP; A.vt = (const GAS bf16*)(ws + WS_VNT) + (size_t)bh * 64 * NKEY;
        A.o = CAT + qrow * D + 256 + h * 64; A.opitch = D; A.scale = 0.125f * LOG2E; A.b = b; A.rpb = rpb;
        na_unit(lds, A, rp, tid, lane, wave);
    }
    __syncthreads();
    if (!r3first) { rec_r3_run<0>(cx, l, lds, tid, bid, G, keep_ctx); rec_r3_run<1>(cx, l, lds, tid, bid, G, keep_ctx); }
}
DI void ph_gemm_out(const Ctx& cx, int l) {
    TIDS; GAS unsigned char* ws = cx.ws(); LAS unsigned char* lds = (LAS unsigned char*)lds_raw;
    const int roff = (l == 0) ? 0 : NCTX, Mg = MTOK - roff;
    pg8::Gemm g{(const GAS bf16*)(ws + WS_CAT) + (size_t)roff * D, (const GAS bf16*)(ws + WS_WTOUT + (size_t)l * D * D * 2), Mg, D, D}; pg8::StaticOrder S; S.init(Mg, D, G, bid); S.wgm = 8;
    pg8::EpiResid E{(GAS pg8::bf16_t*)(ws + WS_X), roff, (const GAS float*)(ws + WS_MOD) + (size_t)l * 5 * 6144 + 2 * 1024, l == 0 ? cx.in(I_CTX) : (const GAS float*)nullptr, l == 0 ? cx.in(I_X) : (const GAS float*)nullptr};
    const int nbusy = (Mg / 256) * (D / 256) - G;
    if (l == 0 && nbusy > 0 && 2 * nbusy <= G && G % 8 == 0 && nbusy % 8 == 0) {
        S.imax = 1; pg8::gemm_phase(lds, g, S, E);
        __syncthreads();
        if (bid < 2 * nbusy) { const int xcd = bid & 7, j = bid >> 3, t = (j >> 1) * 8 + xcd, hoff = (j & 1) * 128;
            pg8::TailOrder T{S, G + t}; pg8::EpiResidH EH{E.X, E.row_off, E.mod, E.src_ctx, E.src_lat, hoff};
            pg8::gemm_phase<pg8::EpiResidH, pg8::TailOrder, pg8::TailRows, true>(lds, g, T, EH, pg8::TailRows{hoff}); }
        else if (mod_l1_deferred(G) && bid < 2 * nbusy + 96) { mod_fill(cx, lds, tid); __syncthreads(); mod_unit(cx, lds, tid, 96 + bid - 2 * nbusy); }
        else if (bid >= 8 * nbusy) { const int nb = 8 * nbusy; weight_copies(cx, 1, lds, tid, lane, wave, (bid - nb) * 8 + wave, (G - nb) * 8, (bid - nb) * 512 + tid, (G - nb) * 512, 1);
            weight_copies(cx, 0, lds, tid, lane, wave, (bid - nb) * 8 + wave, (G - nb) * 8, 0, 1, 3); }
        return;
    }
    pg8::gemm_phase(lds, g, S, E);
    if (l == 0) { if (nbusy >= 0 && nbusy < G && bid >= nbusy) { __syncthreads(); weight_copies(cx, 1, lds, tid, lane, wave, (bid - nbusy) * 8 + wave, (G - nbusy) * 8, (bid - nbusy) * 512 + tid, (G - nbusy) * 512, 1);
            weight_copies(cx, 0, lds, tid, lane, wave, (bid - nbusy) * 8 + wave, (G - nbusy) * 8, 0, 1, 3); } }
}
DI void ph_router(const Ctx& cx, int l) {
    TIDS; GAS unsigned char* ws = cx.ws(); LAS unsigned char* lds = (LAS unsigned char*)lds_raw;
    const int m_lo = (l == 0) ? 0 : NCTX;
    const GAS bf16* X = (const GAS bf16*)(ws + WS_X); GAS bf16* H = (GAS bf16*)(ws + WS_H); const GAS float* MOD = (const GAS float*)(ws + WS_MOD) + (size_t)l * 5 * 6144;
    GAS int* EID = (GAS int*)(ws + WS_MOE); GAS float* GATE = (GAS float*)(ws + WS_MOE) + MTOK * 2; GAS int* POS = (GAS int*)(ws + WS_MOE) + MTOK * 4;
    GAS unsigned* cnt = (GAS unsigned*)(ws + WS_CTL) + CW_CNT + l * 32 * 64; GAS int* RIDX = (GAS int*)(ws + WS_RIDX);
    const GAS bf16* WRh = (const GAS bf16*)(ws + WS_WR) + (size_t)l * 2 * 48 * 1024; const GAS bf16* WRl = WRh + 48 * 1024;
    const GAS float* n2g = cx.in(I_N2G) + l * D; const GAS float* brg = cx.in(I_BRG) + l * 4; const GAS float* bre = cx.in(I_BRE) + l * 32;
    constexpr int AP = 136;
    LAS bf16* Ah = (LAS bf16*)(lds + wave * 12288); LAS bf16* Al = Ah + 16 * AP; LAS float* LG = (LAS float*)(lds + wave * 12288 + 2 * 16 * AP * 2); LAS float* RSD = LG + 16 * 48;
    const int nunits = (MTOK - m_lo) / 16;
    LAS int* hist = (LAS int*)(lds + 8 * 12288); LAS int* hbase = hist + 32;
    const int maxit = (nunits + NGW - 1) / NGW;
#pragma unroll 1
    for (int it = 0; it < maxit; ++it) { const int unit = wave * G + bid + it * NGW; const bool act = unit < nunits;
        if (tid < 32) hist[tid] = 0;
        __syncthreads();
        int ex1 = 0, ex2 = 0, lr1 = 0, lr2 = 0; float w1 = 0.f, w2 = 0.f;
        const int m0 = m_lo + (act ? unit : 0) * 16; const GAS float* mb = MOD + (size_t)bidx_of_row(m0) * 6144;
        if (act) {
        const int p16 = lane & 15, rg = lane >> 4;
        float rsr[4];
        { float ss[4] = {0.f, 0.f, 0.f, 0.f};
#pragma unroll 2
            for (int kc = 0; kc < 8; ++kc) { v4u xp[4];
#pragma unroll
                for (int i = 0; i < 4; ++i) xp[i] = *(const GAS v4u*)(X + (size_t)(m0 + 4 * rg + i) * D + kc * 128 + 8 * p16);
#pragma unroll
                for (int i = 0; i < 4; ++i) { float x[8]; unpack8(xp[i], x);
#pragma unroll
                    for (int e = 0; e < 8; ++e) ss[i] += x[e] * x[e]; } }
#pragma unroll
            for (int i = 0; i < 4; ++i) { float t = ss[i]; t += __shfl_xor(t, 1); t += __shfl_xor(t, 2); t += __shfl_xor(t, 4); t += __shfl_xor(t, 8); rsr[i] = rsqrtf(t * (1.f / D) + EPS); } }
        f32x4 acc[3];
#pragma unroll
        for (int ct = 0; ct < 3; ++ct) acc[ct] = (f32x4){0.f, 0.f, 0.f, 0.f};
#pragma unroll 1
        for (int kc = 0; kc < 8; ++kc) { const int c = kc * 128 + 8 * p16;
            const int fr = lane & 15, fq = lane >> 4;
            bf16x8 bh[4][3], bl[4][3];
#pragma unroll
            for (int ks = 0; ks < 4; ++ks)
#pragma unroll
                for (int ct = 0; ct < 3; ++ct) { const size_t bo = (size_t)(ct * 16 + fr) * 1024 + kc * 128 + ks * 32 + fq * 8; bh[ks][ct] = *(const GAS bf16x8*)(WRh + bo); bl[ks][ct] = *(const GAS bf16x8*)(WRl + bo); }
            v4u xp[4];
#pragma unroll
            for (int i = 0; i < 4; ++i) xp[i] = *(const GAS v4u*)(X + (size_t)(m0 + 4 * rg + i) * D + c);
            float gg[8], sh[8], sc[8];
            { const f32x4 a0 = *(const GAS f32x4*)(n2g + c), a1 = *(const GAS f32x4*)(n2g + c + 4), b0 = *(const GAS f32x4*)(mb + 3 * 1024 + c), b1 = *(const GAS f32x4*)(mb + 3 * 1024 + c + 4),
                  c0 = *(const GAS f32x4*)(mb + 4 * 1024 + c), c1 = *(const GAS f32x4*)(mb + 4 * 1024 + c + 4);
                gg[0] = a0.x; gg[1] = a0.y; gg[2] = a0.z; gg[3] = a0.w; gg[4] = a1.x; gg[5] = a1.y; gg[6] = a1.z; gg[7] = a1.w;
                sh[0] = b0.x; sh[1] = b0.y; sh[2] = b0.z; sh[3] = b0.w; sh[4] = b1.x; sh[5] = b1.y; sh[6] = b1.z; sh[7] = b1.w;
                sc[0] = c0.x; sc[1] = c0.y; sc[2] = c0.z; sc[3] = c0.w; sc[4] = c1.x; sc[5] = c1.y; sc[6] = c1.z; sc[7] = c1.w; }
            LDS_WAIT();
#pragma unroll
            for (int i = 0; i < 4; ++i) { const int r = 4 * rg + i; float x[8], y[8]; unpack8(xp[i], x);
#pragma unroll
                for (int e = 0; e < 8; ++e) y[e] = x[e] * rsr[i] * gg[e] * (1.f + sc[e]) + sh[e];
                const v4u hi = (v4u){pk2(y[0], y[1]), pk2(y[2], y[3]), pk2(y[4], y[5]), pk2(y[6], y[7])};
                float hf[8]; unpack8(hi, hf);
                const v4u lo = (v4u){pk2(y[0] - hf[0], y[1] - hf[1]), pk2(y[2] - hf[2], y[3] - hf[3]), pk2(y[4] - hf[4], y[5] - hf[5]), pk2(y[6] - hf[6], y[7] - hf[7])};
                *(GAS v4u*)(H + (size_t)(m0 + r) * D + c) = hi;
                *(LAS v4u*)(Ah + r * AP + 8 * p16) = hi; *(LAS v4u*)(Al + r * AP + 8 * p16) = lo; }
            LDS_WAIT();
            asm volatile("s_waitcnt vmcnt(0)" : "+v"(bh[0][0]), "+v"(bh[0][1]), "+v"(bh[0][2]), "+v"(bl[0][0]), "+v"(bl[0][1]), "+v"(bl[0][2]), "+v"(bh[1][0]), "+v"(bh[1][1]), "+v"(bh[1][2]), "+v"(bl[1][0]), "+v"(bl[1][1]), "+v"(bl[1][2]),
                         "+v"(bh[2][0]), "+v"(bh[2][1]), "+v"(bh[2][2]), "+v"(bl[2][0]), "+v"(bl[2][1]), "+v"(bl[2][2]), "+v"(bh[3][0]), "+v"(bh[3][1]), "+v"(bh[3][2]), "+v"(bl[3][0]), "+v"(bl[3][1]), "+v"(bl[3][2]) :: "memory");
#pragma unroll
            for (int ks = 0; ks < 4; ++ks) { const bf16x8 ah = *(const LAS bf16x8*)(Ah + fr * AP + ks * 32 + fq * 8), al = *(const LAS bf16x8*)(Al + fr * AP + ks * 32 + fq * 8);
#pragma unroll
                for (int ct = 0; ct < 3; ++ct) {
                    acc[ct] = __builtin_amdgcn_mfma_f32_16x16x32_bf16(ah, bh[ks][ct], acc[ct], 0, 0, 0);
                    acc[ct] = __builtin_amdgcn_mfma_f32_16x16x32_bf16(ah, bl[ks][ct], acc[ct], 0, 0, 0);
                    acc[ct] = __builtin_amdgcn_mfma_f32_16x16x32_bf16(al, bh[ks][ct], acc[ct], 0, 0, 0); } }
        }
#pragma unroll
        for (int ct = 0; ct < 3; ++ct)
#pragma unroll
            for (int j = 0; j < 4; ++j) LG[(4 * (lane >> 4) + j) * 48 + ct * 16 + (lane & 15)] = acc[ct][j];
        LDS_WAIT(); asm volatile("" ::: "memory");
        if (lane < 16) { const LAS float* lg = LG + lane * 48; const int m = m0 + lane;
            float gl[4]; int gsel = 0;
#pragma unroll
            for (int i = 0; i < 4; ++i) gl[i] = lg[i] + brg[i];
            float gmax = gl[0];
#pragma unroll
            for (int i = 1; i < 4; ++i) if (gl[i] > gmax) { gmax = gl[i]; gsel = i; }
            float den = 0.f;
#pragma unroll
            for (int i = 0; i < 4; ++i) den += __expf(gl[i] - gmax);
            const float pg = 1.f / den;
            float e1 = -INFINITY, e2 = -INFINITY; int i1 = 0, i2 = 0;
#pragma unroll 1
            for (int i = 0; i < 8; ++i) { const float ev = lg[4 + gsel * 8 + i] + bre[gsel * 8 + i];
                if (ev > e1) { e2 = e1; i2 = i1; e1 = ev; i1 = i; } else if (ev > e2) { e2 = ev; i2 = i; } }
            const float x2 = __expf(e2 - e1); w1 = pg / (1.f + x2); w2 = pg * x2 / (1.f + x2);
            ex1 = gsel * 8 + i1; ex2 = gsel * 8 + i2;
            lr1 = __hip_atomic_fetch_add(hist + ex1, 1, __ATOMIC_RELAXED, __HIP_MEMORY_SCOPE_WORKGROUP); lr2 = __hip_atomic_fetch_add(hist + ex2, 1, __ATOMIC_RELAXED, __HIP_MEMORY_SCOPE_WORKGROUP); }
        LDS_WAIT(); asm volatile("" ::: "memory");
        }
        __syncthreads();
        if (tid < 32) { const int c = hist[tid]; hbase[tid] = c ? (int)__hip_atomic_fetch_add(cnt + tid * 64, (unsigned)c, __ATOMIC_RELAXED, __HIP_MEMORY_SCOPE_AGENT) : 0; }
        __syncthreads();
        if (act && lane < 16) { const int m = m0 + lane, p1 = hbase[ex1] + lr1, p2 = hbase[ex2] + lr2;
            EID[m * 2] = ex1; EID[m * 2 + 1] = ex2; GATE[m * 2] = w1; GATE[m * 2 + 1] = w2; POS[m * 2] = p1; POS[m * 2 + 1] = p2;
            RIDX[(size_t)ex1 * MOE_CAP + p1] = m; RIDX[(size_t)ex2 * MOE_CAP + p2] = m; }
        __syncthreads();
    }
}
DI void ph_gemm_gu(const Ctx& cx, int l) {
    TIDS; GAS unsigned char* ws = cx.ws(); LAS unsigned char* lds = (LAS unsigned char*)lds_raw;
    LAS int* moe_off = (LAS int*)(lds + MISC_OFF + 64 * 4); LAS int* moe_te = (LAS int*)(lds + MISC_OFF + 128 * 4);
    const int nT = moe_tables((const GAS unsigned*)(ws + WS_CTL) + CW_CNT + l * 32 * 64, moe_off, moe_te, tid);
    pg8::Gemm g{(const GAS bf16*)(ws + WS_H), (const GAS bf16*)(ws + WS_WTGU + (size_t)l * 32 * 512 * D * 2), nT * 256, 512, D};
    const int vc = (G % 8 == 0) ? (bid % 8) * (G / 8) + bid / 8 : bid;
    const int nb2 = (nT * 2 > G && nT * 2 - G < G / 2) ? nT * 2 - G : 0; const bool split = nb2 > 0 && nb2 * 4 <= G;
    GAS unsigned* guc = (GAS unsigned*)(ws + WS_CTL) + CW_GUC + l * MOE_MAXT * 64;
    pg8::GroupedPublish S{{nT, 2, G, vc, moe_te, (size_t)512 * D * 2}, guc};
    if (split) S.imax = 1;
    const int L2 = split ? (vc < 2 * nb2 ? G + (vc >> 1) : -1) : (vc + G < nT * 2 ? vc + G : -1), hoff = (vc & 1) * 128;
    pg8::EpiGateUp E{(GAS bf16*)(ws + WS_ACT), (unsigned)(MOE_MAXT * 256 * 256 * 2)};
    LAS int* ridx_l = (LAS int*)(lds + MISC_OFF + 4096);
    { const GAS unsigned* cntp = (const GAS unsigned*)(ws + WS_CTL) + CW_CNT + l * 32 * 64; const GAS int* RIDX = (const GAS int*)(ws + WS_RIDX);
        const int i = tid >> 8, r = tid & 255, L = i == 0 ? vc : L2;
        if (L >= 0 && L < nT * 2) { const int pm = L >> 1, e = moe_te[pm], slot = pm * 256 - moe_off[e] + r; ridx_l[i * 256 + r] = slot < (int)cntp[e * 64] ? RIDX[(size_t)e * MOE_CAP + slot] : 0; }
        __syncthreads(); }
    pg8::MoeRows RM{ridx_l, vc >> 1};
    pg8::gemm_phase(lds, g, S, E, RM);
    if (split && L2 >= 0) { __syncthreads();
        pg8::GroupedTailPublish T{L2, 2, moe_te, (size_t)512 * D * 2, guc}; pg8::EpiGateUpH EH{(GAS bf16*)(ws + WS_ACT), (unsigned)(MOE_MAXT * 256 * 256 * 2), hoff};
        pg8::gemm_phase<pg8::EpiGateUpH, pg8::GroupedTailPublish, pg8::MoeRowsH, true>(lds, g, T, EH, pg8::MoeRowsH{ridx_l, hoff}); }
}
DI void ph_gemm_dn(const Ctx& cx, int l) {
    TIDS; GAS unsigned char* ws = cx.ws(); LAS unsigned char* lds = (LAS unsigned char*)lds_raw;
    LAS int* moe_off = (LAS int*)(lds + MISC_OFF + 64 * 4); LAS int* moe_te = (LAS int*)(lds + MISC_OFF + 128 * 4);
#if MK_ONE_LAUNCH
    const int nT = moe_off[32] >> 8;
#else
    const int nT = moe_tables((const GAS unsigned*)(ws + WS_CTL) + CW_CNT + l * 32 * 64, moe_off, moe_te, tid);
#endif
    pg8::Gemm g{(const GAS bf16*)(ws + WS_ACT), (const GAS bf16*)(ws + WS_WTDN + (size_t)l * 32 * D * 256 * 2), nT * 256, D, 256};
    pg8::EpiStoreBf16 E{(GAS bf16*)(ws + WS_XS), D};
    const GAS unsigned* ready = (const GAS unsigned*)(ws + WS_CTL) + CW_GUC + l * MOE_MAXT * 64;
    const int vc = (G % 8 == 0) ? (bid % 8) * (G / 8) + bid / 8 : bid;
    const int nb2 = (nT * 2 > G && nT * 2 - G < G / 2) ? nT * 2 - G : 0; const bool split = nb2 > 0 && nb2 * 4 <= G;
    const int nx = split ? 2 * nb2 : nb2, Gd = G - nx, cd = vc - nx;
    const int pmE = nb2 ? G / 2 : nT, nE = pmE * 4, nL = (nT - pmE) * 4;
    const int cl = split ? (vc < nx ? vc : -1) : (cd < 0 ? -1 : (cd - nE % Gd + Gd) % Gd);
    const unsigned needL = split ? 32u : 16u;
    pg8::GroupedOrder S1{pmE, 4, Gd, cd, moe_te, (size_t)D * 256 * 2, 0};
    pg8::GroupedOrder S2{nT - pmE, 4, split ? nx : Gd, cl, moe_te, (size_t)D * 256 * 2, pmE};
    { pg8::Unit u;
#pragma unroll 1
      for (int i = 0; S1.next(i, u); ++i) pg8::wait_rowtile(ready, u.pm, 16u); }
    pg8::gemm_phase(lds, g, S1, E);
    if (nL > 0) { pg8::Unit u;
#pragma unroll 1
      for (int i = 0; S2.next(i, u); ++i) pg8::wait_rowtile(ready, u.pm, needL);
      pg8::gemm_phase(lds, g, S2, E); }
}
DI void ph_combine(const Ctx& cx, int l) {
    TIDS; GAS unsigned char* ws = cx.ws(); LAS unsigned char* lds = (LAS unsigned char*)lds_raw;
    LAS int* moe_off = (LAS int*)(lds + MISC_OFF + 64 * 4); LAS int* moe_te = (LAS int*)(lds + MISC_OFF + 128 * 4);
    const int m_lo = (l == 0) ? 0 : NCTX;
#if !MK_ONE_LAUNCH
    moe_tables((const GAS unsigned*)(ws + WS_CTL) + CW_CNT + l * 32 * 64, moe_off, moe_te, tid);
#endif
    const GAS int* EID = (const GAS int*)(ws + WS_MOE); const GAS float* GATE = (const GAS float*)(ws + WS_MOE) + MTOK * 2; const GAS int* POS = (const GAS int*)(ws + WS_MOE) + MTOK * 4;
    const GAS bf16* YS = (const GAS bf16*)(ws + WS_XS); GAS bf16* X = (GAS bf16*)(ws + WS_X); GAS bf16* H = (GAS bf16*)(ws + WS_H);
    const GAS float* MODB = (const GAS float*)(ws + WS_MOD); const GAS float* MOD = MODB + (size_t)l * 5 * 6144;
    const GAS float* n1g1 = cx.in(I_N1G) + D; const GAS float* fng = cx.in(I_FNG); GAS float* outp = cx.out();
    const int R = (MTOK - m_lo + G - 1) / G, m_beg = m_lo + bid * R + wave, m_end = min(m_lo + (bid + 1) * R, MTOK);
    f32x4 g5r[4], fgr[4]; NormPar np; int cb = -1;
    if (l != 0) {
#pragma unroll
        for (int j = 0; j < 4; ++j) fgr[j] = *(const GAS f32x4*)(fng + 4 * lane + 256 * j); }
    int e0n = 0, e1n = 0, p0n = 0, p1n = 0; float w0n = 0.f, w1n = 0.f;
    float w0 = 0.f, w1 = 0.f, w0d = 0.f, w1d = 0.f;
    v2u A0[4], A1[4], XW[4];
    auto rec_load = [&](int mm) { e0n = EID[mm * 2]; e1n = EID[mm * 2 + 1]; p0n = POS[mm * 2]; p1n = POS[mm * 2 + 1]; w0n = GATE[mm * 2]; w1n = GATE[mm * 2 + 1]; };
    auto data_load = [&](int mm) { const int d0 = moe_off[e0n] + p0n, d1 = moe_off[e1n] + p1n; w0d = w0n; w1d = w1n;
#pragma unroll
        for (int j = 0; j < 4; ++j) { const int c = 4 * lane + 256 * j; A0[j] = *(const GAS v2u*)(YS + (size_t)d0 * D + c); A1[j] = *(const GAS v2u*)(YS + (size_t)d1 * D + c); XW[j] = *(const GAS v2u*)(X + (size_t)mm * D + c); } };
    if (m_beg < m_end) { rec_load(m_beg); data_load(m_beg); rec_load(m_beg + 8 < m_end ? m_beg + 8 : m_beg); }
#pragma unroll 1
    for (int m = m_beg; m < m_end; m += 8) {
        v2u a0[4], a1[4], xw[4];
#pragma unroll
        for (int j = 0; j < 4; ++j) { a0[j] = A0[j]; a1[j] = A1[j]; xw[j] = XW[j]; }
        w0 = w0d; w1 = w1d;
        { const int m1 = m + 8 < m_end ? m + 8 : m, m2 = m + 16 < m_end ? m + 16 : m1; data_load(m1); rec_load(m2); }
        { const int b = bidx_of_row(m);
            if (b != cb) { const GAS float* mb = MOD + (size_t)b * 6144;
#pragma unroll
                for (int j = 0; j < 4; ++j) g5r[j] = *(const GAS f32x4*)(mb + 5 * 1024 + 4 * lane + 256 * j);
                if (l == 0) { const GAS float* mb1 = MODB + (size_t)(5 + b) * 6144; load_normpar(np, n1g1, mb1, mb1 + 1024, lane); }
                cb = b; } }
        f32x4 v[4];
#pragma unroll
        for (int j = 0; j < 4; ++j) { const f32x4 y = w0 * bf4f(a0[j]) + w1 * bf4f(a1[j]); v[j] = bf4f(xw[j]) + g5r[j] * y; }
        if (l == 0) {
#pragma unroll
            for (int j = 0; j < 4; ++j) *(GAS v2u*)(X + (size_t)m * D + 4 * lane + 256 * j) = f4bf(v[j]);
            norm_row_store_c(v, np, H + (size_t)m * D, lane);
        } else {
            float ss = 0.f;
#pragma unroll
            for (int j = 0; j < 4; ++j) ss += (v[j].x * v[j].x + v[j].y * v[j].y) + (v[j].z * v[j].z + v[j].w * v[j].w);
            const float rstd = rsqrtf(wave_sum(ss) * (1.f / D) + EPS);
#pragma unroll
            for (int j = 0; j < 4; ++j) { const int c = 4 * lane + 256 * j;
                *(GAS f32x4*)(outp + (size_t)(m - NCTX) * D + c) = v[j] * rstd * fgr[j]; }
        }
    }
}

#ifndef PH_MASK
#define PH_MASK 0xFFF
#endif
#define PHON(j) (((PH_MASK) >> (j)) & 1)
__global__ void __launch_bounds__(512, 2) fwd_kernel(Args args) {
    LAS unsigned char* lds = (LAS unsigned char*)lds_raw;
    volatile LAS unsigned* MISC = (volatile LAS unsigned*)(lds + MISC_OFF);
    {
        const int tid = threadIdx.x;
        for (int u = tid; u < (LDS_BYTES - MISC_OFF) / 4; u += 512) MISC[u] = 0u;
        __syncthreads();
        if (tid == 0) { volatile LAS unsigned long long* t = (volatile LAS unsigned long long*)(lds + PTR_OFF);
#pragma unroll
            for (int i = 0; i < N_IN; ++i) t[i] = (unsigned long long)args.in[i];
            t[N_IN] = (unsigned long long)args.out; t[N_IN + 1] = (unsigned long long)args.ws; }
        __syncthreads();
    }
    const Ctx cx;
#if MK_ONE_LAUNCH
    XcdBarrier bar = xcd_barrier_post((unsigned*)(cx.ws() + WS_CTL) + CW_BAR, MISC + 8);
#define GRID_BAR() xcd_barrier(bar)
#else
#define GRID_BAR() do { } while (0)
#endif
    const int lo = args.ph_lo, hi = args.ph_hi;
#define IN(k) (lo <= (k) && (k) < hi)
#define BOTH(k) (IN(k) && IN((k) + 1))
    if (PHON(0) && IN(0)) { TIDS; phase_prologue(cx, lds, tid, lane, wave, bid, G); if (BOTH(0)) GRID_BAR(); }
    if (PHON(1) && IN(1)) { TIDS; phase_norm1_l0(cx, lane, gw, NGW); if (BOTH(1)) GRID_BAR(); }
#define LAYER(L) { constexpr int l = L; constexpr int pb = 2 + 10 * l; \
        if (PHON(2) && IN(pb + 0)) { ph_gemm_in(cx, l); if (BOTH(pb + 0)) GRID_BAR(); } \
        if (PHON(3) && IN(pb + 1)) { ph_prep_r1(cx, l); if (BOTH(pb + 1)) GRID_BAR(); } \
        if (PHON(4) && IN(pb + 2)) { rec_r2(cx, blockIdx.x * 512 + threadIdx.x, gridDim.x * 512); if (BOTH(pb + 2)) GRID_BAR(); } \
        if (PHON(5) && IN(pb + 3)) { ph_mixers(cx, l); if (BOTH(pb + 3)) GRID_BAR(); } \
        if (PHON(6) && IN(pb + 4)) { ph_gemm_out(cx, l); if (BOTH(pb + 4)) GRID_BAR(); } \
        if (PHON(7) && IN(pb + 5)) { ph_router(cx, l); if (BOTH(pb + 5)) GRID_BAR(); } \
        if (PHON(9) && IN(pb + 7)) { ph_gemm_gu(cx, l);   } \
        if (PHON(10) && IN(pb + 8)) { ph_gemm_dn(cx, l); if (BOTH(pb + 8)) GRID_BAR(); } \
        if (PHON(11) && IN(pb + 9)) { ph_combine(cx, l); if (BOTH(pb + 9)) GRID_BAR(); } }
    LAYER(0)
    LAYER(1)
#undef LAYER
#undef IN
#undef BOTH
}

constexpr int NPHASES = 22;
extern "C" void kernel_launch(void* const* d_in, const int* in_sizes, int n_in, void* d_out, int out_size, void* d_ws, size_t ws_size, hipStream_t stream) {
    static int grid = 0;
    if (grid == 0) {
        if (n_in != N_IN || out_size != NLAT * D || ws_size < WS_END) { fprintf(stderr, "kernel_launch: unexpected problem (n_in %d, out %d, ws %zu)\n", n_in, out_size, ws_size); grid = -1; return; }
        int dev = 0, cus = 0, per_cu = 0;
        if (hipGetDevice(&dev) != hipSuccess || hipDeviceGetAttribute(&cus, hipDeviceAttributeMultiprocessorCount, dev) != hipSuccess) { grid = -1; return; }
        if (hipFuncSetAttribute((const void*)fwd_kernel, hipFuncAttributeMaxDynamicSharedMemorySize, LDS_BYTES) != hipSuccess) { fprintf(stderr, "kernel_launch: hipFuncSetAttribute failed\n"); grid = -1; return; }
        if (hipOccupancyMaxActiveBlocksPerMultiprocessor(&per_cu, (const void*)fwd_kernel, 512, LDS_BYTES) != hipSuccess || per_cu < 1) fprintf(stderr, "kernel_launch: occupancy query reports %d\n", per_cu);
        (void)hipGetLastError();
        grid = cus;
    }
    if (grid < 0) return;
    (void)hipMemsetAsync((char*)d_ws + WS_CTL, 0, CTL_BYTES, stream);
    Args a{};
    for (int i = 0; i < N_IN; ++i) a.in[i] = (const float*)d_in[i];
    a.out = (float*)d_out; a.ws = (unsigned char*)d_ws;
#if MK_ONE_LAUNCH
    a.ph_lo = 0; a.ph_hi = NPHASES;
    hipLaunchKernelGGL(fwd_kernel, dim3(grid), dim3(512), LDS_BYTES, stream, a);
#else
    for (int p = 0; p < NPHASES; ++p) { a.ph_lo = p; a.ph_hi = p + 1; hipLaunchKernelGGL(fwd_kernel, dim3(grid), dim3(512), LDS_BYTES, stream, a); }
#endif
}
```
